# Optimizing an MI355X kernel written in HIP

```python
import math
import jax, jax.numpy as jnp
from jax import lax
import numpy as np

D_MODEL = 1024
BATCH = 4
SEQ = 8192
DEPTH = 1

HG_HEADS = 4
HG_HEAD_K = 128
HG_HEAD_V = 128
HG_KEY = HG_HEADS * HG_HEAD_K
HG_VAL = HG_HEADS * HG_HEAD_V
GLA_HEADS = 4
GLA_HEAD_K = 64
GLA_HEAD_V = 128
GLA_KEY = GLA_HEADS * GLA_HEAD_K
GLA_VAL = GLA_HEADS * GLA_HEAD_V
GLA_GATE_RANK = 16
GLA_GATE_NORMALIZER = 16.0
MIX_WIDTH = HG_VAL + GLA_VAL
IN_SPLITS = (HG_KEY, HG_KEY, HG_VAL, HG_VAL, GLA_KEY, GLA_KEY, GLA_VAL, GLA_GATE_RANK, GLA_VAL)
IN_WIDTH = sum(IN_SPLITS)
CHUNK = 64
PEER_HEADS = 8
PEER_N_KEYS = 128
PEER_N_EXPERTS = PEER_N_KEYS * PEER_N_KEYS
PEER_QUERY_DIM = 256
PEER_HALF = PEER_QUERY_DIM // 2
PEER_TOPK = 16
PEER_BLOCK = 128
EPS = 1e-6

kernel_name = "hymba_hgrn2_gla_peer_block"


def rms_norm(x, g):
    xf = x.astype(jnp.float32)
    y = xf * lax.rsqrt(jnp.mean(xf * xf, axis=-1, keepdims=True) + EPS)
    return (y * g.astype(jnp.float32)).astype(x.dtype)


def split_heads(a, n_heads):
    b, t, w = a.shape
    return a.reshape(b, t, n_heads, w // n_heads).transpose(0, 2, 1, 3)


def merge_heads(a):
    b, n, t, d = a.shape
    return a.transpose(0, 2, 1, 3).reshape(b, t, n * d)


def chunk_gated_linear_attention(q, k, v, log_g):
    b, h, t, dk = q.shape
    dv = v.shape[-1]
    n_chunks = t // CHUNK

    def to_chunks(a):
        return a.astype(jnp.float32).reshape(b, h, n_chunks, CHUNK, a.shape[-1]).transpose(2, 0, 1, 3, 4)

    qc, kc, vc, gc = to_chunks(q), to_chunks(k), to_chunks(v), to_chunks(log_g)
    causal = jnp.tril(jnp.ones((CHUNK, CHUNK), dtype=bool))[:, :, None]

    def step(state, inp):
        qb, kb, vb, gb = inp
        cum = jnp.cumsum(gb, axis=2)
        rel = cum[:, :, :, None, :] - cum[:, :, None, :, :]
        decay = jnp.exp(jnp.where(causal, rel, -jnp.inf))
        scores = jnp.einsum('bhid,bhjd,bhijd->bhij', qb, kb, decay)
        out = (jnp.einsum('bhij,bhjv->bhiv', scores, vb)
               + jnp.einsum('bhid,bhdv->bhiv', qb * jnp.exp(cum), state))
        last = cum[:, :, -1:, :]
        state = (jnp.exp(last[:, :, 0, :])[..., None] * state
                 + jnp.einsum('bhjd,bhjv->bhdv', kb * jnp.exp(last - cum), vb))
        return state, out

    s0 = jnp.zeros((b, h, dk, dv), jnp.float32)
    _, o = lax.scan(step, s0, (qc, kc, vc, gc))
    return o.transpose(1, 2, 0, 3, 4).reshape(b, h, t, dv)


def hgrn2_mixer(q, f, i, gate, lower_bound, norm_g):
    q = jax.nn.silu(q)
    forget = lower_bound + (1.0 - lower_bound) * jax.nn.sigmoid(f.astype(jnp.float32))
    key = 1.0 - forget
    log_f = jnp.log(forget)
    o = chunk_gated_linear_attention(split_heads(q, HG_HEADS), split_heads(key, HG_HEADS),
                                     split_heads(i, HG_HEADS), split_heads(log_f, HG_HEADS))
    o = merge_heads(rms_norm(o, norm_g))
    return (o * jax.nn.silu(gate.astype(jnp.float32))).astype(gate.dtype)


def gla_mixer(q, k, v, gate_low, gate, w_gate_up, b_gate, norm_g):
    log_g = jax.nn.log_sigmoid((gate_low @ w_gate_up + b_gate).astype(jnp.float32)) / GLA_GATE_NORMALIZER
    q = q * (GLA_HEAD_K ** -0.5)
    o = chunk_gated_linear_attention(split_heads(q, GLA_HEADS), split_heads(k, GLA_HEADS),
                                     split_heads(v, GLA_HEADS), split_heads(log_g, GLA_HEADS))
    o = merge_heads(rms_norm(o, norm_g))
    return (o * jax.nn.silu(gate.astype(jnp.float32))).astype(gate.dtype)


def peer_ffn(xn, w_q, sub_keys, u, v):
    b, t, d = xn.shape
    blocks = xn.reshape(-1, PEER_BLOCK, d)

    def block(xb):
        q = (xb @ w_q).reshape(PEER_BLOCK, PEER_HEADS, 2, PEER_HALF)
        s = jnp.einsum('thpd,hpnd->thpn', q, sub_keys).astype(jnp.float32)
        s_top, i_top = lax.top_k(s, PEER_TOPK)
        cand = s_top[:, :, 0, :, None] + s_top[:, :, 1, None, :]
        cand_idx = i_top[:, :, 0, :, None] * PEER_N_KEYS + i_top[:, :, 1, None, :]
        cand = cand.reshape(PEER_BLOCK, PEER_HEADS, PEER_TOPK * PEER_TOPK)
        cand_idx = cand_idx.reshape(PEER_BLOCK, PEER_HEADS, PEER_TOPK * PEER_TOPK)
        best, pos = lax.top_k(cand, PEER_TOPK)
        expert = jnp.take_along_axis(cand_idx, pos, axis=-1)
        g = jax.nn.softmax(best, axis=-1)
        act = jax.nn.gelu(jnp.einsum('td,thkd->thk', xb, u[expert]), approximate=False)
        return jnp.einsum('thk,thkd->td', (g * act).astype(xb.dtype), v[expert])

    return lax.map(block, blocks).reshape(b, t, d)


def setup_inputs(seed: int = 0) -> dict:
    key = jax.random.key(seed)
    ks = jax.random.split(key, 16)
    nrm = jax.random.normal
    L = DEPTH
    return {
        "x": nrm(ks[0], (BATCH, SEQ, D_MODEL), jnp.float32),
        "norm1_g": 1.0 + 0.02 * nrm(ks[1], (L, D_MODEL), jnp.float32),
        "w_in": nrm(ks[2], (L, D_MODEL, IN_WIDTH), jnp.float32) * D_MODEL ** -0.5,
        "hg_lower_logits": 0.1 * nrm(ks[3], (L + 1, HG_KEY), jnp.float32),
        "hg_norm_g": 1.0 + 0.02 * nrm(ks[4], (L, HG_HEAD_V), jnp.float32),
        "gla_w_gate_up": nrm(ks[5], (L, GLA_GATE_RANK, GLA_KEY), jnp.float32) * GLA_GATE_RANK ** -0.5,
        "gla_b_gate": 0.1 * nrm(ks[6], (L, GLA_KEY), jnp.float32),
        "gla_norm_g": 1.0 + 0.02 * nrm(ks[7], (L, GLA_HEAD_V), jnp.float32),
        "w_out": nrm(ks[8], (L, MIX_WIDTH, D_MODEL), jnp.float32) * MIX_WIDTH ** -0.5,
        "norm2_g": 1.0 + 0.02 * nrm(ks[9], (L, D_MODEL), jnp.float32),
        "peer_w_q": nrm(ks[10], (L, D_MODEL, PEER_HEADS * PEER_QUERY_DIM), jnp.float32) * D_MODEL ** -0.5,
        "peer_sub_keys": nrm(ks[11], (L, PEER_HEADS, 2, PEER_N_KEYS, PEER_HALF), jnp.float32) * PEER_HALF ** -0.5,
        "peer_u": nrm(ks[12], (L, PEER_N_EXPERTS, D_MODEL), jnp.float32) * D_MODEL ** -0.5,
        "peer_v": nrm(ks[13], (L, PEER_N_EXPERTS, D_MODEL), jnp.float32) * 0.3,
        "norm_f_g": 1.0 + 0.02 * nrm(ks[14], (D_MODEL,), jnp.float32),
    }


def reference(x, norm1_g, w_in, hg_lower_logits, hg_norm_g, gla_w_gate_up, gla_b_gate, gla_norm_g,
              w_out, norm2_g, peer_w_q, peer_sub_keys, peer_u, peer_v, norm_f_g):
    lower_bounds = jnp.cumsum(jax.nn.softmax(hg_lower_logits.astype(jnp.float32), axis=0), axis=0)
    offsets = [int(o) for o in np.cumsum(IN_SPLITS)[:-1]]
    h = x
    for layer in range(DEPTH):
        xn = rms_norm(h, norm1_g[layer])
        proj = xn @ w_in[layer]
        hq, hf, hi, hgate, gq, gk, gv, glow, ggate = jnp.split(proj, offsets, axis=-1)
        o_hgrn = hgrn2_mixer(hq, hf, hi, hgate, lower_bounds[layer], hg_norm_g[layer])
        o_gla = gla_mixer(gq, gk, gv, glow, ggate, gla_w_gate_up[layer], gla_b_gate[layer], gla_norm_g[layer])
        mixed = jnp.concatenate([o_hgrn, o_gla], axis=-1)
        h = h + (mixed @ w_out[layer]).astype(h.dtype)
        hn = rms_norm(h, norm2_g[layer])
        h = h + peer_ffn(hn, peer_w_q[layer], peer_sub_keys[layer], peer_u[layer], peer_v[layer]).astype(h.dtype)
    return rms_norm(h, norm_f_g)
```

```cpp
#include <hip/hip_runtime.h>
#include <hip/hip_cooperative_groups.h>
#include <cstdio>
#include <cstdint>
namespace cg = cooperative_groups;

#ifndef N_LAUNCH_MODE
#define N_LAUNCH_MODE 0
#endif

#define DEVI __device__ __forceinline__
typedef unsigned short bf16_t;
using bf16x8 = __attribute__((ext_vector_type(8))) short;
using f32x4 = __attribute__((ext_vector_type(4))) float;

constexpr int M_TOK = 32768;
constexpr int DM = 1024;
constexpr int IN_WP = 3712;
constexpr size_t MiB = 1024ull * 1024ull;

constexpr size_t OFF_XN   = 0;
constexpr size_t OFF_WIN  = 64 * MiB;
constexpr size_t OFF_WOUT = 72 * MiB;
constexpr size_t OFF_WQ   = 74 * MiB;
constexpr size_t OFF_SK   = 78 * MiB;
constexpr size_t OFF_LB   = 79 * MiB;
constexpr size_t OFF_UB   = 80 * MiB;
constexpr size_t OFF_VB   = 112 * MiB;
constexpr size_t OFF_R2   = 144 * MiB;
constexpr size_t OFF_HQ   = OFF_R2;
constexpr size_t OFF_HLF  = OFF_R2 + 32 * MiB;
constexpr size_t OFF_HVT  = OFF_R2 + 64 * MiB;
constexpr size_t OFF_HG   = OFF_R2 + 96 * MiB;
constexpr size_t OFF_GQ   = OFF_R2 + 128 * MiB;
constexpr size_t OFF_GK   = OFF_R2 + 144 * MiB;
constexpr size_t OFF_GVT  = OFF_R2 + 160 * MiB;
constexpr size_t OFF_GG   = OFF_R2 + 192 * MiB;
constexpr size_t OFF_GLOW = OFF_R2 + 224 * MiB;
constexpr size_t OFF_KTH  = 370 * MiB;
constexpr size_t OFF_KTG  = 402 * MiB;
constexpr size_t OFF_DECH = 418 * MiB;
constexpr size_t OFF_DECG = 419 * MiB;
constexpr size_t WS_NEED  = 420 * MiB;
constexpr size_t OFF_MIX  = OFF_XN;
constexpr size_t OFF_HN   = OFF_R2;
constexpr size_t OFF_Q    = OFF_R2 + 64 * MiB;
constexpr size_t OFF_EIDX = OFF_KTH;
constexpr size_t OFF_EW   = OFF_KTH + 16 * MiB;
constexpr size_t OUT_STH = 0;
constexpr size_t OUT_STG = 64 * MiB;

struct Params {
    const float* x; const float* norm1_g; const float* w_in; const float* hg_lower; const float* hg_norm_g;
    const float* gla_wg; const float* gla_bg; const float* gla_norm_g; const float* w_out; const float* norm2_g;
    const float* w_q; const float* sub_keys; const float* peer_u; const float* peer_v; const float* norm_f_g;
    float* out; unsigned char* ws;
    int ph_lo, ph_hi;
};

DEVI unsigned short f2bf(float f) {
    unsigned u = __float_as_uint(f);
    u += 0x7fffu + ((u >> 16) & 1u);
    return (unsigned short)(u >> 16);
}
DEVI float bf2f(unsigned short b) { return __uint_as_float(((unsigned)b) << 16); }
DEVI unsigned pack2(float a, float b) { return (unsigned)f2bf(a) | ((unsigned)f2bf(b) << 16); }
DEVI float bflo(unsigned u) { return __uint_as_float(u << 16); }
DEVI float bfhi(unsigned u) { return __uint_as_float(u & 0xffff0000u); }
DEVI float wave_sum(float v) {
#pragma unroll
    for (int o = 32; o > 0; o >>= 1) v += __shfl_xor(v, o);
    return v;
}
DEVI float wave_max(float v) {
#pragma unroll
    for (int o = 32; o > 0; o >>= 1) v = fmaxf(v, __shfl_xor(v, o));
    return v;
}
DEVI float silu_f(float x) { return x / (1.f + __expf(-x)); }
DEVI f32x4 mfma16(bf16x8 a, bf16x8 b, f32x4 c) { return __builtin_amdgcn_mfma_f32_16x16x32_bf16(a, b, c, 0, 0, 0); }
DEVI bf16x8 ldg_frag(const bf16_t* p) { return *reinterpret_cast<const bf16x8*>(p); }

DEVI void rms_row_bf16(const float* __restrict__ xr, const float* __restrict__ g, bf16_t* __restrict__ dst, int lane) {
    float4 v[4]; float ss = 0.f;
#pragma unroll
    for (int i = 0; i < 4; ++i) { v[i] = reinterpret_cast<const float4*>(xr)[lane + 64 * i]; ss += v[i].x * v[i].x + v[i].y * v[i].y + v[i].z * v[i].z + v[i].w * v[i].w; }
    ss = wave_sum(ss);
    const float r = rsqrtf(ss * (1.f / 1024.f) + 1e-6f);
#pragma unroll
    for (int i = 0; i < 4; ++i) {
        const float4 gg = reinterpret_cast<const float4*>(g)[lane + 64 * i];
        uint2 o; o.x = pack2(v[i].x * r * gg.x, v[i].y * r * gg.y); o.y = pack2(v[i].z * r * gg.z, v[i].w * r * gg.w);
        reinterpret_cast<uint2*>(dst)[lane + 64 * i] = o;
    }
}

DEVI void transpose_tile(const float* __restrict__ src, int Nsrc, bf16_t* __restrict__ dst, int nt, int kt, int mode, float* lds) {
    const int tid = threadIdx.x, tx = tid & 63, ty = tid >> 6;
    const int np = nt * 64 + tx;
    int col = np; bool valid = true;
    if (mode == 1) {
        if (np < 3072) col = np; else if (np < 3584) col = np + 16; else if (np < 3600) col = np - 512; else { valid = false; col = 0; }
    }
#pragma unroll 4
    for (int kk = ty; kk < 64; kk += 4) {
        lds[kk * 65 + tx] = valid ? src[(size_t)(kt * 64 + kk) * Nsrc + col] : 0.f;
    }
    __syncthreads();
    const int nl = tid >> 2, kq = tid & 3;
    unsigned pk[8];
#pragma unroll
    for (int i = 0; i < 8; ++i) pk[i] = pack2(lds[(kq * 16 + 2 * i) * 65 + nl], lds[(kq * 16 + 2 * i + 1) * 65 + nl]);
    uint4* d = reinterpret_cast<uint4*>(dst + (size_t)(nt * 64 + nl) * 1024 + kt * 64 + kq * 16);
    d[0] = make_uint4(pk[0], pk[1], pk[2], pk[3]);
    d[1] = make_uint4(pk[4], pk[5], pk[6], pk[7]);
    __syncthreads();
}

DEVI void convert8(const float* __restrict__ src, bf16_t* __restrict__ dst, size_t idx8) {
    const float4 a = reinterpret_cast<const float4*>(src)[idx8 * 2], b = reinterpret_cast<const float4*>(src)[idx8 * 2 + 1];
    reinterpret_cast<uint4*>(dst)[idx8] = make_uint4(pack2(a.x, a.y), pack2(a.z, a.w), pack2(b.x, b.y), pack2(b.z, b.w));
}

constexpr int P0_XN = 8192, P0_WIN = 58 * 16, P0_WOUT = 16 * 16, P0_WQ = 32 * 16, P0_UV = 16384, P0_SK = 128, P0_LB = 1;
constexpr int P0_UNITS = P0_XN + P0_WIN + P0_WOUT + P0_WQ + P0_UV + P0_SK + P0_LB;

DEVI void phase0_unit(const Params& p, int u, char* smem) {
    const int tid = threadIdx.x, lane = tid & 63, w = tid >> 6;
    unsigned char* ws = p.ws;
    if (u < P0_XN) {
        const int row = u * 4 + w;
        rms_row_bf16(p.x + (size_t)row * DM, p.norm1_g, reinterpret_cast<bf16_t*>(ws + OFF_XN) + (size_t)row * DM, lane);
        return;
    }
    u -= P0_XN;
    if (u < P0_WIN) { transpose_tile(p.w_in, 3600, reinterpret_cast<bf16_t*>(ws + OFF_WIN), u / 16, u % 16, 1, reinterpret_cast<float*>(smem)); return; }
    u -= P0_WIN;
    if (u < P0_WOUT) { transpose_tile(p.w_out, 1024, reinterpret_cast<bf16_t*>(ws + OFF_WOUT), u / 16, u % 16, 0, reinterpret_cast<float*>(smem)); return; }
    u -= P0_WOUT;
    if (u < P0_WQ) { transpose_tile(p.w_q, 2048, reinterpret_cast<bf16_t*>(ws + OFF_WQ), u / 16, u % 16, 0, reinterpret_cast<float*>(smem)); return; }
    u -= P0_WQ;
    if (u < P0_UV) {
        const bool isv = u >= 8192; const int uu = isv ? u - 8192 : u;
        convert8(isv ? p.peer_v : p.peer_u, reinterpret_cast<bf16_t*>(ws + (isv ? OFF_VB : OFF_UB)), (size_t)uu * 256 + tid);
        return;
    }
    u -= P0_UV;
    if (u < P0_SK) { convert8(p.sub_keys, reinterpret_cast<bf16_t*>(ws + OFF_SK), (size_t)u * 256 + tid); return; }
    float* lb = reinterpret_cast<float*>(ws + OFF_LB);
    for (int n = tid; n < 512; n += 256) {
        const float l0 = p.hg_lower[n], l1 = p.hg_lower[512 + n];
        const float mx = fmaxf(l0, l1); const float e0 = __expf(l0 - mx), e1 = __expf(l1 - mx);
        lb[n] = e0 / (e0 + e1);
    }
}

template <bool SW>
DEVI void gemm_tile(const bf16_t* __restrict__ A, const bf16_t* __restrict__ Bt, int K, int m0, int n0, char* smem, f32x4 (&acc)[4][4]) {
    const int tid = threadIdx.x, lane = tid & 63, w = tid >> 6, wm = w >> 1, wn = w & 1;
#pragma unroll
    for (int i = 0; i < 4; ++i)
#pragma unroll
        for (int j = 0; j < 4; ++j) acc[i][j] = f32x4{0.f, 0.f, 0.f, 0.f};
    const int lrow = tid >> 3, lch = tid & 7;
    const bf16_t* ga = A + (size_t)(m0 + lrow) * K + lch * 8;
    const bf16_t* gb = Bt + (size_t)(n0 + lrow) * K + lch * 8;
    const int lds_off = lrow * 128 + ((lch ^ (lrow & 7)) << 4);
    const int fr_base = (lane & 15) * 128;
    const int xo0 = (((lane >> 4)) ^ (lane & 7)) << 4;
    const int xo1 = ((4 + (lane >> 4)) ^ (lane & 7)) << 4;
    uint4 ra[4], rb[4];
    const int nk = K >> 6;
#pragma unroll
    for (int i = 0; i < 4; ++i) { ra[i] = *reinterpret_cast<const uint4*>(ga + (size_t)i * 32 * K); rb[i] = *reinterpret_cast<const uint4*>(gb + (size_t)i * 32 * K); }
#pragma unroll
    for (int i = 0; i < 4; ++i) { *reinterpret_cast<uint4*>(smem + lds_off + i * 4096) = ra[i]; *reinterpret_cast<uint4*>(smem + 16384 + lds_off + i * 4096) = rb[i]; }
    __syncthreads();
    for (int kt = 0; kt < nk; ++kt) {
        const char* sA = smem + (kt & 1) * 32768;
        const char* sB = sA + 16384;
        if (kt + 1 < nk) {
#pragma unroll
            for (int i = 0; i < 4; ++i) { ra[i] = *reinterpret_cast<const uint4*>(ga + (size_t)i * 32 * K + (kt + 1) * 64); rb[i] = *reinterpret_cast<const uint4*>(gb + (size_t)i * 32 * K + (kt + 1) * 64); }
        }
#pragma unroll
        for (int ks = 0; ks < 2; ++ks) {
            const int xo = ks ? xo1 : xo0;
            bf16x8 af[4], bfr[4];
#pragma unroll
            for (int i = 0; i < 4; ++i) {
                af[i] = *reinterpret_cast<const bf16x8*>(sA + (wm * 64 + i * 16) * 128 + fr_base + xo);
                bfr[i] = *reinterpret_cast<const bf16x8*>(sB + (wn * 64 + i * 16) * 128 + fr_base + xo);
            }
#pragma unroll
            for (int i = 0; i < 4; ++i)
#pragma unroll
                for (int j = 0; j < 4; ++j) acc[i][j] = SW ? mfma16(bfr[j], af[i], acc[i][j]) : mfma16(af[i], bfr[j], acc[i][j]);
        }
        if (kt + 1 < nk) {
            char* dA = smem + ((kt + 1) & 1) * 32768;
#pragma unroll
            for (int i = 0; i < 4; ++i) { *reinterpret_cast<uint4*>(dA + lds_off + i * 4096) = ra[i]; *reinterpret_cast<uint4*>(dA + 16384 + lds_off + i * 4096) = rb[i]; }
        }
        __syncthreads();
    }
}

constexpr int P1_NT = IN_WP / 128;
constexpr int P1_UNITS = (M_TOK / 128) * P1_NT;

template <typename F>
DEVI void store_sw_bf16(const f32x4 (&acc)[4][4], bf16_t* dst, int ld, int m0, int ncol0, F f) {
    const int lane = threadIdx.x & 63, w = threadIdx.x >> 6, wm = w >> 1, wn = w & 1;
#pragma unroll
    for (int mi = 0; mi < 4; ++mi)
#pragma unroll
        for (int ni = 0; ni < 4; ++ni) {
            const int m = m0 + wm * 64 + mi * 16 + (lane & 15);
            const int n = ncol0 + wn * 64 + ni * 16 + 4 * (lane >> 4);
            uint2 o; o.x = pack2(f(acc[mi][ni][0], n), f(acc[mi][ni][1], n + 1)); o.y = pack2(f(acc[mi][ni][2], n + 2), f(acc[mi][ni][3], n + 3));
            *reinterpret_cast<uint2*>(dst + (size_t)m * ld + n) = o;
        }
}
DEVI void store_ns_T(const f32x4 (&acc)[4][4], bf16_t* dst, int ncols, int m0, int ncol0) {
    const int lane = threadIdx.x & 63, w = threadIdx.x >> 6, wm = w >> 1, wn = w & 1;
#pragma unroll
    for (int mi = 0; mi < 4; ++mi)
#pragma unroll
        for (int ni = 0; ni < 4; ++ni) {
            const int m = m0 + wm * 64 + mi * 16 + 4 * (lane >> 4);
            const int n = ncol0 + wn * 64 + ni * 16 + (lane & 15);
            uint2 o; o.x = pack2(acc[mi][ni][0], acc[mi][ni][1]); o.y = pack2(acc[mi][ni][2], acc[mi][ni][3]);
            *reinterpret_cast<uint2*>(dst + ((size_t)(m >> 6) * ncols + n) * 64 + (m & 63)) = o;
        }
}

DEVI void phase1_unit(const Params& p, int u, char* smem) {
    unsigned char* ws = p.ws;
    const int mt = u / P1_NT, nt = u % P1_NT;
    const int m0 = mt * 128, n0 = nt * 128;
    const bf16_t* A = reinterpret_cast<const bf16_t*>(ws + OFF_XN);
    const bf16_t* Bt = reinterpret_cast<const bf16_t*>(ws + OFF_WIN);
    f32x4 acc[4][4];
    const bool ns = (n0 >= 1024 && n0 < 1536) || (n0 >= 2560 && n0 < 3072);
    if (ns) {
        gemm_tile<false>(A, Bt, 1024, m0, n0, smem, acc);
        if (n0 < 1536) store_ns_T(acc, reinterpret_cast<bf16_t*>(ws + OFF_HVT), 512, m0, n0 - 1024);
        else store_ns_T(acc, reinterpret_cast<bf16_t*>(ws + OFF_GVT), 512, m0, n0 - 2560);
        return;
    }
    gemm_tile<true>(A, Bt, 1024, m0, n0, smem, acc);
    if (n0 < 512) {
        store_sw_bf16(acc, reinterpret_cast<bf16_t*>(ws + OFF_HQ), 512, m0, n0, [](float v, int) { return silu_f(v); });
    } else if (n0 < 1024) {
        const float* lb = reinterpret_cast<const float*>(ws + OFF_LB);
        store_sw_bf16(acc, reinterpret_cast<bf16_t*>(ws + OFF_HLF), 512, m0, n0 - 512, [lb](float v, int n) {
            const float l = lb[n]; const float fg = l + (1.f - l) / (1.f + __expf(-v)); return __logf(fg); });
    } else if (n0 < 2048) {
        store_sw_bf16(acc, reinterpret_cast<bf16_t*>(ws + OFF_HG), 512, m0, n0 - 1536, [](float v, int) { return silu_f(v); });
    } else if (n0 < 2304) {
        store_sw_bf16(acc, reinterpret_cast<bf16_t*>(ws + OFF_GQ), 256, m0, n0 - 2048, [](float v, int) { return v * 0.125f; });
    } else if (n0 < 2560) {
        store_sw_bf16(acc, reinterpret_cast<bf16_t*>(ws + OFF_GK), 256, m0, n0 - 2304, [](float v, int) { return v; });
    } else if (n0 < 3584) {
        store_sw_bf16(acc, reinterpret_cast<bf16_t*>(ws + OFF_GG), 512, m0, n0 - 3072, [](float v, int) { return silu_f(v); });
    } else {
        const int lane = threadIdx.x & 63, w = threadIdx.x >> 6, wm = w >> 1, wn = w & 1;
        if (wn == 0) {
            float* gl = reinterpret_cast<float*>(ws + OFF_GLOW);
#pragma unroll
            for (int mi = 0; mi < 4; ++mi) {
                const int m = m0 + wm * 64 + mi * 16 + (lane & 15);
                const int n = 4 * (lane >> 4);
                *reinterpret_cast<float4*>(gl + (size_t)m * 16 + n) = make_float4(acc[mi][0][0], acc[mi][0][1], acc[mi][0][2], acc[mi][0][3]);
            }
        }
    }
}

constexpr int P2_UNITS = 512 * 3;
DEVI float logsigmoid_f(float z) { return fminf(z, 0.f) - __logf(1.f + __expf(-fabsf(z))); }

DEVI void phase2_unit(const Params& p, int u, char* smem) {
    unsigned char* ws = p.ws;
    const int tid = threadIdx.x;
    const int cidx = u / 3, part = u % 3;
    const size_t row0 = (size_t)cidx * 64;
    if (part < 2) {
        const int n = part * 256 + tid;
        bf16_t* HQ = reinterpret_cast<bf16_t*>(ws + OFF_HQ);
        bf16_t* HLF = reinterpret_cast<bf16_t*>(ws + OFF_HLF);
        bf16_t* KT = reinterpret_cast<bf16_t*>(ws + OFF_KTH);
        float Gl = 0.f;
#pragma unroll 8
        for (int r = 0; r < 64; ++r) Gl += bf2f(HLF[(row0 + r) * 512 + n]);
        float G = 0.f;
        for (int r8 = 0; r8 < 8; ++r8) {
            unsigned pk[4];
#pragma unroll
            for (int rr = 0; rr < 8; ++rr) {
                const size_t idx = (row0 + r8 * 8 + rr) * 512 + n;
                const float lf = bf2f(HLF[idx]);
                G += lf;
                const float key = 1.f - __expf(lf);
                const float q = bf2f(HQ[idx]);
                const unsigned short bq = f2bf(q * __expf(G));
                const unsigned short bk = f2bf(key * __expf(-G));
                HQ[idx] = bq; HLF[idx] = bk;
                if (rr & 1) pk[rr >> 1] |= ((unsigned)bk << 16); else pk[rr >> 1] = bk;
            }
            *reinterpret_cast<uint4*>(KT + ((size_t)cidx * 512 + n) * 64 + r8 * 8) = make_uint4(pk[0], pk[1], pk[2], pk[3]);
        }
        reinterpret_cast<float*>(ws + OFF_DECH)[(size_t)cidx * 512 + n] = __expf(Gl);
    } else {
        const int n = tid;
        bf16_t* GQ = reinterpret_cast<bf16_t*>(ws + OFF_GQ);
        bf16_t* GK = reinterpret_cast<bf16_t*>(ws + OFF_GK);
        bf16_t* KT = reinterpret_cast<bf16_t*>(ws + OFF_KTG);
        const float* GL = reinterpret_cast<const float*>(ws + OFF_GLOW);
        float wg[16];
#pragma unroll
        for (int j = 0; j < 16; ++j) wg[j] = p.gla_wg[j * 256 + n];
        const float bg = p.gla_bg[n];
        float Gl = 0.f;
        for (int r = 0; r < 64; ++r) {
            const float4* g4 = reinterpret_cast<const float4*>(GL + (row0 + r) * 16);
            float z = bg;
#pragma unroll
            for (int j = 0; j < 4; ++j) { const float4 t = g4[j]; z += t.x * wg[4 * j] + t.y * wg[4 * j + 1] + t.z * wg[4 * j + 2] + t.w * wg[4 * j + 3]; }
            Gl += logsigmoid_f(z) * (1.f / 16.f);
        }
        float G = 0.f;
        for (int r8 = 0; r8 < 8; ++r8) {
            unsigned pk[4];
#pragma unroll
            for (int rr = 0; rr < 8; ++rr) {
                const size_t row = row0 + r8 * 8 + rr;
                const float4* g4 = reinterpret_cast<const float4*>(GL + row * 16);
                float z = bg;
#pragma unroll
                for (int j = 0; j < 4; ++j) { const float4 t = g4[j]; z += t.x * wg[4 * j] + t.y * wg[4 * j + 1] + t.z * wg[4 * j + 2] + t.w * wg[4 * j + 3]; }
                G += logsigmoid_f(z) * (1.f / 16.f);
                const size_t idx = row * 256 + n;
                const unsigned short bq = f2bf(bf2f(GQ[idx]) * __expf(G));
                const unsigned short bk = f2bf(bf2f(GK[idx]) * __expf(-G));
                GQ[idx] = bq; GK[idx] = bk;
                if (rr & 1) pk[rr >> 1] |= ((unsigned)bk << 16); else pk[rr >> 1] = bk;
            }
            *reinterpret_cast<uint4*>(KT + ((size_t)cidx * 256 + n) * 64 + r8 * 8) = make_uint4(pk[0], pk[1], pk[2], pk[3]);
        }
        reinterpret_cast<float*>(ws + OFF_DECG)[(size_t)cidx * 256 + n] = __expf(Gl);
    }
}

constexpr int P3_UNITS = 4096;
template <int DK>
DEVI void kv_unit(const Params& p, int sidx, int c) {
    unsigned char* ws = p.ws;
    const int lane = threadIdx.x & 63, w = threadIdx.x >> 6;
    const int b = sidx >> 2, h = sidx & 3;
    const int cidx = b * 128 + c;
    constexpr int NDB = DK / 16;
    const bf16_t* KT = reinterpret_cast<const bf16_t*>(ws + (DK == 128 ? OFF_KTH : OFF_KTG)) + ((size_t)cidx * (4 * DK) + h * DK) * 64;
    const bf16_t* VT = reinterpret_cast<const bf16_t*>(ws + (DK == 128 ? OFF_HVT : OFF_GVT)) + ((size_t)cidx * 512 + h * 128) * 64;
    const float* DEC = reinterpret_cast<const float*>(ws + (DK == 128 ? OFF_DECH : OFF_DECG)) + (size_t)cidx * (4 * DK) + h * DK;
    bf16_t* ST = reinterpret_cast<bf16_t*>(reinterpret_cast<unsigned char*>(p.out) + (DK == 128 ? OUT_STH : OUT_STG)) + ((size_t)sidx * 128 + c) * (128 * DK);
    f32x4 acc[NDB][2];
#pragma unroll
    for (int i = 0; i < NDB; ++i) { acc[i][0] = f32x4{0, 0, 0, 0}; acc[i][1] = f32x4{0, 0, 0, 0}; }
    const int fo = (lane & 15) * 64 + 8 * (lane >> 4);
#pragma unroll
    for (int ks = 0; ks < 2; ++ks) {
        bf16x8 bv[2];
#pragma unroll
        for (int nb = 0; nb < 2; ++nb) bv[nb] = ldg_frag(VT + (size_t)(32 * w + nb * 16) * 64 + fo + ks * 32);
#pragma unroll
        for (int db = 0; db < NDB; ++db) {
            const bf16x8 ak = ldg_frag(KT + (size_t)(db * 16) * 64 + fo + ks * 32);
            acc[db][0] = mfma16(ak, bv[0], acc[db][0]);
            acc[db][1] = mfma16(ak, bv[1], acc[db][1]);
        }
    }
#pragma unroll
    for (int db = 0; db < NDB; ++db) {
        const int d = db * 16 + 4 * (lane >> 4);
        const float4 dc = *reinterpret_cast<const float4*>(DEC + d);
#pragma unroll
        for (int nb = 0; nb < 2; ++nb) {
            const int dv = 32 * w + nb * 16 + (lane & 15);
            uint2 o; o.x = pack2(acc[db][nb][0] * dc.x, acc[db][nb][1] * dc.y); o.y = pack2(acc[db][nb][2] * dc.z, acc[db][nb][3] * dc.w);
            *reinterpret_cast<uint2*>(ST + (size_t)dv * DK + d) = o;
        }
    }
}
DEVI void phase3_unit(const Params& p, int u, char* smem) {
    if (u < 2048) kv_unit<128>(p, u >> 7, u & 127); else { u -= 2048; kv_unit<64>(p, u >> 7, u & 127); }
}

constexpr int P4_UNITS = 384;
DEVI void phase4_unit(const Params& p, int u, char* smem) {
    unsigned char* ws = p.ws;
    int e = u * 256 + threadIdx.x;
    bf16_t* base; const float* dec; size_t cstride; int decstride;
    if (e < 65536) {
        const int sidx = e >> 12, rem = e & 4095, dv = rem >> 5, d4 = (rem & 31) * 4;
        const int b = sidx >> 2, h = sidx & 3;
        base = reinterpret_cast<bf16_t*>(reinterpret_cast<unsigned char*>(p.out) + OUT_STH) + ((size_t)sidx * 128) * 16384 + dv * 128 + d4;
        cstride = 16384;
        dec = reinterpret_cast<const float*>(ws + OFF_DECH) + (size_t)(b * 128) * 512 + h * 128 + d4; decstride = 512;
    } else {
        e -= 65536;
        const int sidx = e >> 11, rem = e & 2047, dv = rem >> 4, d4 = (rem & 15) * 4;
        const int b = sidx >> 2, h = sidx & 3;
        base = reinterpret_cast<bf16_t*>(reinterpret_cast<unsigned char*>(p.out) + OUT_STG) + ((size_t)sidx * 128) * 8192 + dv * 64 + d4;
        cstride = 8192;
        dec = reinterpret_cast<const float*>(ws + OFF_DECG) + (size_t)(b * 128) * 256 + h * 64 + d4; decstride = 256;
    }
    float s0 = 0.f, s1 = 0.f, s2 = 0.f, s3 = 0.f;
    for (int c8 = 0; c8 < 128; c8 += 8) {
        uint2 kv[8]; float4 dc[8];
#pragma unroll
        for (int i = 0; i < 8; ++i) { kv[i] = *reinterpret_cast<const uint2*>(base + (size_t)(c8 + i) * cstride); dc[i] = *reinterpret_cast<const float4*>(dec + (size_t)(c8 + i) * decstride); }
#pragma unroll
        for (int i = 0; i < 8; ++i) {
            uint2 o; o.x = pack2(s0, s1); o.y = pack2(s2, s3);
            *reinterpret_cast<uint2*>(base + (size_t)(c8 + i) * cstride) = o;
            s0 = dc[i].x * s0 + bflo(kv[i].x); s1 = dc[i].y * s1 + bfhi(kv[i].x);
            s2 = dc[i].z * s2 + bflo(kv[i].y); s3 = dc[i].w * s3 + bfhi(kv[i].y);
        }
    }
}

constexpr int P5_UNITS = 4096;
constexpr int PL_PITCH = 72;
template <int DK>
DEVI void out_unit(const Params& p, int sidx, int c, char* smem) {
    unsigned char* ws = p.ws;
    const int lane = threadIdx.x & 63, w = threadIdx.x >> 6;
    const int b = sidx >> 2, h = sidx & 3;
    const int cidx = b * 128 + c;
    const size_t row0 = (size_t)cidx * 64;
    constexpr int LDQ = 4 * DK;
    const bf16_t* Qn = reinterpret_cast<const bf16_t*>(ws + (DK == 128 ? OFF_HQ : OFF_GQ)) + row0 * LDQ + h * DK;
    const bf16_t* Kn = reinterpret_cast<const bf16_t*>(ws + (DK == 128 ? OFF_HLF : OFF_GK)) + row0 * LDQ + h * DK;
    const bf16_t* VT = reinterpret_cast<const bf16_t*>(ws + (DK == 128 ? OFF_HVT : OFF_GVT)) + ((size_t)cidx * 512 + h * 128) * 64;
    const bf16_t* ST = reinterpret_cast<const bf16_t*>(reinterpret_cast<const unsigned char*>(p.out) + (DK == 128 ? OUT_STH : OUT_STG)) + ((size_t)sidx * 128 + c) * (128 * DK);
    const bf16_t* GATE = reinterpret_cast<const bf16_t*>(ws + (DK == 128 ? OFF_HG : OFF_GG)) + row0 * 512 + h * 128;
    const float* ng = (DK == 128) ? p.hg_norm_g : p.gla_norm_g;
    bf16_t* MIX = reinterpret_cast<bf16_t*>(ws + OFF_MIX) + row0 * 1024 + (DK == 128 ? 0 : 512) + h * 128;
    bf16_t* PL = reinterpret_cast<bf16_t*>(smem);
    float* RED = reinterpret_cast<float*>(smem + 64 * PL_PITCH * 2);

    const int l15 = lane & 15, lg = lane >> 4;
    {
        bf16x8 bq[DK / 32];
#pragma unroll
        for (int ks = 0; ks < DK / 32; ++ks) bq[ks] = ldg_frag(Qn + (size_t)(w * 16 + l15) * LDQ + ks * 32 + 8 * lg);
#pragma unroll
        for (int jb = 0; jb < 4; ++jb) {
            f32x4 a = f32x4{0, 0, 0, 0};
            if (jb <= w) {
#pragma unroll
                for (int ks = 0; ks < DK / 32; ++ks) {
                    const bf16x8 ak = ldg_frag(Kn + (size_t)(jb * 16 + l15) * LDQ + ks * 32 + 8 * lg);
                    a = mfma16(ak, bq[ks], a);
                }
            }
            const int i = w * 16 + l15, j0 = jb * 16 + 4 * lg;
            const float v0 = (j0 + 0 <= i) ? a[0] : 0.f, v1 = (j0 + 1 <= i) ? a[1] : 0.f, v2 = (j0 + 2 <= i) ? a[2] : 0.f, v3 = (j0 + 3 <= i) ? a[3] : 0.f;
            uint2 o; o.x = pack2(v0, v1); o.y = pack2(v2, v3);
            *reinterpret_cast<uint2*>(PL + i * PL_PITCH + j0) = o;
        }
    }
    __syncthreads();
    f32x4 acc[2][4];
#pragma unroll
    for (int x = 0; x < 2; ++x)
#pragma unroll
        for (int y = 0; y < 4; ++y) acc[x][y] = f32x4{0, 0, 0, 0};
#pragma unroll
    for (int ks = 0; ks < 2; ++ks) {
        bf16x8 av[2], bp[4];
#pragma unroll
        for (int x = 0; x < 2; ++x) av[x] = ldg_frag(VT + (size_t)((2 * w + x) * 16 + l15) * 64 + ks * 32 + 8 * lg);
#pragma unroll
        for (int y = 0; y < 4; ++y) bp[y] = *reinterpret_cast<const bf16x8*>(PL + (y * 16 + l15) * PL_PITCH + ks * 32 + 8 * lg);
#pragma unroll
        for (int x = 0; x < 2; ++x)
#pragma unroll
            for (int y = 0; y < 4; ++y) acc[x][y] = mfma16(av[x], bp[y], acc[x][y]);
    }
#pragma unroll
    for (int ks = 0; ks < DK / 32; ++ks) {
        bf16x8 as[2], bq[4];
#pragma unroll
        for (int x = 0; x < 2; ++x) as[x] = ldg_frag(ST + (size_t)((2 * w + x) * 16 + l15) * DK + ks * 32 + 8 * lg);
#pragma unroll
        for (int y = 0; y < 4; ++y) bq[y] = ldg_frag(Qn + (size_t)(y * 16 + l15) * LDQ + ks * 32 + 8 * lg);
#pragma unroll
        for (int x = 0; x < 2; ++x)
#pragma unroll
            for (int y = 0; y < 4; ++y) acc[x][y] = mfma16(as[x], bq[y], acc[x][y]);
    }
    float ssq[4];
#pragma unroll
    for (int y = 0; y < 4; ++y) {
        float s = 0.f;
#pragma unroll
        for (int x = 0; x < 2; ++x)
#pragma unroll
            for (int r = 0; r < 4; ++r) s += acc[x][y][r] * acc[x][y][r];
        s += __shfl_xor(s, 16); s += __shfl_xor(s, 32);
        ssq[y] = s;
    }
    if (lg == 0) {
#pragma unroll
        for (int y = 0; y < 4; ++y) RED[w * 64 + y * 16 + l15] = ssq[y];
    }
    __syncthreads();
#pragma unroll
    for (int y = 0; y < 4; ++y) {
        const int i = y * 16 + l15;
        const float tot = RED[i] + RED[64 + i] + RED[128 + i] + RED[192 + i];
        const float rstd = rsqrtf(tot * (1.f / 128.f) + 1e-6f);
#pragma unroll
        for (int x = 0; x < 2; ++x) {
            const int dv = (2 * w + x) * 16 + 4 * lg;
            const float4 g4 = *reinterpret_cast<const float4*>(ng + dv);
            const uint2 gt = *reinterpret_cast<const uint2*>(GATE + (size_t)i * 512 + dv);
            uint2 o;
            o.x = pack2(acc[x][y][0] * rstd * g4.x * bflo(gt.x), acc[x][y][1] * rstd * g4.y * bfhi(gt.x));
            o.y = pack2(acc[x][y][2] * rstd * g4.z * bflo(gt.y), acc[x][y][3] * rstd * g4.w * bfhi(gt.y));
            *reinterpret_cast<uint2*>(MIX + (size_t)i * 1024 + dv) = o;
        }
    }
    __syncthreads();
}
DEVI void phase5_unit(const Params& p, int u, char* smem) {
    if (u < 2048) out_unit<128>(p, u >> 7, u & 127, smem); else { u -= 2048; out_unit<64>(p, u >> 7, u & 127, smem); }
}

constexpr int P6_UNITS = (M_TOK / 128) * 8;
DEVI void phase6_unit(const Params& p, int u, char* smem) {
    unsigned char* ws = p.ws;
    const int mt = u >> 3, nt = u & 7;
    const int m0 = mt * 128, n0 = nt * 128;
    f32x4 acc[4][4];
    gemm_tile<true>(reinterpret_cast<const bf16_t*>(ws + OFF_MIX), reinterpret_cast<const bf16_t*>(ws + OFF_WOUT), 1024, m0, n0, smem, acc);
    const int lane = threadIdx.x & 63, w = threadIdx.x >> 6, wm = w >> 1, wn = w & 1;
#pragma unroll
    for (int mi = 0; mi < 4; ++mi)
#pragma unroll
        for (int ni = 0; ni < 4; ++ni) {
            const int m = m0 + wm * 64 + mi * 16 + (lane & 15);
            const int n = n0 + wn * 64 + ni * 16 + 4 * (lane >> 4);
            const float4 xv = *reinterpret_cast<const float4*>(p.x + (size_t)m * DM + n);
            *reinterpret_cast<float4*>(p.out + (size_t)m * DM + n) = make_float4(xv.x + acc[mi][ni][0], xv.y + acc[mi][ni][1], xv.z + acc[mi][ni][2], xv.w + acc[mi][ni][3]);
        }
}

constexpr int P7_UNITS = 8192;
DEVI void phase7_unit(const Params& p, int u, char* smem) {
    const int lane = threadIdx.x & 63, w = threadIdx.x >> 6;
    const int row = u * 4 + w;
    rms_row_bf16(p.out + (size_t)row * DM, p.norm2_g, reinterpret_cast<bf16_t*>(p.ws + OFF_HN) + (size_t)row * DM, lane);
}

constexpr int P8_UNITS = (M_TOK / 128) * 16;
DEVI void phase8_unit(const Params& p, int u, char* smem) {
    unsigned char* ws = p.ws;
    const int mt = u >> 4, nt = u & 15;
    f32x4 acc[4][4];
    gemm_tile<true>(reinterpret_cast<const bf16_t*>(ws + OFF_HN), reinterpret_cast<const bf16_t*>(ws + OFF_WQ), 1024, mt * 128, nt * 128, smem, acc);
    store_sw_bf16(acc, reinterpret_cast<bf16_t*>(ws + OFF_Q), 2048, mt * 128, nt * 128, [](float v, int) { return v; });
}

constexpr int P9_UNITS = (M_TOK / 16) * 8;
DEVI void phase9_unit(const Params& p, int u, char* smem) {
    unsigned char* ws = p.ws;
    const int tid = threadIdx.x, lane = tid & 63, w = tid >> 6;
    const int tg = u >> 3, h = u & 7;
    const int m0 = tg * 16;
    float* S = reinterpret_cast<float*>(smem);
    float* TV = S + 2 * 16 * 128;
    int* TI = reinterpret_cast<int*>(TV + 2 * 16 * 16);
    const int l15 = lane & 15, lg = lane >> 4;
    {
        const int ph = w & 1, nh = w >> 1;
        const bf16_t* SK = reinterpret_cast<const bf16_t*>(ws + OFF_SK) + (size_t)((h * 2 + ph) * 128) * 128;
        const bf16_t* Q = reinterpret_cast<const bf16_t*>(ws + OFF_Q) + (size_t)m0 * 2048 + h * 256 + ph * 128;
        f32x4 acc[4];
#pragma unroll
        for (int i = 0; i < 4; ++i) acc[i] = f32x4{0, 0, 0, 0};
#pragma unroll
        for (int ks = 0; ks < 4; ++ks) {
            const bf16x8 bq = ldg_frag(Q + (size_t)l15 * 2048 + ks * 32 + 8 * lg);
#pragma unroll
            for (int nb = 0; nb < 4; ++nb) {
                const bf16x8 ak = ldg_frag(SK + (size_t)((nh * 4 + nb) * 16 + l15) * 128 + ks * 32 + 8 * lg);
                acc[nb] = mfma16(ak, bq, acc[nb]);
            }
        }
#pragma unroll
        for (int nb = 0; nb < 4; ++nb) {
            const int n = (nh * 4 + nb) * 16 + 4 * lg;
            *reinterpret_cast<float4*>(S + (ph * 16 + l15) * 128 + n) = make_float4(acc[nb][0], acc[nb][1], acc[nb][2], acc[nb][3]);
        }
    }
    __syncthreads();
    for (int li = 0; li < 8; ++li) {
        const int L = w * 8 + li;
        float v0 = S[L * 128 + lane], v1 = S[L * 128 + 64 + lane];
        float myv = 0.f; int myi = 0;
        for (int k = 0; k < 16; ++k) {
            const float mx = wave_max(fmaxf(v0, v1));
            const unsigned long long b0 = __ballot(v0 == mx);
            int idx;
            if (b0) { idx = __ffsll((long long)b0) - 1; if (lane == idx) v0 = -INFINITY; }
            else { const unsigned long long b1 = __ballot(v1 == mx); idx = __ffsll((long long)b1) - 1; if (lane == idx) v1 = -INFINITY; idx += 64; }
            if (lane == k) { myv = mx; myi = idx; }
        }
        if (lane < 16) { TV[L * 16 + lane] = myv; TI[L * 16 + lane] = myi; }
    }
    __syncthreads();
    for (int ti = 0; ti < 4; ++ti) {
        const int t = w * 4 + ti;
        const float sa = TV[t * 16 + (lane >> 2)];
        float cv[4];
#pragma unroll
        for (int q = 0; q < 4; ++q) cv[q] = sa + TV[(16 + t) * 16 + (lane & 3) * 4 + q];
        float myv = 0.f; int myc = 0;
        for (int k = 0; k < 16; ++k) {
            const float mx = wave_max(fmaxf(fmaxf(cv[0], cv[1]), fmaxf(cv[2], cv[3])));
            int best = 1 << 20;
#pragma unroll
            for (int q = 0; q < 4; ++q) {
                const unsigned long long bq = __ballot(cv[q] == mx);
                if (bq) { const int cand = (__ffsll((long long)bq) - 1) * 4 + q; best = cand < best ? cand : best; }
            }
            const int bl = best >> 2, bqi = best & 3;
            if (lane == bl) {
#pragma unroll
                for (int q = 0; q < 4; ++q) if (q == bqi) cv[q] = -INFINITY;
            }
            if (lane == k) { myv = mx; myc = best; }
        }
        const float top = __shfl(myv, 0);
        float e = (lane < 16) ? __expf(myv - top) : 0.f;
        const float sum = wave_sum(e);
        if (lane < 16) {
            const int a = myc >> 4, bb = myc & 15;
            const int ex = TI[t * 16 + a] * 128 + TI[(16 + t) * 16 + bb];
            reinterpret_cast<int*>(ws + OFF_EIDX)[(size_t)(m0 + t) * 128 + h * 16 + lane] = ex;
            reinterpret_cast<float*>(ws + OFF_EW)[(size_t)(m0 + t) * 128 + h * 16 + lane] = e / sum;
        }
    }
    __syncthreads();
}

constexpr int P10_UNITS = 8192;
DEVI void phase10_unit(const Params& p, int u, char* smem) {
    unsigned char* ws = p.ws;
    const int lane = threadIdx.x & 63, w = threadIdx.x >> 6;
    const int m = u * 4 + w;
    const bf16_t* HN = reinterpret_cast<const bf16_t*>(ws + OFF_HN) + (size_t)m * DM;
    const bf16_t* UB = reinterpret_cast<const bf16_t*>(ws + OFF_UB);
    const bf16_t* VB = reinterpret_cast<const bf16_t*>(ws + OFF_VB);
    const int* EI = reinterpret_cast<const int*>(ws + OFF_EIDX) + (size_t)m * 128;
    const float* EW = reinterpret_cast<const float*>(ws + OFF_EW) + (size_t)m * 128;
    float hn[16];
    {
        const uint4 a = *reinterpret_cast<const uint4*>(HN + 8 * lane), b = *reinterpret_cast<const uint4*>(HN + 512 + 8 * lane);
        hn[0] = bflo(a.x); hn[1] = bfhi(a.x); hn[2] = bflo(a.y); hn[3] = bfhi(a.y); hn[4] = bflo(a.z); hn[5] = bfhi(a.z); hn[6] = bflo(a.w); hn[7] = bfhi(a.w);
        hn[8] = bflo(b.x); hn[9] = bfhi(b.x); hn[10] = bflo(b.y); hn[11] = bfhi(b.y); hn[12] = bflo(b.z); hn[13] = bfhi(b.z); hn[14] = bflo(b.w); hn[15] = bfhi(b.w);
    }
    const int e0 = EI[lane], e1 = EI[64 + lane];
    const float g0 = EW[lane], g1 = EW[64 + lane];
    float acc[16];
#pragma unroll
    for (int i = 0; i < 16; ++i) acc[i] = 0.f;
#pragma unroll 1
    for (int half = 0; half < 2; ++half) {
        const int ev = half ? e1 : e0; const float gv = half ? g1 : g0;
#pragma unroll 4
        for (int k = 0; k < 64; ++k) {
            const int e = __shfl(ev, k);
            const float g = __shfl(gv, k);
            const bf16_t* ur = UB + (size_t)e * DM;
            const uint4 a = *reinterpret_cast<const uint4*>(ur + 8 * lane), b = *reinterpret_cast<const uint4*>(ur + 512 + 8 * lane);
            float d = bflo(a.x) * hn[0] + bfhi(a.x) * hn[1] + bflo(a.y) * hn[2] + bfhi(a.y) * hn[3] + bflo(a.z) * hn[4] + bfhi(a.z) * hn[5] + bflo(a.w) * hn[6] + bfhi(a.w) * hn[7]
                    + bflo(b.x) * hn[8] + bfhi(b.x) * hn[9] + bflo(b.y) * hn[10] + bfhi(b.y) * hn[11] + bflo(b.z) * hn[12] + bfhi(b.z) * hn[13] + bflo(b.w) * hn[14] + bfhi(b.w) * hn[15];
            d = wave_sum(d);
            const float act = 0.5f * d * (1.f + erff(d * 0.70710678118654752f));
            const float wk = g * act;
            const bf16_t* vr = VB + (size_t)e * DM;
            const uint4 c = *reinterpret_cast<const uint4*>(vr + 8 * lane), dd = *reinterpret_cast<const uint4*>(vr + 512 + 8 * lane);
            acc[0] += wk * bflo(c.x); acc[1] += wk * bfhi(c.x); acc[2] += wk * bflo(c.y); acc[3] += wk * bfhi(c.y);
            acc[4] += wk * bflo(c.z); acc[5] += wk * bfhi(c.z); acc[6] += wk * bflo(c.w); acc[7] += wk * bfhi(c.w);
            acc[8] += wk * bflo(dd.x); acc[9] += wk * bfhi(dd.x); acc[10] += wk * bflo(dd.y); acc[11] += wk * bfhi(dd.y);
            acc[12] += wk * bflo(dd.z); acc[13] += wk * bfhi(dd.z); acc[14] += wk * bflo(dd.w); acc[15] += wk * bfhi(dd.w);
        }
    }
    float* orow = p.out + (size_t)m * DM;
    float4 hv[4];
    hv[0] = *reinterpret_cast<const float4*>(orow + 8 * lane); hv[1] = *reinterpret_cast<const float4*>(orow + 8 * lane + 4);
    hv[2] = *reinterpret_cast<const float4*>(orow + 512 + 8 * lane); hv[3] = *reinterpret_cast<const float4*>(orow + 512 + 8 * lane + 4);
    float o[16];
#pragma unroll
    for (int i = 0; i < 4; ++i) { o[4 * i] = hv[i].x + acc[4 * i]; o[4 * i + 1] = hv[i].y + acc[4 * i + 1]; o[4 * i + 2] = hv[i].z + acc[4 * i + 2]; o[4 * i + 3] = hv[i].w + acc[4 * i + 3]; }
    float ss = 0.f;
#pragma unroll
    for (int i = 0; i < 16; ++i) ss += o[i] * o[i];
    ss = wave_sum(ss);
    const float r = rsqrtf(ss * (1.f / 1024.f) + 1e-6f);
    const float* gf = p.norm_f_g;
    const float4 ga = *reinterpret_cast<const float4*>(gf + 8 * lane), gb = *reinterpret_cast<const float4*>(gf + 8 * lane + 4);
    const float4 gc = *reinterpret_cast<const float4*>(gf + 512 + 8 * lane), gd = *reinterpret_cast<const float4*>(gf + 512 + 8 * lane + 4);
    *reinterpret_cast<float4*>(orow + 8 * lane) = make_float4(o[0] * r * ga.x, o[1] * r * ga.y, o[2] * r * ga.z, o[3] * r * ga.w);
    *reinterpret_cast<float4*>(orow + 8 * lane + 4) = make_float4(o[4] * r * gb.x, o[5] * r * gb.y, o[6] * r * gb.z, o[7] * r * gb.w);
    *reinterpret_cast<float4*>(orow + 512 + 8 * lane) = make_float4(o[8] * r * gc.x, o[9] * r * gc.y, o[10] * r * gc.z, o[11] * r * gc.w);
    *reinterpret_cast<float4*>(orow + 512 + 8 * lane + 4) = make_float4(o[12] * r * gd.x, o[13] * r * gd.y, o[14] * r * gd.z, o[15] * r * gd.w);
}

constexpr int N_PHASES = 11;
constexpr int LDS_BYTES = 65536;

__global__ void __launch_bounds__(256, 2) hymba_fwd(Params p) {
    extern __shared__ __attribute__((aligned(16))) char smem[];
    cg::grid_group grid = cg::this_grid();
    const int lo = p.ph_lo, hi = p.ph_hi;
#define RUN_PHASE(K, FN, N) if (lo <= (K) && (K) < hi) { if ((K) > lo) grid.sync(); for (int u = blockIdx.x; u < (N); u += gridDim.x) FN(p, u, smem); }
    RUN_PHASE(0, phase0_unit, P0_UNITS)
    RUN_PHASE(1, phase1_unit, P1_UNITS)
    RUN_PHASE(2, phase2_unit, P2_UNITS)
    RUN_PHASE(3, phase3_unit, P3_UNITS)
    RUN_PHASE(4, phase4_unit, P4_UNITS)
    RUN_PHASE(5, phase5_unit, P5_UNITS)
    RUN_PHASE(6, phase6_unit, P6_UNITS)
    RUN_PHASE(7, phase7_unit, P7_UNITS)
    RUN_PHASE(8, phase8_unit, P8_UNITS)
    RUN_PHASE(9, phase9_unit, P9_UNITS)
    RUN_PHASE(10, phase10_unit, P10_UNITS)
#undef RUN_PHASE
}

extern "C" void kernel_launch(void* const* d_in, const int* in_sizes, int n_in, void* d_out, int out_size, void* d_ws, size_t ws_size, hipStream_t stream) {
    static int grid_blocks = 0;
    if (grid_blocks == 0) {
        if (n_in != 15 || in_sizes[0] != M_TOK * DM || out_size != M_TOK * DM || ws_size < WS_NEED) {
            fprintf(stderr, "kernel_launch: unexpected shapes (n_in %d, in0 %d, out %d, ws %zu)\n", n_in, n_in > 0 ? in_sizes[0] : -1, out_size, ws_size);
            grid_blocks = -1; return;
        }
        int dev = 0, cus = 0, per_cu = 0;
        (void)hipGetDevice(&dev);
        (void)hipDeviceGetAttribute(&cus, hipDeviceAttributeMultiprocessorCount, dev);
        (void)hipFuncSetAttribute((const void*)hymba_fwd, hipFuncAttributeMaxDynamicSharedMemorySize, LDS_BYTES);
        (void)hipOccupancyMaxActiveBlocksPerMultiprocessor(&per_cu, (const void*)hymba_fwd, 256, LDS_BYTES);
        if (per_cu < 1) per_cu = 1;
        if (per_cu > 2) per_cu = 2;
        grid_blocks = cus * per_cu;
    }
    if (grid_blocks < 0) return;
    Params p{};
    p.x = (const float*)d_in[0]; p.norm1_g = (const float*)d_in[1]; p.w_in = (const float*)d_in[2]; p.hg_lower = (const float*)d_in[3];
    p.hg_norm_g = (const float*)d_in[4]; p.gla_wg = (const float*)d_in[5]; p.gla_bg = (const float*)d_in[6]; p.gla_norm_g = (const float*)d_in[7];
    p.w_out = (const float*)d_in[8]; p.norm2_g = (const float*)d_in[9]; p.w_q = (const float*)d_in[10]; p.sub_keys = (const float*)d_in[11];
    p.peer_u = (const float*)d_in[12]; p.peer_v = (const float*)d_in[13]; p.norm_f_g = (const float*)d_in[14];
    p.out = (float*)d_out; p.ws = (unsigned char*)d_ws;
#if N_LAUNCH_MODE == 1
    p.ph_lo = 0; p.ph_hi = N_PHASES;
    void* args[] = {&p};
    hipError_t e = hipLaunchCooperativeKernel((const void*)hymba_fwd, dim3(grid_blocks), dim3(256), args, LDS_BYTES, stream);
    if (e != hipSuccess) fprintf(stderr, "cooperative launch failed: %s (grid %d)\n", hipGetErrorString(e), grid_blocks);
#else
    for (int ph = 0; ph < N_PHASES; ++ph) {
        p.ph_lo = ph; p.ph_hi = ph + 1;
        hipLaunchKernelGGL(hymba_fwd, dim3(grid_blocks), dim3(256), LDS_BYTES, stream, p);
    }
#endif
}
```

```cpp
#include <hip/hip_runtime.h>
#include <hip/hip_cooperative_groups.h>
#include <cstdio>
#include <cstdint>
namespace cg = cooperative_groups;

#ifndef N_LAUNCH_MODE
#define N_LAUNCH_MODE 1
#endif

#define DEVI __device__ __forceinline__
typedef unsigned short bf16_t;
using bf16x8 = __attribute__((ext_vector_type(8))) short;
using f32x4 = __attribute__((ext_vector_type(4))) float;

constexpr int M_TOK = 32768;
constexpr int DM = 1024;
constexpr int IN_WP = 3712;
constexpr size_t MiB = 1024ull * 1024ull;

constexpr size_t OFF_XN   = 0;
constexpr size_t OFF_WIN  = 64 * MiB;
constexpr size_t OFF_WOUT = 72 * MiB;
constexpr size_t OFF_WQ   = 74 * MiB;
constexpr size_t OFF_SK   = 78 * MiB;
constexpr size_t OFF_LB   = 79 * MiB;
constexpr size_t OFF_UB   = 80 * MiB;
constexpr size_t OFF_VB   = 112 * MiB;
constexpr size_t OFF_R2   = 144 * MiB;
constexpr size_t OFF_HQ   = OFF_R2;
constexpr size_t OFF_HLF  = OFF_R2 + 32 * MiB;
constexpr size_t OFF_HVT  = OFF_R2 + 64 * MiB;
constexpr size_t OFF_HG   = OFF_R2 + 96 * MiB;
constexpr size_t OFF_GQ   = OFF_R2 + 128 * MiB;
constexpr size_t OFF_GK   = OFF_R2 + 144 * MiB;
constexpr size_t OFF_GVT  = OFF_R2 + 160 * MiB;
constexpr size_t OFF_GG   = OFF_R2 + 192 * MiB;
constexpr size_t OFF_GLOW = OFF_R2 + 224 * MiB;
constexpr size_t OFF_KTH  = 370 * MiB;
constexpr size_t OFF_KTG  = 402 * MiB;
constexpr size_t OFF_DECH = 418 * MiB;
constexpr size_t OFF_DECG = 419 * MiB;
constexpr size_t WS_NEED  = 420 * MiB;
constexpr size_t OFF_MIX  = OFF_XN;
constexpr size_t OFF_HN   = OFF_R2;
constexpr size_t OFF_Q    = OFF_R2 + 64 * MiB;
constexpr size_t OFF_EIDX = OFF_KTH;
constexpr size_t OFF_EW   = OFF_KTH + 16 * MiB;
constexpr size_t OUT_STH = 0;
constexpr size_t OUT_STG = 64 * MiB;

struct Params {
    const float* x; const float* norm1_g; const float* w_in; const float* hg_lower; const float* hg_norm_g;
    const float* gla_wg; const float* gla_bg; const float* gla_norm_g; const float* w_out; const float* norm2_g;
    const float* w_q; const float* sub_keys; const float* peer_u; const float* peer_v; const float* norm_f_g;
    float* out; unsigned char* ws;
    int ph_lo, ph_hi;
};

DEVI unsigned short f2bf(float f) {
    unsigned u = __float_as_uint(f);
    u += 0x7fffu + ((u >> 16) & 1u);
    return (unsigned short)(u >> 16);
}
DEVI float bf2f(unsigned short b) { return __uint_as_float(((unsigned)b) << 16); }
DEVI unsigned pack2(float a, float b) { return (unsigned)f2bf(a) | ((unsigned)f2bf(b) << 16); }
DEVI float bflo(unsigned u) { return __uint_as_float(u << 16); }
DEVI float bfhi(unsigned u) { return __uint_as_float(u & 0xffff0000u); }
DEVI float wave_sum(float v) {
#pragma unroll
    for (int o = 32; o > 0; o >>= 1) v += __shfl_xor(v, o);
    return v;
}
DEVI float wave_max(float v) {
#pragma unroll
    for (int o = 32; o > 0; o >>= 1) v = fmaxf(v, __shfl_xor(v, o));
    return v;
}
DEVI float silu_f(float x) { return x / (1.f + __expf(-x)); }
DEVI f32x4 mfma16(bf16x8 a, bf16x8 b, f32x4 c) { return __builtin_amdgcn_mfma_f32_16x16x32_bf16(a, b, c, 0, 0, 0); }
DEVI bf16x8 ldg_frag(const bf16_t* p) { return *reinterpret_cast<const bf16x8*>(p); }

DEVI void rms_row_bf16(const float* __restrict__ xr, const float* __restrict__ g, bf16_t* __restrict__ dst, int lane) {
    float4 v[4]; float ss = 0.f;
#pragma unroll
    for (int i = 0; i < 4; ++i) { v[i] = reinterpret_cast<const float4*>(xr)[lane + 64 * i]; ss += v[i].x * v[i].x + v[i].y * v[i].y + v[i].z * v[i].z + v[i].w * v[i].w; }
    ss = wave_sum(ss);
    const float r = rsqrtf(ss * (1.f / 1024.f) + 1e-6f);
#pragma unroll
    for (int i = 0; i < 4; ++i) {
        const float4 gg = reinterpret_cast<const float4*>(g)[lane + 64 * i];
        uint2 o; o.x = pack2(v[i].x * r * gg.x, v[i].y * r * gg.y); o.y = pack2(v[i].z * r * gg.z, v[i].w * r * gg.w);
        reinterpret_cast<uint2*>(dst)[lane + 64 * i] = o;
    }
}

DEVI void transpose_tile(const float* __restrict__ src, int Nsrc, bf16_t* __restrict__ dst, int nt, int kt, int mode, float* lds) {
    const int tid = threadIdx.x, tx = tid & 63, ty = tid >> 6;
    const int np = nt * 64 + tx;
    int col = np; bool valid = true;
    if (mode == 1) {
        if (np < 3072) col = np; else if (np < 3584) col = np + 16; else if (np < 3600) col = np - 512; else { valid = false; col = 0; }
    }
#pragma unroll 4
    for (int kk = ty; kk < 64; kk += 4) {
        lds[kk * 65 + tx] = valid ? src[(size_t)(kt * 64 + kk) * Nsrc + col] : 0.f;
    }
    __syncthreads();
    const int nl = tid >> 2, kq = tid & 3;
    unsigned pk[8];
#pragma unroll
    for (int i = 0; i < 8; ++i) pk[i] = pack2(lds[(kq * 16 + 2 * i) * 65 + nl], lds[(kq * 16 + 2 * i + 1) * 65 + nl]);
    uint4* d = reinterpret_cast<uint4*>(dst + (size_t)(nt * 64 + nl) * 1024 + kt * 64 + kq * 16);
    d[0] = make_uint4(pk[0], pk[1], pk[2], pk[3]);
    d[1] = make_uint4(pk[4], pk[5], pk[6], pk[7]);
    __syncthreads();
}

DEVI void convert8(const float* __restrict__ src, bf16_t* __restrict__ dst, size_t idx8) {
    const float4 a = reinterpret_cast<const float4*>(src)[idx8 * 2], b = reinterpret_cast<const float4*>(src)[idx8 * 2 + 1];
    reinterpret_cast<uint4*>(dst)[idx8] = make_uint4(pack2(a.x, a.y), pack2(a.z, a.w), pack2(b.x, b.y), pack2(b.z, b.w));
}

constexpr int P0_XN = 8192, P0_WIN = 58 * 16, P0_WOUT = 16 * 16, P0_WQ = 32 * 16, P0_UV = 16384, P0_SK = 128, P0_LB = 1;
constexpr int P0_UNITS = P0_XN + P0_WIN + P0_WOUT + P0_WQ + P0_UV + P0_SK + P0_LB;

DEVI void phase0_unit(const Params& p, int u, char* smem) {
    const int tid = threadIdx.x, lane = tid & 63, w = tid >> 6;
    unsigned char* ws = p.ws;
    if (u < P0_XN) {
        const int row = u * 4 + w;
        rms_row_bf16(p.x + (size_t)row * DM, p.norm1_g, reinterpret_cast<bf16_t*>(ws + OFF_XN) + (size_t)row * DM, lane);
        return;
    }
    u -= P0_XN;
    if (u < P0_WIN) { transpose_tile(p.w_in, 3600, reinterpret_cast<bf16_t*>(ws + OFF_WIN), u / 16, u % 16, 1, reinterpret_cast<float*>(smem)); return; }
    u -= P0_WIN;
    if (u < P0_WOUT) { transpose_tile(p.w_out, 1024, reinterpret_cast<bf16_t*>(ws + OFF_WOUT), u / 16, u % 16, 0, reinterpret_cast<float*>(smem)); return; }
    u -= P0_WOUT;
    if (u < P0_WQ) { transpose_tile(p.w_q, 2048, reinterpret_cast<bf16_t*>(ws + OFF_WQ), u / 16, u % 16, 0, reinterpret_cast<float*>(smem)); return; }
    u -= P0_WQ;
    if (u < P0_UV) {
        const bool isv = u >= 8192; const int uu = isv ? u - 8192 : u;
        convert8(isv ? p.peer_v : p.peer_u, reinterpret_cast<bf16_t*>(ws + (isv ? OFF_VB : OFF_UB)), (size_t)uu * 256 + tid);
        return;
    }
    u -= P0_UV;
    if (u < P0_SK) { convert8(p.sub_keys, reinterpret_cast<bf16_t*>(ws + OFF_SK), (size_t)u * 256 + tid); return; }
    float* lb = reinterpret_cast<float*>(ws + OFF_LB);
    for (int n = tid; n < 512; n += 256) {
        const float l0 = p.hg_lower[n], l1 = p.hg_lower[512 + n];
        const float mx = fmaxf(l0, l1); const float e0 = __expf(l0 - mx), e1 = __expf(l1 - mx);
        lb[n] = e0 / (e0 + e1);
    }
}

template <bool SW>
DEVI void gemm_tile(const bf16_t* __restrict__ A, const bf16_t* __restrict__ Bt, int K, int m0, int n0, char* smem, f32x4 (&acc)[4][4]) {
    const int tid = threadIdx.x, lane = tid & 63, w = tid >> 6, wm = w >> 1, wn = w & 1;
#pragma unroll
    for (int i = 0; i < 4; ++i)
#pragma unroll
        for (int j = 0; j < 4; ++j) acc[i][j] = f32x4{0.f, 0.f, 0.f, 0.f};
    const int lrow = tid >> 3, lch = tid & 7;
    const bf16_t* ga = A + (size_t)(m0 + lrow) * K + lch * 8;
    const bf16_t* gb = Bt + (size_t)(n0 + lrow) * K + lch * 8;
    const int lds_off = lrow * 128 + ((lch ^ (lrow & 7)) << 4);
    const int fr_base = (lane & 15) * 128;
    const int xo0 = (((lane >> 4)) ^ (lane & 7)) << 4;
    const int xo1 = ((4 + (lane >> 4)) ^ (lane & 7)) << 4;
    uint4 ra[4], rb[4];
    const int nk = K >> 6;
#pragma unroll
    for (int i = 0; i < 4; ++i) { ra[i] = *reinterpret_cast<const uint4*>(ga + (size_t)i * 32 * K); rb[i] = *reinterpret_cast<const uint4*>(gb + (size_t)i * 32 * K); }
#pragma unroll
    for (int i = 0; i < 4; ++i) { *reinterpret_cast<uint4*>(smem + lds_off + i * 4096) = ra[i]; *reinterpret_cast<uint4*>(smem + 16384 + lds_off + i * 4096) = rb[i]; }
    __syncthreads();
    for (int kt = 0; kt < nk; ++kt) {
        const char* sA = smem + (kt & 1) * 32768;
        const char* sB = sA + 16384;
        if (kt + 1 < nk) {
#pragma unroll
            for (int i = 0; i < 4; ++i) { ra[i] = *reinterpret_cast<const uint4*>(ga + (size_t)i * 32 * K + (kt + 1) * 64); rb[i] = *reinterpret_cast<const uint4*>(gb + (size_t)i * 32 * K + (kt + 1) * 64); }
        }
#pragma unroll
        for (int ks = 0; ks < 2; ++ks) {
            const int xo = ks ? xo1 : xo0;
            bf16x8 af[4], bfr[4];
#pragma unroll
            for (int i = 0; i < 4; ++i) {
                af[i] = *reinterpret_cast<const bf16x8*>(sA + (wm * 64 + i * 16) * 128 + fr_base + xo);
                bfr[i] = *reinterpret_cast<const bf16x8*>(sB + (wn * 64 + i * 16) * 128 + fr_base + xo);
            }
#pragma unroll
            for (int i = 0; i < 4; ++i)
#pragma unroll
                for (int j = 0; j < 4; ++j) acc[i][j] = SW ? mfma16(bfr[j], af[i], acc[i][j]) : mfma16(af[i], bfr[j], acc[i][j]);
        }
        if (kt + 1 < nk) {
            char* dA = smem + ((kt + 1) & 1) * 32768;
#pragma unroll
            for (int i = 0; i < 4; ++i) { *reinterpret_cast<uint4*>(dA + lds_off + i * 4096) = ra[i]; *reinterpret_cast<uint4*>(dA + 16384 + lds_off + i * 4096) = rb[i]; }
        }
        __syncthreads();
    }
}

constexpr int P1_NT = IN_WP / 128;
constexpr int P1_UNITS = (M_TOK / 128) * P1_NT;

template <typename F>
DEVI void store_sw_bf16(const f32x4 (&acc)[4][4], bf16_t* dst, int ld, int m0, int ncol0, F f) {
    const int lane = threadIdx.x & 63, w = threadIdx.x >> 6, wm = w >> 1, wn = w & 1;
#pragma unroll
    for (int mi = 0; mi < 4; ++mi)
#pragma unroll
        for (int ni = 0; ni < 4; ++ni) {
            const int m = m0 + wm * 64 + mi * 16 + (lane & 15);
            const int n = ncol0 + wn * 64 + ni * 16 + 4 * (lane >> 4);
            uint2 o; o.x = pack2(f(acc[mi][ni][0], n), f(acc[mi][ni][1], n + 1)); o.y = pack2(f(acc[mi][ni][2], n + 2), f(acc[mi][ni][3], n + 3));
            *reinterpret_cast<uint2*>(dst + (size_t)m * ld + n) = o;
        }
}
DEVI void store_ns_T(const f32x4 (&acc)[4][4], bf16_t* dst, int ncols, int m0, int ncol0) {
    const int lane = threadIdx.x & 63, w = threadIdx.x >> 6, wm = w >> 1, wn = w & 1;
#pragma unroll
    for (int mi = 0; mi < 4; ++mi)
#pragma unroll
        for (int ni = 0; ni < 4; ++ni) {
            const int m = m0 + wm * 64 + mi * 16 + 4 * (lane >> 4);
            const int n = ncol0 + wn * 64 + ni * 16 + (lane & 15);
            uint2 o; o.x = pack2(acc[mi][ni][0], acc[mi][ni][1]); o.y = pack2(acc[mi][ni][2], acc[mi][ni][3]);
            *reinterpret_cast<uint2*>(dst + ((size_t)(m >> 6) * ncols + n) * 64 + (m & 63)) = o;
        }
}

DEVI void phase1_unit(const Params& p, int u, char* smem) {
    unsigned char* ws = p.ws;
    const int mt = u / P1_NT, nt = u % P1_NT;
    const int m0 = mt * 128, n0 = nt * 128;
    const bf16_t* A = reinterpret_cast<const bf16_t*>(ws + OFF_XN);
    const bf16_t* Bt = reinterpret_cast<const bf16_t*>(ws + OFF_WIN);
    f32x4 acc[4][4];
    const bool ns = (n0 >= 1024 && n0 < 1536) || (n0 >= 2560 && n0 < 3072);
    if (ns) {
        gemm_tile<false>(A, Bt, 1024, m0, n0, smem, acc);
        if (n0 < 1536) store_ns_T(acc, reinterpret_cast<bf16_t*>(ws + OFF_HVT), 512, m0, n0 - 1024);
        else store_ns_T(acc, reinterpret_cast<bf16_t*>(ws + OFF_GVT), 512, m0, n0 - 2560);
        return;
    }
    gemm_tile<true>(A, Bt, 1024, m0, n0, smem, acc);
    if (n0 < 512) {
        store_sw_bf16(acc, reinterpret_cast<bf16_t*>(ws + OFF_HQ), 512, m0, n0, [](float v, int) { return silu_f(v); });
    } else if (n0 < 1024) {
        const float* lb = reinterpret_cast<const float*>(ws + OFF_LB);
        store_sw_bf16(acc, reinterpret_cast<bf16_t*>(ws + OFF_HLF), 512, m0, n0 - 512, [lb](float v, int n) {
            const float l = lb[n]; const float fg = l + (1.f - l) / (1.f + __expf(-v)); return __logf(fg); });
    } else if (n0 < 2048) {
        store_sw_bf16(acc, reinterpret_cast<bf16_t*>(ws + OFF_HG), 512, m0, n0 - 1536, [](float v, int) { return silu_f(v); });
    } else if (n0 < 2304) {
        store_sw_bf16(acc, reinterpret_cast<bf16_t*>(ws + OFF_GQ), 256, m0, n0 - 2048, [](float v, int) { return v * 0.125f; });
    } else if (n0 < 2560) {
        store_sw_bf16(acc, reinterpret_cast<bf16_t*>(ws + OFF_GK), 256, m0, n0 - 2304, [](float v, int) { return v; });
    } else if (n0 < 3584) {
        store_sw_bf16(acc, reinterpret_cast<bf16_t*>(ws + OFF_GG), 512, m0, n0 - 3072, [](float v, int) { return silu_f(v); });
    } else {
        const int lane = threadIdx.x & 63, w = threadIdx.x >> 6, wm = w >> 1, wn = w & 1;
        if (wn == 0) {
            float* gl = reinterpret_cast<float*>(ws + OFF_GLOW);
#pragma unroll
            for (int mi = 0; mi < 4; ++mi) {
                const int m = m0 + wm * 64 + mi * 16 + (lane & 15);
                const int n = 4 * (lane >> 4);
                *reinterpret_cast<float4*>(gl + (size_t)m * 16 + n) = make_float4(acc[mi][0][0], acc[mi][0][1], acc[mi][0][2], acc[mi][0][3]);
            }
        }
    }
}

constexpr int P2_UNITS = 512 * 3;
DEVI float logsigmoid_f(float z) { return fminf(z, 0.f) - __logf(1.f + __expf(-fabsf(z))); }

DEVI void phase2_unit(const Params& p, int u, char* smem) {
    unsigned char* ws = p.ws;
    const int tid = threadIdx.x;
    const int cidx = u / 3, part = u % 3;
    const size_t row0 = (size_t)cidx * 64;
    if (part < 2) {
        const int n = part * 256 + tid;
        bf16_t* HQ = reinterpret_cast<bf16_t*>(ws + OFF_HQ);
        bf16_t* HLF = reinterpret_cast<bf16_t*>(ws + OFF_HLF);
        bf16_t* KT = reinterpret_cast<bf16_t*>(ws + OFF_KTH);
        float Gl = 0.f;
#pragma unroll 8
        for (int r = 0; r < 64; ++r) Gl += bf2f(HLF[(row0 + r) * 512 + n]);
        float G = 0.f;
        for (int r8 = 0; r8 < 8; ++r8) {
            unsigned pk[4];
#pragma unroll
            for (int rr = 0; rr < 8; ++rr) {
                const size_t idx = (row0 + r8 * 8 + rr) * 512 + n;
                const float lf = bf2f(HLF[idx]);
                G += lf;
                const float key = 1.f - __expf(lf);
                const float q = bf2f(HQ[idx]);
                const unsigned short bq = f2bf(q * __expf(G));
                const unsigned short bk = f2bf(key * __expf(-G));
                HQ[idx] = bq; HLF[idx] = bk;
                if (rr & 1) pk[rr >> 1] |= ((unsigned)bk << 16); else pk[rr >> 1] = bk;
            }
            *reinterpret_cast<uint4*>(KT + ((size_t)cidx * 512 + n) * 64 + r8 * 8) = make_uint4(pk[0], pk[1], pk[2], pk[3]);
        }
        reinterpret_cast<float*>(ws + OFF_DECH)[(size_t)cidx * 512 + n] = __expf(Gl);
    } else {
        const int n = tid;
        bf16_t* GQ = reinterpret_cast<bf16_t*>(ws + OFF_GQ);
        bf16_t* GK = reinterpret_cast<bf16_t*>(ws + OFF_GK);
        bf16_t* KT = reinterpret_cast<bf16_t*>(ws + OFF_KTG);
        const float* GL = reinterpret_cast<const float*>(ws + OFF_GLOW);
        float wg[16];
#pragma unroll
        for (int j = 0; j < 16; ++j) wg[j] = p.gla_wg[j * 256 + n];
        const float bg = p.gla_bg[n];
        float Gl = 0.f;
        for (int r = 0; r < 64; ++r) {
            const float4* g4 = reinterpret_cast<const float4*>(GL + (row0 + r) * 16);
            float z = bg;
#pragma unroll
            for (int j = 0; j < 4; ++j) { const float4 t = g4[j]; z += t.x * wg[4 * j] + t.y * wg[4 * j + 1] + t.z * wg[4 * j + 2] + t.w * wg[4 * j + 3]; }
            Gl += logsigmoid_f(z) * (1.f / 16.f);
        }
        float G = 0.f;
        for (int r8 = 0; r8 < 8; ++r8) {
            unsigned pk[4];
#pragma unroll
            for (int rr = 0; rr < 8; ++rr) {
                const size_t row = row0 + r8 * 8 + rr;
                const float4* g4 = reinterpret_cast<const float4*>(GL + row * 16);
                float z = bg;
#pragma unroll
                for (int j = 0; j < 4; ++j) { const float4 t = g4[j]; z += t.x * wg[4 * j] + t.y * wg[4 * j + 1] + t.z * wg[4 * j + 2] + t.w * wg[4 * j + 3]; }
                G += logsigmoid_f(z) * (1.f / 16.f);
                const size_t idx = row * 256 + n;
                const unsigned short bq = f2bf(bf2f(GQ[idx]) * __expf(G));
                const unsigned short bk = f2bf(bf2f(GK[idx]) * __expf(-G));
                GQ[idx] = bq; GK[idx] = bk;
                if (rr & 1) pk[rr >> 1] |= ((unsigned)bk << 16); else pk[rr >> 1] = bk;
            }
            *reinterpret_cast<uint4*>(KT + ((size_t)cidx * 256 + n) * 64 + r8 * 8) = make_uint4(pk[0], pk[1], pk[2], pk[3]);
        }
        reinterpret_cast<float*>(ws + OFF_DECG)[(size_t)cidx * 256 + n] = __expf(Gl);
    }
}

constexpr int P3_UNITS = 4096;
template <int DK>
DEVI void kv_unit(const Params& p, int sidx, int c) {
    unsigned char* ws = p.ws;
    const int lane = threadIdx.x & 63, w = threadIdx.x >> 6;
    const int b = sidx >> 2, h = sidx & 3;
    const int cidx = b * 128 + c;
    constexpr int NDB = DK / 16;
    const bf16_t* KT = reinterpret_cast<const bf16_t*>(ws + (DK == 128 ? OFF_KTH : OFF_KTG)) + ((size_t)cidx * (4 * DK) + h * DK) * 64;
    const bf16_t* VT = reinterpret_cast<const bf16_t*>(ws + (DK == 128 ? OFF_HVT : OFF_GVT)) + ((size_t)cidx * 512 + h * 128) * 64;
    const float* DEC = reinterpret_cast<const float*>(ws + (DK == 128 ? OFF_DECH : OFF_DECG)) + (size_t)cidx * (4 * DK) + h * DK;
    bf16_t* ST = reinterpret_cast<bf16_t*>(reinterpret_cast<unsigned char*>(p.out) + (DK == 128 ? OUT_STH : OUT_STG)) + ((size_t)sidx * 128 + c) * (128 * DK);
    f32x4 acc[NDB][2];
#pragma unroll
    for (int i = 0; i < NDB; ++i) { acc[i][0] = f32x4{0, 0, 0, 0}; acc[i][1] = f32x4{0, 0, 0, 0}; }
    const int fo = (lane & 15) * 64 + 8 * (lane >> 4);
#pragma unroll
    for (int ks = 0; ks < 2; ++ks) {
        bf16x8 bv[2];
#pragma unroll
        for (int nb = 0; nb < 2; ++nb) bv[nb] = ldg_frag(VT + (size_t)(32 * w + nb * 16) * 64 + fo + ks * 32);
#pragma unroll
        for (int db = 0; db < NDB; ++db) {
            const bf16x8 ak = ldg_frag(KT + (size_t)(db * 16) * 64 + fo + ks * 32);
            acc[db][0] = mfma16(ak, bv[0], acc[db][0]);
            acc[db][1] = mfma16(ak, bv[1], acc[db][1]);
        }
    }
#pragma unroll
    for (int db = 0; db < NDB; ++db) {
        const int d = db * 16 + 4 * (lane >> 4);
        const float4 dc = *reinterpret_cast<const float4*>(DEC + d);
#pragma unroll
        for (int nb = 0; nb < 2; ++nb) {
            const int dv = 32 * w + nb * 16 + (lane & 15);
            uint2 o; o.x = pack2(acc[db][nb][0] * dc.x, acc[db][nb][1] * dc.y); o.y = pack2(acc[db][nb][2] * dc.z, acc[db][nb][3] * dc.w);
            *reinterpret_cast<uint2*>(ST + (size_t)dv * DK + d) = o;
        }
    }
}
DEVI void phase3_unit(const Params& p, int u, char* smem) {
    if (u < 2048) kv_unit<128>(p, u >> 7, u & 127); else { u -= 2048; kv_unit<64>(p, u >> 7, u & 127); }
}

constexpr int P4_UNITS = 384;
DEVI void phase4_unit(const Params& p, int u, char* smem) {
    unsigned char* ws = p.ws;
    int e = u * 256 + threadIdx.x;
    bf16_t* base; const float* dec; size_t cstride; int decstride;
    if (e < 65536) {
        const int sidx = e >> 12, rem = e & 4095, dv = rem >> 5, d4 = (rem & 31) * 4;
        const int b = sidx >> 2, h = sidx & 3;
        base = reinterpret_cast<bf16_t*>(reinterpret_cast<unsigned char*>(p.out) + OUT_STH) + ((size_t)sidx * 128) * 16384 + dv * 128 + d4;
        cstride = 16384;
        dec = reinterpret_cast<const float*>(ws + OFF_DECH) + (size_t)(b * 128) * 512 + h * 128 + d4; decstride = 512;
    } else {
        e -= 65536;
        const int sidx = e >> 11, rem = e & 2047, dv = rem >> 4, d4 = (rem & 15) * 4;
        const int b = sidx >> 2, h = sidx & 3;
        base = reinterpret_cast<bf16_t*>(reinterpret_cast<unsigned char*>(p.out) + OUT_STG) + ((size_t)sidx * 128) * 8192 + dv * 64 + d4;
        cstride = 8192;
        dec = reinterpret_cast<const float*>(ws + OFF_DECG) + (size_t)(b * 128) * 256 + h * 64 + d4; decstride = 256;
    }
    float s0 = 0.f, s1 = 0.f, s2 = 0.f, s3 = 0.f;
    for (int c8 = 0; c8 < 128; c8 += 8) {
        uint2 kv[8]; float4 dc[8];
#pragma unroll
        for (int i = 0; i < 8; ++i) { kv[i] = *reinterpret_cast<const uint2*>(base + (size_t)(c8 + i) * cstride); dc[i] = *reinterpret_cast<const float4*>(dec + (size_t)(c8 + i) * decstride); }
#pragma unroll
        for (int i = 0; i < 8; ++i) {
            uint2 o; o.x = pack2(s0, s1); o.y = pack2(s2, s3);
            *reinterpret_cast<uint2*>(base + (size_t)(c8 + i) * cstride) = o;
            s0 = dc[i].x * s0 + bflo(kv[i].x); s1 = dc[i].y * s1 + bfhi(kv[i].x);
            s2 = dc[i].z * s2 + bflo(kv[i].y); s3 = dc[i].w * s3 + bfhi(kv[i].y);
        }
    }
}

constexpr int P5_UNITS = 4096;
constexpr int PL_PITCH = 72;
template <int DK>
DEVI void out_unit(const Params& p, int sidx, int c, char* smem) {
    unsigned char* ws = p.ws;
    const int lane = threadIdx.x & 63, w = threadIdx.x >> 6;
    const int b = sidx >> 2, h = sidx & 3;
    const int cidx = b * 128 + c;
    const size_t row0 = (size_t)cidx * 64;
    constexpr int LDQ = 4 * DK;
    const bf16_t* Qn = reinterpret_cast<const bf16_t*>(ws + (DK == 128 ? OFF_HQ : OFF_GQ)) + row0 * LDQ + h * DK;
    const bf16_t* Kn = reinterpret_cast<const bf16_t*>(ws + (DK == 128 ? OFF_HLF : OFF_GK)) + row0 * LDQ + h * DK;
    const bf16_t* VT = reinterpret_cast<const bf16_t*>(ws + (DK == 128 ? OFF_HVT : OFF_GVT)) + ((size_t)cidx * 512 + h * 128) * 64;
    const bf16_t* ST = reinterpret_cast<const bf16_t*>(reinterpret_cast<const unsigned char*>(p.out) + (DK == 128 ? OUT_STH : OUT_STG)) + ((size_t)sidx * 128 + c) * (128 * DK);
    const bf16_t* GATE = reinterpret_cast<const bf16_t*>(ws + (DK == 128 ? OFF_HG : OFF_GG)) + row0 * 512 + h * 128;
    const float* ng = (DK == 128) ? p.hg_norm_g : p.gla_norm_g;
    bf16_t* MIX = reinterpret_cast<bf16_t*>(ws + OFF_MIX) + row0 * 1024 + (DK == 128 ? 0 : 512) + h * 128;
    bf16_t* PL = reinterpret_cast<bf16_t*>(smem);
    float* RED = reinterpret_cast<float*>(smem + 64 * PL_PITCH * 2);

    const int l15 = lane & 15, lg = lane >> 4;
    {
        bf16x8 bq[DK / 32];
#pragma unroll
        for (int ks = 0; ks < DK / 32; ++ks) bq[ks] = ldg_frag(Qn + (size_t)(w * 16 + l15) * LDQ + ks * 32 + 8 * lg);
#pragma unroll
        for (int jb = 0; jb < 4; ++jb) {
            f32x4 a = f32x4{0, 0, 0, 0};
            if (jb <= w) {
#pragma unroll
                for (int ks = 0; ks < DK / 32; ++ks) {
                    const bf16x8 ak = ldg_frag(Kn + (size_t)(jb * 16 + l15) * LDQ + ks * 32 + 8 * lg);
                    a = mfma16(ak, bq[ks], a);
                }
            }
            const int i = w * 16 + l15, j0 = jb * 16 + 4 * lg;
            const float v0 = (j0 + 0 <= i) ? a[0] : 0.f, v1 = (j0 + 1 <= i) ? a[1] : 0.f, v2 = (j0 + 2 <= i) ? a[2] : 0.f, v3 = (j0 + 3 <= i) ? a[3] : 0.f;
            uint2 o; o.x = pack2(v0, v1); o.y = pack2(v2, v3);
            *reinterpret_cast<uint2*>(PL + i * PL_PITCH + j0) = o;
        }
    }
    __syncthreads();
    f32x4 acc[2][4];
#pragma unroll
    for (int x = 0; x < 2; ++x)
#pragma unroll
        for (int y = 0; y < 4; ++y) acc[x][y] = f32x4{0, 0, 0, 0};
#pragma unroll
    for (int ks = 0; ks < 2; ++ks) {
        bf16x8 av[2], bp[4];
#pragma unroll
        for (int x = 0; x < 2; ++x) av[x] = ldg_frag(VT + (size_t)((2 * w + x) * 16 + l15) * 64 + ks * 32 + 8 * lg);
#pragma unroll
        for (int y = 0; y < 4; ++y) bp[y] = *reinterpret_cast<const bf16x8*>(PL + (y * 16 + l15) * PL_PITCH + ks * 32 + 8 * lg);
#pragma unroll
        for (int x = 0; x < 2; ++x)
#pragma unroll
            for (int y = 0; y < 4; ++y) acc[x][y] = mfma16(av[x], bp[y], acc[x][y]);
    }
#pragma unroll
    for (int ks = 0; ks < DK / 32; ++ks) {
        bf16x8 as[2], bq[4];
#pragma unroll
        for (int x = 0; x < 2; ++x) as[x] = ldg_frag(ST + (size_t)((2 * w + x) * 16 + l15) * DK + ks * 32 + 8 * lg);
#pragma unroll
        for (int y = 0; y < 4; ++y) bq[y] = ldg_frag(Qn + (size_t)(y * 16 + l15) * LDQ + ks * 32 + 8 * lg);
#pragma unroll
        for (int x = 0; x < 2; ++x)
#pragma unroll
            for (int y = 0; y < 4; ++y) acc[x][y] = mfma16(as[x], bq[y], acc[x][y]);
    }
    float ssq[4];
#pragma unroll
    for (int y = 0; y < 4; ++y) {
        float s = 0.f;
#pragma unroll
        for (int x = 0; x < 2; ++x)
#pragma unroll
            for (int r = 0; r < 4; ++r) s += acc[x][y][r] * acc[x][y][r];
        s += __shfl_xor(s, 16); s += __shfl_xor(s, 32);
        ssq[y] = s;
    }
    if (lg == 0) {
#pragma unroll
        for (int y = 0; y < 4; ++y) RED[w * 64 + y * 16 + l15] = ssq[y];
    }
    __syncthreads();
#pragma unroll
    for (int y = 0; y < 4; ++y) {
        const int i = y * 16 + l15;
        const float tot = RED[i] + RED[64 + i] + RED[128 + i] + RED[192 + i];
        const float rstd = rsqrtf(tot * (1.f / 128.f) + 1e-6f);
#pragma unroll
        for (int x = 0; x < 2; ++x) {
            const int dv = (2 * w + x) * 16 + 4 * lg;
            const float4 g4 = *reinterpret_cast<const float4*>(ng + dv);
            const uint2 gt = *reinterpret_cast<const uint2*>(GATE + (size_t)i * 512 + dv);
            uint2 o;
            o.x = pack2(acc[x][y][0] * rstd * g4.x * bflo(gt.x), acc[x][y][1] * rstd * g4.y * bfhi(gt.x));
            o.y = pack2(acc[x][y][2] * rstd * g4.z * bflo(gt.y), acc[x][y][3] * rstd * g4.w * bfhi(gt.y));
            *reinterpret_cast<uint2*>(MIX + (size_t)i * 1024 + dv) = o;
        }
    }
    __syncthreads();
}
DEVI void phase5_unit(const Params& p, int u, char* smem) {
    if (u < 2048) out_unit<128>(p, u >> 7, u & 127, smem); else { u -= 2048; out_unit<64>(p, u >> 7, u & 127, smem); }
}

constexpr int P6_UNITS = (M_TOK / 128) * 8;
DEVI void phase6_unit(const Params& p, int u, char* smem) {
    unsigned char* ws = p.ws;
    const int mt = u >> 3, nt = u & 7;
    const int m0 = mt * 128, n0 = nt * 128;
    f32x4 acc[4][4];
    gemm_tile<true>(reinterpret_cast<const bf16_t*>(ws + OFF_MIX), reinterpret_cast<const bf16_t*>(ws + OFF_WOUT), 1024, m0, n0, smem, acc);
    const int lane = threadIdx.x & 63, w = threadIdx.x >> 6, wm = w >> 1, wn = w & 1;
#pragma unroll
    for (int mi = 0; mi < 4; ++mi)
#pragma unroll
        for (int ni = 0; ni < 4; ++ni) {
            const int m = m0 + wm * 64 + mi * 16 + (lane & 15);
            const int n = n0 + wn * 64 + ni * 16 + 4 * (lane >> 4);
            const float4 xv = *reinterpret_cast<const float4*>(p.x + (size_t)m * DM + n);
            *reinterpret_cast<float4*>(p.out + (size_t)m * DM + n) = make_float4(xv.x + acc[mi][ni][0], xv.y + acc[mi][ni][1], xv.z + acc[mi][ni][2], xv.w + acc[mi][ni][3]);
        }
}

constexpr int P7_UNITS = 8192;
DEVI void phase7_unit(const Params& p, int u, char* smem) {
    const int lane = threadIdx.x & 63, w = threadIdx.x >> 6;
    const int row = u * 4 + w;
    rms_row_bf16(p.out + (size_t)row * DM, p.norm2_g, reinterpret_cast<bf16_t*>(p.ws + OFF_HN) + (size_t)row * DM, lane);
}

constexpr int P8_UNITS = (M_TOK / 128) * 16;
DEVI void phase8_unit(const Params& p, int u, char* smem) {
    unsigned char* ws = p.ws;
    const int mt = u >> 4, nt = u & 15;
    f32x4 acc[4][4];
    gemm_tile<true>(reinterpret_cast<const bf16_t*>(ws + OFF_HN), reinterpret_cast<const bf16_t*>(ws + OFF_WQ), 1024, mt * 128, nt * 128, smem, acc);
    store_sw_bf16(acc, reinterpret_cast<bf16_t*>(ws + OFF_Q), 2048, mt * 128, nt * 128, [](float v, int) { return v; });
}

constexpr int P9_UNITS = (M_TOK / 16) * 8;
DEVI void phase9_unit(const Params& p, int u, char* smem) {
    unsigned char* ws = p.ws;
    const int tid = threadIdx.x, lane = tid & 63, w = tid >> 6;
    const int tg = u >> 3, h = u & 7;
    const int m0 = tg * 16;
    float* S = reinterpret_cast<float*>(smem);
    float* TV = S + 2 * 16 * 128;
    int* TI = reinterpret_cast<int*>(TV + 2 * 16 * 16);
    const int l15 = lane & 15, lg = lane >> 4;
    {
        const int ph = w & 1, nh = w >> 1;
        const bf16_t* SK = reinterpret_cast<const bf16_t*>(ws + OFF_SK) + (size_t)((h * 2 + ph) * 128) * 128;
        const bf16_t* Q = reinterpret_cast<const bf16_t*>(ws + OFF_Q) + (size_t)m0 * 2048 + h * 256 + ph * 128;
        f32x4 acc[4];
#pragma unroll
        for (int i = 0; i < 4; ++i) acc[i] = f32x4{0, 0, 0, 0};
#pragma unroll
        for (int ks = 0; ks < 4; ++ks) {
            const bf16x8 bq = ldg_frag(Q + (size_t)l15 * 2048 + ks * 32 + 8 * lg);
#pragma unroll
            for (int nb = 0; nb < 4; ++nb) {
                const bf16x8 ak = ldg_frag(SK + (size_t)((nh * 4 + nb) * 16 + l15) * 128 + ks * 32 + 8 * lg);
                acc[nb] = mfma16(ak, bq, acc[nb]);
            }
        }
#pragma unroll
        for (int nb = 0; nb < 4; ++nb) {
            const int n = (nh * 4 + nb) * 16 + 4 * lg;
            *reinterpret_cast<float4*>(S + (ph * 16 + l15) * 128 + n) = make_float4(acc[nb][0], acc[nb][1], acc[nb][2], acc[nb][3]);
        }
    }
    __syncthreads();
    for (int li = 0; li < 8; ++li) {
        const int L = w * 8 + li;
        float v0 = S[L * 128 + lane], v1 = S[L * 128 + 64 + lane];
        float myv = 0.f; int myi = 0;
        for (int k = 0; k < 16; ++k) {
            const float mx = wave_max(fmaxf(v0, v1));
            const unsigned long long b0 = __ballot(v0 == mx);
            int idx;
            if (b0) { idx = __ffsll((long long)b0) - 1; if (lane == idx) v0 = -INFINITY; }
            else { const unsigned long long b1 = __ballot(v1 == mx); idx = __ffsll((long long)b1) - 1; if (lane == idx) v1 = -INFINITY; idx += 64; }
            if (lane == k) { myv = mx; myi = idx; }
        }
        if (lane < 16) { TV[L * 16 + lane] = myv; TI[L * 16 + lane] = myi; }
    }
    __syncthreads();
    for (int ti = 0; ti < 4; ++ti) {
        const int t = w * 4 + ti;
        const float sa = TV[t * 16 + (lane >> 2)];
        float cv[4];
#pragma unroll
        for (int q = 0; q < 4; ++q) cv[q] = sa + TV[(16 + t) * 16 + (lane & 3) * 4 + q];
        float myv = 0.f; int myc = 0;
        for (int k = 0; k < 16; ++k) {
            const float mx = wave_max(fmaxf(fmaxf(cv[0], cv[1]), fmaxf(cv[2], cv[3])));
            int best = 1 << 20;
#pragma unroll
            for (int q = 0; q < 4; ++q) {
                const unsigned long long bq = __ballot(cv[q] == mx);
                if (bq) { const int cand = (__ffsll((long long)bq) - 1) * 4 + q; best = cand < best ? cand : best; }
            }
            const int bl = best >> 2, bqi = best & 3;
            if (lane == bl) {
#pragma unroll
                for (int q = 0; q < 4; ++q) if (q == bqi) cv[q] = -INFINITY;
            }
            if (lane == k) { myv = mx; myc = best; }
        }
        const float top = __shfl(myv, 0);
        float e = (lane < 16) ? __expf(myv - top) : 0.f;
        const float sum = wave_sum(e);
        if (lane < 16) {
            const int a = myc >> 4, bb = myc & 15;
            const int ex = TI[t * 16 + a] * 128 + TI[(16 + t) * 16 + bb];
            reinterpret_cast<int*>(ws + OFF_EIDX)[(size_t)(m0 + t) * 128 + h * 16 + lane] = ex;
            reinterpret_cast<float*>(ws + OFF_EW)[(size_t)(m0 + t) * 128 + h * 16 + lane] = e / sum;
        }
    }
    __syncthreads();
}

constexpr int P10_UNITS = 8192;
DEVI void phase10_unit(const Params& p, int u, char* smem) {
    unsigned char* ws = p.ws;
    const int lane = threadIdx.x & 63, w = threadIdx.x >> 6;
    const int m = u * 4 + w;
    const bf16_t* HN = reinterpret_cast<const bf16_t*>(ws + OFF_HN) + (size_t)m * DM;
    const bf16_t* UB = reinterpret_cast<const bf16_t*>(ws + OFF_UB);
    const bf16_t* VB = reinterpret_cast<const bf16_t*>(ws + OFF_VB);
    const int* EI = reinterpret_cast<const int*>(ws + OFF_EIDX) + (size_t)m * 128;
    const float* EW = reinterpret_cast<const float*>(ws + OFF_EW) + (size_t)m * 128;
    float hn[16];
    {
        const uint4 a = *reinterpret_cast<const uint4*>(HN + 8 * lane), b = *reinterpret_cast<const uint4*>(HN + 512 + 8 * lane);
        hn[0] = bflo(a.x); hn[1] = bfhi(a.x); hn[2] = bflo(a.y); hn[3] = bfhi(a.y); hn[4] = bflo(a.z); hn[5] = bfhi(a.z); hn[6] = bflo(a.w); hn[7] = bfhi(a.w);
        hn[8] = bflo(b.x); hn[9] = bfhi(b.x); hn[10] = bflo(b.y); hn[11] = bfhi(b.y); hn[12] = bflo(b.z); hn[13] = bfhi(b.z); hn[14] = bflo(b.w); hn[15] = bfhi(b.w);
    }
    const int e0 = EI[lane], e1 = EI[64 + lane];
    const float g0 = EW[lane], g1 = EW[64 + lane];
    float acc[16];
#pragma unroll
    for (int i = 0; i < 16; ++i) acc[i] = 0.f;
#pragma unroll 1
    for (int half = 0; half < 2; ++half) {
        const int ev = half ? e1 : e0; const float gv = half ? g1 : g0;
#pragma unroll 4
        for (int k = 0; k < 64; ++k) {
            const int e = __shfl(ev, k);
            const float g = __shfl(gv, k);
            const bf16_t* ur = UB + (size_t)e * DM;
            const uint4 a = *reinterpret_cast<const uint4*>(ur + 8 * lane), b = *reinterpret_cast<const uint4*>(ur + 512 + 8 * lane);
            float d = bflo(a.x) * hn[0] + bfhi(a.x) * hn[1] + bflo(a.y) * hn[2] + bfhi(a.y) * hn[3] + bflo(a.z) * hn[4] + bfhi(a.z) * hn[5] + bflo(a.w) * hn[6] + bfhi(a.w) * hn[7]
                    + bflo(b.x) * hn[8] + bfhi(b.x) * hn[9] + bflo(b.y) * hn[10] + bfhi(b.y) * hn[11] + bflo(b.z) * hn[12] + bfhi(b.z) * hn[13] + bflo(b.w) * hn[14] + bfhi(b.w) * hn[15];
            d = wave_sum(d);
            const float act = 0.5f * d * (1.f + erff(d * 0.70710678118654752f));
            const float wk = g * act;
            const bf16_t* vr = VB + (size_t)e * DM;
            const uint4 c = *reinterpret_cast<const uint4*>(vr + 8 * lane), dd = *reinterpret_cast<const uint4*>(vr + 512 + 8 * lane);
            acc[0] += wk * bflo(c.x); acc[1] += wk * bfhi(c.x); acc[2] += wk * bflo(c.y); acc[3] += wk * bfhi(c.y);
            acc[4] += wk * bflo(c.z); acc[5] += wk * bfhi(c.z); acc[6] += wk * bflo(c.w); acc[7] += wk * bfhi(c.w);
            acc[8] += wk * bflo(dd.x); acc[9] += wk * bfhi(dd.x); acc[10] += wk * bflo(dd.y); acc[11] += wk * bfhi(dd.y);
            acc[12] += wk * bflo(dd.z); acc[13] += wk * bfhi(dd.z); acc[14] += wk * bflo(dd.w); acc[15] += wk * bfhi(dd.w);
        }
    }
    float* orow = p.out + (size_t)m * DM;
    float4 hv[4];
    hv[0] = *reinterpret_cast<const float4*>(orow + 8 * lane); hv[1] = *reinterpret_cast<const float4*>(orow + 8 * lane + 4);
    hv[2] = *reinterpret_cast<const float4*>(orow + 512 + 8 * lane); hv[3] = *reinterpret_cast<const float4*>(orow + 512 + 8 * lane + 4);
    float o[16];
#pragma unroll
    for (int i = 0; i < 4; ++i) { o[4 * i] = hv[i].x + acc[4 * i]; o[4 * i + 1] = hv[i].y + acc[4 * i + 1]; o[4 * i + 2] = hv[i].z + acc[4 * i + 2]; o[4 * i + 3] = hv[i].w + acc[4 * i + 3]; }
    float ss = 0.f;
#pragma unroll
    for (int i = 0; i < 16; ++i) ss += o[i] * o[i];
    ss = wave_sum(ss);
    const float r = rsqrtf(ss * (1.f / 1024.f) + 1e-6f);
    const float* gf = p.norm_f_g;
    const float4 ga = *reinterpret_cast<const float4*>(gf + 8 * lane), gb = *reinterpret_cast<const float4*>(gf + 8 * lane + 4);
    const float4 gc = *reinterpret_cast<const float4*>(gf + 512 + 8 * lane), gd = *reinterpret_cast<const float4*>(gf + 512 + 8 * lane + 4);
    *reinterpret_cast<float4*>(orow + 8 * lane) = make_float4(o[0] * r * ga.x, o[1] * r * ga.y, o[2] * r * ga.z, o[3] * r * ga.w);
    *reinterpret_cast<float4*>(orow + 8 * lane + 4) = make_float4(o[4] * r * gb.x, o[5] * r * gb.y, o[6] * r * gb.z, o[7] * r * gb.w);
    *reinterpret_cast<float4*>(orow + 512 + 8 * lane) = make_float4(o[8] * r * gc.x, o[9] * r * gc.y, o[10] * r * gc.z, o[11] * r * gc.w);
    *reinterpret_cast<float4*>(orow + 512 + 8 * lane + 4) = make_float4(o[12] * r * gd.x, o[13] * r * gd.y, o[14] * r * gd.z, o[15] * r * gd.w);
}

constexpr int N_PHASES = 11;
constexpr int LDS_BYTES = 65536;

__global__ void __launch_bounds__(256, 2) hymba_fwd(Params p) {
    extern __shared__ __attribute__((aligned(16))) char smem[];
    cg::grid_group grid = cg::this_grid();
    const int lo = p.ph_lo, hi = p.ph_hi;
#define RUN_PHASE(K, FN, N) if (lo <= (K) && (K) < hi) { if ((K) > lo) grid.sync(); for (int u = blockIdx.x; u < (N); u += gridDim.x) FN(p, u, smem); }
    RUN_PHASE(0, phase0_unit, P0_UNITS)
    RUN_PHASE(1, phase1_unit, P1_UNITS)
    RUN_PHASE(2, phase2_unit, P2_UNITS)
    RUN_PHASE(3, phase3_unit, P3_UNITS)
    RUN_PHASE(4, phase4_unit, P4_UNITS)
    RUN_PHASE(5, phase5_unit, P5_UNITS)
    RUN_PHASE(6, phase6_unit, P6_UNITS)
    RUN_PHASE(7, phase7_unit, P7_UNITS)
    RUN_PHASE(8, phase8_unit, P8_UNITS)
    RUN_PHASE(9, phase9_unit, P9_UNITS)
    RUN_PHASE(10, phase10_unit, P10_UNITS)
#undef RUN_PHASE
}

extern "C" void kernel_launch(void* const* d_in, const int* in_sizes, int n_in, void* d_out, int out_size, void* d_ws, size_t ws_size, hipStream_t stream) {
    static int grid_blocks = 0;
    if (grid_blocks == 0) {
        if (n_in != 15 || in_sizes[0] != M_TOK * DM || out_size != M_TOK * DM || ws_size < WS_NEED) {
            fprintf(stderr, "kernel_launch: unexpected shapes (n_in %d, in0 %d, out %d, ws %zu)\n", n_in, n_in > 0 ? in_sizes[0] : -1, out_size, ws_size);
            grid_blocks = -1; return;
        }
        int dev = 0, cus = 0, per_cu = 0;
        (void)hipGetDevice(&dev);
        (void)hipDeviceGetAttribute(&cus, hipDeviceAttributeMultiprocessorCount, dev);
        (void)hipFuncSetAttribute((const void*)hymba_fwd, hipFuncAttributeMaxDynamicSharedMemorySize, LDS_BYTES);
        (void)hipOccupancyMaxActiveBlocksPerMultiprocessor(&per_cu, (const void*)hymba_fwd, 256, LDS_BYTES);
        if (per_cu < 1) per_cu = 1;
        if (per_cu > 2) per_cu = 2;
        grid_blocks = cus * per_cu;
    }
    if (grid_blocks < 0) return;
    Params p{};
    p.x = (const float*)d_in[0]; p.norm1_g = (const float*)d_in[1]; p.w_in = (const float*)d_in[2]; p.hg_lower = (const float*)d_in[3];
    p.hg_norm_g = (const float*)d_in[4]; p.gla_wg = (const float*)d_in[5]; p.gla_bg = (const float*)d_in[6]; p.gla_norm_g = (const float*)d_in[7];
    p.w_out = (const float*)d_in[8]; p.norm2_g = (const float*)d_in[9]; p.w_q = (const float*)d_in[10]; p.sub_keys = (const float*)d_in[11];
    p.peer_u = (const float*)d_in[12]; p.peer_v = (const float*)d_in[13]; p.norm_f_g = (const float*)d_in[14];
    p.out = (float*)d_out; p.ws = (unsigned char*)d_ws;
#if N_LAUNCH_MODE == 1
    p.ph_lo = 0; p.ph_hi = N_PHASES;
    void* args[] = {&p};
    hipError_t e = hipLaunchCooperativeKernel((const void*)hymba_fwd, dim3(grid_blocks), dim3(256), args, LDS_BYTES, stream);
    if (e != hipSuccess) fprintf(stderr, "cooperative launch failed: %s (grid %d)\n", hipGetErrorString(e), grid_blocks);
#else
    for (int ph = 0; ph < N_PHASES; ++ph) {
        p.ph_lo = ph; p.ph_hi = ph + 1;
        hipLaunchKernelGGL(hymba_fwd, dim3(grid_blocks), dim3(256), LDS_BYTES, stream, p);
    }
#endif
}
```

```cpp
#include <hip/hip_runtime.h>
#include <hip/hip_cooperative_groups.h>
#include <cstdio>
#include <cstdint>
namespace cg = cooperative_groups;

#ifndef N_LAUNCH_MODE
#define N_LAUNCH_MODE 1
#endif

#ifndef PROBE_DUP
#define PROBE_DUP 0
#endif
#define DEVI __device__ __forceinline__
typedef unsigned short bf16_t;
using bf16x8 = __attribute__((ext_vector_type(8))) short;
using f32x4 = __attribute__((ext_vector_type(4))) float;

constexpr int M_TOK = 32768;
constexpr int DM = 1024;
constexpr int IN_WP = 3712;
constexpr size_t MiB = 1024ull * 1024ull;

constexpr size_t OFF_XN   = 0;
constexpr size_t OFF_WIN  = 64 * MiB;
constexpr size_t OFF_WOUT = 72 * MiB;
constexpr size_t OFF_WQ   = 74 * MiB;
constexpr size_t OFF_SK   = 78 * MiB;
constexpr size_t OFF_LB   = 79 * MiB;
constexpr size_t OFF_UB   = 80 * MiB;
constexpr size_t OFF_VB   = 112 * MiB;
constexpr size_t OFF_R2   = 144 * MiB;
constexpr size_t OFF_HQ   = OFF_R2;
constexpr size_t OFF_HLF  = OFF_R2 + 32 * MiB;
constexpr size_t OFF_HVT  = OFF_R2 + 64 * MiB;
constexpr size_t OFF_HG   = OFF_R2 + 96 * MiB;
constexpr size_t OFF_GQ   = OFF_R2 + 128 * MiB;
constexpr size_t OFF_GK   = OFF_R2 + 144 * MiB;
constexpr size_t OFF_GVT  = OFF_R2 + 160 * MiB;
constexpr size_t OFF_GG   = OFF_R2 + 192 * MiB;
constexpr size_t OFF_GLOW = OFF_R2 + 224 * MiB;
constexpr size_t OFF_KTH  = 370 * MiB;
constexpr size_t OFF_KTG  = 402 * MiB;
constexpr size_t OFF_DECH = 418 * MiB;
constexpr size_t OFF_DECG = 419 * MiB;
constexpr size_t OFF_BAR  = 420 * MiB;
constexpr size_t WS_NEED  = 421 * MiB;
constexpr size_t OFF_MIX  = OFF_XN;
constexpr size_t OFF_HN   = OFF_R2;
constexpr size_t OFF_Q    = OFF_R2 + 64 * MiB;
constexpr size_t OFF_EIDX = OFF_KTH;
constexpr size_t OFF_EW   = OFF_KTH + 16 * MiB;
constexpr size_t OUT_STH = 0;
constexpr size_t OUT_STG = 64 * MiB;

struct Params {
    const float* x; const float* norm1_g; const float* w_in; const float* hg_lower; const float* hg_norm_g;
    const float* gla_wg; const float* gla_bg; const float* gla_norm_g; const float* w_out; const float* norm2_g;
    const float* w_q; const float* sub_keys; const float* peer_u; const float* peer_v; const float* norm_f_g;
    float* out; unsigned char* ws;
    int ph_lo, ph_hi;
};

DEVI unsigned short f2bf(float f) {
    unsigned u = __float_as_uint(f);
    u += 0x7fffu + ((u >> 16) & 1u);
    return (unsigned short)(u >> 16);
}
DEVI float bf2f(unsigned short b) { return __uint_as_float(((unsigned)b) << 16); }
DEVI unsigned pack2(float a, float b) { return (unsigned)f2bf(a) | ((unsigned)f2bf(b) << 16); }
DEVI float bflo(unsigned u) { return __uint_as_float(u << 16); }
DEVI float bfhi(unsigned u) { return __uint_as_float(u & 0xffff0000u); }
DEVI float wave_sum(float v) {
#pragma unroll
    for (int o = 32; o > 0; o >>= 1) v += __shfl_xor(v, o);
    return v;
}
DEVI float wave_max(float v) {
#pragma unroll
    for (int o = 32; o > 0; o >>= 1) v = fmaxf(v, __shfl_xor(v, o));
    return v;
}
DEVI float silu_f(float x) { return x / (1.f + __expf(-x)); }
DEVI f32x4 mfma16(bf16x8 a, bf16x8 b, f32x4 c) { return __builtin_amdgcn_mfma_f32_16x16x32_bf16(a, b, c, 0, 0, 0); }
DEVI bf16x8 ldg_frag(const bf16_t* p) { return *reinterpret_cast<const bf16x8*>(p); }

DEVI void rms_row_bf16(const float* __restrict__ xr, const float* __restrict__ g, bf16_t* __restrict__ dst, int lane) {
    float4 v[4]; float ss = 0.f;
#pragma unroll
    for (int i = 0; i < 4; ++i) { v[i] = reinterpret_cast<const float4*>(xr)[lane + 64 * i]; ss += v[i].x * v[i].x + v[i].y * v[i].y + v[i].z * v[i].z + v[i].w * v[i].w; }
    ss = wave_sum(ss);
    const float r = rsqrtf(ss * (1.f / 1024.f) + 1e-6f);
#pragma unroll
    for (int i = 0; i < 4; ++i) {
        const float4 gg = reinterpret_cast<const float4*>(g)[lane + 64 * i];
        uint2 o; o.x = pack2(v[i].x * r * gg.x, v[i].y * r * gg.y); o.y = pack2(v[i].z * r * gg.z, v[i].w * r * gg.w);
        reinterpret_cast<uint2*>(dst)[lane + 64 * i] = o;
    }
}

DEVI void transpose_tile(const float* __restrict__ src, int Nsrc, bf16_t* __restrict__ dst, int nt, int kt, int mode, float* lds) {
    const int tid = threadIdx.x, tx = tid & 63, ty = tid >> 6;
    const int np = nt * 64 + tx;
    int col = np; bool valid = true;
    if (mode == 1) {
        if (np < 3072) col = np; else if (np < 3584) col = np + 16; else if (np < 3600) col = np - 512; else { valid = false; col = 0; }
    }
#pragma unroll 4
    for (int kk = ty; kk < 64; kk += 4) {
        lds[kk * 65 + tx] = valid ? src[(size_t)(kt * 64 + kk) * Nsrc + col] : 0.f;
    }
    __syncthreads();
    const int nl = tid >> 2, kq = tid & 3;
    unsigned pk[8];
#pragma unroll
    for (int i = 0; i < 8; ++i) pk[i] = pack2(lds[(kq * 16 + 2 * i) * 65 + nl], lds[(kq * 16 + 2 * i + 1) * 65 + nl]);
    uint4* d = reinterpret_cast<uint4*>(dst + (size_t)(nt * 64 + nl) * 1024 + kt * 64 + kq * 16);
    d[0] = make_uint4(pk[0], pk[1], pk[2], pk[3]);
    d[1] = make_uint4(pk[4], pk[5], pk[6], pk[7]);
    __syncthreads();
}

DEVI void convert8(const float* __restrict__ src, bf16_t* __restrict__ dst, size_t idx8) {
    const float4 a = reinterpret_cast<const float4*>(src)[idx8 * 2], b = reinterpret_cast<const float4*>(src)[idx8 * 2 + 1];
    reinterpret_cast<uint4*>(dst)[idx8] = make_uint4(pack2(a.x, a.y), pack2(a.z, a.w), pack2(b.x, b.y), pack2(b.z, b.w));
}

constexpr int P0_XN = 8192, P0_WIN = 58 * 16, P0_WOUT = 16 * 16, P0_WQ = 32 * 16, P0_UV = 16384, P0_SK = 128, P0_LB = 1;
constexpr int P0_UNITS = P0_XN + P0_WIN + P0_WOUT + P0_WQ + P0_UV + P0_SK + P0_LB;

DEVI void phase0_unit(const Params& p, int u, char* smem) {
    const int tid = threadIdx.x, lane = tid & 63, w = tid >> 6;
    unsigned char* ws = p.ws;
    if (u < P0_XN) {
        const int row = u * 4 + w;
        rms_row_bf16(p.x + (size_t)row * DM, p.norm1_g, reinterpret_cast<bf16_t*>(ws + OFF_XN) + (size_t)row * DM, lane);
        return;
    }
    u -= P0_XN;
    if (u < P0_WIN) { transpose_tile(p.w_in, 3600, reinterpret_cast<bf16_t*>(ws + OFF_WIN), u / 16, u % 16, 1, reinterpret_cast<float*>(smem)); return; }
    u -= P0_WIN;
    if (u < P0_WOUT) { transpose_tile(p.w_out, 1024, reinterpret_cast<bf16_t*>(ws + OFF_WOUT), u / 16, u % 16, 0, reinterpret_cast<float*>(smem)); return; }
    u -= P0_WOUT;
    if (u < P0_WQ) { transpose_tile(p.w_q, 2048, reinterpret_cast<bf16_t*>(ws + OFF_WQ), u / 16, u % 16, 0, reinterpret_cast<float*>(smem)); return; }
    u -= P0_WQ;
    if (u < P0_UV) {
        const bool isv = u >= 8192; const int uu = isv ? u - 8192 : u;
        convert8(isv ? p.peer_v : p.peer_u, reinterpret_cast<bf16_t*>(ws + (isv ? OFF_VB : OFF_UB)), (size_t)uu * 256 + tid);
        return;
    }
    u -= P0_UV;
    if (u < P0_SK) { convert8(p.sub_keys, reinterpret_cast<bf16_t*>(ws + OFF_SK), (size_t)u * 256 + tid); return; }
    float* lb = reinterpret_cast<float*>(ws + OFF_LB);
    for (int n = tid; n < 512; n += 256) {
        const float l0 = p.hg_lower[n], l1 = p.hg_lower[512 + n];
        const float mx = fmaxf(l0, l1); const float e0 = __expf(l0 - mx), e1 = __expf(l1 - mx);
        lb[n] = e0 / (e0 + e1);
    }
}

template <bool SW>
DEVI void gemm_tile(const bf16_t* __restrict__ A, const bf16_t* __restrict__ Bt, int K, int m0, int n0, char* smem, f32x4 (&acc)[4][4]) {
    const int tid = threadIdx.x, lane = tid & 63, w = tid >> 6, wm = w >> 1, wn = w & 1;
#pragma unroll
    for (int i = 0; i < 4; ++i)
#pragma unroll
        for (int j = 0; j < 4; ++j) acc[i][j] = f32x4{0.f, 0.f, 0.f, 0.f};
    const int lrow = tid >> 3, lch = tid & 7;
    const bf16_t* ga = A + (size_t)(m0 + lrow) * K + lch * 8;
    const bf16_t* gb = Bt + (size_t)(n0 + lrow) * K + lch * 8;
    const int lds_off = lrow * 128 + ((lch ^ (lrow & 7)) << 4);
    const int fr_base = (lane & 15) * 128;
    const int xo0 = (((lane >> 4)) ^ (lane & 7)) << 4;
    const int xo1 = ((4 + (lane >> 4)) ^ (lane & 7)) << 4;
    uint4 ra[4], rb[4];
    const int nk = K >> 6;
#pragma unroll
    for (int i = 0; i < 4; ++i) { ra[i] = *reinterpret_cast<const uint4*>(ga + (size_t)i * 32 * K); rb[i] = *reinterpret_cast<const uint4*>(gb + (size_t)i * 32 * K); }
#pragma unroll
    for (int i = 0; i < 4; ++i) { *reinterpret_cast<uint4*>(smem + lds_off + i * 4096) = ra[i]; *reinterpret_cast<uint4*>(smem + 16384 + lds_off + i * 4096) = rb[i]; }
    __syncthreads();
    for (int kt = 0; kt < nk; ++kt) {
        const char* sA = smem + (kt & 1) * 32768;
        const char* sB = sA + 16384;
        if (kt + 1 < nk) {
#pragma unroll
            for (int i = 0; i < 4; ++i) { ra[i] = *reinterpret_cast<const uint4*>(ga + (size_t)i * 32 * K + (kt + 1) * 64); rb[i] = *reinterpret_cast<const uint4*>(gb + (size_t)i * 32 * K + (kt + 1) * 64); }
        }
#pragma unroll
        for (int ks = 0; ks < 2; ++ks) {
            const int xo = ks ? xo1 : xo0;
            bf16x8 af[4], bfr[4];
#pragma unroll
            for (int i = 0; i < 4; ++i) {
                af[i] = *reinterpret_cast<const bf16x8*>(sA + (wm * 64 + i * 16) * 128 + fr_base + xo);
                bfr[i] = *reinterpret_cast<const bf16x8*>(sB + (wn * 64 + i * 16) * 128 + fr_base + xo);
            }
#pragma unroll
            for (int i = 0; i < 4; ++i)
#pragma unroll
                for (int j = 0; j < 4; ++j) acc[i][j] = SW ? mfma16(bfr[j], af[i], acc[i][j]) : mfma16(af[i], bfr[j], acc[i][j]);
        }
        if (kt + 1 < nk) {
            char* dA = smem + ((kt + 1) & 1) * 32768;
#pragma unroll
            for (int i = 0; i < 4; ++i) { *reinterpret_cast<uint4*>(dA + lds_off + i * 4096) = ra[i]; *reinterpret_cast<uint4*>(dA + 16384 + lds_off + i * 4096) = rb[i]; }
        }
        __syncthreads();
    }
}

constexpr int P1_NT = IN_WP / 128;
constexpr int P1_UNITS = (M_TOK / 128) * P1_NT;

template <typename F>
DEVI void store_sw_bf16(const f32x4 (&acc)[4][4], bf16_t* dst, int ld, int m0, int ncol0, F f) {
    const int lane = threadIdx.x & 63, w = threadIdx.x >> 6, wm = w >> 1, wn = w & 1;
#pragma unroll
    for (int mi = 0; mi < 4; ++mi)
#pragma unroll
        for (int ni = 0; ni < 4; ++ni) {
            const int m = m0 + wm * 64 + mi * 16 + (lane & 15);
            const int n = ncol0 + wn * 64 + ni * 16 + 4 * (lane >> 4);
            uint2 o; o.x = pack2(f(acc[mi][ni][0], n), f(acc[mi][ni][1], n + 1)); o.y = pack2(f(acc[mi][ni][2], n + 2), f(acc[mi][ni][3], n + 3));
            *reinterpret_cast<uint2*>(dst + (size_t)m * ld + n) = o;
        }
}
DEVI void store_ns_T(const f32x4 (&acc)[4][4], bf16_t* dst, int ncols, int m0, int ncol0) {
    const int lane = threadIdx.x & 63, w = threadIdx.x >> 6, wm = w >> 1, wn = w & 1;
#pragma unroll
    for (int mi = 0; mi < 4; ++mi)
#pragma unroll
        for (int ni = 0; ni < 4; ++ni) {
            const int m = m0 + wm * 64 + mi * 16 + 4 * (lane >> 4);
            const int n = ncol0 + wn * 64 + ni * 16 + (lane & 15);
            uint2 o; o.x = pack2(acc[mi][ni][0], acc[mi][ni][1]); o.y = pack2(acc[mi][ni][2], acc[mi][ni][3]);
            *reinterpret_cast<uint2*>(dst + ((size_t)(m >> 6) * ncols + n) * 64 + (m & 63)) = o;
        }
}

DEVI void phase1_unit(const Params& p, int u, char* smem) {
    unsigned char* ws = p.ws;
    const int mt = u / P1_NT, nt = u % P1_NT;
    const int m0 = mt * 128, n0 = nt * 128;
    const bf16_t* A = reinterpret_cast<const bf16_t*>(ws + OFF_XN);
    const bf16_t* Bt = reinterpret_cast<const bf16_t*>(ws + OFF_WIN);
    f32x4 acc[4][4];
    const bool ns = (n0 >= 1024 && n0 < 1536) || (n0 >= 2560 && n0 < 3072);
    if (ns) {
        gemm_tile<false>(A, Bt, 1024, m0, n0, smem, acc);
        if (n0 < 1536) store_ns_T(acc, reinterpret_cast<bf16_t*>(ws + OFF_HVT), 512, m0, n0 - 1024);
        else store_ns_T(acc, reinterpret_cast<bf16_t*>(ws + OFF_GVT), 512, m0, n0 - 2560);
        return;
    }
    gemm_tile<true>(A, Bt, 1024, m0, n0, smem, acc);
    if (n0 < 512) {
        store_sw_bf16(acc, reinterpret_cast<bf16_t*>(ws + OFF_HQ), 512, m0, n0, [](float v, int) { return silu_f(v); });
    } else if (n0 < 1024) {
        const float* lb = reinterpret_cast<const float*>(ws + OFF_LB);
        store_sw_bf16(acc, reinterpret_cast<bf16_t*>(ws + OFF_HLF), 512, m0, n0 - 512, [lb](float v, int n) {
            const float l = lb[n]; const float fg = l + (1.f - l) / (1.f + __expf(-v)); return __logf(fg); });
    } else if (n0 < 2048) {
        store_sw_bf16(acc, reinterpret_cast<bf16_t*>(ws + OFF_HG), 512, m0, n0 - 1536, [](float v, int) { return silu_f(v); });
    } else if (n0 < 2304) {
        store_sw_bf16(acc, reinterpret_cast<bf16_t*>(ws + OFF_GQ), 256, m0, n0 - 2048, [](float v, int) { return v * 0.125f; });
    } else if (n0 < 2560) {
        store_sw_bf16(acc, reinterpret_cast<bf16_t*>(ws + OFF_GK), 256, m0, n0 - 2304, [](float v, int) { return v; });
    } else if (n0 < 3584) {
        store_sw_bf16(acc, reinterpret_cast<bf16_t*>(ws + OFF_GG), 512, m0, n0 - 3072, [](float v, int) { return silu_f(v); });
    } else {
        const int lane = threadIdx.x & 63, w = threadIdx.x >> 6, wm = w >> 1, wn = w & 1;
        if (wn == 0) {
            float* gl = reinterpret_cast<float*>(ws + OFF_GLOW);
#pragma unroll
            for (int mi = 0; mi < 4; ++mi) {
                const int m = m0 + wm * 64 + mi * 16 + (lane & 15);
                const int n = 4 * (lane >> 4);
                *reinterpret_cast<float4*>(gl + (size_t)m * 16 + n) = make_float4(acc[mi][0][0], acc[mi][0][1], acc[mi][0][2], acc[mi][0][3]);
            }
        }
    }
}

constexpr int P2_UNITS = 512 * 3;
DEVI float logsigmoid_f(float z) { return fminf(z, 0.f) - __logf(1.f + __expf(-fabsf(z))); }

DEVI void phase2_unit(const Params& p, int u, char* smem) {
    unsigned char* ws = p.ws;
    const int tid = threadIdx.x;
    const int cidx = u / 3, part = u % 3;
    const size_t row0 = (size_t)cidx * 64;
    if (part < 2) {
        const int n = part * 256 + tid;
        bf16_t* HQ = reinterpret_cast<bf16_t*>(ws + OFF_HQ);
        bf16_t* HLF = reinterpret_cast<bf16_t*>(ws + OFF_HLF);
        bf16_t* KT = reinterpret_cast<bf16_t*>(ws + OFF_KTH);
        float Gl = 0.f;
#pragma unroll 8
        for (int r = 0; r < 64; ++r) Gl += bf2f(HLF[(row0 + r) * 512 + n]);
        float G = 0.f;
        for (int r8 = 0; r8 < 8; ++r8) {
            unsigned pk[4];
#pragma unroll
            for (int rr = 0; rr < 8; ++rr) {
                const size_t idx = (row0 + r8 * 8 + rr) * 512 + n;
                const float lf = bf2f(HLF[idx]);
                G += lf;
                const float key = 1.f - __expf(lf);
                const float q = bf2f(HQ[idx]);
                const unsigned short bq = f2bf(q * __expf(G));
                const unsigned short bk = f2bf(key * __expf(-G));
                HQ[idx] = bq; HLF[idx] = bk;
                if (rr & 1) pk[rr >> 1] |= ((unsigned)bk << 16); else pk[rr >> 1] = bk;
            }
            *reinterpret_cast<uint4*>(KT + ((size_t)cidx * 512 + n) * 64 + r8 * 8) = make_uint4(pk[0], pk[1], pk[2], pk[3]);
        }
        reinterpret_cast<float*>(ws + OFF_DECH)[(size_t)cidx * 512 + n] = __expf(Gl);
    } else {
        const int n = tid;
        bf16_t* GQ = reinterpret_cast<bf16_t*>(ws + OFF_GQ);
        bf16_t* GK = reinterpret_cast<bf16_t*>(ws + OFF_GK);
        bf16_t* KT = reinterpret_cast<bf16_t*>(ws + OFF_KTG);
        const float* GL = reinterpret_cast<const float*>(ws + OFF_GLOW);
        float wg[16];
#pragma unroll
        for (int j = 0; j < 16; ++j) wg[j] = p.gla_wg[j * 256 + n];
        const float bg = p.gla_bg[n];
        float Gl = 0.f;
        for (int r = 0; r < 64; ++r) {
            const float4* g4 = reinterpret_cast<const float4*>(GL + (row0 + r) * 16);
            float z = bg;
#pragma unroll
            for (int j = 0; j < 4; ++j) { const float4 t = g4[j]; z += t.x * wg[4 * j] + t.y * wg[4 * j + 1] + t.z * wg[4 * j + 2] + t.w * wg[4 * j + 3]; }
            Gl += logsigmoid_f(z) * (1.f / 16.f);
        }
        float G = 0.f;
        for (int r8 = 0; r8 < 8; ++r8) {
            unsigned pk[4];
#pragma unroll
            for (int rr = 0; rr < 8; ++rr) {
                const size_t row = row0 + r8 * 8 + rr;
                const float4* g4 = reinterpret_cast<const float4*>(GL + row * 16);
                float z = bg;
#pragma unroll
                for (int j = 0; j < 4; ++j) { const float4 t = g4[j]; z += t.x * wg[4 * j] + t.y * wg[4 * j + 1] + t.z * wg[4 * j + 2] + t.w * wg[4 * j + 3]; }
                G += logsigmoid_f(z) * (1.f / 16.f);
                const size_t idx = row * 256 + n;
                const unsigned short bq = f2bf(bf2f(GQ[idx]) * __expf(G));
                const unsigned short bk = f2bf(bf2f(GK[idx]) * __expf(-G));
                GQ[idx] = bq; GK[idx] = bk;
                if (rr & 1) pk[rr >> 1] |= ((unsigned)bk << 16); else pk[rr >> 1] = bk;
            }
            *reinterpret_cast<uint4*>(KT + ((size_t)cidx * 256 + n) * 64 + r8 * 8) = make_uint4(pk[0], pk[1], pk[2], pk[3]);
        }
        reinterpret_cast<float*>(ws + OFF_DECG)[(size_t)cidx * 256 + n] = __expf(Gl);
    }
}

constexpr int P3_UNITS = 4096;
template <int DK>
DEVI void kv_unit(const Params& p, int sidx, int c) {
    unsigned char* ws = p.ws;
    const int lane = threadIdx.x & 63, w = threadIdx.x >> 6;
    const int b = sidx >> 2, h = sidx & 3;
    const int cidx = b * 128 + c;
    constexpr int NDB = DK / 16;
    const bf16_t* KT = reinterpret_cast<const bf16_t*>(ws + (DK == 128 ? OFF_KTH : OFF_KTG)) + ((size_t)cidx * (4 * DK) + h * DK) * 64;
    const bf16_t* VT = reinterpret_cast<const bf16_t*>(ws + (DK == 128 ? OFF_HVT : OFF_GVT)) + ((size_t)cidx * 512 + h * 128) * 64;
    const float* DEC = reinterpret_cast<const float*>(ws + (DK == 128 ? OFF_DECH : OFF_DECG)) + (size_t)cidx * (4 * DK) + h * DK;
    bf16_t* ST = reinterpret_cast<bf16_t*>(reinterpret_cast<unsigned char*>(p.out) + (DK == 128 ? OUT_STH : OUT_STG)) + ((size_t)sidx * 128 + c) * (128 * DK);
    f32x4 acc[NDB][2];
#pragma unroll
    for (int i = 0; i < NDB; ++i) { acc[i][0] = f32x4{0, 0, 0, 0}; acc[i][1] = f32x4{0, 0, 0, 0}; }
    const int fo = (lane & 15) * 64 + 8 * (lane >> 4);
#pragma unroll
    for (int ks = 0; ks < 2; ++ks) {
        bf16x8 bv[2];
#pragma unroll
        for (int nb = 0; nb < 2; ++nb) bv[nb] = ldg_frag(VT + (size_t)(32 * w + nb * 16) * 64 + fo + ks * 32);
#pragma unroll
        for (int db = 0; db < NDB; ++db) {
            const bf16x8 ak = ldg_frag(KT + (size_t)(db * 16) * 64 + fo + ks * 32);
            acc[db][0] = mfma16(ak, bv[0], acc[db][0]);
            acc[db][1] = mfma16(ak, bv[1], acc[db][1]);
        }
    }
#pragma unroll
    for (int db = 0; db < NDB; ++db) {
        const int d = db * 16 + 4 * (lane >> 4);
        const float4 dc = *reinterpret_cast<const float4*>(DEC + d);
#pragma unroll
        for (int nb = 0; nb < 2; ++nb) {
            const int dv = 32 * w + nb * 16 + (lane & 15);
            uint2 o; o.x = pack2(acc[db][nb][0] * dc.x, acc[db][nb][1] * dc.y); o.y = pack2(acc[db][nb][2] * dc.z, acc[db][nb][3] * dc.w);
            *reinterpret_cast<uint2*>(ST + (size_t)dv * DK + d) = o;
        }
    }
}
DEVI void phase3_unit(const Params& p, int u, char* smem) {
    if (u < 2048) kv_unit<128>(p, u >> 7, u & 127); else { u -= 2048; kv_unit<64>(p, u >> 7, u & 127); }
}

constexpr int P4_UNITS = 384;
DEVI void phase4_unit(const Params& p, int u, char* smem) {
    unsigned char* ws = p.ws;
    int e = u * 256 + threadIdx.x;
    bf16_t* base; const float* dec; size_t cstride; int decstride;
    if (e < 65536) {
        const int sidx = e >> 12, rem = e & 4095, dv = rem >> 5, d4 = (rem & 31) * 4;
        const int b = sidx >> 2, h = sidx & 3;
        base = reinterpret_cast<bf16_t*>(reinterpret_cast<unsigned char*>(p.out) + OUT_STH) + ((size_t)sidx * 128) * 16384 + dv * 128 + d4;
        cstride = 16384;
        dec = reinterpret_cast<const float*>(ws + OFF_DECH) + (size_t)(b * 128) * 512 + h * 128 + d4; decstride = 512;
    } else {
        e -= 65536;
        const int sidx = e >> 11, rem = e & 2047, dv = rem >> 4, d4 = (rem & 15) * 4;
        const int b = sidx >> 2, h = sidx & 3;
        base = reinterpret_cast<bf16_t*>(reinterpret_cast<unsigned char*>(p.out) + OUT_STG) + ((size_t)sidx * 128) * 8192 + dv * 64 + d4;
        cstride = 8192;
        dec = reinterpret_cast<const float*>(ws + OFF_DECG) + (size_t)(b * 128) * 256 + h * 64 + d4; decstride = 256;
    }
    float s0 = 0.f, s1 = 0.f, s2 = 0.f, s3 = 0.f;
    for (int c8 = 0; c8 < 128; c8 += 8) {
        uint2 kv[8]; float4 dc[8];
#pragma unroll
        for (int i = 0; i < 8; ++i) { kv[i] = *reinterpret_cast<const uint2*>(base + (size_t)(c8 + i) * cstride); dc[i] = *reinterpret_cast<const float4*>(dec + (size_t)(c8 + i) * decstride); }
#pragma unroll
        for (int i = 0; i < 8; ++i) {
            uint2 o; o.x = pack2(s0, s1); o.y = pack2(s2, s3);
            *reinterpret_cast<uint2*>(base + (size_t)(c8 + i) * cstride) = o;
            s0 = dc[i].x * s0 + bflo(kv[i].x); s1 = dc[i].y * s1 + bfhi(kv[i].x);
            s2 = dc[i].z * s2 + bflo(kv[i].y); s3 = dc[i].w * s3 + bfhi(kv[i].y);
        }
    }
}

constexpr int P5_UNITS = 4096;
constexpr int PL_PITCH = 72;
template <int DK>
DEVI void out_unit(const Params& p, int sidx, int c, char* smem) {
    unsigned char* ws = p.ws;
    const int lane = threadIdx.x & 63, w = threadIdx.x >> 6;
    const int b = sidx >> 2, h = sidx & 3;
    const int cidx = b * 128 + c;
    const size_t row0 = (size_t)cidx * 64;
    constexpr int LDQ = 4 * DK;
    const bf16_t* Qn = reinterpret_cast<const bf16_t*>(ws + (DK == 128 ? OFF_HQ : OFF_GQ)) + row0 * LDQ + h * DK;
    const bf16_t* Kn = reinterpret_cast<const bf16_t*>(ws + (DK == 128 ? OFF_HLF : OFF_GK)) + row0 * LDQ + h * DK;
    const bf16_t* VT = reinterpret_cast<const bf16_t*>(ws + (DK == 128 ? OFF_HVT : OFF_GVT)) + ((size_t)cidx * 512 + h * 128) * 64;
    const bf16_t* ST = reinterpret_cast<const bf16_t*>(reinterpret_cast<const unsigned char*>(p.out) + (DK == 128 ? OUT_STH : OUT_STG)) + ((size_t)sidx * 128 + c) * (128 * DK);
    const bf16_t* GATE = reinterpret_cast<const bf16_t*>(ws + (DK == 128 ? OFF_HG : OFF_GG)) + row0 * 512 + h * 128;
    const float* ng = (DK == 128) ? p.hg_norm_g : p.gla_norm_g;
    bf16_t* MIX = reinterpret_cast<bf16_t*>(ws + OFF_MIX) + row0 * 1024 + (DK == 128 ? 0 : 512) + h * 128;
    bf16_t* PL = reinterpret_cast<bf16_t*>(smem);
    float* RED = reinterpret_cast<float*>(smem + 64 * PL_PITCH * 2);

    const int l15 = lane & 15, lg = lane >> 4;
    {
        bf16x8 bq[DK / 32];
#pragma unroll
        for (int ks = 0; ks < DK / 32; ++ks) bq[ks] = ldg_frag(Qn + (size_t)(w * 16 + l15) * LDQ + ks * 32 + 8 * lg);
#pragma unroll
        for (int jb = 0; jb < 4; ++jb) {
            f32x4 a = f32x4{0, 0, 0, 0};
            if (jb <= w) {
#pragma unroll
                for (int ks = 0; ks < DK / 32; ++ks) {
                    const bf16x8 ak = ldg_frag(Kn + (size_t)(jb * 16 + l15) * LDQ + ks * 32 + 8 * lg);
                    a = mfma16(ak, bq[ks], a);
                }
            }
            const int i = w * 16 + l15, j0 = jb * 16 + 4 * lg;
            const float v0 = (j0 + 0 <= i) ? a[0] : 0.f, v1 = (j0 + 1 <= i) ? a[1] : 0.f, v2 = (j0 + 2 <= i) ? a[2] : 0.f, v3 = (j0 + 3 <= i) ? a[3] : 0.f;
            uint2 o; o.x = pack2(v0, v1); o.y = pack2(v2, v3);
            *reinterpret_cast<uint2*>(PL + i * PL_PITCH + j0) = o;
        }
    }
    __syncthreads();
    f32x4 acc[2][4];
#pragma unroll
    for (int x = 0; x < 2; ++x)
#pragma unroll
        for (int y = 0; y < 4; ++y) acc[x][y] = f32x4{0, 0, 0, 0};
#pragma unroll
    for (int ks = 0; ks < 2; ++ks) {
        bf16x8 av[2], bp[4];
#pragma unroll
        for (int x = 0; x < 2; ++x) av[x] = ldg_frag(VT + (size_t)((2 * w + x) * 16 + l15) * 64 + ks * 32 + 8 * lg);
#pragma unroll
        for (int y = 0; y < 4; ++y) bp[y] = *reinterpret_cast<const bf16x8*>(PL + (y * 16 + l15) * PL_PITCH + ks * 32 + 8 * lg);
#pragma unroll
        for (int x = 0; x < 2; ++x)
#pragma unroll
            for (int y = 0; y < 4; ++y) acc[x][y] = mfma16(av[x], bp[y], acc[x][y]);
    }
#pragma unroll
    for (int ks = 0; ks < DK / 32; ++ks) {
        bf16x8 as[2], bq[4];
#pragma unroll
        for (int x = 0; x < 2; ++x) as[x] = ldg_frag(ST + (size_t)((2 * w + x) * 16 + l15) * DK + ks * 32 + 8 * lg);
#pragma unroll
        for (int y = 0; y < 4; ++y) bq[y] = ldg_frag(Qn + (size_t)(y * 16 + l15) * LDQ + ks * 32 + 8 * lg);
#pragma unroll
        for (int x = 0; x < 2; ++x)
#pragma unroll
            for (int y = 0; y < 4; ++y) acc[x][y] = mfma16(as[x], bq[y], acc[x][y]);
    }
    float ssq[4];
#pragma unroll
    for (int y = 0; y < 4; ++y) {
        float s = 0.f;
#pragma unroll
        for (int x = 0; x < 2; ++x)
#pragma unroll
            for (int r = 0; r < 4; ++r) s += acc[x][y][r] * acc[x][y][r];
        s += __shfl_xor(s, 16); s += __shfl_xor(s, 32);
        ssq[y] = s;
    }
    if (lg == 0) {
#pragma unroll
        for (int y = 0; y < 4; ++y) RED[w * 64 + y * 16 + l15] = ssq[y];
    }
    __syncthreads();
#pragma unroll
    for (int y = 0; y < 4; ++y) {
        const int i = y * 16 + l15;
        const float tot = RED[i] + RED[64 + i] + RED[128 + i] + RED[192 + i];
        const float rstd = rsqrtf(tot * (1.f / 128.f) + 1e-6f);
#pragma unroll
        for (int x = 0; x < 2; ++x) {
            const int dv = (2 * w + x) * 16 + 4 * lg;
            const float4 g4 = *reinterpret_cast<const float4*>(ng + dv);
            const uint2 gt = *reinterpret_cast<const uint2*>(GATE + (size_t)i * 512 + dv);
            uint2 o;
            o.x = pack2(acc[x][y][0] * rstd * g4.x * bflo(gt.x), acc[x][y][1] * rstd * g4.y * bfhi(gt.x));
            o.y = pack2(acc[x][y][2] * rstd * g4.z * bflo(gt.y), acc[x][y][3] * rstd * g4.w * bfhi(gt.y));
            *reinterpret_cast<uint2*>(MIX + (size_t)i * 1024 + dv) = o;
        }
    }
    __syncthreads();
}
DEVI void phase5_unit(const Params& p, int u, char* smem) {
    if (u < 2048) out_unit<128>(p, u >> 7, u & 127, smem); else { u -= 2048; out_unit<64>(p, u >> 7, u & 127, smem); }
}

constexpr int P6_UNITS = (M_TOK / 128) * 8;
DEVI void phase6_unit(const Params& p, int u, char* smem) {
    unsigned char* ws = p.ws;
    const int mt = u >> 3, nt = u & 7;
    const int m0 = mt * 128, n0 = nt * 128;
    f32x4 acc[4][4];
    gemm_tile<true>(reinterpret_cast<const bf16_t*>(ws + OFF_MIX), reinterpret_cast<const bf16_t*>(ws + OFF_WOUT), 1024, m0, n0, smem, acc);
    const int lane = threadIdx.x & 63, w = threadIdx.x >> 6, wm = w >> 1, wn = w & 1;
#pragma unroll
    for (int mi = 0; mi < 4; ++mi)
#pragma unroll
        for (int ni = 0; ni < 4; ++ni) {
            const int m = m0 + wm * 64 + mi * 16 + (lane & 15);
            const int n = n0 + wn * 64 + ni * 16 + 4 * (lane >> 4);
            const float4 xv = *reinterpret_cast<const float4*>(p.x + (size_t)m * DM + n);
            *reinterpret_cast<float4*>(p.out + (size_t)m * DM + n) = make_float4(xv.x + acc[mi][ni][0], xv.y + acc[mi][ni][1], xv.z + acc[mi][ni][2], xv.w + acc[mi][ni][3]);
        }
}

constexpr int P7_UNITS = 8192;
DEVI void phase7_unit(const Params& p, int u, char* smem) {
    const int lane = threadIdx.x & 63, w = threadIdx.x >> 6;
    const int row = u * 4 + w;
    rms_row_bf16(p.out + (size_t)row * DM, p.norm2_g, reinterpret_cast<bf16_t*>(p.ws + OFF_HN) + (size_t)row * DM, lane);
}

constexpr int P8_UNITS = (M_TOK / 128) * 16;
DEVI void phase8_unit(const Params& p, int u, char* smem) {
    unsigned char* ws = p.ws;
    const int mt = u >> 4, nt = u & 15;
    f32x4 acc[4][4];
    gemm_tile<true>(reinterpret_cast<const bf16_t*>(ws + OFF_HN), reinterpret_cast<const bf16_t*>(ws + OFF_WQ), 1024, mt * 128, nt * 128, smem, acc);
    store_sw_bf16(acc, reinterpret_cast<bf16_t*>(ws + OFF_Q), 2048, mt * 128, nt * 128, [](float v, int) { return v; });
}

using f32x16 = __attribute__((ext_vector_type(16))) float;
DEVI f32x16 mfma32(bf16x8 a, bf16x8 b, f32x16 c) { return __builtin_amdgcn_mfma_f32_32x32x16_bf16(a, b, c, 0, 0, 0); }
DEVI unsigned umax(unsigned a, unsigned b) { return a > b ? a : b; }
DEVI unsigned umin(unsigned a, unsigned b) { return a > b ? b : a; }
DEVI unsigned f2ord(float f) { const unsigned u = __float_as_uint(f); return u ^ ((unsigned)((int)u >> 31) | 0x80000000u); }
DEVI float ord2f(unsigned k) { return __uint_as_float((k & 0x80000000u) ? (k ^ 0x80000000u) : ~k); }

template <int BASE>
DEVI void sort16_desc(unsigned (&x)[64]) {
#pragma unroll
    for (int k = 2; k <= 16; k <<= 1) {
#pragma unroll
        for (int j = k >> 1; j > 0; j >>= 1) {
#pragma unroll
            for (int i = 0; i < 16; ++i) {
                const int l = i ^ j;
                if (l > i) {
                    const bool desc = ((i & k) == 0);
                    const unsigned a = x[BASE + i], b = x[BASE + l];
                    const unsigned hi = umax(a, b), lo = umin(a, b);
                    x[BASE + i] = desc ? hi : lo; x[BASE + l] = desc ? lo : hi;
                }
            }
        }
    }
}
template <int BASE>
DEVI void bmerge16_desc(unsigned (&x)[64]) {
#pragma unroll
    for (int j = 8; j > 0; j >>= 1) {
#pragma unroll
        for (int i = 0; i < 16; ++i) {
            const int l = i ^ j;
            if (l > i) { const unsigned a = x[BASE + i], b = x[BASE + l]; x[BASE + i] = umax(a, b); x[BASE + l] = umin(a, b); }
        }
    }
}
DEVI void top16_of_64(unsigned (&x)[64]) {
    sort16_desc<0>(x); sort16_desc<16>(x); sort16_desc<32>(x); sort16_desc<48>(x);
#pragma unroll
    for (int i = 0; i < 16; ++i) x[i] = umax(x[i], x[31 - i]);
    bmerge16_desc<0>(x);
#pragma unroll
    for (int i = 0; i < 16; ++i) x[32 + i] = umax(x[32 + i], x[63 - i]);
    bmerge16_desc<32>(x);
#pragma unroll
    for (int i = 0; i < 16; ++i) x[i] = umax(x[i], x[47 - i]);
    bmerge16_desc<0>(x);
}

DEVI void scores_top16(const bf16_t* __restrict__ SKp, const bf16_t* __restrict__ Qp, int lane, unsigned (&out)[16]) {
    const int r31 = lane & 31, hh = lane >> 5;
    f32x16 acc[4];
#pragma unroll
    for (int nb = 0; nb < 4; ++nb)
#pragma unroll
        for (int r = 0; r < 16; ++r) acc[nb][r] = 0.f;
#pragma unroll
    for (int ks = 0; ks < 8; ++ks) {
        const bf16x8 bq = ldg_frag(Qp + (size_t)r31 * 2048 + ks * 16 + 8 * hh);
#pragma unroll
        for (int nb = 0; nb < 4; ++nb) {
            const bf16x8 ak = ldg_frag(SKp + (size_t)(nb * 32 + r31) * 128 + ks * 16 + 8 * hh);
            acc[nb] = mfma32(ak, bq, acc[nb]);
        }
    }
    unsigned x[64];
    const unsigned hx = (unsigned)hh * 4u;
#pragma unroll
    for (int nb = 0; nb < 4; ++nb)
#pragma unroll
        for (int r = 0; r < 16; ++r) {
            const int nbase = nb * 32 + (r & 3) + 8 * (r >> 2);
            x[nb * 16 + r] = ((f2ord(acc[nb][r]) & ~127u) | (unsigned)(127 - nbase)) ^ hx;
        }
    top16_of_64(x);
    unsigned lo[16], hi[16];
#pragma unroll
    for (int i = 0; i < 16; ++i) { auto rr = __builtin_amdgcn_permlane32_swap(x[i], x[i], false, false); lo[i] = rr[0]; hi[i] = rr[1]; }
#pragma unroll
    for (int i = 0; i < 16; ++i) x[i] = umax(lo[i], hi[15 - i]);
    bmerge16_desc<0>(x);
#pragma unroll
    for (int i = 0; i < 16; ++i) out[i] = x[i];
}

constexpr int P9_UNITS = (M_TOK / 128) * 8;
DEVI void phase9_unit(const Params& p, int u, char* smem) {
    unsigned char* ws = p.ws;
    const int tid = threadIdx.x, lane = tid & 63, w = tid >> 6;
    const int tg = u >> 3, h = u & 7;
    const int t0 = tg * 128 + w * 32;
    const int hh = lane >> 5;
    unsigned* KL = reinterpret_cast<unsigned*>(smem) + w * 2048;
    const bf16_t* SK = reinterpret_cast<const bf16_t*>(ws + OFF_SK) + (size_t)(h * 2) * 128 * 128;
    const bf16_t* Q = reinterpret_cast<const bf16_t*>(ws + OFF_Q) + (size_t)t0 * 2048 + h * 256;
    unsigned k0[16], k1[16];
    scores_top16(SK, Q, lane, k0);
    scores_top16(SK + 128 * 128, Q + 128, lane, k1);
#pragma unroll
    for (int i = 0; i < 16; ++i) { KL[i * 64 + lane] = k0[i]; KL[(16 + i) * 64 + lane] = k1[i]; }
    float s0[16], s1[16];
#pragma unroll
    for (int i = 0; i < 16; ++i) { s0[i] = ord2f(k0[i] & ~127u); s1[i] = ord2f(k1[i] & ~127u); }
    unsigned x[64];
    {
        int n = 0;
#pragma unroll
        for (int a = 0; a < 16; ++a)
#pragma unroll
            for (int b = 0; b < 16; ++b)
                if ((a + 1) * (b + 1) <= 16) { x[n] = (f2ord(s0[a] + s1[b]) & ~255u) | (unsigned)(255 - (a * 16 + b)); ++n; }
#pragma unroll
        for (int i = 50; i < 64; ++i) x[i] = 0u;
    }
    top16_of_64(x);
    float cv[16]; int ex[16];
#pragma unroll
    for (int i = 0; i < 16; ++i) {
        cv[i] = ord2f(x[i] & ~255u);
        const int cid = 255 - (int)(x[i] & 255u);
        const unsigned ka = KL[(cid >> 4) * 64 + lane], kb = KL[(16 + (cid & 15)) * 64 + lane];
        ex[i] = (127 - (int)(ka & 127u)) * 128 + (127 - (int)(kb & 127u));
    }
    float sum = 0.f;
    const float mx = cv[0];
#pragma unroll
    for (int i = 0; i < 16; ++i) cv[i] = __expf(cv[i] - mx);
#pragma unroll
    for (int i = 0; i < 16; ++i) sum += cv[i];
    const float inv = 1.f / sum;
    const size_t orow = (size_t)(t0 + (lane & 31)) * 128 + h * 16;
    if (hh == 0) {
        int4* d = reinterpret_cast<int4*>(reinterpret_cast<int*>(ws + OFF_EIDX) + orow);
#pragma unroll
        for (int i = 0; i < 4; ++i) d[i] = make_int4(ex[4 * i], ex[4 * i + 1], ex[4 * i + 2], ex[4 * i + 3]);
    } else {
        float4* d = reinterpret_cast<float4*>(reinterpret_cast<float*>(ws + OFF_EW) + orow);
#pragma unroll
        for (int i = 0; i < 4; ++i) d[i] = make_float4(cv[4 * i] * inv, cv[4 * i + 1] * inv, cv[4 * i + 2] * inv, cv[4 * i + 3] * inv);
    }
}

constexpr int P10_UNITS = 8192;
DEVI void phase10_unit(const Params& p, int u, char* smem) {
    unsigned char* ws = p.ws;
    const int lane = threadIdx.x & 63, w = threadIdx.x >> 6;
    const int m = u * 4 + w;
    const bf16_t* HN = reinterpret_cast<const bf16_t*>(ws + OFF_HN) + (size_t)m * DM;
    const bf16_t* UB = reinterpret_cast<const bf16_t*>(ws + OFF_UB);
    const bf16_t* VB = reinterpret_cast<const bf16_t*>(ws + OFF_VB);
    const int* EI = reinterpret_cast<const int*>(ws + OFF_EIDX) + (size_t)m * 128;
    const float* EW = reinterpret_cast<const float*>(ws + OFF_EW) + (size_t)m * 128;
    float hn[16];
    {
        const uint4 a = *reinterpret_cast<const uint4*>(HN + 8 * lane), b = *reinterpret_cast<const uint4*>(HN + 512 + 8 * lane);
        hn[0] = bflo(a.x); hn[1] = bfhi(a.x); hn[2] = bflo(a.y); hn[3] = bfhi(a.y); hn[4] = bflo(a.z); hn[5] = bfhi(a.z); hn[6] = bflo(a.w); hn[7] = bfhi(a.w);
        hn[8] = bflo(b.x); hn[9] = bfhi(b.x); hn[10] = bflo(b.y); hn[11] = bfhi(b.y); hn[12] = bflo(b.z); hn[13] = bfhi(b.z); hn[14] = bflo(b.w); hn[15] = bfhi(b.w);
    }
    const int e0 = EI[lane], e1 = EI[64 + lane];
    const float g0 = EW[lane], g1 = EW[64 + lane];
    float acc[16];
#pragma unroll
    for (int i = 0; i < 16; ++i) acc[i] = 0.f;
#pragma unroll 1
    for (int half = 0; half < 2; ++half) {
        const int ev = half ? e1 : e0; const float gv = half ? g1 : g0;
#pragma unroll 4
        for (int k = 0; k < 64; ++k) {
            const int e = __shfl(ev, k);
            const float g = __shfl(gv, k);
            const bf16_t* ur = UB + (size_t)e * DM;
            const uint4 a = *reinterpret_cast<const uint4*>(ur + 8 * lane), b = *reinterpret_cast<const uint4*>(ur + 512 + 8 * lane);
            float d = bflo(a.x) * hn[0] + bfhi(a.x) * hn[1] + bflo(a.y) * hn[2] + bfhi(a.y) * hn[3] + bflo(a.z) * hn[4] + bfhi(a.z) * hn[5] + bflo(a.w) * hn[6] + bfhi(a.w) * hn[7]
                    + bflo(b.x) * hn[8] + bfhi(b.x) * hn[9] + bflo(b.y) * hn[10] + bfhi(b.y) * hn[11] + bflo(b.z) * hn[12] + bfhi(b.z) * hn[13] + bflo(b.w) * hn[14] + bfhi(b.w) * hn[15];
            d = wave_sum(d);
            const float act = 0.5f * d * (1.f + erff(d * 0.70710678118654752f));
            const float wk = g * act;
            const bf16_t* vr = VB + (size_t)e * DM;
            const uint4 c = *reinterpret_cast<const uint4*>(vr + 8 * lane), dd = *reinterpret_cast<const uint4*>(vr + 512 + 8 * lane);
            acc[0] += wk * bflo(c.x); acc[1] += wk * bfhi(c.x); acc[2] += wk * bflo(c.y); acc[3] += wk * bfhi(c.y);
            acc[4] += wk * bflo(c.z); acc[5] += wk * bfhi(c.z); acc[6] += wk * bflo(c.w); acc[7] += wk * bfhi(c.w);
            acc[8] += wk * bflo(dd.x); acc[9] += wk * bfhi(dd.x); acc[10] += wk * bflo(dd.y); acc[11] += wk * bfhi(dd.y);
            acc[12] += wk * bflo(dd.z); acc[13] += wk * bfhi(dd.z); acc[14] += wk * bflo(dd.w); acc[15] += wk * bfhi(dd.w);
        }
    }
    float* orow = p.out + (size_t)m * DM;
    float4 hv[4];
    hv[0] = *reinterpret_cast<const float4*>(orow + 8 * lane); hv[1] = *reinterpret_cast<const float4*>(orow + 8 * lane + 4);
    hv[2] = *reinterpret_cast<const float4*>(orow + 512 + 8 * lane); hv[3] = *reinterpret_cast<const float4*>(orow + 512 + 8 * lane + 4);
    float o[16];
#pragma unroll
    for (int i = 0; i < 4; ++i) { o[4 * i] = hv[i].x + acc[4 * i]; o[4 * i + 1] = hv[i].y + acc[4 * i + 1]; o[4 * i + 2] = hv[i].z + acc[4 * i + 2]; o[4 * i + 3] = hv[i].w + acc[4 * i + 3]; }
    float ss = 0.f;
#pragma unroll
    for (int i = 0; i < 16; ++i) ss += o[i] * o[i];
    ss = wave_sum(ss);
    const float r = rsqrtf(ss * (1.f / 1024.f) + 1e-6f);
    const float* gf = p.norm_f_g;
    const float4 ga = *reinterpret_cast<const float4*>(gf + 8 * lane), gb = *reinterpret_cast<const float4*>(gf + 8 * lane + 4);
    const float4 gc = *reinterpret_cast<const float4*>(gf + 512 + 8 * lane), gd = *reinterpret_cast<const float4*>(gf + 512 + 8 * lane + 4);
    *reinterpret_cast<float4*>(orow + 8 * lane) = make_float4(o[0] * r * ga.x, o[1] * r * ga.y, o[2] * r * ga.z, o[3] * r * ga.w);
    *reinterpret_cast<float4*>(orow + 8 * lane + 4) = make_float4(o[4] * r * gb.x, o[5] * r * gb.y, o[6] * r * gb.z, o[7] * r * gb.w);
    *reinterpret_cast<float4*>(orow + 512 + 8 * lane) = make_float4(o[8] * r * gc.x, o[9] * r * gc.y, o[10] * r * gc.z, o[11] * r * gc.w);
    *reinterpret_cast<float4*>(orow + 512 + 8 * lane + 4) = make_float4(o[12] * r * gd.x, o[13] * r * gd.y, o[14] * r * gd.z, o[15] * r * gd.w);
}


#define XB_TMO      128
#define XB_XCNT(j)  (256  + 64 * (j))
#define XB_XSUB(j)  (1280 + 64 * (j))
#define XB_XGEN(j)  (2304 + 64 * (j))
#define XB_TOP      3328
#define XB_TOPGEN   3392
#define XCD_BAR_WORDS 3456
#define XB_SPIN_CAP (1u << 22)
#define LAS __attribute__((address_space(3)))
DEVI unsigned xb_ld(unsigned* p)              { return __hip_atomic_load(p, __ATOMIC_RELAXED, __HIP_MEMORY_SCOPE_AGENT); }
DEVI unsigned xb_add(unsigned* p, unsigned v) { return __hip_atomic_fetch_add(p, v, __ATOMIC_RELAXED, __HIP_MEMORY_SCOPE_AGENT); }
DEVI unsigned xb_xcc_id() { return (unsigned)__builtin_amdgcn_s_getreg((3 << 11) | 20) & 0xFu; }
#define XB_SPIN(cond, bar) do { unsigned _sp = 0; while (cond) { __builtin_amdgcn_s_sleep(1); \
    if ((++_sp & 255u) == 0u) { if (xb_ld(&(bar)[XB_TMO])) break; if (_sp > XB_SPIN_CAP) { atomicAdd(&(bar)[XB_TMO], 1u); break; } } } } while (0)
struct XcdBarrier { unsigned* bar; unsigned x; volatile LAS unsigned* st; };
DEVI XcdBarrier xcd_barrier_post(unsigned* bar, volatile LAS unsigned* st) {
    XcdBarrier b; b.bar = bar; b.x = xb_xcc_id(); b.st = st;
    if (threadIdx.x == 0) (void)xb_add(&bar[XB_XCNT(b.x)], 1u);
    return b;
}
DEVI void xcd_barrier_complete(unsigned* bar, unsigned x, unsigned& nloc, unsigned& nx) {
    const unsigned G = gridDim.x * gridDim.y * gridDim.z;
    unsigned sum, cnt, mine, sp = 0u;
    for (;;) {
        sum = 0u; cnt = 0u; mine = 0u;
#pragma unroll
        for (unsigned j = 0; j < 16; ++j) { const unsigned c = xb_ld(&bar[XB_XCNT(j)]); sum += c; cnt += (c > 0u) ? 1u : 0u; mine = (j == x) ? c : mine; }
        if (sum == G) break;
        __builtin_amdgcn_s_sleep(1);
        if ((++sp & 255u) == 0u) { if (xb_ld(&bar[XB_TMO])) break; if (sp > XB_SPIN_CAP) { atomicAdd(&bar[XB_TMO], 1u); break; } }
    }
    nloc = mine > 0u ? mine : 1u; nx = cnt > 0u ? cnt : 1u;
}
DEVI void xcd_barrier(const XcdBarrier& b) {
    asm volatile("s_waitcnt vmcnt(0)" ::: "memory");
    __syncthreads();
    if (threadIdx.x == 0) {
        unsigned* bar = b.bar;
        __builtin_amdgcn_s_waitcnt(0);
        unsigned nloc = b.st[0], nx = b.st[1];
        if (nloc == 0u) { xcd_barrier_complete(bar, b.x, nloc, nx); b.st[0] = nloc; b.st[1] = nx; }
        const unsigned old = xb_add(&bar[XB_XSUB(b.x)], 1u);
        const unsigned gen = old / nloc;
        if (old + 1u == (gen + 1u) * nloc) {
            __builtin_amdgcn_fence(__ATOMIC_RELEASE, "agent");
            asm volatile("s_waitcnt vmcnt(0)" ::: "memory");
            const unsigned og = xb_add(&bar[XB_TOP], 1u);
            const unsigned tg = og / nx;
            if (og + 1u == (tg + 1u) * nx) xb_add(&bar[XB_TOPGEN], 1u);
            else XB_SPIN(xb_ld(&bar[XB_TOPGEN]) == tg, bar);
            __builtin_amdgcn_fence(__ATOMIC_ACQUIRE, "agent");
            xb_add(&bar[XB_XGEN(b.x)], 1u);
            asm volatile("s_waitcnt vmcnt(0)" ::: "memory");
        } else {
            XB_SPIN(xb_ld(&bar[XB_XGEN(b.x)]) == gen, bar);
            __builtin_amdgcn_fence(__ATOMIC_ACQUIRE, "agent");
            asm volatile("s_waitcnt vmcnt(0)" ::: "memory");
        }
    }
    __syncthreads();
}

constexpr int N_PHASES = 11;
constexpr int LDS_PHASE_BYTES = 65536;
constexpr int LDS_BYTES = LDS_PHASE_BYTES + 16;

__global__ void __launch_bounds__(256, 2) hymba_fwd(Params p) {
    extern __shared__ __attribute__((aligned(16))) char smem[];
    cg::grid_group grid = cg::this_grid();
    const int lo = p.ph_lo, hi = p.ph_hi;
    volatile LAS unsigned* bst = (volatile LAS unsigned*)(smem + LDS_BYTES - 16);
    if (threadIdx.x == 0) { bst[0] = 0u; bst[1] = 0u; bst[2] = 0u; bst[3] = 0u; }
    __syncthreads();
    XcdBarrier xb = xcd_barrier_post(reinterpret_cast<unsigned*>(p.ws + OFF_BAR), bst);
#define RUN_PHASE(K, FN, N) if (lo <= (K) && (K) < hi) { if ((K) > lo) { if ((K) == lo + 1) grid.sync(); else xcd_barrier(xb); } for (int rep = 0; rep < 1 + ((PROBE_DUP >> (K)) & 1); ++rep) { if (rep) xcd_barrier(xb); for (int u = blockIdx.x; u < (N); u += gridDim.x) FN(p, u, smem); } }
    RUN_PHASE(0, phase0_unit, P0_UNITS)
    RUN_PHASE(1, phase1_unit, P1_UNITS)
    RUN_PHASE(2, phase2_unit, P2_UNITS)
    RUN_PHASE(3, phase3_unit, P3_UNITS)
    RUN_PHASE(4, phase4_unit, P4_UNITS)
    RUN_PHASE(5, phase5_unit, P5_UNITS)
    RUN_PHASE(6, phase6_unit, P6_UNITS)
    RUN_PHASE(7, phase7_unit, P7_UNITS)
    RUN_PHASE(8, phase8_unit, P8_UNITS)
    RUN_PHASE(9, phase9_unit, P9_UNITS)
    RUN_PHASE(10, phase10_unit, P10_UNITS)
#undef RUN_PHASE
}

extern "C" void kernel_launch(void* const* d_in, const int* in_sizes, int n_in, void* d_out, int out_size, void* d_ws, size_t ws_size, hipStream_t stream) {
    static int grid_blocks = 0;
    if (grid_blocks == 0) {
        if (n_in != 15 || in_sizes[0] != M_TOK * DM || out_size != M_TOK * DM || ws_size < WS_NEED) {
            fprintf(stderr, "kernel_launch: unexpected shapes (n_in %d, in0 %d, out %d, ws %zu)\n", n_in, n_in > 0 ? in_sizes[0] : -1, out_size, ws_size);
            grid_blocks = -1; return;
        }
        int dev = 0, cus = 0, per_cu = 0;
        (void)hipGetDevice(&dev);
        (void)hipDeviceGetAttribute(&cus, hipDeviceAttributeMultiprocessorCount, dev);
        (void)hipFuncSetAttribute((const void*)hymba_fwd, hipFuncAttributeMaxDynamicSharedMemorySize, LDS_BYTES);
        (void)hipOccupancyMaxActiveBlocksPerMultiprocessor(&per_cu, (const void*)hymba_fwd, 256, LDS_BYTES);
        if (per_cu < 1) per_cu = 1;
        if (per_cu > 2) per_cu = 2;
        grid_blocks = cus * per_cu;
    }
    if (grid_blocks < 0) return;
    Params p{};
    p.x = (const float*)d_in[0]; p.norm1_g = (const float*)d_in[1]; p.w_in = (const float*)d_in[2]; p.hg_lower = (const float*)d_in[3];
    p.hg_norm_g = (const float*)d_in[4]; p.gla_wg = (const float*)d_in[5]; p.gla_bg = (const float*)d_in[6]; p.gla_norm_g = (const float*)d_in[7];
    p.w_out = (const float*)d_in[8]; p.norm2_g = (const float*)d_in[9]; p.w_q = (const float*)d_in[10]; p.sub_keys = (const float*)d_in[11];
    p.peer_u = (const float*)d_in[12]; p.peer_v = (const float*)d_in[13]; p.norm_f_g = (const float*)d_in[14];
    p.out = (float*)d_out; p.ws = (unsigned char*)d_ws;
#if N_LAUNCH_MODE == 1
    (void)hipMemsetAsync((unsigned char*)d_ws + OFF_BAR, 0, XCD_BAR_WORDS * 4, stream);
    p.ph_lo = 0; p.ph_hi = N_PHASES;
    void* args[] = {&p};
    hipError_t e = hipLaunchCooperativeKernel((const void*)hymba_fwd, dim3(grid_blocks), dim3(256), args, LDS_BYTES, stream);
    if (e != hipSuccess) fprintf(stderr, "cooperative launch failed: %s (grid %d)\n", hipGetErrorString(e), grid_blocks);
#else
    for (int ph = 0; ph < N_PHASES; ++ph) {
        p.ph_lo = ph; p.ph_hi = ph + 1;
        hipLaunchKernelGGL(hymba_fwd, dim3(grid_blocks), dim3(256), LDS_BYTES, stream, p);
    }
#endif
}
```

```cpp
#include <hip/hip_runtime.h>
#include <hip/hip_cooperative_groups.h>
#include <cstdio>
#include <cstdint>
namespace cg = cooperative_groups;

#ifndef N_LAUNCH_MODE
#define N_LAUNCH_MODE 1
#endif

#ifndef PROBE_DUP
#define PROBE_DUP 0
#endif
#define DEVI __device__ __forceinline__
typedef unsigned short bf16_t;
using bf16x8 = __attribute__((ext_vector_type(8))) short;
using f32x4 = __attribute__((ext_vector_type(4))) float;

constexpr int M_TOK = 32768;
constexpr int DM = 1024;
constexpr int IN_WP = 3712;
constexpr size_t MiB = 1024ull * 1024ull;

constexpr size_t OFF_XN   = 0;
constexpr size_t OFF_WIN  = 64 * MiB;
constexpr size_t OFF_WOUT = 72 * MiB;
constexpr size_t OFF_WQ   = 74 * MiB;
constexpr size_t OFF_SK   = 78 * MiB;
constexpr size_t OFF_LB   = 79 * MiB;
constexpr size_t OFF_U8   = 80 * MiB;
constexpr size_t OFF_V8   = 96 * MiB;
constexpr size_t OFF_US   = 112 * MiB;
constexpr size_t OFF_VS   = 113 * MiB;
constexpr size_t OFF_R2   = 144 * MiB;
constexpr size_t OFF_HQ   = OFF_R2;
constexpr size_t OFF_HLF  = OFF_R2 + 32 * MiB;
constexpr size_t OFF_HVT  = OFF_R2 + 64 * MiB;
constexpr size_t OFF_HG   = OFF_R2 + 96 * MiB;
constexpr size_t OFF_GQ   = OFF_R2 + 128 * MiB;
constexpr size_t OFF_GK   = OFF_R2 + 144 * MiB;
constexpr size_t OFF_GVT  = OFF_R2 + 160 * MiB;
constexpr size_t OFF_GG   = OFF_R2 + 192 * MiB;
constexpr size_t OFF_GLOW = OFF_R2 + 224 * MiB;
constexpr size_t OFF_KTH  = 370 * MiB;
constexpr size_t OFF_KTG  = 402 * MiB;
constexpr size_t OFF_DECH = 418 * MiB;
constexpr size_t OFF_DECG = 419 * MiB;
constexpr size_t OFF_BAR  = 420 * MiB;
constexpr size_t WS_NEED  = 421 * MiB;
constexpr size_t OFF_MIX  = OFF_XN;
constexpr size_t OFF_HN   = OFF_R2;
constexpr size_t OFF_Q    = OFF_R2 + 64 * MiB;
constexpr size_t OFF_EIDX = OFF_KTH;
constexpr size_t OFF_EW   = OFF_KTH + 16 * MiB;
constexpr size_t OUT_STH = 0;
constexpr size_t OUT_STG = 64 * MiB;

struct Params {
    const float* x; const float* norm1_g; const float* w_in; const float* hg_lower; const float* hg_norm_g;
    const float* gla_wg; const float* gla_bg; const float* gla_norm_g; const float* w_out; const float* norm2_g;
    const float* w_q; const float* sub_keys; const float* peer_u; const float* peer_v; const float* norm_f_g;
    float* out; unsigned char* ws;
    int ph_lo, ph_hi;
};

DEVI unsigned short f2bf(float f) {
    unsigned u = __float_as_uint(f);
    u += 0x7fffu + ((u >> 16) & 1u);
    return (unsigned short)(u >> 16);
}
DEVI float bf2f(unsigned short b) { return __uint_as_float(((unsigned)b) << 16); }
DEVI unsigned pack2(float a, float b) { return (unsigned)f2bf(a) | ((unsigned)f2bf(b) << 16); }
DEVI float bflo(unsigned u) { return __uint_as_float(u << 16); }
DEVI float bfhi(unsigned u) { return __uint_as_float(u & 0xffff0000u); }
DEVI float wave_sum(float v) {
#pragma unroll
    for (int o = 32; o > 0; o >>= 1) v += __shfl_xor(v, o);
    return v;
}
DEVI float wave_max(float v) {
#pragma unroll
    for (int o = 32; o > 0; o >>= 1) v = fmaxf(v, __shfl_xor(v, o));
    return v;
}
DEVI float silu_f(float x) { return x / (1.f + __expf(-x)); }
DEVI f32x4 mfma16(bf16x8 a, bf16x8 b, f32x4 c) { return __builtin_amdgcn_mfma_f32_16x16x32_bf16(a, b, c, 0, 0, 0); }
DEVI bf16x8 ldg_frag(const bf16_t* p) { return *reinterpret_cast<const bf16x8*>(p); }

DEVI void rms_row_bf16(const float* __restrict__ xr, const float* __restrict__ g, bf16_t* __restrict__ dst, int lane) {
    float4 v[4]; float ss = 0.f;
#pragma unroll
    for (int i = 0; i < 4; ++i) { v[i] = reinterpret_cast<const float4*>(xr)[lane + 64 * i]; ss += v[i].x * v[i].x + v[i].y * v[i].y + v[i].z * v[i].z + v[i].w * v[i].w; }
    ss = wave_sum(ss);
    const float r = rsqrtf(ss * (1.f / 1024.f) + 1e-6f);
#pragma unroll
    for (int i = 0; i < 4; ++i) {
        const float4 gg = reinterpret_cast<const float4*>(g)[lane + 64 * i];
        uint2 o; o.x = pack2(v[i].x * r * gg.x, v[i].y * r * gg.y); o.y = pack2(v[i].z * r * gg.z, v[i].w * r * gg.w);
        reinterpret_cast<uint2*>(dst)[lane + 64 * i] = o;
    }
}

DEVI void transpose_tile(const float* __restrict__ src, int Nsrc, bf16_t* __restrict__ dst, int nt, int kt, int mode, float* lds) {
    const int tid = threadIdx.x, tx = tid & 63, ty = tid >> 6;
    const int np = nt * 64 + tx;
    int col = np; bool valid = true;
    if (mode == 1) {
        if (np < 3072) col = np; else if (np < 3584) col = np + 16; else if (np < 3600) col = np - 512; else { valid = false; col = 0; }
    }
#pragma unroll 4
    for (int kk = ty; kk < 64; kk += 4) {
        lds[kk * 65 + tx] = valid ? src[(size_t)(kt * 64 + kk) * Nsrc + col] : 0.f;
    }
    __syncthreads();
    const int nl = tid >> 2, kq = tid & 3;
    unsigned pk[8];
#pragma unroll
    for (int i = 0; i < 8; ++i) pk[i] = pack2(lds[(kq * 16 + 2 * i) * 65 + nl], lds[(kq * 16 + 2 * i + 1) * 65 + nl]);
    uint4* d = reinterpret_cast<uint4*>(dst + (size_t)(nt * 64 + nl) * 1024 + kt * 64 + kq * 16);
    d[0] = make_uint4(pk[0], pk[1], pk[2], pk[3]);
    d[1] = make_uint4(pk[4], pk[5], pk[6], pk[7]);
    __syncthreads();
}

DEVI void convert8(const float* __restrict__ src, bf16_t* __restrict__ dst, size_t idx8) {
    const float4 a = reinterpret_cast<const float4*>(src)[idx8 * 2], b = reinterpret_cast<const float4*>(src)[idx8 * 2 + 1];
    reinterpret_cast<uint4*>(dst)[idx8] = make_uint4(pack2(a.x, a.y), pack2(a.z, a.w), pack2(b.x, b.y), pack2(b.z, b.w));
}

DEVI void quant_row_fp8(const float* __restrict__ xr, unsigned char* __restrict__ dst, float* __restrict__ descale, int lane) {
    float4 v[4]; float am = 0.f;
#pragma unroll
    for (int i = 0; i < 4; ++i) { v[i] = reinterpret_cast<const float4*>(xr)[lane + 64 * i]; am = fmaxf(am, fmaxf(fmaxf(fabsf(v[i].x), fabsf(v[i].y)), fmaxf(fabsf(v[i].z), fabsf(v[i].w)))); }
    am = wave_max(am);
    const float sc = am > 0.f ? 448.f / am : 1.f;
#pragma unroll
    for (int i = 0; i < 4; ++i) {
        const float a = fminf(fmaxf(v[i].x * sc, -448.f), 448.f), b = fminf(fmaxf(v[i].y * sc, -448.f), 448.f);
        const float c = fminf(fmaxf(v[i].z * sc, -448.f), 448.f), d = fminf(fmaxf(v[i].w * sc, -448.f), 448.f);
        int pk = __builtin_amdgcn_cvt_pk_fp8_f32(a, b, 0, false);
        pk = __builtin_amdgcn_cvt_pk_fp8_f32(c, d, pk, true);
        reinterpret_cast<int*>(dst)[lane + 64 * i] = pk;
    }
    if (lane == 0) *descale = am > 0.f ? am * (1.f / 448.f) : 1.f;
}

constexpr int P0_XN = 8192, P0_WIN = 58 * 16, P0_WOUT = 16 * 16, P0_WQ = 32 * 16, P0_UV = 8192, P0_SK = 128, P0_LB = 1;
constexpr int P0_UNITS = P0_XN + P0_WIN + P0_WOUT + P0_WQ + P0_UV + P0_SK + P0_LB;

DEVI void phase0_unit(const Params& p, int u, char* smem) {
    const int tid = threadIdx.x, lane = tid & 63, w = tid >> 6;
    unsigned char* ws = p.ws;
    if (u < P0_XN) {
        const int row = u * 4 + w;
        rms_row_bf16(p.x + (size_t)row * DM, p.norm1_g, reinterpret_cast<bf16_t*>(ws + OFF_XN) + (size_t)row * DM, lane);
        return;
    }
    u -= P0_XN;
    if (u < P0_WIN) { transpose_tile(p.w_in, 3600, reinterpret_cast<bf16_t*>(ws + OFF_WIN), u / 16, u % 16, 1, reinterpret_cast<float*>(smem)); return; }
    u -= P0_WIN;
    if (u < P0_WOUT) { transpose_tile(p.w_out, 1024, reinterpret_cast<bf16_t*>(ws + OFF_WOUT), u / 16, u % 16, 0, reinterpret_cast<float*>(smem)); return; }
    u -= P0_WOUT;
    if (u < P0_WQ) { transpose_tile(p.w_q, 2048, reinterpret_cast<bf16_t*>(ws + OFF_WQ), u / 16, u % 16, 0, reinterpret_cast<float*>(smem)); return; }
    u -= P0_WQ;
    if (u < P0_UV) {
        const bool isv = u >= 4096; const int row = (isv ? u - 4096 : u) * 4 + w;
        quant_row_fp8((isv ? p.peer_v : p.peer_u) + (size_t)row * DM, ws + (isv ? OFF_V8 : OFF_U8) + (size_t)row * DM,
                      reinterpret_cast<float*>(ws + (isv ? OFF_VS : OFF_US)) + row, lane);
        return;
    }
    u -= P0_UV;
    if (u < P0_SK) { convert8(p.sub_keys, reinterpret_cast<bf16_t*>(ws + OFF_SK), (size_t)u * 256 + tid); return; }
    float* lb = reinterpret_cast<float*>(ws + OFF_LB);
    for (int n = tid; n < 512; n += 256) {
        const float l0 = p.hg_lower[n], l1 = p.hg_lower[512 + n];
        const float mx = fmaxf(l0, l1); const float e0 = __expf(l0 - mx), e1 = __expf(l1 - mx);
        lb[n] = e0 / (e0 + e1);
    }
}

template <bool SW>
DEVI void gemm_tile(const bf16_t* __restrict__ A, const bf16_t* __restrict__ Bt, int K, int m0, int n0, char* smem, f32x4 (&acc)[4][4]) {
    const int tid = threadIdx.x, lane = tid & 63, w = tid >> 6, wm = w >> 1, wn = w & 1;
#pragma unroll
    for (int i = 0; i < 4; ++i)
#pragma unroll
        for (int j = 0; j < 4; ++j) acc[i][j] = f32x4{0.f, 0.f, 0.f, 0.f};
    const int lrow = tid >> 3, lch = tid & 7;
    const bf16_t* ga = A + (size_t)(m0 + lrow) * K + lch * 8;
    const bf16_t* gb = Bt + (size_t)(n0 + lrow) * K + lch * 8;
    const int lds_off = lrow * 128 + ((lch ^ (lrow & 7)) << 4);
    const int fr_base = (lane & 15) * 128;
    const int xo0 = (((lane >> 4)) ^ (lane & 7)) << 4;
    const int xo1 = ((4 + (lane >> 4)) ^ (lane & 7)) << 4;
    uint4 ra[4], rb[4];
    const int nk = K >> 6;
#pragma unroll
    for (int i = 0; i < 4; ++i) { ra[i] = *reinterpret_cast<const uint4*>(ga + (size_t)i * 32 * K); rb[i] = *reinterpret_cast<const uint4*>(gb + (size_t)i * 32 * K); }
#pragma unroll
    for (int i = 0; i < 4; ++i) { *reinterpret_cast<uint4*>(smem + lds_off + i * 4096) = ra[i]; *reinterpret_cast<uint4*>(smem + 16384 + lds_off + i * 4096) = rb[i]; }
    __syncthreads();
    for (int kt = 0; kt < nk; ++kt) {
        const char* sA = smem + (kt & 1) * 32768;
        const char* sB = sA + 16384;
        if (kt + 1 < nk) {
#pragma unroll
            for (int i = 0; i < 4; ++i) { ra[i] = *reinterpret_cast<const uint4*>(ga + (size_t)i * 32 * K + (kt + 1) * 64); rb[i] = *reinterpret_cast<const uint4*>(gb + (size_t)i * 32 * K + (kt + 1) * 64); }
        }
#pragma unroll
        for (int ks = 0; ks < 2; ++ks) {
            const int xo = ks ? xo1 : xo0;
            bf16x8 af[4], bfr[4];
#pragma unroll
            for (int i = 0; i < 4; ++i) {
                af[i] = *reinterpret_cast<const bf16x8*>(sA + (wm * 64 + i * 16) * 128 + fr_base + xo);
                bfr[i] = *reinterpret_cast<const bf16x8*>(sB + (wn * 64 + i * 16) * 128 + fr_base + xo);
            }
#pragma unroll
            for (int i = 0; i < 4; ++i)
#pragma unroll
                for (int j = 0; j < 4; ++j) acc[i][j] = SW ? mfma16(bfr[j], af[i], acc[i][j]) : mfma16(af[i], bfr[j], acc[i][j]);
        }
        if (kt + 1 < nk) {
            char* dA = smem + ((kt + 1) & 1) * 32768;
#pragma unroll
            for (int i = 0; i < 4; ++i) { *reinterpret_cast<uint4*>(dA + lds_off + i * 4096) = ra[i]; *reinterpret_cast<uint4*>(dA + 16384 + lds_off + i * 4096) = rb[i]; }
        }
        __syncthreads();
    }
}

constexpr int P1_NT = IN_WP / 128;
constexpr int P1_UNITS = (M_TOK / 128) * P1_NT;

template <typename F>
DEVI void store_sw_bf16(const f32x4 (&acc)[4][4], bf16_t* dst, int ld, int m0, int ncol0, F f) {
    const int lane = threadIdx.x & 63, w = threadIdx.x >> 6, wm = w >> 1, wn = w & 1;
#pragma unroll
    for (int mi = 0; mi < 4; ++mi)
#pragma unroll
        for (int ni = 0; ni < 4; ++ni) {
            const int m = m0 + wm * 64 + mi * 16 + (lane & 15);
            const int n = ncol0 + wn * 64 + ni * 16 + 4 * (lane >> 4);
            uint2 o; o.x = pack2(f(acc[mi][ni][0], n), f(acc[mi][ni][1], n + 1)); o.y = pack2(f(acc[mi][ni][2], n + 2), f(acc[mi][ni][3], n + 3));
            *reinterpret_cast<uint2*>(dst + (size_t)m * ld + n) = o;
        }
}
DEVI void store_ns_T(const f32x4 (&acc)[4][4], bf16_t* dst, int ncols, int m0, int ncol0) {
    const int lane = threadIdx.x & 63, w = threadIdx.x >> 6, wm = w >> 1, wn = w & 1;
#pragma unroll
    for (int mi = 0; mi < 4; ++mi)
#pragma unroll
        for (int ni = 0; ni < 4; ++ni) {
            const int m = m0 + wm * 64 + mi * 16 + 4 * (lane >> 4);
            const int n = ncol0 + wn * 64 + ni * 16 + (lane & 15);
            uint2 o; o.x = pack2(acc[mi][ni][0], acc[mi][ni][1]); o.y = pack2(acc[mi][ni][2], acc[mi][ni][3]);
            *reinterpret_cast<uint2*>(dst + ((size_t)(m >> 6) * ncols + n) * 64 + (m & 63)) = o;
        }
}

DEVI void phase1_unit(const Params& p, int u, char* smem) {
    unsigned char* ws = p.ws;
    const int mt = u / P1_NT, nt = u % P1_NT;
    const int m0 = mt * 128, n0 = nt * 128;
    const bf16_t* A = reinterpret_cast<const bf16_t*>(ws + OFF_XN);
    const bf16_t* Bt = reinterpret_cast<const bf16_t*>(ws + OFF_WIN);
    f32x4 acc[4][4];
    const bool ns = (n0 >= 1024 && n0 < 1536) || (n0 >= 2560 && n0 < 3072);
    if (ns) {
        gemm_tile<false>(A, Bt, 1024, m0, n0, smem, acc);
        if (n0 < 1536) store_ns_T(acc, reinterpret_cast<bf16_t*>(ws + OFF_HVT), 512, m0, n0 - 1024);
        else store_ns_T(acc, reinterpret_cast<bf16_t*>(ws + OFF_GVT), 512, m0, n0 - 2560);
        return;
    }
    gemm_tile<true>(A, Bt, 1024, m0, n0, smem, acc);
    if (n0 < 512) {
        store_sw_bf16(acc, reinterpret_cast<bf16_t*>(ws + OFF_HQ), 512, m0, n0, [](float v, int) { return silu_f(v); });
    } else if (n0 < 1024) {
        const float* lb = reinterpret_cast<const float*>(ws + OFF_LB);
        store_sw_bf16(acc, reinterpret_cast<bf16_t*>(ws + OFF_HLF), 512, m0, n0 - 512, [lb](float v, int n) {
            const float l = lb[n]; const float fg = l + (1.f - l) / (1.f + __expf(-v)); return __logf(fg); });
    } else if (n0 < 2048) {
        store_sw_bf16(acc, reinterpret_cast<bf16_t*>(ws + OFF_HG), 512, m0, n0 - 1536, [](float v, int) { return silu_f(v); });
    } else if (n0 < 2304) {
        store_sw_bf16(acc, reinterpret_cast<bf16_t*>(ws + OFF_GQ), 256, m0, n0 - 2048, [](float v, int) { return v * 0.125f; });
    } else if (n0 < 2560) {
        store_sw_bf16(acc, reinterpret_cast<bf16_t*>(ws + OFF_GK), 256, m0, n0 - 2304, [](float v, int) { return v; });
    } else if (n0 < 3584) {
        store_sw_bf16(acc, reinterpret_cast<bf16_t*>(ws + OFF_GG), 512, m0, n0 - 3072, [](float v, int) { return silu_f(v); });
    } else {
        const int lane = threadIdx.x & 63, w = threadIdx.x >> 6, wm = w >> 1, wn = w & 1;
        if (wn == 0) {
            float* gl = reinterpret_cast<float*>(ws + OFF_GLOW);
#pragma unroll
            for (int mi = 0; mi < 4; ++mi) {
                const int m = m0 + wm * 64 + mi * 16 + (lane & 15);
                const int n = 4 * (lane >> 4);
                *reinterpret_cast<float4*>(gl + (size_t)m * 16 + n) = make_float4(acc[mi][0][0], acc[mi][0][1], acc[mi][0][2], acc[mi][0][3]);
            }
        }
    }
}

constexpr int P2_UNITS = 512 * 3;
DEVI float logsigmoid_f(float z) { return fminf(z, 0.f) - __logf(1.f + __expf(-fabsf(z))); }

DEVI void phase2_unit(const Params& p, int u, char* smem) {
    unsigned char* ws = p.ws;
    const int tid = threadIdx.x;
    const int cidx = u / 3, part = u % 3;
    const size_t row0 = (size_t)cidx * 64;
    if (part < 2) {
        const int n = part * 256 + tid;
        bf16_t* HQ = reinterpret_cast<bf16_t*>(ws + OFF_HQ);
        bf16_t* HLF = reinterpret_cast<bf16_t*>(ws + OFF_HLF);
        bf16_t* KT = reinterpret_cast<bf16_t*>(ws + OFF_KTH);
        float Gl = 0.f;
#pragma unroll 8
        for (int r = 0; r < 64; ++r) Gl += bf2f(HLF[(row0 + r) * 512 + n]);
        float G = 0.f;
        for (int r8 = 0; r8 < 8; ++r8) {
            unsigned pk[4];
#pragma unroll
            for (int rr = 0; rr < 8; ++rr) {
                const size_t idx = (row0 + r8 * 8 + rr) * 512 + n;
                const float lf = bf2f(HLF[idx]);
                G += lf;
                const float key = 1.f - __expf(lf);
                const float q = bf2f(HQ[idx]);
                const unsigned short bq = f2bf(q * __expf(G));
                const unsigned short bk = f2bf(key * __expf(-G));
                HQ[idx] = bq; HLF[idx] = bk;
                if (rr & 1) pk[rr >> 1] |= ((unsigned)bk << 16); else pk[rr >> 1] = bk;
            }
            *reinterpret_cast<uint4*>(KT + ((size_t)cidx * 512 + n) * 64 + r8 * 8) = make_uint4(pk[0], pk[1], pk[2], pk[3]);
        }
        reinterpret_cast<float*>(ws + OFF_DECH)[(size_t)cidx * 512 + n] = __expf(Gl);
    } else {
        const int n = tid;
        bf16_t* GQ = reinterpret_cast<bf16_t*>(ws + OFF_GQ);
        bf16_t* GK = reinterpret_cast<bf16_t*>(ws + OFF_GK);
        bf16_t* KT = reinterpret_cast<bf16_t*>(ws + OFF_KTG);
        const float* GL = reinterpret_cast<const float*>(ws + OFF_GLOW);
        float wg[16];
#pragma unroll
        for (int j = 0; j < 16; ++j) wg[j] = p.gla_wg[j * 256 + n];
        const float bg = p.gla_bg[n];
        float Gl = 0.f;
        for (int r = 0; r < 64; ++r) {
            const float4* g4 = reinterpret_cast<const float4*>(GL + (row0 + r) * 16);
            float z = bg;
#pragma unroll
            for (int j = 0; j < 4; ++j) { const float4 t = g4[j]; z += t.x * wg[4 * j] + t.y * wg[4 * j + 1] + t.z * wg[4 * j + 2] + t.w * wg[4 * j + 3]; }
            Gl += logsigmoid_f(z) * (1.f / 16.f);
        }
        float G = 0.f;
        for (int r8 = 0; r8 < 8; ++r8) {
            unsigned pk[4];
#pragma unroll
            for (int rr = 0; rr < 8; ++rr) {
                const size_t row = row0 + r8 * 8 + rr;
                const float4* g4 = reinterpret_cast<const float4*>(GL + row * 16);
                float z = bg;
#pragma unroll
                for (int j = 0; j < 4; ++j) { const float4 t = g4[j]; z += t.x * wg[4 * j] + t.y * wg[4 * j + 1] + t.z * wg[4 * j + 2] + t.w * wg[4 * j + 3]; }
                G += logsigmoid_f(z) * (1.f / 16.f);
                const size_t idx = row * 256 + n;
                const unsigned short bq = f2bf(bf2f(GQ[idx]) * __expf(G));
                const unsigned short bk = f2bf(bf2f(GK[idx]) * __expf(-G));
                GQ[idx] = bq; GK[idx] = bk;
                if (rr & 1) pk[rr >> 1] |= ((unsigned)bk << 16); else pk[rr >> 1] = bk;
            }
            *reinterpret_cast<uint4*>(KT + ((size_t)cidx * 256 + n) * 64 + r8 * 8) = make_uint4(pk[0], pk[1], pk[2], pk[3]);
        }
        reinterpret_cast<float*>(ws + OFF_DECG)[(size_t)cidx * 256 + n] = __expf(Gl);
    }
}

constexpr int P3_UNITS = 4096;
template <int DK>
DEVI void kv_unit(const Params& p, int sidx, int c) {
    unsigned char* ws = p.ws;
    const int lane = threadIdx.x & 63, w = threadIdx.x >> 6;
    const int b = sidx >> 2, h = sidx & 3;
    const int cidx = b * 128 + c;
    constexpr int NDB = DK / 16;
    const bf16_t* KT = reinterpret_cast<const bf16_t*>(ws + (DK == 128 ? OFF_KTH : OFF_KTG)) + ((size_t)cidx * (4 * DK) + h * DK) * 64;
    const bf16_t* VT = reinterpret_cast<const bf16_t*>(ws + (DK == 128 ? OFF_HVT : OFF_GVT)) + ((size_t)cidx * 512 + h * 128) * 64;
    const float* DEC = reinterpret_cast<const float*>(ws + (DK == 128 ? OFF_DECH : OFF_DECG)) + (size_t)cidx * (4 * DK) + h * DK;
    bf16_t* ST = reinterpret_cast<bf16_t*>(reinterpret_cast<unsigned char*>(p.out) + (DK == 128 ? OUT_STH : OUT_STG)) + ((size_t)sidx * 128 + c) * (128 * DK);
    f32x4 acc[NDB][2];
#pragma unroll
    for (int i = 0; i < NDB; ++i) { acc[i][0] = f32x4{0, 0, 0, 0}; acc[i][1] = f32x4{0, 0, 0, 0}; }
    const int fo = (lane & 15) * 64 + 8 * (lane >> 4);
#pragma unroll
    for (int ks = 0; ks < 2; ++ks) {
        bf16x8 bv[2];
#pragma unroll
        for (int nb = 0; nb < 2; ++nb) bv[nb] = ldg_frag(VT + (size_t)(32 * w + nb * 16) * 64 + fo + ks * 32);
#pragma unroll
        for (int db = 0; db < NDB; ++db) {
            const bf16x8 ak = ldg_frag(KT + (size_t)(db * 16) * 64 + fo + ks * 32);
            acc[db][0] = mfma16(ak, bv[0], acc[db][0]);
            acc[db][1] = mfma16(ak, bv[1], acc[db][1]);
        }
    }
#pragma unroll
    for (int db = 0; db < NDB; ++db) {
        const int d = db * 16 + 4 * (lane >> 4);
        const float4 dc = *reinterpret_cast<const float4*>(DEC + d);
#pragma unroll
        for (int nb = 0; nb < 2; ++nb) {
            const int dv = 32 * w + nb * 16 + (lane & 15);
            uint2 o; o.x = pack2(acc[db][nb][0] * dc.x, acc[db][nb][1] * dc.y); o.y = pack2(acc[db][nb][2] * dc.z, acc[db][nb][3] * dc.w);
            *reinterpret_cast<uint2*>(ST + (size_t)dv * DK + d) = o;
        }
    }
}
DEVI void phase3_unit(const Params& p, int u, char* smem) {
    if (u < 2048) kv_unit<128>(p, u >> 7, u & 127); else { u -= 2048; kv_unit<64>(p, u >> 7, u & 127); }
}

constexpr int P4_UNITS = 384;
DEVI void phase4_unit(const Params& p, int u, char* smem) {
    unsigned char* ws = p.ws;
    int e = u * 256 + threadIdx.x;
    bf16_t* base; const float* dec; size_t cstride; int decstride;
    if (e < 65536) {
        const int sidx = e >> 12, rem = e & 4095, dv = rem >> 5, d4 = (rem & 31) * 4;
        const int b = sidx >> 2, h = sidx & 3;
        base = reinterpret_cast<bf16_t*>(reinterpret_cast<unsigned char*>(p.out) + OUT_STH) + ((size_t)sidx * 128) * 16384 + dv * 128 + d4;
        cstride = 16384;
        dec = reinterpret_cast<const float*>(ws + OFF_DECH) + (size_t)(b * 128) * 512 + h * 128 + d4; decstride = 512;
    } else {
        e -= 65536;
        const int sidx = e >> 11, rem = e & 2047, dv = rem >> 4, d4 = (rem & 15) * 4;
        const int b = sidx >> 2, h = sidx & 3;
        base = reinterpret_cast<bf16_t*>(reinterpret_cast<unsigned char*>(p.out) + OUT_STG) + ((size_t)sidx * 128) * 8192 + dv * 64 + d4;
        cstride = 8192;
        dec = reinterpret_cast<const float*>(ws + OFF_DECG) + (size_t)(b * 128) * 256 + h * 64 + d4; decstride = 256;
    }
    float s0 = 0.f, s1 = 0.f, s2 = 0.f, s3 = 0.f;
    for (int c8 = 0; c8 < 128; c8 += 8) {
        uint2 kv[8]; float4 dc[8];
#pragma unroll
        for (int i = 0; i < 8; ++i) { kv[i] = *reinterpret_cast<const uint2*>(base + (size_t)(c8 + i) * cstride); dc[i] = *reinterpret_cast<const float4*>(dec + (size_t)(c8 + i) * decstride); }
#pragma unroll
        for (int i = 0; i < 8; ++i) {
            uint2 o; o.x = pack2(s0, s1); o.y = pack2(s2, s3);
            *reinterpret_cast<uint2*>(base + (size_t)(c8 + i) * cstride) = o;
            s0 = dc[i].x * s0 + bflo(kv[i].x); s1 = dc[i].y * s1 + bfhi(kv[i].x);
            s2 = dc[i].z * s2 + bflo(kv[i].y); s3 = dc[i].w * s3 + bfhi(kv[i].y);
        }
    }
}

constexpr int P5_UNITS = 4096;
constexpr int PL_PITCH = 72;
template <int DK>
DEVI void out_unit(const Params& p, int sidx, int c, char* smem) {
    unsigned char* ws = p.ws;
    const int lane = threadIdx.x & 63, w = threadIdx.x >> 6;
    const int b = sidx >> 2, h = sidx & 3;
    const int cidx = b * 128 + c;
    const size_t row0 = (size_t)cidx * 64;
    constexpr int LDQ = 4 * DK;
    const bf16_t* Qn = reinterpret_cast<const bf16_t*>(ws + (DK == 128 ? OFF_HQ : OFF_GQ)) + row0 * LDQ + h * DK;
    const bf16_t* Kn = reinterpret_cast<const bf16_t*>(ws + (DK == 128 ? OFF_HLF : OFF_GK)) + row0 * LDQ + h * DK;
    const bf16_t* VT = reinterpret_cast<const bf16_t*>(ws + (DK == 128 ? OFF_HVT : OFF_GVT)) + ((size_t)cidx * 512 + h * 128) * 64;
    const bf16_t* ST = reinterpret_cast<const bf16_t*>(reinterpret_cast<const unsigned char*>(p.out) + (DK == 128 ? OUT_STH : OUT_STG)) + ((size_t)sidx * 128 + c) * (128 * DK);
    const bf16_t* GATE = reinterpret_cast<const bf16_t*>(ws + (DK == 128 ? OFF_HG : OFF_GG)) + row0 * 512 + h * 128;
    const float* ng = (DK == 128) ? p.hg_norm_g : p.gla_norm_g;
    bf16_t* MIX = reinterpret_cast<bf16_t*>(ws + OFF_MIX) + row0 * 1024 + (DK == 128 ? 0 : 512) + h * 128;
    bf16_t* PL = reinterpret_cast<bf16_t*>(smem);
    float* RED = reinterpret_cast<float*>(smem + 64 * PL_PITCH * 2);

    const int l15 = lane & 15, lg = lane >> 4;
    {
        bf16x8 bq[DK / 32];
#pragma unroll
        for (int ks = 0; ks < DK / 32; ++ks) bq[ks] = ldg_frag(Qn + (size_t)(w * 16 + l15) * LDQ + ks * 32 + 8 * lg);
#pragma unroll
        for (int jb = 0; jb < 4; ++jb) {
            f32x4 a = f32x4{0, 0, 0, 0};
            if (jb <= w) {
#pragma unroll
                for (int ks = 0; ks < DK / 32; ++ks) {
                    const bf16x8 ak = ldg_frag(Kn + (size_t)(jb * 16 + l15) * LDQ + ks * 32 + 8 * lg);
                    a = mfma16(ak, bq[ks], a);
                }
            }
            const int i = w * 16 + l15, j0 = jb * 16 + 4 * lg;
            const float v0 = (j0 + 0 <= i) ? a[0] : 0.f, v1 = (j0 + 1 <= i) ? a[1] : 0.f, v2 = (j0 + 2 <= i) ? a[2] : 0.f, v3 = (j0 + 3 <= i) ? a[3] : 0.f;
            uint2 o; o.x = pack2(v0, v1); o.y = pack2(v2, v3);
            *reinterpret_cast<uint2*>(PL + i * PL_PITCH + j0) = o;
        }
    }
    __syncthreads();
    f32x4 acc[2][4];
#pragma unroll
    for (int x = 0; x < 2; ++x)
#pragma unroll
        for (int y = 0; y < 4; ++y) acc[x][y] = f32x4{0, 0, 0, 0};
#pragma unroll
    for (int ks = 0; ks < 2; ++ks) {
        bf16x8 av[2], bp[4];
#pragma unroll
        for (int x = 0; x < 2; ++x) av[x] = ldg_frag(VT + (size_t)((2 * w + x) * 16 + l15) * 64 + ks * 32 + 8 * lg);
#pragma unroll
        for (int y = 0; y < 4; ++y) bp[y] = *reinterpret_cast<const bf16x8*>(PL + (y * 16 + l15) * PL_PITCH + ks * 32 + 8 * lg);
#pragma unroll
        for (int x = 0; x < 2; ++x)
#pragma unroll
            for (int y = 0; y < 4; ++y) acc[x][y] = mfma16(av[x], bp[y], acc[x][y]);
    }
#pragma unroll
    for (int ks = 0; ks < DK / 32; ++ks) {
        bf16x8 as[2], bq[4];
#pragma unroll
        for (int x = 0; x < 2; ++x) as[x] = ldg_frag(ST + (size_t)((2 * w + x) * 16 + l15) * DK + ks * 32 + 8 * lg);
#pragma unroll
        for (int y = 0; y < 4; ++y) bq[y] = ldg_frag(Qn + (size_t)(y * 16 + l15) * LDQ + ks * 32 + 8 * lg);
#pragma unroll
        for (int x = 0; x < 2; ++x)
#pragma unroll
            for (int y = 0; y < 4; ++y) acc[x][y] = mfma16(as[x], bq[y], acc[x][y]);
    }
    float ssq[4];
#pragma unroll
    for (int y = 0; y < 4; ++y) {
        float s = 0.f;
#pragma unroll
        for (int x = 0; x < 2; ++x)
#pragma unroll
            for (int r = 0; r < 4; ++r) s += acc[x][y][r] * acc[x][y][r];
        s += __shfl_xor(s, 16); s += __shfl_xor(s, 32);
        ssq[y] = s;
    }
    if (lg == 0) {
#pragma unroll
        for (int y = 0; y < 4; ++y) RED[w * 64 + y * 16 + l15] = ssq[y];
    }
    __syncthreads();
#pragma unroll
    for (int y = 0; y < 4; ++y) {
        const int i = y * 16 + l15;
        const float tot = RED[i] + RED[64 + i] + RED[128 + i] + RED[192 + i];
        const float rstd = rsqrtf(tot * (1.f / 128.f) + 1e-6f);
#pragma unroll
        for (int x = 0; x < 2; ++x) {
            const int dv = (2 * w + x) * 16 + 4 * lg;
            const float4 g4 = *reinterpret_cast<const float4*>(ng + dv);
            const uint2 gt = *reinterpret_cast<const uint2*>(GATE + (size_t)i * 512 + dv);
            uint2 o;
            o.x = pack2(acc[x][y][0] * rstd * g4.x * bflo(gt.x), acc[x][y][1] * rstd * g4.y * bfhi(gt.x));
            o.y = pack2(acc[x][y][2] * rstd * g4.z * bflo(gt.y), acc[x][y][3] * rstd * g4.w * bfhi(gt.y));
            *reinterpret_cast<uint2*>(MIX + (size_t)i * 1024 + dv) = o;
        }
    }
    __syncthreads();
}
DEVI void phase5_unit(const Params& p, int u, char* smem) {
    if (u < 2048) out_unit<128>(p, u >> 7, u & 127, smem); else { u -= 2048; out_unit<64>(p, u >> 7, u & 127, smem); }
}

constexpr int P6_UNITS = (M_TOK / 128) * 8;
DEVI void phase6_unit(const Params& p, int u, char* smem) {
    unsigned char* ws = p.ws;
    const int mt = u >> 3, nt = u & 7;
    const int m0 = mt * 128, n0 = nt * 128;
    f32x4 acc[4][4];
    gemm_tile<true>(reinterpret_cast<const bf16_t*>(ws + OFF_MIX), reinterpret_cast<const bf16_t*>(ws + OFF_WOUT), 1024, m0, n0, smem, acc);
    const int lane = threadIdx.x & 63, w = threadIdx.x >> 6, wm = w >> 1, wn = w & 1;
#pragma unroll
    for (int mi = 0; mi < 4; ++mi)
#pragma unroll
        for (int ni = 0; ni < 4; ++ni) {
            const int m = m0 + wm * 64 + mi * 16 + (lane & 15);
            const int n = n0 + wn * 64 + ni * 16 + 4 * (lane >> 4);
            const float4 xv = *reinterpret_cast<const float4*>(p.x + (size_t)m * DM + n);
            *reinterpret_cast<float4*>(p.out + (size_t)m * DM + n) = make_float4(xv.x + acc[mi][ni][0], xv.y + acc[mi][ni][1], xv.z + acc[mi][ni][2], xv.w + acc[mi][ni][3]);
        }
}

constexpr int P7_UNITS = 8192;
DEVI void phase7_unit(const Params& p, int u, char* smem) {
    const int lane = threadIdx.x & 63, w = threadIdx.x >> 6;
    const int row = u * 4 + w;
    rms_row_bf16(p.out + (size_t)row * DM, p.norm2_g, reinterpret_cast<bf16_t*>(p.ws + OFF_HN) + (size_t)row * DM, lane);
}

constexpr int P8_UNITS = (M_TOK / 128) * 16;
DEVI void phase8_unit(const Params& p, int u, char* smem) {
    unsigned char* ws = p.ws;
    const int mt = u >> 4, nt = u & 15;
    f32x4 acc[4][4];
    gemm_tile<true>(reinterpret_cast<const bf16_t*>(ws + OFF_HN), reinterpret_cast<const bf16_t*>(ws + OFF_WQ), 1024, mt * 128, nt * 128, smem, acc);
    store_sw_bf16(acc, reinterpret_cast<bf16_t*>(ws + OFF_Q), 2048, mt * 128, nt * 128, [](float v, int) { return v; });
}

using f32x16 = __attribute__((ext_vector_type(16))) float;
DEVI f32x16 mfma32(bf16x8 a, bf16x8 b, f32x16 c) { return __builtin_amdgcn_mfma_f32_32x32x16_bf16(a, b, c, 0, 0, 0); }
DEVI unsigned umax(unsigned a, unsigned b) { return a > b ? a : b; }
DEVI unsigned umin(unsigned a, unsigned b) { return a > b ? b : a; }
DEVI unsigned f2ord(float f) { const unsigned u = __float_as_uint(f); return u ^ ((unsigned)((int)u >> 31) | 0x80000000u); }
DEVI float ord2f(unsigned k) { return __uint_as_float((k & 0x80000000u) ? (k ^ 0x80000000u) : ~k); }

template <int BASE>
DEVI void sort16_desc(unsigned (&x)[64]) {
#pragma unroll
    for (int k = 2; k <= 16; k <<= 1) {
#pragma unroll
        for (int j = k >> 1; j > 0; j >>= 1) {
#pragma unroll
            for (int i = 0; i < 16; ++i) {
                const int l = i ^ j;
                if (l > i) {
                    const bool desc = ((i & k) == 0);
                    const unsigned a = x[BASE + i], b = x[BASE + l];
                    const unsigned hi = umax(a, b), lo = umin(a, b);
                    x[BASE + i] = desc ? hi : lo; x[BASE + l] = desc ? lo : hi;
                }
            }
        }
    }
}
template <int BASE>
DEVI void bmerge16_desc(unsigned (&x)[64]) {
#pragma unroll
    for (int j = 8; j > 0; j >>= 1) {
#pragma unroll
        for (int i = 0; i < 16; ++i) {
            const int l = i ^ j;
            if (l > i) { const unsigned a = x[BASE + i], b = x[BASE + l]; x[BASE + i] = umax(a, b); x[BASE + l] = umin(a, b); }
        }
    }
}
DEVI void top16_of_64(unsigned (&x)[64]) {
    sort16_desc<0>(x); sort16_desc<16>(x); sort16_desc<32>(x); sort16_desc<48>(x);
#pragma unroll
    for (int i = 0; i < 16; ++i) x[i] = umax(x[i], x[31 - i]);
    bmerge16_desc<0>(x);
#pragma unroll
    for (int i = 0; i < 16; ++i) x[32 + i] = umax(x[32 + i], x[63 - i]);
    bmerge16_desc<32>(x);
#pragma unroll
    for (int i = 0; i < 16; ++i) x[i] = umax(x[i], x[47 - i]);
    bmerge16_desc<0>(x);
}

DEVI void scores_top16(const bf16_t* __restrict__ SKp, const bf16_t* __restrict__ Qp, int lane, unsigned (&out)[16]) {
    const int r31 = lane & 31, hh = lane >> 5;
    f32x16 acc[4];
#pragma unroll
    for (int nb = 0; nb < 4; ++nb)
#pragma unroll
        for (int r = 0; r < 16; ++r) acc[nb][r] = 0.f;
#pragma unroll
    for (int ks = 0; ks < 8; ++ks) {
        const bf16x8 bq = ldg_frag(Qp + (size_t)r31 * 2048 + ks * 16 + 8 * hh);
#pragma unroll
        for (int nb = 0; nb < 4; ++nb) {
            const bf16x8 ak = ldg_frag(SKp + (size_t)(nb * 32 + r31) * 128 + ks * 16 + 8 * hh);
            acc[nb] = mfma32(ak, bq, acc[nb]);
        }
    }
    unsigned x[64];
    const unsigned hx = (unsigned)hh * 4u;
#pragma unroll
    for (int nb = 0; nb < 4; ++nb)
#pragma unroll
        for (int r = 0; r < 16; ++r) {
            const int nbase = nb * 32 + (r & 3) + 8 * (r >> 2);
            x[nb * 16 + r] = ((f2ord(acc[nb][r]) & ~127u) | (unsigned)(127 - nbase)) ^ hx;
        }
    top16_of_64(x);
    unsigned lo[16], hi[16];
#pragma unroll
    for (int i = 0; i < 16; ++i) { auto rr = __builtin_amdgcn_permlane32_swap(x[i], x[i], false, false); lo[i] = rr[0]; hi[i] = rr[1]; }
#pragma unroll
    for (int i = 0; i < 16; ++i) x[i] = umax(lo[i], hi[15 - i]);
    bmerge16_desc<0>(x);
#pragma unroll
    for (int i = 0; i < 16; ++i) out[i] = x[i];
}

constexpr int P9_UNITS = (M_TOK / 128) * 8;
DEVI void phase9_unit(const Params& p, int u, char* smem) {
    unsigned char* ws = p.ws;
    const int tid = threadIdx.x, lane = tid & 63, w = tid >> 6;
    const int tg = u >> 3, h = u & 7;
    const int t0 = tg * 128 + w * 32;
    const int hh = lane >> 5;
    unsigned* KL = reinterpret_cast<unsigned*>(smem) + w * 2048;
    const bf16_t* SK = reinterpret_cast<const bf16_t*>(ws + OFF_SK) + (size_t)(h * 2) * 128 * 128;
    const bf16_t* Q = reinterpret_cast<const bf16_t*>(ws + OFF_Q) + (size_t)t0 * 2048 + h * 256;
    unsigned k0[16], k1[16];
    scores_top16(SK, Q, lane, k0);
    scores_top16(SK + 128 * 128, Q + 128, lane, k1);
#pragma unroll
    for (int i = 0; i < 16; ++i) { KL[i * 64 + lane] = k0[i]; KL[(16 + i) * 64 + lane] = k1[i]; }
    float s0[16], s1[16];
#pragma unroll
    for (int i = 0; i < 16; ++i) { s0[i] = ord2f(k0[i] & ~127u); s1[i] = ord2f(k1[i] & ~127u); }
    unsigned x[64];
    {
        int n = 0;
#pragma unroll
        for (int a = 0; a < 16; ++a)
#pragma unroll
            for (int b = 0; b < 16; ++b)
                if ((a + 1) * (b + 1) <= 16) { x[n] = (f2ord(s0[a] + s1[b]) & ~255u) | (unsigned)(255 - (a * 16 + b)); ++n; }
#pragma unroll
        for (int i = 50; i < 64; ++i) x[i] = 0u;
    }
    top16_of_64(x);
    float cv[16]; int ex[16];
#pragma unroll
    for (int i = 0; i < 16; ++i) {
        cv[i] = ord2f(x[i] & ~255u);
        const int cid = 255 - (int)(x[i] & 255u);
        const unsigned ka = KL[(cid >> 4) * 64 + lane], kb = KL[(16 + (cid & 15)) * 64 + lane];
        ex[i] = (127 - (int)(ka & 127u)) * 128 + (127 - (int)(kb & 127u));
    }
    float sum = 0.f;
    const float mx = cv[0];
#pragma unroll
    for (int i = 0; i < 16; ++i) cv[i] = __expf(cv[i] - mx);
#pragma unroll
    for (int i = 0; i < 16; ++i) sum += cv[i];
    const float inv = 1.f / sum;
    const size_t orow = (size_t)(t0 + (lane & 31)) * 128 + h * 16;
    if (hh == 0) {
        int4* d = reinterpret_cast<int4*>(reinterpret_cast<int*>(ws + OFF_EIDX) + orow);
#pragma unroll
        for (int i = 0; i < 4; ++i) d[i] = make_int4(ex[4 * i], ex[4 * i + 1], ex[4 * i + 2], ex[4 * i + 3]);
    } else {
        float4* d = reinterpret_cast<float4*>(reinterpret_cast<float*>(ws + OFF_EW) + orow);
#pragma unroll
        for (int i = 0; i < 4; ++i) d[i] = make_float4(cv[4 * i] * inv, cv[4 * i + 1] * inv, cv[4 * i + 2] * inv, cv[4 * i + 3] * inv);
    }
}

using f32x2 = __attribute__((ext_vector_type(2))) float;
DEVI float dot16_fp8(const uint4 r, const float (&hn)[16]) {
    const unsigned wd[4] = {r.x, r.y, r.z, r.w};
    float s = 0.f;
#pragma unroll
    for (int j = 0; j < 4; ++j) {
        const f32x2 lo = __builtin_amdgcn_cvt_pk_f32_fp8((int)wd[j], false), hi = __builtin_amdgcn_cvt_pk_f32_fp8((int)wd[j], true);
        s += lo[0] * hn[4 * j] + lo[1] * hn[4 * j + 1] + hi[0] * hn[4 * j + 2] + hi[1] * hn[4 * j + 3];
    }
    return s;
}
DEVI void axpy16_fp8(const uint4 r, const float wk, float (&acc)[16]) {
    const unsigned wd[4] = {r.x, r.y, r.z, r.w};
#pragma unroll
    for (int j = 0; j < 4; ++j) {
        const f32x2 lo = __builtin_amdgcn_cvt_pk_f32_fp8((int)wd[j], false), hi = __builtin_amdgcn_cvt_pk_f32_fp8((int)wd[j], true);
        acc[4 * j] += wk * lo[0]; acc[4 * j + 1] += wk * lo[1]; acc[4 * j + 2] += wk * hi[0]; acc[4 * j + 3] += wk * hi[1];
    }
}
DEVI float reduce16(const float (&pd)[16], int lane) {
    float q[8], t[4], v[2];
#pragma unroll
    for (int i = 0; i < 8; ++i) { auto rr = __builtin_amdgcn_permlane32_swap(__float_as_uint(pd[i]), __float_as_uint(pd[i + 8]), false, false); q[i] = __uint_as_float(rr[0]) + __uint_as_float(rr[1]); }
#pragma unroll
    for (int i = 0; i < 4; ++i) { auto rr = __builtin_amdgcn_permlane16_swap(__float_as_uint(q[i]), __float_as_uint(q[i + 4]), false, false); t[i] = __uint_as_float(rr[0]) + __uint_as_float(rr[1]); }
    const bool b3 = (lane & 8) != 0, b2 = (lane & 4) != 0;
#pragma unroll
    for (int i = 0; i < 2; ++i) { const float keep = b3 ? t[i + 2] : t[i], send = b3 ? t[i] : t[i + 2]; v[i] = keep + __shfl_xor(send, 8); }
    const float keep = b2 ? v[1] : v[0], send = b2 ? v[0] : v[1];
    float s = keep + __shfl_xor(send, 4);
    s += __shfl_xor(s, 2);
    s += __shfl_xor(s, 1);
    return s;
}

constexpr int P10_UNITS = 8192;
DEVI void phase10_unit(const Params& p, int u, char* smem) {
    unsigned char* ws = p.ws;
    const int lane = threadIdx.x & 63, w = threadIdx.x >> 6;
    const int m = u * 4 + w;
    const bf16_t* HN = reinterpret_cast<const bf16_t*>(ws + OFF_HN) + (size_t)m * DM;
    const unsigned char* U8 = ws + OFF_U8;
    const unsigned char* V8 = ws + OFF_V8;
    const float* US = reinterpret_cast<const float*>(ws + OFF_US);
    const float* VS = reinterpret_cast<const float*>(ws + OFF_VS);
    const int* EI = reinterpret_cast<const int*>(ws + OFF_EIDX) + (size_t)m * 128;
    const float* EW = reinterpret_cast<const float*>(ws + OFF_EW) + (size_t)m * 128;
    float hn[16];
    {
        const uint4 a = *reinterpret_cast<const uint4*>(HN + 16 * lane), b = *reinterpret_cast<const uint4*>(HN + 16 * lane + 8);
        hn[0] = bflo(a.x); hn[1] = bfhi(a.x); hn[2] = bflo(a.y); hn[3] = bfhi(a.y); hn[4] = bflo(a.z); hn[5] = bfhi(a.z); hn[6] = bflo(a.w); hn[7] = bfhi(a.w);
        hn[8] = bflo(b.x); hn[9] = bfhi(b.x); hn[10] = bflo(b.y); hn[11] = bfhi(b.y); hn[12] = bflo(b.z); hn[13] = bfhi(b.z); hn[14] = bflo(b.w); hn[15] = bfhi(b.w);
    }
    const int e0 = EI[lane], e1 = EI[64 + lane];
    const float us0 = US[e0], us1 = US[e1];
    const float gv0 = EW[lane] * VS[e0], gv1 = EW[64 + lane] * VS[e1];
    float acc[16];
#pragma unroll
    for (int i = 0; i < 16; ++i) acc[i] = 0.f;
    const int E = (lane >> 2) & 15;
#pragma unroll 1
    for (int grp = 0; grp < 8; ++grp) {
        const int ev = grp < 4 ? e0 : e1;
        const int lb = (grp & 3) * 16;
        float pd[16];
#pragma unroll
        for (int k = 0; k < 16; ++k) {
            const int e = __builtin_amdgcn_readlane(ev, lb + k);
            const uint4 r = *reinterpret_cast<const uint4*>(U8 + (size_t)e * DM + 16 * lane);
            pd[k] = dot16_fp8(r, hn);
        }
        float d = reduce16(pd, lane);
        d *= __shfl(grp < 4 ? us0 : us1, lb + E);
        const float act = 0.5f * d * (1.f + erff(d * 0.70710678118654752f));
        const float wl = act * __shfl(grp < 4 ? gv0 : gv1, lb + E);
#pragma unroll
        for (int k = 0; k < 16; ++k) {
            const int e = __builtin_amdgcn_readlane(ev, lb + k);
            const float wk = __uint_as_float((unsigned)__builtin_amdgcn_readlane((int)__float_as_uint(wl), 4 * k));
            const uint4 r = *reinterpret_cast<const uint4*>(V8 + (size_t)e * DM + 16 * lane);
            axpy16_fp8(r, wk, acc);
        }
    }
    float* orow = p.out + (size_t)m * DM + 16 * lane;
    float o[16];
#pragma unroll
    for (int i = 0; i < 4; ++i) { const float4 hv = *reinterpret_cast<const float4*>(orow + 4 * i); o[4 * i] = hv.x + acc[4 * i]; o[4 * i + 1] = hv.y + acc[4 * i + 1]; o[4 * i + 2] = hv.z + acc[4 * i + 2]; o[4 * i + 3] = hv.w + acc[4 * i + 3]; }
    float ss = 0.f;
#pragma unroll
    for (int i = 0; i < 16; ++i) ss += o[i] * o[i];
    ss = wave_sum(ss);
    const float r = rsqrtf(ss * (1.f / 1024.f) + 1e-6f);
    const float* gf = p.norm_f_g + 16 * lane;
#pragma unroll
    for (int i = 0; i < 4; ++i) {
        const float4 g4 = *reinterpret_cast<const float4*>(gf + 4 * i);
        *reinterpret_cast<float4*>(orow + 4 * i) = make_float4(o[4 * i] * r * g4.x, o[4 * i + 1] * r * g4.y, o[4 * i + 2] * r * g4.z, o[4 * i + 3] * r * g4.w);
    }
}

#define XB_TMO      128
#define XB_XCNT(j)  (256  + 64 * (j))
#define XB_XSUB(j)  (1280 + 64 * (j))
#define XB_XGEN(j)  (2304 + 64 * (j))
#define XB_TOP      3328
#define XB_TOPGEN   3392
#define XCD_BAR_WORDS 3456
#define XB_SPIN_CAP (1u << 22)
#define LAS __attribute__((address_space(3)))
DEVI unsigned xb_ld(unsigned* p)              { return __hip_atomic_load(p, __ATOMIC_RELAXED, __HIP_MEMORY_SCOPE_AGENT); }
DEVI unsigned xb_add(unsigned* p, unsigned v) { return __hip_atomic_fetch_add(p, v, __ATOMIC_RELAXED, __HIP_MEMORY_SCOPE_AGENT); }
DEVI unsigned xb_xcc_id() { return (unsigned)__builtin_amdgcn_s_getreg((3 << 11) | 20) & 0xFu; }
#define XB_SPIN(cond, bar) do { unsigned _sp = 0; while (cond) { __builtin_amdgcn_s_sleep(1); \
    if ((++_sp & 255u) == 0u) { if (xb_ld(&(bar)[XB_TMO])) break; if (_sp > XB_SPIN_CAP) { atomicAdd(&(bar)[XB_TMO], 1u); break; } } } } while (0)
struct XcdBarrier { unsigned* bar; unsigned x; volatile LAS unsigned* st; };
DEVI XcdBarrier xcd_barrier_post(unsigned* bar, volatile LAS unsigned* st) {
    XcdBarrier b; b.bar = bar; b.x = xb_xcc_id(); b.st = st;
    if (threadIdx.x == 0) (void)xb_add(&bar[XB_XCNT(b.x)], 1u);
    return b;
}
DEVI void xcd_barrier_complete(unsigned* bar, unsigned x, unsigned& nloc, unsigned& nx) {
    const unsigned G = gridDim.x * gridDim.y * gridDim.z;
    unsigned sum, cnt, mine, sp = 0u;
    for (;;) {
        sum = 0u; cnt = 0u; mine = 0u;
#pragma unroll
        for (unsigned j = 0; j < 16; ++j) { const unsigned c = xb_ld(&bar[XB_XCNT(j)]); sum += c; cnt += (c > 0u) ? 1u : 0u; mine = (j == x) ? c : mine; }
        if (sum == G) break;
        __builtin_amdgcn_s_sleep(1);
        if ((++sp & 255u) == 0u) { if (xb_ld(&bar[XB_TMO])) break; if (sp > XB_SPIN_CAP) { atomicAdd(&bar[XB_TMO], 1u); break; } }
    }
    nloc = mine > 0u ? mine : 1u; nx = cnt > 0u ? cnt : 1u;
}
DEVI void xcd_barrier(const XcdBarrier& b) {
    asm volatile("s_waitcnt vmcnt(0)" ::: "memory");
    __syncthreads();
    if (threadIdx.x == 0) {
        unsigned* bar = b.bar;
        __builtin_amdgcn_s_waitcnt(0);
        unsigned nloc = b.st[0], nx = b.st[1];
        if (nloc == 0u) { xcd_barrier_complete(bar, b.x, nloc, nx); b.st[0] = nloc; b.st[1] = nx; }
        const unsigned old = xb_add(&bar[XB_XSUB(b.x)], 1u);
        const unsigned gen = old / nloc;
        if (old + 1u == (gen + 1u) * nloc) {
            __builtin_amdgcn_fence(__ATOMIC_RELEASE, "agent");
            asm volatile("s_waitcnt vmcnt(0)" ::: "memory");
            const unsigned og = xb_add(&bar[XB_TOP], 1u);
            const unsigned tg = og / nx;
            if (og + 1u == (tg + 1u) * nx) xb_add(&bar[XB_TOPGEN], 1u);
            else XB_SPIN(xb_ld(&bar[XB_TOPGEN]) == tg, bar);
            __builtin_amdgcn_fence(__ATOMIC_ACQUIRE, "agent");
            xb_add(&bar[XB_XGEN(b.x)], 1u);
            asm volatile("s_waitcnt vmcnt(0)" ::: "memory");
        } else {
            XB_SPIN(xb_ld(&bar[XB_XGEN(b.x)]) == gen, bar);
            __builtin_amdgcn_fence(__ATOMIC_ACQUIRE, "agent");
            asm volatile("s_waitcnt vmcnt(0)" ::: "memory");
        }
    }
    __syncthreads();
}

constexpr int N_PHASES = 11;
constexpr int LDS_PHASE_BYTES = 65536;
constexpr int LDS_BYTES = LDS_PHASE_BYTES + 16;

__global__ void __launch_bounds__(256, 2) hymba_fwd(Params p) {
    extern __shared__ __attribute__((aligned(16))) char smem[];
    cg::grid_group grid = cg::this_grid();
    const int lo = p.ph_lo, hi = p.ph_hi;
    volatile LAS unsigned* bst = (volatile LAS unsigned*)(smem + LDS_BYTES - 16);
    if (threadIdx.x == 0) { bst[0] = 0u; bst[1] = 0u; bst[2] = 0u; bst[3] = 0u; }
    __syncthreads();
    XcdBarrier xb = xcd_barrier_post(reinterpret_cast<unsigned*>(p.ws + OFF_BAR), bst);
#define RUN_PHASE(K, FN, N) if (lo <= (K) && (K) < hi) { if ((K) > lo) { if ((K) == lo + 1) grid.sync(); else xcd_barrier(xb); } for (int rep = 0; rep < 1 + ((PROBE_DUP >> (K)) & 1); ++rep) { if (rep) xcd_barrier(xb); for (int u = blockIdx.x; u < (N); u += gridDim.x) FN(p, u, smem); } }
    RUN_PHASE(0, phase0_unit, P0_UNITS)
    RUN_PHASE(1, phase1_unit, P1_UNITS)
    RUN_PHASE(2, phase2_unit, P2_UNITS)
    RUN_PHASE(3, phase3_unit, P3_UNITS)
    RUN_PHASE(4, phase4_unit, P4_UNITS)
    RUN_PHASE(5, phase5_unit, P5_UNITS)
    RUN_PHASE(6, phase6_unit, P6_UNITS)
    RUN_PHASE(7, phase7_unit, P7_UNITS)
    RUN_PHASE(8, phase8_unit, P8_UNITS)
    RUN_PHASE(9, phase9_unit, P9_UNITS)
    RUN_PHASE(10, phase10_unit, P10_UNITS)
#undef RUN_PHASE
}

extern "C" void kernel_launch(void* const* d_in, const int* in_sizes, int n_in, void* d_out, int out_size, void* d_ws, size_t ws_size, hipStream_t stream) {
    static int grid_blocks = 0;
    if (grid_blocks == 0) {
        if (n_in != 15 || in_sizes[0] != M_TOK * DM || out_size != M_TOK * DM || ws_size < WS_NEED) {
            fprintf(stderr, "kernel_launch: unexpected shapes (n_in %d, in0 %d, out %d, ws %zu)\n", n_in, n_in > 0 ? in_sizes[0] : -1, out_size, ws_size);
            grid_blocks = -1; return;
        }
        int dev = 0, cus = 0, per_cu = 0;
        (void)hipGetDevice(&dev);
        (void)hipDeviceGetAttribute(&cus, hipDeviceAttributeMultiprocessorCount, dev);
        (void)hipFuncSetAttribute((const void*)hymba_fwd, hipFuncAttributeMaxDynamicSharedMemorySize, LDS_BYTES);
        (void)hipOccupancyMaxActiveBlocksPerMultiprocessor(&per_cu, (const void*)hymba_fwd, 256, LDS_BYTES);
        if (per_cu < 1) per_cu = 1;
        if (per_cu > 2) per_cu = 2;
        grid_blocks = cus * per_cu;
    }
    if (grid_blocks < 0) return;
    Params p{};
    p.x = (const float*)d_in[0]; p.norm1_g = (const float*)d_in[1]; p.w_in = (const float*)d_in[2]; p.hg_lower = (const float*)d_in[3];
    p.hg_norm_g = (const float*)d_in[4]; p.gla_wg = (const float*)d_in[5]; p.gla_bg = (const float*)d_in[6]; p.gla_norm_g = (const float*)d_in[7];
    p.w_out = (const float*)d_in[8]; p.norm2_g = (const float*)d_in[9]; p.w_q = (const float*)d_in[10]; p.sub_keys = (const float*)d_in[11];
    p.peer_u = (const float*)d_in[12]; p.peer_v = (const float*)d_in[13]; p.norm_f_g = (const float*)d_in[14];
    p.out = (float*)d_out; p.ws = (unsigned char*)d_ws;
#if N_LAUNCH_MODE == 1
    (void)hipMemsetAsync((unsigned char*)d_ws + OFF_BAR, 0, XCD_BAR_WORDS * 4, stream);
    p.ph_lo = 0; p.ph_hi = N_PHASES;
    void* args[] = {&p};
    hipError_t e = hipLaunchCooperativeKernel((const void*)hymba_fwd, dim3(grid_blocks), dim3(256), args, LDS_BYTES, stream);
    if (e != hipSuccess) fprintf(stderr, "cooperative launch failed: %s (grid %d)\n", hipGetErrorString(e), grid_blocks);
#else
    for (int ph = 0; ph < N_PHASES; ++ph) {
        p.ph_lo = ph; p.ph_hi = ph + 1;
        hipLaunchKernelGGL(hymba_fwd, dim3(grid_blocks), dim3(256), LDS_BYTES, stream, p);
    }
#endif
}
```

```cpp
#include <hip/hip_runtime.h>
#include <hip/hip_cooperative_groups.h>
#include <cstdio>
#include <cstdint>
namespace cg = cooperative_groups;

#ifndef N_LAUNCH_MODE
#define N_LAUNCH_MODE 1
#endif

#ifndef PROBE_DUP
#define PROBE_DUP 0
#endif
#ifndef PROBE_P10_DUP
#define PROBE_P10_DUP 0
#endif
#ifndef P10_SLICED
#define P10_SLICED 0
#endif
#ifndef PROBE_P10A
#define PROBE_P10A 0
#endif
#ifndef PROBE_P10_MASK
#define PROBE_P10_MASK 0x7fffffff
#endif
#ifndef PROBE_P10X
#define PROBE_P10X 0
#endif
#ifndef PROBE_GEMM_DUP
#define PROBE_GEMM_DUP 0
#endif
#define DEVI __device__ __forceinline__
#define LTID ((int)(threadIdx.x & 255u))
typedef unsigned short bf16_t;
using bf16x8 = __attribute__((ext_vector_type(8))) short;
using f32x4 = __attribute__((ext_vector_type(4))) float;

constexpr int M_TOK = 32768;
constexpr int DM = 1024;
constexpr int IN_WP = 3840;
constexpr size_t MiB = 1024ull * 1024ull;

constexpr size_t OFF_XN   = 0;
constexpr size_t OFF_WIN  = 64 * MiB;
constexpr size_t OFF_WOUT = 72 * MiB;
constexpr size_t OFF_WQ   = 74 * MiB;
constexpr size_t OFF_SK   = 78 * MiB;
constexpr size_t OFF_LB   = 79 * MiB;
constexpr size_t OFF_U8   = 80 * MiB;
constexpr size_t OFF_V8   = 96 * MiB;
constexpr size_t OFF_US   = 112 * MiB;
constexpr size_t OFF_VS   = 113 * MiB;
constexpr size_t OFF_R2   = 144 * MiB;
constexpr size_t OFF_HQ   = OFF_R2;
constexpr size_t OFF_HLF  = OFF_R2 + 32 * MiB;
constexpr size_t OFF_HV   = OFF_R2 + 64 * MiB;
constexpr size_t OFF_HG   = OFF_R2 + 96 * MiB;
constexpr size_t OFF_GQ   = OFF_R2 + 128 * MiB;
constexpr size_t OFF_GK   = OFF_R2 + 144 * MiB;
constexpr size_t OFF_GV   = OFF_R2 + 160 * MiB;
constexpr size_t OFF_GG   = OFF_R2 + 192 * MiB;
constexpr size_t OFF_GLOW = OFF_R2 + 224 * MiB;
constexpr size_t OFF_KTH  = 370 * MiB;
constexpr size_t OFF_KTG  = 402 * MiB;
constexpr size_t OFF_DECH = 418 * MiB;
constexpr size_t OFF_DECG = 419 * MiB;
constexpr size_t OFF_HVT  = 420 * MiB;
constexpr size_t OFF_GVT  = 452 * MiB;
constexpr size_t OFF_BAR  = 484 * MiB;
constexpr size_t WS_NEED  = 485 * MiB;
constexpr size_t OFF_MIX  = OFF_XN;
constexpr size_t OFF_HN   = OFF_R2;
constexpr size_t OFF_Q    = OFF_R2 + 64 * MiB;
constexpr size_t OFF_EIDX = OFF_KTH;
constexpr size_t OFF_EW   = OFF_KTH + 16 * MiB;
constexpr size_t OFF_EU   = OFF_KTG;
constexpr size_t OFF_HN8  = OFF_XN;
constexpr size_t OFF_HS   = OFF_XN + 32 * MiB;
constexpr size_t OFF_SSQ  = OFF_XN + 33 * MiB;
constexpr size_t OFF_PD   = OFF_Q;
constexpr size_t OUT_STH = 0;
constexpr size_t OUT_STG = 64 * MiB;

struct Params {
    const float* x; const float* norm1_g; const float* w_in; const float* hg_lower; const float* hg_norm_g;
    const float* gla_wg; const float* gla_bg; const float* gla_norm_g; const float* w_out; const float* norm2_g;
    const float* w_q; const float* sub_keys; const float* peer_u; const float* peer_v; const float* norm_f_g;
    float* out; unsigned char* ws;
    int ph_lo, ph_hi;
};

DEVI unsigned short f2bf(float f) {
    unsigned u = __float_as_uint(f);
    u += 0x7fffu + ((u >> 16) & 1u);
    return (unsigned short)(u >> 16);
}
DEVI float bf2f(unsigned short b) { return __uint_as_float(((unsigned)b) << 16); }
DEVI unsigned pack2(float a, float b) { return (unsigned)f2bf(a) | ((unsigned)f2bf(b) << 16); }
DEVI float bflo(unsigned u) { return __uint_as_float(u << 16); }
DEVI float bfhi(unsigned u) { return __uint_as_float(u & 0xffff0000u); }
DEVI float wave_sum(float v) {
#pragma unroll
    for (int o = 32; o > 0; o >>= 1) v += __shfl_xor(v, o);
    return v;
}
DEVI float wave_max(float v) {
#pragma unroll
    for (int o = 32; o > 0; o >>= 1) v = fmaxf(v, __shfl_xor(v, o));
    return v;
}
DEVI float silu_f(float x) { return x / (1.f + __expf(-x)); }
DEVI f32x4 mfma16(bf16x8 a, bf16x8 b, f32x4 c) { return __builtin_amdgcn_mfma_f32_16x16x32_bf16(a, b, c, 0, 0, 0); }
DEVI bf16x8 ldg_frag(const bf16_t* p) { return *reinterpret_cast<const bf16x8*>(p); }

DEVI void rms_row_bf16(const float* __restrict__ xr, const float* __restrict__ g, bf16_t* __restrict__ dst, int lane) {
    float4 v[4]; float ss = 0.f;
#pragma unroll
    for (int i = 0; i < 4; ++i) { v[i] = reinterpret_cast<const float4*>(xr)[lane + 64 * i]; ss += v[i].x * v[i].x + v[i].y * v[i].y + v[i].z * v[i].z + v[i].w * v[i].w; }
    ss = wave_sum(ss);
    const float r = rsqrtf(ss * (1.f / 1024.f) + 1e-6f);
#pragma unroll
    for (int i = 0; i < 4; ++i) {
        const float4 gg = reinterpret_cast<const float4*>(g)[lane + 64 * i];
        uint2 o; o.x = pack2(v[i].x * r * gg.x, v[i].y * r * gg.y); o.y = pack2(v[i].z * r * gg.z, v[i].w * r * gg.w);
        reinterpret_cast<uint2*>(dst)[lane + 64 * i] = o;
    }
}

DEVI void transpose_tile(const float* __restrict__ src, int Nsrc, bf16_t* __restrict__ dst, int nt, int kt, int mode, float* lds) {
    const int tid = LTID, tx = tid & 63, ty = tid >> 6;
    const int np = nt * 64 + tx;
    int col = np; bool valid = true;
    if (mode == 1) {
        if (np < 3072) col = np; else if (np < 3584) col = np + 16; else if (np < 3600) col = np - 512; else { valid = false; col = 0; }
    }
#pragma unroll 4
    for (int kk = ty; kk < 64; kk += 4) {
        lds[kk * 65 + tx] = valid ? src[(size_t)(kt * 64 + kk) * Nsrc + col] : 0.f;
    }
    __syncthreads();
    const int nl = tid >> 2, kq = tid & 3;
    unsigned pk[8];
#pragma unroll
    for (int i = 0; i < 8; ++i) pk[i] = pack2(lds[(kq * 16 + 2 * i) * 65 + nl], lds[(kq * 16 + 2 * i + 1) * 65 + nl]);
    uint4* d = reinterpret_cast<uint4*>(dst + (size_t)(nt * 64 + nl) * 1024 + kt * 64 + kq * 16);
    d[0] = make_uint4(pk[0], pk[1], pk[2], pk[3]);
    d[1] = make_uint4(pk[4], pk[5], pk[6], pk[7]);
    __syncthreads();
}

DEVI void convert8(const float* __restrict__ src, bf16_t* __restrict__ dst, size_t idx8) {
    const float4 a = reinterpret_cast<const float4*>(src)[idx8 * 2], b = reinterpret_cast<const float4*>(src)[idx8 * 2 + 1];
    reinterpret_cast<uint4*>(dst)[idx8] = make_uint4(pack2(a.x, a.y), pack2(a.z, a.w), pack2(b.x, b.y), pack2(b.z, b.w));
}

DEVI void quant_row_fp8(const float* __restrict__ xr, unsigned char* __restrict__ dst_table, int row, float* __restrict__ descale, int lane) {
    float4 v[4]; float am = 0.f;
#pragma unroll
    for (int i = 0; i < 4; ++i) { v[i] = reinterpret_cast<const float4*>(xr)[lane + 64 * i]; am = fmaxf(am, fmaxf(fmaxf(fabsf(v[i].x), fabsf(v[i].y)), fmaxf(fabsf(v[i].z), fabsf(v[i].w)))); }
    am = wave_max(am);
    const float sc = am > 0.f ? 448.f / am : 1.f;
#pragma unroll
    for (int i = 0; i < 4; ++i) {
        const float a = fminf(fmaxf(v[i].x * sc, -448.f), 448.f), b = fminf(fmaxf(v[i].y * sc, -448.f), 448.f);
        const float c = fminf(fmaxf(v[i].z * sc, -448.f), 448.f), d = fminf(fmaxf(v[i].w * sc, -448.f), 448.f);
        int pk = __builtin_amdgcn_cvt_pk_fp8_f32(a, b, 0, false);
        pk = __builtin_amdgcn_cvt_pk_fp8_f32(c, d, pk, true);
        const int w = lane + 64 * i;
        reinterpret_cast<int*>(dst_table)[(size_t)(w >> 5) * (16384 * 32) + (size_t)row * 32 + (w & 31)] = pk;
    }
    if (lane == 0) *descale = am > 0.f ? am * (1.f / 448.f) : 1.f;
}

constexpr int P0_XN = 8192, P0_WIN = 60 * 16, P0_WOUT = 16 * 16, P0_WQ = 32 * 16, P0_UV = 8192, P0_SK = 128, P0_LB = 1;
constexpr int P0_UNITS = P0_XN + P0_WIN + P0_WOUT + P0_WQ + P0_UV + P0_SK + P0_LB;

DEVI void phase0_unit(const Params& p, int u, char* smem) {
    const int tid = LTID, lane = tid & 63, w = tid >> 6;
    unsigned char* ws = p.ws;
    if (u < P0_XN) {
        const int row = u * 4 + w;
        rms_row_bf16(p.x + (size_t)row * DM, p.norm1_g, reinterpret_cast<bf16_t*>(ws + OFF_XN) + (size_t)row * DM, lane);
        return;
    }
    u -= P0_XN;
    if (u < P0_WIN) { transpose_tile(p.w_in, 3600, reinterpret_cast<bf16_t*>(ws + OFF_WIN), u / 16, u % 16, 1, reinterpret_cast<float*>(smem)); return; }
    u -= P0_WIN;
    if (u < P0_WOUT) { transpose_tile(p.w_out, 1024, reinterpret_cast<bf16_t*>(ws + OFF_WOUT), u / 16, u % 16, 0, reinterpret_cast<float*>(smem)); return; }
    u -= P0_WOUT;
    if (u < P0_WQ) { transpose_tile(p.w_q, 2048, reinterpret_cast<bf16_t*>(ws + OFF_WQ), u / 16, u % 16, 0, reinterpret_cast<float*>(smem)); return; }
    u -= P0_WQ;
    if (u < P0_UV) {
        const bool isv = u >= 4096; const int row = (isv ? u - 4096 : u) * 4 + w;
        quant_row_fp8((isv ? p.peer_v : p.peer_u) + (size_t)row * DM, ws + (isv ? OFF_V8 : OFF_U8), row,
                      reinterpret_cast<float*>(ws + (isv ? OFF_VS : OFF_US)) + row, lane);
        return;
    }
    u -= P0_UV;
    if (u < P0_SK) { convert8(p.sub_keys, reinterpret_cast<bf16_t*>(ws + OFF_SK), (size_t)u * 256 + tid); return; }
    float* lb = reinterpret_cast<float*>(ws + OFF_LB);
    for (int n = tid; n < 512; n += 256) {
        const float l0 = p.hg_lower[n], l1 = p.hg_lower[512 + n];
        const float mx = fmaxf(l0, l1); const float e0 = __expf(l0 - mx), e1 = __expf(l1 - mx);
        lb[n] = e0 / (e0 + e1);
    }
}

namespace pg8 {
#define PG8_LAS __attribute__((address_space(3)))
typedef unsigned short bf16_t;
typedef short bf16x8 __attribute__((ext_vector_type(8)));
typedef float f32x4 __attribute__((ext_vector_type(4)));
typedef unsigned u32x4 __attribute__((ext_vector_type(4)));
constexpr int BM = 256, BK = 64, HALF = 128, HTB = HALF * BK * 2  , STAGE_BYTES = 8 * HTB, NXCD = 8, WGM = 8;

__host__ __device__ __forceinline__ int lds_byte(int r, int c) { const int st = (r >> 4) * 2 + (c >> 5), rr = r & 15, cc = c & 31, ob = rr * 64 + cc * 2; return st * 1024 + (ob ^ (((ob >> 9) & 1) << 5)); }
__host__ __device__ __forceinline__ void stage_rc(int b, int& R, int& C) { const int st = b / 1024, sb = b % 1024, swz = sb ^ (((sb >> 9) & 1) << 5); R = (st >> 1) * 16 + swz / 64; C = (st & 1) * 32 + (swz % 64) / 2; }
__host__ __device__ __forceinline__ int perm32(int rho) { const int n = rho >> 4, i = rho & 15; return 8 * (i >> 2) + 4 * n + (i & 3); }

struct Unit { int pm, pn; };
struct Gemm { const bf16_t* A; const bf16_t* Bt; int M, N, K; };

struct StaticOrder {
    int nM, nN, nwg, G, c;
    __host__ __device__ void init(int M, int N, int G_, int c_) { nM = M / BM; nN = N / BM; nwg = nM * nN; G = G_; c = c_; }
    __host__ __device__ bool next(int i, Unit& u) const {
        const long L = (long)i * G + c; if (L >= nwg) return false;
        int wgid = (int)L; { const int q = nwg / NXCD, r = nwg % NXCD, xcd = wgid % NXCD, off = wgid / NXCD; wgid = (xcd < r ? xcd * (q + 1) : r * (q + 1) + (xcd - r) * q) + off; }
        const int nig = WGM * nN, gid = wgid / nig, fm = gid * WGM, gsz = (nM - fm) < WGM ? (nM - fm) : WGM;
        u.pm = fm + ((wgid % nig) % gsz); u.pn = (wgid % nig) / gsz; return true;
    }
    __device__ __forceinline__ void a_ready(const Unit&) const {}
    __device__ __forceinline__ void done(const Unit&) const {}
};
__device__ __forceinline__ unsigned cvt_pk_bf16(float lo, float hi) { unsigned r; asm volatile("v_cvt_pk_bf16_f32 %0, %1, %2" : "=v"(r) : "v"(lo), "v"(hi)); return r; }
typedef float f32x2 __attribute__((ext_vector_type(2)));
template <class Epi, class Sched, bool STAMP = false>
__device__ __forceinline__ void gemm_phase(PG8_LAS unsigned char* lds, const Gemm g, const Sched& S, const Epi& E, unsigned long long* stamps) {
    const int tid = threadIdx.x, wid = __builtin_amdgcn_readfirstlane(tid >> 6), lane = tid & 63, wr = wid >> 2, wc = wid & 3, fr = lane & 15, fq = lane >> 4;
    const int K = g.K, nt = K / BK;
    int ts_lo = 0, ts_hi = 0, nts = 0; const unsigned long long rt_entry = STAMP ? (unsigned long long)wall_clock64() : 0ull;
#define PG8_STAMP() do { if (STAMP && wid == 0 && nts < 64) { const unsigned long long _c = (unsigned long long)clock64(); \
        ts_lo = (lane == nts) ? (int)(unsigned)_c : ts_lo; ts_hi = (lane == nts) ? (int)(unsigned)(_c >> 32) : ts_hi; ++nts; } } while (0)
    PG8_STAMP();
    unsigned voffA[2], voffB[2];
#pragma unroll
    for (int i = 0; i < 2; ++i) { int R, C; stage_rc(tid * 16 + i * 8192, R, C); const int Rb = Epi::PERM ? ((R & ~31) + perm32(R & 31)) : R;
        voffA[i] = (unsigned)(R * K + C) * 2u; voffB[i] = (unsigned)(Rb * K + C) * 2u; }
    const size_t kstep = (size_t)(BK * 2);
    const size_t hstep = (size_t)HALF * K * 2;
    const size_t tstep = 2 * hstep;
    const unsigned ldsw = (unsigned)wid * 1024u;
    const int aoff = lds_byte(wr * 64 + fr, fq * 8), boff = lds_byte(wc * 32 + fr, fq * 8);
#define PG8_SA(b, h) (((b) * 2 + (h)) * HTB)
#define PG8_SB(b, h) ((4 + (b) * 2 + (h)) * HTB)
#define PG8_STAGE(bufoff, gbase, voff) do { _Pragma("unroll") for (int _i = 0; _i < 2; ++_i) \
        __builtin_amdgcn_global_load_lds((const unsigned*)((const char*)(gbase) + (voff)[_i]), (PG8_LAS unsigned*)(lds + (bufoff) + ldsw + _i * 8192), 16, 0, 0); } while (0)
#define PG8_LDA(dst, b, h) do { _Pragma("unroll") for (int m = 0; m < 4; ++m) _Pragma("unroll") for (int k = 0; k < 2; ++k) dst[m][k] = *(const PG8_LAS bf16x8*)(lds + PG8_SA(b, h) + aoff + m * 2048 + k * 1024); } while (0)
#define PG8_LDB(dst, b, h) do { _Pragma("unroll") for (int n = 0; n < 2; ++n) _Pragma("unroll") for (int k = 0; k < 2; ++k) dst[n][k] = *(const PG8_LAS bf16x8*)(lds + PG8_SB(b, h) + boff + n * 2048 + k * 1024); } while (0)
#define PG8_MMA(ai, bj, At, Bt) do { __builtin_amdgcn_s_setprio(1); _Pragma("unroll") for (int m = 0; m < 4; ++m) _Pragma("unroll") for (int n = 0; n < 2; ++n) _Pragma("unroll") for (int k = 0; k < 2; ++k) \
        acc[ai][bj][m][n] = __builtin_amdgcn_mfma_f32_16x16x32_bf16(Bt[n][k], At[m][k], acc[ai][bj][m][n], 0, 0, 0); __builtin_amdgcn_s_setprio(0); } while (0)
#define PG8_WAIT_V(n) asm volatile("s_waitcnt vmcnt(" #n ")" ::: "memory")
#define PG8_WAIT_L(n) asm volatile("s_waitcnt lgkmcnt(" #n ")" ::: "memory")
#define PG8_BAR __builtin_amdgcn_s_barrier()
#define PG8_SCHED __builtin_amdgcn_sched_barrier(0)
    Unit cur, nxt; int ui = 0;
    if (!S.next(0, cur)) return;
    f32x4 acc[2][2][4][2];
#pragma unroll
    for (int a = 0; a < 2; ++a)
#pragma unroll
        for (int b = 0; b < 2; ++b)
#pragma unroll
            for (int m = 0; m < 4; ++m)
#pragma unroll
                for (int n = 0; n < 2; ++n) acc[a][b][m][n] = (f32x4){0.f, 0.f, 0.f, 0.f};
    bf16x8 At[4][2], B0[2][2], B1[2][2];
    const char* cA = (const char*)g.A + (size_t)cur.pm * tstep; const char* cB = (const char*)g.Bt + (size_t)cur.pn * tstep;
    S.a_ready(cur);
    PG8_STAGE(PG8_SB(0, 0), cB, voffB); PG8_STAGE(PG8_SA(0, 0), cA, voffA); PG8_STAGE(PG8_SB(0, 1), cB + hstep, voffB); PG8_STAGE(PG8_SA(0, 1), cA + hstep, voffA);
    if (wr == 1) PG8_BAR;
    PG8_WAIT_V(4); PG8_BAR;
    PG8_STAGE(PG8_SB(1, 0), cB + kstep, voffB); PG8_STAGE(PG8_SA(1, 0), cA + kstep, voffA); PG8_STAGE(PG8_SB(1, 1), cB + hstep + kstep, voffB);
    PG8_WAIT_V(6); PG8_BAR;
    PG8_STAMP();
    for (;;) {
        const bool has_next = S.next(ui + 1, nxt);
        const char* nA = has_next ? (const char*)g.A + (size_t)nxt.pm * tstep : cA; const char* nB = has_next ? (const char*)g.Bt + (size_t)nxt.pn * tstep : cB;
        for (int t = 0; t < nt; t += 2) {
            const bool last = (t == nt - 2);
            const char* a1 = cA + (size_t)(t + 1) * kstep;
            const char* a2 = last ? nA : cA + (size_t)(t + 2) * kstep; const char* b2 = last ? nB : cB + (size_t)(t + 2) * kstep;
            const char* a3 = a2 + kstep; const char* b3 = b2 + kstep;
            if (last && has_next) S.a_ready(nxt);
            PG8_LDB(B0, 0, 0); PG8_SCHED; PG8_LDA(At, 0, 0); PG8_STAGE(PG8_SA(1, 1), a1 + hstep, voffA);
            PG8_WAIT_L(8); PG8_BAR; PG8_WAIT_L(0); PG8_MMA(0, 0, At, B0); PG8_BAR; PG8_SCHED;
            PG8_LDB(B1, 0, 1); PG8_STAGE(PG8_SB(0, 0), b2, voffB);
            PG8_BAR; PG8_WAIT_L(0); PG8_MMA(0, 1, At, B1); PG8_BAR;
            PG8_LDA(At, 0, 1); PG8_STAGE(PG8_SA(0, 0), a2, voffA);
            PG8_BAR; PG8_WAIT_L(0); PG8_MMA(1, 0, At, B0); PG8_BAR; PG8_SCHED;
            PG8_STAGE(PG8_SB(0, 1), b2 + hstep, voffB);
            PG8_WAIT_V(6); PG8_BAR; PG8_MMA(1, 1, At, B1); PG8_BAR;
            PG8_LDB(B0, 1, 0); PG8_SCHED; PG8_LDA(At, 1, 0); PG8_STAGE(PG8_SA(0, 1), a2 + hstep, voffA);
            PG8_WAIT_L(8); PG8_BAR; PG8_WAIT_L(0); PG8_MMA(0, 0, At, B0); PG8_BAR; PG8_SCHED;
            PG8_LDB(B1, 1, 1); PG8_STAGE(PG8_SB(1, 0), b3, voffB);
            PG8_BAR; PG8_WAIT_L(0); PG8_MMA(0, 1, At, B1); PG8_BAR;
            PG8_LDA(At, 1, 1); PG8_STAGE(PG8_SA(1, 0), a3, voffA);
            PG8_BAR; PG8_WAIT_L(0); PG8_MMA(1, 0, At, B0); PG8_BAR; PG8_SCHED;
            PG8_STAGE(PG8_SB(1, 1), b3 + hstep, voffB);
            PG8_WAIT_V(6); PG8_BAR; PG8_MMA(1, 1, At, B1); PG8_BAR;
        }
        PG8_STAMP();
        if constexpr (!Epi::AFTER_DRAIN) { E(acc, cur, wr, wc, fr, fq); S.done(cur); }
        PG8_STAMP();
        if (!has_next) break;
#pragma unroll
        for (int a = 0; a < 2; ++a)
#pragma unroll
            for (int b = 0; b < 2; ++b)
#pragma unroll
                for (int m = 0; m < 4; ++m)
#pragma unroll
                    for (int n = 0; n < 2; ++n) acc[a][b][m][n] = (f32x4){0.f, 0.f, 0.f, 0.f};
        cur = nxt; cA = nA; cB = nB; ++ui;
    }
    PG8_WAIT_V(0);
    if (wr == 0) PG8_BAR;
    PG8_BAR;
    if constexpr (Epi::AFTER_DRAIN) { E.fused(acc, cur, wr, wc, fr, fq, lds, wid, lane); S.done(cur); }
    PG8_STAMP();
    if (STAMP && wid == 0) { stamps[lane] = lane < nts ? (((unsigned long long)(unsigned)ts_hi << 32) | (unsigned)ts_lo) : 0ull;
        if (lane == 62) stamps[62] = rt_entry; if (lane == 63) stamps[63] = (unsigned long long)wall_clock64(); }
#undef PG8_STAMP
#undef PG8_SA
#undef PG8_SB
#undef PG8_STAGE
#undef PG8_LDA
#undef PG8_LDB
#undef PG8_MMA
#undef PG8_WAIT_V
#undef PG8_WAIT_L
#undef PG8_BAR
#undef PG8_SCHED
}
}

DEVI uint4 pack8(const pg8::f32x4 a, const pg8::f32x4 b) { return make_uint4(pack2(a[0], a[1]), pack2(a[2], a[3]), pack2(b[0], b[1]), pack2(b[2], b[3])); }

constexpr int P1_N = IN_WP;
struct EpiInProj {
    static constexpr bool PERM = true, AFTER_DRAIN = false;
    unsigned char* ws;
    __device__ __forceinline__ void operator()(const pg8::f32x4 (&acc)[2][2][4][2], const pg8::Unit& u, int wr, int wc, int fr, int fq) const {
        const int row0 = u.pm * 256 + wr * 64 + fr;
        const int pn = u.pn;
        const int cl0 = wc * 32 + 8 * fq;
        bf16_t* dst; int ld, cbase, kind;
        if (pn < 2)       { dst = reinterpret_cast<bf16_t*>(ws + OFF_HQ);  ld = 512; cbase = pn * 256;        kind = 1; }
        else if (pn < 4)  { dst = reinterpret_cast<bf16_t*>(ws + OFF_HLF); ld = 512; cbase = (pn - 2) * 256;  kind = 2; }
        else if (pn < 6)  { dst = reinterpret_cast<bf16_t*>(ws + OFF_HV);  ld = 512; cbase = (pn - 4) * 256;  kind = 0; }
        else if (pn < 8)  { dst = reinterpret_cast<bf16_t*>(ws + OFF_HG);  ld = 512; cbase = (pn - 6) * 256;  kind = 1; }
        else if (pn == 8) { dst = reinterpret_cast<bf16_t*>(ws + OFF_GQ);  ld = 256; cbase = 0;               kind = 3; }
        else if (pn == 9) { dst = reinterpret_cast<bf16_t*>(ws + OFF_GK);  ld = 256; cbase = 0;               kind = 0; }
        else if (pn < 12) { dst = reinterpret_cast<bf16_t*>(ws + OFF_GV);  ld = 512; cbase = (pn - 10) * 256; kind = 0; }
        else if (pn < 14) { dst = reinterpret_cast<bf16_t*>(ws + OFF_GG);  ld = 512; cbase = (pn - 12) * 256; kind = 1; }
        else {
            if (wc == 0 && fq < 2) {
                float* gl = reinterpret_cast<float*>(ws + OFF_GLOW);
#pragma unroll
                for (int ai = 0; ai < 2; ++ai)
#pragma unroll
                    for (int m = 0; m < 4; ++m) {
                        float* rp = gl + (size_t)(row0 + ai * 128 + m * 16) * 16 + 8 * fq;
                        *reinterpret_cast<pg8::f32x4*>(rp) = acc[ai][0][m][0];
                        *reinterpret_cast<pg8::f32x4*>(rp + 4) = acc[ai][0][m][1];
                    }
            }
            return;
        }
        float lbv[2][8];
#pragma unroll
        for (int bj = 0; bj < 2; ++bj)
#pragma unroll
            for (int j = 0; j < 8; ++j) lbv[bj][j] = 0.f;
        if (kind == 2) {
            const float* lb = reinterpret_cast<const float*>(ws + OFF_LB);
#pragma unroll
            for (int bj = 0; bj < 2; ++bj)
#pragma unroll
                for (int j = 0; j < 8; ++j) lbv[bj][j] = lb[cbase + bj * 128 + cl0 + j];
        }
#pragma unroll
        for (int ai = 0; ai < 2; ++ai)
#pragma unroll
            for (int m = 0; m < 4; ++m) {
                bf16_t* rowp = dst + (size_t)(row0 + ai * 128 + m * 16) * ld + cbase + cl0;
#pragma unroll
                for (int bj = 0; bj < 2; ++bj) {
                    pg8::f32x4 v0 = acc[ai][bj][m][0], v1 = acc[ai][bj][m][1];
                    if (kind == 1) {
#pragma unroll
                        for (int j = 0; j < 4; ++j) { v0[j] = silu_f(v0[j]); v1[j] = silu_f(v1[j]); }
                    } else if (kind == 2) {
#pragma unroll
                        for (int j = 0; j < 4; ++j) {
                            const float l0 = lbv[bj][j], l1 = lbv[bj][4 + j];
                            v0[j] = __logf(l0 + (1.f - l0) / (1.f + __expf(-v0[j])));
                            v1[j] = __logf(l1 + (1.f - l1) / (1.f + __expf(-v1[j])));
                        }
                    } else if (kind == 3) {
#pragma unroll
                        for (int j = 0; j < 4; ++j) { v0[j] *= 0.125f; v1[j] *= 0.125f; }
                    }
                    *reinterpret_cast<uint4*>(rowp + bj * 128) = pack8(v0, v1);
                }
            }
    }
};
struct EpiOutProj {
    static constexpr bool PERM = false, AFTER_DRAIN = false;
    const float* x; float* out;
    __device__ __forceinline__ void operator()(const pg8::f32x4 (&acc)[2][2][4][2], const pg8::Unit& u, int wr, int wc, int fr, int fq) const {
        const int row0 = u.pm * 256 + wr * 64 + fr, col0 = u.pn * 256 + wc * 32 + 4 * fq;
#pragma unroll
        for (int ai = 0; ai < 2; ++ai)
#pragma unroll
            for (int m = 0; m < 4; ++m) {
                const size_t ro = (size_t)(row0 + ai * 128 + m * 16) * DM + col0;
#pragma unroll
                for (int bj = 0; bj < 2; ++bj)
#pragma unroll
                    for (int n = 0; n < 2; ++n) {
                        const pg8::f32x4 xv = *reinterpret_cast<const pg8::f32x4*>(x + ro + bj * 128 + n * 16);
                        *reinterpret_cast<pg8::f32x4*>(out + ro + bj * 128 + n * 16) = xv + acc[ai][bj][m][n];
                    }
            }
    }
};
struct EpiQ {
    static constexpr bool PERM = true, AFTER_DRAIN = false;
    bf16_t* Q;
    __device__ __forceinline__ void operator()(const pg8::f32x4 (&acc)[2][2][4][2], const pg8::Unit& u, int wr, int wc, int fr, int fq) const {
        const int row0 = u.pm * 256 + wr * 64 + fr, col0 = u.pn * 256 + wc * 32 + 8 * fq;
#pragma unroll
        for (int ai = 0; ai < 2; ++ai)
#pragma unroll
            for (int m = 0; m < 4; ++m) {
                bf16_t* rowp = Q + (size_t)(row0 + ai * 128 + m * 16) * 2048 + col0;
#pragma unroll
                for (int bj = 0; bj < 2; ++bj) *reinterpret_cast<uint4*>(rowp + bj * 128) = pack8(acc[ai][bj][m][0], acc[ai][bj][m][1]);
            }
    }
};
template <class Epi>
DEVI void run_gemm(const bf16_t* A, const bf16_t* Bt, int N, const Epi& E, char* smem) {
    pg8::Gemm g{A, Bt, M_TOK, N, 1024};
#if PROBE_GEMM_DUP
    struct DupOrder : pg8::StaticOrder { __host__ __device__ bool next(int i, pg8::Unit& u) const { return pg8::StaticOrder::next(i >> 1, u); } };
    DupOrder S; S.init(M_TOK, N, (int)gridDim.x, (int)blockIdx.x);
    pg8::gemm_phase<Epi, DupOrder, false>((PG8_LAS unsigned char*)smem, g, S, E, nullptr);
#else
    pg8::StaticOrder S; S.init(M_TOK, N, (int)gridDim.x, (int)blockIdx.x);
    pg8::gemm_phase<Epi, pg8::StaticOrder, false>((PG8_LAS unsigned char*)smem, g, S, E, nullptr);
#endif
    __builtin_amdgcn_s_waitcnt(0);
}

constexpr int P2_UNITS = 512 * 7;
DEVI float logsigmoid_f(float z) { return fminf(z, 0.f) - __logf(1.f + __expf(-fabsf(z))); }

DEVI void phase2_unit(const Params& p, int u, char* smem) {
    unsigned char* ws = p.ws;
    const int tid = LTID;
    const int cidx = u / 7, part = u % 7;
    const size_t row0 = (size_t)cidx * 64;
    if (part >= 3) {
        const bool isg = part >= 5; const int n = ((part - 3) & 1) * 256 + tid;
        const bf16_t* V = reinterpret_cast<const bf16_t*>(ws + (isg ? OFF_GV : OFF_HV));
        bf16_t* VT = reinterpret_cast<bf16_t*>(ws + (isg ? OFF_GVT : OFF_HVT));
        for (int r8 = 0; r8 < 8; ++r8) {
            unsigned pk[4];
#pragma unroll
            for (int rr = 0; rr < 8; ++rr) {
                const unsigned short b = V[(row0 + r8 * 8 + rr) * 512 + n];
                if (rr & 1) pk[rr >> 1] |= ((unsigned)b << 16); else pk[rr >> 1] = b;
            }
            *reinterpret_cast<uint4*>(VT + ((size_t)cidx * 512 + n) * 64 + r8 * 8) = make_uint4(pk[0], pk[1], pk[2], pk[3]);
        }
        return;
    }
    if (part < 2) {
        const int n = part * 256 + tid;
        bf16_t* HQ = reinterpret_cast<bf16_t*>(ws + OFF_HQ);
        bf16_t* HLF = reinterpret_cast<bf16_t*>(ws + OFF_HLF);
        bf16_t* KT = reinterpret_cast<bf16_t*>(ws + OFF_KTH);
        float Gl = 0.f;
#pragma unroll 8
        for (int r = 0; r < 64; ++r) Gl += bf2f(HLF[(row0 + r) * 512 + n]);
        float G = 0.f;
        for (int r8 = 0; r8 < 8; ++r8) {
            unsigned pk[4];
#pragma unroll
            for (int rr = 0; rr < 8; ++rr) {
                const size_t idx = (row0 + r8 * 8 + rr) * 512 + n;
                const float lf = bf2f(HLF[idx]);
                G += lf;
                const float key = 1.f - __expf(lf);
                const float q = bf2f(HQ[idx]);
                const unsigned short bq = f2bf(q * __expf(G));
                const unsigned short bk = f2bf(key * __expf(-G));
                HQ[idx] = bq; HLF[idx] = bk;
                if (rr & 1) pk[rr >> 1] |= ((unsigned)bk << 16); else pk[rr >> 1] = bk;
            }
            *reinterpret_cast<uint4*>(KT + ((size_t)cidx * 512 + n) * 64 + r8 * 8) = make_uint4(pk[0], pk[1], pk[2], pk[3]);
        }
        reinterpret_cast<float*>(ws + OFF_DECH)[(size_t)cidx * 512 + n] = __expf(Gl);
    } else {
        const int n = tid;
        bf16_t* GQ = reinterpret_cast<bf16_t*>(ws + OFF_GQ);
        bf16_t* GK = reinterpret_cast<bf16_t*>(ws + OFF_GK);
        bf16_t* KT = reinterpret_cast<bf16_t*>(ws + OFF_KTG);
        const float* GL = reinterpret_cast<const float*>(ws + OFF_GLOW);
        float wg[16];
#pragma unroll
        for (int j = 0; j < 16; ++j) wg[j] = p.gla_wg[j * 256 + n];
        const float bg = p.gla_bg[n];
        float Gl = 0.f;
        for (int r = 0; r < 64; ++r) {
            const float4* g4 = reinterpret_cast<const float4*>(GL + (row0 + r) * 16);
            float z = bg;
#pragma unroll
            for (int j = 0; j < 4; ++j) { const float4 t = g4[j]; z += t.x * wg[4 * j] + t.y * wg[4 * j + 1] + t.z * wg[4 * j + 2] + t.w * wg[4 * j + 3]; }
            Gl += logsigmoid_f(z) * (1.f / 16.f);
        }
        float G = 0.f;
        for (int r8 = 0; r8 < 8; ++r8) {
            unsigned pk[4];
#pragma unroll
            for (int rr = 0; rr < 8; ++rr) {
                const size_t row = row0 + r8 * 8 + rr;
                const float4* g4 = reinterpret_cast<const float4*>(GL + row * 16);
                float z = bg;
#pragma unroll
                for (int j = 0; j < 4; ++j) { const float4 t = g4[j]; z += t.x * wg[4 * j] + t.y * wg[4 * j + 1] + t.z * wg[4 * j + 2] + t.w * wg[4 * j + 3]; }
                G += logsigmoid_f(z) * (1.f / 16.f);
                const size_t idx = row * 256 + n;
                const unsigned short bq = f2bf(bf2f(GQ[idx]) * __expf(G));
                const unsigned short bk = f2bf(bf2f(GK[idx]) * __expf(-G));
                GQ[idx] = bq; GK[idx] = bk;
                if (rr & 1) pk[rr >> 1] |= ((unsigned)bk << 16); else pk[rr >> 1] = bk;
            }
            *reinterpret_cast<uint4*>(KT + ((size_t)cidx * 256 + n) * 64 + r8 * 8) = make_uint4(pk[0], pk[1], pk[2], pk[3]);
        }
        reinterpret_cast<float*>(ws + OFF_DECG)[(size_t)cidx * 256 + n] = __expf(Gl);
    }
}

constexpr int P3_UNITS = 4096;
template <int DK>
DEVI void kv_unit(const Params& p, int sidx, int c) {
    unsigned char* ws = p.ws;
    const int lane = LTID & 63, w = LTID >> 6;
    const int b = sidx >> 2, h = sidx & 3;
    const int cidx = b * 128 + c;
    constexpr int NDB = DK / 16;
    const bf16_t* KT = reinterpret_cast<const bf16_t*>(ws + (DK == 128 ? OFF_KTH : OFF_KTG)) + ((size_t)cidx * (4 * DK) + h * DK) * 64;
    const bf16_t* VT = reinterpret_cast<const bf16_t*>(ws + (DK == 128 ? OFF_HVT : OFF_GVT)) + ((size_t)cidx * 512 + h * 128) * 64;
    const float* DEC = reinterpret_cast<const float*>(ws + (DK == 128 ? OFF_DECH : OFF_DECG)) + (size_t)cidx * (4 * DK) + h * DK;
    bf16_t* ST = reinterpret_cast<bf16_t*>(reinterpret_cast<unsigned char*>(p.out) + (DK == 128 ? OUT_STH : OUT_STG)) + ((size_t)sidx * 128 + c) * (128 * DK);
    f32x4 acc[NDB][2];
#pragma unroll
    for (int i = 0; i < NDB; ++i) { acc[i][0] = f32x4{0, 0, 0, 0}; acc[i][1] = f32x4{0, 0, 0, 0}; }
    const int fo = (lane & 15) * 64 + 8 * (lane >> 4);
#pragma unroll
    for (int ks = 0; ks < 2; ++ks) {
        bf16x8 bv[2];
#pragma unroll
        for (int nb = 0; nb < 2; ++nb) bv[nb] = ldg_frag(VT + (size_t)(32 * w + nb * 16) * 64 + fo + ks * 32);
#pragma unroll
        for (int db = 0; db < NDB; ++db) {
            const bf16x8 ak = ldg_frag(KT + (size_t)(db * 16) * 64 + fo + ks * 32);
            acc[db][0] = mfma16(ak, bv[0], acc[db][0]);
            acc[db][1] = mfma16(ak, bv[1], acc[db][1]);
        }
    }
#pragma unroll
    for (int db = 0; db < NDB; ++db) {
        const int d = db * 16 + 4 * (lane >> 4);
        const float4 dc = *reinterpret_cast<const float4*>(DEC + d);
#pragma unroll
        for (int nb = 0; nb < 2; ++nb) {
            const int dv = 32 * w + nb * 16 + (lane & 15);
            uint2 o; o.x = pack2(acc[db][nb][0] * dc.x, acc[db][nb][1] * dc.y); o.y = pack2(acc[db][nb][2] * dc.z, acc[db][nb][3] * dc.w);
            *reinterpret_cast<uint2*>(ST + (size_t)dv * DK + d) = o;
        }
    }
}
DEVI void phase3_unit(const Params& p, int u, char* smem) {
    if (u < 2048) kv_unit<128>(p, u >> 7, u & 127); else { u -= 2048; kv_unit<64>(p, u >> 7, u & 127); }
}

constexpr int P4_UNITS = 384;
DEVI void phase4_unit(const Params& p, int u, char* smem) {
    unsigned char* ws = p.ws;
    int e = u * 256 + LTID;
    bf16_t* base; const float* dec; size_t cstride; int decstride;
    if (e < 65536) {
        const int sidx = e >> 12, rem = e & 4095, dv = rem >> 5, d4 = (rem & 31) * 4;
        const int b = sidx >> 2, h = sidx & 3;
        base = reinterpret_cast<bf16_t*>(reinterpret_cast<unsigned char*>(p.out) + OUT_STH) + ((size_t)sidx * 128) * 16384 + dv * 128 + d4;
        cstride = 16384;
        dec = reinterpret_cast<const float*>(ws + OFF_DECH) + (size_t)(b * 128) * 512 + h * 128 + d4; decstride = 512;
    } else {
        e -= 65536;
        const int sidx = e >> 11, rem = e & 2047, dv = rem >> 4, d4 = (rem & 15) * 4;
        const int b = sidx >> 2, h = sidx & 3;
        base = reinterpret_cast<bf16_t*>(reinterpret_cast<unsigned char*>(p.out) + OUT_STG) + ((size_t)sidx * 128) * 8192 + dv * 64 + d4;
        cstride = 8192;
        dec = reinterpret_cast<const float*>(ws + OFF_DECG) + (size_t)(b * 128) * 256 + h * 64 + d4; decstride = 256;
    }
    float s0 = 0.f, s1 = 0.f, s2 = 0.f, s3 = 0.f;
    for (int c8 = 0; c8 < 128; c8 += 8) {
        uint2 kv[8]; float4 dc[8];
#pragma unroll
        for (int i = 0; i < 8; ++i) { kv[i] = *reinterpret_cast<const uint2*>(base + (size_t)(c8 + i) * cstride); dc[i] = *reinterpret_cast<const float4*>(dec + (size_t)(c8 + i) * decstride); }
#pragma unroll
        for (int i = 0; i < 8; ++i) {
            uint2 o; o.x = pack2(s0, s1); o.y = pack2(s2, s3);
            *reinterpret_cast<uint2*>(base + (size_t)(c8 + i) * cstride) = o;
            s0 = dc[i].x * s0 + bflo(kv[i].x); s1 = dc[i].y * s1 + bfhi(kv[i].x);
            s2 = dc[i].z * s2 + bflo(kv[i].y); s3 = dc[i].w * s3 + bfhi(kv[i].y);
        }
    }
}

constexpr int P5_UNITS = 4096;
constexpr int PL_PITCH = 72;
template <int DK>
DEVI void out_unit(const Params& p, int sidx, int c, char* smem) {
    unsigned char* ws = p.ws;
    const int lane = LTID & 63, w = LTID >> 6;
    const int b = sidx >> 2, h = sidx & 3;
    const int cidx = b * 128 + c;
    const size_t row0 = (size_t)cidx * 64;
    constexpr int LDQ = 4 * DK;
    const bf16_t* Qn = reinterpret_cast<const bf16_t*>(ws + (DK == 128 ? OFF_HQ : OFF_GQ)) + row0 * LDQ + h * DK;
    const bf16_t* Kn = reinterpret_cast<const bf16_t*>(ws + (DK == 128 ? OFF_HLF : OFF_GK)) + row0 * LDQ + h * DK;
    const bf16_t* VT = reinterpret_cast<const bf16_t*>(ws + (DK == 128 ? OFF_HVT : OFF_GVT)) + ((size_t)cidx * 512 + h * 128) * 64;
    const bf16_t* ST = reinterpret_cast<const bf16_t*>(reinterpret_cast<const unsigned char*>(p.out) + (DK == 128 ? OUT_STH : OUT_STG)) + ((size_t)sidx * 128 + c) * (128 * DK);
    const bf16_t* GATE = reinterpret_cast<const bf16_t*>(ws + (DK == 128 ? OFF_HG : OFF_GG)) + row0 * 512 + h * 128;
    const float* ng = (DK == 128) ? p.hg_norm_g : p.gla_norm_g;
    bf16_t* MIX = reinterpret_cast<bf16_t*>(ws + OFF_MIX) + row0 * 1024 + (DK == 128 ? 0 : 512) + h * 128;
    bf16_t* PL = reinterpret_cast<bf16_t*>(smem);
    float* RED = reinterpret_cast<float*>(smem + 64 * PL_PITCH * 2);

    const int l15 = lane & 15, lg = lane >> 4;
    {
        bf16x8 bq[DK / 32];
#pragma unroll
        for (int ks = 0; ks < DK / 32; ++ks) bq[ks] = ldg_frag(Qn + (size_t)(w * 16 + l15) * LDQ + ks * 32 + 8 * lg);
#pragma unroll
        for (int jb = 0; jb < 4; ++jb) {
            f32x4 a = f32x4{0, 0, 0, 0};
            if (jb <= w) {
#pragma unroll
                for (int ks = 0; ks < DK / 32; ++ks) {
                    const bf16x8 ak = ldg_frag(Kn + (size_t)(jb * 16 + l15) * LDQ + ks * 32 + 8 * lg);
                    a = mfma16(ak, bq[ks], a);
                }
            }
            const int i = w * 16 + l15, j0 = jb * 16 + 4 * lg;
            const float v0 = (j0 + 0 <= i) ? a[0] : 0.f, v1 = (j0 + 1 <= i) ? a[1] : 0.f, v2 = (j0 + 2 <= i) ? a[2] : 0.f, v3 = (j0 + 3 <= i) ? a[3] : 0.f;
            uint2 o; o.x = pack2(v0, v1); o.y = pack2(v2, v3);
            *reinterpret_cast<uint2*>(PL + i * PL_PITCH + j0) = o;
        }
    }
    __syncthreads();
    f32x4 acc[2][4];
#pragma unroll
    for (int x = 0; x < 2; ++x)
#pragma unroll
        for (int y = 0; y < 4; ++y) acc[x][y] = f32x4{0, 0, 0, 0};
#pragma unroll
    for (int ks = 0; ks < 2; ++ks) {
        bf16x8 av[2], bp[4];
#pragma unroll
        for (int x = 0; x < 2; ++x) av[x] = ldg_frag(VT + (size_t)((2 * w + x) * 16 + l15) * 64 + ks * 32 + 8 * lg);
#pragma unroll
        for (int y = 0; y < 4; ++y) bp[y] = *reinterpret_cast<const bf16x8*>(PL + (y * 16 + l15) * PL_PITCH + ks * 32 + 8 * lg);
#pragma unroll
        for (int x = 0; x < 2; ++x)
#pragma unroll
            for (int y = 0; y < 4; ++y) acc[x][y] = mfma16(av[x], bp[y], acc[x][y]);
    }
#pragma unroll
    for (int ks = 0; ks < DK / 32; ++ks) {
        bf16x8 as[2], bq[4];
#pragma unroll
        for (int x = 0; x < 2; ++x) as[x] = ldg_frag(ST + (size_t)((2 * w + x) * 16 + l15) * DK + ks * 32 + 8 * lg);
#pragma unroll
        for (int y = 0; y < 4; ++y) bq[y] = ldg_frag(Qn + (size_t)(y * 16 + l15) * LDQ + ks * 32 + 8 * lg);
#pragma unroll
        for (int x = 0; x < 2; ++x)
#pragma unroll
            for (int y = 0; y < 4; ++y) acc[x][y] = mfma16(as[x], bq[y], acc[x][y]);
    }
    float ssq[4];
#pragma unroll
    for (int y = 0; y < 4; ++y) {
        float s = 0.f;
#pragma unroll
        for (int x = 0; x < 2; ++x)
#pragma unroll
            for (int r = 0; r < 4; ++r) s += acc[x][y][r] * acc[x][y][r];
        s += __shfl_xor(s, 16); s += __shfl_xor(s, 32);
        ssq[y] = s;
    }
    if (lg == 0) {
#pragma unroll
        for (int y = 0; y < 4; ++y) RED[w * 64 + y * 16 + l15] = ssq[y];
    }
    __syncthreads();
#pragma unroll
    for (int y = 0; y < 4; ++y) {
        const int i = y * 16 + l15;
        const float tot = RED[i] + RED[64 + i] + RED[128 + i] + RED[192 + i];
        const float rstd = rsqrtf(tot * (1.f / 128.f) + 1e-6f);
#pragma unroll
        for (int x = 0; x < 2; ++x) {
            const int dv = (2 * w + x) * 16 + 4 * lg;
            const float4 g4 = *reinterpret_cast<const float4*>(ng + dv);
            const uint2 gt = *reinterpret_cast<const uint2*>(GATE + (size_t)i * 512 + dv);
            uint2 o;
            o.x = pack2(acc[x][y][0] * rstd * g4.x * bflo(gt.x), acc[x][y][1] * rstd * g4.y * bfhi(gt.x));
            o.y = pack2(acc[x][y][2] * rstd * g4.z * bflo(gt.y), acc[x][y][3] * rstd * g4.w * bfhi(gt.y));
            *reinterpret_cast<uint2*>(MIX + (size_t)i * 1024 + dv) = o;
        }
    }
    __syncthreads();
}
DEVI void phase5_unit(const Params& p, int u, char* smem) {
    if (u < 2048) out_unit<128>(p, u >> 7, u & 127, smem); else { u -= 2048; out_unit<64>(p, u >> 7, u & 127, smem); }
}

DEVI void rms_row_bf16_fp8(const float* __restrict__ xr, const float* __restrict__ g, bf16_t* __restrict__ dst, unsigned char* __restrict__ dst8, float* __restrict__ descale, int lane) {
    float4 v[4]; float ss = 0.f;
#pragma unroll
    for (int i = 0; i < 4; ++i) { v[i] = reinterpret_cast<const float4*>(xr)[lane + 64 * i]; ss += v[i].x * v[i].x + v[i].y * v[i].y + v[i].z * v[i].z + v[i].w * v[i].w; }
    ss = wave_sum(ss);
    const float r = rsqrtf(ss * (1.f / 1024.f) + 1e-6f);
    float am = 0.f;
#pragma unroll
    for (int i = 0; i < 4; ++i) {
        const float4 gg = reinterpret_cast<const float4*>(g)[lane + 64 * i];
        v[i].x *= r * gg.x; v[i].y *= r * gg.y; v[i].z *= r * gg.z; v[i].w *= r * gg.w;
        uint2 o; o.x = pack2(v[i].x, v[i].y); o.y = pack2(v[i].z, v[i].w);
        reinterpret_cast<uint2*>(dst)[lane + 64 * i] = o;
        am = fmaxf(am, fmaxf(fmaxf(fabsf(v[i].x), fabsf(v[i].y)), fmaxf(fabsf(v[i].z), fabsf(v[i].w))));
    }
    am = wave_max(am);
    const float sc = am > 0.f ? 448.f / am : 1.f;
#pragma unroll
    for (int i = 0; i < 4; ++i) {
        const float a = fminf(fmaxf(v[i].x * sc, -448.f), 448.f), b = fminf(fmaxf(v[i].y * sc, -448.f), 448.f);
        const float c = fminf(fmaxf(v[i].z * sc, -448.f), 448.f), d = fminf(fmaxf(v[i].w * sc, -448.f), 448.f);
        int pk = __builtin_amdgcn_cvt_pk_fp8_f32(a, b, 0, false);
        pk = __builtin_amdgcn_cvt_pk_fp8_f32(c, d, pk, true);
        reinterpret_cast<int*>(dst8)[lane + 64 * i] = pk;
    }
    if (lane == 0) *descale = am > 0.f ? am * (1.f / 448.f) : 1.f;
}
constexpr int P7_UNITS = 8192;
DEVI void phase7_unit(const Params& p, int u, char* smem) {
    const int lane = LTID & 63, w = LTID >> 6;
    const int row = u * 4 + w;
    rms_row_bf16(p.out + (size_t)row * DM, p.norm2_g, reinterpret_cast<bf16_t*>(p.ws + OFF_HN) + (size_t)row * DM, lane);
}

using f32x16 = __attribute__((ext_vector_type(16))) float;
DEVI f32x16 mfma32(bf16x8 a, bf16x8 b, f32x16 c) { return __builtin_amdgcn_mfma_f32_32x32x16_bf16(a, b, c, 0, 0, 0); }
DEVI unsigned umax(unsigned a, unsigned b) { return a > b ? a : b; }
DEVI unsigned umin(unsigned a, unsigned b) { return a > b ? b : a; }
DEVI unsigned f2ord(float f) { const unsigned u = __float_as_uint(f); return u ^ ((unsigned)((int)u >> 31) | 0x80000000u); }
DEVI float ord2f(unsigned k) { return __uint_as_float((k & 0x80000000u) ? (k ^ 0x80000000u) : ~k); }

template <int BASE>
DEVI void sort16_desc(unsigned (&x)[64]) {
#pragma unroll
    for (int k = 2; k <= 16; k <<= 1) {
#pragma unroll
        for (int j = k >> 1; j > 0; j >>= 1) {
#pragma unroll
            for (int i = 0; i < 16; ++i) {
                const int l = i ^ j;
                if (l > i) {
                    const bool desc = ((i & k) == 0);
                    const unsigned a = x[BASE + i], b = x[BASE + l];
                    const unsigned hi = umax(a, b), lo = umin(a, b);
                    x[BASE + i] = desc ? hi : lo; x[BASE + l] = desc ? lo : hi;
                }
            }
        }
    }
}
template <int BASE>
DEVI void bmerge16_desc(unsigned (&x)[64]) {
#pragma unroll
    for (int j = 8; j > 0; j >>= 1) {
#pragma unroll
        for (int i = 0; i < 16; ++i) {
            const int l = i ^ j;
            if (l > i) { const unsigned a = x[BASE + i], b = x[BASE + l]; x[BASE + i] = umax(a, b); x[BASE + l] = umin(a, b); }
        }
    }
}
DEVI void top16_of_64(unsigned (&x)[64]) {
    sort16_desc<0>(x); sort16_desc<16>(x); sort16_desc<32>(x); sort16_desc<48>(x);
#pragma unroll
    for (int i = 0; i < 16; ++i) x[i] = umax(x[i], x[31 - i]);
    bmerge16_desc<0>(x);
#pragma unroll
    for (int i = 0; i < 16; ++i) x[32 + i] = umax(x[32 + i], x[63 - i]);
    bmerge16_desc<32>(x);
#pragma unroll
    for (int i = 0; i < 16; ++i) x[i] = umax(x[i], x[47 - i]);
    bmerge16_desc<0>(x);
}

DEVI void scores_top16(const bf16_t* __restrict__ SKp, const bf16_t* __restrict__ Qp, int lane, unsigned (&out)[16]) {
    const int r31 = lane & 31, hh = lane >> 5;
    f32x16 acc[4];
#pragma unroll
    for (int nb = 0; nb < 4; ++nb)
#pragma unroll
        for (int r = 0; r < 16; ++r) acc[nb][r] = 0.f;
#pragma unroll
    for (int ks = 0; ks < 8; ++ks) {
        const bf16x8 bq = ldg_frag(Qp + (size_t)r31 * 2048 + ks * 16 + 8 * hh);
#pragma unroll
        for (int nb = 0; nb < 4; ++nb) {
            const bf16x8 ak = ldg_frag(SKp + (size_t)(nb * 32 + r31) * 128 + ks * 16 + 8 * hh);
            acc[nb] = mfma32(ak, bq, acc[nb]);
        }
    }
    unsigned x[64];
    const unsigned hx = (unsigned)hh * 4u;
#pragma unroll
    for (int nb = 0; nb < 4; ++nb)
#pragma unroll
        for (int r = 0; r < 16; ++r) {
            const int nbase = nb * 32 + (r & 3) + 8 * (r >> 2);
            x[nb * 16 + r] = ((f2ord(acc[nb][r]) & ~127u) | (unsigned)(127 - nbase)) ^ hx;
        }
    top16_of_64(x);
    unsigned lo[16], hi[16];
#pragma unroll
    for (int i = 0; i < 16; ++i) { auto rr = __builtin_amdgcn_permlane32_swap(x[i], x[i], false, false); lo[i] = rr[0]; hi[i] = rr[1]; }
#pragma unroll
    for (int i = 0; i < 16; ++i) x[i] = umax(lo[i], hi[15 - i]);
    bmerge16_desc<0>(x);
#pragma unroll
    for (int i = 0; i < 16; ++i) out[i] = x[i];
}

constexpr int P9_UNITS = (M_TOK / 128) * 8;
DEVI void phase9_unit(const Params& p, int u, char* smem) {
    unsigned char* ws = p.ws;
    const int tid = LTID, lane = tid & 63, w = tid >> 6;
    const int tg = u >> 3, h = u & 7;
    const int t0 = tg * 128 + w * 32;
    const int hh = lane >> 5;
    unsigned* KL = reinterpret_cast<unsigned*>(smem) + w * 2048;
    const bf16_t* SK = reinterpret_cast<const bf16_t*>(ws + OFF_SK) + (size_t)(h * 2) * 128 * 128;
    const bf16_t* Q = reinterpret_cast<const bf16_t*>(ws + OFF_Q) + (size_t)t0 * 2048 + h * 256;
    unsigned k0[16], k1[16];
    scores_top16(SK, Q, lane, k0);
    scores_top16(SK + 128 * 128, Q + 128, lane, k1);
#pragma unroll
    for (int i = 0; i < 16; ++i) { KL[i * 64 + lane] = k0[i]; KL[(16 + i) * 64 + lane] = k1[i]; }
    float s0[16], s1[16];
#pragma unroll
    for (int i = 0; i < 16; ++i) { s0[i] = ord2f(k0[i] & ~127u); s1[i] = ord2f(k1[i] & ~127u); }
    unsigned x[64];
    {
        int n = 0;
#pragma unroll
        for (int a = 0; a < 16; ++a)
#pragma unroll
            for (int b = 0; b < 16; ++b)
                if ((a + 1) * (b + 1) <= 16) { x[n] = (f2ord(s0[a] + s1[b]) & ~255u) | (unsigned)(255 - (a * 16 + b)); ++n; }
#pragma unroll
        for (int i = 50; i < 64; ++i) x[i] = 0u;
    }
    top16_of_64(x);
    float cv[16]; int ex[16];
#pragma unroll
    for (int i = 0; i < 16; ++i) {
        cv[i] = ord2f(x[i] & ~255u);
        const int cid = 255 - (int)(x[i] & 255u);
        const unsigned ka = KL[(cid >> 4) * 64 + lane], kb = KL[(16 + (cid & 15)) * 64 + lane];
        ex[i] = (127 - (int)(ka & 127u)) * 128 + (127 - (int)(kb & 127u));
    }
    float sum = 0.f;
    const float mx = cv[0];
#pragma unroll
    for (int i = 0; i < 16; ++i) cv[i] = __expf(cv[i] - mx);
#pragma unroll
    for (int i = 0; i < 16; ++i) sum += cv[i];
    const float inv = 1.f / sum;
    const size_t orow = (size_t)(t0 + (lane & 31)) * 128 + h * 16;
    if (hh == 0) {
        int4* d = reinterpret_cast<int4*>(reinterpret_cast<int*>(ws + OFF_EIDX) + orow);
#pragma unroll
        for (int i = 0; i < 4; ++i) d[i] = make_int4(ex[4 * i], ex[4 * i + 1], ex[4 * i + 2], ex[4 * i + 3]);
        const float* US = reinterpret_cast<const float*>(ws + OFF_US);
        float4* du = reinterpret_cast<float4*>(reinterpret_cast<float*>(ws + OFF_EU) + orow);
#pragma unroll
        for (int i = 0; i < 4; ++i) du[i] = make_float4(US[ex[4 * i]], US[ex[4 * i + 1]], US[ex[4 * i + 2]], US[ex[4 * i + 3]]);
    } else {
        const float* VS = reinterpret_cast<const float*>(ws + OFF_VS);
        float4* d = reinterpret_cast<float4*>(reinterpret_cast<float*>(ws + OFF_EW) + orow);
#pragma unroll
        for (int i = 0; i < 4; ++i) d[i] = make_float4(cv[4 * i] * inv * VS[ex[4 * i]], cv[4 * i + 1] * inv * VS[ex[4 * i + 1]], cv[4 * i + 2] * inv * VS[ex[4 * i + 2]], cv[4 * i + 3] * inv * VS[ex[4 * i + 3]]);
    }
}

typedef _Float16 h2_t __attribute__((ext_vector_type(2)));
DEVI float sum8(float v) { v += __shfl_xor(v, 1); v += __shfl_xor(v, 2); v += __shfl_xor(v, 4); return v; }
DEVI long pack_i64(unsigned lo, unsigned hi) { return (long)(((unsigned long long)hi << 32) | (unsigned long long)lo); }

#define SB __builtin_amdgcn_sched_barrier(0)
#define SB __builtin_amdgcn_sched_barrier(0)
#define PIN4(Q) "+v"(Q.x), "+v"(Q.y), "+v"(Q.z), "+v"(Q.w)
DEVI void phase10a_block(const Params& p, char* smem) {
    unsigned char* ws = p.ws;
    const int s = blockIdx.x & 7, rank = blockIdx.x >> 3, nrank = ((int)gridDim.x - s + 7) >> 3;
    const int lane = threadIdx.x & 63, wave = threadIdx.x >> 6;
    const int lg = lane & 7, grp = lane >> 3;
    const unsigned char* U8 = ws + OFF_U8 + (size_t)s * (16384 * 128) + 16 * lg;
    const bf16_t* HNs = reinterpret_cast<const bf16_t*>(ws + OFF_HN) + 128 * s + 16 * lg;
    float* PD = reinterpret_cast<float*>(ws + OFF_PD) + (size_t)s * M_TOK * 128;
    float* stg = reinterpret_cast<float*>(smem) + wave * (16 * 128);
    constexpr int NTG = M_TOK / 8;
#define P10A_LOAD_EV(TG, E) do { const int4* _q = reinterpret_cast<const int4*>(reinterpret_cast<const int*>(ws + OFF_EIDX) + (size_t)((TG) * 8 + wave) * 128 + 16 * grp); \
        E[0] = _q[0]; E[1] = _q[1]; E[2] = _q[2]; E[3] = _q[3]; } while (0)
#define P10A_LOAD_ROWS(TG, E, R, HA, HB) do { \
        asm volatile("" : PIN4(E[0]), PIN4(E[1]), PIN4(E[2]), PIN4(E[3])); \
        const int _e[16] = {E[0].x, E[0].y, E[0].z, E[0].w, E[1].x, E[1].y, E[1].z, E[1].w, E[2].x, E[2].y, E[2].z, E[2].w, E[3].x, E[3].y, E[3].z, E[3].w}; \
        _Pragma("unroll") for (int _i = 0; _i < 16; ++_i) R[_i] = *reinterpret_cast<const uint4*>(U8 + (size_t)_e[_i] * 128); \
        const bf16_t* _h = HNs + (size_t)((TG) * 8 + wave) * DM; HA = *reinterpret_cast<const uint4*>(_h); HB = *reinterpret_cast<const uint4*>(_h + 8); } while (0)
#define P10A_COMPUTE(SLOT, R, HA, HB) do { \
        asm volatile("" : PIN4(R[0]), PIN4(R[1]), PIN4(R[2]), PIN4(R[3]), PIN4(R[4]), PIN4(R[5])); \
        asm volatile("" : PIN4(R[6]), PIN4(R[7]), PIN4(R[8]), PIN4(R[9]), PIN4(R[10]), PIN4(R[11])); \
        asm volatile("" : PIN4(R[12]), PIN4(R[13]), PIN4(R[14]), PIN4(R[15]), PIN4(HA), PIN4(HB)); \
        const unsigned _hw[8] = {HA.x, HA.y, HA.z, HA.w, HB.x, HB.y, HB.z, HB.w}; \
        h2_t _hn[8]; \
        _Pragma("unroll") for (int _j = 0; _j < 8; ++_j) _hn[_j] = h2_t{(_Float16)bflo(_hw[_j]), (_Float16)bfhi(_hw[_j])}; \
        float _v1 = 0.f, _v2 = 0.f; \
        _Pragma("unroll") for (int _i = 0; _i < 16; ++_i) { \
            const unsigned _wd[4] = {R[_i].x, R[_i].y, R[_i].z, R[_i].w}; \
            float _a = 0.f; \
            _Pragma("unroll") for (int _j = 0; _j < 4; ++_j) { \
                _a = __builtin_amdgcn_fdot2(__builtin_amdgcn_cvt_scalef32_pk_f16_fp8((int)_wd[_j], 1.0f, false), _hn[2 * _j], _a, false); \
                _a = __builtin_amdgcn_fdot2(__builtin_amdgcn_cvt_scalef32_pk_f16_fp8((int)_wd[_j], 1.0f, true), _hn[2 * _j + 1], _a, false); } \
            _a = sum8(_a); \
            if (_i < 8) _v1 = (lg == _i) ? _a : _v1; else _v2 = (lg == _i - 8) ? _a : _v2; } \
        stg[(SLOT) * 128 + 16 * grp + lg] = _v1; stg[(SLOT) * 128 + 16 * grp + 8 + lg] = _v2; } while (0)
    int4 eA[4], eB[4], eC[4]; uint4 rA[16], rB[16]; uint4 hA0, hA1, hB0, hB1;
    if (rank >= NTG) return;
    const int ntok = (NTG - rank + nrank - 1) / nrank;
#define TGI(I) (rank + ((I) < ntok ? (I) : ntok - 1) * nrank)
    P10A_LOAD_EV(TGI(0), eA);
    SB; P10A_LOAD_EV(TGI(1), eB);
    SB; P10A_LOAD_ROWS(TGI(0), eA, rA, hA0, hA1);
    SB;
    for (int base = 0; base < ntok; base += 16) {
#pragma unroll 1
        for (int i = base; i < base + 16; i += 2) {
            SB; P10A_LOAD_EV(TGI(i + 2), eC);
            SB; P10A_LOAD_ROWS(TGI(i + 1), eB, rB, hB0, hB1);
            SB; P10A_COMPUTE(i - base, rA, hA0, hA1);
            SB; P10A_LOAD_EV(TGI(i + 3), eB);
            SB; P10A_LOAD_ROWS(TGI(i + 2), eC, rA, hA0, hA1);
            SB; P10A_COMPUTE(i + 1 - base, rB, hB0, hB1);
            SB;
        }
#pragma unroll 4
        for (int j = 0; j < 16; ++j) {
            const float2 v = *reinterpret_cast<const float2*>(stg + j * 128 + 2 * lane);
            *reinterpret_cast<float2*>(PD + (size_t)(TGI(base + j) * 8 + wave) * 128 + 2 * lane) = v;
        }
        __builtin_amdgcn_s_waitcnt(0x0F70);
    }
#undef TGI
#undef P10A_LOAD_EV
#undef P10A_LOAD_ROWS
#undef P10A_COMPUTE
}

DEVI void phase10b_block(const Params& p, char* smem) {
    unsigned char* ws = p.ws;
    const int s = blockIdx.x & 7, rank = blockIdx.x >> 3, nrank = ((int)gridDim.x - s + 7) >> 3;
    const int lane = threadIdx.x & 63, wave = threadIdx.x >> 6;
    const int lg = lane & 7, grp = lane >> 3;
    const unsigned char* V8 = ws + OFF_V8 + (size_t)s * (16384 * 128) + 16 * lg;
    const float* PD = reinterpret_cast<const float*>(ws + OFF_PD);
    float* wl = reinterpret_cast<float*>(smem) + wave * 256;
    float* stg = reinterpret_cast<float*>(smem) + 8 * 256 + wave * (16 * 128);
    float* sst = reinterpret_cast<float*>(smem) + 8 * 256 + 8 * (16 * 128) + wave * 16;
    constexpr int NTG = M_TOK / 8;
#define P10B_W_LOAD(TG, D0, D1, U0, U1, G0, G1, HSV) do { const size_t _t = (size_t)((TG) * 8 + wave); \
        _Pragma("unroll") for (int _sl = 0; _sl < 8; ++_sl) { D0[_sl] = PD[((size_t)_sl * M_TOK + _t) * 128 + lane]; D1[_sl] = PD[((size_t)_sl * M_TOK + _t) * 128 + 64 + lane]; } \
        U0 = reinterpret_cast<const float*>(ws + OFF_EU)[_t * 128 + lane]; U1 = reinterpret_cast<const float*>(ws + OFF_EU)[_t * 128 + 64 + lane]; \
        G0 = reinterpret_cast<const float*>(ws + OFF_EW)[_t * 128 + lane]; G1 = reinterpret_cast<const float*>(ws + OFF_EW)[_t * 128 + 64 + lane]; \
        HSV = 1.f; } while (0)
#define P10B_W_FINISH(BUF, D0, D1, U0, U1, G0, G1, HSV) do { \
        asm volatile("" : "+v"(D0[0]), "+v"(D0[1]), "+v"(D0[2]), "+v"(D0[3]), "+v"(D0[4]), "+v"(D0[5]), "+v"(D0[6]), "+v"(D0[7]), \
                          "+v"(D1[0]), "+v"(D1[1]), "+v"(D1[2]), "+v"(D1[3]), "+v"(D1[4]), "+v"(D1[5]), "+v"(D1[6]), "+v"(D1[7]), \
                          "+v"(U0), "+v"(U1), "+v"(G0), "+v"(G1), "+v"(HSV));     \
        const float _s0 = ((D0[0] + D0[1]) + (D0[2] + D0[3])) + ((D0[4] + D0[5]) + (D0[6] + D0[7])); \
        const float _s1 = ((D1[0] + D1[1]) + (D1[2] + D1[3])) + ((D1[4] + D1[5]) + (D1[6] + D1[7])); \
        const float _d0 = _s0 * U0 * HSV, _d1 = _s1 * U1 * HSV; \
        wl[(BUF) * 128 + lane] = G0 * 0.5f * _d0 * (1.f + erff(_d0 * 0.70710678118654752f)); \
        wl[(BUF) * 128 + 64 + lane] = G1 * 0.5f * _d1 * (1.f + erff(_d1 * 0.70710678118654752f)); } while (0)
#define P10B_LOAD_EV(TG, E) do { const int4* _q = reinterpret_cast<const int4*>(reinterpret_cast<const int*>(ws + OFF_EIDX) + (size_t)((TG) * 8 + wave) * 128 + 16 * grp); \
        E[0] = _q[0]; E[1] = _q[1]; E[2] = _q[2]; E[3] = _q[3]; } while (0)
#define P10B_LOAD_ROWS(TG, E, R) do { \
        asm volatile("" : "+v"(E[0].x), "+v"(E[0].y), "+v"(E[0].z), "+v"(E[0].w), "+v"(E[1].x), "+v"(E[1].y), "+v"(E[1].z), "+v"(E[1].w), \
                          "+v"(E[2].x), "+v"(E[2].y), "+v"(E[2].z), "+v"(E[2].w), "+v"(E[3].x), "+v"(E[3].y), "+v"(E[3].z), "+v"(E[3].w)); \
        const int _e[16] = {E[0].x, E[0].y, E[0].z, E[0].w, E[1].x, E[1].y, E[1].z, E[1].w, E[2].x, E[2].y, E[2].z, E[2].w, E[3].x, E[3].y, E[3].z, E[3].w}; \
        _Pragma("unroll") for (int _i = 0; _i < 16; ++_i) R[_i] = *reinterpret_cast<const uint4*>(V8 + (size_t)_e[_i] * 128); } while (0)
#define P10B_COMPUTE(SLOT, BUF, R) do { \
          \
        asm volatile("" : PIN4(R[0]), PIN4(R[1]), PIN4(R[2]), PIN4(R[3]), PIN4(R[4]), PIN4(R[5])); \
        asm volatile("" : PIN4(R[6]), PIN4(R[7]), PIN4(R[8]), PIN4(R[9]), PIN4(R[10]), PIN4(R[11])); \
        asm volatile("" : PIN4(R[12]), PIN4(R[13]), PIN4(R[14]), PIN4(R[15])); \
        h2_t _acc[8]; unsigned _zb; asm volatile("v_mov_b32 %0, 0" : "=v"(_zb)); \
        _Pragma("unroll") for (int _j = 0; _j < 8; ++_j) _acc[_j] = __builtin_bit_cast(h2_t, _zb); \
        _Pragma("unroll") for (int _i = 0; _i < 16; ++_i) { \
            const _Float16 _w = (_Float16)wl[(BUF) * 128 + 16 * grp + _i]; const h2_t _wp = h2_t{_w, _w}; \
            const unsigned _wd[4] = {R[_i].x, R[_i].y, R[_i].z, R[_i].w}; \
            _Pragma("unroll") for (int _j = 0; _j < 4; ++_j) { \
                _acc[2 * _j] += _wp * __builtin_amdgcn_cvt_scalef32_pk_f16_fp8((int)_wd[_j], 1.0f, false); \
                _acc[2 * _j + 1] += _wp * __builtin_amdgcn_cvt_scalef32_pk_f16_fp8((int)_wd[_j], 1.0f, true); } } \
        float _o[16]; \
        _Pragma("unroll") for (int _j = 0; _j < 8; ++_j) { \
            h2_t _x = _acc[_j]; \
            _x += __builtin_bit_cast(h2_t, __shfl_xor(__builtin_bit_cast(int, _x), 8)); \
            { auto _s = __builtin_amdgcn_permlane16_swap(__builtin_bit_cast(unsigned, _x), __builtin_bit_cast(unsigned, _x), false, false); _x = __builtin_bit_cast(h2_t, (unsigned)_s[0]) + __builtin_bit_cast(h2_t, (unsigned)_s[1]); } \
            { auto _s = __builtin_amdgcn_permlane32_swap(__builtin_bit_cast(unsigned, _x), __builtin_bit_cast(unsigned, _x), false, false); _x = __builtin_bit_cast(h2_t, (unsigned)_s[0]) + __builtin_bit_cast(h2_t, (unsigned)_s[1]); } \
            _o[2 * _j] = (float)_x[0]; _o[2 * _j + 1] = (float)_x[1]; } \
        if (grp == 0) { float* _orow = stg + (SLOT) * 128 + 16 * lg; \
            _Pragma("unroll") for (int _i = 0; _i < 4; ++_i) *reinterpret_cast<float4*>(_orow + 4 * _i) = make_float4(_o[4 * _i], _o[4 * _i + 1], _o[4 * _i + 2], _o[4 * _i + 3]); } } while (0)
    int4 eA[4], eB[4], eC[4]; uint4 rA[16], rB[16];
    float d0[8], d1[8], u0, u1, g0, g1, hsv;
    if (rank >= NTG) return;
    const int ntok = (NTG - rank + nrank - 1) / nrank;
#define TGI(I) (rank + ((I) < ntok ? (I) : ntok - 1) * nrank)
    P10B_LOAD_EV(TGI(0), eA);
    SB; P10B_W_LOAD(TGI(0), d0, d1, u0, u1, g0, g1, hsv);
    SB; P10B_LOAD_EV(TGI(1), eB);
    SB; P10B_LOAD_ROWS(TGI(0), eA, rA);
    SB; P10B_W_FINISH(0, d0, d1, u0, u1, g0, g1, hsv);
    SB;
    for (int base = 0; base < ntok; base += 16) {
#pragma unroll 1
        for (int i = base; i < base + 16; i += 2) {
            SB; P10B_W_LOAD(TGI(i + 1), d0, d1, u0, u1, g0, g1, hsv);
            SB; P10B_LOAD_EV(TGI(i + 2), eC);
            SB; P10B_LOAD_ROWS(TGI(i + 1), eB, rB);
            SB; P10B_COMPUTE(i - base, 0, rA);
            SB; P10B_W_FINISH(1, d0, d1, u0, u1, g0, g1, hsv);
            SB; P10B_W_LOAD(TGI(i + 2), d0, d1, u0, u1, g0, g1, hsv);
            SB; P10B_LOAD_EV(TGI(i + 3), eB);
            SB; P10B_LOAD_ROWS(TGI(i + 2), eC, rA);
            SB; P10B_COMPUTE(i + 1 - base, 1, rB);
            SB; P10B_W_FINISH(0, d0, d1, u0, u1, g0, g1, hsv);
            SB;
        }
        float ssv = 0.f;
#pragma unroll 4
        for (int j = 0; j < 16; ++j) {
            if (base + j < ntok) {
                const size_t ro = (size_t)(TGI(base + j) * 8 + wave) * DM + 128 * s + 2 * lane;
                const float2 v = *reinterpret_cast<const float2*>(stg + j * 128 + 2 * lane);
                const float2 hv = *reinterpret_cast<const float2*>(p.out + ro);
                const float2 r = make_float2(hv.x + v.x, hv.y + v.y);
                *reinterpret_cast<float2*>(p.out + ro) = r;
                const float sq = wave_sum(r.x * r.x + r.y * r.y);
                ssv = (lane == j) ? sq : ssv;
            }
        }
        if (lane < 16 && base + lane < ntok) reinterpret_cast<float*>(ws + OFF_SSQ)[(size_t)(TGI(base + lane) * 8 + wave) * 8 + s] = ssv;
        __builtin_amdgcn_s_waitcnt(0x0F70);
    }
#undef SB
#undef TGI
#undef P10B_W_LOAD
#undef P10B_W_FINISH
#undef P10B_LOAD_EV
#undef P10B_LOAD_ROWS
#undef P10B_COMPUTE
}

DEVI void phase10c_block(const Params& p) {
    unsigned char* ws = p.ws;
    const int lane = threadIdx.x & 63, wave = threadIdx.x >> 6;
    for (int t = blockIdx.x * 8 + wave; t < M_TOK; t += gridDim.x * 8) {
        const float* sq = reinterpret_cast<const float*>(ws + OFF_SSQ) + (size_t)t * 8;
        const float4 a = *reinterpret_cast<const float4*>(sq), b = *reinterpret_cast<const float4*>(sq + 4);
        const float r = rsqrtf((a.x + a.y + a.z + a.w + b.x + b.y + b.z + b.w) * (1.f / 1024.f) + 1e-6f);
        float4* orow = reinterpret_cast<float4*>(p.out + (size_t)t * DM);
        const float4* gf = reinterpret_cast<const float4*>(p.norm_f_g);
#pragma unroll
        for (int i = 0; i < 4; ++i) {
            const float4 v = orow[lane + 64 * i], g = gf[lane + 64 * i];
            orow[lane + 64 * i] = make_float4(v.x * r * g.x, v.y * r * g.y, v.z * r * g.z, v.w * r * g.w);
        }
    }
}

#define XB_TMO      128
#define XB_XCNT(j)  (256  + 64 * (j))
#define XB_XSUB(j)  (1280 + 64 * (j))
#define XB_XGEN(j)  (2304 + 64 * (j))
#define XB_TOP      3328
#define XB_TOPGEN   3392
#define XCD_BAR_WORDS 3456
#define XB_SPIN_CAP (1u << 22)
#define LAS __attribute__((address_space(3)))
DEVI unsigned xb_ld(unsigned* p)              { return __hip_atomic_load(p, __ATOMIC_RELAXED, __HIP_MEMORY_SCOPE_AGENT); }
DEVI unsigned xb_add(unsigned* p, unsigned v) { return __hip_atomic_fetch_add(p, v, __ATOMIC_RELAXED, __HIP_MEMORY_SCOPE_AGENT); }
DEVI unsigned xb_xcc_id() { return (unsigned)__builtin_amdgcn_s_getreg((3 << 11) | 20) & 0xFu; }
#define XB_SPIN(cond, bar) do { unsigned _sp = 0; while (cond) { __builtin_amdgcn_s_sleep(1); \
    if ((++_sp & 255u) == 0u) { if (xb_ld(&(bar)[XB_TMO])) break; if (_sp > XB_SPIN_CAP) { atomicAdd(&(bar)[XB_TMO], 1u); break; } } } } while (0)
struct XcdBarrier { unsigned* bar; unsigned x; volatile LAS unsigned* st; };
DEVI XcdBarrier xcd_barrier_post(unsigned* bar, volatile LAS unsigned* st) {
    XcdBarrier b; b.bar = bar; b.x = xb_xcc_id(); b.st = st;
    if (threadIdx.x == 0) (void)xb_add(&bar[XB_XCNT(b.x)], 1u);
    return b;
}
DEVI void xcd_barrier_complete(unsigned* bar, unsigned x, unsigned& nloc, unsigned& nx) {
    const unsigned G = gridDim.x * gridDim.y * gridDim.z;
    unsigned sum, cnt, mine, sp = 0u;
    for (;;) {
        sum = 0u; cnt = 0u; mine = 0u;
#pragma unroll
        for (unsigned j = 0; j < 16; ++j) { const unsigned c = xb_ld(&bar[XB_XCNT(j)]); sum += c; cnt += (c > 0u) ? 1u : 0u; mine = (j == x) ? c : mine; }
        if (sum == G) break;
        __builtin_amdgcn_s_sleep(1);
        if ((++sp & 255u) == 0u) { if (xb_ld(&bar[XB_TMO])) break; if (sp > XB_SPIN_CAP) { atomicAdd(&bar[XB_TMO], 1u); break; } }
    }
    nloc = mine > 0u ? mine : 1u; nx = cnt > 0u ? cnt : 1u;
}
DEVI void xcd_barrier(const XcdBarrier& b) {
    asm volatile("s_waitcnt vmcnt(0)" ::: "memory");
    __syncthreads();
    if (threadIdx.x == 0) {
        unsigned* bar = b.bar;
        __builtin_amdgcn_s_waitcnt(0);
        unsigned nloc = b.st[0], nx = b.st[1];
        if (nloc == 0u) { xcd_barrier_complete(bar, b.x, nloc, nx); b.st[0] = nloc; b.st[1] = nx; }
        const unsigned old = xb_add(&bar[XB_XSUB(b.x)], 1u);
        const unsigned gen = old / nloc;
        if (old + 1u == (gen + 1u) * nloc) {
            __builtin_amdgcn_fence(__ATOMIC_RELEASE, "agent");
            asm volatile("s_waitcnt vmcnt(0)" ::: "memory");
            const unsigned og = xb_add(&bar[XB_TOP], 1u);
            const unsigned tg = og / nx;
            if (og + 1u == (tg + 1u) * nx) xb_add(&bar[XB_TOPGEN], 1u);
            else XB_SPIN(xb_ld(&bar[XB_TOPGEN]) == tg, bar);
            __builtin_amdgcn_fence(__ATOMIC_ACQUIRE, "agent");
            xb_add(&bar[XB_XGEN(b.x)], 1u);
            asm volatile("s_waitcnt vmcnt(0)" ::: "memory");
        } else {
            XB_SPIN(xb_ld(&bar[XB_XGEN(b.x)]) == gen, bar);
            __builtin_amdgcn_fence(__ATOMIC_ACQUIRE, "agent");
            asm volatile("s_waitcnt vmcnt(0)" ::: "memory");
        }
    }
    __syncthreads();
}

constexpr int N_PHASES = 11;
constexpr int LDS_PHASE_BYTES = 131072;
constexpr int LDS_BYTES = LDS_PHASE_BYTES + 16;

__global__ void __launch_bounds__(512, 2) hymba_fwd(Params p) {
    extern __shared__ __attribute__((aligned(16))) char smem[];
    cg::grid_group grid = cg::this_grid();
    const int lo = p.ph_lo, hi = p.ph_hi;
    volatile LAS unsigned* bst = (volatile LAS unsigned*)(smem + LDS_PHASE_BYTES);
    if (threadIdx.x == 0) { bst[0] = 0u; bst[1] = 0u; bst[2] = 0u; bst[3] = 0u; }
    __syncthreads();
    XcdBarrier xb = xcd_barrier_post(reinterpret_cast<unsigned*>(p.ws + OFF_BAR), bst);
    const int hb = (int)(threadIdx.x >> 8);
    char* hsm = smem + hb * 65536;
#define SEAM(K) if ((K) > lo) { if ((K) == lo + 1) grid.sync(); else xcd_barrier(xb); }
#define RUN_PHASE(K, FN, N) if (lo <= (K) && (K) < hi) { SEAM(K) for (int rep = 0; rep < 1 + ((PROBE_DUP >> (K)) & 1); ++rep) { if (rep) xcd_barrier(xb); \
        for (int ub = blockIdx.x * 2; ub < (N); ub += gridDim.x * 2) { const int u = ub + hb; if (u < (N)) FN(p, u, hsm); } } }
#define RUN_GEMM(K, CALL) if (lo <= (K) && (K) < hi) { SEAM(K) CALL; }
    RUN_PHASE(0, phase0_unit, P0_UNITS)
    RUN_GEMM(1, run_gemm(reinterpret_cast<const bf16_t*>(p.ws + OFF_XN), reinterpret_cast<const bf16_t*>(p.ws + OFF_WIN), P1_N, EpiInProj{p.ws}, smem))
    RUN_PHASE(2, phase2_unit, P2_UNITS)
    RUN_PHASE(3, phase3_unit, P3_UNITS)
    RUN_PHASE(4, phase4_unit, P4_UNITS)
    RUN_PHASE(5, phase5_unit, P5_UNITS)
    RUN_GEMM(6, run_gemm(reinterpret_cast<const bf16_t*>(p.ws + OFF_MIX), reinterpret_cast<const bf16_t*>(p.ws + OFF_WOUT), 1024, EpiOutProj{p.x, p.out}, smem))
    RUN_PHASE(7, phase7_unit, P7_UNITS)
    RUN_GEMM(8, run_gemm(reinterpret_cast<const bf16_t*>(p.ws + OFF_HN), reinterpret_cast<const bf16_t*>(p.ws + OFF_WQ), 2048, EpiQ{reinterpret_cast<bf16_t*>(p.ws + OFF_Q)}, smem))
    RUN_PHASE(9, phase9_unit, P9_UNITS)
    if (lo <= 10 && 10 < hi) {
        SEAM(10)
#if PROBE_P10X == 4
        phase10a_block(p, smem); xcd_barrier(xb);
#endif
        phase10a_block(p, smem);
#if PROBE_P10X == 1
        xcd_barrier(xb); phase10a_block(p, smem);
#endif

        xcd_barrier(xb); phase10b_block(p, smem);
#if PROBE_P10X == 2
        xcd_barrier(xb); phase10b_block(p, smem);
#endif
        xcd_barrier(xb); phase10c_block(p);
#if PROBE_P10X == 3
        xcd_barrier(xb); phase10c_block(p);
#endif
    }
#undef RUN_PHASE
#undef RUN_GEMM
#undef SEAM
}

extern "C" void kernel_launch(void* const* d_in, const int* in_sizes, int n_in, void* d_out, int out_size, void* d_ws, size_t ws_size, hipStream_t stream) {
    static int grid_blocks = 0;
    if (grid_blocks == 0) {
        if (n_in != 15 || in_sizes[0] != M_TOK * DM || out_size != M_TOK * DM || ws_size < WS_NEED) {
            fprintf(stderr, "kernel_launch: unexpected shapes (n_in %d, in0 %d, out %d, ws %zu)\n", n_in, n_in > 0 ? in_sizes[0] : -1, out_size, ws_size);
            grid_blocks = -1; return;
        }
        int dev = 0, cus = 0, per_cu = 0;
        (void)hipGetDevice(&dev);
        (void)hipDeviceGetAttribute(&cus, hipDeviceAttributeMultiprocessorCount, dev);
        (void)hipFuncSetAttribute((const void*)hymba_fwd, hipFuncAttributeMaxDynamicSharedMemorySize, LDS_BYTES);
        (void)hipOccupancyMaxActiveBlocksPerMultiprocessor(&per_cu, (const void*)hymba_fwd, 512, LDS_BYTES);
        if (per_cu < 1) per_cu = 1;
        if (per_cu > 1) per_cu = 1;
        grid_blocks = cus * per_cu;
    }
    if (grid_blocks < 0) return;
    Params p{};
    p.x = (const float*)d_in[0]; p.norm1_g = (const float*)d_in[1]; p.w_in = (const float*)d_in[2]; p.hg_lower = (const float*)d_in[3];
    p.hg_norm_g = (const float*)d_in[4]; p.gla_wg = (const float*)d_in[5]; p.gla_bg = (const float*)d_in[6]; p.gla_norm_g = (const float*)d_in[7];
    p.w_out = (const float*)d_in[8]; p.norm2_g = (const float*)d_in[9]; p.w_q = (const float*)d_in[10]; p.sub_keys = (const float*)d_in[11];
    p.peer_u = (const float*)d_in[12]; p.peer_v = (const float*)d_in[13]; p.norm_f_g = (const float*)d_in[14];
    p.out = (float*)d_out; p.ws = (unsigned char*)d_ws;
#if N_LAUNCH_MODE == 1
    (void)hipMemsetAsync((unsigned char*)d_ws + OFF_BAR, 0, XCD_BAR_WORDS * 4, stream);
    p.ph_lo = 0; p.ph_hi = N_PHASES;
    void* args[] = {&p};
    hipError_t e = hipLaunchCooperativeKernel((const void*)hymba_fwd, dim3(grid_blocks), dim3(512), args, LDS_BYTES, stream);
    if (e != hipSuccess) fprintf(stderr, "cooperative launch failed: %s (grid %d)\n", hipGetErrorString(e), grid_blocks);
#else
    for (int ph = 0; ph < N_PHASES; ++ph) {
        p.ph_lo = ph; p.ph_hi = ph + 1;
        hipLaunchKernelGGL(hymba_fwd, dim3(grid_blocks), dim3(512), LDS_BYTES, stream, p);
    }
#endif
}
```

```cpp
#include <hip/hip_runtime.h>
#include <hip/hip_cooperative_groups.h>
#include <cstdio>
#include <cstdint>
namespace cg = cooperative_groups;

#ifndef N_LAUNCH_MODE
#define N_LAUNCH_MODE 1
#endif

#ifndef PROBE_DUP
#define PROBE_DUP 0
#endif
#ifndef PROBE_P10_DUP
#define PROBE_P10_DUP 0
#endif
#ifndef P10_SLICED
#define P10_SLICED 0
#endif
#ifndef PROBE_P10A
#define PROBE_P10A 0
#endif
#ifndef PROBE_P10_MASK
#define PROBE_P10_MASK 0x7fffffff
#endif
#ifndef PROBE_P10X
#define PROBE_P10X 0
#endif
#ifndef PROBE_GEMM_DUP
#define PROBE_GEMM_DUP 0
#endif
#define DEVI __device__ __forceinline__
#define LTID ((int)(threadIdx.x & 255u))
typedef unsigned short bf16_t;
using bf16x8 = __attribute__((ext_vector_type(8))) short;
using f32x4 = __attribute__((ext_vector_type(4))) float;

constexpr int M_TOK = 32768;
constexpr int DM = 1024;
constexpr int IN_WP = 3840;
constexpr size_t MiB = 1024ull * 1024ull;

constexpr size_t OFF_XN   = 0;
constexpr size_t OFF_WIN  = 64 * MiB;
constexpr size_t OFF_WOUT = 72 * MiB;
constexpr size_t OFF_WQ   = 74 * MiB;
constexpr size_t OFF_SK   = 78 * MiB;
constexpr size_t OFF_LB   = 79 * MiB;
constexpr size_t OFF_U8   = 80 * MiB;
constexpr size_t OFF_V8   = 96 * MiB;
constexpr size_t OFF_US   = 112 * MiB;
constexpr size_t OFF_VS   = 113 * MiB;
constexpr size_t OFF_R2   = 144 * MiB;
constexpr size_t OFF_HQ   = OFF_R2;
constexpr size_t OFF_HLF  = OFF_R2 + 32 * MiB;
constexpr size_t OFF_HV   = OFF_R2 + 64 * MiB;
constexpr size_t OFF_HG   = OFF_R2 + 96 * MiB;
constexpr size_t OFF_GQ   = OFF_R2 + 128 * MiB;
constexpr size_t OFF_GK   = OFF_R2 + 144 * MiB;
constexpr size_t OFF_GV   = OFF_R2 + 160 * MiB;
constexpr size_t OFF_GG   = OFF_R2 + 192 * MiB;
constexpr size_t OFF_GLOW = OFF_R2 + 224 * MiB;
constexpr size_t OFF_KTH  = 370 * MiB;
constexpr size_t OFF_KTG  = 402 * MiB;
constexpr size_t OFF_DECH = 418 * MiB;
constexpr size_t OFF_DECG = 419 * MiB;
constexpr size_t OFF_HVT  = 420 * MiB;
constexpr size_t OFF_GVT  = 452 * MiB;
constexpr size_t OFF_BAR  = 484 * MiB;
constexpr size_t WS_NEED  = 485 * MiB;
constexpr size_t OFF_MIX  = OFF_XN;
constexpr size_t OFF_HN   = OFF_R2;
constexpr size_t OFF_Q    = OFF_R2 + 64 * MiB;
constexpr size_t OFF_EIDX = OFF_KTH;
constexpr size_t OFF_EW   = OFF_KTH + 16 * MiB;
constexpr size_t OFF_EU   = OFF_KTG;
constexpr size_t OFF_HN8  = OFF_XN;
constexpr size_t OFF_HS   = OFF_XN + 32 * MiB;
constexpr size_t OFF_W16  = OFF_XN + 48 * MiB;
constexpr size_t OFF_SSQ  = OFF_XN + 33 * MiB;
constexpr size_t OFF_PD   = OFF_Q;
constexpr size_t OUT_STH = 0;
constexpr size_t OUT_STG = 64 * MiB;

struct Params {
    const float* x; const float* norm1_g; const float* w_in; const float* hg_lower; const float* hg_norm_g;
    const float* gla_wg; const float* gla_bg; const float* gla_norm_g; const float* w_out; const float* norm2_g;
    const float* w_q; const float* sub_keys; const float* peer_u; const float* peer_v; const float* norm_f_g;
    float* out; unsigned char* ws;
    int ph_lo, ph_hi;
};

DEVI unsigned short f2bf(float f) {
    unsigned u = __float_as_uint(f);
    u += 0x7fffu + ((u >> 16) & 1u);
    return (unsigned short)(u >> 16);
}
DEVI float bf2f(unsigned short b) { return __uint_as_float(((unsigned)b) << 16); }
DEVI unsigned pack2(float a, float b) { return (unsigned)f2bf(a) | ((unsigned)f2bf(b) << 16); }
DEVI float bflo(unsigned u) { return __uint_as_float(u << 16); }
DEVI float bfhi(unsigned u) { return __uint_as_float(u & 0xffff0000u); }
DEVI float wave_sum(float v) {
#pragma unroll
    for (int o = 32; o > 0; o >>= 1) v += __shfl_xor(v, o);
    return v;
}
DEVI float wave_max(float v) {
#pragma unroll
    for (int o = 32; o > 0; o >>= 1) v = fmaxf(v, __shfl_xor(v, o));
    return v;
}
DEVI float silu_f(float x) { return x / (1.f + __expf(-x)); }
DEVI f32x4 mfma16(bf16x8 a, bf16x8 b, f32x4 c) { return __builtin_amdgcn_mfma_f32_16x16x32_bf16(a, b, c, 0, 0, 0); }
DEVI bf16x8 ldg_frag(const bf16_t* p) { return *reinterpret_cast<const bf16x8*>(p); }

DEVI void rms_row_bf16(const float* __restrict__ xr, const float* __restrict__ g, bf16_t* __restrict__ dst, int lane) {
    float4 v[4]; float ss = 0.f;
#pragma unroll
    for (int i = 0; i < 4; ++i) { v[i] = reinterpret_cast<const float4*>(xr)[lane + 64 * i]; ss += v[i].x * v[i].x + v[i].y * v[i].y + v[i].z * v[i].z + v[i].w * v[i].w; }
    ss = wave_sum(ss);
    const float r = rsqrtf(ss * (1.f / 1024.f) + 1e-6f);
#pragma unroll
    for (int i = 0; i < 4; ++i) {
        const float4 gg = reinterpret_cast<const float4*>(g)[lane + 64 * i];
        uint2 o; o.x = pack2(v[i].x * r * gg.x, v[i].y * r * gg.y); o.y = pack2(v[i].z * r * gg.z, v[i].w * r * gg.w);
        reinterpret_cast<uint2*>(dst)[lane + 64 * i] = o;
    }
}

DEVI void transpose_tile(const float* __restrict__ src, int Nsrc, bf16_t* __restrict__ dst, int nt, int kt, int mode, float* lds) {
    const int tid = LTID, tx = tid & 63, ty = tid >> 6;
    const int np = nt * 64 + tx;
    int col = np; bool valid = true;
    if (mode == 1) {
        if (np < 3072) col = np; else if (np < 3584) col = np + 16; else if (np < 3600) col = np - 512; else { valid = false; col = 0; }
    }
#pragma unroll 4
    for (int kk = ty; kk < 64; kk += 4) {
        lds[kk * 65 + tx] = valid ? src[(size_t)(kt * 64 + kk) * Nsrc + col] : 0.f;
    }
    __syncthreads();
    const int nl = tid >> 2, kq = tid & 3;
    unsigned pk[8];
#pragma unroll
    for (int i = 0; i < 8; ++i) pk[i] = pack2(lds[(kq * 16 + 2 * i) * 65 + nl], lds[(kq * 16 + 2 * i + 1) * 65 + nl]);
    uint4* d = reinterpret_cast<uint4*>(dst + (size_t)(nt * 64 + nl) * 1024 + kt * 64 + kq * 16);
    d[0] = make_uint4(pk[0], pk[1], pk[2], pk[3]);
    d[1] = make_uint4(pk[4], pk[5], pk[6], pk[7]);
    __syncthreads();
}

DEVI void convert8(const float* __restrict__ src, bf16_t* __restrict__ dst, size_t idx8) {
    const float4 a = reinterpret_cast<const float4*>(src)[idx8 * 2], b = reinterpret_cast<const float4*>(src)[idx8 * 2 + 1];
    reinterpret_cast<uint4*>(dst)[idx8] = make_uint4(pack2(a.x, a.y), pack2(a.z, a.w), pack2(b.x, b.y), pack2(b.z, b.w));
}

DEVI int pack_i8x4(float a, float b, float c, float d) {
    const int ia = (int)rintf(a), ib = (int)rintf(b), ic = (int)rintf(c), id = (int)rintf(d);
    return (ia & 255) | ((ib & 255) << 8) | ((ic & 255) << 16) | (id << 24);
}
DEVI void quant_row_i8(const float* __restrict__ xr, unsigned char* __restrict__ dst_table, int row, float* __restrict__ descale, int lane) {
    float4 v[4]; float am = 0.f;
#pragma unroll
    for (int i = 0; i < 4; ++i) { v[i] = reinterpret_cast<const float4*>(xr)[lane + 64 * i]; am = fmaxf(am, fmaxf(fmaxf(fabsf(v[i].x), fabsf(v[i].y)), fmaxf(fabsf(v[i].z), fabsf(v[i].w)))); }
    am = wave_max(am);
    const float sc = am > 0.f ? 127.f / am : 1.f;
#pragma unroll
    for (int i = 0; i < 4; ++i) {
        const int w = lane + 64 * i;
        reinterpret_cast<int*>(dst_table)[(size_t)(w >> 5) * (16384 * 32) + (size_t)row * 32 + (w & 31)] = pack_i8x4(v[i].x * sc, v[i].y * sc, v[i].z * sc, v[i].w * sc);
    }
    if (lane == 0) *descale = am > 0.f ? am * (1.f / 127.f) : 1.f;
}
DEVI void quant_row_fp8(const float* __restrict__ xr, unsigned char* __restrict__ dst_table, int row, float* __restrict__ descale, int lane) {
    float4 v[4]; float am = 0.f;
#pragma unroll
    for (int i = 0; i < 4; ++i) { v[i] = reinterpret_cast<const float4*>(xr)[lane + 64 * i]; am = fmaxf(am, fmaxf(fmaxf(fabsf(v[i].x), fabsf(v[i].y)), fmaxf(fabsf(v[i].z), fabsf(v[i].w)))); }
    am = wave_max(am);
    const float sc = am > 0.f ? 448.f / am : 1.f;
#pragma unroll
    for (int i = 0; i < 4; ++i) {
        const float a = fminf(fmaxf(v[i].x * sc, -448.f), 448.f), b = fminf(fmaxf(v[i].y * sc, -448.f), 448.f);
        const float c = fminf(fmaxf(v[i].z * sc, -448.f), 448.f), d = fminf(fmaxf(v[i].w * sc, -448.f), 448.f);
        int pk = __builtin_amdgcn_cvt_pk_fp8_f32(a, b, 0, false);
        pk = __builtin_amdgcn_cvt_pk_fp8_f32(c, d, pk, true);
        const int w = lane + 64 * i;
        reinterpret_cast<int*>(dst_table)[(size_t)(w >> 5) * (16384 * 32) + (size_t)row * 32 + (w & 31)] = pk;
    }
    if (lane == 0) *descale = am > 0.f ? am * (1.f / 448.f) : 1.f;
}

constexpr int P0_XN = 8192, P0_WIN = 60 * 16, P0_WOUT = 16 * 16, P0_WQ = 32 * 16, P0_UV = 8192, P0_SK = 128, P0_LB = 1;
constexpr int P0_UNITS = P0_XN + P0_WIN + P0_WOUT + P0_WQ + P0_UV + P0_SK + P0_LB;

DEVI void phase0_unit(const Params& p, int u, char* smem) {
    const int tid = LTID, lane = tid & 63, w = tid >> 6;
    unsigned char* ws = p.ws;
    if (u < P0_XN) {
        const int row = u * 4 + w;
        rms_row_bf16(p.x + (size_t)row * DM, p.norm1_g, reinterpret_cast<bf16_t*>(ws + OFF_XN) + (size_t)row * DM, lane);
        return;
    }
    u -= P0_XN;
    if (u < P0_WIN) { transpose_tile(p.w_in, 3600, reinterpret_cast<bf16_t*>(ws + OFF_WIN), u / 16, u % 16, 1, reinterpret_cast<float*>(smem)); return; }
    u -= P0_WIN;
    if (u < P0_WOUT) { transpose_tile(p.w_out, 1024, reinterpret_cast<bf16_t*>(ws + OFF_WOUT), u / 16, u % 16, 0, reinterpret_cast<float*>(smem)); return; }
    u -= P0_WOUT;
    if (u < P0_WQ) { transpose_tile(p.w_q, 2048, reinterpret_cast<bf16_t*>(ws + OFF_WQ), u / 16, u % 16, 0, reinterpret_cast<float*>(smem)); return; }
    u -= P0_WQ;
    if (u < P0_UV) {
        const bool isv = u >= 4096; const int row = (isv ? u - 4096 : u) * 4 + w;
        if (isv) quant_row_fp8(p.peer_v + (size_t)row * DM, ws + OFF_V8, row, reinterpret_cast<float*>(ws + OFF_VS) + row, lane);
        else quant_row_i8(p.peer_u + (size_t)row * DM, ws + OFF_U8, row, reinterpret_cast<float*>(ws + OFF_US) + row, lane);
        return;
    }
    u -= P0_UV;
    if (u < P0_SK) { convert8(p.sub_keys, reinterpret_cast<bf16_t*>(ws + OFF_SK), (size_t)u * 256 + tid); return; }
    float* lb = reinterpret_cast<float*>(ws + OFF_LB);
    for (int n = tid; n < 512; n += 256) {
        const float l0 = p.hg_lower[n], l1 = p.hg_lower[512 + n];
        const float mx = fmaxf(l0, l1); const float e0 = __expf(l0 - mx), e1 = __expf(l1 - mx);
        lb[n] = e0 / (e0 + e1);
    }
}

namespace pg8 {
#define PG8_LAS __attribute__((address_space(3)))
typedef unsigned short bf16_t;
typedef short bf16x8 __attribute__((ext_vector_type(8)));
typedef float f32x4 __attribute__((ext_vector_type(4)));
typedef unsigned u32x4 __attribute__((ext_vector_type(4)));
constexpr int BM = 256, BK = 64, HALF = 128, HTB = HALF * BK * 2  , STAGE_BYTES = 8 * HTB, NXCD = 8, WGM = 8;

__host__ __device__ __forceinline__ int lds_byte(int r, int c) { const int st = (r >> 4) * 2 + (c >> 5), rr = r & 15, cc = c & 31, ob = rr * 64 + cc * 2; return st * 1024 + (ob ^ (((ob >> 9) & 1) << 5)); }
__host__ __device__ __forceinline__ void stage_rc(int b, int& R, int& C) { const int st = b / 1024, sb = b % 1024, swz = sb ^ (((sb >> 9) & 1) << 5); R = (st >> 1) * 16 + swz / 64; C = (st & 1) * 32 + (swz % 64) / 2; }
__host__ __device__ __forceinline__ int perm32(int rho) { const int n = rho >> 4, i = rho & 15; return 8 * (i >> 2) + 4 * n + (i & 3); }

struct Unit { int pm, pn; };
struct Gemm { const bf16_t* A; const bf16_t* Bt; int M, N, K; };

struct StaticOrder {
    int nM, nN, nwg, G, c;
    __host__ __device__ void init(int M, int N, int G_, int c_) { nM = M / BM; nN = N / BM; nwg = nM * nN; G = G_; c = c_; }
    __host__ __device__ bool next(int i, Unit& u) const {
        const long L = (long)i * G + c; if (L >= nwg) return false;
        int wgid = (int)L; { const int q = nwg / NXCD, r = nwg % NXCD, xcd = wgid % NXCD, off = wgid / NXCD; wgid = (xcd < r ? xcd * (q + 1) : r * (q + 1) + (xcd - r) * q) + off; }
        const int nig = WGM * nN, gid = wgid / nig, fm = gid * WGM, gsz = (nM - fm) < WGM ? (nM - fm) : WGM;
        u.pm = fm + ((wgid % nig) % gsz); u.pn = (wgid % nig) / gsz; return true;
    }
    __device__ __forceinline__ void a_ready(const Unit&) const {}
    __device__ __forceinline__ void done(const Unit&) const {}
};
__device__ __forceinline__ unsigned cvt_pk_bf16(float lo, float hi) { unsigned r; asm volatile("v_cvt_pk_bf16_f32 %0, %1, %2" : "=v"(r) : "v"(lo), "v"(hi)); return r; }
typedef float f32x2 __attribute__((ext_vector_type(2)));
template <class Epi, class Sched, bool STAMP = false>
__device__ __forceinline__ void gemm_phase(PG8_LAS unsigned char* lds, const Gemm g, const Sched& S, const Epi& E, unsigned long long* stamps) {
    const int tid = threadIdx.x, wid = __builtin_amdgcn_readfirstlane(tid >> 6), lane = tid & 63, wr = wid >> 2, wc = wid & 3, fr = lane & 15, fq = lane >> 4;
    const int K = g.K, nt = K / BK;
    int ts_lo = 0, ts_hi = 0, nts = 0; const unsigned long long rt_entry = STAMP ? (unsigned long long)wall_clock64() : 0ull;
#define PG8_STAMP() do { if (STAMP && wid == 0 && nts < 64) { const unsigned long long _c = (unsigned long long)clock64(); \
        ts_lo = (lane == nts) ? (int)(unsigned)_c : ts_lo; ts_hi = (lane == nts) ? (int)(unsigned)(_c >> 32) : ts_hi; ++nts; } } while (0)
    PG8_STAMP();
    unsigned voffA[2], voffB[2];
#pragma unroll
    for (int i = 0; i < 2; ++i) { int R, C; stage_rc(tid * 16 + i * 8192, R, C); const int Rb = Epi::PERM ? ((R & ~31) + perm32(R & 31)) : R;
        voffA[i] = (unsigned)(R * K + C) * 2u; voffB[i] = (unsigned)(Rb * K + C) * 2u; }
    const size_t kstep = (size_t)(BK * 2);
    const size_t hstep = (size_t)HALF * K * 2;
    const size_t tstep = 2 * hstep;
    const unsigned ldsw = (unsigned)wid * 1024u;
    const int aoff = lds_byte(wr * 64 + fr, fq * 8), boff = lds_byte(wc * 32 + fr, fq * 8);
#define PG8_SA(b, h) (((b) * 2 + (h)) * HTB)
#define PG8_SB(b, h) ((4 + (b) * 2 + (h)) * HTB)
#define PG8_STAGE(bufoff, gbase, voff) do { _Pragma("unroll") for (int _i = 0; _i < 2; ++_i) \
        __builtin_amdgcn_global_load_lds((const unsigned*)((const char*)(gbase) + (voff)[_i]), (PG8_LAS unsigned*)(lds + (bufoff) + ldsw + _i * 8192), 16, 0, 0); } while (0)
#define PG8_LDA(dst, b, h) do { _Pragma("unroll") for (int m = 0; m < 4; ++m) _Pragma("unroll") for (int k = 0; k < 2; ++k) dst[m][k] = *(const PG8_LAS bf16x8*)(lds + PG8_SA(b, h) + aoff + m * 2048 + k * 1024); } while (0)
#define PG8_LDB(dst, b, h) do { _Pragma("unroll") for (int n = 0; n < 2; ++n) _Pragma("unroll") for (int k = 0; k < 2; ++k) dst[n][k] = *(const PG8_LAS bf16x8*)(lds + PG8_SB(b, h) + boff + n * 2048 + k * 1024); } while (0)
#define PG8_MMA(ai, bj, At, Bt) do { __builtin_amdgcn_s_setprio(1); _Pragma("unroll") for (int m = 0; m < 4; ++m) _Pragma("unroll") for (int n = 0; n < 2; ++n) _Pragma("unroll") for (int k = 0; k < 2; ++k) \
        acc[ai][bj][m][n] = __builtin_amdgcn_mfma_f32_16x16x32_bf16(Bt[n][k], At[m][k], acc[ai][bj][m][n], 0, 0, 0); __builtin_amdgcn_s_setprio(0); } while (0)
#define PG8_WAIT_V(n) asm volatile("s_waitcnt vmcnt(" #n ")" ::: "memory")
#define PG8_WAIT_L(n) asm volatile("s_waitcnt lgkmcnt(" #n ")" ::: "memory")
#define PG8_BAR __builtin_amdgcn_s_barrier()
#define PG8_SCHED __builtin_amdgcn_sched_barrier(0)
    Unit cur, nxt; int ui = 0;
    if (!S.next(0, cur)) return;
    f32x4 acc[2][2][4][2];
#pragma unroll
    for (int a = 0; a < 2; ++a)
#pragma unroll
        for (int b = 0; b < 2; ++b)
#pragma unroll
            for (int m = 0; m < 4; ++m)
#pragma unroll
                for (int n = 0; n < 2; ++n) acc[a][b][m][n] = (f32x4){0.f, 0.f, 0.f, 0.f};
    bf16x8 At[4][2], B0[2][2], B1[2][2];
    const char* cA = (const char*)g.A + (size_t)cur.pm * tstep; const char* cB = (const char*)g.Bt + (size_t)cur.pn * tstep;
    S.a_ready(cur);
    PG8_STAGE(PG8_SB(0, 0), cB, voffB); PG8_STAGE(PG8_SA(0, 0), cA, voffA); PG8_STAGE(PG8_SB(0, 1), cB + hstep, voffB); PG8_STAGE(PG8_SA(0, 1), cA + hstep, voffA);
    if (wr == 1) PG8_BAR;
    PG8_WAIT_V(4); PG8_BAR;
    PG8_STAGE(PG8_SB(1, 0), cB + kstep, voffB); PG8_STAGE(PG8_SA(1, 0), cA + kstep, voffA); PG8_STAGE(PG8_SB(1, 1), cB + hstep + kstep, voffB);
    PG8_WAIT_V(6); PG8_BAR;
    PG8_STAMP();
    for (;;) {
        const bool has_next = S.next(ui + 1, nxt);
        const char* nA = has_next ? (const char*)g.A + (size_t)nxt.pm * tstep : cA; const char* nB = has_next ? (const char*)g.Bt + (size_t)nxt.pn * tstep : cB;
        for (int t = 0; t < nt; t += 2) {
            const bool last = (t == nt - 2);
            const char* a1 = cA + (size_t)(t + 1) * kstep;
            const char* a2 = last ? nA : cA + (size_t)(t + 2) * kstep; const char* b2 = last ? nB : cB + (size_t)(t + 2) * kstep;
            const char* a3 = a2 + kstep; const char* b3 = b2 + kstep;
            if (last && has_next) S.a_ready(nxt);
            PG8_LDB(B0, 0, 0); PG8_SCHED; PG8_LDA(At, 0, 0); PG8_STAGE(PG8_SA(1, 1), a1 + hstep, voffA);
            PG8_WAIT_L(8); PG8_BAR; PG8_WAIT_L(0); PG8_MMA(0, 0, At, B0); PG8_BAR; PG8_SCHED;
            PG8_LDB(B1, 0, 1); PG8_STAGE(PG8_SB(0, 0), b2, voffB);
            PG8_BAR; PG8_WAIT_L(0); PG8_MMA(0, 1, At, B1); PG8_BAR;
            PG8_LDA(At, 0, 1); PG8_STAGE(PG8_SA(0, 0), a2, voffA);
            PG8_BAR; PG8_WAIT_L(0); PG8_MMA(1, 0, At, B0); PG8_BAR; PG8_SCHED;
            PG8_STAGE(PG8_SB(0, 1), b2 + hstep, voffB);
            PG8_WAIT_V(6); PG8_BAR; PG8_MMA(1, 1, At, B1); PG8_BAR;
            PG8_LDB(B0, 1, 0); PG8_SCHED; PG8_LDA(At, 1, 0); PG8_STAGE(PG8_SA(0, 1), a2 + hstep, voffA);
            PG8_WAIT_L(8); PG8_BAR; PG8_WAIT_L(0); PG8_MMA(0, 0, At, B0); PG8_BAR; PG8_SCHED;
            PG8_LDB(B1, 1, 1); PG8_STAGE(PG8_SB(1, 0), b3, voffB);
            PG8_BAR; PG8_WAIT_L(0); PG8_MMA(0, 1, At, B1); PG8_BAR;
            PG8_LDA(At, 1, 1); PG8_STAGE(PG8_SA(1, 0), a3, voffA);
            PG8_BAR; PG8_WAIT_L(0); PG8_MMA(1, 0, At, B0); PG8_BAR; PG8_SCHED;
            PG8_STAGE(PG8_SB(1, 1), b3 + hstep, voffB);
            PG8_WAIT_V(6); PG8_BAR; PG8_MMA(1, 1, At, B1); PG8_BAR;
        }
        PG8_STAMP();
        if constexpr (!Epi::AFTER_DRAIN) { E(acc, cur, wr, wc, fr, fq); S.done(cur); }
        PG8_STAMP();
        if (!has_next) break;
#pragma unroll
        for (int a = 0; a < 2; ++a)
#pragma unroll
            for (int b = 0; b < 2; ++b)
#pragma unroll
                for (int m = 0; m < 4; ++m)
#pragma unroll
                    for (int n = 0; n < 2; ++n) acc[a][b][m][n] = (f32x4){0.f, 0.f, 0.f, 0.f};
        cur = nxt; cA = nA; cB = nB; ++ui;
    }
    PG8_WAIT_V(0);
    if (wr == 0) PG8_BAR;
    PG8_BAR;
    if constexpr (Epi::AFTER_DRAIN) { E.fused(acc, cur, wr, wc, fr, fq, lds, wid, lane); S.done(cur); }
    PG8_STAMP();
    if (STAMP && wid == 0) { stamps[lane] = lane < nts ? (((unsigned long long)(unsigned)ts_hi << 32) | (unsigned)ts_lo) : 0ull;
        if (lane == 62) stamps[62] = rt_entry; if (lane == 63) stamps[63] = (unsigned long long)wall_clock64(); }
#undef PG8_STAMP
#undef PG8_SA
#undef PG8_SB
#undef PG8_STAGE
#undef PG8_LDA
#undef PG8_LDB
#undef PG8_MMA
#undef PG8_WAIT_V
#undef PG8_WAIT_L
#undef PG8_BAR
#undef PG8_SCHED
}
}

DEVI uint4 pack8(const pg8::f32x4 a, const pg8::f32x4 b) { return make_uint4(pack2(a[0], a[1]), pack2(a[2], a[3]), pack2(b[0], b[1]), pack2(b[2], b[3])); }

constexpr int P1_N = IN_WP;
struct EpiInProj {
    static constexpr bool PERM = true, AFTER_DRAIN = false;
    unsigned char* ws;
    __device__ __forceinline__ void operator()(const pg8::f32x4 (&acc)[2][2][4][2], const pg8::Unit& u, int wr, int wc, int fr, int fq) const {
        const int row0 = u.pm * 256 + wr * 64 + fr;
        const int pn = u.pn;
        const int cl0 = wc * 32 + 8 * fq;
        bf16_t* dst; int ld, cbase, kind;
        if (pn < 2)       { dst = reinterpret_cast<bf16_t*>(ws + OFF_HQ);  ld = 512; cbase = pn * 256;        kind = 1; }
        else if (pn < 4)  { dst = reinterpret_cast<bf16_t*>(ws + OFF_HLF); ld = 512; cbase = (pn - 2) * 256;  kind = 2; }
        else if (pn < 6)  { dst = reinterpret_cast<bf16_t*>(ws + OFF_HV);  ld = 512; cbase = (pn - 4) * 256;  kind = 0; }
        else if (pn < 8)  { dst = reinterpret_cast<bf16_t*>(ws + OFF_HG);  ld = 512; cbase = (pn - 6) * 256;  kind = 1; }
        else if (pn == 8) { dst = reinterpret_cast<bf16_t*>(ws + OFF_GQ);  ld = 256; cbase = 0;               kind = 3; }
        else if (pn == 9) { dst = reinterpret_cast<bf16_t*>(ws + OFF_GK);  ld = 256; cbase = 0;               kind = 0; }
        else if (pn < 12) { dst = reinterpret_cast<bf16_t*>(ws + OFF_GV);  ld = 512; cbase = (pn - 10) * 256; kind = 0; }
        else if (pn < 14) { dst = reinterpret_cast<bf16_t*>(ws + OFF_GG);  ld = 512; cbase = (pn - 12) * 256; kind = 1; }
        else {
            if (wc == 0 && fq < 2) {
                float* gl = reinterpret_cast<float*>(ws + OFF_GLOW);
#pragma unroll
                for (int ai = 0; ai < 2; ++ai)
#pragma unroll
                    for (int m = 0; m < 4; ++m) {
                        float* rp = gl + (size_t)(row0 + ai * 128 + m * 16) * 16 + 8 * fq;
                        *reinterpret_cast<pg8::f32x4*>(rp) = acc[ai][0][m][0];
                        *reinterpret_cast<pg8::f32x4*>(rp + 4) = acc[ai][0][m][1];
                    }
            }
            return;
        }
        float lbv[2][8];
#pragma unroll
        for (int bj = 0; bj < 2; ++bj)
#pragma unroll
            for (int j = 0; j < 8; ++j) lbv[bj][j] = 0.f;
        if (kind == 2) {
            const float* lb = reinterpret_cast<const float*>(ws + OFF_LB);
#pragma unroll
            for (int bj = 0; bj < 2; ++bj)
#pragma unroll
                for (int j = 0; j < 8; ++j) lbv[bj][j] = lb[cbase + bj * 128 + cl0 + j];
        }
#pragma unroll
        for (int ai = 0; ai < 2; ++ai)
#pragma unroll
            for (int m = 0; m < 4; ++m) {
                bf16_t* rowp = dst + (size_t)(row0 + ai * 128 + m * 16) * ld + cbase + cl0;
#pragma unroll
                for (int bj = 0; bj < 2; ++bj) {
                    pg8::f32x4 v0 = acc[ai][bj][m][0], v1 = acc[ai][bj][m][1];
                    if (kind == 1) {
#pragma unroll
                        for (int j = 0; j < 4; ++j) { v0[j] = silu_f(v0[j]); v1[j] = silu_f(v1[j]); }
                    } else if (kind == 2) {
#pragma unroll
                        for (int j = 0; j < 4; ++j) {
                            const float l0 = lbv[bj][j], l1 = lbv[bj][4 + j];
                            v0[j] = __logf(l0 + (1.f - l0) / (1.f + __expf(-v0[j])));
                            v1[j] = __logf(l1 + (1.f - l1) / (1.f + __expf(-v1[j])));
                        }
                    } else if (kind == 3) {
#pragma unroll
                        for (int j = 0; j < 4; ++j) { v0[j] *= 0.125f; v1[j] *= 0.125f; }
                    }
                    *reinterpret_cast<uint4*>(rowp + bj * 128) = pack8(v0, v1);
                }
            }
    }
};
struct EpiOutProj {
    static constexpr bool PERM = false, AFTER_DRAIN = false;
    const float* x; float* out;
    __device__ __forceinline__ void operator()(const pg8::f32x4 (&acc)[2][2][4][2], const pg8::Unit& u, int wr, int wc, int fr, int fq) const {
        const int row0 = u.pm * 256 + wr * 64 + fr, col0 = u.pn * 256 + wc * 32 + 4 * fq;
#pragma unroll
        for (int ai = 0; ai < 2; ++ai)
#pragma unroll
            for (int m = 0; m < 4; ++m) {
                const size_t ro = (size_t)(row0 + ai * 128 + m * 16) * DM + col0;
#pragma unroll
                for (int bj = 0; bj < 2; ++bj)
#pragma unroll
                    for (int n = 0; n < 2; ++n) {
                        const pg8::f32x4 xv = *reinterpret_cast<const pg8::f32x4*>(x + ro + bj * 128 + n * 16);
                        *reinterpret_cast<pg8::f32x4*>(out + ro + bj * 128 + n * 16) = xv + acc[ai][bj][m][n];
                    }
            }
    }
};
struct EpiQ {
    static constexpr bool PERM = true, AFTER_DRAIN = false;
    bf16_t* Q;
    __device__ __forceinline__ void operator()(const pg8::f32x4 (&acc)[2][2][4][2], const pg8::Unit& u, int wr, int wc, int fr, int fq) const {
        const int row0 = u.pm * 256 + wr * 64 + fr, col0 = u.pn * 256 + wc * 32 + 8 * fq;
#pragma unroll
        for (int ai = 0; ai < 2; ++ai)
#pragma unroll
            for (int m = 0; m < 4; ++m) {
                bf16_t* rowp = Q + (size_t)(row0 + ai * 128 + m * 16) * 2048 + col0;
#pragma unroll
                for (int bj = 0; bj < 2; ++bj) *reinterpret_cast<uint4*>(rowp + bj * 128) = pack8(acc[ai][bj][m][0], acc[ai][bj][m][1]);
            }
    }
};
template <class Epi>
DEVI void run_gemm(const bf16_t* A, const bf16_t* Bt, int N, const Epi& E, char* smem) {
    pg8::Gemm g{A, Bt, M_TOK, N, 1024};
#if PROBE_GEMM_DUP
    struct DupOrder : pg8::StaticOrder { __host__ __device__ bool next(int i, pg8::Unit& u) const { return pg8::StaticOrder::next(i >> 1, u); } };
    DupOrder S; S.init(M_TOK, N, (int)gridDim.x, (int)blockIdx.x);
    pg8::gemm_phase<Epi, DupOrder, false>((PG8_LAS unsigned char*)smem, g, S, E, nullptr);
#else
    pg8::StaticOrder S; S.init(M_TOK, N, (int)gridDim.x, (int)blockIdx.x);
    pg8::gemm_phase<Epi, pg8::StaticOrder, false>((PG8_LAS unsigned char*)smem, g, S, E, nullptr);
#endif
    __builtin_amdgcn_s_waitcnt(0);
}

constexpr int P2_UNITS = 512 * 7;
DEVI float logsigmoid_f(float z) { return fminf(z, 0.f) - __logf(1.f + __expf(-fabsf(z))); }

DEVI void phase2_unit(const Params& p, int u, char* smem) {
    unsigned char* ws = p.ws;
    const int tid = LTID;
    const int cidx = u / 7, part = u % 7;
    const size_t row0 = (size_t)cidx * 64;
    if (part >= 3) {
        const bool isg = part >= 5; const int n = ((part - 3) & 1) * 256 + tid;
        const bf16_t* V = reinterpret_cast<const bf16_t*>(ws + (isg ? OFF_GV : OFF_HV));
        bf16_t* VT = reinterpret_cast<bf16_t*>(ws + (isg ? OFF_GVT : OFF_HVT));
        for (int r8 = 0; r8 < 8; ++r8) {
            unsigned pk[4];
#pragma unroll
            for (int rr = 0; rr < 8; ++rr) {
                const unsigned short b = V[(row0 + r8 * 8 + rr) * 512 + n];
                if (rr & 1) pk[rr >> 1] |= ((unsigned)b << 16); else pk[rr >> 1] = b;
            }
            *reinterpret_cast<uint4*>(VT + ((size_t)cidx * 512 + n) * 64 + r8 * 8) = make_uint4(pk[0], pk[1], pk[2], pk[3]);
        }
        return;
    }
    if (part < 2) {
        const int n = part * 256 + tid;
        bf16_t* HQ = reinterpret_cast<bf16_t*>(ws + OFF_HQ);
        bf16_t* HLF = reinterpret_cast<bf16_t*>(ws + OFF_HLF);
        bf16_t* KT = reinterpret_cast<bf16_t*>(ws + OFF_KTH);
        float Gl = 0.f;
#pragma unroll 8
        for (int r = 0; r < 64; ++r) Gl += bf2f(HLF[(row0 + r) * 512 + n]);
        float G = 0.f;
        for (int r8 = 0; r8 < 8; ++r8) {
            unsigned pk[4];
#pragma unroll
            for (int rr = 0; rr < 8; ++rr) {
                const size_t idx = (row0 + r8 * 8 + rr) * 512 + n;
                const float lf = bf2f(HLF[idx]);
                G += lf;
                const float key = 1.f - __expf(lf);
                const float q = bf2f(HQ[idx]);
                const unsigned short bq = f2bf(q * __expf(G));
                const unsigned short bk = f2bf(key * __expf(-G));
                HQ[idx] = bq; HLF[idx] = bk;
                if (rr & 1) pk[rr >> 1] |= ((unsigned)bk << 16); else pk[rr >> 1] = bk;
            }
            *reinterpret_cast<uint4*>(KT + ((size_t)cidx * 512 + n) * 64 + r8 * 8) = make_uint4(pk[0], pk[1], pk[2], pk[3]);
        }
        reinterpret_cast<float*>(ws + OFF_DECH)[(size_t)cidx * 512 + n] = __expf(Gl);
    } else {
        const int n = tid;
        bf16_t* GQ = reinterpret_cast<bf16_t*>(ws + OFF_GQ);
        bf16_t* GK = reinterpret_cast<bf16_t*>(ws + OFF_GK);
        bf16_t* KT = reinterpret_cast<bf16_t*>(ws + OFF_KTG);
        const float* GL = reinterpret_cast<const float*>(ws + OFF_GLOW);
        float wg[16];
#pragma unroll
        for (int j = 0; j < 16; ++j) wg[j] = p.gla_wg[j * 256 + n];
        const float bg = p.gla_bg[n];
        float Gl = 0.f;
        for (int r = 0; r < 64; ++r) {
            const float4* g4 = reinterpret_cast<const float4*>(GL + (row0 + r) * 16);
            float z = bg;
#pragma unroll
            for (int j = 0; j < 4; ++j) { const float4 t = g4[j]; z += t.x * wg[4 * j] + t.y * wg[4 * j + 1] + t.z * wg[4 * j + 2] + t.w * wg[4 * j + 3]; }
            Gl += logsigmoid_f(z) * (1.f / 16.f);
        }
        float G = 0.f;
        for (int r8 = 0; r8 < 8; ++r8) {
            unsigned pk[4];
#pragma unroll
            for (int rr = 0; rr < 8; ++rr) {
                const size_t row = row0 + r8 * 8 + rr;
                const float4* g4 = reinterpret_cast<const float4*>(GL + row * 16);
                float z = bg;
#pragma unroll
                for (int j = 0; j < 4; ++j) { const float4 t = g4[j]; z += t.x * wg[4 * j] + t.y * wg[4 * j + 1] + t.z * wg[4 * j + 2] + t.w * wg[4 * j + 3]; }
                G += logsigmoid_f(z) * (1.f / 16.f);
                const size_t idx = row * 256 + n;
                const unsigned short bq = f2bf(bf2f(GQ[idx]) * __expf(G));
                const unsigned short bk = f2bf(bf2f(GK[idx]) * __expf(-G));
                GQ[idx] = bq; GK[idx] = bk;
                if (rr & 1) pk[rr >> 1] |= ((unsigned)bk << 16); else pk[rr >> 1] = bk;
            }
            *reinterpret_cast<uint4*>(KT + ((size_t)cidx * 256 + n) * 64 + r8 * 8) = make_uint4(pk[0], pk[1], pk[2], pk[3]);
        }
        reinterpret_cast<float*>(ws + OFF_DECG)[(size_t)cidx * 256 + n] = __expf(Gl);
    }
}

constexpr int P3_UNITS = 4096;
template <int DK>
DEVI void kv_unit(const Params& p, int sidx, int c) {
    unsigned char* ws = p.ws;
    const int lane = LTID & 63, w = LTID >> 6;
    const int b = sidx >> 2, h = sidx & 3;
    const int cidx = b * 128 + c;
    constexpr int NDB = DK / 16;
    const bf16_t* KT = reinterpret_cast<const bf16_t*>(ws + (DK == 128 ? OFF_KTH : OFF_KTG)) + ((size_t)cidx * (4 * DK) + h * DK) * 64;
    const bf16_t* VT = reinterpret_cast<const bf16_t*>(ws + (DK == 128 ? OFF_HVT : OFF_GVT)) + ((size_t)cidx * 512 + h * 128) * 64;
    const float* DEC = reinterpret_cast<const float*>(ws + (DK == 128 ? OFF_DECH : OFF_DECG)) + (size_t)cidx * (4 * DK) + h * DK;
    bf16_t* ST = reinterpret_cast<bf16_t*>(reinterpret_cast<unsigned char*>(p.out) + (DK == 128 ? OUT_STH : OUT_STG)) + ((size_t)sidx * 128 + c) * (128 * DK);
    f32x4 acc[NDB][2];
#pragma unroll
    for (int i = 0; i < NDB; ++i) { acc[i][0] = f32x4{0, 0, 0, 0}; acc[i][1] = f32x4{0, 0, 0, 0}; }
    const int fo = (lane & 15) * 64 + 8 * (lane >> 4);
#pragma unroll
    for (int ks = 0; ks < 2; ++ks) {
        bf16x8 bv[2];
#pragma unroll
        for (int nb = 0; nb < 2; ++nb) bv[nb] = ldg_frag(VT + (size_t)(32 * w + nb * 16) * 64 + fo + ks * 32);
#pragma unroll
        for (int db = 0; db < NDB; ++db) {
            const bf16x8 ak = ldg_frag(KT + (size_t)(db * 16) * 64 + fo + ks * 32);
            acc[db][0] = mfma16(ak, bv[0], acc[db][0]);
            acc[db][1] = mfma16(ak, bv[1], acc[db][1]);
        }
    }
#pragma unroll
    for (int db = 0; db < NDB; ++db) {
        const int d = db * 16 + 4 * (lane >> 4);
        const float4 dc = *reinterpret_cast<const float4*>(DEC + d);
#pragma unroll
        for (int nb = 0; nb < 2; ++nb) {
            const int dv = 32 * w + nb * 16 + (lane & 15);
            uint2 o; o.x = pack2(acc[db][nb][0] * dc.x, acc[db][nb][1] * dc.y); o.y = pack2(acc[db][nb][2] * dc.z, acc[db][nb][3] * dc.w);
            *reinterpret_cast<uint2*>(ST + (size_t)dv * DK + d) = o;
        }
    }
}
DEVI void phase3_unit(const Params& p, int u, char* smem) {
    if (u < 2048) kv_unit<128>(p, u >> 7, u & 127); else { u -= 2048; kv_unit<64>(p, u >> 7, u & 127); }
}

constexpr int P4_UNITS = 384;
DEVI void phase4_unit(const Params& p, int u, char* smem) {
    unsigned char* ws = p.ws;
    int e = u * 256 + LTID;
    bf16_t* base; const float* dec; size_t cstride; int decstride;
    if (e < 65536) {
        const int sidx = e >> 12, rem = e & 4095, dv = rem >> 5, d4 = (rem & 31) * 4;
        const int b = sidx >> 2, h = sidx & 3;
        base = reinterpret_cast<bf16_t*>(reinterpret_cast<unsigned char*>(p.out) + OUT_STH) + ((size_t)sidx * 128) * 16384 + dv * 128 + d4;
        cstride = 16384;
        dec = reinterpret_cast<const float*>(ws + OFF_DECH) + (size_t)(b * 128) * 512 + h * 128 + d4; decstride = 512;
    } else {
        e -= 65536;
        const int sidx = e >> 11, rem = e & 2047, dv = rem >> 4, d4 = (rem & 15) * 4;
        const int b = sidx >> 2, h = sidx & 3;
        base = reinterpret_cast<bf16_t*>(reinterpret_cast<unsigned char*>(p.out) + OUT_STG) + ((size_t)sidx * 128) * 8192 + dv * 64 + d4;
        cstride = 8192;
        dec = reinterpret_cast<const float*>(ws + OFF_DECG) + (size_t)(b * 128) * 256 + h * 64 + d4; decstride = 256;
    }
    float s0 = 0.f, s1 = 0.f, s2 = 0.f, s3 = 0.f;
    for (int c8 = 0; c8 < 128; c8 += 8) {
        uint2 kv[8]; float4 dc[8];
#pragma unroll
        for (int i = 0; i < 8; ++i) { kv[i] = *reinterpret_cast<const uint2*>(base + (size_t)(c8 + i) * cstride); dc[i] = *reinterpret_cast<const float4*>(dec + (size_t)(c8 + i) * decstride); }
#pragma unroll
        for (int i = 0; i < 8; ++i) {
            uint2 o; o.x = pack2(s0, s1); o.y = pack2(s2, s3);
            *reinterpret_cast<uint2*>(base + (size_t)(c8 + i) * cstride) = o;
            s0 = dc[i].x * s0 + bflo(kv[i].x); s1 = dc[i].y * s1 + bfhi(kv[i].x);
            s2 = dc[i].z * s2 + bflo(kv[i].y); s3 = dc[i].w * s3 + bfhi(kv[i].y);
        }
    }
}

constexpr int P5_UNITS = 4096;
constexpr int PL_PITCH = 72;
template <int DK>
DEVI void out_unit(const Params& p, int sidx, int c, char* smem) {
    unsigned char* ws = p.ws;
    const int lane = LTID & 63, w = LTID >> 6;
    const int b = sidx >> 2, h = sidx & 3;
    const int cidx = b * 128 + c;
    const size_t row0 = (size_t)cidx * 64;
    constexpr int LDQ = 4 * DK;
    const bf16_t* Qn = reinterpret_cast<const bf16_t*>(ws + (DK == 128 ? OFF_HQ : OFF_GQ)) + row0 * LDQ + h * DK;
    const bf16_t* Kn = reinterpret_cast<const bf16_t*>(ws + (DK == 128 ? OFF_HLF : OFF_GK)) + row0 * LDQ + h * DK;
    const bf16_t* VT = reinterpret_cast<const bf16_t*>(ws + (DK == 128 ? OFF_HVT : OFF_GVT)) + ((size_t)cidx * 512 + h * 128) * 64;
    const bf16_t* ST = reinterpret_cast<const bf16_t*>(reinterpret_cast<const unsigned char*>(p.out) + (DK == 128 ? OUT_STH : OUT_STG)) + ((size_t)sidx * 128 + c) * (128 * DK);
    const bf16_t* GATE = reinterpret_cast<const bf16_t*>(ws + (DK == 128 ? OFF_HG : OFF_GG)) + row0 * 512 + h * 128;
    const float* ng = (DK == 128) ? p.hg_norm_g : p.gla_norm_g;
    bf16_t* MIX = reinterpret_cast<bf16_t*>(ws + OFF_MIX) + row0 * 1024 + (DK == 128 ? 0 : 512) + h * 128;
    bf16_t* PL = reinterpret_cast<bf16_t*>(smem);
    float* RED = reinterpret_cast<float*>(smem + 64 * PL_PITCH * 2);

    const int l15 = lane & 15, lg = lane >> 4;
    {
        bf16x8 bq[DK / 32];
#pragma unroll
        for (int ks = 0; ks < DK / 32; ++ks) bq[ks] = ldg_frag(Qn + (size_t)(w * 16 + l15) * LDQ + ks * 32 + 8 * lg);
#pragma unroll
        for (int jb = 0; jb < 4; ++jb) {
            f32x4 a = f32x4{0, 0, 0, 0};
            if (jb <= w) {
#pragma unroll
                for (int ks = 0; ks < DK / 32; ++ks) {
                    const bf16x8 ak = ldg_frag(Kn + (size_t)(jb * 16 + l15) * LDQ + ks * 32 + 8 * lg);
                    a = mfma16(ak, bq[ks], a);
                }
            }
            const int i = w * 16 + l15, j0 = jb * 16 + 4 * lg;
            const float v0 = (j0 + 0 <= i) ? a[0] : 0.f, v1 = (j0 + 1 <= i) ? a[1] : 0.f, v2 = (j0 + 2 <= i) ? a[2] : 0.f, v3 = (j0 + 3 <= i) ? a[3] : 0.f;
            uint2 o; o.x = pack2(v0, v1); o.y = pack2(v2, v3);
            *reinterpret_cast<uint2*>(PL + i * PL_PITCH + j0) = o;
        }
    }
    __syncthreads();
    f32x4 acc[2][4];
#pragma unroll
    for (int x = 0; x < 2; ++x)
#pragma unroll
        for (int y = 0; y < 4; ++y) acc[x][y] = f32x4{0, 0, 0, 0};
#pragma unroll
    for (int ks = 0; ks < 2; ++ks) {
        bf16x8 av[2], bp[4];
#pragma unroll
        for (int x = 0; x < 2; ++x) av[x] = ldg_frag(VT + (size_t)((2 * w + x) * 16 + l15) * 64 + ks * 32 + 8 * lg);
#pragma unroll
        for (int y = 0; y < 4; ++y) bp[y] = *reinterpret_cast<const bf16x8*>(PL + (y * 16 + l15) * PL_PITCH + ks * 32 + 8 * lg);
#pragma unroll
        for (int x = 0; x < 2; ++x)
#pragma unroll
            for (int y = 0; y < 4; ++y) acc[x][y] = mfma16(av[x], bp[y], acc[x][y]);
    }
#pragma unroll
    for (int ks = 0; ks < DK / 32; ++ks) {
        bf16x8 as[2], bq[4];
#pragma unroll
        for (int x = 0; x < 2; ++x) as[x] = ldg_frag(ST + (size_t)((2 * w + x) * 16 + l15) * DK + ks * 32 + 8 * lg);
#pragma unroll
        for (int y = 0; y < 4; ++y) bq[y] = ldg_frag(Qn + (size_t)(y * 16 + l15) * LDQ + ks * 32 + 8 * lg);
#pragma unroll
        for (int x = 0; x < 2; ++x)
#pragma unroll
            for (int y = 0; y < 4; ++y) acc[x][y] = mfma16(as[x], bq[y], acc[x][y]);
    }
    float ssq[4];
#pragma unroll
    for (int y = 0; y < 4; ++y) {
        float s = 0.f;
#pragma unroll
        for (int x = 0; x < 2; ++x)
#pragma unroll
            for (int r = 0; r < 4; ++r) s += acc[x][y][r] * acc[x][y][r];
        s += __shfl_xor(s, 16); s += __shfl_xor(s, 32);
        ssq[y] = s;
    }
    if (lg == 0) {
#pragma unroll
        for (int y = 0; y < 4; ++y) RED[w * 64 + y * 16 + l15] = ssq[y];
    }
    __syncthreads();
#pragma unroll
    for (int y = 0; y < 4; ++y) {
        const int i = y * 16 + l15;
        const float tot = RED[i] + RED[64 + i] + RED[128 + i] + RED[192 + i];
        const float rstd = rsqrtf(tot * (1.f / 128.f) + 1e-6f);
#pragma unroll
        for (int x = 0; x < 2; ++x) {
            const int dv = (2 * w + x) * 16 + 4 * lg;
            const float4 g4 = *reinterpret_cast<const float4*>(ng + dv);
            const uint2 gt = *reinterpret_cast<const uint2*>(GATE + (size_t)i * 512 + dv);
            uint2 o;
            o.x = pack2(acc[x][y][0] * rstd * g4.x * bflo(gt.x), acc[x][y][1] * rstd * g4.y * bfhi(gt.x));
            o.y = pack2(acc[x][y][2] * rstd * g4.z * bflo(gt.y), acc[x][y][3] * rstd * g4.w * bfhi(gt.y));
            *reinterpret_cast<uint2*>(MIX + (size_t)i * 1024 + dv) = o;
        }
    }
    __syncthreads();
}
DEVI void phase5_unit(const Params& p, int u, char* smem) {
    if (u < 2048) out_unit<128>(p, u >> 7, u & 127, smem); else { u -= 2048; out_unit<64>(p, u >> 7, u & 127, smem); }
}

DEVI void rms_row_bf16_i8(const float* __restrict__ xr, const float* __restrict__ g, bf16_t* __restrict__ dst, unsigned char* __restrict__ dst8, float* __restrict__ descale, int lane) {
    float4 v[4]; float ss = 0.f;
#pragma unroll
    for (int i = 0; i < 4; ++i) { v[i] = reinterpret_cast<const float4*>(xr)[lane + 64 * i]; ss += v[i].x * v[i].x + v[i].y * v[i].y + v[i].z * v[i].z + v[i].w * v[i].w; }
    ss = wave_sum(ss);
    const float r = rsqrtf(ss * (1.f / 1024.f) + 1e-6f);
    float am = 0.f;
#pragma unroll
    for (int i = 0; i < 4; ++i) {
        const float4 gg = reinterpret_cast<const float4*>(g)[lane + 64 * i];
        v[i].x *= r * gg.x; v[i].y *= r * gg.y; v[i].z *= r * gg.z; v[i].w *= r * gg.w;
        uint2 o; o.x = pack2(v[i].x, v[i].y); o.y = pack2(v[i].z, v[i].w);
        reinterpret_cast<uint2*>(dst)[lane + 64 * i] = o;
        am = fmaxf(am, fmaxf(fmaxf(fabsf(v[i].x), fabsf(v[i].y)), fmaxf(fabsf(v[i].z), fabsf(v[i].w))));
    }
    am = wave_max(am);
    const float sc = am > 0.f ? 127.f / am : 1.f;
#pragma unroll
    for (int i = 0; i < 4; ++i) reinterpret_cast<int*>(dst8)[lane + 64 * i] = pack_i8x4(v[i].x * sc, v[i].y * sc, v[i].z * sc, v[i].w * sc);
    if (lane == 0) *descale = am > 0.f ? am * (1.f / 127.f) : 1.f;
}
constexpr int P7_UNITS = 8192;
DEVI void phase7_unit(const Params& p, int u, char* smem) {
    const int lane = LTID & 63, w = LTID >> 6;
    const int row = u * 4 + w;
    rms_row_bf16_i8(p.out + (size_t)row * DM, p.norm2_g, reinterpret_cast<bf16_t*>(p.ws + OFF_HN) + (size_t)row * DM,
                    p.ws + OFF_HN8 + (size_t)row * DM, reinterpret_cast<float*>(p.ws + OFF_HS) + row, lane);
}

using f32x16 = __attribute__((ext_vector_type(16))) float;
DEVI f32x16 mfma32(bf16x8 a, bf16x8 b, f32x16 c) { return __builtin_amdgcn_mfma_f32_32x32x16_bf16(a, b, c, 0, 0, 0); }
DEVI unsigned umax(unsigned a, unsigned b) { return a > b ? a : b; }
DEVI unsigned umin(unsigned a, unsigned b) { return a > b ? b : a; }
DEVI unsigned f2ord(float f) { const unsigned u = __float_as_uint(f); return u ^ ((unsigned)((int)u >> 31) | 0x80000000u); }
DEVI float ord2f(unsigned k) { return __uint_as_float((k & 0x80000000u) ? (k ^ 0x80000000u) : ~k); }

template <int BASE>
DEVI void sort16_desc(unsigned (&x)[64]) {
#pragma unroll
    for (int k = 2; k <= 16; k <<= 1) {
#pragma unroll
        for (int j = k >> 1; j > 0; j >>= 1) {
#pragma unroll
            for (int i = 0; i < 16; ++i) {
                const int l = i ^ j;
                if (l > i) {
                    const bool desc = ((i & k) == 0);
                    const unsigned a = x[BASE + i], b = x[BASE + l];
                    const unsigned hi = umax(a, b), lo = umin(a, b);
                    x[BASE + i] = desc ? hi : lo; x[BASE + l] = desc ? lo : hi;
                }
            }
        }
    }
}
template <int BASE>
DEVI void bmerge16_desc(unsigned (&x)[64]) {
#pragma unroll
    for (int j = 8; j > 0; j >>= 1) {
#pragma unroll
        for (int i = 0; i < 16; ++i) {
            const int l = i ^ j;
            if (l > i) { const unsigned a = x[BASE + i], b = x[BASE + l]; x[BASE + i] = umax(a, b); x[BASE + l] = umin(a, b); }
        }
    }
}
DEVI void top16_of_64(unsigned (&x)[64]) {
    sort16_desc<0>(x); sort16_desc<16>(x); sort16_desc<32>(x); sort16_desc<48>(x);
#pragma unroll
    for (int i = 0; i < 16; ++i) x[i] = umax(x[i], x[31 - i]);
    bmerge16_desc<0>(x);
#pragma unroll
    for (int i = 0; i < 16; ++i) x[32 + i] = umax(x[32 + i], x[63 - i]);
    bmerge16_desc<32>(x);
#pragma unroll
    for (int i = 0; i < 16; ++i) x[i] = umax(x[i], x[47 - i]);
    bmerge16_desc<0>(x);
}

DEVI void scores_top16(const bf16_t* __restrict__ SKp, const bf16_t* __restrict__ Qp, int lane, unsigned (&out)[16]) {
    const int r31 = lane & 31, hh = lane >> 5;
    f32x16 acc[4];
#pragma unroll
    for (int nb = 0; nb < 4; ++nb)
#pragma unroll
        for (int r = 0; r < 16; ++r) acc[nb][r] = 0.f;
#pragma unroll
    for (int ks = 0; ks < 8; ++ks) {
        const bf16x8 bq = ldg_frag(Qp + (size_t)r31 * 2048 + ks * 16 + 8 * hh);
#pragma unroll
        for (int nb = 0; nb < 4; ++nb) {
            const bf16x8 ak = ldg_frag(SKp + (size_t)(nb * 32 + r31) * 128 + ks * 16 + 8 * hh);
            acc[nb] = mfma32(ak, bq, acc[nb]);
        }
    }
    unsigned x[64];
    const unsigned hx = (unsigned)hh * 4u;
#pragma unroll
    for (int nb = 0; nb < 4; ++nb)
#pragma unroll
        for (int r = 0; r < 16; ++r) {
            const int nbase = nb * 32 + (r & 3) + 8 * (r >> 2);
            x[nb * 16 + r] = ((f2ord(acc[nb][r]) & ~127u) | (unsigned)(127 - nbase)) ^ hx;
        }
    top16_of_64(x);
    unsigned lo[16], hi[16];
#pragma unroll
    for (int i = 0; i < 16; ++i) { auto rr = __builtin_amdgcn_permlane32_swap(x[i], x[i], false, false); lo[i] = rr[0]; hi[i] = rr[1]; }
#pragma unroll
    for (int i = 0; i < 16; ++i) x[i] = umax(lo[i], hi[15 - i]);
    bmerge16_desc<0>(x);
#pragma unroll
    for (int i = 0; i < 16; ++i) out[i] = x[i];
}

constexpr int P9_UNITS = (M_TOK / 128) * 8;
DEVI void phase9_unit(const Params& p, int u, char* smem) {
    unsigned char* ws = p.ws;
    const int tid = LTID, lane = tid & 63, w = tid >> 6;
    const int tg = u >> 3, h = u & 7;
    const int t0 = tg * 128 + w * 32;
    const int hh = lane >> 5;
    unsigned* KL = reinterpret_cast<unsigned*>(smem) + w * 2048;
    const bf16_t* SK = reinterpret_cast<const bf16_t*>(ws + OFF_SK) + (size_t)(h * 2) * 128 * 128;
    const bf16_t* Q = reinterpret_cast<const bf16_t*>(ws + OFF_Q) + (size_t)t0 * 2048 + h * 256;
    unsigned k0[16], k1[16];
    scores_top16(SK, Q, lane, k0);
    scores_top16(SK + 128 * 128, Q + 128, lane, k1);
#pragma unroll
    for (int i = 0; i < 16; ++i) { KL[i * 64 + lane] = k0[i]; KL[(16 + i) * 64 + lane] = k1[i]; }
    float s0[16], s1[16];
#pragma unroll
    for (int i = 0; i < 16; ++i) { s0[i] = ord2f(k0[i] & ~127u); s1[i] = ord2f(k1[i] & ~127u); }
    unsigned x[64];
    {
        int n = 0;
#pragma unroll
        for (int a = 0; a < 16; ++a)
#pragma unroll
            for (int b = 0; b < 16; ++b)
                if ((a + 1) * (b + 1) <= 16) { x[n] = (f2ord(s0[a] + s1[b]) & ~255u) | (unsigned)(255 - (a * 16 + b)); ++n; }
#pragma unroll
        for (int i = 50; i < 64; ++i) x[i] = 0u;
    }
    top16_of_64(x);
    float cv[16]; int ex[16];
#pragma unroll
    for (int i = 0; i < 16; ++i) {
        cv[i] = ord2f(x[i] & ~255u);
        const int cid = 255 - (int)(x[i] & 255u);
        const unsigned ka = KL[(cid >> 4) * 64 + lane], kb = KL[(16 + (cid & 15)) * 64 + lane];
        ex[i] = (127 - (int)(ka & 127u)) * 128 + (127 - (int)(kb & 127u));
    }
    float sum = 0.f;
    const float mx = cv[0];
#pragma unroll
    for (int i = 0; i < 16; ++i) cv[i] = __expf(cv[i] - mx);
#pragma unroll
    for (int i = 0; i < 16; ++i) sum += cv[i];
    const float inv = 1.f / sum;
    const size_t orow = (size_t)(t0 + (lane & 31)) * 128 + h * 16;
    if (hh == 0) {
        int4* d = reinterpret_cast<int4*>(reinterpret_cast<int*>(ws + OFF_EIDX) + orow);
#pragma unroll
        for (int i = 0; i < 4; ++i) d[i] = make_int4(ex[4 * i], ex[4 * i + 1], ex[4 * i + 2], ex[4 * i + 3]);
        const float* US = reinterpret_cast<const float*>(ws + OFF_US);
        float4* du = reinterpret_cast<float4*>(reinterpret_cast<float*>(ws + OFF_EU) + orow);
#pragma unroll
        for (int i = 0; i < 4; ++i) du[i] = make_float4(US[ex[4 * i]], US[ex[4 * i + 1]], US[ex[4 * i + 2]], US[ex[4 * i + 3]]);
    } else {
        const float* VS = reinterpret_cast<const float*>(ws + OFF_VS);
        float4* d = reinterpret_cast<float4*>(reinterpret_cast<float*>(ws + OFF_EW) + orow);
#pragma unroll
        for (int i = 0; i < 4; ++i) d[i] = make_float4(cv[4 * i] * inv * VS[ex[4 * i]], cv[4 * i + 1] * inv * VS[ex[4 * i + 1]], cv[4 * i + 2] * inv * VS[ex[4 * i + 2]], cv[4 * i + 3] * inv * VS[ex[4 * i + 3]]);
    }
}

typedef _Float16 h2_t __attribute__((ext_vector_type(2)));
template <int CTRL> DEVI float dpp_f(float x) { return __builtin_bit_cast(float, __builtin_amdgcn_mov_dpp(__builtin_bit_cast(int, x), CTRL, 0xf, 0xf, true)); }
DEVI float sum8(float v) { v += dpp_f<0xB1>(v); v += dpp_f<0x4E>(v); v += dpp_f<0x141>(v); return v; }
DEVI long pack_i64(unsigned lo, unsigned hi) { return (long)(((unsigned long long)hi << 32) | (unsigned long long)lo); }

#define SB __builtin_amdgcn_sched_barrier(0)
#define SB __builtin_amdgcn_sched_barrier(0)
#define PIN4(Q) "+v"(Q.x), "+v"(Q.y), "+v"(Q.z), "+v"(Q.w)
DEVI void phase10a_block(const Params& p, char* smem) {
    unsigned char* ws = p.ws;
    const int s = blockIdx.x & 7, rank = blockIdx.x >> 3, nrank = ((int)gridDim.x - s + 7) >> 3;
    const int lane = threadIdx.x & 63, wave = threadIdx.x >> 6;
    const int lg = lane & 7, grp = lane >> 3;
    const unsigned char* U8 = ws + OFF_U8 + (size_t)s * (16384 * 128) + 16 * lg;
    const unsigned char* HNs = ws + OFF_HN8 + 128 * s + 16 * lg;
    float* PD = reinterpret_cast<float*>(ws + OFF_PD) + (size_t)s * M_TOK * 128;
    float* stg = reinterpret_cast<float*>(smem) + wave * (16 * 128);
    constexpr int NTG = M_TOK / 8;
#define P10A_LOAD_EV(TG, E) do { const int4* _q = reinterpret_cast<const int4*>(reinterpret_cast<const int*>(ws + OFF_EIDX) + (size_t)((TG) * 8 + wave) * 128 + 16 * grp); \
        E[0] = _q[0]; E[1] = _q[1]; E[2] = _q[2]; E[3] = _q[3]; } while (0)
#define P10A_LOAD_ROWS(TG, E, R, HA) do { \
        asm volatile("" : PIN4(E[0]), PIN4(E[1]), PIN4(E[2]), PIN4(E[3])); \
        const int _e[16] = {E[0].x, E[0].y, E[0].z, E[0].w, E[1].x, E[1].y, E[1].z, E[1].w, E[2].x, E[2].y, E[2].z, E[2].w, E[3].x, E[3].y, E[3].z, E[3].w}; \
        _Pragma("unroll") for (int _i = 0; _i < 16; ++_i) R[_i] = *reinterpret_cast<const uint4*>(U8 + (size_t)_e[_i] * 128); \
        HA = *reinterpret_cast<const uint4*>(HNs + (size_t)((TG) * 8 + wave) * DM); } while (0)
#define P10A_COMPUTE(SLOT, R, HA) do { \
        asm volatile("" : PIN4(R[0]), PIN4(R[1]), PIN4(R[2]), PIN4(R[3]), PIN4(R[4]), PIN4(R[5])); \
        asm volatile("" : PIN4(R[6]), PIN4(R[7]), PIN4(R[8]), PIN4(R[9]), PIN4(R[10]), PIN4(R[11])); \
        asm volatile("" : PIN4(R[12]), PIN4(R[13]), PIN4(R[14]), PIN4(R[15]), PIN4(HA)); \
        int _v1 = 0, _v2 = 0; \
        _Pragma("unroll") for (int _i = 0; _i < 16; ++_i) { \
            int _a = __builtin_amdgcn_sdot4((int)R[_i].x, (int)HA.x, 0, false); \
            _a = __builtin_amdgcn_sdot4((int)R[_i].y, (int)HA.y, _a, false); \
            _a = __builtin_amdgcn_sdot4((int)R[_i].z, (int)HA.z, _a, false); \
            _a = __builtin_amdgcn_sdot4((int)R[_i].w, (int)HA.w, _a, false); \
            _a += __builtin_amdgcn_mov_dpp(_a, 0xB1, 0xf, 0xf, true); _a += __builtin_amdgcn_mov_dpp(_a, 0x4E, 0xf, 0xf, true); _a += __builtin_amdgcn_mov_dpp(_a, 0x141, 0xf, 0xf, true); \
            if (_i < 8) _v1 = (lg == _i) ? _a : _v1; else _v2 = (lg == _i - 8) ? _a : _v2; } \
        stg[(SLOT) * 128 + 16 * grp + lg] = (float)_v1; stg[(SLOT) * 128 + 16 * grp + 8 + lg] = (float)_v2; } while (0)
    int4 eA[4], eB[4], eC[4]; uint4 rA[16], rB[16]; uint4 hA0, hB0;
    if (rank >= NTG) return;
    const int ntok = (NTG - rank + nrank - 1) / nrank;
#define TGI(I) (rank + ((I) < ntok ? (I) : ntok - 1) * nrank)
    P10A_LOAD_EV(TGI(0), eA);
    SB; P10A_LOAD_EV(TGI(1), eB);
    SB; P10A_LOAD_ROWS(TGI(0), eA, rA, hA0);
    SB;
    for (int base = 0; base < ntok; base += 16) {
#pragma unroll 1
        for (int i = base; i < base + 16; i += 2) {
            SB; P10A_LOAD_EV(TGI(i + 2), eC);
            SB; P10A_LOAD_ROWS(TGI(i + 1), eB, rB, hB0);
            SB; P10A_COMPUTE(i - base, rA, hA0);
            SB; P10A_LOAD_EV(TGI(i + 3), eB);
            SB; P10A_LOAD_ROWS(TGI(i + 2), eC, rA, hA0);
            SB; P10A_COMPUTE(i + 1 - base, rB, hB0);
            SB;
        }
#pragma unroll 4
        for (int j = 0; j < 16; ++j) {
            const float2 v = *reinterpret_cast<const float2*>(stg + j * 128 + 2 * lane);
            *reinterpret_cast<float2*>(PD + (size_t)(TGI(base + j) * 8 + wave) * 128 + 2 * lane) = v;
        }
        __builtin_amdgcn_s_waitcnt(0x0F70);
    }
#undef TGI
#undef P10A_LOAD_EV
#undef P10A_LOAD_ROWS
#undef P10A_COMPUTE
}

DEVI void phase10w_block(const Params& p) {
    unsigned char* ws = p.ws;
    const int lane = threadIdx.x & 63, wave = threadIdx.x >> 6;
    const float* PD = reinterpret_cast<const float*>(ws + OFF_PD);
    const float* HS = reinterpret_cast<const float*>(ws + OFF_HS);
    for (int t = blockIdx.x * 8 + wave; t < M_TOK; t += gridDim.x * 8) {
        float d0 = 0.f, d1 = 0.f;
#pragma unroll
        for (int sl = 0; sl < 8; ++sl) { d0 += PD[((size_t)sl * M_TOK + t) * 128 + lane]; d1 += PD[((size_t)sl * M_TOK + t) * 128 + 64 + lane]; }
        const float hs = HS[t];
        const float u0 = reinterpret_cast<const float*>(ws + OFF_EU)[(size_t)t * 128 + lane], u1 = reinterpret_cast<const float*>(ws + OFF_EU)[(size_t)t * 128 + 64 + lane];
        const float g0 = reinterpret_cast<const float*>(ws + OFF_EW)[(size_t)t * 128 + lane], g1 = reinterpret_cast<const float*>(ws + OFF_EW)[(size_t)t * 128 + 64 + lane];
        d0 *= u0 * hs; d1 *= u1 * hs;
        _Float16* W = reinterpret_cast<_Float16*>(ws + OFF_W16) + (size_t)t * 128;
        W[lane] = (_Float16)(g0 * 0.5f * d0 * (1.f + erff(d0 * 0.70710678118654752f)));
        W[64 + lane] = (_Float16)(g1 * 0.5f * d1 * (1.f + erff(d1 * 0.70710678118654752f)));
    }
}

template <bool DRY>
DEVI void phase10b_block(const Params& p, char* smem) {
    unsigned char* ws = p.ws;
    const int s = blockIdx.x & 7, rank = blockIdx.x >> 3, nrank = ((int)gridDim.x - s + 7) >> 3;
    const int lane = threadIdx.x & 63, wave = threadIdx.x >> 6;
    const int lg = lane & 7, grp = lane >> 3;
    const unsigned char* V8 = ws + OFF_V8 + (size_t)s * (16384 * 128) + 16 * lg;
    float* stg = reinterpret_cast<float*>(smem) + wave * (16 * 128);
    constexpr int NTG = M_TOK / 8;
#define P10B_LOAD_EV(TG, E) do { const int4* _q = reinterpret_cast<const int4*>(reinterpret_cast<const int*>(ws + OFF_EIDX) + (size_t)((TG) * 8 + wave) * 128 + 16 * grp); \
        E[0] = _q[0]; E[1] = _q[1]; E[2] = _q[2]; E[3] = _q[3]; } while (0)
#define P10B_LOAD_ROWS(TG, E, R, WA, WB) do { \
        asm volatile("" : PIN4(E[0]), PIN4(E[1]), PIN4(E[2]), PIN4(E[3])); \
        const int _e[16] = {E[0].x, E[0].y, E[0].z, E[0].w, E[1].x, E[1].y, E[1].z, E[1].w, E[2].x, E[2].y, E[2].z, E[2].w, E[3].x, E[3].y, E[3].z, E[3].w}; \
        _Pragma("unroll") for (int _i = 0; _i < 16; ++_i) R[_i] = *reinterpret_cast<const uint4*>(V8 + (size_t)_e[_i] * 128); \
        const uint4* _w = reinterpret_cast<const uint4*>(reinterpret_cast<const _Float16*>(ws + OFF_W16) + (size_t)((TG) * 8 + wave) * 128 + 16 * grp); WA = _w[0]; WB = _w[1]; } while (0)
#define P10B_COMPUTE(SLOT, R, WA, WB) do { \
          \
        asm volatile("" : PIN4(R[0]), PIN4(R[1]), PIN4(R[2]), PIN4(R[3]), PIN4(R[4]), PIN4(R[5])); \
        asm volatile("" : PIN4(R[6]), PIN4(R[7]), PIN4(R[8]), PIN4(R[9]), PIN4(R[10]), PIN4(R[11])); \
        asm volatile("" : PIN4(R[12]), PIN4(R[13]), PIN4(R[14]), PIN4(R[15]), PIN4(WA), PIN4(WB)); \
        const unsigned _ww[8] = {WA.x, WA.y, WA.z, WA.w, WB.x, WB.y, WB.z, WB.w}; \
        h2_t _acc[8]; unsigned _zb; asm volatile("v_mov_b32 %0, 0" : "=v"(_zb)); \
        _Pragma("unroll") for (int _j = 0; _j < 8; ++_j) _acc[_j] = __builtin_bit_cast(h2_t, _zb); \
        _Pragma("unroll") for (int _i = 0; _i < 16; ++_i) { \
            const unsigned _pw = _ww[_i >> 1]; \
            const h2_t _wp = __builtin_bit_cast(h2_t, (_i & 1) ? ((_pw >> 16) | (_pw & 0xffff0000u)) : ((_pw << 16) | (_pw & 0xffffu))); \
            const unsigned _wd[4] = {R[_i].x, R[_i].y, R[_i].z, R[_i].w}; \
            _Pragma("unroll") for (int _j = 0; _j < 4; ++_j) { \
                _acc[2 * _j] += _wp * __builtin_amdgcn_cvt_scalef32_pk_f16_fp8((int)_wd[_j], 1.0f, false); \
                _acc[2 * _j + 1] += _wp * __builtin_amdgcn_cvt_scalef32_pk_f16_fp8((int)_wd[_j], 1.0f, true); } } \
        float _o[16]; \
        _Pragma("unroll") for (int _j = 0; _j < 8; ++_j) { \
            h2_t _x = _acc[_j]; \
            _x += __builtin_bit_cast(h2_t, __builtin_amdgcn_mov_dpp(__builtin_bit_cast(int, _x), 0x128, 0xf, 0xf, true));     \
            { auto _s = __builtin_amdgcn_permlane16_swap(__builtin_bit_cast(unsigned, _x), __builtin_bit_cast(unsigned, _x), false, false); _x = __builtin_bit_cast(h2_t, (unsigned)_s[0]) + __builtin_bit_cast(h2_t, (unsigned)_s[1]); } \
            { auto _s = __builtin_amdgcn_permlane32_swap(__builtin_bit_cast(unsigned, _x), __builtin_bit_cast(unsigned, _x), false, false); _x = __builtin_bit_cast(h2_t, (unsigned)_s[0]) + __builtin_bit_cast(h2_t, (unsigned)_s[1]); } \
            _o[2 * _j] = (float)_x[0]; _o[2 * _j + 1] = (float)_x[1]; } \
        if (grp == 0) { float* _orow = stg + (SLOT) * 128 + 16 * lg; \
            _Pragma("unroll") for (int _i = 0; _i < 4; ++_i) *reinterpret_cast<float4*>(_orow + 4 * _i) = make_float4(_o[4 * _i], _o[4 * _i + 1], _o[4 * _i + 2], _o[4 * _i + 3]); } } while (0)
    int4 eA[4], eB[4], eC[4]; uint4 rA[16], rB[16]; uint4 wA0, wA1, wB0, wB1;
    if (rank >= NTG) return;
    const int ntok = (NTG - rank + nrank - 1) / nrank;
#define TGI(I) (rank + ((I) < ntok ? (I) : ntok - 1) * nrank)
    P10B_LOAD_EV(TGI(0), eA);
    SB; P10B_LOAD_EV(TGI(1), eB);
    SB; P10B_LOAD_ROWS(TGI(0), eA, rA, wA0, wA1);
    SB;
    for (int base = 0; base < ntok; base += 16) {
#pragma unroll 1
        for (int i = base; i < base + 16; i += 2) {
            SB; P10B_LOAD_EV(TGI(i + 2), eC);
            SB; P10B_LOAD_ROWS(TGI(i + 1), eB, rB, wB0, wB1);
            SB; P10B_COMPUTE(i - base, rA, wA0, wA1);
            SB; P10B_LOAD_EV(TGI(i + 3), eB);
            SB; P10B_LOAD_ROWS(TGI(i + 2), eC, rA, wA0, wA1);
            SB; P10B_COMPUTE(i + 1 - base, rB, wB0, wB1);
            SB;
        }
        float ssv = 0.f;
#pragma unroll 4
        for (int j = 0; j < 16; ++j) {
            if (base + j < ntok) {
                const size_t ro = (size_t)(TGI(base + j) * 8 + wave) * DM + 128 * s + 2 * lane;
                const float2 v = *reinterpret_cast<const float2*>(stg + j * 128 + 2 * lane);
                const float2 hv = *reinterpret_cast<const float2*>(p.out + ro);
                const float2 r = make_float2(hv.x + v.x, hv.y + v.y);
                *reinterpret_cast<float2*>(p.out + ro) = DRY ? hv : r;
                const float sq = wave_sum(r.x * r.x + r.y * r.y);
                ssv = (lane == j) ? sq : ssv;
            }
        }
        if (lane < 16 && base + lane < ntok) reinterpret_cast<float*>(ws + OFF_SSQ)[(DRY ? (size_t)M_TOK * 8 : 0) + (size_t)(TGI(base + lane) * 8 + wave) * 8 + s] = ssv;
        __builtin_amdgcn_s_waitcnt(0x0F70);
    }
#undef TGI
#undef P10B_LOAD_EV
#undef P10B_LOAD_ROWS
#undef P10B_COMPUTE
}

DEVI void phase10c_block(const Params& p) {
    unsigned char* ws = p.ws;
    const int lane = threadIdx.x & 63, wave = threadIdx.x >> 6;
    for (int t = blockIdx.x * 8 + wave; t < M_TOK; t += gridDim.x * 8) {
        const float* sq = reinterpret_cast<const float*>(ws + OFF_SSQ) + (size_t)t * 8;
        const float4 a = *reinterpret_cast<const float4*>(sq), b = *reinterpret_cast<const float4*>(sq + 4);
        const float r = rsqrtf((a.x + a.y + a.z + a.w + b.x + b.y + b.z + b.w) * (1.f / 1024.f) + 1e-6f);
        float4* orow = reinterpret_cast<float4*>(p.out + (size_t)t * DM);
        const float4* gf = reinterpret_cast<const float4*>(p.norm_f_g);
#pragma unroll
        for (int i = 0; i < 4; ++i) {
            const float4 v = orow[lane + 64 * i], g = gf[lane + 64 * i];
            orow[lane + 64 * i] = make_float4(v.x * r * g.x, v.y * r * g.y, v.z * r * g.z, v.w * r * g.w);
        }
    }
}

#define XB_TMO      128
#define XB_XCNT(j)  (256  + 64 * (j))
#define XB_XSUB(j)  (1280 + 64 * (j))
#define XB_XGEN(j)  (2304 + 64 * (j))
#define XB_TOP      3328
#define XB_TOPGEN   3392
#define XCD_BAR_WORDS 3456
#define XB_SPIN_CAP (1u << 22)
#define LAS __attribute__((address_space(3)))
DEVI unsigned xb_ld(unsigned* p)              { return __hip_atomic_load(p, __ATOMIC_RELAXED, __HIP_MEMORY_SCOPE_AGENT); }
DEVI unsigned xb_add(unsigned* p, unsigned v) { return __hip_atomic_fetch_add(p, v, __ATOMIC_RELAXED, __HIP_MEMORY_SCOPE_AGENT); }
DEVI unsigned xb_xcc_id() { return (unsigned)__builtin_amdgcn_s_getreg((3 << 11) | 20) & 0xFu; }
#define XB_SPIN(cond, bar) do { unsigned _sp = 0; while (cond) { __builtin_amdgcn_s_sleep(1); \
    if ((++_sp & 255u) == 0u) { if (xb_ld(&(bar)[XB_TMO])) break; if (_sp > XB_SPIN_CAP) { atomicAdd(&(bar)[XB_TMO], 1u); break; } } } } while (0)
struct XcdBarrier { unsigned* bar; unsigned x; volatile LAS unsigned* st; };
DEVI XcdBarrier xcd_barrier_post(unsigned* bar, volatile LAS unsigned* st) {
    XcdBarrier b; b.bar = bar; b.x = xb_xcc_id(); b.st = st;
    if (threadIdx.x == 0) (void)xb_add(&bar[XB_XCNT(b.x)], 1u);
    return b;
}
DEVI void xcd_barrier_complete(unsigned* bar, unsigned x, unsigned& nloc, unsigned& nx) {
    const unsigned G = gridDim.x * gridDim.y * gridDim.z;
    unsigned sum, cnt, mine, sp = 0u;
    for (;;) {
        sum = 0u; cnt = 0u; mine = 0u;
#pragma unroll
        for (unsigned j = 0; j < 16; ++j) { const unsigned c = xb_ld(&bar[XB_XCNT(j)]); sum += c; cnt += (c > 0u) ? 1u : 0u; mine = (j == x) ? c : mine; }
        if (sum == G) break;
        __builtin_amdgcn_s_sleep(1);
        if ((++sp & 255u) == 0u) { if (xb_ld(&bar[XB_TMO])) break; if (sp > XB_SPIN_CAP) { atomicAdd(&bar[XB_TMO], 1u); break; } }
    }
    nloc = mine > 0u ? mine : 1u; nx = cnt > 0u ? cnt : 1u;
}
DEVI void xcd_barrier(const XcdBarrier& b) {
    asm volatile("s_waitcnt vmcnt(0)" ::: "memory");
    __syncthreads();
    if (threadIdx.x == 0) {
        unsigned* bar = b.bar;
        __builtin_amdgcn_s_waitcnt(0);
        unsigned nloc = b.st[0], nx = b.st[1];
        if (nloc == 0u) { xcd_barrier_complete(bar, b.x, nloc, nx); b.st[0] = nloc; b.st[1] = nx; }
        const unsigned old = xb_add(&bar[XB_XSUB(b.x)], 1u);
        const unsigned gen = old / nloc;
        if (old + 1u == (gen + 1u) * nloc) {
            __builtin_amdgcn_fence(__ATOMIC_RELEASE, "agent");
            asm volatile("s_waitcnt vmcnt(0)" ::: "memory");
            const unsigned og = xb_add(&bar[XB_TOP], 1u);
            const unsigned tg = og / nx;
            if (og + 1u == (tg + 1u) * nx) xb_add(&bar[XB_TOPGEN], 1u);
            else XB_SPIN(xb_ld(&bar[XB_TOPGEN]) == tg, bar);
            __builtin_amdgcn_fence(__ATOMIC_ACQUIRE, "agent");
            xb_add(&bar[XB_XGEN(b.x)], 1u);
            asm volatile("s_waitcnt vmcnt(0)" ::: "memory");
        } else {
            XB_SPIN(xb_ld(&bar[XB_XGEN(b.x)]) == gen, bar);
            __builtin_amdgcn_fence(__ATOMIC_ACQUIRE, "agent");
            asm volatile("s_waitcnt vmcnt(0)" ::: "memory");
        }
    }
    __syncthreads();
}

constexpr int N_PHASES = 11;
constexpr int LDS_PHASE_BYTES = 131072;
constexpr int LDS_BYTES = LDS_PHASE_BYTES + 16;

__global__ void __launch_bounds__(512, 2) hymba_fwd(Params p) {
    extern __shared__ __attribute__((aligned(16))) char smem[];
    cg::grid_group grid = cg::this_grid();
    const int lo = p.ph_lo, hi = p.ph_hi;
    volatile LAS unsigned* bst = (volatile LAS unsigned*)(smem + LDS_PHASE_BYTES);
    if (threadIdx.x == 0) { bst[0] = 0u; bst[1] = 0u; bst[2] = 0u; bst[3] = 0u; }
    __syncthreads();
    XcdBarrier xb = xcd_barrier_post(reinterpret_cast<unsigned*>(p.ws + OFF_BAR), bst);
    const int hb = (int)(threadIdx.x >> 8);
    char* hsm = smem + hb * 65536;
#define SEAM(K) if ((K) > lo) { if ((K) == lo + 1) grid.sync(); else xcd_barrier(xb); }
#define RUN_PHASE(K, FN, N) if (lo <= (K) && (K) < hi) { SEAM(K) for (int rep = 0; rep < 1 + ((PROBE_DUP >> (K)) & 1); ++rep) { if (rep) xcd_barrier(xb); \
        for (int ub = blockIdx.x * 2; ub < (N); ub += gridDim.x * 2) { const int u = ub + hb; if (u < (N)) FN(p, u, hsm); } } }
#define RUN_GEMM(K, CALL) if (lo <= (K) && (K) < hi) { SEAM(K) CALL; }
    RUN_PHASE(0, phase0_unit, P0_UNITS)
    RUN_GEMM(1, run_gemm(reinterpret_cast<const bf16_t*>(p.ws + OFF_XN), reinterpret_cast<const bf16_t*>(p.ws + OFF_WIN), P1_N, EpiInProj{p.ws}, smem))
    RUN_PHASE(2, phase2_unit, P2_UNITS)
    RUN_PHASE(3, phase3_unit, P3_UNITS)
    RUN_PHASE(4, phase4_unit, P4_UNITS)
    RUN_PHASE(5, phase5_unit, P5_UNITS)
    RUN_GEMM(6, run_gemm(reinterpret_cast<const bf16_t*>(p.ws + OFF_MIX), reinterpret_cast<const bf16_t*>(p.ws + OFF_WOUT), 1024, EpiOutProj{p.x, p.out}, smem))
    RUN_PHASE(7, phase7_unit, P7_UNITS)
    RUN_GEMM(8, run_gemm(reinterpret_cast<const bf16_t*>(p.ws + OFF_HN), reinterpret_cast<const bf16_t*>(p.ws + OFF_WQ), 2048, EpiQ{reinterpret_cast<bf16_t*>(p.ws + OFF_Q)}, smem))
    RUN_PHASE(9, phase9_unit, P9_UNITS)
    if (lo <= 10 && 10 < hi) {
        SEAM(10)
#if PROBE_P10X == 4
        phase10a_block(p, smem); xcd_barrier(xb);
#endif
        phase10a_block(p, smem);
#if PROBE_P10X == 1
        xcd_barrier(xb); phase10a_block(p, smem);
#endif

        xcd_barrier(xb); phase10w_block(p);
#if PROBE_P10X == 2
        xcd_barrier(xb); phase10b_block<true>(p, smem);
#endif
        xcd_barrier(xb); phase10b_block<false>(p, smem);
        xcd_barrier(xb); phase10c_block(p);
#if PROBE_P10X == 3
        xcd_barrier(xb); phase10c_block(p);
#endif
    }
#undef RUN_PHASE
#undef RUN_GEMM
#undef SEAM
}

extern "C" void kernel_launch(void* const* d_in, const int* in_sizes, int n_in, void* d_out, int out_size, void* d_ws, size_t ws_size, hipStream_t stream) {
    static int grid_blocks = 0;
    if (grid_blocks == 0) {
        if (n_in != 15 || in_sizes[0] != M_TOK * DM || out_size != M_TOK * DM || ws_size < WS_NEED) {
            fprintf(stderr, "kernel_launch: unexpected shapes (n_in %d, in0 %d, out %d, ws %zu)\n", n_in, n_in > 0 ? in_sizes[0] : -1, out_size, ws_size);
            grid_blocks = -1; return;
        }
        int dev = 0, cus = 0, per_cu = 0;
        (void)hipGetDevice(&dev);
        (void)hipDeviceGetAttribute(&cus, hipDeviceAttributeMultiprocessorCount, dev);
        (void)hipFuncSetAttribute((const void*)hymba_fwd, hipFuncAttributeMaxDynamicSharedMemorySize, LDS_BYTES);
        (void)hipOccupancyMaxActiveBlocksPerMultiprocessor(&per_cu, (const void*)hymba_fwd, 512, LDS_BYTES);
        if (per_cu < 1) per_cu = 1;
        if (per_cu > 1) per_cu = 1;
        grid_blocks = cus * per_cu;
    }
    if (grid_blocks < 0) return;
    Params p{};
    p.x = (const float*)d_in[0]; p.norm1_g = (const float*)d_in[1]; p.w_in = (const float*)d_in[2]; p.hg_lower = (const float*)d_in[3];
    p.hg_norm_g = (const float*)d_in[4]; p.gla_wg = (const float*)d_in[5]; p.gla_bg = (const float*)d_in[6]; p.gla_norm_g = (const float*)d_in[7];
    p.w_out = (const float*)d_in[8]; p.norm2_g = (const float*)d_in[9]; p.w_q = (const float*)d_in[10]; p.sub_keys = (const float*)d_in[11];
    p.peer_u = (const float*)d_in[12]; p.peer_v = (const float*)d_in[13]; p.norm_f_g = (const float*)d_in[14];
    p.out = (float*)d_out; p.ws = (unsigned char*)d_ws;
#if N_LAUNCH_MODE == 1
    (void)hipMemsetAsync((unsigned char*)d_ws + OFF_BAR, 0, XCD_BAR_WORDS * 4, stream);
    p.ph_lo = 0; p.ph_hi = N_PHASES;
    void* args[] = {&p};
    hipError_t e = hipLaunchCooperativeKernel((const void*)hymba_fwd, dim3(grid_blocks), dim3(512), args, LDS_BYTES, stream);
    if (e != hipSuccess) fprintf(stderr, "cooperative launch failed: %s (grid %d)\n", hipGetErrorString(e), grid_blocks);
#else
    for (int ph = 0; ph < N_PHASES; ++ph) {
        p.ph_lo = ph; p.ph_hi = ph + 1;
        hipLaunchKernelGGL(hymba_fwd, dim3(grid_blocks), dim3(512), LDS_BYTES, stream, p);
    }
#endif
}
```

```cpp
#include <hip/hip_runtime.h>
#include <hip/hip_cooperative_groups.h>
#include <cstdio>
#include <cstdint>
namespace cg = cooperative_groups;

#ifndef N_LAUNCH_MODE
#define N_LAUNCH_MODE 1
#endif

#ifndef PROBE_DUP
#define PROBE_DUP 0
#endif
#ifndef PROBE_P10_DUP
#define PROBE_P10_DUP 0
#endif
#ifndef P10_SLICED
#define P10_SLICED 0
#endif
#ifndef PROBE_P10A
#define PROBE_P10A 0
#endif
#ifndef PROBE_P10_MASK
#define PROBE_P10_MASK 0x7fffffff
#endif
#ifndef PROBE_P10X
#define PROBE_P10X 0
#endif
#ifndef PROBE_P2T
#define PROBE_P2T 0
#endif
#ifndef PROBE_P4
#define PROBE_P4 0
#endif
#ifndef PROBE_P2G
#define PROBE_P2G 0
#endif
#ifndef PROBE_GEMM_DUP
#define PROBE_GEMM_DUP 0
#endif
#define DEVI __device__ __forceinline__
#define LTID ((int)(threadIdx.x & 255u))
typedef unsigned short bf16_t;
using bf16x8 = __attribute__((ext_vector_type(8))) short;
using f32x4 = __attribute__((ext_vector_type(4))) float;

constexpr int M_TOK = 32768;
constexpr int DM = 1024;
constexpr int IN_WP = 3840;
constexpr size_t MiB = 1024ull * 1024ull;

constexpr size_t OFF_XN   = 0;
constexpr size_t OFF_WIN  = 64 * MiB;
constexpr size_t OFF_WOUT = 72 * MiB;
constexpr size_t OFF_WQ   = 74 * MiB;
constexpr size_t OFF_SK   = 78 * MiB;
constexpr size_t OFF_LB   = 79 * MiB;
constexpr size_t OFF_U8   = 80 * MiB;
constexpr size_t OFF_V8   = 96 * MiB;
constexpr size_t OFF_US   = 112 * MiB;
constexpr size_t OFF_VS   = 113 * MiB;
constexpr size_t OFF_R2   = 144 * MiB;
constexpr size_t OFF_HQ   = OFF_R2;
constexpr size_t OFF_HLF  = OFF_R2 + 32 * MiB;
constexpr size_t OFF_HV   = OFF_R2 + 64 * MiB;
constexpr size_t OFF_HG   = OFF_R2 + 96 * MiB;
constexpr size_t OFF_GQ   = OFF_R2 + 128 * MiB;
constexpr size_t OFF_GK   = OFF_R2 + 144 * MiB;
constexpr size_t OFF_GV   = OFF_R2 + 160 * MiB;
constexpr size_t OFF_GG   = OFF_R2 + 192 * MiB;
constexpr size_t OFF_GLOW = OFF_R2 + 224 * MiB;
constexpr size_t OFF_KTH  = 370 * MiB;
constexpr size_t OFF_KTG  = 402 * MiB;
constexpr size_t OFF_DECH = 418 * MiB;
constexpr size_t OFF_DECG = 419 * MiB;
constexpr size_t OFF_HVT  = 420 * MiB;
constexpr size_t OFF_GVT  = 452 * MiB;
constexpr size_t OFF_BAR  = 484 * MiB;
constexpr size_t WS_NEED  = 485 * MiB;
constexpr size_t OFF_MIX  = OFF_XN;
constexpr size_t OFF_HN   = OFF_R2;
constexpr size_t OFF_Q    = OFF_R2 + 64 * MiB;
constexpr size_t OFF_EIDX = OFF_KTH;
constexpr size_t OFF_EW   = OFF_KTH + 16 * MiB;
constexpr size_t OFF_EU   = OFF_KTG;
constexpr size_t OFF_HN8  = OFF_XN;
constexpr size_t OFF_HS   = OFF_XN + 32 * MiB;
constexpr size_t OFF_W16  = OFF_XN + 48 * MiB;
constexpr size_t OFF_SSQ  = OFF_XN + 33 * MiB;
constexpr size_t OFF_PD   = OFF_Q;
constexpr size_t OUT_STH = 0;
constexpr size_t OUT_STG = 64 * MiB;

struct Params {
    const float* x; const float* norm1_g; const float* w_in; const float* hg_lower; const float* hg_norm_g;
    const float* gla_wg; const float* gla_bg; const float* gla_norm_g; const float* w_out; const float* norm2_g;
    const float* w_q; const float* sub_keys; const float* peer_u; const float* peer_v; const float* norm_f_g;
    float* out; unsigned char* ws;
    int ph_lo, ph_hi;
};

DEVI unsigned short f2bf(float f) {
    unsigned u = __float_as_uint(f);
    u += 0x7fffu + ((u >> 16) & 1u);
    return (unsigned short)(u >> 16);
}
DEVI float bf2f(unsigned short b) { return __uint_as_float(((unsigned)b) << 16); }
DEVI unsigned pack2(float a, float b) { return (unsigned)f2bf(a) | ((unsigned)f2bf(b) << 16); }
DEVI float bflo(unsigned u) { return __uint_as_float(u << 16); }
DEVI float bfhi(unsigned u) { return __uint_as_float(u & 0xffff0000u); }
DEVI float wave_sum(float v) {
#pragma unroll
    for (int o = 32; o > 0; o >>= 1) v += __shfl_xor(v, o);
    return v;
}
DEVI float wave_max(float v) {
#pragma unroll
    for (int o = 32; o > 0; o >>= 1) v = fmaxf(v, __shfl_xor(v, o));
    return v;
}
DEVI float silu_f(float x) { return x / (1.f + __expf(-x)); }
DEVI f32x4 mfma16(bf16x8 a, bf16x8 b, f32x4 c) { return __builtin_amdgcn_mfma_f32_16x16x32_bf16(a, b, c, 0, 0, 0); }
DEVI bf16x8 ldg_frag(const bf16_t* p) { return *reinterpret_cast<const bf16x8*>(p); }

DEVI void rms_row_bf16(const float* __restrict__ xr, const float* __restrict__ g, bf16_t* __restrict__ dst, int lane) {
    float4 v[4]; float ss = 0.f;
#pragma unroll
    for (int i = 0; i < 4; ++i) { v[i] = reinterpret_cast<const float4*>(xr)[lane + 64 * i]; ss += v[i].x * v[i].x + v[i].y * v[i].y + v[i].z * v[i].z + v[i].w * v[i].w; }
    ss = wave_sum(ss);
    const float r = rsqrtf(ss * (1.f / 1024.f) + 1e-6f);
#pragma unroll
    for (int i = 0; i < 4; ++i) {
        const float4 gg = reinterpret_cast<const float4*>(g)[lane + 64 * i];
        uint2 o; o.x = pack2(v[i].x * r * gg.x, v[i].y * r * gg.y); o.y = pack2(v[i].z * r * gg.z, v[i].w * r * gg.w);
        reinterpret_cast<uint2*>(dst)[lane + 64 * i] = o;
    }
}

DEVI void transpose_tile(const float* __restrict__ src, int Nsrc, bf16_t* __restrict__ dst, int nt, int kt, int mode, float* lds) {
    const int tid = LTID, tx = tid & 63, ty = tid >> 6;
    const int np = nt * 64 + tx;
    int col = np; bool valid = true;
    if (mode == 1) {
        if (np < 3072) col = np; else if (np < 3584) col = np + 16; else if (np < 3600) col = np - 512; else { valid = false; col = 0; }
    }
#pragma unroll 4
    for (int kk = ty; kk < 64; kk += 4) {
        lds[kk * 65 + tx] = valid ? src[(size_t)(kt * 64 + kk) * Nsrc + col] : 0.f;
    }
    __syncthreads();
    const int nl = tid >> 2, kq = tid & 3;
    unsigned pk[8];
#pragma unroll
    for (int i = 0; i < 8; ++i) pk[i] = pack2(lds[(kq * 16 + 2 * i) * 65 + nl], lds[(kq * 16 + 2 * i + 1) * 65 + nl]);
    uint4* d = reinterpret_cast<uint4*>(dst + (size_t)(nt * 64 + nl) * 1024 + kt * 64 + kq * 16);
    d[0] = make_uint4(pk[0], pk[1], pk[2], pk[3]);
    d[1] = make_uint4(pk[4], pk[5], pk[6], pk[7]);
    __syncthreads();
}

DEVI void convert8(const float* __restrict__ src, bf16_t* __restrict__ dst, size_t idx8) {
    const float4 a = reinterpret_cast<const float4*>(src)[idx8 * 2], b = reinterpret_cast<const float4*>(src)[idx8 * 2 + 1];
    reinterpret_cast<uint4*>(dst)[idx8] = make_uint4(pack2(a.x, a.y), pack2(a.z, a.w), pack2(b.x, b.y), pack2(b.z, b.w));
}

DEVI int pack_i8x4(float a, float b, float c, float d) {
    const int ia = (int)rintf(a), ib = (int)rintf(b), ic = (int)rintf(c), id = (int)rintf(d);
    return (ia & 255) | ((ib & 255) << 8) | ((ic & 255) << 16) | (id << 24);
}
DEVI void quant_row_i8(const float* __restrict__ xr, unsigned char* __restrict__ dst_table, int row, float* __restrict__ descale, int lane) {
    float4 v[4]; float am = 0.f;
#pragma unroll
    for (int i = 0; i < 4; ++i) { v[i] = reinterpret_cast<const float4*>(xr)[lane + 64 * i]; am = fmaxf(am, fmaxf(fmaxf(fabsf(v[i].x), fabsf(v[i].y)), fmaxf(fabsf(v[i].z), fabsf(v[i].w)))); }
    am = wave_max(am);
    const float sc = am > 0.f ? 127.f / am : 1.f;
#pragma unroll
    for (int i = 0; i < 4; ++i) {
        const int w = lane + 64 * i;
        reinterpret_cast<int*>(dst_table)[(size_t)(w >> 5) * (16384 * 32) + (size_t)row * 32 + (w & 31)] = pack_i8x4(v[i].x * sc, v[i].y * sc, v[i].z * sc, v[i].w * sc);
    }
    if (lane == 0) *descale = am > 0.f ? am * (1.f / 127.f) : 1.f;
}
DEVI void quant_row_fp8(const float* __restrict__ xr, unsigned char* __restrict__ dst_table, int row, float* __restrict__ descale, int lane) {
    float4 v[4]; float am = 0.f;
#pragma unroll
    for (int i = 0; i < 4; ++i) { v[i] = reinterpret_cast<const float4*>(xr)[lane + 64 * i]; am = fmaxf(am, fmaxf(fmaxf(fabsf(v[i].x), fabsf(v[i].y)), fmaxf(fabsf(v[i].z), fabsf(v[i].w)))); }
    am = wave_max(am);
    const float sc = am > 0.f ? 448.f / am : 1.f;
#pragma unroll
    for (int i = 0; i < 4; ++i) {
        const float a = fminf(fmaxf(v[i].x * sc, -448.f), 448.f), b = fminf(fmaxf(v[i].y * sc, -448.f), 448.f);
        const float c = fminf(fmaxf(v[i].z * sc, -448.f), 448.f), d = fminf(fmaxf(v[i].w * sc, -448.f), 448.f);
        int pk = __builtin_amdgcn_cvt_pk_fp8_f32(a, b, 0, false);
        pk = __builtin_amdgcn_cvt_pk_fp8_f32(c, d, pk, true);
        const int w = lane + 64 * i;
        reinterpret_cast<int*>(dst_table)[(size_t)(w >> 5) * (16384 * 32) + (size_t)row * 32 + (w & 31)] = pk;
    }
    if (lane == 0) *descale = am > 0.f ? am * (1.f / 448.f) : 1.f;
}

constexpr int P0_XN = 8192, P0_WIN = 60 * 16, P0_WOUT = 16 * 16, P0_WQ = 32 * 16, P0_UV = 8192, P0_SK = 128, P0_LB = 1;
constexpr int P0_UNITS = P0_XN + P0_WIN + P0_WOUT + P0_WQ + P0_UV + P0_SK + P0_LB;

DEVI void phase0_unit(const Params& p, int u, char* smem) {
    const int tid = LTID, lane = tid & 63, w = tid >> 6;
    unsigned char* ws = p.ws;
    if (u < P0_XN) {
        const int row = u * 4 + w;
        rms_row_bf16(p.x + (size_t)row * DM, p.norm1_g, reinterpret_cast<bf16_t*>(ws + OFF_XN) + (size_t)row * DM, lane);
        return;
    }
    u -= P0_XN;
    if (u < P0_WIN) { transpose_tile(p.w_in, 3600, reinterpret_cast<bf16_t*>(ws + OFF_WIN), u / 16, u % 16, 1, reinterpret_cast<float*>(smem)); return; }
    u -= P0_WIN;
    if (u < P0_WOUT) { transpose_tile(p.w_out, 1024, reinterpret_cast<bf16_t*>(ws + OFF_WOUT), u / 16, u % 16, 0, reinterpret_cast<float*>(smem)); return; }
    u -= P0_WOUT;
    if (u < P0_WQ) { transpose_tile(p.w_q, 2048, reinterpret_cast<bf16_t*>(ws + OFF_WQ), u / 16, u % 16, 0, reinterpret_cast<float*>(smem)); return; }
    u -= P0_WQ;
    if (u < P0_UV) {
        const bool isv = u >= 4096; const int row = (isv ? u - 4096 : u) * 4 + w;
        if (isv) quant_row_fp8(p.peer_v + (size_t)row * DM, ws + OFF_V8, row, reinterpret_cast<float*>(ws + OFF_VS) + row, lane);
        else quant_row_i8(p.peer_u + (size_t)row * DM, ws + OFF_U8, row, reinterpret_cast<float*>(ws + OFF_US) + row, lane);
        return;
    }
    u -= P0_UV;
    if (u < P0_SK) { convert8(p.sub_keys, reinterpret_cast<bf16_t*>(ws + OFF_SK), (size_t)u * 256 + tid); return; }
    float* lb = reinterpret_cast<float*>(ws + OFF_LB);
    for (int n = tid; n < 512; n += 256) {
        const float l0 = p.hg_lower[n], l1 = p.hg_lower[512 + n];
        const float mx = fmaxf(l0, l1); const float e0 = __expf(l0 - mx), e1 = __expf(l1 - mx);
        lb[n] = e0 / (e0 + e1);
    }
}

namespace pg8 {
#define PG8_LAS __attribute__((address_space(3)))
typedef unsigned short bf16_t;
typedef short bf16x8 __attribute__((ext_vector_type(8)));
typedef float f32x4 __attribute__((ext_vector_type(4)));
typedef unsigned u32x4 __attribute__((ext_vector_type(4)));
constexpr int BM = 256, BK = 64, HALF = 128, HTB = HALF * BK * 2  , STAGE_BYTES = 8 * HTB, NXCD = 8, WGM = 8;

__host__ __device__ __forceinline__ int lds_byte(int r, int c) { const int st = (r >> 4) * 2 + (c >> 5), rr = r & 15, cc = c & 31, ob = rr * 64 + cc * 2; return st * 1024 + (ob ^ (((ob >> 9) & 1) << 5)); }
__host__ __device__ __forceinline__ void stage_rc(int b, int& R, int& C) { const int st = b / 1024, sb = b % 1024, swz = sb ^ (((sb >> 9) & 1) << 5); R = (st >> 1) * 16 + swz / 64; C = (st & 1) * 32 + (swz % 64) / 2; }
__host__ __device__ __forceinline__ int perm32(int rho) { const int n = rho >> 4, i = rho & 15; return 8 * (i >> 2) + 4 * n + (i & 3); }

struct Unit { int pm, pn; };
struct Gemm { const bf16_t* A; const bf16_t* Bt; int M, N, K; };

struct StaticOrder {
    int nM, nN, nwg, G, c;
    __host__ __device__ void init(int M, int N, int G_, int c_) { nM = M / BM; nN = N / BM; nwg = nM * nN; G = G_; c = c_; }
    __host__ __device__ bool next(int i, Unit& u) const {
        const long L = (long)i * G + c; if (L >= nwg) return false;
        int wgid = (int)L; { const int q = nwg / NXCD, r = nwg % NXCD, xcd = wgid % NXCD, off = wgid / NXCD; wgid = (xcd < r ? xcd * (q + 1) : r * (q + 1) + (xcd - r) * q) + off; }
        const int nig = WGM * nN, gid = wgid / nig, fm = gid * WGM, gsz = (nM - fm) < WGM ? (nM - fm) : WGM;
        u.pm = fm + ((wgid % nig) % gsz); u.pn = (wgid % nig) / gsz; return true;
    }
    __device__ __forceinline__ void a_ready(const Unit&) const {}
    __device__ __forceinline__ void done(const Unit&) const {}
};
__device__ __forceinline__ unsigned cvt_pk_bf16(float lo, float hi) { unsigned r; asm volatile("v_cvt_pk_bf16_f32 %0, %1, %2" : "=v"(r) : "v"(lo), "v"(hi)); return r; }
typedef float f32x2 __attribute__((ext_vector_type(2)));
template <class Epi, class Sched, bool STAMP = false>
__device__ __forceinline__ void gemm_phase(PG8_LAS unsigned char* lds, const Gemm g, const Sched& S, const Epi& E, unsigned long long* stamps) {
    const int tid = threadIdx.x, wid = __builtin_amdgcn_readfirstlane(tid >> 6), lane = tid & 63, wr = wid >> 2, wc = wid & 3, fr = lane & 15, fq = lane >> 4;
    const int K = g.K, nt = K / BK;
    int ts_lo = 0, ts_hi = 0, nts = 0; const unsigned long long rt_entry = STAMP ? (unsigned long long)wall_clock64() : 0ull;
#define PG8_STAMP() do { if (STAMP && wid == 0 && nts < 64) { const unsigned long long _c = (unsigned long long)clock64(); \
        ts_lo = (lane == nts) ? (int)(unsigned)_c : ts_lo; ts_hi = (lane == nts) ? (int)(unsigned)(_c >> 32) : ts_hi; ++nts; } } while (0)
    PG8_STAMP();
    unsigned voffA[2], voffB[2];
#pragma unroll
    for (int i = 0; i < 2; ++i) { int R, C; stage_rc(tid * 16 + i * 8192, R, C); const int Rb = Epi::PERM ? ((R & ~31) + perm32(R & 31)) : R;
        voffA[i] = (unsigned)(R * K + C) * 2u; voffB[i] = (unsigned)(Rb * K + C) * 2u; }
    const size_t kstep = (size_t)(BK * 2);
    const size_t hstep = (size_t)HALF * K * 2;
    const size_t tstep = 2 * hstep;
    const unsigned ldsw = (unsigned)wid * 1024u;
    const int aoff = lds_byte(wr * 64 + fr, fq * 8), boff = lds_byte(wc * 32 + fr, fq * 8);
#define PG8_SA(b, h) (((b) * 2 + (h)) * HTB)
#define PG8_SB(b, h) ((4 + (b) * 2 + (h)) * HTB)
#define PG8_STAGE(bufoff, gbase, voff) do { _Pragma("unroll") for (int _i = 0; _i < 2; ++_i) \
        __builtin_amdgcn_global_load_lds((const unsigned*)((const char*)(gbase) + (voff)[_i]), (PG8_LAS unsigned*)(lds + (bufoff) + ldsw + _i * 8192), 16, 0, 0); } while (0)
#define PG8_LDA(dst, b, h) do { _Pragma("unroll") for (int m = 0; m < 4; ++m) _Pragma("unroll") for (int k = 0; k < 2; ++k) dst[m][k] = *(const PG8_LAS bf16x8*)(lds + PG8_SA(b, h) + aoff + m * 2048 + k * 1024); } while (0)
#define PG8_LDB(dst, b, h) do { _Pragma("unroll") for (int n = 0; n < 2; ++n) _Pragma("unroll") for (int k = 0; k < 2; ++k) dst[n][k] = *(const PG8_LAS bf16x8*)(lds + PG8_SB(b, h) + boff + n * 2048 + k * 1024); } while (0)
#define PG8_MMA(ai, bj, At, Bt) do { __builtin_amdgcn_s_setprio(1); _Pragma("unroll") for (int m = 0; m < 4; ++m) _Pragma("unroll") for (int n = 0; n < 2; ++n) _Pragma("unroll") for (int k = 0; k < 2; ++k) \
        acc[ai][bj][m][n] = __builtin_amdgcn_mfma_f32_16x16x32_bf16(Bt[n][k], At[m][k], acc[ai][bj][m][n], 0, 0, 0); __builtin_amdgcn_s_setprio(0); } while (0)
#define PG8_WAIT_V(n) asm volatile("s_waitcnt vmcnt(" #n ")" ::: "memory")
#define PG8_WAIT_L(n) asm volatile("s_waitcnt lgkmcnt(" #n ")" ::: "memory")
#define PG8_BAR __builtin_amdgcn_s_barrier()
#define PG8_SCHED __builtin_amdgcn_sched_barrier(0)
    Unit cur, nxt; int ui = 0;
    if (!S.next(0, cur)) return;
    f32x4 acc[2][2][4][2];
#pragma unroll
    for (int a = 0; a < 2; ++a)
#pragma unroll
        for (int b = 0; b < 2; ++b)
#pragma unroll
            for (int m = 0; m < 4; ++m)
#pragma unroll
                for (int n = 0; n < 2; ++n) acc[a][b][m][n] = (f32x4){0.f, 0.f, 0.f, 0.f};
    bf16x8 At[4][2], B0[2][2], B1[2][2];
    const char* cA = (const char*)g.A + (size_t)cur.pm * tstep; const char* cB = (const char*)g.Bt + (size_t)cur.pn * tstep;
    S.a_ready(cur);
    PG8_STAGE(PG8_SB(0, 0), cB, voffB); PG8_STAGE(PG8_SA(0, 0), cA, voffA); PG8_STAGE(PG8_SB(0, 1), cB + hstep, voffB); PG8_STAGE(PG8_SA(0, 1), cA + hstep, voffA);
    if (wr == 1) PG8_BAR;
    PG8_WAIT_V(4); PG8_BAR;
    PG8_STAGE(PG8_SB(1, 0), cB + kstep, voffB); PG8_STAGE(PG8_SA(1, 0), cA + kstep, voffA); PG8_STAGE(PG8_SB(1, 1), cB + hstep + kstep, voffB);
    PG8_WAIT_V(6); PG8_BAR;
    PG8_STAMP();
    for (;;) {
        const bool has_next = S.next(ui + 1, nxt);
        const char* nA = has_next ? (const char*)g.A + (size_t)nxt.pm * tstep : cA; const char* nB = has_next ? (const char*)g.Bt + (size_t)nxt.pn * tstep : cB;
        for (int t = 0; t < nt; t += 2) {
            const bool last = (t == nt - 2);
            const char* a1 = cA + (size_t)(t + 1) * kstep;
            const char* a2 = last ? nA : cA + (size_t)(t + 2) * kstep; const char* b2 = last ? nB : cB + (size_t)(t + 2) * kstep;
            const char* a3 = a2 + kstep; const char* b3 = b2 + kstep;
            if (last && has_next) S.a_ready(nxt);
            PG8_LDB(B0, 0, 0); PG8_SCHED; PG8_LDA(At, 0, 0); PG8_STAGE(PG8_SA(1, 1), a1 + hstep, voffA);
            PG8_WAIT_L(8); PG8_BAR; PG8_WAIT_L(0); PG8_MMA(0, 0, At, B0); PG8_BAR; PG8_SCHED;
            PG8_LDB(B1, 0, 1); PG8_STAGE(PG8_SB(0, 0), b2, voffB);
            PG8_BAR; PG8_WAIT_L(0); PG8_MMA(0, 1, At, B1); PG8_BAR;
            PG8_LDA(At, 0, 1); PG8_STAGE(PG8_SA(0, 0), a2, voffA);
            PG8_BAR; PG8_WAIT_L(0); PG8_MMA(1, 0, At, B0); PG8_BAR; PG8_SCHED;
            PG8_STAGE(PG8_SB(0, 1), b2 + hstep, voffB);
            PG8_WAIT_V(6); PG8_BAR; PG8_MMA(1, 1, At, B1); PG8_BAR;
            PG8_LDB(B0, 1, 0); PG8_SCHED; PG8_LDA(At, 1, 0); PG8_STAGE(PG8_SA(0, 1), a2 + hstep, voffA);
            PG8_WAIT_L(8); PG8_BAR; PG8_WAIT_L(0); PG8_MMA(0, 0, At, B0); PG8_BAR; PG8_SCHED;
            PG8_LDB(B1, 1, 1); PG8_STAGE(PG8_SB(1, 0), b3, voffB);
            PG8_BAR; PG8_WAIT_L(0); PG8_MMA(0, 1, At, B1); PG8_BAR;
            PG8_LDA(At, 1, 1); PG8_STAGE(PG8_SA(1, 0), a3, voffA);
            PG8_BAR; PG8_WAIT_L(0); PG8_MMA(1, 0, At, B0); PG8_BAR; PG8_SCHED;
            PG8_STAGE(PG8_SB(1, 1), b3 + hstep, voffB);
            PG8_WAIT_V(6); PG8_BAR; PG8_MMA(1, 1, At, B1); PG8_BAR;
        }
        PG8_STAMP();
        if constexpr (!Epi::AFTER_DRAIN) { E(acc, cur, wr, wc, fr, fq); S.done(cur); }
        PG8_STAMP();
        if (!has_next) break;
#pragma unroll
        for (int a = 0; a < 2; ++a)
#pragma unroll
            for (int b = 0; b < 2; ++b)
#pragma unroll
                for (int m = 0; m < 4; ++m)
#pragma unroll
                    for (int n = 0; n < 2; ++n) acc[a][b][m][n] = (f32x4){0.f, 0.f, 0.f, 0.f};
        cur = nxt; cA = nA; cB = nB; ++ui;
    }
    PG8_WAIT_V(0);
    if (wr == 0) PG8_BAR;
    PG8_BAR;
    if constexpr (Epi::AFTER_DRAIN) { E.fused(acc, cur, wr, wc, fr, fq, lds, wid, lane); S.done(cur); }
    PG8_STAMP();
    if (STAMP && wid == 0) { stamps[lane] = lane < nts ? (((unsigned long long)(unsigned)ts_hi << 32) | (unsigned)ts_lo) : 0ull;
        if (lane == 62) stamps[62] = rt_entry; if (lane == 63) stamps[63] = (unsigned long long)wall_clock64(); }
#undef PG8_STAMP
#undef PG8_SA
#undef PG8_SB
#undef PG8_STAGE
#undef PG8_LDA
#undef PG8_LDB
#undef PG8_MMA
#undef PG8_WAIT_V
#undef PG8_WAIT_L
#undef PG8_BAR
#undef PG8_SCHED
}
}

DEVI uint4 pack8(const pg8::f32x4 a, const pg8::f32x4 b) { return make_uint4(pack2(a[0], a[1]), pack2(a[2], a[3]), pack2(b[0], b[1]), pack2(b[2], b[3])); }

constexpr int P1_N = IN_WP;
struct EpiInProj {
    static constexpr bool PERM = true, AFTER_DRAIN = false;
    unsigned char* ws;
    __device__ __forceinline__ void operator()(const pg8::f32x4 (&acc)[2][2][4][2], const pg8::Unit& u, int wr, int wc, int fr, int fq) const {
        const int row0 = u.pm * 256 + wr * 64 + fr;
        const int pn = u.pn;
        const int cl0 = wc * 32 + 8 * fq;
        bf16_t* dst; int ld, cbase, kind;
        if (pn < 2)       { dst = reinterpret_cast<bf16_t*>(ws + OFF_HQ);  ld = 512; cbase = pn * 256;        kind = 1; }
        else if (pn < 4)  { dst = reinterpret_cast<bf16_t*>(ws + OFF_HLF); ld = 512; cbase = (pn - 2) * 256;  kind = 2; }
        else if (pn < 6)  { dst = reinterpret_cast<bf16_t*>(ws + OFF_HV);  ld = 512; cbase = (pn - 4) * 256;  kind = 0; }
        else if (pn < 8)  { dst = reinterpret_cast<bf16_t*>(ws + OFF_HG);  ld = 512; cbase = (pn - 6) * 256;  kind = 1; }
        else if (pn == 8) { dst = reinterpret_cast<bf16_t*>(ws + OFF_GQ);  ld = 256; cbase = 0;               kind = 3; }
        else if (pn == 9) { dst = reinterpret_cast<bf16_t*>(ws + OFF_GK);  ld = 256; cbase = 0;               kind = 0; }
        else if (pn < 12) { dst = reinterpret_cast<bf16_t*>(ws + OFF_GV);  ld = 512; cbase = (pn - 10) * 256; kind = 0; }
        else if (pn < 14) { dst = reinterpret_cast<bf16_t*>(ws + OFF_GG);  ld = 512; cbase = (pn - 12) * 256; kind = 1; }
        else {
            if (wc == 0 && fq < 2) {
                float* gl = reinterpret_cast<float*>(ws + OFF_GLOW);
#pragma unroll
                for (int ai = 0; ai < 2; ++ai)
#pragma unroll
                    for (int m = 0; m < 4; ++m) {
                        float* rp = gl + (size_t)(row0 + ai * 128 + m * 16) * 16 + 8 * fq;
                        *reinterpret_cast<pg8::f32x4*>(rp) = acc[ai][0][m][0];
                        *reinterpret_cast<pg8::f32x4*>(rp + 4) = acc[ai][0][m][1];
                    }
            }
            return;
        }
        float lbv[2][8];
#pragma unroll
        for (int bj = 0; bj < 2; ++bj)
#pragma unroll
            for (int j = 0; j < 8; ++j) lbv[bj][j] = 0.f;
        if (kind == 2) {
            const float* lb = reinterpret_cast<const float*>(ws + OFF_LB);
#pragma unroll
            for (int bj = 0; bj < 2; ++bj)
#pragma unroll
                for (int j = 0; j < 8; ++j) lbv[bj][j] = lb[cbase + bj * 128 + cl0 + j];
        }
#pragma unroll
        for (int ai = 0; ai < 2; ++ai)
#pragma unroll
            for (int m = 0; m < 4; ++m) {
                bf16_t* rowp = dst + (size_t)(row0 + ai * 128 + m * 16) * ld + cbase + cl0;
#pragma unroll
                for (int bj = 0; bj < 2; ++bj) {
                    pg8::f32x4 v0 = acc[ai][bj][m][0], v1 = acc[ai][bj][m][1];
                    if (kind == 1) {
#pragma unroll
                        for (int j = 0; j < 4; ++j) { v0[j] = silu_f(v0[j]); v1[j] = silu_f(v1[j]); }
                    } else if (kind == 2) {
#pragma unroll
                        for (int j = 0; j < 4; ++j) {
                            const float l0 = lbv[bj][j], l1 = lbv[bj][4 + j];
                            v0[j] = __logf(l0 + (1.f - l0) / (1.f + __expf(-v0[j])));
                            v1[j] = __logf(l1 + (1.f - l1) / (1.f + __expf(-v1[j])));
                        }
                    } else if (kind == 3) {
#pragma unroll
                        for (int j = 0; j < 4; ++j) { v0[j] *= 0.125f; v1[j] *= 0.125f; }
                    }
                    *reinterpret_cast<uint4*>(rowp + bj * 128) = pack8(v0, v1);
                }
            }
    }
};
struct EpiOutProj {
    static constexpr bool PERM = false, AFTER_DRAIN = false;
    const float* x; float* out;
    __device__ __forceinline__ void operator()(const pg8::f32x4 (&acc)[2][2][4][2], const pg8::Unit& u, int wr, int wc, int fr, int fq) const {
        const int row0 = u.pm * 256 + wr * 64 + fr, col0 = u.pn * 256 + wc * 32 + 4 * fq;
#pragma unroll
        for (int ai = 0; ai < 2; ++ai)
#pragma unroll
            for (int m = 0; m < 4; ++m) {
                const size_t ro = (size_t)(row0 + ai * 128 + m * 16) * DM + col0;
#pragma unroll
                for (int bj = 0; bj < 2; ++bj)
#pragma unroll
                    for (int n = 0; n < 2; ++n) {
                        const pg8::f32x4 xv = *reinterpret_cast<const pg8::f32x4*>(x + ro + bj * 128 + n * 16);
                        *reinterpret_cast<pg8::f32x4*>(out + ro + bj * 128 + n * 16) = xv + acc[ai][bj][m][n];
                    }
            }
    }
};
struct EpiQ {
    static constexpr bool PERM = true, AFTER_DRAIN = false;
    bf16_t* Q;
    __device__ __forceinline__ void operator()(const pg8::f32x4 (&acc)[2][2][4][2], const pg8::Unit& u, int wr, int wc, int fr, int fq) const {
        const int row0 = u.pm * 256 + wr * 64 + fr, col0 = u.pn * 256 + wc * 32 + 8 * fq;
#pragma unroll
        for (int ai = 0; ai < 2; ++ai)
#pragma unroll
            for (int m = 0; m < 4; ++m) {
                bf16_t* rowp = Q + (size_t)(row0 + ai * 128 + m * 16) * 2048 + col0;
#pragma unroll
                for (int bj = 0; bj < 2; ++bj) *reinterpret_cast<uint4*>(rowp + bj * 128) = pack8(acc[ai][bj][m][0], acc[ai][bj][m][1]);
            }
    }
};
template <class Epi>
DEVI void run_gemm(const bf16_t* A, const bf16_t* Bt, int N, const Epi& E, char* smem) {
    pg8::Gemm g{A, Bt, M_TOK, N, 1024};
#if PROBE_GEMM_DUP
    struct DupOrder : pg8::StaticOrder { __host__ __device__ bool next(int i, pg8::Unit& u) const { return pg8::StaticOrder::next(i >> 1, u); } };
    DupOrder S; S.init(M_TOK, N, (int)gridDim.x, (int)blockIdx.x);
    pg8::gemm_phase<Epi, DupOrder, false>((PG8_LAS unsigned char*)smem, g, S, E, nullptr);
#else
    pg8::StaticOrder S; S.init(M_TOK, N, (int)gridDim.x, (int)blockIdx.x);
    pg8::gemm_phase<Epi, pg8::StaticOrder, false>((PG8_LAS unsigned char*)smem, g, S, E, nullptr);
#endif
    __builtin_amdgcn_s_waitcnt(0);
}

constexpr int P2_UNITS = 512 * 7;
DEVI float logsigmoid_f(float z) { return fminf(z, 0.f) - __logf(1.f + __expf(-fabsf(z))); }

template <bool DRY>
DEVI void phase2_unit_t(const Params& p, int u, char* smem) {
    unsigned char* ws = p.ws;
    const int tid = LTID;
    const int cidx = u / 7, part = u % 7;
    const size_t row0 = (size_t)cidx * 64;
    if (part >= 3) {
        const bool isg = part >= 5; const int n = ((part - 3) & 1) * 256 + tid;
        const bf16_t* V = reinterpret_cast<const bf16_t*>(ws + (isg ? OFF_GV : OFF_HV));
        bf16_t* VT = reinterpret_cast<bf16_t*>(ws + (isg ? OFF_GVT : OFF_HVT));
#pragma unroll 1
        for (int hf = 0; hf < 4; ++hf) {
            unsigned short vb[16];
#pragma unroll
            for (int r = 0; r < 16; ++r) vb[r] = V[(row0 + hf * 16 + r) * 512 + n];
#pragma unroll
            for (int r8 = 0; r8 < 2; ++r8) {
                unsigned pk[4];
#pragma unroll
                for (int rr = 0; rr < 8; ++rr) {
                    const unsigned short b = vb[r8 * 8 + rr];
                    if (rr & 1) pk[rr >> 1] |= ((unsigned)b << 16); else pk[rr >> 1] = b;
                }
                *reinterpret_cast<uint4*>(VT + ((size_t)cidx * 512 + n) * 64 + hf * 16 + r8 * 8) = make_uint4(pk[0], pk[1], pk[2], pk[3]);
            }
        }
        return;
    }
    if (part < 2) {
        const int n = part * 256 + tid;
        bf16_t* HQ = reinterpret_cast<bf16_t*>(ws + OFF_HQ);
        bf16_t* HLF = reinterpret_cast<bf16_t*>(ws + OFF_HLF);
        bf16_t* KT = reinterpret_cast<bf16_t*>(ws + OFF_KTH);
        float Gl = 0.f;
#pragma unroll 16
        for (int r = 0; r < 64; ++r) Gl += bf2f(HLF[(row0 + r) * 512 + n]);
        float G = 0.f;
#pragma unroll 1
        for (int hf = 0; hf < 4; ++hf) {
            unsigned short lfb[16], qb[16];
#pragma unroll
            for (int r = 0; r < 16; ++r) { lfb[r] = HLF[(row0 + hf * 16 + r) * 512 + n]; qb[r] = HQ[(row0 + hf * 16 + r) * 512 + n]; }
#pragma unroll
            for (int r8 = 0; r8 < 2; ++r8) {
                unsigned pk[4];
#pragma unroll
                for (int rr = 0; rr < 8; ++rr) {
                    const int r = r8 * 8 + rr;
                    const size_t idx = (row0 + hf * 16 + r) * 512 + n;
                    const float lf = bf2f(lfb[r]);
                    G += lf;
                    const float key = 1.f - __expf(lf);
                    const unsigned short bq = f2bf(bf2f(qb[r]) * __expf(G));
                    const unsigned short bk = f2bf(key * __expf(-G));
                    if (DRY) { reinterpret_cast<bf16_t*>(ws + OFF_XN)[idx] = bq; reinterpret_cast<bf16_t*>(ws + OFF_XN + 32 * MiB)[idx] = bk; } else { HQ[idx] = bq; HLF[idx] = bk; }
                    if (rr & 1) pk[rr >> 1] |= ((unsigned)bk << 16); else pk[rr >> 1] = bk;
                }
                *reinterpret_cast<uint4*>((DRY ? reinterpret_cast<bf16_t*>(p.out) : KT) + ((size_t)cidx * 512 + n) * 64 + hf * 16 + r8 * 8) = make_uint4(pk[0], pk[1], pk[2], pk[3]);
            }
        }
        reinterpret_cast<float*>(DRY ? reinterpret_cast<unsigned char*>(p.out) + 64 * MiB : ws + OFF_DECH)[(size_t)cidx * 512 + n] = __expf(Gl);
    } else {
        const int n = tid;
        bf16_t* GQ = reinterpret_cast<bf16_t*>(ws + OFF_GQ);
        bf16_t* GK = reinterpret_cast<bf16_t*>(ws + OFF_GK);
        bf16_t* KT = reinterpret_cast<bf16_t*>(ws + OFF_KTG);
        const float* GL = reinterpret_cast<const float*>(ws + OFF_GLOW);
        float wg[16];
#pragma unroll
        for (int j = 0; j < 16; ++j) wg[j] = p.gla_wg[j * 256 + n];
        const float bg = p.gla_bg[n];
        float Gl = 0.f, G = 0.f;
#pragma unroll 1
        for (int hf = 0; hf < 4; ++hf) {
            unsigned short qb[16], kb[16]; float lgv[16];
#pragma unroll
            for (int r = 0; r < 16; ++r) { qb[r] = GQ[(row0 + hf * 16 + r) * 256 + n]; kb[r] = GK[(row0 + hf * 16 + r) * 256 + n]; }
#pragma unroll
            for (int r = 0; r < 16; ++r) {
                const float4* g4 = reinterpret_cast<const float4*>(GL + (row0 + hf * 16 + r) * 16);
                float z = bg;
#pragma unroll
                for (int j = 0; j < 4; ++j) { const float4 t = g4[j]; z += t.x * wg[4 * j] + t.y * wg[4 * j + 1] + t.z * wg[4 * j + 2] + t.w * wg[4 * j + 3]; }
                lgv[r] = logsigmoid_f(z) * (1.f / 16.f);
            }
#pragma unroll
            for (int r8 = 0; r8 < 2; ++r8) {
                unsigned pk[4];
#pragma unroll
                for (int rr = 0; rr < 8; ++rr) {
                    const int r = r8 * 8 + rr;
                    G += lgv[r];
                    const size_t idx = (row0 + hf * 16 + r) * 256 + n;
                    const unsigned short bq = f2bf(bf2f(qb[r]) * __expf(G));
                    const unsigned short bk = f2bf(bf2f(kb[r]) * __expf(-G));
                    GQ[idx] = bq; GK[idx] = bk;
                    if (rr & 1) pk[rr >> 1] |= ((unsigned)bk << 16); else pk[rr >> 1] = bk;
                }
                *reinterpret_cast<uint4*>(KT + ((size_t)cidx * 256 + n) * 64 + hf * 16 + r8 * 8) = make_uint4(pk[0], pk[1], pk[2], pk[3]);
            }
        }
        Gl = G;
        reinterpret_cast<float*>(ws + OFF_DECG)[(size_t)cidx * 256 + n] = __expf(Gl);
    }
}

DEVI void phase2_unit(const Params& p, int u, char* smem) { phase2_unit_t<false>(p, u, smem); }
DEVI void phase2_dry_unit(const Params& p, int u, char* smem) { if ((u % 7) < 2) phase2_unit_t<true>(p, u, smem); }

constexpr int P3_UNITS = 4096;
template <int DK>
DEVI void kv_unit(const Params& p, int sidx, int c) {
    unsigned char* ws = p.ws;
    const int lane = LTID & 63, w = LTID >> 6;
    const int b = sidx >> 2, h = sidx & 3;
    const int cidx = b * 128 + c;
    constexpr int NDB = DK / 16;
    const bf16_t* KT = reinterpret_cast<const bf16_t*>(ws + (DK == 128 ? OFF_KTH : OFF_KTG)) + ((size_t)cidx * (4 * DK) + h * DK) * 64;
    const bf16_t* VT = reinterpret_cast<const bf16_t*>(ws + (DK == 128 ? OFF_HVT : OFF_GVT)) + ((size_t)cidx * 512 + h * 128) * 64;
    const float* DEC = reinterpret_cast<const float*>(ws + (DK == 128 ? OFF_DECH : OFF_DECG)) + (size_t)cidx * (4 * DK) + h * DK;
    bf16_t* ST = reinterpret_cast<bf16_t*>(reinterpret_cast<unsigned char*>(p.out) + (DK == 128 ? OUT_STH : OUT_STG)) + ((size_t)sidx * 128 + c) * (128 * DK);
    f32x4 acc[NDB][2];
#pragma unroll
    for (int i = 0; i < NDB; ++i) { acc[i][0] = f32x4{0, 0, 0, 0}; acc[i][1] = f32x4{0, 0, 0, 0}; }
    const int fo = (lane & 15) * 64 + 8 * (lane >> 4);
#pragma unroll
    for (int ks = 0; ks < 2; ++ks) {
        bf16x8 bv[2];
#pragma unroll
        for (int nb = 0; nb < 2; ++nb) bv[nb] = ldg_frag(VT + (size_t)(32 * w + nb * 16) * 64 + fo + ks * 32);
#pragma unroll
        for (int db = 0; db < NDB; ++db) {
            const bf16x8 ak = ldg_frag(KT + (size_t)(db * 16) * 64 + fo + ks * 32);
            acc[db][0] = mfma16(ak, bv[0], acc[db][0]);
            acc[db][1] = mfma16(ak, bv[1], acc[db][1]);
        }
    }
#pragma unroll
    for (int db = 0; db < NDB; ++db) {
        const int d = db * 16 + 4 * (lane >> 4);
        const float4 dc = *reinterpret_cast<const float4*>(DEC + d);
#pragma unroll
        for (int nb = 0; nb < 2; ++nb) {
            const int dv = 32 * w + nb * 16 + (lane & 15);
            uint2 o; o.x = pack2(acc[db][nb][0] * dc.x, acc[db][nb][1] * dc.y); o.y = pack2(acc[db][nb][2] * dc.z, acc[db][nb][3] * dc.w);
            *reinterpret_cast<uint2*>(ST + (size_t)dv * DK + d) = o;
        }
    }
}
DEVI void phase3_unit(const Params& p, int u, char* smem) {
    if (u < 2048) kv_unit<128>(p, u >> 7, u & 127); else { u -= 2048; kv_unit<64>(p, u >> 7, u & 127); }
}

constexpr int P4_UNITS = 384;
template <bool DRY>
DEVI void phase4_unit_t(const Params& p, int u, char* smem) {
    unsigned char* ws = p.ws;
    int e = u * 256 + LTID;
    bf16_t* base; bf16_t* sbase; const float* dec; size_t cstride; int decstride;
    if (e < 65536) {
        const int sidx = e >> 12, rem = e & 4095, dv = rem >> 5, d4 = (rem & 31) * 4;
        const int b = sidx >> 2, h = sidx & 3;
        base = reinterpret_cast<bf16_t*>(reinterpret_cast<unsigned char*>(p.out) + OUT_STH) + ((size_t)sidx * 128) * 16384 + dv * 128 + d4;
        sbase = DRY ? reinterpret_cast<bf16_t*>(ws + OFF_XN) + ((size_t)sidx * 128) * 16384 + dv * 128 + d4 : base;
        cstride = 16384;
        dec = reinterpret_cast<const float*>(ws + OFF_DECH) + (size_t)(b * 128) * 512 + h * 128 + d4; decstride = 512;
    } else {
        e -= 65536;
        const int sidx = e >> 11, rem = e & 2047, dv = rem >> 4, d4 = (rem & 15) * 4;
        const int b = sidx >> 2, h = sidx & 3;
        base = reinterpret_cast<bf16_t*>(reinterpret_cast<unsigned char*>(p.out) + OUT_STG) + ((size_t)sidx * 128) * 8192 + dv * 64 + d4;
        sbase = DRY ? reinterpret_cast<bf16_t*>(ws + OFF_KTH) + ((size_t)sidx * 128) * 8192 + dv * 64 + d4 : base;
        cstride = 8192;
        dec = reinterpret_cast<const float*>(ws + OFF_DECG) + (size_t)(b * 128) * 256 + h * 64 + d4; decstride = 256;
    }
    float s0 = 0.f, s1 = 0.f, s2 = 0.f, s3 = 0.f;
    for (int c8 = 0; c8 < 128; c8 += 8) {
        uint2 kv[8]; float4 dc[8];
#pragma unroll
        for (int i = 0; i < 8; ++i) { kv[i] = *reinterpret_cast<const uint2*>(base + (size_t)(c8 + i) * cstride); dc[i] = *reinterpret_cast<const float4*>(dec + (size_t)(c8 + i) * decstride); }
#pragma unroll
        for (int i = 0; i < 8; ++i) {
            uint2 o; o.x = pack2(s0, s1); o.y = pack2(s2, s3);
            *reinterpret_cast<uint2*>(sbase + (size_t)(c8 + i) * cstride) = o;
            s0 = dc[i].x * s0 + bflo(kv[i].x); s1 = dc[i].y * s1 + bfhi(kv[i].x);
            s2 = dc[i].z * s2 + bflo(kv[i].y); s3 = dc[i].w * s3 + bfhi(kv[i].y);
        }
    }
}

DEVI void phase4_unit(const Params& p, int u, char* smem) { phase4_unit_t<false>(p, u, smem); }
DEVI void phase4_dry_unit(const Params& p, int u, char* smem) { phase4_unit_t<true>(p, u, smem); }

constexpr int P5_UNITS = 4096;
constexpr int PL_PITCH = 72;
template <int DK>
DEVI void out_unit(const Params& p, int sidx, int c, char* smem) {
    unsigned char* ws = p.ws;
    const int lane = LTID & 63, w = LTID >> 6;
    const int b = sidx >> 2, h = sidx & 3;
    const int cidx = b * 128 + c;
    const size_t row0 = (size_t)cidx * 64;
    constexpr int LDQ = 4 * DK;
    const bf16_t* Qn = reinterpret_cast<const bf16_t*>(ws + (DK == 128 ? OFF_HQ : OFF_GQ)) + row0 * LDQ + h * DK;
    const bf16_t* Kn = reinterpret_cast<const bf16_t*>(ws + (DK == 128 ? OFF_HLF : OFF_GK)) + row0 * LDQ + h * DK;
    const bf16_t* VT = reinterpret_cast<const bf16_t*>(ws + (DK == 128 ? OFF_HVT : OFF_GVT)) + ((size_t)cidx * 512 + h * 128) * 64;
    const bf16_t* ST = reinterpret_cast<const bf16_t*>(reinterpret_cast<const unsigned char*>(p.out) + (DK == 128 ? OUT_STH : OUT_STG)) + ((size_t)sidx * 128 + c) * (128 * DK);
    const bf16_t* GATE = reinterpret_cast<const bf16_t*>(ws + (DK == 128 ? OFF_HG : OFF_GG)) + row0 * 512 + h * 128;
    const float* ng = (DK == 128) ? p.hg_norm_g : p.gla_norm_g;
    bf16_t* MIX = reinterpret_cast<bf16_t*>(ws + OFF_MIX) + row0 * 1024 + (DK == 128 ? 0 : 512) + h * 128;
    bf16_t* PL = reinterpret_cast<bf16_t*>(smem);
    float* RED = reinterpret_cast<float*>(smem + 64 * PL_PITCH * 2);

    const int l15 = lane & 15, lg = lane >> 4;
    {
        bf16x8 bq[DK / 32];
#pragma unroll
        for (int ks = 0; ks < DK / 32; ++ks) bq[ks] = ldg_frag(Qn + (size_t)(w * 16 + l15) * LDQ + ks * 32 + 8 * lg);
#pragma unroll
        for (int jb = 0; jb < 4; ++jb) {
            f32x4 a = f32x4{0, 0, 0, 0};
            if (jb <= w) {
#pragma unroll
                for (int ks = 0; ks < DK / 32; ++ks) {
                    const bf16x8 ak = ldg_frag(Kn + (size_t)(jb * 16 + l15) * LDQ + ks * 32 + 8 * lg);
                    a = mfma16(ak, bq[ks], a);
                }
            }
            const int i = w * 16 + l15, j0 = jb * 16 + 4 * lg;
            const float v0 = (j0 + 0 <= i) ? a[0] : 0.f, v1 = (j0 + 1 <= i) ? a[1] : 0.f, v2 = (j0 + 2 <= i) ? a[2] : 0.f, v3 = (j0 + 3 <= i) ? a[3] : 0.f;
            uint2 o; o.x = pack2(v0, v1); o.y = pack2(v2, v3);
            *reinterpret_cast<uint2*>(PL + i * PL_PITCH + j0) = o;
        }
    }
    __syncthreads();
    f32x4 acc[2][4];
#pragma unroll
    for (int x = 0; x < 2; ++x)
#pragma unroll
        for (int y = 0; y < 4; ++y) acc[x][y] = f32x4{0, 0, 0, 0};
#pragma unroll
    for (int ks = 0; ks < 2; ++ks) {
        bf16x8 av[2], bp[4];
#pragma unroll
        for (int x = 0; x < 2; ++x) av[x] = ldg_frag(VT + (size_t)((2 * w + x) * 16 + l15) * 64 + ks * 32 + 8 * lg);
#pragma unroll
        for (int y = 0; y < 4; ++y) bp[y] = *reinterpret_cast<const bf16x8*>(PL + (y * 16 + l15) * PL_PITCH + ks * 32 + 8 * lg);
#pragma unroll
        for (int x = 0; x < 2; ++x)
#pragma unroll
            for (int y = 0; y < 4; ++y) acc[x][y] = mfma16(av[x], bp[y], acc[x][y]);
    }
#pragma unroll
    for (int ks = 0; ks < DK / 32; ++ks) {
        bf16x8 as[2], bq[4];
#pragma unroll
        for (int x = 0; x < 2; ++x) as[x] = ldg_frag(ST + (size_t)((2 * w + x) * 16 + l15) * DK + ks * 32 + 8 * lg);
#pragma unroll
        for (int y = 0; y < 4; ++y) bq[y] = ldg_frag(Qn + (size_t)(y * 16 + l15) * LDQ + ks * 32 + 8 * lg);
#pragma unroll
        for (int x = 0; x < 2; ++x)
#pragma unroll
            for (int y = 0; y < 4; ++y) acc[x][y] = mfma16(as[x], bq[y], acc[x][y]);
    }
    float ssq[4];
#pragma unroll
    for (int y = 0; y < 4; ++y) {
        float s = 0.f;
#pragma unroll
        for (int x = 0; x < 2; ++x)
#pragma unroll
            for (int r = 0; r < 4; ++r) s += acc[x][y][r] * acc[x][y][r];
        s += __shfl_xor(s, 16); s += __shfl_xor(s, 32);
        ssq[y] = s;
    }
    if (lg == 0) {
#pragma unroll
        for (int y = 0; y < 4; ++y) RED[w * 64 + y * 16 + l15] = ssq[y];
    }
    __syncthreads();
#pragma unroll
    for (int y = 0; y < 4; ++y) {
        const int i = y * 16 + l15;
        const float tot = RED[i] + RED[64 + i] + RED[128 + i] + RED[192 + i];
        const float rstd = rsqrtf(tot * (1.f / 128.f) + 1e-6f);
#pragma unroll
        for (int x = 0; x < 2; ++x) {
            const int dv = (2 * w + x) * 16 + 4 * lg;
            const float4 g4 = *reinterpret_cast<const float4*>(ng + dv);
            const uint2 gt = *reinterpret_cast<const uint2*>(GATE + (size_t)i * 512 + dv);
            uint2 o;
            o.x = pack2(acc[x][y][0] * rstd * g4.x * bflo(gt.x), acc[x][y][1] * rstd * g4.y * bfhi(gt.x));
            o.y = pack2(acc[x][y][2] * rstd * g4.z * bflo(gt.y), acc[x][y][3] * rstd * g4.w * bfhi(gt.y));
            *reinterpret_cast<uint2*>(MIX + (size_t)i * 1024 + dv) = o;
        }
    }
    __syncthreads();
}
DEVI void phase5_unit(const Params& p, int u, char* smem) {
    if (u < 2048) out_unit<128>(p, u >> 7, u & 127, smem); else { u -= 2048; out_unit<64>(p, u >> 7, u & 127, smem); }
}

DEVI void rms_row_bf16_i8(const float* __restrict__ xr, const float* __restrict__ g, bf16_t* __restrict__ dst, unsigned char* __restrict__ dst8, float* __restrict__ descale, int lane) {
    float4 v[4]; float ss = 0.f;
#pragma unroll
    for (int i = 0; i < 4; ++i) { v[i] = reinterpret_cast<const float4*>(xr)[lane + 64 * i]; ss += v[i].x * v[i].x + v[i].y * v[i].y + v[i].z * v[i].z + v[i].w * v[i].w; }
    ss = wave_sum(ss);
    const float r = rsqrtf(ss * (1.f / 1024.f) + 1e-6f);
    float am = 0.f;
#pragma unroll
    for (int i = 0; i < 4; ++i) {
        const float4 gg = reinterpret_cast<const float4*>(g)[lane + 64 * i];
        v[i].x *= r * gg.x; v[i].y *= r * gg.y; v[i].z *= r * gg.z; v[i].w *= r * gg.w;
        uint2 o; o.x = pack2(v[i].x, v[i].y); o.y = pack2(v[i].z, v[i].w);
        reinterpret_cast<uint2*>(dst)[lane + 64 * i] = o;
        am = fmaxf(am, fmaxf(fmaxf(fabsf(v[i].x), fabsf(v[i].y)), fmaxf(fabsf(v[i].z), fabsf(v[i].w))));
    }
    am = wave_max(am);
    const float sc = am > 0.f ? 127.f / am : 1.f;
#pragma unroll
    for (int i = 0; i < 4; ++i) reinterpret_cast<int*>(dst8)[lane + 64 * i] = pack_i8x4(v[i].x * sc, v[i].y * sc, v[i].z * sc, v[i].w * sc);
    if (lane == 0) *descale = am > 0.f ? am * (1.f / 127.f) : 1.f;
}
constexpr int P7_UNITS = 8192;
DEVI void phase7_unit(const Params& p, int u, char* smem) {
    const int lane = LTID & 63, w = LTID >> 6;
    const int row = u * 4 + w;
    rms_row_bf16_i8(p.out + (size_t)row * DM, p.norm2_g, reinterpret_cast<bf16_t*>(p.ws + OFF_HN) + (size_t)row * DM,
                    p.ws + OFF_HN8 + (size_t)row * DM, reinterpret_cast<float*>(p.ws + OFF_HS) + row, lane);
}

using f32x16 = __attribute__((ext_vector_type(16))) float;
DEVI f32x16 mfma32(bf16x8 a, bf16x8 b, f32x16 c) { return __builtin_amdgcn_mfma_f32_32x32x16_bf16(a, b, c, 0, 0, 0); }
DEVI unsigned umax(unsigned a, unsigned b) { return a > b ? a : b; }
DEVI unsigned umin(unsigned a, unsigned b) { return a > b ? b : a; }
DEVI unsigned f2ord(float f) { const unsigned u = __float_as_uint(f); return u ^ ((unsigned)((int)u >> 31) | 0x80000000u); }
DEVI float ord2f(unsigned k) { return __uint_as_float((k & 0x80000000u) ? (k ^ 0x80000000u) : ~k); }

template <int BASE>
DEVI void sort16_desc(unsigned (&x)[64]) {
#pragma unroll
    for (int k = 2; k <= 16; k <<= 1) {
#pragma unroll
        for (int j = k >> 1; j > 0; j >>= 1) {
#pragma unroll
            for (int i = 0; i < 16; ++i) {
                const int l = i ^ j;
                if (l > i) {
                    const bool desc = ((i & k) == 0);
                    const unsigned a = x[BASE + i], b = x[BASE + l];
                    const unsigned hi = umax(a, b), lo = umin(a, b);
                    x[BASE + i] = desc ? hi : lo; x[BASE + l] = desc ? lo : hi;
                }
            }
        }
    }
}
template <int BASE>
DEVI void bmerge16_desc(unsigned (&x)[64]) {
#pragma unroll
    for (int j = 8; j > 0; j >>= 1) {
#pragma unroll
        for (int i = 0; i < 16; ++i) {
            const int l = i ^ j;
            if (l > i) { const unsigned a = x[BASE + i], b = x[BASE + l]; x[BASE + i] = umax(a, b); x[BASE + l] = umin(a, b); }
        }
    }
}
DEVI void top16_of_64(unsigned (&x)[64]) {
    sort16_desc<0>(x); sort16_desc<16>(x); sort16_desc<32>(x); sort16_desc<48>(x);
#pragma unroll
    for (int i = 0; i < 16; ++i) x[i] = umax(x[i], x[31 - i]);
    bmerge16_desc<0>(x);
#pragma unroll
    for (int i = 0; i < 16; ++i) x[32 + i] = umax(x[32 + i], x[63 - i]);
    bmerge16_desc<32>(x);
#pragma unroll
    for (int i = 0; i < 16; ++i) x[i] = umax(x[i], x[47 - i]);
    bmerge16_desc<0>(x);
}

DEVI void scores_top16(const bf16_t* __restrict__ SKp, const bf16_t* __restrict__ Qp, int lane, unsigned (&out)[16]) {
    const int r31 = lane & 31, hh = lane >> 5;
    f32x16 acc[4];
#pragma unroll
    for (int nb = 0; nb < 4; ++nb)
#pragma unroll
        for (int r = 0; r < 16; ++r) acc[nb][r] = 0.f;
#pragma unroll
    for (int ks = 0; ks < 8; ++ks) {
        const bf16x8 bq = ldg_frag(Qp + (size_t)r31 * 2048 + ks * 16 + 8 * hh);
#pragma unroll
        for (int nb = 0; nb < 4; ++nb) {
            const bf16x8 ak = ldg_frag(SKp + (size_t)(nb * 32 + r31) * 128 + ks * 16 + 8 * hh);
            acc[nb] = mfma32(ak, bq, acc[nb]);
        }
    }
    unsigned x[64];
    const unsigned hx = (unsigned)hh * 4u;
#pragma unroll
    for (int nb = 0; nb < 4; ++nb)
#pragma unroll
        for (int r = 0; r < 16; ++r) {
            const int nbase = nb * 32 + (r & 3) + 8 * (r >> 2);
            x[nb * 16 + r] = ((f2ord(acc[nb][r]) & ~127u) | (unsigned)(127 - nbase)) ^ hx;
        }
    top16_of_64(x);
    unsigned lo[16], hi[16];
#pragma unroll
    for (int i = 0; i < 16; ++i) { auto rr = __builtin_amdgcn_permlane32_swap(x[i], x[i], false, false); lo[i] = rr[0]; hi[i] = rr[1]; }
#pragma unroll
    for (int i = 0; i < 16; ++i) x[i] = umax(lo[i], hi[15 - i]);
    bmerge16_desc<0>(x);
#pragma unroll
    for (int i = 0; i < 16; ++i) out[i] = x[i];
}

constexpr int P9_UNITS = (M_TOK / 128) * 8;
DEVI void phase9_unit(const Params& p, int u, char* smem) {
    unsigned char* ws = p.ws;
    const int tid = LTID, lane = tid & 63, w = tid >> 6;
    const int tg = u >> 3, h = u & 7;
    const int t0 = tg * 128 + w * 32;
    const int hh = lane >> 5;
    unsigned* KL = reinterpret_cast<unsigned*>(smem) + w * 2048;
    const bf16_t* SK = reinterpret_cast<const bf16_t*>(ws + OFF_SK) + (size_t)(h * 2) * 128 * 128;
    const bf16_t* Q = reinterpret_cast<const bf16_t*>(ws + OFF_Q) + (size_t)t0 * 2048 + h * 256;
    unsigned k0[16], k1[16];
    scores_top16(SK, Q, lane, k0);
    scores_top16(SK + 128 * 128, Q + 128, lane, k1);
#pragma unroll
    for (int i = 0; i < 16; ++i) { KL[i * 64 + lane] = k0[i]; KL[(16 + i) * 64 + lane] = k1[i]; }
    float s0[16], s1[16];
#pragma unroll
    for (int i = 0; i < 16; ++i) { s0[i] = ord2f(k0[i] & ~127u); s1[i] = ord2f(k1[i] & ~127u); }
    unsigned x[64];
    {
        int n = 0;
#pragma unroll
        for (int a = 0; a < 16; ++a)
#pragma unroll
            for (int b = 0; b < 16; ++b)
                if ((a + 1) * (b + 1) <= 16) { x[n] = (f2ord(s0[a] + s1[b]) & ~255u) | (unsigned)(255 - (a * 16 + b)); ++n; }
#pragma unroll
        for (int i = 50; i < 64; ++i) x[i] = 0u;
    }
    top16_of_64(x);
    float cv[16]; int ex[16];
#pragma unroll
    for (int i = 0; i < 16; ++i) {
        cv[i] = ord2f(x[i] & ~255u);
        const int cid = 255 - (int)(x[i] & 255u);
        const unsigned ka = KL[(cid >> 4) * 64 + lane], kb = KL[(16 + (cid & 15)) * 64 + lane];
        ex[i] = (127 - (int)(ka & 127u)) * 128 + (127 - (int)(kb & 127u));
    }
    float sum = 0.f;
    const float mx = cv[0];
#pragma unroll
    for (int i = 0; i < 16; ++i) cv[i] = __expf(cv[i] - mx);
#pragma unroll
    for (int i = 0; i < 16; ++i) sum += cv[i];
    const float inv = 1.f / sum;
    const size_t orow = (size_t)(t0 + (lane & 31)) * 128 + h * 16;
    if (hh == 0) {
        int4* d = reinterpret_cast<int4*>(reinterpret_cast<int*>(ws + OFF_EIDX) + orow);
#pragma unroll
        for (int i = 0; i < 4; ++i) d[i] = make_int4(ex[4 * i], ex[4 * i + 1], ex[4 * i + 2], ex[4 * i + 3]);
        const float* US = reinterpret_cast<const float*>(ws + OFF_US);
        float4* du = reinterpret_cast<float4*>(reinterpret_cast<float*>(ws + OFF_EU) + orow);
#pragma unroll
        for (int i = 0; i < 4; ++i) du[i] = make_float4(US[ex[4 * i]], US[ex[4 * i + 1]], US[ex[4 * i + 2]], US[ex[4 * i + 3]]);
    } else {
        const float* VS = reinterpret_cast<const float*>(ws + OFF_VS);
        float4* d = reinterpret_cast<float4*>(reinterpret_cast<float*>(ws + OFF_EW) + orow);
#pragma unroll
        for (int i = 0; i < 4; ++i) d[i] = make_float4(cv[4 * i] * inv * VS[ex[4 * i]], cv[4 * i + 1] * inv * VS[ex[4 * i + 1]], cv[4 * i + 2] * inv * VS[ex[4 * i + 2]], cv[4 * i + 3] * inv * VS[ex[4 * i + 3]]);
    }
}

typedef _Float16 h2_t __attribute__((ext_vector_type(2)));
template <int CTRL> DEVI float dpp_f(float x) { return __builtin_bit_cast(float, __builtin_amdgcn_mov_dpp(__builtin_bit_cast(int, x), CTRL, 0xf, 0xf, true)); }
DEVI float sum8(float v) { v += dpp_f<0xB1>(v); v += dpp_f<0x4E>(v); v += dpp_f<0x141>(v); return v; }
DEVI float sum64(float v) {
    v = sum8(v); v += dpp_f<0x128>(v);
    { auto s = __builtin_amdgcn_permlane16_swap(__float_as_uint(v), __float_as_uint(v), false, false); v = __uint_as_float(s[0]) + __uint_as_float(s[1]); }
    { auto s = __builtin_amdgcn_permlane32_swap(__float_as_uint(v), __float_as_uint(v), false, false); v = __uint_as_float(s[0]) + __uint_as_float(s[1]); }
    return v;
}
DEVI long pack_i64(unsigned lo, unsigned hi) { return (long)(((unsigned long long)hi << 32) | (unsigned long long)lo); }

#define SB __builtin_amdgcn_sched_barrier(0)
#define SB __builtin_amdgcn_sched_barrier(0)
#define PIN4(Q) "+v"(Q.x), "+v"(Q.y), "+v"(Q.z), "+v"(Q.w)
DEVI void phase10a_block(const Params& p, char* smem) {
    unsigned char* ws = p.ws;
    const int s = blockIdx.x & 7, rank = blockIdx.x >> 3, nrank = ((int)gridDim.x - s + 7) >> 3;
    const int lane = threadIdx.x & 63, wave = threadIdx.x >> 6;
    const int lg = lane & 7, grp = lane >> 3;
    const unsigned char* U8 = ws + OFF_U8 + (size_t)s * (16384 * 128) + 16 * lg;
    const unsigned char* HNs = ws + OFF_HN8 + 128 * s + 16 * lg;
    float* PD = reinterpret_cast<float*>(ws + OFF_PD) + (size_t)s * M_TOK * 128;
    float* stg = reinterpret_cast<float*>(smem) + wave * (16 * 128);
    constexpr int NTG = M_TOK / 8;
#define P10A_LOAD_EV(TG, E) do { const int4* _q = reinterpret_cast<const int4*>(reinterpret_cast<const int*>(ws + OFF_EIDX) + (size_t)((TG) * 8 + wave) * 128 + 16 * grp); \
        E[0] = _q[0]; E[1] = _q[1]; E[2] = _q[2]; E[3] = _q[3]; } while (0)
#define P10A_LOAD_ROWS(TG, E, R, HA) do { \
        asm volatile("" : PIN4(E[0]), PIN4(E[1]), PIN4(E[2]), PIN4(E[3])); \
        const int _e[16] = {E[0].x, E[0].y, E[0].z, E[0].w, E[1].x, E[1].y, E[1].z, E[1].w, E[2].x, E[2].y, E[2].z, E[2].w, E[3].x, E[3].y, E[3].z, E[3].w}; \
        _Pragma("unroll") for (int _i = 0; _i < 16; ++_i) R[_i] = *reinterpret_cast<const uint4*>(U8 + (size_t)_e[_i] * 128); \
        HA = *reinterpret_cast<const uint4*>(HNs + (size_t)((TG) * 8 + wave) * DM); } while (0)
#define P10A_COMPUTE(SLOT, R, HA) do { \
        asm volatile("" : PIN4(R[0]), PIN4(R[1]), PIN4(R[2]), PIN4(R[3]), PIN4(R[4]), PIN4(R[5])); \
        asm volatile("" : PIN4(R[6]), PIN4(R[7]), PIN4(R[8]), PIN4(R[9]), PIN4(R[10]), PIN4(R[11])); \
        asm volatile("" : PIN4(R[12]), PIN4(R[13]), PIN4(R[14]), PIN4(R[15]), PIN4(HA)); \
        int _v1 = 0, _v2 = 0; \
        _Pragma("unroll") for (int _i = 0; _i < 16; ++_i) { \
            int _a = __builtin_amdgcn_sdot4((int)R[_i].x, (int)HA.x, 0, false); \
            _a = __builtin_amdgcn_sdot4((int)R[_i].y, (int)HA.y, _a, false); \
            _a = __builtin_amdgcn_sdot4((int)R[_i].z, (int)HA.z, _a, false); \
            _a = __builtin_amdgcn_sdot4((int)R[_i].w, (int)HA.w, _a, false); \
            _a += __builtin_amdgcn_mov_dpp(_a, 0xB1, 0xf, 0xf, true); _a += __builtin_amdgcn_mov_dpp(_a, 0x4E, 0xf, 0xf, true); _a += __builtin_amdgcn_mov_dpp(_a, 0x141, 0xf, 0xf, true); \
            if (_i < 8) _v1 = (lg == _i) ? _a : _v1; else _v2 = (lg == _i - 8) ? _a : _v2; } \
        stg[(SLOT) * 128 + 16 * grp + lg] = (float)_v1; stg[(SLOT) * 128 + 16 * grp + 8 + lg] = (float)_v2; } while (0)
    int4 eA[4], eB[4], eC[4]; uint4 rA[16], rB[16]; uint4 hA0, hB0;
    if (rank >= NTG) return;
    const int ntok = (NTG - rank + nrank - 1) / nrank;
#define TGI(I) (rank + ((I) < ntok ? (I) : ntok - 1) * nrank)
    P10A_LOAD_EV(TGI(0), eA);
    SB; P10A_LOAD_EV(TGI(1), eB);
    SB; P10A_LOAD_ROWS(TGI(0), eA, rA, hA0);
    SB;
    for (int base = 0; base < ntok; base += 16) {
#pragma unroll 1
        for (int i = base; i < base + 16; i += 2) {
            SB; P10A_LOAD_EV(TGI(i + 2), eC);
            SB; P10A_LOAD_ROWS(TGI(i + 1), eB, rB, hB0);
            SB; P10A_COMPUTE(i - base, rA, hA0);
            SB; P10A_LOAD_EV(TGI(i + 3), eB);
            SB; P10A_LOAD_ROWS(TGI(i + 2), eC, rA, hA0);
            SB; P10A_COMPUTE(i + 1 - base, rB, hB0);
            SB;
        }
#pragma unroll 4
        for (int j = 0; j < 16; ++j) {
            const float2 v = *reinterpret_cast<const float2*>(stg + j * 128 + 2 * lane);
            *reinterpret_cast<float2*>(PD + (size_t)(TGI(base + j) * 8 + wave) * 128 + 2 * lane) = v;
        }
        __builtin_amdgcn_s_waitcnt(0x0F70);
    }
#undef TGI
#undef P10A_LOAD_EV
#undef P10A_LOAD_ROWS
#undef P10A_COMPUTE
}

DEVI void phase10w_block(const Params& p) {
    unsigned char* ws = p.ws;
    const int lane = threadIdx.x & 63, wave = threadIdx.x >> 6;
    const float* PD = reinterpret_cast<const float*>(ws + OFF_PD);
    const float* HS = reinterpret_cast<const float*>(ws + OFF_HS);
    for (int t = blockIdx.x * 8 + wave; t < M_TOK; t += gridDim.x * 8) {
        float d0 = 0.f, d1 = 0.f;
#pragma unroll
        for (int sl = 0; sl < 8; ++sl) { d0 += PD[((size_t)sl * M_TOK + t) * 128 + lane]; d1 += PD[((size_t)sl * M_TOK + t) * 128 + 64 + lane]; }
        const float hs = HS[t];
        const float u0 = reinterpret_cast<const float*>(ws + OFF_EU)[(size_t)t * 128 + lane], u1 = reinterpret_cast<const float*>(ws + OFF_EU)[(size_t)t * 128 + 64 + lane];
        const float g0 = reinterpret_cast<const float*>(ws + OFF_EW)[(size_t)t * 128 + lane], g1 = reinterpret_cast<const float*>(ws + OFF_EW)[(size_t)t * 128 + 64 + lane];
        d0 *= u0 * hs; d1 *= u1 * hs;
        _Float16* W = reinterpret_cast<_Float16*>(ws + OFF_W16) + (size_t)t * 128;
        W[lane] = (_Float16)(g0 * 0.5f * d0 * (1.f + erff(d0 * 0.70710678118654752f)));
        W[64 + lane] = (_Float16)(g1 * 0.5f * d1 * (1.f + erff(d1 * 0.70710678118654752f)));
    }
}

template <bool DRY>
DEVI void phase10b_block(const Params& p, char* smem) {
    unsigned char* ws = p.ws;
    const int s = blockIdx.x & 7, rank = blockIdx.x >> 3, nrank = ((int)gridDim.x - s + 7) >> 3;
    const int lane = threadIdx.x & 63, wave = threadIdx.x >> 6;
    const int lg = lane & 7, grp = lane >> 3;
    const unsigned char* V8 = ws + OFF_V8 + (size_t)s * (16384 * 128) + 16 * lg;
    float* stg = reinterpret_cast<float*>(smem) + wave * (16 * 128);
    constexpr int NTG = M_TOK / 8;
#define P10B_LOAD_EV(TG, E) do { const int4* _q = reinterpret_cast<const int4*>(reinterpret_cast<const int*>(ws + OFF_EIDX) + (size_t)((TG) * 8 + wave) * 128 + 16 * grp); \
        E[0] = _q[0]; E[1] = _q[1]; E[2] = _q[2]; E[3] = _q[3]; } while (0)
#define P10B_LOAD_ROWS(TG, E, R, WA, WB) do { \
        asm volatile("" : PIN4(E[0]), PIN4(E[1]), PIN4(E[2]), PIN4(E[3])); \
        const int _e[16] = {E[0].x, E[0].y, E[0].z, E[0].w, E[1].x, E[1].y, E[1].z, E[1].w, E[2].x, E[2].y, E[2].z, E[2].w, E[3].x, E[3].y, E[3].z, E[3].w}; \
        _Pragma("unroll") for (int _i = 0; _i < 16; ++_i) R[_i] = *reinterpret_cast<const uint4*>(V8 + (size_t)_e[_i] * 128); \
        const uint4* _w = reinterpret_cast<const uint4*>(reinterpret_cast<const _Float16*>(ws + OFF_W16) + (size_t)((TG) * 8 + wave) * 128 + 16 * grp); WA = _w[0]; WB = _w[1]; } while (0)
#define P10B_COMPUTE(SLOT, R, WA, WB) do { \
          \
        asm volatile("" : PIN4(R[0]), PIN4(R[1]), PIN4(R[2]), PIN4(R[3]), PIN4(R[4]), PIN4(R[5])); \
        asm volatile("" : PIN4(R[6]), PIN4(R[7]), PIN4(R[8]), PIN4(R[9]), PIN4(R[10]), PIN4(R[11])); \
        asm volatile("" : PIN4(R[12]), PIN4(R[13]), PIN4(R[14]), PIN4(R[15]), PIN4(WA), PIN4(WB)); \
        const unsigned _ww[8] = {WA.x, WA.y, WA.z, WA.w, WB.x, WB.y, WB.z, WB.w}; \
        h2_t _acc[8]; unsigned _zb; asm volatile("v_mov_b32 %0, 0" : "=v"(_zb)); \
        _Pragma("unroll") for (int _j = 0; _j < 8; ++_j) _acc[_j] = __builtin_bit_cast(h2_t, _zb); \
        _Pragma("unroll") for (int _i = 0; _i < 16; ++_i) { \
            const unsigned _pw = _ww[_i >> 1]; \
            const h2_t _wp = __builtin_bit_cast(h2_t, (_i & 1) ? ((_pw >> 16) | (_pw & 0xffff0000u)) : ((_pw << 16) | (_pw & 0xffffu))); \
            const unsigned _wd[4] = {R[_i].x, R[_i].y, R[_i].z, R[_i].w}; \
            _Pragma("unroll") for (int _j = 0; _j < 4; ++_j) { \
                _acc[2 * _j] += _wp * __builtin_amdgcn_cvt_scalef32_pk_f16_fp8((int)_wd[_j], 1.0f, false); \
                _acc[2 * _j + 1] += _wp * __builtin_amdgcn_cvt_scalef32_pk_f16_fp8((int)_wd[_j], 1.0f, true); } } \
        float _o[16]; \
        _Pragma("unroll") for (int _j = 0; _j < 8; ++_j) { \
            h2_t _x = _acc[_j]; \
            _x += __builtin_bit_cast(h2_t, __builtin_amdgcn_mov_dpp(__builtin_bit_cast(int, _x), 0x128, 0xf, 0xf, true));     \
            { auto _s = __builtin_amdgcn_permlane16_swap(__builtin_bit_cast(unsigned, _x), __builtin_bit_cast(unsigned, _x), false, false); _x = __builtin_bit_cast(h2_t, (unsigned)_s[0]) + __builtin_bit_cast(h2_t, (unsigned)_s[1]); } \
            { auto _s = __builtin_amdgcn_permlane32_swap(__builtin_bit_cast(unsigned, _x), __builtin_bit_cast(unsigned, _x), false, false); _x = __builtin_bit_cast(h2_t, (unsigned)_s[0]) + __builtin_bit_cast(h2_t, (unsigned)_s[1]); } \
            _o[2 * _j] = (float)_x[0]; _o[2 * _j + 1] = (float)_x[1]; } \
        if (grp == 0) { float* _orow = stg + (SLOT) * 128 + 16 * lg; \
            _Pragma("unroll") for (int _i = 0; _i < 4; ++_i) *reinterpret_cast<float4*>(_orow + 4 * _i) = make_float4(_o[4 * _i], _o[4 * _i + 1], _o[4 * _i + 2], _o[4 * _i + 3]); } } while (0)
    int4 eA[4], eB[4], eC[4]; uint4 rA[16], rB[16]; uint4 wA0, wA1, wB0, wB1;
    if (rank >= NTG) return;
    const int ntok = (NTG - rank + nrank - 1) / nrank;
#define TGI(I) (rank + ((I) < ntok ? (I) : ntok - 1) * nrank)
    P10B_LOAD_EV(TGI(0), eA);
    SB; P10B_LOAD_EV(TGI(1), eB);
    SB; P10B_LOAD_ROWS(TGI(0), eA, rA, wA0, wA1);
    SB;
    for (int base = 0; base < ntok; base += 16) {
        float2 hrow[16];
#pragma unroll
        for (int j = 0; j < 16; ++j) hrow[j] = *reinterpret_cast<const float2*>(p.out + (size_t)(TGI(base + j) * 8 + wave) * DM + 128 * s + 2 * lane);
#pragma unroll 1
        for (int i = base; i < base + 16; i += 2) {
            SB; P10B_LOAD_EV(TGI(i + 2), eC);
            SB; P10B_LOAD_ROWS(TGI(i + 1), eB, rB, wB0, wB1);
            SB; P10B_COMPUTE(i - base, rA, wA0, wA1);
            SB; P10B_LOAD_EV(TGI(i + 3), eB);
            SB; P10B_LOAD_ROWS(TGI(i + 2), eC, rA, wA0, wA1);
            SB; P10B_COMPUTE(i + 1 - base, rB, wB0, wB1);
            SB;
        }
        float ssv = 0.f;
#pragma unroll
        for (int j = 0; j < 16; ++j) {
            if (base + j < ntok) {
                const size_t ro = (size_t)(TGI(base + j) * 8 + wave) * DM + 128 * s + 2 * lane;
                const float2 v = *reinterpret_cast<const float2*>(stg + j * 128 + 2 * lane);
                const float2 hv = hrow[j];
                const float2 r = make_float2(hv.x + v.x, hv.y + v.y);
                *reinterpret_cast<float2*>(p.out + ro) = DRY ? hv : r;
                const float sq = sum64(r.x * r.x + r.y * r.y);
                ssv = (lane == j) ? sq : ssv;
            }
        }
        if (lane < 16 && base + lane < ntok) reinterpret_cast<float*>(ws + OFF_SSQ)[(DRY ? (size_t)M_TOK * 8 : 0) + (size_t)(TGI(base + lane) * 8 + wave) * 8 + s] = ssv;
        __builtin_amdgcn_s_waitcnt(0x0F70);
    }
#undef TGI
#undef P10B_LOAD_EV
#undef P10B_LOAD_ROWS
#undef P10B_COMPUTE
}

DEVI void phase10c_block(const Params& p) {
    unsigned char* ws = p.ws;
    const int lane = threadIdx.x & 63, wave = threadIdx.x >> 6;
    for (int t = blockIdx.x * 8 + wave; t < M_TOK; t += gridDim.x * 8) {
        const float* sq = reinterpret_cast<const float*>(ws + OFF_SSQ) + (size_t)t * 8;
        const float4 a = *reinterpret_cast<const float4*>(sq), b = *reinterpret_cast<const float4*>(sq + 4);
        const float r = rsqrtf((a.x + a.y + a.z + a.w + b.x + b.y + b.z + b.w) * (1.f / 1024.f) + 1e-6f);
        float4* orow = reinterpret_cast<float4*>(p.out + (size_t)t * DM);
        const float4* gf = reinterpret_cast<const float4*>(p.norm_f_g);
#pragma unroll
        for (int i = 0; i < 4; ++i) {
            const float4 v = orow[lane + 64 * i], g = gf[lane + 64 * i];
            orow[lane + 64 * i] = make_float4(v.x * r * g.x, v.y * r * g.y, v.z * r * g.z, v.w * r * g.w);
        }
    }
}

#define XB_TMO      128
#define XB_XCNT(j)  (256  + 64 * (j))
#define XB_XSUB(j)  (1280 + 64 * (j))
#define XB_XGEN(j)  (2304 + 64 * (j))
#define XB_TOP      3328
#define XB_TOPGEN   3392
#define XCD_BAR_WORDS 3456
#define XB_SPIN_CAP (1u << 22)
#define LAS __attribute__((address_space(3)))
DEVI unsigned xb_ld(unsigned* p)              { return __hip_atomic_load(p, __ATOMIC_RELAXED, __HIP_MEMORY_SCOPE_AGENT); }
DEVI unsigned xb_add(unsigned* p, unsigned v) { return __hip_atomic_fetch_add(p, v, __ATOMIC_RELAXED, __HIP_MEMORY_SCOPE_AGENT); }
DEVI unsigned xb_xcc_id() { return (unsigned)__builtin_amdgcn_s_getreg((3 << 11) | 20) & 0xFu; }
#define XB_SPIN(cond, bar) do { unsigned _sp = 0; while (cond) { __builtin_amdgcn_s_sleep(1); \
    if ((++_sp & 255u) == 0u) { if (xb_ld(&(bar)[XB_TMO])) break; if (_sp > XB_SPIN_CAP) { atomicAdd(&(bar)[XB_TMO], 1u); break; } } } } while (0)
struct XcdBarrier { unsigned* bar; unsigned x; volatile LAS unsigned* st; };
DEVI XcdBarrier xcd_barrier_post(unsigned* bar, volatile LAS unsigned* st) {
    XcdBarrier b; b.bar = bar; b.x = xb_xcc_id(); b.st = st;
    if (threadIdx.x == 0) (void)xb_add(&bar[XB_XCNT(b.x)], 1u);
    return b;
}
DEVI void xcd_barrier_complete(unsigned* bar, unsigned x, unsigned& nloc, unsigned& nx) {
    const unsigned G = gridDim.x * gridDim.y * gridDim.z;
    unsigned sum, cnt, mine, sp = 0u;
    for (;;) {
        sum = 0u; cnt = 0u; mine = 0u;
#pragma unroll
        for (unsigned j = 0; j < 16; ++j) { const unsigned c = xb_ld(&bar[XB_XCNT(j)]); sum += c; cnt += (c > 0u) ? 1u : 0u; mine = (j == x) ? c : mine; }
        if (sum == G) break;
        __builtin_amdgcn_s_sleep(1);
        if ((++sp & 255u) == 0u) { if (xb_ld(&bar[XB_TMO])) break; if (sp > XB_SPIN_CAP) { atomicAdd(&bar[XB_TMO], 1u); break; } }
    }
    nloc = mine > 0u ? mine : 1u; nx = cnt > 0u ? cnt : 1u;
}
DEVI void xcd_barrier(const XcdBarrier& b) {
    asm volatile("s_waitcnt vmcnt(0)" ::: "memory");
    __syncthreads();
    if (threadIdx.x == 0) {
        unsigned* bar = b.bar;
        __builtin_amdgcn_s_waitcnt(0);
        unsigned nloc = b.st[0], nx = b.st[1];
        if (nloc == 0u) { xcd_barrier_complete(bar, b.x, nloc, nx); b.st[0] = nloc; b.st[1] = nx; }
        const unsigned old = xb_add(&bar[XB_XSUB(b.x)], 1u);
        const unsigned gen = old / nloc;
        if (old + 1u == (gen + 1u) * nloc) {
            __builtin_amdgcn_fence(__ATOMIC_RELEASE, "agent");
            asm volatile("s_waitcnt vmcnt(0)" ::: "memory");
            const unsigned og = xb_add(&bar[XB_TOP], 1u);
            const unsigned tg = og / nx;
            if (og + 1u == (tg + 1u) * nx) xb_add(&bar[XB_TOPGEN], 1u);
            else XB_SPIN(xb_ld(&bar[XB_TOPGEN]) == tg, bar);
            __builtin_amdgcn_fence(__ATOMIC_ACQUIRE, "agent");
            xb_add(&bar[XB_XGEN(b.x)], 1u);
            asm volatile("s_waitcnt vmcnt(0)" ::: "memory");
        } else {
            XB_SPIN(xb_ld(&bar[XB_XGEN(b.x)]) == gen, bar);
            __builtin_amdgcn_fence(__ATOMIC_ACQUIRE, "agent");
            asm volatile("s_waitcnt vmcnt(0)" ::: "memory");
        }
    }
    __syncthreads();
}

constexpr int N_PHASES = 11;
constexpr int LDS_PHASE_BYTES = 131072;
constexpr int LDS_BYTES = LDS_PHASE_BYTES + 16;

__global__ void __launch_bounds__(512, 2) hymba_fwd(Params p) {
    extern __shared__ __attribute__((aligned(16))) char smem[];
    cg::grid_group grid = cg::this_grid();
    const int lo = p.ph_lo, hi = p.ph_hi;
    volatile LAS unsigned* bst = (volatile LAS unsigned*)(smem + LDS_PHASE_BYTES);
    if (threadIdx.x == 0) { bst[0] = 0u; bst[1] = 0u; bst[2] = 0u; bst[3] = 0u; }
    __syncthreads();
    XcdBarrier xb = xcd_barrier_post(reinterpret_cast<unsigned*>(p.ws + OFF_BAR), bst);
    const int hb = (int)(threadIdx.x >> 8);
    char* hsm = smem + hb * 65536;
#define SEAM(K) if ((K) > lo) { if ((K) == lo + 1) grid.sync(); else xcd_barrier(xb); }
#define RUN_PHASE(K, FN, N) if (lo <= (K) && (K) < hi) { SEAM(K) for (int rep = 0; rep < 1 + ((PROBE_DUP >> (K)) & 1); ++rep) { if (rep) xcd_barrier(xb); \
        for (int ub = blockIdx.x * 2; ub < (N); ub += gridDim.x * 2) { const int u = ub + hb; if (u < (N)) FN(p, u, hsm); } } }
#define RUN_GEMM(K, CALL) if (lo <= (K) && (K) < hi) { SEAM(K) CALL; }
    RUN_PHASE(0, phase0_unit, P0_UNITS)
    RUN_GEMM(1, run_gemm(reinterpret_cast<const bf16_t*>(p.ws + OFF_XN), reinterpret_cast<const bf16_t*>(p.ws + OFF_WIN), P1_N, EpiInProj{p.ws}, smem))
#if PROBE_P2G
    if (lo <= 2 && 2 < hi) { xcd_barrier(xb); for (int ub = blockIdx.x * 2; ub < P2_UNITS; ub += gridDim.x * 2) { const int u = ub + hb; if (u < P2_UNITS) phase2_dry_unit(p, u, hsm); } }
#endif
    RUN_PHASE(2, phase2_unit, P2_UNITS)
#if PROBE_P2T
    if (lo <= 2 && 2 < hi) { xcd_barrier(xb); for (int ub = blockIdx.x * 2; ub < P2_UNITS; ub += gridDim.x * 2) { const int u = ub + hb; if (u < P2_UNITS && (u % 7) >= 3) phase2_unit(p, u, hsm); } }
#endif
    RUN_PHASE(3, phase3_unit, P3_UNITS)
#if PROBE_P4
    if (lo <= 4 && 4 < hi) { xcd_barrier(xb); for (int ub = blockIdx.x * 2; ub < P4_UNITS; ub += gridDim.x * 2) { const int u = ub + hb; if (u < P4_UNITS) phase4_dry_unit(p, u, hsm); } }
#endif
    RUN_PHASE(4, phase4_unit, P4_UNITS)
    RUN_PHASE(5, phase5_unit, P5_UNITS)
    RUN_GEMM(6, run_gemm(reinterpret_cast<const bf16_t*>(p.ws + OFF_MIX), reinterpret_cast<const bf16_t*>(p.ws + OFF_WOUT), 1024, EpiOutProj{p.x, p.out}, smem))
    RUN_PHASE(7, phase7_unit, P7_UNITS)
    RUN_GEMM(8, run_gemm(reinterpret_cast<const bf16_t*>(p.ws + OFF_HN), reinterpret_cast<const bf16_t*>(p.ws + OFF_WQ), 2048, EpiQ{reinterpret_cast<bf16_t*>(p.ws + OFF_Q)}, smem))
    RUN_PHASE(9, phase9_unit, P9_UNITS)
    if (lo <= 10 && 10 < hi) {
        SEAM(10)
#if PROBE_P10X == 4
        phase10a_block(p, smem); xcd_barrier(xb);
#endif
        phase10a_block(p, smem);
#if PROBE_P10X == 1
        xcd_barrier(xb); phase10a_block(p, smem);
#endif

        xcd_barrier(xb); phase10w_block(p);
#if PROBE_P10X == 2
        xcd_barrier(xb); phase10b_block<true>(p, smem);
#endif
        xcd_barrier(xb); phase10b_block<false>(p, smem);
        xcd_barrier(xb); phase10c_block(p);
#if PROBE_P10X == 3
        xcd_barrier(xb); phase10c_block(p);
#endif
    }
#undef RUN_PHASE
#undef RUN_GEMM
#undef SEAM
}

extern "C" void kernel_launch(void* const* d_in, const int* in_sizes, int n_in, void* d_out, int out_size, void* d_ws, size_t ws_size, hipStream_t stream) {
    static int grid_blocks = 0;
    if (grid_blocks == 0) {
        if (n_in != 15 || in_sizes[0] != M_TOK * DM || out_size != M_TOK * DM || ws_size < WS_NEED) {
            fprintf(stderr, "kernel_launch: unexpected shapes (n_in %d, in0 %d, out %d, ws %zu)\n", n_in, n_in > 0 ? in_sizes[0] : -1, out_size, ws_size);
            grid_blocks = -1; return;
        }
        int dev = 0, cus = 0, per_cu = 0;
        (void)hipGetDevice(&dev);
        (void)hipDeviceGetAttribute(&cus, hipDeviceAttributeMultiprocessorCount, dev);
        (void)hipFuncSetAttribute((const void*)hymba_fwd, hipFuncAttributeMaxDynamicSharedMemorySize, LDS_BYTES);
        (void)hipOccupancyMaxActiveBlocksPerMultiprocessor(&per_cu, (const void*)hymba_fwd, 512, LDS_BYTES);
        if (per_cu < 1) per_cu = 1;
        if (per_cu > 1) per_cu = 1;
        grid_blocks = cus * per_cu;
    }
    if (grid_blocks < 0) return;
    Params p{};
    p.x = (const float*)d_in[0]; p.norm1_g = (const float*)d_in[1]; p.w_in = (const float*)d_in[2]; p.hg_lower = (const float*)d_in[3];
    p.hg_norm_g = (const float*)d_in[4]; p.gla_wg = (const float*)d_in[5]; p.gla_bg = (const float*)d_in[6]; p.gla_norm_g = (const float*)d_in[7];
    p.w_out = (const float*)d_in[8]; p.norm2_g = (const float*)d_in[9]; p.w_q = (const float*)d_in[10]; p.sub_keys = (const float*)d_in[11];
    p.peer_u = (const float*)d_in[12]; p.peer_v = (const float*)d_in[13]; p.norm_f_g = (const float*)d_in[14];
    p.out = (float*)d_out; p.ws = (unsigned char*)d_ws;
#if N_LAUNCH_MODE == 1
    (void)hipMemsetAsync((unsigned char*)d_ws + OFF_BAR, 0, XCD_BAR_WORDS * 4, stream);
    p.ph_lo = 0; p.ph_hi = N_PHASES;
    void* args[] = {&p};
    hipError_t e = hipLaunchCooperativeKernel((const void*)hymba_fwd, dim3(grid_blocks), dim3(512), args, LDS_BYTES, stream);
    if (e != hipSuccess) fprintf(stderr, "cooperative launch failed: %s (grid %d)\n", hipGetErrorString(e), grid_blocks);
#else
    for (int ph = 0; ph < N_PHASES; ++ph) {
        p.ph_lo = ph; p.ph_hi = ph + 1;
        hipLaunchKernelGGL(hymba_fwd, dim3(grid_blocks), dim3(512), LDS_BYTES, stream, p);
    }
#endif
}
```

```cpp
#include <hip/hip_runtime.h>
#include <hip/hip_cooperative_groups.h>
#include <cstdio>
#include <cstdint>
namespace cg = cooperative_groups;

#ifndef N_LAUNCH_MODE
#define N_LAUNCH_MODE 1
#endif

#ifndef PROBE_DUP
#define PROBE_DUP 0
#endif
#ifndef PROBE_P10_DUP
#define PROBE_P10_DUP 0
#endif
#ifndef P10_SLICED
#define P10_SLICED 0
#endif
#ifndef PROBE_P10A
#define PROBE_P10A 0
#endif
#ifndef PROBE_P10_MASK
#define PROBE_P10_MASK 0x7fffffff
#endif
#ifndef PROBE_P10X
#define PROBE_P10X 0
#endif
#ifndef PROBE_P2T
#define PROBE_P2T 0
#endif
#ifndef PROBE_P4
#define PROBE_P4 0
#endif
#ifndef PROBE_P2G
#define PROBE_P2G 0
#endif
#ifndef PROBE_GEMM_DUP
#define PROBE_GEMM_DUP 0
#endif
#define DEVI __device__ __forceinline__
#define LTID ((int)(threadIdx.x & 255u))
typedef unsigned short bf16_t;
using bf16x8 = __attribute__((ext_vector_type(8))) short;
using f32x4 = __attribute__((ext_vector_type(4))) float;

constexpr int M_TOK = 32768;
constexpr int DM = 1024;
constexpr int IN_WP = 3840;
constexpr size_t MiB = 1024ull * 1024ull;

constexpr size_t OFF_XN   = 0;
constexpr size_t OFF_WIN  = 64 * MiB;
constexpr size_t OFF_WOUT = 72 * MiB;
constexpr size_t OFF_WQ   = 74 * MiB;
constexpr size_t OFF_SK   = 78 * MiB;
constexpr size_t OFF_LB   = 79 * MiB;
constexpr size_t OFF_U8   = 80 * MiB;
constexpr size_t OFF_V8   = 96 * MiB;
constexpr size_t OFF_US   = 112 * MiB;
constexpr size_t OFF_VS   = 113 * MiB;
constexpr size_t OFF_R2   = 144 * MiB;
constexpr size_t OFF_HQ   = OFF_R2;
constexpr size_t OFF_HLF  = OFF_R2 + 32 * MiB;
constexpr size_t OFF_HV   = OFF_R2 + 64 * MiB;
constexpr size_t OFF_HG   = OFF_R2 + 96 * MiB;
constexpr size_t OFF_GQ   = OFF_R2 + 128 * MiB;
constexpr size_t OFF_GK   = OFF_R2 + 144 * MiB;
constexpr size_t OFF_GV   = OFF_R2 + 160 * MiB;
constexpr size_t OFF_GG   = OFF_R2 + 192 * MiB;
constexpr size_t OFF_GLOW = OFF_R2 + 224 * MiB;
constexpr size_t OFF_KTH  = 370 * MiB;
constexpr size_t OFF_KTG  = 402 * MiB;
constexpr size_t OFF_DECH = 418 * MiB;
constexpr size_t OFF_DECG = 419 * MiB;
constexpr size_t OFF_HVT  = 420 * MiB;
constexpr size_t OFF_GVT  = 452 * MiB;
constexpr size_t OFF_BAR  = 484 * MiB;
constexpr size_t WS_NEED  = 485 * MiB;
constexpr size_t OFF_MIX  = OFF_XN;
constexpr size_t OFF_HN   = OFF_R2;
constexpr size_t OFF_Q    = OFF_R2 + 64 * MiB;
constexpr size_t OFF_EIDX = OFF_KTH;
constexpr size_t OFF_EW   = OFF_KTH + 16 * MiB;
constexpr size_t OFF_EU   = OFF_KTG;
constexpr size_t OFF_HN8  = OFF_XN;
constexpr size_t OFF_HS   = OFF_XN + 32 * MiB;
constexpr size_t OFF_W16  = OFF_XN + 48 * MiB;
constexpr size_t OFF_SSQ  = OFF_XN + 33 * MiB;
constexpr size_t OFF_PD   = OFF_Q;
constexpr size_t OUT_STH = 0;
constexpr size_t OUT_STG = 64 * MiB;

struct Params {
    const float* x; const float* norm1_g; const float* w_in; const float* hg_lower; const float* hg_norm_g;
    const float* gla_wg; const float* gla_bg; const float* gla_norm_g; const float* w_out; const float* norm2_g;
    const float* w_q; const float* sub_keys; const float* peer_u; const float* peer_v; const float* norm_f_g;
    float* out; unsigned char* ws;
    int ph_lo, ph_hi;
};

DEVI unsigned short f2bf(float f) {
    unsigned u = __float_as_uint(f);
    u += 0x7fffu + ((u >> 16) & 1u);
    return (unsigned short)(u >> 16);
}
DEVI float bf2f(unsigned short b) { return __uint_as_float(((unsigned)b) << 16); }
DEVI unsigned pack2(float a, float b) { return (unsigned)f2bf(a) | ((unsigned)f2bf(b) << 16); }
DEVI float bflo(unsigned u) { return __uint_as_float(u << 16); }
DEVI float bfhi(unsigned u) { return __uint_as_float(u & 0xffff0000u); }
DEVI float wave_sum(float v) {
#pragma unroll
    for (int o = 32; o > 0; o >>= 1) v += __shfl_xor(v, o);
    return v;
}
DEVI float wave_max(float v) {
#pragma unroll
    for (int o = 32; o > 0; o >>= 1) v = fmaxf(v, __shfl_xor(v, o));
    return v;
}
DEVI float silu_f(float x) { return x / (1.f + __expf(-x)); }
DEVI f32x4 mfma16(bf16x8 a, bf16x8 b, f32x4 c) { return __builtin_amdgcn_mfma_f32_16x16x32_bf16(a, b, c, 0, 0, 0); }
DEVI bf16x8 ldg_frag(const bf16_t* p) { return *reinterpret_cast<const bf16x8*>(p); }

DEVI void rms_row_bf16(const float* __restrict__ xr, const float* __restrict__ g, bf16_t* __restrict__ dst, int lane) {
    float4 v[4]; float ss = 0.f;
#pragma unroll
    for (int i = 0; i < 4; ++i) { v[i] = reinterpret_cast<const float4*>(xr)[lane + 64 * i]; ss += v[i].x * v[i].x + v[i].y * v[i].y + v[i].z * v[i].z + v[i].w * v[i].w; }
    ss = wave_sum(ss);
    const float r = rsqrtf(ss * (1.f / 1024.f) + 1e-6f);
#pragma unroll
    for (int i = 0; i < 4; ++i) {
        const float4 gg = reinterpret_cast<const float4*>(g)[lane + 64 * i];
        uint2 o; o.x = pack2(v[i].x * r * gg.x, v[i].y * r * gg.y); o.y = pack2(v[i].z * r * gg.z, v[i].w * r * gg.w);
        reinterpret_cast<uint2*>(dst)[lane + 64 * i] = o;
    }
}

DEVI void transpose_tile(const float* __restrict__ src, int Nsrc, bf16_t* __restrict__ dst, int nt, int kt, int mode, float* lds) {
    const int tid = LTID, tx = tid & 63, ty = tid >> 6;
    const int np = nt * 64 + tx;
    int col = np; bool valid = true;
    if (mode == 1) {
        if (np < 3072) col = np; else if (np < 3584) col = np + 16; else if (np < 3600) col = np - 512; else { valid = false; col = 0; }
    }
#pragma unroll 4
    for (int kk = ty; kk < 64; kk += 4) {
        lds[kk * 65 + tx] = valid ? src[(size_t)(kt * 64 + kk) * Nsrc + col] : 0.f;
    }
    __syncthreads();
    const int nl = tid >> 2, kq = tid & 3;
    unsigned pk[8];
#pragma unroll
    for (int i = 0; i < 8; ++i) pk[i] = pack2(lds[(kq * 16 + 2 * i) * 65 + nl], lds[(kq * 16 + 2 * i + 1) * 65 + nl]);
    uint4* d = reinterpret_cast<uint4*>(dst + (size_t)(nt * 64 + nl) * 1024 + kt * 64 + kq * 16);
    d[0] = make_uint4(pk[0], pk[1], pk[2], pk[3]);
    d[1] = make_uint4(pk[4], pk[5], pk[6], pk[7]);
    __syncthreads();
}

DEVI void convert8(const float* __restrict__ src, bf16_t* __restrict__ dst, size_t idx8) {
    const float4 a = reinterpret_cast<const float4*>(src)[idx8 * 2], b = reinterpret_cast<const float4*>(src)[idx8 * 2 + 1];
    reinterpret_cast<uint4*>(dst)[idx8] = make_uint4(pack2(a.x, a.y), pack2(a.z, a.w), pack2(b.x, b.y), pack2(b.z, b.w));
}

DEVI int pack_i8x4(float a, float b, float c, float d) {
    const int ia = (int)rintf(a), ib = (int)rintf(b), ic = (int)rintf(c), id = (int)rintf(d);
    return (ia & 255) | ((ib & 255) << 8) | ((ic & 255) << 16) | (id << 24);
}
DEVI void quant_row_i8(const float* __restrict__ xr, unsigned char* __restrict__ dst_table, int row, float* __restrict__ descale, int lane) {
    float4 v[4]; float am = 0.f;
#pragma unroll
    for (int i = 0; i < 4; ++i) { v[i] = reinterpret_cast<const float4*>(xr)[lane + 64 * i]; am = fmaxf(am, fmaxf(fmaxf(fabsf(v[i].x), fabsf(v[i].y)), fmaxf(fabsf(v[i].z), fabsf(v[i].w)))); }
    am = wave_max(am);
    const float sc = am > 0.f ? 127.f / am : 1.f;
#pragma unroll
    for (int i = 0; i < 4; ++i) {
        const int w = lane + 64 * i;
        reinterpret_cast<int*>(dst_table)[(size_t)(w >> 5) * (16384 * 32) + (size_t)row * 32 + (w & 31)] = pack_i8x4(v[i].x * sc, v[i].y * sc, v[i].z * sc, v[i].w * sc);
    }
    if (lane == 0) *descale = am > 0.f ? am * (1.f / 127.f) : 1.f;
}
DEVI void quant_row_fp8(const float* __restrict__ xr, unsigned char* __restrict__ dst_table, int row, float* __restrict__ descale, int lane) {
    float4 v[4]; float am = 0.f;
#pragma unroll
    for (int i = 0; i < 4; ++i) { v[i] = reinterpret_cast<const float4*>(xr)[lane + 64 * i]; am = fmaxf(am, fmaxf(fmaxf(fabsf(v[i].x), fabsf(v[i].y)), fmaxf(fabsf(v[i].z), fabsf(v[i].w)))); }
    am = wave_max(am);
    const float sc = am > 0.f ? 448.f / am : 1.f;
#pragma unroll
    for (int i = 0; i < 4; ++i) {
        const float a = fminf(fmaxf(v[i].x * sc, -448.f), 448.f), b = fminf(fmaxf(v[i].y * sc, -448.f), 448.f);
        const float c = fminf(fmaxf(v[i].z * sc, -448.f), 448.f), d = fminf(fmaxf(v[i].w * sc, -448.f), 448.f);
        int pk = __builtin_amdgcn_cvt_pk_fp8_f32(a, b, 0, false);
        pk = __builtin_amdgcn_cvt_pk_fp8_f32(c, d, pk, true);
        const int w = lane + 64 * i;
        reinterpret_cast<int*>(dst_table)[(size_t)(w >> 5) * (16384 * 32) + (size_t)row * 32 + (w & 31)] = pk;
    }
    if (lane == 0) *descale = am > 0.f ? am * (1.f / 448.f) : 1.f;
}

constexpr int P0_XN = 8192, P0_WIN = 60 * 16, P0_WOUT = 16 * 16, P0_WQ = 32 * 16, P0_UV = 8192, P0_SK = 128, P0_LB = 1;
constexpr int P0_UNITS = P0_XN + P0_WIN + P0_WOUT + P0_WQ + P0_UV + P0_SK + P0_LB;

DEVI void phase0_unit(const Params& p, int u, char* smem) {
    const int tid = LTID, lane = tid & 63, w = tid >> 6;
    unsigned char* ws = p.ws;
    if (u < P0_XN) {
        const int row = u * 4 + w;
        rms_row_bf16(p.x + (size_t)row * DM, p.norm1_g, reinterpret_cast<bf16_t*>(ws + OFF_XN) + (size_t)row * DM, lane);
        return;
    }
    u -= P0_XN;
    if (u < P0_WIN) { transpose_tile(p.w_in, 3600, reinterpret_cast<bf16_t*>(ws + OFF_WIN), u / 16, u % 16, 1, reinterpret_cast<float*>(smem)); return; }
    u -= P0_WIN;
    if (u < P0_WOUT) { transpose_tile(p.w_out, 1024, reinterpret_cast<bf16_t*>(ws + OFF_WOUT), u / 16, u % 16, 0, reinterpret_cast<float*>(smem)); return; }
    u -= P0_WOUT;
    if (u < P0_WQ) { transpose_tile(p.w_q, 2048, reinterpret_cast<bf16_t*>(ws + OFF_WQ), u / 16, u % 16, 0, reinterpret_cast<float*>(smem)); return; }
    u -= P0_WQ;
    if (u < P0_UV) {
        const bool isv = u >= 4096; const int row = (isv ? u - 4096 : u) * 4 + w;
        if (isv) quant_row_fp8(p.peer_v + (size_t)row * DM, ws + OFF_V8, row, reinterpret_cast<float*>(ws + OFF_VS) + row, lane);
        else quant_row_i8(p.peer_u + (size_t)row * DM, ws + OFF_U8, row, reinterpret_cast<float*>(ws + OFF_US) + row, lane);
        return;
    }
    u -= P0_UV;
    if (u < P0_SK) { convert8(p.sub_keys, reinterpret_cast<bf16_t*>(ws + OFF_SK), (size_t)u * 256 + tid); return; }
    float* lb = reinterpret_cast<float*>(ws + OFF_LB);
    for (int n = tid; n < 512; n += 256) {
        const float l0 = p.hg_lower[n], l1 = p.hg_lower[512 + n];
        const float mx = fmaxf(l0, l1); const float e0 = __expf(l0 - mx), e1 = __expf(l1 - mx);
        lb[n] = e0 / (e0 + e1);
    }
}

namespace pg8 {
#define PG8_LAS __attribute__((address_space(3)))
typedef unsigned short bf16_t;
typedef short bf16x8 __attribute__((ext_vector_type(8)));
typedef float f32x4 __attribute__((ext_vector_type(4)));
typedef unsigned u32x4 __attribute__((ext_vector_type(4)));
constexpr int BM = 256, BK = 64, HALF = 128, HTB = HALF * BK * 2  , STAGE_BYTES = 8 * HTB, NXCD = 8, WGM = 8;

__host__ __device__ __forceinline__ int lds_byte(int r, int c) { const int st = (r >> 4) * 2 + (c >> 5), rr = r & 15, cc = c & 31, ob = rr * 64 + cc * 2; return st * 1024 + (ob ^ (((ob >> 9) & 1) << 5)); }
__host__ __device__ __forceinline__ void stage_rc(int b, int& R, int& C) { const int st = b / 1024, sb = b % 1024, swz = sb ^ (((sb >> 9) & 1) << 5); R = (st >> 1) * 16 + swz / 64; C = (st & 1) * 32 + (swz % 64) / 2; }
__host__ __device__ __forceinline__ int perm32(int rho) { const int n = rho >> 4, i = rho & 15; return 8 * (i >> 2) + 4 * n + (i & 3); }

struct Unit { int pm, pn; };
struct Gemm { const bf16_t* A; const bf16_t* Bt; int M, N, K; };

struct StaticOrder {
    int nM, nN, nwg, G, c;
    __host__ __device__ void init(int M, int N, int G_, int c_) { nM = M / BM; nN = N / BM; nwg = nM * nN; G = G_; c = c_; }
    __host__ __device__ bool next(int i, Unit& u) const {
        const long L = (long)i * G + c; if (L >= nwg) return false;
        int wgid = (int)L; { const int q = nwg / NXCD, r = nwg % NXCD, xcd = wgid % NXCD, off = wgid / NXCD; wgid = (xcd < r ? xcd * (q + 1) : r * (q + 1) + (xcd - r) * q) + off; }
        const int nig = WGM * nN, gid = wgid / nig, fm = gid * WGM, gsz = (nM - fm) < WGM ? (nM - fm) : WGM;
        u.pm = fm + ((wgid % nig) % gsz); u.pn = (wgid % nig) / gsz; return true;
    }
    __device__ __forceinline__ void a_ready(const Unit&) const {}
    __device__ __forceinline__ void done(const Unit&) const {}
};
__device__ __forceinline__ unsigned cvt_pk_bf16(float lo, float hi) { unsigned r; asm volatile("v_cvt_pk_bf16_f32 %0, %1, %2" : "=v"(r) : "v"(lo), "v"(hi)); return r; }
typedef float f32x2 __attribute__((ext_vector_type(2)));
template <class Epi, class Sched, bool STAMP = false>
__device__ __forceinline__ void gemm_phase(PG8_LAS unsigned char* lds, const Gemm g, const Sched& S, const Epi& E, unsigned long long* stamps) {
    const int tid = threadIdx.x, wid = __builtin_amdgcn_readfirstlane(tid >> 6), lane = tid & 63, wr = wid >> 2, wc = wid & 3, fr = lane & 15, fq = lane >> 4;
    const int K = g.K, nt = K / BK;
    int ts_lo = 0, ts_hi = 0, nts = 0; const unsigned long long rt_entry = STAMP ? (unsigned long long)wall_clock64() : 0ull;
#define PG8_STAMP() do { if (STAMP && wid == 0 && nts < 64) { const unsigned long long _c = (unsigned long long)clock64(); \
        ts_lo = (lane == nts) ? (int)(unsigned)_c : ts_lo; ts_hi = (lane == nts) ? (int)(unsigned)(_c >> 32) : ts_hi; ++nts; } } while (0)
    PG8_STAMP();
    unsigned voffA[2], voffB[2];
#pragma unroll
    for (int i = 0; i < 2; ++i) { int R, C; stage_rc(tid * 16 + i * 8192, R, C); const int Rb = Epi::PERM ? ((R & ~31) + perm32(R & 31)) : R;
        voffA[i] = (unsigned)(R * K + C) * 2u; voffB[i] = (unsigned)(Rb * K + C) * 2u; }
    const size_t kstep = (size_t)(BK * 2);
    const size_t hstep = (size_t)HALF * K * 2;
    const size_t tstep = 2 * hstep;
    const unsigned ldsw = (unsigned)wid * 1024u;
    const int aoff = lds_byte(wr * 64 + fr, fq * 8), boff = lds_byte(wc * 32 + fr, fq * 8);
#define PG8_SA(b, h) (((b) * 2 + (h)) * HTB)
#define PG8_SB(b, h) ((4 + (b) * 2 + (h)) * HTB)
#define PG8_STAGE(bufoff, gbase, voff) do { _Pragma("unroll") for (int _i = 0; _i < 2; ++_i) \
        __builtin_amdgcn_global_load_lds((const unsigned*)((const char*)(gbase) + (voff)[_i]), (PG8_LAS unsigned*)(lds + (bufoff) + ldsw + _i * 8192), 16, 0, 0); } while (0)
#define PG8_LDA(dst, b, h) do { _Pragma("unroll") for (int m = 0; m < 4; ++m) _Pragma("unroll") for (int k = 0; k < 2; ++k) dst[m][k] = *(const PG8_LAS bf16x8*)(lds + PG8_SA(b, h) + aoff + m * 2048 + k * 1024); } while (0)
#define PG8_LDB(dst, b, h) do { _Pragma("unroll") for (int n = 0; n < 2; ++n) _Pragma("unroll") for (int k = 0; k < 2; ++k) dst[n][k] = *(const PG8_LAS bf16x8*)(lds + PG8_SB(b, h) + boff + n * 2048 + k * 1024); } while (0)
#define PG8_MMA(ai, bj, At, Bt) do { __builtin_amdgcn_s_setprio(1); _Pragma("unroll") for (int m = 0; m < 4; ++m) _Pragma("unroll") for (int n = 0; n < 2; ++n) _Pragma("unroll") for (int k = 0; k < 2; ++k) \
        acc[ai][bj][m][n] = __builtin_amdgcn_mfma_f32_16x16x32_bf16(Bt[n][k], At[m][k], acc[ai][bj][m][n], 0, 0, 0); __builtin_amdgcn_s_setprio(0); } while (0)
#define PG8_WAIT_V(n) asm volatile("s_waitcnt vmcnt(" #n ")" ::: "memory")
#define PG8_WAIT_L(n) asm volatile("s_waitcnt lgkmcnt(" #n ")" ::: "memory")
#define PG8_BAR __builtin_amdgcn_s_barrier()
#define PG8_SCHED __builtin_amdgcn_sched_barrier(0)
    Unit cur, nxt; int ui = 0;
    if (!S.next(0, cur)) return;
    f32x4 acc[2][2][4][2];
#pragma unroll
    for (int a = 0; a < 2; ++a)
#pragma unroll
        for (int b = 0; b < 2; ++b)
#pragma unroll
            for (int m = 0; m < 4; ++m)
#pragma unroll
                for (int n = 0; n < 2; ++n) acc[a][b][m][n] = (f32x4){0.f, 0.f, 0.f, 0.f};
    bf16x8 At[4][2], B0[2][2], B1[2][2];
    const char* cA = (const char*)g.A + (size_t)cur.pm * tstep; const char* cB = (const char*)g.Bt + (size_t)cur.pn * tstep;
    S.a_ready(cur);
    PG8_STAGE(PG8_SB(0, 0), cB, voffB); PG8_STAGE(PG8_SA(0, 0), cA, voffA); PG8_STAGE(PG8_SB(0, 1), cB + hstep, voffB); PG8_STAGE(PG8_SA(0, 1), cA + hstep, voffA);
    if (wr == 1) PG8_BAR;
    PG8_WAIT_V(4); PG8_BAR;
    PG8_STAGE(PG8_SB(1, 0), cB + kstep, voffB); PG8_STAGE(PG8_SA(1, 0), cA + kstep, voffA); PG8_STAGE(PG8_SB(1, 1), cB + hstep + kstep, voffB);
    PG8_WAIT_V(6); PG8_BAR;
    PG8_STAMP();
    for (;;) {
        const bool has_next = S.next(ui + 1, nxt);
        const char* nA = has_next ? (const char*)g.A + (size_t)nxt.pm * tstep : cA; const char* nB = has_next ? (const char*)g.Bt + (size_t)nxt.pn * tstep : cB;
        for (int t = 0; t < nt; t += 2) {
            const bool last = (t == nt - 2);
            const char* a1 = cA + (size_t)(t + 1) * kstep;
            const char* a2 = last ? nA : cA + (size_t)(t + 2) * kstep; const char* b2 = last ? nB : cB + (size_t)(t + 2) * kstep;
            const char* a3 = a2 + kstep; const char* b3 = b2 + kstep;
            if (last && has_next) S.a_ready(nxt);
            PG8_LDB(B0, 0, 0); PG8_SCHED; PG8_LDA(At, 0, 0); PG8_STAGE(PG8_SA(1, 1), a1 + hstep, voffA);
            PG8_WAIT_L(8); PG8_BAR; PG8_WAIT_L(0); PG8_MMA(0, 0, At, B0); PG8_BAR; PG8_SCHED;
            PG8_LDB(B1, 0, 1); PG8_STAGE(PG8_SB(0, 0), b2, voffB);
            PG8_BAR; PG8_WAIT_L(0); PG8_MMA(0, 1, At, B1); PG8_BAR;
            PG8_LDA(At, 0, 1); PG8_STAGE(PG8_SA(0, 0), a2, voffA);
            PG8_BAR; PG8_WAIT_L(0); PG8_MMA(1, 0, At, B0); PG8_BAR; PG8_SCHED;
            PG8_STAGE(PG8_SB(0, 1), b2 + hstep, voffB);
            PG8_WAIT_V(6); PG8_BAR; PG8_MMA(1, 1, At, B1); PG8_BAR;
            PG8_LDB(B0, 1, 0); PG8_SCHED; PG8_LDA(At, 1, 0); PG8_STAGE(PG8_SA(0, 1), a2 + hstep, voffA);
            PG8_WAIT_L(8); PG8_BAR; PG8_WAIT_L(0); PG8_MMA(0, 0, At, B0); PG8_BAR; PG8_SCHED;
            PG8_LDB(B1, 1, 1); PG8_STAGE(PG8_SB(1, 0), b3, voffB);
            PG8_BAR; PG8_WAIT_L(0); PG8_MMA(0, 1, At, B1); PG8_BAR;
            PG8_LDA(At, 1, 1); PG8_STAGE(PG8_SA(1, 0), a3, voffA);
            PG8_BAR; PG8_WAIT_L(0); PG8_MMA(1, 0, At, B0); PG8_BAR; PG8_SCHED;
            PG8_STAGE(PG8_SB(1, 1), b3 + hstep, voffB);
            PG8_WAIT_V(6); PG8_BAR; PG8_MMA(1, 1, At, B1); PG8_BAR;
        }
        PG8_STAMP();
        if constexpr (!Epi::AFTER_DRAIN) { E(acc, cur, wr, wc, fr, fq); S.done(cur); }
        PG8_STAMP();
        if (!has_next) break;
#pragma unroll
        for (int a = 0; a < 2; ++a)
#pragma unroll
            for (int b = 0; b < 2; ++b)
#pragma unroll
                for (int m = 0; m < 4; ++m)
#pragma unroll
                    for (int n = 0; n < 2; ++n) acc[a][b][m][n] = (f32x4){0.f, 0.f, 0.f, 0.f};
        cur = nxt; cA = nA; cB = nB; ++ui;
    }
    PG8_WAIT_V(0);
    if (wr == 0) PG8_BAR;
    PG8_BAR;
    if constexpr (Epi::AFTER_DRAIN) { E.fused(acc, cur, wr, wc, fr, fq, lds, wid, lane); S.done(cur); }
    PG8_STAMP();
    if (STAMP && wid == 0) { stamps[lane] = lane < nts ? (((unsigned long long)(unsigned)ts_hi << 32) | (unsigned)ts_lo) : 0ull;
        if (lane == 62) stamps[62] = rt_entry; if (lane == 63) stamps[63] = (unsigned long long)wall_clock64(); }
#undef PG8_STAMP
#undef PG8_SA
#undef PG8_SB
#undef PG8_STAGE
#undef PG8_LDA
#undef PG8_LDB
#undef PG8_MMA
#undef PG8_WAIT_V
#undef PG8_WAIT_L
#undef PG8_BAR
#undef PG8_SCHED
}
}

DEVI uint4 pack8(const pg8::f32x4 a, const pg8::f32x4 b) { return make_uint4(pack2(a[0], a[1]), pack2(a[2], a[3]), pack2(b[0], b[1]), pack2(b[2], b[3])); }

constexpr int P1_N = IN_WP;
struct EpiInProj {
    static constexpr bool PERM = true, AFTER_DRAIN = false;
    unsigned char* ws;
    __device__ __forceinline__ void operator()(const pg8::f32x4 (&acc)[2][2][4][2], const pg8::Unit& u, int wr, int wc, int fr, int fq) const {
        const int row0 = u.pm * 256 + wr * 64 + fr;
        const int pn = u.pn;
        const int cl0 = wc * 32 + 8 * fq;
        bf16_t* dst; int ld, cbase, kind;
        if (pn < 2)       { dst = reinterpret_cast<bf16_t*>(ws + OFF_HQ);  ld = 512; cbase = pn * 256;        kind = 1; }
        else if (pn < 4)  { dst = reinterpret_cast<bf16_t*>(ws + OFF_HLF); ld = 512; cbase = (pn - 2) * 256;  kind = 2; }
        else if (pn < 6)  { dst = reinterpret_cast<bf16_t*>(ws + OFF_HV);  ld = 512; cbase = (pn - 4) * 256;  kind = 0; }
        else if (pn < 8)  { dst = reinterpret_cast<bf16_t*>(ws + OFF_HG);  ld = 512; cbase = (pn - 6) * 256;  kind = 1; }
        else if (pn == 8) { dst = reinterpret_cast<bf16_t*>(ws + OFF_GQ);  ld = 256; cbase = 0;               kind = 3; }
        else if (pn == 9) { dst = reinterpret_cast<bf16_t*>(ws + OFF_GK);  ld = 256; cbase = 0;               kind = 0; }
        else if (pn < 12) { dst = reinterpret_cast<bf16_t*>(ws + OFF_GV);  ld = 512; cbase = (pn - 10) * 256; kind = 0; }
        else if (pn < 14) { dst = reinterpret_cast<bf16_t*>(ws + OFF_GG);  ld = 512; cbase = (pn - 12) * 256; kind = 1; }
        else {
            if (wc == 0 && fq < 2) {
                float* gl = reinterpret_cast<float*>(ws + OFF_GLOW);
#pragma unroll
                for (int ai = 0; ai < 2; ++ai)
#pragma unroll
                    for (int m = 0; m < 4; ++m) {
                        float* rp = gl + (size_t)(row0 + ai * 128 + m * 16) * 16 + 8 * fq;
                        *reinterpret_cast<pg8::f32x4*>(rp) = acc[ai][0][m][0];
                        *reinterpret_cast<pg8::f32x4*>(rp + 4) = acc[ai][0][m][1];
                    }
            }
            return;
        }
        float lbv[2][8];
#pragma unroll
        for (int bj = 0; bj < 2; ++bj)
#pragma unroll
            for (int j = 0; j < 8; ++j) lbv[bj][j] = 0.f;
        if (kind == 2) {
            const float* lb = reinterpret_cast<const float*>(ws + OFF_LB);
#pragma unroll
            for (int bj = 0; bj < 2; ++bj)
#pragma unroll
                for (int j = 0; j < 8; ++j) lbv[bj][j] = lb[cbase + bj * 128 + cl0 + j];
        }
#pragma unroll
        for (int ai = 0; ai < 2; ++ai)
#pragma unroll
            for (int m = 0; m < 4; ++m) {
                bf16_t* rowp = dst + (size_t)(row0 + ai * 128 + m * 16) * ld + cbase + cl0;
#pragma unroll
                for (int bj = 0; bj < 2; ++bj) {
                    pg8::f32x4 v0 = acc[ai][bj][m][0], v1 = acc[ai][bj][m][1];
                    if (kind == 1) {
#pragma unroll
                        for (int j = 0; j < 4; ++j) { v0[j] = silu_f(v0[j]); v1[j] = silu_f(v1[j]); }
                    } else if (kind == 2) {
#pragma unroll
                        for (int j = 0; j < 4; ++j) {
                            const float l0 = lbv[bj][j], l1 = lbv[bj][4 + j];
                            v0[j] = __logf(l0 + (1.f - l0) / (1.f + __expf(-v0[j])));
                            v1[j] = __logf(l1 + (1.f - l1) / (1.f + __expf(-v1[j])));
                        }
                    } else if (kind == 3) {
#pragma unroll
                        for (int j = 0; j < 4; ++j) { v0[j] *= 0.125f; v1[j] *= 0.125f; }
                    }
                    *reinterpret_cast<uint4*>(rowp + bj * 128) = pack8(v0, v1);
                }
            }
    }
};
struct EpiOutProj {
    static constexpr bool PERM = false, AFTER_DRAIN = false;
    const float* x; float* out;
    __device__ __forceinline__ void operator()(const pg8::f32x4 (&acc)[2][2][4][2], const pg8::Unit& u, int wr, int wc, int fr, int fq) const {
        const int row0 = u.pm * 256 + wr * 64 + fr, col0 = u.pn * 256 + wc * 32 + 4 * fq;
#pragma unroll
        for (int ai = 0; ai < 2; ++ai)
#pragma unroll
            for (int m = 0; m < 4; ++m) {
                const size_t ro = (size_t)(row0 + ai * 128 + m * 16) * DM + col0;
#pragma unroll
                for (int bj = 0; bj < 2; ++bj)
#pragma unroll
                    for (int n = 0; n < 2; ++n) {
                        const pg8::f32x4 xv = *reinterpret_cast<const pg8::f32x4*>(x + ro + bj * 128 + n * 16);
                        *reinterpret_cast<pg8::f32x4*>(out + ro + bj * 128 + n * 16) = xv + acc[ai][bj][m][n];
                    }
            }
    }
};
struct EpiQ {
    static constexpr bool PERM = true, AFTER_DRAIN = false;
    bf16_t* Q;
    __device__ __forceinline__ void operator()(const pg8::f32x4 (&acc)[2][2][4][2], const pg8::Unit& u, int wr, int wc, int fr, int fq) const {
        const int row0 = u.pm * 256 + wr * 64 + fr, col0 = u.pn * 256 + wc * 32 + 8 * fq;
#pragma unroll
        for (int ai = 0; ai < 2; ++ai)
#pragma unroll
            for (int m = 0; m < 4; ++m) {
                bf16_t* rowp = Q + (size_t)(row0 + ai * 128 + m * 16) * 2048 + col0;
#pragma unroll
                for (int bj = 0; bj < 2; ++bj) *reinterpret_cast<uint4*>(rowp + bj * 128) = pack8(acc[ai][bj][m][0], acc[ai][bj][m][1]);
            }
    }
};
template <class Epi>
DEVI void run_gemm(const bf16_t* A, const bf16_t* Bt, int N, const Epi& E, char* smem) {
    pg8::Gemm g{A, Bt, M_TOK, N, 1024};
#if PROBE_GEMM_DUP
    struct DupOrder : pg8::StaticOrder { __host__ __device__ bool next(int i, pg8::Unit& u) const { return pg8::StaticOrder::next(i >> 1, u); } };
    DupOrder S; S.init(M_TOK, N, (int)gridDim.x, (int)blockIdx.x);
    pg8::gemm_phase<Epi, DupOrder, false>((PG8_LAS unsigned char*)smem, g, S, E, nullptr);
#else
    pg8::StaticOrder S; S.init(M_TOK, N, (int)gridDim.x, (int)blockIdx.x);
    pg8::gemm_phase<Epi, pg8::StaticOrder, false>((PG8_LAS unsigned char*)smem, g, S, E, nullptr);
#endif
    __builtin_amdgcn_s_waitcnt(0);
}

constexpr int P2_UNITS = 512 * 3;
DEVI float logsigmoid_f(float z) { return fminf(z, 0.f) - __logf(1.f + __expf(-fabsf(z))); }

template <bool DRY>
DEVI void phase2_unit_t(const Params& p, int u, char* smem) {
    unsigned char* ws = p.ws;
    const int tid = LTID;
    const int cidx = u / 3, part = u % 3;
    const size_t row0 = (size_t)cidx * 64;
    if (part >= 3) {
        const bool isg = part >= 5; const int n = ((part - 3) & 1) * 256 + tid;
        const bf16_t* V = reinterpret_cast<const bf16_t*>(ws + (isg ? OFF_GV : OFF_HV));
        bf16_t* VT = reinterpret_cast<bf16_t*>(ws + (isg ? OFF_GVT : OFF_HVT));
#pragma unroll 1
        for (int hf = 0; hf < 4; ++hf) {
            unsigned short vb[16];
#pragma unroll
            for (int r = 0; r < 16; ++r) vb[r] = V[(row0 + hf * 16 + r) * 512 + n];
#pragma unroll
            for (int r8 = 0; r8 < 2; ++r8) {
                unsigned pk[4];
#pragma unroll
                for (int rr = 0; rr < 8; ++rr) {
                    const unsigned short b = vb[r8 * 8 + rr];
                    if (rr & 1) pk[rr >> 1] |= ((unsigned)b << 16); else pk[rr >> 1] = b;
                }
                *reinterpret_cast<uint4*>(VT + ((size_t)cidx * 512 + n) * 64 + hf * 16 + r8 * 8) = make_uint4(pk[0], pk[1], pk[2], pk[3]);
            }
        }
        return;
    }
    if (part < 2) {
        const int n = part * 256 + tid;
        bf16_t* HQ = reinterpret_cast<bf16_t*>(ws + OFF_HQ);
        bf16_t* HLF = reinterpret_cast<bf16_t*>(ws + OFF_HLF);
        float Gl = 0.f;
#pragma unroll 16
        for (int r = 0; r < 64; ++r) Gl += bf2f(HLF[(row0 + r) * 512 + n]);
        float G = 0.f;
#pragma unroll 1
        for (int hf = 0; hf < 4; ++hf) {
            unsigned short lfb[16], qb[16];
#pragma unroll
            for (int r = 0; r < 16; ++r) { lfb[r] = HLF[(row0 + hf * 16 + r) * 512 + n]; qb[r] = HQ[(row0 + hf * 16 + r) * 512 + n]; }
#pragma unroll
            for (int r8 = 0; r8 < 2; ++r8) {
                unsigned pk[4];
#pragma unroll
                for (int rr = 0; rr < 8; ++rr) {
                    const int r = r8 * 8 + rr;
                    const size_t idx = (row0 + hf * 16 + r) * 512 + n;
                    const float lf = bf2f(lfb[r]);
                    G += lf;
                    const float key = 1.f - __expf(lf);
                    const unsigned short bq = f2bf(bf2f(qb[r]) * __expf(G));
                    const unsigned short bk = f2bf(key * __expf(-G));
                    if (DRY) { reinterpret_cast<bf16_t*>(ws + OFF_XN)[idx] = bq; reinterpret_cast<bf16_t*>(ws + OFF_XN + 32 * MiB)[idx] = bk; } else { HQ[idx] = bq; HLF[idx] = bk; }
                    if (rr & 1) pk[rr >> 1] |= ((unsigned)bk << 16); else pk[rr >> 1] = bk;
                }
            }
        }
        reinterpret_cast<float*>(DRY ? reinterpret_cast<unsigned char*>(p.out) + 64 * MiB : ws + OFF_DECH)[(size_t)cidx * 512 + n] = __expf(Gl);
    } else {
        const int n = tid;
        bf16_t* GQ = reinterpret_cast<bf16_t*>(ws + OFF_GQ);
        bf16_t* GK = reinterpret_cast<bf16_t*>(ws + OFF_GK);
        const float* GL = reinterpret_cast<const float*>(ws + OFF_GLOW);
        float wg[16];
#pragma unroll
        for (int j = 0; j < 16; ++j) wg[j] = p.gla_wg[j * 256 + n];
        const float bg = p.gla_bg[n];
        float Gl = 0.f, G = 0.f;
#pragma unroll 1
        for (int hf = 0; hf < 4; ++hf) {
            unsigned short qb[16], kb[16]; float lgv[16];
#pragma unroll
            for (int r = 0; r < 16; ++r) { qb[r] = GQ[(row0 + hf * 16 + r) * 256 + n]; kb[r] = GK[(row0 + hf * 16 + r) * 256 + n]; }
#pragma unroll
            for (int r = 0; r < 16; ++r) {
                const float4* g4 = reinterpret_cast<const float4*>(GL + (row0 + hf * 16 + r) * 16);
                float z = bg;
#pragma unroll
                for (int j = 0; j < 4; ++j) { const float4 t = g4[j]; z += t.x * wg[4 * j] + t.y * wg[4 * j + 1] + t.z * wg[4 * j + 2] + t.w * wg[4 * j + 3]; }
                lgv[r] = logsigmoid_f(z) * (1.f / 16.f);
            }
#pragma unroll
            for (int r8 = 0; r8 < 2; ++r8) {
                unsigned pk[4];
#pragma unroll
                for (int rr = 0; rr < 8; ++rr) {
                    const int r = r8 * 8 + rr;
                    G += lgv[r];
                    const size_t idx = (row0 + hf * 16 + r) * 256 + n;
                    const unsigned short bq = f2bf(bf2f(qb[r]) * __expf(G));
                    const unsigned short bk = f2bf(bf2f(kb[r]) * __expf(-G));
                    GQ[idx] = bq; GK[idx] = bk;
                    if (rr & 1) pk[rr >> 1] |= ((unsigned)bk << 16); else pk[rr >> 1] = bk;
                }
            }
        }
        Gl = G;
        reinterpret_cast<float*>(ws + OFF_DECG)[(size_t)cidx * 256 + n] = __expf(Gl);
    }
}

DEVI void phase2_unit(const Params& p, int u, char* smem) { phase2_unit_t<false>(p, u, smem); }
DEVI void phase2_dry_unit(const Params& p, int u, char* smem) { if ((u % 7) < 2) phase2_unit_t<true>(p, u, smem); }

DEVI unsigned off_b(unsigned row, unsigned ch) { return 256u * row + 16u * (ch ^ (((row & 3u) << 2) | ((row >> 2) & 3u))); }
DEVI unsigned tr_addr16(unsigned lane, unsigned c, unsigned ks, unsigned t) {
    const unsigned g = lane >> 4, q = (lane & 15u) >> 2, pp = lane & 3u;
    return off_b(32u * ks + 8u * g + 4u * t + q, 2u * c + (pp >> 1)) + 8u * (pp & 1u);
}
typedef unsigned short u16x4_t __attribute__((ext_vector_type(4)));
DEVI bf16x8 tr_frag(unsigned base, unsigned lane, unsigned c, unsigned ks) {
    u16x4_t a, b;
    asm volatile("ds_read_b64_tr_b16 %0, %2\n\tds_read_b64_tr_b16 %1, %3\n\ts_waitcnt lgkmcnt(0)" : "=&v"(a), "=&v"(b) : "v"(base + tr_addr16(lane, c, ks, 0)), "v"(base + tr_addr16(lane, c, ks, 1)) : "memory");
    bf16x8 r;
    r[0] = (short)a[0]; r[1] = (short)a[1]; r[2] = (short)a[2]; r[3] = (short)a[3]; r[4] = (short)b[0]; r[5] = (short)b[1]; r[6] = (short)b[2]; r[7] = (short)b[3];
    return r;
}
DEVI void fill_tile64(char* tile, const bf16_t* __restrict__ g, int ldg) {
#pragma unroll
    for (int i = 0; i < 4; ++i) {
        const int n = LTID + 256 * i, row = n >> 4, ch = n & 15;
        *reinterpret_cast<uint4*>(tile + off_b(row, ch)) = *reinterpret_cast<const uint4*>(g + (size_t)row * ldg + ch * 8);
    }
}
DEVI void fill_tile64x64(char* tile, const bf16_t* __restrict__ g, int ldg) {
#pragma unroll
    for (int i = 0; i < 2; ++i) {
        const int n = LTID + 256 * i, row = n >> 3, ch = n & 7;
        *reinterpret_cast<uint4*>(tile + off_b(row, ch)) = *reinterpret_cast<const uint4*>(g + (size_t)row * ldg + ch * 8);
    }
}

constexpr int P3_UNITS = 4096;
template <int DK>
DEVI void kv_unit(const Params& p, int sidx, int c, char* smem) {
    unsigned char* ws = p.ws;
    const int lane = LTID & 63, w = LTID >> 6;
    const int b = sidx >> 2, h = sidx & 3;
    const int cidx = b * 128 + c;
    constexpr int NDB = DK / 16;
    const bf16_t* Kn = reinterpret_cast<const bf16_t*>(ws + (DK == 128 ? OFF_HLF : OFF_GK)) + (size_t)cidx * 64 * (4 * DK) + h * DK;
    const bf16_t* V = reinterpret_cast<const bf16_t*>(ws + (DK == 128 ? OFF_HV : OFF_GV)) + (size_t)cidx * 64 * 512 + h * 128;
    const float* DEC = reinterpret_cast<const float*>(ws + (DK == 128 ? OFF_DECH : OFF_DECG)) + (size_t)cidx * (4 * DK) + h * DK;
    bf16_t* ST = reinterpret_cast<bf16_t*>(reinterpret_cast<unsigned char*>(p.out) + (DK == 128 ? OUT_STH : OUT_STG)) + ((size_t)sidx * 128 + c) * (128 * DK);
    f32x4 acc[NDB][2];
#pragma unroll
    for (int i = 0; i < NDB; ++i) { acc[i][0] = f32x4{0, 0, 0, 0}; acc[i][1] = f32x4{0, 0, 0, 0}; }
    const int fo = (lane & 15) * 64 + 8 * (lane >> 4);
    fill_tile64(smem, V, 512);
    if (DK == 128) fill_tile64(smem + 16384, Kn, 512); else fill_tile64x64(smem + 16384, Kn, 256);
    __syncthreads();
    const unsigned tbase = (unsigned)(size_t)smem, kbase = tbase + 16384u;
#pragma unroll
    for (int ks = 0; ks < 2; ++ks) {
        bf16x8 bv[2];
#pragma unroll
        for (int nb = 0; nb < 2; ++nb) bv[nb] = tr_frag(tbase, (unsigned)lane, (unsigned)(2 * w + nb), (unsigned)ks);
#pragma unroll
        for (int db = 0; db < NDB; ++db) {
            const bf16x8 ak = tr_frag(kbase, (unsigned)lane, (unsigned)db, (unsigned)ks);
            acc[db][0] = mfma16(ak, bv[0], acc[db][0]);
            acc[db][1] = mfma16(ak, bv[1], acc[db][1]);
        }
    }
#pragma unroll
    for (int db = 0; db < NDB; ++db) {
        const int d = db * 16 + 4 * (lane >> 4);
        const float4 dc = *reinterpret_cast<const float4*>(DEC + d);
#pragma unroll
        for (int nb = 0; nb < 2; ++nb) {
            const int dv = 32 * w + nb * 16 + (lane & 15);
            uint2 o; o.x = pack2(acc[db][nb][0] * dc.x, acc[db][nb][1] * dc.y); o.y = pack2(acc[db][nb][2] * dc.z, acc[db][nb][3] * dc.w);
            *reinterpret_cast<uint2*>(ST + (size_t)dv * DK + d) = o;
        }
    }
    __syncthreads();
}
DEVI void phase3_unit(const Params& p, int u, char* smem) {
    if (u < 2048) kv_unit<128>(p, u >> 7, u & 127, smem); else { u -= 2048; kv_unit<64>(p, u >> 7, u & 127, smem); }
}

constexpr int P4_UNITS = 384;
template <bool DRY>
DEVI void phase4_unit_t(const Params& p, int u, char* smem) {
    unsigned char* ws = p.ws;
    int e = u * 256 + LTID;
    bf16_t* base; bf16_t* sbase; const float* dec; size_t cstride; int decstride;
    if (e < 65536) {
        const int sidx = e >> 12, rem = e & 4095, dv = rem >> 5, d4 = (rem & 31) * 4;
        const int b = sidx >> 2, h = sidx & 3;
        base = reinterpret_cast<bf16_t*>(reinterpret_cast<unsigned char*>(p.out) + OUT_STH) + ((size_t)sidx * 128) * 16384 + dv * 128 + d4;
        sbase = DRY ? reinterpret_cast<bf16_t*>(ws + OFF_XN) + ((size_t)sidx * 128) * 16384 + dv * 128 + d4 : base;
        cstride = 16384;
        dec = reinterpret_cast<const float*>(ws + OFF_DECH) + (size_t)(b * 128) * 512 + h * 128 + d4; decstride = 512;
    } else {
        e -= 65536;
        const int sidx = e >> 11, rem = e & 2047, dv = rem >> 4, d4 = (rem & 15) * 4;
        const int b = sidx >> 2, h = sidx & 3;
        base = reinterpret_cast<bf16_t*>(reinterpret_cast<unsigned char*>(p.out) + OUT_STG) + ((size_t)sidx * 128) * 8192 + dv * 64 + d4;
        sbase = DRY ? reinterpret_cast<bf16_t*>(ws + OFF_KTH) + ((size_t)sidx * 128) * 8192 + dv * 64 + d4 : base;
        cstride = 8192;
        dec = reinterpret_cast<const float*>(ws + OFF_DECG) + (size_t)(b * 128) * 256 + h * 64 + d4; decstride = 256;
    }
    float s0 = 0.f, s1 = 0.f, s2 = 0.f, s3 = 0.f;
    for (int c8 = 0; c8 < 128; c8 += 8) {
        uint2 kv[8]; float4 dc[8];
#pragma unroll
        for (int i = 0; i < 8; ++i) { kv[i] = *reinterpret_cast<const uint2*>(base + (size_t)(c8 + i) * cstride); dc[i] = *reinterpret_cast<const float4*>(dec + (size_t)(c8 + i) * decstride); }
#pragma unroll
        for (int i = 0; i < 8; ++i) {
            uint2 o; o.x = pack2(s0, s1); o.y = pack2(s2, s3);
            *reinterpret_cast<uint2*>(sbase + (size_t)(c8 + i) * cstride) = o;
            s0 = dc[i].x * s0 + bflo(kv[i].x); s1 = dc[i].y * s1 + bfhi(kv[i].x);
            s2 = dc[i].z * s2 + bflo(kv[i].y); s3 = dc[i].w * s3 + bfhi(kv[i].y);
        }
    }
}

DEVI void phase4_unit(const Params& p, int u, char* smem) { phase4_unit_t<false>(p, u, smem); }
DEVI void phase4_dry_unit(const Params& p, int u, char* smem) { phase4_unit_t<true>(p, u, smem); }

constexpr int P5_UNITS = 4096;
constexpr int PL_PITCH = 72;
template <int DK>
DEVI void out_unit(const Params& p, int sidx, int c, char* smem) {
    unsigned char* ws = p.ws;
    const int lane = LTID & 63, w = LTID >> 6;
    const int b = sidx >> 2, h = sidx & 3;
    const int cidx = b * 128 + c;
    const size_t row0 = (size_t)cidx * 64;
    constexpr int LDQ = 4 * DK;
    const bf16_t* Qn = reinterpret_cast<const bf16_t*>(ws + (DK == 128 ? OFF_HQ : OFF_GQ)) + row0 * LDQ + h * DK;
    const bf16_t* Kn = reinterpret_cast<const bf16_t*>(ws + (DK == 128 ? OFF_HLF : OFF_GK)) + row0 * LDQ + h * DK;
    const bf16_t* V = reinterpret_cast<const bf16_t*>(ws + (DK == 128 ? OFF_HV : OFF_GV)) + row0 * 512 + h * 128;
    const bf16_t* ST = reinterpret_cast<const bf16_t*>(reinterpret_cast<const unsigned char*>(p.out) + (DK == 128 ? OUT_STH : OUT_STG)) + ((size_t)sidx * 128 + c) * (128 * DK);
    const bf16_t* GATE = reinterpret_cast<const bf16_t*>(ws + (DK == 128 ? OFF_HG : OFF_GG)) + row0 * 512 + h * 128;
    const float* ng = (DK == 128) ? p.hg_norm_g : p.gla_norm_g;
    bf16_t* MIX = reinterpret_cast<bf16_t*>(ws + OFF_MIX) + row0 * 1024 + (DK == 128 ? 0 : 512) + h * 128;
    bf16_t* PL = reinterpret_cast<bf16_t*>(smem);
    float* RED = reinterpret_cast<float*>(smem + 64 * PL_PITCH * 2);

    const int l15 = lane & 15, lg = lane >> 4;
    bf16x8 ast[DK / 32][2], bqa[DK / 32][4];
    uint2 gtv[4][2]; float4 g4v[2];
    char* vtile = smem + 16384;
    fill_tile64(vtile, V, 512);
#pragma unroll
    for (int ks = 0; ks < DK / 32; ++ks) {
#pragma unroll
        for (int x = 0; x < 2; ++x) ast[ks][x] = ldg_frag(ST + (size_t)((2 * w + x) * 16 + l15) * DK + ks * 32 + 8 * lg);
#pragma unroll
        for (int y = 0; y < 4; ++y) bqa[ks][y] = ldg_frag(Qn + (size_t)(y * 16 + l15) * LDQ + ks * 32 + 8 * lg);
    }
#pragma unroll
    for (int x = 0; x < 2; ++x) {
        g4v[x] = *reinterpret_cast<const float4*>(ng + (2 * w + x) * 16 + 4 * lg);
#pragma unroll
        for (int y = 0; y < 4; ++y) gtv[y][x] = *reinterpret_cast<const uint2*>(GATE + (size_t)(y * 16 + l15) * 512 + (2 * w + x) * 16 + 4 * lg);
    }
    {
        bf16x8 bq[DK / 32];
#pragma unroll
        for (int ks = 0; ks < DK / 32; ++ks) bq[ks] = ldg_frag(Qn + (size_t)(w * 16 + l15) * LDQ + ks * 32 + 8 * lg);
#pragma unroll
        for (int jb = 0; jb < 4; ++jb) {
            f32x4 a = f32x4{0, 0, 0, 0};
            if (jb <= w) {
#pragma unroll
                for (int ks = 0; ks < DK / 32; ++ks) {
                    const bf16x8 ak = ldg_frag(Kn + (size_t)(jb * 16 + l15) * LDQ + ks * 32 + 8 * lg);
                    a = mfma16(ak, bq[ks], a);
                }
            }
            const int i = w * 16 + l15, j0 = jb * 16 + 4 * lg;
            const float v0 = (j0 + 0 <= i) ? a[0] : 0.f, v1 = (j0 + 1 <= i) ? a[1] : 0.f, v2 = (j0 + 2 <= i) ? a[2] : 0.f, v3 = (j0 + 3 <= i) ? a[3] : 0.f;
            uint2 o; o.x = pack2(v0, v1); o.y = pack2(v2, v3);
            *reinterpret_cast<uint2*>(PL + i * PL_PITCH + j0) = o;
        }
    }
    __syncthreads();
    f32x4 acc[2][4];
#pragma unroll
    for (int x = 0; x < 2; ++x)
#pragma unroll
        for (int y = 0; y < 4; ++y) acc[x][y] = f32x4{0, 0, 0, 0};
#pragma unroll
    for (int ks = 0; ks < 2; ++ks) {
        bf16x8 bp[4], avx[2];
#pragma unroll
        for (int x = 0; x < 2; ++x) avx[x] = tr_frag((unsigned)(size_t)vtile, (unsigned)lane, (unsigned)(2 * w + x), (unsigned)ks);
#pragma unroll
        for (int y = 0; y < 4; ++y) bp[y] = *reinterpret_cast<const bf16x8*>(PL + (y * 16 + l15) * PL_PITCH + ks * 32 + 8 * lg);
#pragma unroll
        for (int x = 0; x < 2; ++x)
#pragma unroll
            for (int y = 0; y < 4; ++y) acc[x][y] = mfma16(avx[x], bp[y], acc[x][y]);
    }
#pragma unroll
    for (int ks = 0; ks < DK / 32; ++ks) {
#pragma unroll
        for (int x = 0; x < 2; ++x)
#pragma unroll
            for (int y = 0; y < 4; ++y) acc[x][y] = mfma16(ast[ks][x], bqa[ks][y], acc[x][y]);
    }
    float ssq[4];
#pragma unroll
    for (int y = 0; y < 4; ++y) {
        float s = 0.f;
#pragma unroll
        for (int x = 0; x < 2; ++x)
#pragma unroll
            for (int r = 0; r < 4; ++r) s += acc[x][y][r] * acc[x][y][r];
        s += __shfl_xor(s, 16); s += __shfl_xor(s, 32);
        ssq[y] = s;
    }
    if (lg == 0) {
#pragma unroll
        for (int y = 0; y < 4; ++y) RED[w * 64 + y * 16 + l15] = ssq[y];
    }
    __syncthreads();
#pragma unroll
    for (int y = 0; y < 4; ++y) {
        const int i = y * 16 + l15;
        const float tot = RED[i] + RED[64 + i] + RED[128 + i] + RED[192 + i];
        const float rstd = rsqrtf(tot * (1.f / 128.f) + 1e-6f);
#pragma unroll
        for (int x = 0; x < 2; ++x) {
            const int dv = (2 * w + x) * 16 + 4 * lg;
            const float4 g4 = g4v[x];
            const uint2 gt = gtv[y][x];
            uint2 o;
            o.x = pack2(acc[x][y][0] * rstd * g4.x * bflo(gt.x), acc[x][y][1] * rstd * g4.y * bfhi(gt.x));
            o.y = pack2(acc[x][y][2] * rstd * g4.z * bflo(gt.y), acc[x][y][3] * rstd * g4.w * bfhi(gt.y));
            *reinterpret_cast<uint2*>(MIX + (size_t)i * 1024 + dv) = o;
        }
    }
    __syncthreads();
}
DEVI void phase5_unit(const Params& p, int u, char* smem) {
    if (u < 2048) out_unit<128>(p, u >> 7, u & 127, smem); else { u -= 2048; out_unit<64>(p, u >> 7, u & 127, smem); }
}

DEVI void rms_row_bf16_i8(const float* __restrict__ xr, const float* __restrict__ g, bf16_t* __restrict__ dst, unsigned char* __restrict__ dst8, float* __restrict__ descale, int lane) {
    float4 v[4]; float ss = 0.f;
#pragma unroll
    for (int i = 0; i < 4; ++i) { v[i] = reinterpret_cast<const float4*>(xr)[lane + 64 * i]; ss += v[i].x * v[i].x + v[i].y * v[i].y + v[i].z * v[i].z + v[i].w * v[i].w; }
    ss = wave_sum(ss);
    const float r = rsqrtf(ss * (1.f / 1024.f) + 1e-6f);
    float am = 0.f;
#pragma unroll
    for (int i = 0; i < 4; ++i) {
        const float4 gg = reinterpret_cast<const float4*>(g)[lane + 64 * i];
        v[i].x *= r * gg.x; v[i].y *= r * gg.y; v[i].z *= r * gg.z; v[i].w *= r * gg.w;
        uint2 o; o.x = pack2(v[i].x, v[i].y); o.y = pack2(v[i].z, v[i].w);
        reinterpret_cast<uint2*>(dst)[lane + 64 * i] = o;
        am = fmaxf(am, fmaxf(fmaxf(fabsf(v[i].x), fabsf(v[i].y)), fmaxf(fabsf(v[i].z), fabsf(v[i].w))));
    }
    am = wave_max(am);
    const float sc = am > 0.f ? 127.f / am : 1.f;
#pragma unroll
    for (int i = 0; i < 4; ++i) reinterpret_cast<int*>(dst8)[lane + 64 * i] = pack_i8x4(v[i].x * sc, v[i].y * sc, v[i].z * sc, v[i].w * sc);
    if (lane == 0) *descale = am > 0.f ? am * (1.f / 127.f) : 1.f;
}
constexpr int P7_UNITS = 8192;
DEVI void phase7_unit(const Params& p, int u, char* smem) {
    const int lane = LTID & 63, w = LTID >> 6;
    const int row = u * 4 + w;
    rms_row_bf16_i8(p.out + (size_t)row * DM, p.norm2_g, reinterpret_cast<bf16_t*>(p.ws + OFF_HN) + (size_t)row * DM,
                    p.ws + OFF_HN8 + (size_t)row * DM, reinterpret_cast<float*>(p.ws + OFF_HS) + row, lane);
}

using f32x16 = __attribute__((ext_vector_type(16))) float;
DEVI f32x16 mfma32(bf16x8 a, bf16x8 b, f32x16 c) { return __builtin_amdgcn_mfma_f32_32x32x16_bf16(a, b, c, 0, 0, 0); }
DEVI unsigned umax(unsigned a, unsigned b) { return a > b ? a : b; }
DEVI unsigned umin(unsigned a, unsigned b) { return a > b ? b : a; }
DEVI unsigned f2ord(float f) { const unsigned u = __float_as_uint(f); return u ^ ((unsigned)((int)u >> 31) | 0x80000000u); }
DEVI float ord2f(unsigned k) { return __uint_as_float((k & 0x80000000u) ? (k ^ 0x80000000u) : ~k); }

template <int BASE>
DEVI void sort16_desc(unsigned (&x)[64]) {
#pragma unroll
    for (int k = 2; k <= 16; k <<= 1) {
#pragma unroll
        for (int j = k >> 1; j > 0; j >>= 1) {
#pragma unroll
            for (int i = 0; i < 16; ++i) {
                const int l = i ^ j;
                if (l > i) {
                    const bool desc = ((i & k) == 0);
                    const unsigned a = x[BASE + i], b = x[BASE + l];
                    const unsigned hi = umax(a, b), lo = umin(a, b);
                    x[BASE + i] = desc ? hi : lo; x[BASE + l] = desc ? lo : hi;
                }
            }
        }
    }
}
template <int BASE>
DEVI void bmerge16_desc(unsigned (&x)[64]) {
#pragma unroll
    for (int j = 8; j > 0; j >>= 1) {
#pragma unroll
        for (int i = 0; i < 16; ++i) {
            const int l = i ^ j;
            if (l > i) { const unsigned a = x[BASE + i], b = x[BASE + l]; x[BASE + i] = umax(a, b); x[BASE + l] = umin(a, b); }
        }
    }
}
DEVI void top16_of_64(unsigned (&x)[64]) {
    sort16_desc<0>(x); sort16_desc<16>(x); sort16_desc<32>(x); sort16_desc<48>(x);
#pragma unroll
    for (int i = 0; i < 16; ++i) x[i] = umax(x[i], x[31 - i]);
    bmerge16_desc<0>(x);
#pragma unroll
    for (int i = 0; i < 16; ++i) x[32 + i] = umax(x[32 + i], x[63 - i]);
    bmerge16_desc<32>(x);
#pragma unroll
    for (int i = 0; i < 16; ++i) x[i] = umax(x[i], x[47 - i]);
    bmerge16_desc<0>(x);
}

DEVI void scores_top16(const bf16_t* __restrict__ SKp, const bf16_t* __restrict__ Qp, int lane, unsigned (&out)[16]) {
    const int r31 = lane & 31, hh = lane >> 5;
    f32x16 acc[4];
#pragma unroll
    for (int nb = 0; nb < 4; ++nb)
#pragma unroll
        for (int r = 0; r < 16; ++r) acc[nb][r] = 0.f;
#pragma unroll
    for (int ks = 0; ks < 8; ++ks) {
        const bf16x8 bq = ldg_frag(Qp + (size_t)r31 * 2048 + ks * 16 + 8 * hh);
#pragma unroll
        for (int nb = 0; nb < 4; ++nb) {
            const bf16x8 ak = ldg_frag(SKp + (size_t)(nb * 32 + r31) * 128 + ks * 16 + 8 * hh);
            acc[nb] = mfma32(ak, bq, acc[nb]);
        }
    }
    unsigned x[64];
    const unsigned hx = (unsigned)hh * 4u;
#pragma unroll
    for (int nb = 0; nb < 4; ++nb)
#pragma unroll
        for (int r = 0; r < 16; ++r) {
            const int nbase = nb * 32 + (r & 3) + 8 * (r >> 2);
            x[nb * 16 + r] = ((f2ord(acc[nb][r]) & ~127u) | (unsigned)(127 - nbase)) ^ hx;
        }
    top16_of_64(x);
    unsigned lo[16], hi[16];
#pragma unroll
    for (int i = 0; i < 16; ++i) { auto rr = __builtin_amdgcn_permlane32_swap(x[i], x[i], false, false); lo[i] = rr[0]; hi[i] = rr[1]; }
#pragma unroll
    for (int i = 0; i < 16; ++i) x[i] = umax(lo[i], hi[15 - i]);
    bmerge16_desc<0>(x);
#pragma unroll
    for (int i = 0; i < 16; ++i) out[i] = x[i];
}

constexpr int P9_UNITS = (M_TOK / 128) * 8;
DEVI void phase9_unit(const Params& p, int u, char* smem) {
    unsigned char* ws = p.ws;
    const int tid = LTID, lane = tid & 63, w = tid >> 6;
    const int tg = u >> 3, h = u & 7;
    const int t0 = tg * 128 + w * 32;
    const int hh = lane >> 5;
    unsigned* KL = reinterpret_cast<unsigned*>(smem) + w * 2048;
    const bf16_t* SK = reinterpret_cast<const bf16_t*>(ws + OFF_SK) + (size_t)(h * 2) * 128 * 128;
    const bf16_t* Q = reinterpret_cast<const bf16_t*>(ws + OFF_Q) + (size_t)t0 * 2048 + h * 256;
    unsigned k0[16], k1[16];
    scores_top16(SK, Q, lane, k0);
    scores_top16(SK + 128 * 128, Q + 128, lane, k1);
#pragma unroll
    for (int i = 0; i < 16; ++i) { KL[i * 64 + lane] = k0[i]; KL[(16 + i) * 64 + lane] = k1[i]; }
    float s0[16], s1[16];
#pragma unroll
    for (int i = 0; i < 16; ++i) { s0[i] = ord2f(k0[i] & ~127u); s1[i] = ord2f(k1[i] & ~127u); }
    unsigned x[64];
    {
        int n = 0;
#pragma unroll
        for (int a = 0; a < 16; ++a)
#pragma unroll
            for (int b = 0; b < 16; ++b)
                if ((a + 1) * (b + 1) <= 16) { x[n] = (f2ord(s0[a] + s1[b]) & ~255u) | (unsigned)(255 - (a * 16 + b)); ++n; }
#pragma unroll
        for (int i = 50; i < 64; ++i) x[i] = 0u;
    }
    top16_of_64(x);
    float cv[16]; int ex[16];
#pragma unroll
    for (int i = 0; i < 16; ++i) {
        cv[i] = ord2f(x[i] & ~255u);
        const int cid = 255 - (int)(x[i] & 255u);
        const unsigned ka = KL[(cid >> 4) * 64 + lane], kb = KL[(16 + (cid & 15)) * 64 + lane];
        ex[i] = (127 - (int)(ka & 127u)) * 128 + (127 - (int)(kb & 127u));
    }
    float sum = 0.f;
    const float mx = cv[0];
#pragma unroll
    for (int i = 0; i < 16; ++i) cv[i] = __expf(cv[i] - mx);
#pragma unroll
    for (int i = 0; i < 16; ++i) sum += cv[i];
    const float inv = 1.f / sum;
    const size_t orow = (size_t)(t0 + (lane & 31)) * 128 + h * 16;
    if (hh == 0) {
        int4* d = reinterpret_cast<int4*>(reinterpret_cast<int*>(ws + OFF_EIDX) + orow);
#pragma unroll
        for (int i = 0; i < 4; ++i) d[i] = make_int4(ex[4 * i], ex[4 * i + 1], ex[4 * i + 2], ex[4 * i + 3]);
        const float* US = reinterpret_cast<const float*>(ws + OFF_US);
        float4* du = reinterpret_cast<float4*>(reinterpret_cast<float*>(ws + OFF_EU) + orow);
#pragma unroll
        for (int i = 0; i < 4; ++i) du[i] = make_float4(US[ex[4 * i]], US[ex[4 * i + 1]], US[ex[4 * i + 2]], US[ex[4 * i + 3]]);
    } else {
        const float* VS = reinterpret_cast<const float*>(ws + OFF_VS);
        float4* d = reinterpret_cast<float4*>(reinterpret_cast<float*>(ws + OFF_EW) + orow);
#pragma unroll
        for (int i = 0; i < 4; ++i) d[i] = make_float4(cv[4 * i] * inv * VS[ex[4 * i]], cv[4 * i + 1] * inv * VS[ex[4 * i + 1]], cv[4 * i + 2] * inv * VS[ex[4 * i + 2]], cv[4 * i + 3] * inv * VS[ex[4 * i + 3]]);
    }
}

typedef _Float16 h2_t __attribute__((ext_vector_type(2)));
template <int CTRL> DEVI float dpp_f(float x) { return __builtin_bit_cast(float, __builtin_amdgcn_mov_dpp(__builtin_bit_cast(int, x), CTRL, 0xf, 0xf, true)); }
DEVI float sum8(float v) { v += dpp_f<0xB1>(v); v += dpp_f<0x4E>(v); v += dpp_f<0x141>(v); return v; }
DEVI float sum64(float v) {
    v = sum8(v); v += dpp_f<0x128>(v);
    { auto s = __builtin_amdgcn_permlane16_swap(__float_as_uint(v), __float_as_uint(v), false, false); v = __uint_as_float(s[0]) + __uint_as_float(s[1]); }
    { auto s = __builtin_amdgcn_permlane32_swap(__float_as_uint(v), __float_as_uint(v), false, false); v = __uint_as_float(s[0]) + __uint_as_float(s[1]); }
    return v;
}
DEVI long pack_i64(unsigned lo, unsigned hi) { return (long)(((unsigned long long)hi << 32) | (unsigned long long)lo); }

#define SB __builtin_amdgcn_sched_barrier(0)
#define SB __builtin_amdgcn_sched_barrier(0)
#define PIN4(Q) "+v"(Q.x), "+v"(Q.y), "+v"(Q.z), "+v"(Q.w)
DEVI void phase10a_block(const Params& p, char* smem) {
    unsigned char* ws = p.ws;
    const int s = blockIdx.x & 7, rank = blockIdx.x >> 3, nrank = ((int)gridDim.x - s + 7) >> 3;
    const int lane = threadIdx.x & 63, wave = threadIdx.x >> 6;
    const int lg = lane & 7, grp = lane >> 3;
    const unsigned char* U8 = ws + OFF_U8 + (size_t)s * (16384 * 128) + 16 * lg;
    const unsigned char* HNs = ws + OFF_HN8 + 128 * s + 16 * lg;
    float* PD = reinterpret_cast<float*>(ws + OFF_PD) + (size_t)s * M_TOK * 128;
    float* stg = reinterpret_cast<float*>(smem) + wave * (16 * 128);
    constexpr int NTG = M_TOK / 8;
#define P10A_LOAD_EV(TG, E) do { const int4* _q = reinterpret_cast<const int4*>(reinterpret_cast<const int*>(ws + OFF_EIDX) + (size_t)((TG) * 8 + wave) * 128 + 16 * grp); \
        E[0] = _q[0]; E[1] = _q[1]; E[2] = _q[2]; E[3] = _q[3]; } while (0)
#define P10A_LOAD_ROWS(TG, E, R, HA) do { \
        asm volatile("" : PIN4(E[0]), PIN4(E[1]), PIN4(E[2]), PIN4(E[3])); \
        const int _e[16] = {E[0].x, E[0].y, E[0].z, E[0].w, E[1].x, E[1].y, E[1].z, E[1].w, E[2].x, E[2].y, E[2].z, E[2].w, E[3].x, E[3].y, E[3].z, E[3].w}; \
        _Pragma("unroll") for (int _i = 0; _i < 16; ++_i) R[_i] = *reinterpret_cast<const uint4*>(U8 + (size_t)_e[_i] * 128); \
        HA = *reinterpret_cast<const uint4*>(HNs + (size_t)((TG) * 8 + wave) * DM); } while (0)
#define P10A_COMPUTE(SLOT, R, HA) do { \
        asm volatile("" : PIN4(R[0]), PIN4(R[1]), PIN4(R[2]), PIN4(R[3]), PIN4(R[4]), PIN4(R[5])); \
        asm volatile("" : PIN4(R[6]), PIN4(R[7]), PIN4(R[8]), PIN4(R[9]), PIN4(R[10]), PIN4(R[11])); \
        asm volatile("" : PIN4(R[12]), PIN4(R[13]), PIN4(R[14]), PIN4(R[15]), PIN4(HA)); \
        int _v1 = 0, _v2 = 0; \
        _Pragma("unroll") for (int _i = 0; _i < 16; ++_i) { \
            int _a = __builtin_amdgcn_sdot4((int)R[_i].x, (int)HA.x, 0, false); \
            _a = __builtin_amdgcn_sdot4((int)R[_i].y, (int)HA.y, _a, false); \
            _a = __builtin_amdgcn_sdot4((int)R[_i].z, (int)HA.z, _a, false); \
            _a = __builtin_amdgcn_sdot4((int)R[_i].w, (int)HA.w, _a, false); \
            _a += __builtin_amdgcn_mov_dpp(_a, 0xB1, 0xf, 0xf, true); _a += __builtin_amdgcn_mov_dpp(_a, 0x4E, 0xf, 0xf, true); _a += __builtin_amdgcn_mov_dpp(_a, 0x141, 0xf, 0xf, true); \
            if (_i < 8) _v1 = (lg == _i) ? _a : _v1; else _v2 = (lg == _i - 8) ? _a : _v2; } \
        stg[(SLOT) * 128 + 16 * grp + lg] = (float)_v1; stg[(SLOT) * 128 + 16 * grp + 8 + lg] = (float)_v2; } while (0)
    int4 eA[4], eB[4], eC[4]; uint4 rA[16], rB[16]; uint4 hA0, hB0;
    if (rank >= NTG) return;
    const int ntok = (NTG - rank + nrank - 1) / nrank;
#define TGI(I) (rank + ((I) < ntok ? (I) : ntok - 1) * nrank)
    P10A_LOAD_EV(TGI(0), eA);
    SB; P10A_LOAD_EV(TGI(1), eB);
    SB; P10A_LOAD_ROWS(TGI(0), eA, rA, hA0);
    SB;
    for (int base = 0; base < ntok; base += 16) {
#pragma unroll 1
        for (int i = base; i < base + 16; i += 2) {
            SB; P10A_LOAD_EV(TGI(i + 2), eC);
            SB; P10A_LOAD_ROWS(TGI(i + 1), eB, rB, hB0);
            SB; P10A_COMPUTE(i - base, rA, hA0);
            SB; P10A_LOAD_EV(TGI(i + 3), eB);
            SB; P10A_LOAD_ROWS(TGI(i + 2), eC, rA, hA0);
            SB; P10A_COMPUTE(i + 1 - base, rB, hB0);
            SB;
        }
#pragma unroll 4
        for (int j = 0; j < 16; ++j) {
            const float2 v = *reinterpret_cast<const float2*>(stg + j * 128 + 2 * lane);
            *reinterpret_cast<float2*>(PD + (size_t)(TGI(base + j) * 8 + wave) * 128 + 2 * lane) = v;
        }
        __builtin_amdgcn_s_waitcnt(0x0F70);
    }
#undef TGI
#undef P10A_LOAD_EV
#undef P10A_LOAD_ROWS
#undef P10A_COMPUTE
}

DEVI void phase10w_block(const Params& p) {
    unsigned char* ws = p.ws;
    const int lane = threadIdx.x & 63, wave = threadIdx.x >> 6;
    const float* PD = reinterpret_cast<const float*>(ws + OFF_PD);
    const float* HS = reinterpret_cast<const float*>(ws + OFF_HS);
    for (int t = blockIdx.x * 8 + wave; t < M_TOK; t += gridDim.x * 8) {
        float d0 = 0.f, d1 = 0.f;
#pragma unroll
        for (int sl = 0; sl < 8; ++sl) { d0 += PD[((size_t)sl * M_TOK + t) * 128 + lane]; d1 += PD[((size_t)sl * M_TOK + t) * 128 + 64 + lane]; }
        const float hs = HS[t];
        const float u0 = reinterpret_cast<const float*>(ws + OFF_EU)[(size_t)t * 128 + lane], u1 = reinterpret_cast<const float*>(ws + OFF_EU)[(size_t)t * 128 + 64 + lane];
        const float g0 = reinterpret_cast<const float*>(ws + OFF_EW)[(size_t)t * 128 + lane], g1 = reinterpret_cast<const float*>(ws + OFF_EW)[(size_t)t * 128 + 64 + lane];
        d0 *= u0 * hs; d1 *= u1 * hs;
        _Float16* W = reinterpret_cast<_Float16*>(ws + OFF_W16) + (size_t)t * 128;
        W[lane] = (_Float16)(g0 * 0.5f * d0 * (1.f + erff(d0 * 0.70710678118654752f)));
        W[64 + lane] = (_Float16)(g1 * 0.5f * d1 * (1.f + erff(d1 * 0.70710678118654752f)));
    }
}

template <bool DRY>
DEVI void phase10b_block(const Params& p, char* smem) {
    unsigned char* ws = p.ws;
    const int s = blockIdx.x & 7, rank = blockIdx.x >> 3, nrank = ((int)gridDim.x - s + 7) >> 3;
    const int lane = threadIdx.x & 63, wave = threadIdx.x >> 6;
    const int lg = lane & 7, grp = lane >> 3;
    const unsigned char* V8 = ws + OFF_V8 + (size_t)s * (16384 * 128) + 16 * lg;
    float* stg = reinterpret_cast<float*>(smem) + wave * (16 * 128);
    constexpr int NTG = M_TOK / 8;
#define P10B_LOAD_EV(TG, E) do { const int4* _q = reinterpret_cast<const int4*>(reinterpret_cast<const int*>(ws + OFF_EIDX) + (size_t)((TG) * 8 + wave) * 128 + 16 * grp); \
        E[0] = _q[0]; E[1] = _q[1]; E[2] = _q[2]; E[3] = _q[3]; } while (0)
#define P10B_LOAD_ROWS(TG, E, R, WA, WB) do { \
        asm volatile("" : PIN4(E[0]), PIN4(E[1]), PIN4(E[2]), PIN4(E[3])); \
        const int _e[16] = {E[0].x, E[0].y, E[0].z, E[0].w, E[1].x, E[1].y, E[1].z, E[1].w, E[2].x, E[2].y, E[2].z, E[2].w, E[3].x, E[3].y, E[3].z, E[3].w}; \
        _Pragma("unroll") for (int _i = 0; _i < 16; ++_i) R[_i] = *reinterpret_cast<const uint4*>(V8 + (size_t)_e[_i] * 128); \
        const uint4* _w = reinterpret_cast<const uint4*>(reinterpret_cast<const _Float16*>(ws + OFF_W16) + (size_t)((TG) * 8 + wave) * 128 + 16 * grp); WA = _w[0]; WB = _w[1]; } while (0)
#define P10B_COMPUTE(SLOT, R, WA, WB) do { \
          \
        asm volatile("" : PIN4(R[0]), PIN4(R[1]), PIN4(R[2]), PIN4(R[3]), PIN4(R[4]), PIN4(R[5])); \
        asm volatile("" : PIN4(R[6]), PIN4(R[7]), PIN4(R[8]), PIN4(R[9]), PIN4(R[10]), PIN4(R[11])); \
        asm volatile("" : PIN4(R[12]), PIN4(R[13]), PIN4(R[14]), PIN4(R[15]), PIN4(WA), PIN4(WB)); \
        const unsigned _ww[8] = {WA.x, WA.y, WA.z, WA.w, WB.x, WB.y, WB.z, WB.w}; \
        h2_t _acc[8]; unsigned _zb; asm volatile("v_mov_b32 %0, 0" : "=v"(_zb)); \
        _Pragma("unroll") for (int _j = 0; _j < 8; ++_j) _acc[_j] = __builtin_bit_cast(h2_t, _zb); \
        _Pragma("unroll") for (int _i = 0; _i < 16; ++_i) { \
            const unsigned _pw = _ww[_i >> 1]; \
            const h2_t _wp = __builtin_bit_cast(h2_t, (_i & 1) ? ((_pw >> 16) | (_pw & 0xffff0000u)) : ((_pw << 16) | (_pw & 0xffffu))); \
            const unsigned _wd[4] = {R[_i].x, R[_i].y, R[_i].z, R[_i].w}; \
            _Pragma("unroll") for (int _j = 0; _j < 4; ++_j) { \
                _acc[2 * _j] += _wp * __builtin_amdgcn_cvt_scalef32_pk_f16_fp8((int)_wd[_j], 1.0f, false); \
                _acc[2 * _j + 1] += _wp * __builtin_amdgcn_cvt_scalef32_pk_f16_fp8((int)_wd[_j], 1.0f, true); } } \
        float _o[16]; \
        _Pragma("unroll") for (int _j = 0; _j < 8; ++_j) { \
            h2_t _x = _acc[_j]; \
            _x += __builtin_bit_cast(h2_t, __builtin_amdgcn_mov_dpp(__builtin_bit_cast(int, _x), 0x128, 0xf, 0xf, true));     \
            { auto _s = __builtin_amdgcn_permlane16_swap(__builtin_bit_cast(unsigned, _x), __builtin_bit_cast(unsigned, _x), false, false); _x = __builtin_bit_cast(h2_t, (unsigned)_s[0]) + __builtin_bit_cast(h2_t, (unsigned)_s[1]); } \
            { auto _s = __builtin_amdgcn_permlane32_swap(__builtin_bit_cast(unsigned, _x), __builtin_bit_cast(unsigned, _x), false, false); _x = __builtin_bit_cast(h2_t, (unsigned)_s[0]) + __builtin_bit_cast(h2_t, (unsigned)_s[1]); } \
            _o[2 * _j] = (float)_x[0]; _o[2 * _j + 1] = (float)_x[1]; } \
        if (grp == 0) { float* _orow = stg + (SLOT) * 128 + 16 * lg; \
            _Pragma("unroll") for (int _i = 0; _i < 4; ++_i) *reinterpret_cast<float4*>(_orow + 4 * _i) = make_float4(_o[4 * _i], _o[4 * _i + 1], _o[4 * _i + 2], _o[4 * _i + 3]); } } while (0)
    int4 eA[4], eB[4], eC[4]; uint4 rA[16], rB[16]; uint4 wA0, wA1, wB0, wB1;
    if (rank >= NTG) return;
    const int ntok = (NTG - rank + nrank - 1) / nrank;
#define TGI(I) (rank + ((I) < ntok ? (I) : ntok - 1) * nrank)
    P10B_LOAD_EV(TGI(0), eA);
    SB; P10B_LOAD_EV(TGI(1), eB);
    SB; P10B_LOAD_ROWS(TGI(0), eA, rA, wA0, wA1);
    SB;
    for (int base = 0; base < ntok; base += 16) {
        float2 hrow[16];
#pragma unroll
        for (int j = 0; j < 16; ++j) hrow[j] = *reinterpret_cast<const float2*>(p.out + (size_t)(TGI(base + j) * 8 + wave) * DM + 128 * s + 2 * lane);
#pragma unroll 1
        for (int i = base; i < base + 16; i += 2) {
            SB; P10B_LOAD_EV(TGI(i + 2), eC);
            SB; P10B_LOAD_ROWS(TGI(i + 1), eB, rB, wB0, wB1);
            SB; P10B_COMPUTE(i - base, rA, wA0, wA1);
            SB; P10B_LOAD_EV(TGI(i + 3), eB);
            SB; P10B_LOAD_ROWS(TGI(i + 2), eC, rA, wA0, wA1);
            SB; P10B_COMPUTE(i + 1 - base, rB, wB0, wB1);
            SB;
        }
        float ssv = 0.f;
#pragma unroll
        for (int j = 0; j < 16; ++j) {
            if (base + j < ntok) {
                const size_t ro = (size_t)(TGI(base + j) * 8 + wave) * DM + 128 * s + 2 * lane;
                const float2 v = *reinterpret_cast<const float2*>(stg + j * 128 + 2 * lane);
                const float2 hv = hrow[j];
                const float2 r = make_float2(hv.x + v.x, hv.y + v.y);
                *reinterpret_cast<float2*>(p.out + ro) = DRY ? hv : r;
                const float sq = sum64(r.x * r.x + r.y * r.y);
                ssv = (lane == j) ? sq : ssv;
            }
        }
        if (lane < 16 && base + lane < ntok) reinterpret_cast<float*>(ws + OFF_SSQ)[(DRY ? (size_t)M_TOK * 8 : 0) + (size_t)(TGI(base + lane) * 8 + wave) * 8 + s] = ssv;
        __builtin_amdgcn_s_waitcnt(0x0F70);
    }
#undef TGI
#undef P10B_LOAD_EV
#undef P10B_LOAD_ROWS
#undef P10B_COMPUTE
}

DEVI void phase10c_block(const Params& p) {
    unsigned char* ws = p.ws;
    const int lane = threadIdx.x & 63, wave = threadIdx.x >> 6;
    for (int t = blockIdx.x * 8 + wave; t < M_TOK; t += gridDim.x * 8) {
        const float* sq = reinterpret_cast<const float*>(ws + OFF_SSQ) + (size_t)t * 8;
        const float4 a = *reinterpret_cast<const float4*>(sq), b = *reinterpret_cast<const float4*>(sq + 4);
        const float r = rsqrtf((a.x + a.y + a.z + a.w + b.x + b.y + b.z + b.w) * (1.f / 1024.f) + 1e-6f);
        float4* orow = reinterpret_cast<float4*>(p.out + (size_t)t * DM);
        const float4* gf = reinterpret_cast<const float4*>(p.norm_f_g);
#pragma unroll
        for (int i = 0; i < 4; ++i) {
            const float4 v = orow[lane + 64 * i], g = gf[lane + 64 * i];
            orow[lane + 64 * i] = make_float4(v.x * r * g.x, v.y * r * g.y, v.z * r * g.z, v.w * r * g.w);
        }
    }
}

#define XB_TMO      128
#define XB_XCNT(j)  (256  + 64 * (j))
#define XB_XSUB(j)  (1280 + 64 * (j))
#define XB_XGEN(j)  (2304 + 64 * (j))
#define XB_TOP      3328
#define XB_TOPGEN   3392
#define XCD_BAR_WORDS 3456
#define XB_SPIN_CAP (1u << 22)
#define LAS __attribute__((address_space(3)))
DEVI unsigned xb_ld(unsigned* p)              { return __hip_atomic_load(p, __ATOMIC_RELAXED, __HIP_MEMORY_SCOPE_AGENT); }
DEVI unsigned xb_add(unsigned* p, unsigned v) { return __hip_atomic_fetch_add(p, v, __ATOMIC_RELAXED, __HIP_MEMORY_SCOPE_AGENT); }
DEVI unsigned xb_xcc_id() { return (unsigned)__builtin_amdgcn_s_getreg((3 << 11) | 20) & 0xFu; }
#define XB_SPIN(cond, bar) do { unsigned _sp = 0; while (cond) { __builtin_amdgcn_s_sleep(1); \
    if ((++_sp & 255u) == 0u) { if (xb_ld(&(bar)[XB_TMO])) break; if (_sp > XB_SPIN_CAP) { atomicAdd(&(bar)[XB_TMO], 1u); break; } } } } while (0)
struct XcdBarrier { unsigned* bar; unsigned x; volatile LAS unsigned* st; };
DEVI XcdBarrier xcd_barrier_post(unsigned* bar, volatile LAS unsigned* st) {
    XcdBarrier b; b.bar = bar; b.x = xb_xcc_id(); b.st = st;
    if (threadIdx.x == 0) (void)xb_add(&bar[XB_XCNT(b.x)], 1u);
    return b;
}
DEVI void xcd_barrier_complete(unsigned* bar, unsigned x, unsigned& nloc, unsigned& nx) {
    const unsigned G = gridDim.x * gridDim.y * gridDim.z;
    unsigned sum, cnt, mine, sp = 0u;
    for (;;) {
        sum = 0u; cnt = 0u; mine = 0u;
#pragma unroll
        for (unsigned j = 0; j < 16; ++j) { const unsigned c = xb_ld(&bar[XB_XCNT(j)]); sum += c; cnt += (c > 0u) ? 1u : 0u; mine = (j == x) ? c : mine; }
        if (sum == G) break;
        __builtin_amdgcn_s_sleep(1);
        if ((++sp & 255u) == 0u) { if (xb_ld(&bar[XB_TMO])) break; if (sp > XB_SPIN_CAP) { atomicAdd(&bar[XB_TMO], 1u); break; } }
    }
    nloc = mine > 0u ? mine : 1u; nx = cnt > 0u ? cnt : 1u;
}
DEVI void xcd_barrier(const XcdBarrier& b) {
    asm volatile("s_waitcnt vmcnt(0)" ::: "memory");
    __syncthreads();
    if (threadIdx.x == 0) {
        unsigned* bar = b.bar;
        __builtin_amdgcn_s_waitcnt(0);
        unsigned nloc = b.st[0], nx = b.st[1];
        if (nloc == 0u) { xcd_barrier_complete(bar, b.x, nloc, nx); b.st[0] = nloc; b.st[1] = nx; }
        const unsigned old = xb_add(&bar[XB_XSUB(b.x)], 1u);
        const unsigned gen = old / nloc;
        if (old + 1u == (gen + 1u) * nloc) {
            __builtin_amdgcn_fence(__ATOMIC_RELEASE, "agent");
            asm volatile("s_waitcnt vmcnt(0)" ::: "memory");
            const unsigned og = xb_add(&bar[XB_TOP], 1u);
            const unsigned tg = og / nx;
            if (og + 1u == (tg + 1u) * nx) xb_add(&bar[XB_TOPGEN], 1u);
            else XB_SPIN(xb_ld(&bar[XB_TOPGEN]) == tg, bar);
            __builtin_amdgcn_fence(__ATOMIC_ACQUIRE, "agent");
            xb_add(&bar[XB_XGEN(b.x)], 1u);
            asm volatile("s_waitcnt vmcnt(0)" ::: "memory");
        } else {
            XB_SPIN(xb_ld(&bar[XB_XGEN(b.x)]) == gen, bar);
            __builtin_amdgcn_fence(__ATOMIC_ACQUIRE, "agent");
            asm volatile("s_waitcnt vmcnt(0)" ::: "memory");
        }
    }
    __syncthreads();
}

constexpr int N_PHASES = 11;
constexpr int LDS_PHASE_BYTES = 131072;
constexpr int LDS_BYTES = LDS_PHASE_BYTES + 16;

__global__ void __launch_bounds__(512, 2) hymba_fwd(Params p) {
    extern __shared__ __attribute__((aligned(16))) char smem[];
    cg::grid_group grid = cg::this_grid();
    const int lo = p.ph_lo, hi = p.ph_hi;
    volatile LAS unsigned* bst = (volatile LAS unsigned*)(smem + LDS_PHASE_BYTES);
    if (threadIdx.x == 0) { bst[0] = 0u; bst[1] = 0u; bst[2] = 0u; bst[3] = 0u; }
    __syncthreads();
    XcdBarrier xb = xcd_barrier_post(reinterpret_cast<unsigned*>(p.ws + OFF_BAR), bst);
    const int hb = (int)(threadIdx.x >> 8);
    char* hsm = smem + hb * 65536;
#define SEAM(K) if ((K) > lo) { if ((K) == lo + 1) grid.sync(); else xcd_barrier(xb); }
#define RUN_PHASE(K, FN, N) if (lo <= (K) && (K) < hi) { SEAM(K) for (int rep = 0; rep < 1 + ((PROBE_DUP >> (K)) & 1); ++rep) { if (rep) xcd_barrier(xb); \
        for (int ub = blockIdx.x * 2; ub < (N); ub += gridDim.x * 2) { const int u = ub + hb; if (u < (N)) FN(p, u, hsm); } } }
#define RUN_GEMM(K, CALL) if (lo <= (K) && (K) < hi) { SEAM(K) CALL; }
    RUN_PHASE(0, phase0_unit, P0_UNITS)
    RUN_GEMM(1, run_gemm(reinterpret_cast<const bf16_t*>(p.ws + OFF_XN), reinterpret_cast<const bf16_t*>(p.ws + OFF_WIN), P1_N, EpiInProj{p.ws}, smem))
#if PROBE_P2G
    if (lo <= 2 && 2 < hi) { xcd_barrier(xb); for (int ub = blockIdx.x * 2; ub < P2_UNITS; ub += gridDim.x * 2) { const int u = ub + hb; if (u < P2_UNITS) phase2_dry_unit(p, u, hsm); } }
#endif
    RUN_PHASE(2, phase2_unit, P2_UNITS)
#if PROBE_P2T
    if (lo <= 2 && 2 < hi) { xcd_barrier(xb); for (int ub = blockIdx.x * 2; ub < P2_UNITS; ub += gridDim.x * 2) { const int u = ub + hb; if (u < P2_UNITS && (u % 7) >= 3) phase2_unit(p, u, hsm); } }
#endif
    RUN_PHASE(3, phase3_unit, P3_UNITS)
#if PROBE_P4
    if (lo <= 4 && 4 < hi) { xcd_barrier(xb); for (int ub = blockIdx.x * 2; ub < P4_UNITS; ub += gridDim.x * 2) { const int u = ub + hb; if (u < P4_UNITS) phase4_dry_unit(p, u, hsm); } }
#endif
    RUN_PHASE(4, phase4_unit, P4_UNITS)
    RUN_PHASE(5, phase5_unit, P5_UNITS)
    RUN_GEMM(6, run_gemm(reinterpret_cast<const bf16_t*>(p.ws + OFF_MIX), reinterpret_cast<const bf16_t*>(p.ws + OFF_WOUT), 1024, EpiOutProj{p.x, p.out}, smem))
    RUN_PHASE(7, phase7_unit, P7_UNITS)
    RUN_GEMM(8, run_gemm(reinterpret_cast<const bf16_t*>(p.ws + OFF_HN), reinterpret_cast<const bf16_t*>(p.ws + OFF_WQ), 2048, EpiQ{reinterpret_cast<bf16_t*>(p.ws + OFF_Q)}, smem))
    RUN_PHASE(9, phase9_unit, P9_UNITS)
    if (lo <= 10 && 10 < hi) {
        SEAM(10)
#if PROBE_P10X == 4
        phase10a_block(p, smem); xcd_barrier(xb);
#endif
        phase10a_block(p, smem);
#if PROBE_P10X == 1
        xcd_barrier(xb); phase10a_block(p, smem);
#endif

        xcd_barrier(xb); phase10w_block(p);
#if PROBE_P10X == 2
        xcd_barrier(xb); phase10b_block<true>(p, smem);
#endif
        xcd_barrier(xb); phase10b_block<false>(p, smem);
        xcd_barrier(xb); phase10c_block(p);
#if PROBE_P10X == 3
        xcd_barrier(xb); phase10c_block(p);
#endif
    }
#undef RUN_PHASE
#undef RUN_GEMM
#undef SEAM
}

extern "C" void kernel_launch(void* const* d_in, const int* in_sizes, int n_in, void* d_out, int out_size, void* d_ws, size_t ws_size, hipStream_t stream) {
    static int grid_blocks = 0;
    if (grid_blocks == 0) {
        if (n_in != 15 || in_sizes[0] != M_TOK * DM || out_size != M_TOK * DM || ws_size < WS_NEED) {
            fprintf(stderr, "kernel_launch: unexpected shapes (n_in %d, in0 %d, out %d, ws %zu)\n", n_in, n_in > 0 ? in_sizes[0] : -1, out_size, ws_size);
            grid_blocks = -1; return;
        }
        int dev = 0, cus = 0, per_cu = 0;
        (void)hipGetDevice(&dev);
        (void)hipDeviceGetAttribute(&cus, hipDeviceAttributeMultiprocessorCount, dev);
        (void)hipFuncSetAttribute((const void*)hymba_fwd, hipFuncAttributeMaxDynamicSharedMemorySize, LDS_BYTES);
        (void)hipOccupancyMaxActiveBlocksPerMultiprocessor(&per_cu, (const void*)hymba_fwd, 512, LDS_BYTES);
        if (per_cu < 1) per_cu = 1;
        if (per_cu > 1) per_cu = 1;
        grid_blocks = cus * per_cu;
    }
    if (grid_blocks < 0) return;
    Params p{};
    p.x = (const float*)d_in[0]; p.norm1_g = (const float*)d_in[1]; p.w_in = (const float*)d_in[2]; p.hg_lower = (const float*)d_in[3];
    p.hg_norm_g = (const float*)d_in[4]; p.gla_wg = (const float*)d_in[5]; p.gla_bg = (const float*)d_in[6]; p.gla_norm_g = (const float*)d_in[7];
    p.w_out = (const float*)d_in[8]; p.norm2_g = (const float*)d_in[9]; p.w_q = (const float*)d_in[10]; p.sub_keys = (const float*)d_in[11];
    p.peer_u = (const float*)d_in[12]; p.peer_v = (const float*)d_in[13]; p.norm_f_g = (const float*)d_in[14];
    p.out = (float*)d_out; p.ws = (unsigned char*)d_ws;
#if N_LAUNCH_MODE == 1
    (void)hipMemsetAsync((unsigned char*)d_ws + OFF_BAR, 0, XCD_BAR_WORDS * 4, stream);
    p.ph_lo = 0; p.ph_hi = N_PHASES;
    void* args[] = {&p};
    hipError_t e = hipLaunchCooperativeKernel((const void*)hymba_fwd, dim3(grid_blocks), dim3(512), args, LDS_BYTES, stream);
    if (e != hipSuccess) fprintf(stderr, "cooperative launch failed: %s (grid %d)\n", hipGetErrorString(e), grid_blocks);
#else
    for (int ph = 0; ph < N_PHASES; ++ph) {
        p.ph_lo = ph; p.ph_hi = ph + 1;
        hipLaunchKernelGGL(hymba_fwd, dim3(grid_blocks), dim3(512), LDS_BYTES, stream, p);
    }
#endif
}
```

```cpp
#include <hip/hip_runtime.h>
#include <hip/hip_cooperative_groups.h>
#include <cstdio>
#include <cstdint>
namespace cg = cooperative_groups;

#ifndef N_LAUNCH_MODE
#define N_LAUNCH_MODE 1
#endif

#ifndef PROBE_DUP
#define PROBE_DUP 0
#endif
#ifndef PROBE_P10_DUP
#define PROBE_P10_DUP 0
#endif
#ifndef P10_SLICED
#define P10_SLICED 0
#endif
#ifndef PROBE_P10A
#define PROBE_P10A 0
#endif
#ifndef PROBE_P10_MASK
#define PROBE_P10_MASK 0x7fffffff
#endif
#ifndef PROBE_P10X
#define PROBE_P10X 0
#endif
#ifndef PROBE_P2T
#define PROBE_P2T 0
#endif
#ifndef PROBE_P4
#define PROBE_P4 0
#endif
#ifndef PROBE_P2G
#define PROBE_P2G 0
#endif
#ifndef PROBE_GEMM_DUP
#define PROBE_GEMM_DUP 0
#endif
#define DEVI __device__ __forceinline__
#define LTID ((int)(threadIdx.x & 255u))
typedef unsigned short bf16_t;
using bf16x8 = __attribute__((ext_vector_type(8))) short;
using f32x4 = __attribute__((ext_vector_type(4))) float;

constexpr int M_TOK = 32768;
constexpr int DM = 1024;
constexpr int IN_WP = 3840;
constexpr size_t MiB = 1024ull * 1024ull;

constexpr size_t OFF_XN   = 0;
constexpr size_t OFF_WIN  = 64 * MiB;
constexpr size_t OFF_WOUT = 72 * MiB;
constexpr size_t OFF_WQ   = 74 * MiB;
constexpr size_t OFF_SK   = 78 * MiB;
constexpr size_t OFF_LB   = 79 * MiB;
constexpr size_t OFF_U8   = 80 * MiB;
constexpr size_t OFF_V8   = 96 * MiB;
constexpr size_t OFF_US   = 112 * MiB;
constexpr size_t OFF_VS   = 113 * MiB;
constexpr size_t OFF_R2   = 144 * MiB;
constexpr size_t OFF_HQ   = OFF_R2;
constexpr size_t OFF_HLF  = OFF_R2 + 32 * MiB;
constexpr size_t OFF_HV   = OFF_R2 + 64 * MiB;
constexpr size_t OFF_HG   = OFF_R2 + 96 * MiB;
constexpr size_t OFF_GQ   = OFF_R2 + 128 * MiB;
constexpr size_t OFF_GK   = OFF_R2 + 144 * MiB;
constexpr size_t OFF_GV   = OFF_R2 + 160 * MiB;
constexpr size_t OFF_GG   = OFF_R2 + 192 * MiB;
constexpr size_t OFF_GLOW = OFF_R2 + 224 * MiB;
constexpr size_t OFF_KTH  = 370 * MiB;
constexpr size_t OFF_KTG  = 402 * MiB;
constexpr size_t OFF_DECH = 418 * MiB;
constexpr size_t OFF_DECG = 419 * MiB;
constexpr size_t OFF_HVT  = 420 * MiB;
constexpr size_t OFF_GVT  = 452 * MiB;
constexpr size_t OFF_BAR  = 484 * MiB;
constexpr size_t WS_NEED  = 485 * MiB;
constexpr size_t OFF_MIX  = OFF_XN;
constexpr size_t OFF_HN   = OFF_R2;
constexpr size_t OFF_Q    = OFF_R2 + 64 * MiB;
constexpr size_t OFF_EIDX = OFF_KTH;
constexpr size_t OFF_EW   = OFF_KTH + 16 * MiB;
constexpr size_t OFF_EU   = OFF_KTG;
constexpr size_t OFF_HN8  = OFF_XN;
constexpr size_t OFF_HS   = OFF_XN + 32 * MiB;
constexpr size_t OFF_W16  = OFF_XN + 48 * MiB;
constexpr size_t OFF_SSQ  = OFF_XN + 33 * MiB;
constexpr size_t OFF_PD   = OFF_Q;
constexpr size_t OUT_STH = 0;
constexpr size_t OUT_STG = 64 * MiB;

struct Params {
    const float* x; const float* norm1_g; const float* w_in; const float* hg_lower; const float* hg_norm_g;
    const float* gla_wg; const float* gla_bg; const float* gla_norm_g; const float* w_out; const float* norm2_g;
    const float* w_q; const float* sub_keys; const float* peer_u; const float* peer_v; const float* norm_f_g;
    float* out; unsigned char* ws;
    int ph_lo, ph_hi;
};

DEVI unsigned short f2bf(float f) {
    unsigned u = __float_as_uint(f);
    u += 0x7fffu + ((u >> 16) & 1u);
    return (unsigned short)(u >> 16);
}
DEVI float bf2f(unsigned short b) { return __uint_as_float(((unsigned)b) << 16); }
DEVI unsigned pack2(float a, float b) { return (unsigned)f2bf(a) | ((unsigned)f2bf(b) << 16); }
DEVI float bflo(unsigned u) { return __uint_as_float(u << 16); }
DEVI float bfhi(unsigned u) { return __uint_as_float(u & 0xffff0000u); }
DEVI float wave_sum(float v) {
#pragma unroll
    for (int o = 32; o > 0; o >>= 1) v += __shfl_xor(v, o);
    return v;
}
DEVI float wave_max(float v) {
#pragma unroll
    for (int o = 32; o > 0; o >>= 1) v = fmaxf(v, __shfl_xor(v, o));
    return v;
}
DEVI float silu_f(float x) { return x * __builtin_amdgcn_rcpf(1.f + __expf(-x)); }
DEVI f32x4 mfma16(bf16x8 a, bf16x8 b, f32x4 c) { return __builtin_amdgcn_mfma_f32_16x16x32_bf16(a, b, c, 0, 0, 0); }
DEVI bf16x8 ldg_frag(const bf16_t* p) { return *reinterpret_cast<const bf16x8*>(p); }

DEVI void rms_row_bf16(const float* __restrict__ xr, const float* __restrict__ g, bf16_t* __restrict__ dst, int lane) {
    float4 v[4]; float ss = 0.f;
#pragma unroll
    for (int i = 0; i < 4; ++i) { v[i] = reinterpret_cast<const float4*>(xr)[lane + 64 * i]; ss += v[i].x * v[i].x + v[i].y * v[i].y + v[i].z * v[i].z + v[i].w * v[i].w; }
    ss = wave_sum(ss);
    const float r = rsqrtf(ss * (1.f / 1024.f) + 1e-6f);
#pragma unroll
    for (int i = 0; i < 4; ++i) {
        const float4 gg = reinterpret_cast<const float4*>(g)[lane + 64 * i];
        uint2 o; o.x = pack2(v[i].x * r * gg.x, v[i].y * r * gg.y); o.y = pack2(v[i].z * r * gg.z, v[i].w * r * gg.w);
        reinterpret_cast<uint2*>(dst)[lane + 64 * i] = o;
    }
}

DEVI void transpose_tile(const float* __restrict__ src, int Nsrc, bf16_t* __restrict__ dst, int nt, int kt, int mode, float* lds) {
    const int tid = LTID, tx = tid & 63, ty = tid >> 6;
    const int np = nt * 64 + tx;
    int col = np; bool valid = true;
    if (mode == 1) {
        if (np < 3072) col = np; else if (np < 3584) col = np + 16; else if (np < 3600) col = np - 512; else { valid = false; col = 0; }
    }
#pragma unroll 4
    for (int kk = ty; kk < 64; kk += 4) {
        lds[kk * 65 + tx] = valid ? src[(size_t)(kt * 64 + kk) * Nsrc + col] : 0.f;
    }
    __syncthreads();
    const int nl = tid >> 2, kq = tid & 3;
    unsigned pk[8];
#pragma unroll
    for (int i = 0; i < 8; ++i) pk[i] = pack2(lds[(kq * 16 + 2 * i) * 65 + nl], lds[(kq * 16 + 2 * i + 1) * 65 + nl]);
    uint4* d = reinterpret_cast<uint4*>(dst + (size_t)(nt * 64 + nl) * 1024 + kt * 64 + kq * 16);
    d[0] = make_uint4(pk[0], pk[1], pk[2], pk[3]);
    d[1] = make_uint4(pk[4], pk[5], pk[6], pk[7]);
    __syncthreads();
}

DEVI void convert8(const float* __restrict__ src, bf16_t* __restrict__ dst, size_t idx8) {
    const float4 a = reinterpret_cast<const float4*>(src)[idx8 * 2], b = reinterpret_cast<const float4*>(src)[idx8 * 2 + 1];
    reinterpret_cast<uint4*>(dst)[idx8] = make_uint4(pack2(a.x, a.y), pack2(a.z, a.w), pack2(b.x, b.y), pack2(b.z, b.w));
}

DEVI int pack_i8x4(float a, float b, float c, float d) {
    const int ia = (int)rintf(a), ib = (int)rintf(b), ic = (int)rintf(c), id = (int)rintf(d);
    return (ia & 255) | ((ib & 255) << 8) | ((ic & 255) << 16) | (id << 24);
}
DEVI void quant_row_i8(const float* __restrict__ xr, unsigned char* __restrict__ dst_table, int row, float* __restrict__ descale, int lane) {
    float4 v[4]; float am = 0.f;
#pragma unroll
    for (int i = 0; i < 4; ++i) { v[i] = reinterpret_cast<const float4*>(xr)[lane + 64 * i]; am = fmaxf(am, fmaxf(fmaxf(fabsf(v[i].x), fabsf(v[i].y)), fmaxf(fabsf(v[i].z), fabsf(v[i].w)))); }
    am = wave_max(am);
    const float sc = am > 0.f ? 127.f / am : 1.f;
#pragma unroll
    for (int i = 0; i < 4; ++i) {
        const int w = lane + 64 * i;
        reinterpret_cast<int*>(dst_table)[(size_t)(w >> 5) * (16384 * 32) + (size_t)row * 32 + (w & 31)] = pack_i8x4(v[i].x * sc, v[i].y * sc, v[i].z * sc, v[i].w * sc);
    }
    if (lane == 0) *descale = am > 0.f ? am * (1.f / 127.f) : 1.f;
}
DEVI void quant_row_fp8(const float* __restrict__ xr, unsigned char* __restrict__ dst_table, int row, float* __restrict__ descale, int lane) {
    float4 v[4]; float am = 0.f;
#pragma unroll
    for (int i = 0; i < 4; ++i) { v[i] = reinterpret_cast<const float4*>(xr)[lane + 64 * i]; am = fmaxf(am, fmaxf(fmaxf(fabsf(v[i].x), fabsf(v[i].y)), fmaxf(fabsf(v[i].z), fabsf(v[i].w)))); }
    am = wave_max(am);
    const float sc = am > 0.f ? 448.f / am : 1.f;
#pragma unroll
    for (int i = 0; i < 4; ++i) {
        const float a = fminf(fmaxf(v[i].x * sc, -448.f), 448.f), b = fminf(fmaxf(v[i].y * sc, -448.f), 448.f);
        const float c = fminf(fmaxf(v[i].z * sc, -448.f), 448.f), d = fminf(fmaxf(v[i].w * sc, -448.f), 448.f);
        int pk = __builtin_amdgcn_cvt_pk_fp8_f32(a, b, 0, false);
        pk = __builtin_amdgcn_cvt_pk_fp8_f32(c, d, pk, true);
        const int w = lane + 64 * i;
        reinterpret_cast<int*>(dst_table)[(size_t)(w >> 5) * (16384 * 32) + (size_t)row * 32 + (w & 31)] = pk;
    }
    if (lane == 0) *descale = am > 0.f ? am * (1.f / 448.f) : 1.f;
}

constexpr int P0_XN = 8192, P0_WIN = 60 * 16, P0_WOUT = 16 * 16, P0_WQ = 32 * 16, P0_UV = 8192, P0_SK = 128, P0_LB = 1;
constexpr int P0_UNITS = P0_XN + P0_WIN + P0_WOUT + P0_WQ + P0_UV + P0_SK + P0_LB;

DEVI void phase0_unit(const Params& p, int u, char* smem) {
    const int tid = LTID, lane = tid & 63, w = tid >> 6;
    unsigned char* ws = p.ws;
    if (u < P0_XN) {
        const int row = u * 4 + w;
        rms_row_bf16(p.x + (size_t)row * DM, p.norm1_g, reinterpret_cast<bf16_t*>(ws + OFF_XN) + (size_t)row * DM, lane);
        return;
    }
    u -= P0_XN;
    if (u < P0_WIN) { transpose_tile(p.w_in, 3600, reinterpret_cast<bf16_t*>(ws + OFF_WIN), u / 16, u % 16, 1, reinterpret_cast<float*>(smem)); return; }
    u -= P0_WIN;
    if (u < P0_WOUT) { transpose_tile(p.w_out, 1024, reinterpret_cast<bf16_t*>(ws + OFF_WOUT), u / 16, u % 16, 0, reinterpret_cast<float*>(smem)); return; }
    u -= P0_WOUT;
    if (u < P0_WQ) { transpose_tile(p.w_q, 2048, reinterpret_cast<bf16_t*>(ws + OFF_WQ), u / 16, u % 16, 0, reinterpret_cast<float*>(smem)); return; }
    u -= P0_WQ;
    if (u < P0_UV) {
        const bool isv = u >= 4096; const int row = (isv ? u - 4096 : u) * 4 + w;
        if (isv) quant_row_fp8(p.peer_v + (size_t)row * DM, ws + OFF_V8, row, reinterpret_cast<float*>(ws + OFF_VS) + row, lane);
        else quant_row_i8(p.peer_u + (size_t)row * DM, ws + OFF_U8, row, reinterpret_cast<float*>(ws + OFF_US) + row, lane);
        return;
    }
    u -= P0_UV;
    if (u < P0_SK) { convert8(p.sub_keys, reinterpret_cast<bf16_t*>(ws + OFF_SK), (size_t)u * 256 + tid); return; }
    float* lb = reinterpret_cast<float*>(ws + OFF_LB);
    for (int n = tid; n < 512; n += 256) {
        const float l0 = p.hg_lower[n], l1 = p.hg_lower[512 + n];
        const float mx = fmaxf(l0, l1); const float e0 = __expf(l0 - mx), e1 = __expf(l1 - mx);
        lb[n] = e0 / (e0 + e1);
    }
}

namespace pg8 {
#define PG8_LAS __attribute__((address_space(3)))
typedef unsigned short bf16_t;
typedef short bf16x8 __attribute__((ext_vector_type(8)));
typedef float f32x4 __attribute__((ext_vector_type(4)));
typedef unsigned u32x4 __attribute__((ext_vector_type(4)));
constexpr int BM = 256, BK = 64, HALF = 128, HTB = HALF * BK * 2  , STAGE_BYTES = 8 * HTB, NXCD = 8, WGM = 8;

__host__ __device__ __forceinline__ int lds_byte(int r, int c) { const int st = (r >> 4) * 2 + (c >> 5), rr = r & 15, cc = c & 31, ob = rr * 64 + cc * 2; return st * 1024 + (ob ^ (((ob >> 9) & 1) << 5)); }
__host__ __device__ __forceinline__ void stage_rc(int b, int& R, int& C) { const int st = b / 1024, sb = b % 1024, swz = sb ^ (((sb >> 9) & 1) << 5); R = (st >> 1) * 16 + swz / 64; C = (st & 1) * 32 + (swz % 64) / 2; }
__host__ __device__ __forceinline__ int perm32(int rho) { const int n = rho >> 4, i = rho & 15; return 8 * (i >> 2) + 4 * n + (i & 3); }

struct Unit { int pm, pn; };
struct Gemm { const bf16_t* A; const bf16_t* Bt; int M, N, K; };

struct StaticOrder {
    int nM, nN, nwg, G, c;
    __host__ __device__ void init(int M, int N, int G_, int c_) { nM = M / BM; nN = N / BM; nwg = nM * nN; G = G_; c = c_; }
    __host__ __device__ bool next(int i, Unit& u) const {
        const long L = (long)i * G + c; if (L >= nwg) return false;
        int wgid = (int)L; { const int q = nwg / NXCD, r = nwg % NXCD, xcd = wgid % NXCD, off = wgid / NXCD; wgid = (xcd < r ? xcd * (q + 1) : r * (q + 1) + (xcd - r) * q) + off; }
        const int nig = WGM * nN, gid = wgid / nig, fm = gid * WGM, gsz = (nM - fm) < WGM ? (nM - fm) : WGM;
        u.pm = fm + ((wgid % nig) % gsz); u.pn = (wgid % nig) / gsz; return true;
    }
    __device__ __forceinline__ void a_ready(const Unit&) const {}
    __device__ __forceinline__ void done(const Unit&) const {}
};
__device__ __forceinline__ unsigned cvt_pk_bf16(float lo, float hi) { unsigned r; asm volatile("v_cvt_pk_bf16_f32 %0, %1, %2" : "=v"(r) : "v"(lo), "v"(hi)); return r; }
typedef float f32x2 __attribute__((ext_vector_type(2)));
template <class Epi, class Sched, bool STAMP = false>
__device__ __forceinline__ void gemm_phase(PG8_LAS unsigned char* lds, const Gemm g, const Sched& S, const Epi& E, unsigned long long* stamps) {
    const int tid = threadIdx.x, wid = __builtin_amdgcn_readfirstlane(tid >> 6), lane = tid & 63, wr = wid >> 2, wc = wid & 3, fr = lane & 15, fq = lane >> 4;
    const int K = g.K, nt = K / BK;
    int ts_lo = 0, ts_hi = 0, nts = 0; const unsigned long long rt_entry = STAMP ? (unsigned long long)wall_clock64() : 0ull;
#define PG8_STAMP() do { if (STAMP && wid == 0 && nts < 64) { const unsigned long long _c = (unsigned long long)clock64(); \
        ts_lo = (lane == nts) ? (int)(unsigned)_c : ts_lo; ts_hi = (lane == nts) ? (int)(unsigned)(_c >> 32) : ts_hi; ++nts; } } while (0)
    PG8_STAMP();
    unsigned voffA[2], voffB[2];
#pragma unroll
    for (int i = 0; i < 2; ++i) { int R, C; stage_rc(tid * 16 + i * 8192, R, C); const int Rb = Epi::PERM ? ((R & ~31) + perm32(R & 31)) : R;
        voffA[i] = (unsigned)(R * K + C) * 2u; voffB[i] = (unsigned)(Rb * K + C) * 2u; }
    const size_t kstep = (size_t)(BK * 2);
    const size_t hstep = (size_t)HALF * K * 2;
    const size_t tstep = 2 * hstep;
    const unsigned ldsw = (unsigned)wid * 1024u;
    const int aoff = lds_byte(wr * 64 + fr, fq * 8), boff = lds_byte(wc * 32 + fr, fq * 8);
#define PG8_SA(b, h) (((b) * 2 + (h)) * HTB)
#define PG8_SB(b, h) ((4 + (b) * 2 + (h)) * HTB)
#define PG8_STAGE(bufoff, gbase, voff) do { _Pragma("unroll") for (int _i = 0; _i < 2; ++_i) \
        __builtin_amdgcn_global_load_lds((const unsigned*)((const char*)(gbase) + (voff)[_i]), (PG8_LAS unsigned*)(lds + (bufoff) + ldsw + _i * 8192), 16, 0, 0); } while (0)
#define PG8_LDA(dst, b, h) do { _Pragma("unroll") for (int m = 0; m < 4; ++m) _Pragma("unroll") for (int k = 0; k < 2; ++k) dst[m][k] = *(const PG8_LAS bf16x8*)(lds + PG8_SA(b, h) + aoff + m * 2048 + k * 1024); } while (0)
#define PG8_LDB(dst, b, h) do { _Pragma("unroll") for (int n = 0; n < 2; ++n) _Pragma("unroll") for (int k = 0; k < 2; ++k) dst[n][k] = *(const PG8_LAS bf16x8*)(lds + PG8_SB(b, h) + boff + n * 2048 + k * 1024); } while (0)
#define PG8_MMA(ai, bj, At, Bt) do { __builtin_amdgcn_s_setprio(1); _Pragma("unroll") for (int m = 0; m < 4; ++m) _Pragma("unroll") for (int n = 0; n < 2; ++n) _Pragma("unroll") for (int k = 0; k < 2; ++k) \
        acc[ai][bj][m][n] = __builtin_amdgcn_mfma_f32_16x16x32_bf16(Bt[n][k], At[m][k], acc[ai][bj][m][n], 0, 0, 0); __builtin_amdgcn_s_setprio(0); } while (0)
#define PG8_WAIT_V(n) asm volatile("s_waitcnt vmcnt(" #n ")" ::: "memory")
#define PG8_WAIT_L(n) asm volatile("s_waitcnt lgkmcnt(" #n ")" ::: "memory")
#define PG8_BAR __builtin_amdgcn_s_barrier()
#define PG8_SCHED __builtin_amdgcn_sched_barrier(0)
    Unit cur, nxt; int ui = 0;
    if (!S.next(0, cur)) return;
    f32x4 acc[2][2][4][2];
#pragma unroll
    for (int a = 0; a < 2; ++a)
#pragma unroll
        for (int b = 0; b < 2; ++b)
#pragma unroll
            for (int m = 0; m < 4; ++m)
#pragma unroll
                for (int n = 0; n < 2; ++n) acc[a][b][m][n] = (f32x4){0.f, 0.f, 0.f, 0.f};
    bf16x8 At[4][2], B0[2][2], B1[2][2];
    const char* cA = (const char*)g.A + (size_t)cur.pm * tstep; const char* cB = (const char*)g.Bt + (size_t)cur.pn * tstep;
    S.a_ready(cur);
    PG8_STAGE(PG8_SB(0, 0), cB, voffB); PG8_STAGE(PG8_SA(0, 0), cA, voffA); PG8_STAGE(PG8_SB(0, 1), cB + hstep, voffB); PG8_STAGE(PG8_SA(0, 1), cA + hstep, voffA);
    if (wr == 1) PG8_BAR;
    PG8_WAIT_V(4); PG8_BAR;
    PG8_STAGE(PG8_SB(1, 0), cB + kstep, voffB); PG8_STAGE(PG8_SA(1, 0), cA + kstep, voffA); PG8_STAGE(PG8_SB(1, 1), cB + hstep + kstep, voffB);
    PG8_WAIT_V(6); PG8_BAR;
    PG8_STAMP();
    for (;;) {
        const bool has_next = S.next(ui + 1, nxt);
        const char* nA = has_next ? (const char*)g.A + (size_t)nxt.pm * tstep : cA; const char* nB = has_next ? (const char*)g.Bt + (size_t)nxt.pn * tstep : cB;
        for (int t = 0; t < nt; t += 2) {
            const bool last = (t == nt - 2);
            const char* a1 = cA + (size_t)(t + 1) * kstep;
            const char* a2 = last ? nA : cA + (size_t)(t + 2) * kstep; const char* b2 = last ? nB : cB + (size_t)(t + 2) * kstep;
            const char* a3 = a2 + kstep; const char* b3 = b2 + kstep;
            if (last && has_next) S.a_ready(nxt);
            PG8_LDB(B0, 0, 0); PG8_SCHED; PG8_LDA(At, 0, 0); PG8_STAGE(PG8_SA(1, 1), a1 + hstep, voffA);
            PG8_WAIT_L(8); PG8_BAR; PG8_WAIT_L(0); PG8_MMA(0, 0, At, B0); PG8_BAR; PG8_SCHED;
            PG8_LDB(B1, 0, 1); PG8_STAGE(PG8_SB(0, 0), b2, voffB);
            PG8_BAR; PG8_WAIT_L(0); PG8_MMA(0, 1, At, B1); PG8_BAR;
            PG8_LDA(At, 0, 1); PG8_STAGE(PG8_SA(0, 0), a2, voffA);
            PG8_BAR; PG8_WAIT_L(0); PG8_MMA(1, 0, At, B0); PG8_BAR; PG8_SCHED;
            PG8_STAGE(PG8_SB(0, 1), b2 + hstep, voffB);
            PG8_WAIT_V(6); PG8_BAR; PG8_MMA(1, 1, At, B1); PG8_BAR;
            PG8_LDB(B0, 1, 0); PG8_SCHED; PG8_LDA(At, 1, 0); PG8_STAGE(PG8_SA(0, 1), a2 + hstep, voffA);
            PG8_WAIT_L(8); PG8_BAR; PG8_WAIT_L(0); PG8_MMA(0, 0, At, B0); PG8_BAR; PG8_SCHED;
            PG8_LDB(B1, 1, 1); PG8_STAGE(PG8_SB(1, 0), b3, voffB);
            PG8_BAR; PG8_WAIT_L(0); PG8_MMA(0, 1, At, B1); PG8_BAR;
            PG8_LDA(At, 1, 1); PG8_STAGE(PG8_SA(1, 0), a3, voffA);
            PG8_BAR; PG8_WAIT_L(0); PG8_MMA(1, 0, At, B0); PG8_BAR; PG8_SCHED;
            PG8_STAGE(PG8_SB(1, 1), b3 + hstep, voffB);
            PG8_WAIT_V(6); PG8_BAR; PG8_MMA(1, 1, At, B1); PG8_BAR;
        }
        PG8_STAMP();
        if constexpr (!Epi::AFTER_DRAIN) { E(acc, cur, wr, wc, fr, fq); S.done(cur); }
        PG8_STAMP();
        if (!has_next) break;
#pragma unroll
        for (int a = 0; a < 2; ++a)
#pragma unroll
            for (int b = 0; b < 2; ++b)
#pragma unroll
                for (int m = 0; m < 4; ++m)
#pragma unroll
                    for (int n = 0; n < 2; ++n) acc[a][b][m][n] = (f32x4){0.f, 0.f, 0.f, 0.f};
        cur = nxt; cA = nA; cB = nB; ++ui;
    }
    PG8_WAIT_V(0);
    if (wr == 0) PG8_BAR;
    PG8_BAR;
    if constexpr (Epi::AFTER_DRAIN) { E.fused(acc, cur, wr, wc, fr, fq, lds, wid, lane); S.done(cur); }
    PG8_STAMP();
    if (STAMP && wid == 0) { stamps[lane] = lane < nts ? (((unsigned long long)(unsigned)ts_hi << 32) | (unsigned)ts_lo) : 0ull;
        if (lane == 62) stamps[62] = rt_entry; if (lane == 63) stamps[63] = (unsigned long long)wall_clock64(); }
#undef PG8_STAMP
#undef PG8_SA
#undef PG8_SB
#undef PG8_STAGE
#undef PG8_LDA
#undef PG8_LDB
#undef PG8_MMA
#undef PG8_WAIT_V
#undef PG8_WAIT_L
#undef PG8_BAR
#undef PG8_SCHED
}
}

DEVI uint4 pack8(const pg8::f32x4 a, const pg8::f32x4 b) { return make_uint4(pack2(a[0], a[1]), pack2(a[2], a[3]), pack2(b[0], b[1]), pack2(b[2], b[3])); }

constexpr int P1_N = IN_WP;
struct EpiInProj {
    static constexpr bool PERM = true, AFTER_DRAIN = false;
    unsigned char* ws;
    __device__ __forceinline__ void operator()(const pg8::f32x4 (&acc)[2][2][4][2], const pg8::Unit& u, int wr, int wc, int fr, int fq) const {
        const int row0 = u.pm * 256 + wr * 64 + fr;
        const int pn = u.pn;
        const int cl0 = wc * 32 + 8 * fq;
        bf16_t* dst; int ld, cbase, kind;
        if (pn < 2)       { dst = reinterpret_cast<bf16_t*>(ws + OFF_HQ);  ld = 512; cbase = pn * 256;        kind = 1; }
        else if (pn < 4)  { dst = reinterpret_cast<bf16_t*>(ws + OFF_HLF); ld = 512; cbase = (pn - 2) * 256;  kind = 2; }
        else if (pn < 6)  { dst = reinterpret_cast<bf16_t*>(ws + OFF_HV);  ld = 512; cbase = (pn - 4) * 256;  kind = 0; }
        else if (pn < 8)  { dst = reinterpret_cast<bf16_t*>(ws + OFF_HG);  ld = 512; cbase = (pn - 6) * 256;  kind = 1; }
        else if (pn == 8) { dst = reinterpret_cast<bf16_t*>(ws + OFF_GQ);  ld = 256; cbase = 0;               kind = 3; }
        else if (pn == 9) { dst = reinterpret_cast<bf16_t*>(ws + OFF_GK);  ld = 256; cbase = 0;               kind = 0; }
        else if (pn < 12) { dst = reinterpret_cast<bf16_t*>(ws + OFF_GV);  ld = 512; cbase = (pn - 10) * 256; kind = 0; }
        else if (pn < 14) { dst = reinterpret_cast<bf16_t*>(ws + OFF_GG);  ld = 512; cbase = (pn - 12) * 256; kind = 1; }
        else {
            if (wc == 0 && fq < 2) {
                float* gl = reinterpret_cast<float*>(ws + OFF_GLOW);
#pragma unroll
                for (int ai = 0; ai < 2; ++ai)
#pragma unroll
                    for (int m = 0; m < 4; ++m) {
                        float* rp = gl + (size_t)(row0 + ai * 128 + m * 16) * 16 + 8 * fq;
                        *reinterpret_cast<pg8::f32x4*>(rp) = acc[ai][0][m][0];
                        *reinterpret_cast<pg8::f32x4*>(rp + 4) = acc[ai][0][m][1];
                    }
            }
            return;
        }
        float lbv[2][8];
#pragma unroll
        for (int bj = 0; bj < 2; ++bj)
#pragma unroll
            for (int j = 0; j < 8; ++j) lbv[bj][j] = 0.f;
        if (kind == 2) {
            const float* lb = reinterpret_cast<const float*>(ws + OFF_LB);
#pragma unroll
            for (int bj = 0; bj < 2; ++bj)
#pragma unroll
                for (int j = 0; j < 8; ++j) lbv[bj][j] = lb[cbase + bj * 128 + cl0 + j];
        }
#pragma unroll
        for (int ai = 0; ai < 2; ++ai)
#pragma unroll
            for (int m = 0; m < 4; ++m) {
                bf16_t* rowp = dst + (size_t)(row0 + ai * 128 + m * 16) * ld + cbase + cl0;
#pragma unroll
                for (int bj = 0; bj < 2; ++bj) {
                    pg8::f32x4 v0 = acc[ai][bj][m][0], v1 = acc[ai][bj][m][1];
                    if (kind == 1) {
#pragma unroll
                        for (int j = 0; j < 4; ++j) { v0[j] = silu_f(v0[j]); v1[j] = silu_f(v1[j]); }
                    } else if (kind == 2) {
#pragma unroll
                        for (int j = 0; j < 4; ++j) {
                            const float l0 = lbv[bj][j], l1 = lbv[bj][4 + j];
                            v0[j] = __logf(l0 + (1.f - l0) * __builtin_amdgcn_rcpf(1.f + __expf(-v0[j])));
                            v1[j] = __logf(l1 + (1.f - l1) * __builtin_amdgcn_rcpf(1.f + __expf(-v1[j])));
                        }
                    } else if (kind == 3) {
#pragma unroll
                        for (int j = 0; j < 4; ++j) { v0[j] *= 0.125f; v1[j] *= 0.125f; }
                    }
                    *reinterpret_cast<uint4*>(rowp + bj * 128) = pack8(v0, v1);
                }
            }
    }
};
struct EpiOutProj {
    static constexpr bool PERM = false, AFTER_DRAIN = false;
    const float* x; float* out;
    __device__ __forceinline__ void operator()(const pg8::f32x4 (&acc)[2][2][4][2], const pg8::Unit& u, int wr, int wc, int fr, int fq) const {
        const int row0 = u.pm * 256 + wr * 64 + fr, col0 = u.pn * 256 + wc * 32 + 4 * fq;
#pragma unroll
        for (int ai = 0; ai < 2; ++ai)
#pragma unroll
            for (int m = 0; m < 4; ++m) {
                const size_t ro = (size_t)(row0 + ai * 128 + m * 16) * DM + col0;
#pragma unroll
                for (int bj = 0; bj < 2; ++bj)
#pragma unroll
                    for (int n = 0; n < 2; ++n) {
                        const pg8::f32x4 xv = *reinterpret_cast<const pg8::f32x4*>(x + ro + bj * 128 + n * 16);
                        *reinterpret_cast<pg8::f32x4*>(out + ro + bj * 128 + n * 16) = xv + acc[ai][bj][m][n];
                    }
            }
    }
};
struct EpiQ {
    static constexpr bool PERM = true, AFTER_DRAIN = false;
    bf16_t* Q;
    __device__ __forceinline__ void operator()(const pg8::f32x4 (&acc)[2][2][4][2], const pg8::Unit& u, int wr, int wc, int fr, int fq) const {
        const int row0 = u.pm * 256 + wr * 64 + fr, col0 = u.pn * 256 + wc * 32 + 8 * fq;
#pragma unroll
        for (int ai = 0; ai < 2; ++ai)
#pragma unroll
            for (int m = 0; m < 4; ++m) {
                bf16_t* rowp = Q + (size_t)(row0 + ai * 128 + m * 16) * 2048 + col0;
#pragma unroll
                for (int bj = 0; bj < 2; ++bj) *reinterpret_cast<uint4*>(rowp + bj * 128) = pack8(acc[ai][bj][m][0], acc[ai][bj][m][1]);
            }
    }
};
template <class Epi>
DEVI void run_gemm(const bf16_t* A, const bf16_t* Bt, int N, const Epi& E, char* smem) {
    pg8::Gemm g{A, Bt, M_TOK, N, 1024};
#if PROBE_GEMM_DUP
    struct DupOrder : pg8::StaticOrder { __host__ __device__ bool next(int i, pg8::Unit& u) const { return pg8::StaticOrder::next(i >> 1, u); } };
    DupOrder S; S.init(M_TOK, N, (int)gridDim.x, (int)blockIdx.x);
    pg8::gemm_phase<Epi, DupOrder, false>((PG8_LAS unsigned char*)smem, g, S, E, nullptr);
#else
    pg8::StaticOrder S; S.init(M_TOK, N, (int)gridDim.x, (int)blockIdx.x);
    pg8::gemm_phase<Epi, pg8::StaticOrder, false>((PG8_LAS unsigned char*)smem, g, S, E, nullptr);
#endif
    __builtin_amdgcn_s_waitcnt(0);
}

constexpr int P2_UNITS = 512 * 3;
DEVI float logsigmoid_f(float z) { return fminf(z, 0.f) - __logf(1.f + __expf(-fabsf(z))); }

template <bool DRY>
DEVI void phase2_unit_t(const Params& p, int u, char* smem) {
    unsigned char* ws = p.ws;
    const int tid = LTID;
    const int cidx = u / 3, part = u % 3;
    const size_t row0 = (size_t)cidx * 64;
    if (part >= 3) {
        const bool isg = part >= 5; const int n = ((part - 3) & 1) * 256 + tid;
        const bf16_t* V = reinterpret_cast<const bf16_t*>(ws + (isg ? OFF_GV : OFF_HV));
        bf16_t* VT = reinterpret_cast<bf16_t*>(ws + (isg ? OFF_GVT : OFF_HVT));
#pragma unroll 1
        for (int hf = 0; hf < 4; ++hf) {
            unsigned short vb[16];
#pragma unroll
            for (int r = 0; r < 16; ++r) vb[r] = V[(row0 + hf * 16 + r) * 512 + n];
#pragma unroll
            for (int r8 = 0; r8 < 2; ++r8) {
                unsigned pk[4];
#pragma unroll
                for (int rr = 0; rr < 8; ++rr) {
                    const unsigned short b = vb[r8 * 8 + rr];
                    if (rr & 1) pk[rr >> 1] |= ((unsigned)b << 16); else pk[rr >> 1] = b;
                }
                *reinterpret_cast<uint4*>(VT + ((size_t)cidx * 512 + n) * 64 + hf * 16 + r8 * 8) = make_uint4(pk[0], pk[1], pk[2], pk[3]);
            }
        }
        return;
    }
    if (part < 2) {
        const int n = part * 256 + tid;
        bf16_t* HQ = reinterpret_cast<bf16_t*>(ws + OFF_HQ);
        bf16_t* HLF = reinterpret_cast<bf16_t*>(ws + OFF_HLF);
        float Gl = 0.f;
#pragma unroll 16
        for (int r = 0; r < 64; ++r) Gl += bf2f(HLF[(row0 + r) * 512 + n]);
        float G = 0.f;
#pragma unroll 1
        for (int hf = 0; hf < 4; ++hf) {
            unsigned short lfb[16], qb[16];
#pragma unroll
            for (int r = 0; r < 16; ++r) { lfb[r] = HLF[(row0 + hf * 16 + r) * 512 + n]; qb[r] = HQ[(row0 + hf * 16 + r) * 512 + n]; }
#pragma unroll
            for (int r8 = 0; r8 < 2; ++r8) {
                unsigned pk[4];
#pragma unroll
                for (int rr = 0; rr < 8; ++rr) {
                    const int r = r8 * 8 + rr;
                    const size_t idx = (row0 + hf * 16 + r) * 512 + n;
                    const float lf = bf2f(lfb[r]);
                    G += lf;
                    const float key = 1.f - __expf(lf);
                    const unsigned short bq = f2bf(bf2f(qb[r]) * __expf(G));
                    const unsigned short bk = f2bf(key * __expf(-G));
                    if (DRY) { reinterpret_cast<bf16_t*>(ws + OFF_XN)[idx] = bq; reinterpret_cast<bf16_t*>(ws + OFF_XN + 32 * MiB)[idx] = bk; } else { HQ[idx] = bq; HLF[idx] = bk; }
                    if (rr & 1) pk[rr >> 1] |= ((unsigned)bk << 16); else pk[rr >> 1] = bk;
                }
            }
        }
        reinterpret_cast<float*>(DRY ? reinterpret_cast<unsigned char*>(p.out) + 64 * MiB : ws + OFF_DECH)[(size_t)cidx * 512 + n] = __expf(Gl);
    } else {
        const int n = tid;
        bf16_t* GQ = reinterpret_cast<bf16_t*>(ws + OFF_GQ);
        bf16_t* GK = reinterpret_cast<bf16_t*>(ws + OFF_GK);
        const float* GL = reinterpret_cast<const float*>(ws + OFF_GLOW);
        float wg[16];
#pragma unroll
        for (int j = 0; j < 16; ++j) wg[j] = p.gla_wg[j * 256 + n];
        const float bg = p.gla_bg[n];
        float Gl = 0.f, G = 0.f;
#pragma unroll 1
        for (int hf = 0; hf < 4; ++hf) {
            unsigned short qb[16], kb[16]; float lgv[16];
#pragma unroll
            for (int r = 0; r < 16; ++r) { qb[r] = GQ[(row0 + hf * 16 + r) * 256 + n]; kb[r] = GK[(row0 + hf * 16 + r) * 256 + n]; }
#pragma unroll
            for (int r = 0; r < 16; ++r) {
                const float4* g4 = reinterpret_cast<const float4*>(GL + (row0 + hf * 16 + r) * 16);
                float z = bg;
#pragma unroll
                for (int j = 0; j < 4; ++j) { const float4 t = g4[j]; z += t.x * wg[4 * j] + t.y * wg[4 * j + 1] + t.z * wg[4 * j + 2] + t.w * wg[4 * j + 3]; }
                lgv[r] = logsigmoid_f(z) * (1.f / 16.f);
            }
#pragma unroll
            for (int r8 = 0; r8 < 2; ++r8) {
                unsigned pk[4];
#pragma unroll
                for (int rr = 0; rr < 8; ++rr) {
                    const int r = r8 * 8 + rr;
                    G += lgv[r];
                    const size_t idx = (row0 + hf * 16 + r) * 256 + n;
                    const unsigned short bq = f2bf(bf2f(qb[r]) * __expf(G));
                    const unsigned short bk = f2bf(bf2f(kb[r]) * __expf(-G));
                    GQ[idx] = bq; GK[idx] = bk;
                    if (rr & 1) pk[rr >> 1] |= ((unsigned)bk << 16); else pk[rr >> 1] = bk;
                }
            }
        }
        Gl = G;
        reinterpret_cast<float*>(ws + OFF_DECG)[(size_t)cidx * 256 + n] = __expf(Gl);
    }
}

DEVI void phase2_unit(const Params& p, int u, char* smem) { phase2_unit_t<false>(p, u, smem); }
DEVI void phase2_dry_unit(const Params& p, int u, char* smem) { if ((u % 7) < 2) phase2_unit_t<true>(p, u, smem); }

DEVI unsigned off_b(unsigned row, unsigned ch) { return 256u * row + 16u * (ch ^ (((row & 3u) << 2) | ((row >> 2) & 3u))); }
DEVI unsigned tr_addr16(unsigned lane, unsigned c, unsigned ks, unsigned t) {
    const unsigned g = lane >> 4, q = (lane & 15u) >> 2, pp = lane & 3u;
    return off_b(32u * ks + 8u * g + 4u * t + q, 2u * c + (pp >> 1)) + 8u * (pp & 1u);
}
typedef unsigned short u16x4_t __attribute__((ext_vector_type(4)));
DEVI bf16x8 tr_frag(unsigned base, unsigned lane, unsigned c, unsigned ks) {
    u16x4_t a, b;
    asm volatile("ds_read_b64_tr_b16 %0, %2\n\tds_read_b64_tr_b16 %1, %3\n\ts_waitcnt lgkmcnt(0)" : "=&v"(a), "=&v"(b) : "v"(base + tr_addr16(lane, c, ks, 0)), "v"(base + tr_addr16(lane, c, ks, 1)) : "memory");
    bf16x8 r;
    r[0] = (short)a[0]; r[1] = (short)a[1]; r[2] = (short)a[2]; r[3] = (short)a[3]; r[4] = (short)b[0]; r[5] = (short)b[1]; r[6] = (short)b[2]; r[7] = (short)b[3];
    return r;
}
DEVI bf16x8 row_frag(const char* tile, unsigned lane, unsigned rb, unsigned s) { return *reinterpret_cast<const bf16x8*>(tile + off_b((lane & 15u) + 16u * rb, 4u * s + (lane >> 4))); }
DEVI void fill_tile64(char* tile, const bf16_t* __restrict__ g, int ldg) {
#pragma unroll
    for (int i = 0; i < 4; ++i) {
        const int n = LTID + 256 * i, row = n >> 4, ch = n & 15;
        *reinterpret_cast<uint4*>(tile + off_b(row, ch)) = *reinterpret_cast<const uint4*>(g + (size_t)row * ldg + ch * 8);
    }
}
DEVI void fill_tile64x64(char* tile, const bf16_t* __restrict__ g, int ldg) {
#pragma unroll
    for (int i = 0; i < 2; ++i) {
        const int n = LTID + 256 * i, row = n >> 3, ch = n & 7;
        *reinterpret_cast<uint4*>(tile + off_b(row, ch)) = *reinterpret_cast<const uint4*>(g + (size_t)row * ldg + ch * 8);
    }
}

constexpr int P3_UNITS = 4096;
template <int DK>
DEVI void kv_unit(const Params& p, int sidx, int c, char* smem) {
    unsigned char* ws = p.ws;
    const int lane = LTID & 63, w = LTID >> 6;
    const int b = sidx >> 2, h = sidx & 3;
    const int cidx = b * 128 + c;
    constexpr int NDB = DK / 16;
    const bf16_t* Kn = reinterpret_cast<const bf16_t*>(ws + (DK == 128 ? OFF_HLF : OFF_GK)) + (size_t)cidx * 64 * (4 * DK) + h * DK;
    const bf16_t* V = reinterpret_cast<const bf16_t*>(ws + (DK == 128 ? OFF_HV : OFF_GV)) + (size_t)cidx * 64 * 512 + h * 128;
    const float* DEC = reinterpret_cast<const float*>(ws + (DK == 128 ? OFF_DECH : OFF_DECG)) + (size_t)cidx * (4 * DK) + h * DK;
    bf16_t* ST = reinterpret_cast<bf16_t*>(reinterpret_cast<unsigned char*>(p.out) + (DK == 128 ? OUT_STH : OUT_STG)) + ((size_t)sidx * 128 + c) * (128 * DK);
    f32x4 acc[NDB][2];
#pragma unroll
    for (int i = 0; i < NDB; ++i) { acc[i][0] = f32x4{0, 0, 0, 0}; acc[i][1] = f32x4{0, 0, 0, 0}; }
    const int fo = (lane & 15) * 64 + 8 * (lane >> 4);
    fill_tile64(smem, V, 512);
    if (DK == 128) fill_tile64(smem + 16384, Kn, 512); else fill_tile64x64(smem + 16384, Kn, 256);
    __syncthreads();
    const unsigned tbase = (unsigned)(size_t)smem, kbase = tbase + 16384u;
#pragma unroll
    for (int ks = 0; ks < 2; ++ks) {
        bf16x8 bv[2];
#pragma unroll
        for (int nb = 0; nb < 2; ++nb) bv[nb] = tr_frag(tbase, (unsigned)lane, (unsigned)(2 * w + nb), (unsigned)ks);
#pragma unroll
        for (int db = 0; db < NDB; ++db) {
            const bf16x8 ak = tr_frag(kbase, (unsigned)lane, (unsigned)db, (unsigned)ks);
            acc[db][0] = mfma16(ak, bv[0], acc[db][0]);
            acc[db][1] = mfma16(ak, bv[1], acc[db][1]);
        }
    }
#pragma unroll
    for (int db = 0; db < NDB; ++db) {
        const int d = db * 16 + 4 * (lane >> 4);
        const float4 dc = *reinterpret_cast<const float4*>(DEC + d);
#pragma unroll
        for (int nb = 0; nb < 2; ++nb) {
            const int dv = 32 * w + nb * 16 + (lane & 15);
            uint2 o; o.x = pack2(acc[db][nb][0] * dc.x, acc[db][nb][1] * dc.y); o.y = pack2(acc[db][nb][2] * dc.z, acc[db][nb][3] * dc.w);
            *reinterpret_cast<uint2*>(ST + (size_t)dv * DK + d) = o;
        }
    }
    __syncthreads();
}
DEVI void phase3_unit(const Params& p, int u, char* smem) {
    if (u < 2048) kv_unit<128>(p, u >> 7, u & 127, smem); else { u -= 2048; kv_unit<64>(p, u >> 7, u & 127, smem); }
}

constexpr int P4_UNITS = 384;
template <bool DRY>
DEVI void phase4_unit_t(const Params& p, int u, char* smem) {
    unsigned char* ws = p.ws;
    int e = u * 256 + LTID;
    bf16_t* base; bf16_t* sbase; const float* dec; size_t cstride; int decstride;
    if (e < 65536) {
        const int sidx = e >> 12, rem = e & 4095, dv = rem >> 5, d4 = (rem & 31) * 4;
        const int b = sidx >> 2, h = sidx & 3;
        base = reinterpret_cast<bf16_t*>(reinterpret_cast<unsigned char*>(p.out) + OUT_STH) + ((size_t)sidx * 128) * 16384 + dv * 128 + d4;
        sbase = DRY ? reinterpret_cast<bf16_t*>(ws + OFF_XN) + ((size_t)sidx * 128) * 16384 + dv * 128 + d4 : base;
        cstride = 16384;
        dec = reinterpret_cast<const float*>(ws + OFF_DECH) + (size_t)(b * 128) * 512 + h * 128 + d4; decstride = 512;
    } else {
        e -= 65536;
        const int sidx = e >> 11, rem = e & 2047, dv = rem >> 4, d4 = (rem & 15) * 4;
        const int b = sidx >> 2, h = sidx & 3;
        base = reinterpret_cast<bf16_t*>(reinterpret_cast<unsigned char*>(p.out) + OUT_STG) + ((size_t)sidx * 128) * 8192 + dv * 64 + d4;
        sbase = DRY ? reinterpret_cast<bf16_t*>(ws + OFF_KTH) + ((size_t)sidx * 128) * 8192 + dv * 64 + d4 : base;
        cstride = 8192;
        dec = reinterpret_cast<const float*>(ws + OFF_DECG) + (size_t)(b * 128) * 256 + h * 64 + d4; decstride = 256;
    }
    float s0 = 0.f, s1 = 0.f, s2 = 0.f, s3 = 0.f;
    for (int c8 = 0; c8 < 128; c8 += 8) {
        uint2 kv[8]; float4 dc[8];
#pragma unroll
        for (int i = 0; i < 8; ++i) { kv[i] = *reinterpret_cast<const uint2*>(base + (size_t)(c8 + i) * cstride); dc[i] = *reinterpret_cast<const float4*>(dec + (size_t)(c8 + i) * decstride); }
#pragma unroll
        for (int i = 0; i < 8; ++i) {
            uint2 o; o.x = pack2(s0, s1); o.y = pack2(s2, s3);
            *reinterpret_cast<uint2*>(sbase + (size_t)(c8 + i) * cstride) = o;
            s0 = dc[i].x * s0 + bflo(kv[i].x); s1 = dc[i].y * s1 + bfhi(kv[i].x);
            s2 = dc[i].z * s2 + bflo(kv[i].y); s3 = dc[i].w * s3 + bfhi(kv[i].y);
        }
    }
}

DEVI void phase4_unit(const Params& p, int u, char* smem) { phase4_unit_t<false>(p, u, smem); }
DEVI void phase4_dry_unit(const Params& p, int u, char* smem) { phase4_unit_t<true>(p, u, smem); }

constexpr int P5_UNITS = 4096;
constexpr int PL_PITCH = 72;
template <int DK>
DEVI void out_unit(const Params& p, int sidx, int c, char* smem) {
    unsigned char* ws = p.ws;
    const int lane = LTID & 63, w = LTID >> 6;
    const int b = sidx >> 2, h = sidx & 3;
    const int cidx = b * 128 + c;
    const size_t row0 = (size_t)cidx * 64;
    constexpr int LDQ = 4 * DK;
    const bf16_t* Qn = reinterpret_cast<const bf16_t*>(ws + (DK == 128 ? OFF_HQ : OFF_GQ)) + row0 * LDQ + h * DK;
    const bf16_t* Kn = reinterpret_cast<const bf16_t*>(ws + (DK == 128 ? OFF_HLF : OFF_GK)) + row0 * LDQ + h * DK;
    const bf16_t* V = reinterpret_cast<const bf16_t*>(ws + (DK == 128 ? OFF_HV : OFF_GV)) + row0 * 512 + h * 128;
    const bf16_t* ST = reinterpret_cast<const bf16_t*>(reinterpret_cast<const unsigned char*>(p.out) + (DK == 128 ? OUT_STH : OUT_STG)) + ((size_t)sidx * 128 + c) * (128 * DK);
    const bf16_t* GATE = reinterpret_cast<const bf16_t*>(ws + (DK == 128 ? OFF_HG : OFF_GG)) + row0 * 512 + h * 128;
    const float* ng = (DK == 128) ? p.hg_norm_g : p.gla_norm_g;
    bf16_t* MIX = reinterpret_cast<bf16_t*>(ws + OFF_MIX) + row0 * 1024 + (DK == 128 ? 0 : 512) + h * 128;
    bf16_t* PL = reinterpret_cast<bf16_t*>(smem);
    float* RED = reinterpret_cast<float*>(smem + 64 * PL_PITCH * 2);

    const int l15 = lane & 15, lg = lane >> 4;
    bf16x8 ast[DK / 32][2];
    uint2 gtv[4][2]; float4 g4v[2];
    char* vtile = smem + 16384;
    char* qtile = smem + 32768;
    char* ktile = smem + 49152;
    fill_tile64(vtile, V, 512);
    if (DK == 128) { fill_tile64(qtile, Qn, LDQ); fill_tile64(ktile, Kn, LDQ); } else { fill_tile64x64(qtile, Qn, LDQ); fill_tile64x64(ktile, Kn, LDQ); }
#pragma unroll
    for (int ks = 0; ks < DK / 32; ++ks) {
#pragma unroll
        for (int x = 0; x < 2; ++x) ast[ks][x] = ldg_frag(ST + (size_t)((2 * w + x) * 16 + l15) * DK + ks * 32 + 8 * lg);
    }
#pragma unroll
    for (int x = 0; x < 2; ++x) {
        g4v[x] = *reinterpret_cast<const float4*>(ng + (2 * w + x) * 16 + 4 * lg);
#pragma unroll
        for (int y = 0; y < 4; ++y) gtv[y][x] = *reinterpret_cast<const uint2*>(GATE + (size_t)(y * 16 + l15) * 512 + (2 * w + x) * 16 + 4 * lg);
    }
    __syncthreads();
    {
        bf16x8 bq[DK / 32];
#pragma unroll
        for (int ks = 0; ks < DK / 32; ++ks) bq[ks] = row_frag(qtile, (unsigned)lane, (unsigned)w, (unsigned)ks);
#pragma unroll
        for (int jb = 0; jb < 4; ++jb) {
            f32x4 a = f32x4{0, 0, 0, 0};
            if (jb <= w) {
#pragma unroll
                for (int ks = 0; ks < DK / 32; ++ks) {
                    const bf16x8 ak = row_frag(ktile, (unsigned)lane, (unsigned)jb, (unsigned)ks);
                    a = mfma16(ak, bq[ks], a);
                }
            }
            const int i = w * 16 + l15, j0 = jb * 16 + 4 * lg;
            const float v0 = (j0 + 0 <= i) ? a[0] : 0.f, v1 = (j0 + 1 <= i) ? a[1] : 0.f, v2 = (j0 + 2 <= i) ? a[2] : 0.f, v3 = (j0 + 3 <= i) ? a[3] : 0.f;
            uint2 o; o.x = pack2(v0, v1); o.y = pack2(v2, v3);
            *reinterpret_cast<uint2*>(PL + i * PL_PITCH + j0) = o;
        }
    }
    __syncthreads();
    f32x4 acc[2][4];
#pragma unroll
    for (int x = 0; x < 2; ++x)
#pragma unroll
        for (int y = 0; y < 4; ++y) acc[x][y] = f32x4{0, 0, 0, 0};
#pragma unroll
    for (int ks = 0; ks < 2; ++ks) {
        bf16x8 bp[4], avx[2];
#pragma unroll
        for (int x = 0; x < 2; ++x) avx[x] = tr_frag((unsigned)(size_t)vtile, (unsigned)lane, (unsigned)(2 * w + x), (unsigned)ks);
#pragma unroll
        for (int y = 0; y < 4; ++y) bp[y] = *reinterpret_cast<const bf16x8*>(PL + (y * 16 + l15) * PL_PITCH + ks * 32 + 8 * lg);
#pragma unroll
        for (int x = 0; x < 2; ++x)
#pragma unroll
            for (int y = 0; y < 4; ++y) acc[x][y] = mfma16(avx[x], bp[y], acc[x][y]);
    }
#pragma unroll
    for (int ks = 0; ks < DK / 32; ++ks) {
#pragma unroll
        for (int x = 0; x < 2; ++x)
#pragma unroll
            for (int y = 0; y < 4; ++y) acc[x][y] = mfma16(ast[ks][x], row_frag(qtile, (unsigned)lane, (unsigned)y, (unsigned)ks), acc[x][y]);
    }
    float ssq[4];
#pragma unroll
    for (int y = 0; y < 4; ++y) {
        float s = 0.f;
#pragma unroll
        for (int x = 0; x < 2; ++x)
#pragma unroll
            for (int r = 0; r < 4; ++r) s += acc[x][y][r] * acc[x][y][r];
        s += __shfl_xor(s, 16); s += __shfl_xor(s, 32);
        ssq[y] = s;
    }
    if (lg == 0) {
#pragma unroll
        for (int y = 0; y < 4; ++y) RED[w * 64 + y * 16 + l15] = ssq[y];
    }
    __syncthreads();
#pragma unroll
    for (int y = 0; y < 4; ++y) {
        const int i = y * 16 + l15;
        const float tot = RED[i] + RED[64 + i] + RED[128 + i] + RED[192 + i];
        const float rstd = rsqrtf(tot * (1.f / 128.f) + 1e-6f);
#pragma unroll
        for (int x = 0; x < 2; ++x) {
            const int dv = (2 * w + x) * 16 + 4 * lg;
            const float4 g4 = g4v[x];
            const uint2 gt = gtv[y][x];
            uint2 o;
            o.x = pack2(acc[x][y][0] * rstd * g4.x * bflo(gt.x), acc[x][y][1] * rstd * g4.y * bfhi(gt.x));
            o.y = pack2(acc[x][y][2] * rstd * g4.z * bflo(gt.y), acc[x][y][3] * rstd * g4.w * bfhi(gt.y));
            *reinterpret_cast<uint2*>(MIX + (size_t)i * 1024 + dv) = o;
        }
    }
    __syncthreads();
}
DEVI void phase5_unit(const Params& p, int u, char* smem) {
    if (u < 2048) out_unit<128>(p, u >> 7, u & 127, smem); else { u -= 2048; out_unit<64>(p, u >> 7, u & 127, smem); }
}

DEVI void rms_row_bf16_i8(const float* __restrict__ xr, const float* __restrict__ g, bf16_t* __restrict__ dst, unsigned char* __restrict__ dst8, float* __restrict__ descale, int lane) {
    float4 v[4]; float ss = 0.f;
#pragma unroll
    for (int i = 0; i < 4; ++i) { v[i] = reinterpret_cast<const float4*>(xr)[lane + 64 * i]; ss += v[i].x * v[i].x + v[i].y * v[i].y + v[i].z * v[i].z + v[i].w * v[i].w; }
    ss = wave_sum(ss);
    const float r = rsqrtf(ss * (1.f / 1024.f) + 1e-6f);
    float am = 0.f;
#pragma unroll
    for (int i = 0; i < 4; ++i) {
        const float4 gg = reinterpret_cast<const float4*>(g)[lane + 64 * i];
        v[i].x *= r * gg.x; v[i].y *= r * gg.y; v[i].z *= r * gg.z; v[i].w *= r * gg.w;
        uint2 o; o.x = pack2(v[i].x, v[i].y); o.y = pack2(v[i].z, v[i].w);
        reinterpret_cast<uint2*>(dst)[lane + 64 * i] = o;
        am = fmaxf(am, fmaxf(fmaxf(fabsf(v[i].x), fabsf(v[i].y)), fmaxf(fabsf(v[i].z), fabsf(v[i].w))));
    }
    am = wave_max(am);
    const float sc = am > 0.f ? 127.f / am : 1.f;
#pragma unroll
    for (int i = 0; i < 4; ++i) reinterpret_cast<int*>(dst8)[lane + 64 * i] = pack_i8x4(v[i].x * sc, v[i].y * sc, v[i].z * sc, v[i].w * sc);
    if (lane == 0) *descale = am > 0.f ? am * (1.f / 127.f) : 1.f;
}
constexpr int P7_UNITS = 8192;
DEVI void phase7_unit(const Params& p, int u, char* smem) {
    const int lane = LTID & 63, w = LTID >> 6;
    const int row = u * 4 + w;
    rms_row_bf16_i8(p.out + (size_t)row * DM, p.norm2_g, reinterpret_cast<bf16_t*>(p.ws + OFF_HN) + (size_t)row * DM,
                    p.ws + OFF_HN8 + (size_t)row * DM, reinterpret_cast<float*>(p.ws + OFF_HS) + row, lane);
}

using f32x16 = __attribute__((ext_vector_type(16))) float;
DEVI f32x16 mfma32(bf16x8 a, bf16x8 b, f32x16 c) { return __builtin_amdgcn_mfma_f32_32x32x16_bf16(a, b, c, 0, 0, 0); }
DEVI unsigned umax(unsigned a, unsigned b) { return a > b ? a : b; }
DEVI unsigned umin(unsigned a, unsigned b) { return a > b ? b : a; }
DEVI unsigned f2ord(float f) { const unsigned u = __float_as_uint(f); return u ^ ((unsigned)((int)u >> 31) | 0x80000000u); }
DEVI float ord2f(unsigned k) { return __uint_as_float((k & 0x80000000u) ? (k ^ 0x80000000u) : ~k); }

template <int BASE>
DEVI void sort16_desc(unsigned (&x)[64]) {
#pragma unroll
    for (int k = 2; k <= 16; k <<= 1) {
#pragma unroll
        for (int j = k >> 1; j > 0; j >>= 1) {
#pragma unroll
            for (int i = 0; i < 16; ++i) {
                const int l = i ^ j;
                if (l > i) {
                    const bool desc = ((i & k) == 0);
                    const unsigned a = x[BASE + i], b = x[BASE + l];
                    const unsigned hi = umax(a, b), lo = umin(a, b);
                    x[BASE + i] = desc ? hi : lo; x[BASE + l] = desc ? lo : hi;
                }
            }
        }
    }
}
template <int BASE>
DEVI void bmerge16_desc(unsigned (&x)[64]) {
#pragma unroll
    for (int j = 8; j > 0; j >>= 1) {
#pragma unroll
        for (int i = 0; i < 16; ++i) {
            const int l = i ^ j;
            if (l > i) { const unsigned a = x[BASE + i], b = x[BASE + l]; x[BASE + i] = umax(a, b); x[BASE + l] = umin(a, b); }
        }
    }
}
DEVI void top16_of_64(unsigned (&x)[64]) {
    sort16_desc<0>(x); sort16_desc<16>(x); sort16_desc<32>(x); sort16_desc<48>(x);
#pragma unroll
    for (int i = 0; i < 16; ++i) x[i] = umax(x[i], x[31 - i]);
    bmerge16_desc<0>(x);
#pragma unroll
    for (int i = 0; i < 16; ++i) x[32 + i] = umax(x[32 + i], x[63 - i]);
    bmerge16_desc<32>(x);
#pragma unroll
    for (int i = 0; i < 16; ++i) x[i] = umax(x[i], x[47 - i]);
    bmerge16_desc<0>(x);
}

DEVI void scores_top16(const char* sktile, const bf16_t* __restrict__ Qp, int lane, unsigned (&out)[16]) {
    const int r31 = lane & 31, hh = lane >> 5;
    f32x16 acc[4];
#pragma unroll
    for (int nb = 0; nb < 4; ++nb)
#pragma unroll
        for (int r = 0; r < 16; ++r) acc[nb][r] = 0.f;
#pragma unroll
    for (int ks = 0; ks < 8; ++ks) {
        const bf16x8 bq = ldg_frag(Qp + (size_t)r31 * 2048 + ks * 16 + 8 * hh);
#pragma unroll
        for (int nb = 0; nb < 4; ++nb) {
            const bf16x8 ak = *reinterpret_cast<const bf16x8*>(sktile + off_b((unsigned)(nb * 32 + r31), (unsigned)(2 * ks + hh)));
            acc[nb] = mfma32(ak, bq, acc[nb]);
        }
    }
    unsigned x[64];
    const unsigned hx = (unsigned)hh * 4u;
#pragma unroll
    for (int nb = 0; nb < 4; ++nb)
#pragma unroll
        for (int r = 0; r < 16; ++r) {
            const int nbase = nb * 32 + (r & 3) + 8 * (r >> 2);
            x[nb * 16 + r] = ((f2ord(acc[nb][r]) & ~127u) | (unsigned)(127 - nbase)) ^ hx;
        }
    top16_of_64(x);
    unsigned lo[16], hi[16];
#pragma unroll
    for (int i = 0; i < 16; ++i) { auto rr = __builtin_amdgcn_permlane32_swap(x[i], x[i], false, false); lo[i] = rr[0]; hi[i] = rr[1]; }
#pragma unroll
    for (int i = 0; i < 16; ++i) x[i] = umax(lo[i], hi[15 - i]);
    bmerge16_desc<0>(x);
#pragma unroll
    for (int i = 0; i < 16; ++i) out[i] = x[i];
}

DEVI void phase9_block(const Params& p, char* smem) {
    unsigned char* ws = p.ws;
    const int tid = threadIdx.x, lane = tid & 63, w = tid >> 6;
    const int h = blockIdx.x & 7, rank = blockIdx.x >> 3, nrank = ((int)gridDim.x - h + 7) >> 3;
    const int hh = lane >> 5;
    {
        const bf16_t* SK = reinterpret_cast<const bf16_t*>(ws + OFF_SK) + (size_t)(h * 2) * 128 * 128;
#pragma unroll
        for (int i = 0; i < 8; ++i) {
            const int nn = tid + 512 * i, tl = nn >> 11, row = (nn >> 4) & 127, ch = nn & 15;
            *reinterpret_cast<uint4*>(smem + tl * 32768 + off_b((unsigned)row, (unsigned)ch)) = *reinterpret_cast<const uint4*>(SK + (size_t)tl * 16384 + row * 128 + ch * 8);
        }
    }
    __syncthreads();
    unsigned* KL = reinterpret_cast<unsigned*>(smem + 65536) + w * 2048;
    for (int it = rank; it < M_TOK / 256; it += nrank) {
    const int t0 = it * 256 + w * 32;
    const bf16_t* Q = reinterpret_cast<const bf16_t*>(ws + OFF_Q) + (size_t)t0 * 2048 + h * 256;
    unsigned k0[16], k1[16];
    scores_top16(smem, Q, lane, k0);
    scores_top16(smem + 32768, Q + 128, lane, k1);
#pragma unroll
    for (int i = 0; i < 16; ++i) { KL[i * 64 + lane] = k0[i]; KL[(16 + i) * 64 + lane] = k1[i]; }
    float s0[16], s1[16];
#pragma unroll
    for (int i = 0; i < 16; ++i) { s0[i] = ord2f(k0[i] & ~127u); s1[i] = ord2f(k1[i] & ~127u); }
    unsigned x[64];
    {
        int n = 0;
#pragma unroll
        for (int a = 0; a < 16; ++a)
#pragma unroll
            for (int b = 0; b < 16; ++b)
                if ((a + 1) * (b + 1) <= 16) { x[n] = (f2ord(s0[a] + s1[b]) & ~255u) | (unsigned)(255 - (a * 16 + b)); ++n; }
#pragma unroll
        for (int i = 50; i < 64; ++i) x[i] = 0u;
    }
    top16_of_64(x);
    float cv[16]; int ex[16];
#pragma unroll
    for (int i = 0; i < 16; ++i) {
        cv[i] = ord2f(x[i] & ~255u);
        const int cid = 255 - (int)(x[i] & 255u);
        const unsigned ka = KL[(cid >> 4) * 64 + lane], kb = KL[(16 + (cid & 15)) * 64 + lane];
        ex[i] = (127 - (int)(ka & 127u)) * 128 + (127 - (int)(kb & 127u));
    }
    float sum = 0.f;
    const float mx = cv[0];
#pragma unroll
    for (int i = 0; i < 16; ++i) cv[i] = __expf(cv[i] - mx);
#pragma unroll
    for (int i = 0; i < 16; ++i) sum += cv[i];
    const float inv = __builtin_amdgcn_rcpf(sum);
    const size_t orow = (size_t)(t0 + (lane & 31)) * 128 + h * 16;
    if (hh == 0) {
        int4* d = reinterpret_cast<int4*>(reinterpret_cast<int*>(ws + OFF_EIDX) + orow);
#pragma unroll
        for (int i = 0; i < 4; ++i) d[i] = make_int4(ex[4 * i], ex[4 * i + 1], ex[4 * i + 2], ex[4 * i + 3]);
        const float* US = reinterpret_cast<const float*>(ws + OFF_US);
        float4* du = reinterpret_cast<float4*>(reinterpret_cast<float*>(ws + OFF_EU) + orow);
#pragma unroll
        for (int i = 0; i < 4; ++i) du[i] = make_float4(US[ex[4 * i]], US[ex[4 * i + 1]], US[ex[4 * i + 2]], US[ex[4 * i + 3]]);
    } else {
        const float* VS = reinterpret_cast<const float*>(ws + OFF_VS);
        float4* d = reinterpret_cast<float4*>(reinterpret_cast<float*>(ws + OFF_EW) + orow);
#pragma unroll
        for (int i = 0; i < 4; ++i) d[i] = make_float4(cv[4 * i] * inv * VS[ex[4 * i]], cv[4 * i + 1] * inv * VS[ex[4 * i + 1]], cv[4 * i + 2] * inv * VS[ex[4 * i + 2]], cv[4 * i + 3] * inv * VS[ex[4 * i + 3]]);
        }
}
}

typedef _Float16 h2_t __attribute__((ext_vector_type(2)));
template <int CTRL> DEVI float dpp_f(float x) { return __builtin_bit_cast(float, __builtin_amdgcn_mov_dpp(__builtin_bit_cast(int, x), CTRL, 0xf, 0xf, true)); }
DEVI float sum8(float v) { v += dpp_f<0xB1>(v); v += dpp_f<0x4E>(v); v += dpp_f<0x141>(v); return v; }
DEVI float sum64(float v) {
    v = sum8(v); v += dpp_f<0x128>(v);
    { auto s = __builtin_amdgcn_permlane16_swap(__float_as_uint(v), __float_as_uint(v), false, false); v = __uint_as_float(s[0]) + __uint_as_float(s[1]); }
    { auto s = __builtin_amdgcn_permlane32_swap(__float_as_uint(v), __float_as_uint(v), false, false); v = __uint_as_float(s[0]) + __uint_as_float(s[1]); }
    return v;
}
DEVI long pack_i64(unsigned lo, unsigned hi) { return (long)(((unsigned long long)hi << 32) | (unsigned long long)lo); }

#define SB __builtin_amdgcn_sched_barrier(0)
#define SB __builtin_amdgcn_sched_barrier(0)
#define PIN4(Q) "+v"(Q.x), "+v"(Q.y), "+v"(Q.z), "+v"(Q.w)
DEVI void phase10a_block(const Params& p, char* smem) {
    unsigned char* ws = p.ws;
    const int s = blockIdx.x & 7, rank = blockIdx.x >> 3, nrank = ((int)gridDim.x - s + 7) >> 3;
    const int lane = threadIdx.x & 63, wave = threadIdx.x >> 6;
    const int lg = lane & 7, grp = lane >> 3;
    const unsigned char* U8 = ws + OFF_U8 + (size_t)s * (16384 * 128) + 16 * lg;
    const unsigned char* HNs = ws + OFF_HN8 + 128 * s + 16 * lg;
    float* PD = reinterpret_cast<float*>(ws + OFF_PD) + (size_t)s * M_TOK * 128;
    float* stg = reinterpret_cast<float*>(smem) + wave * (16 * 128);
    constexpr int NTG = M_TOK / 8;
#define P10A_LOAD_EV(TG, E) do { const int4* _q = reinterpret_cast<const int4*>(reinterpret_cast<const int*>(ws + OFF_EIDX) + (size_t)((TG) * 8 + wave) * 128 + 16 * grp); \
        E[0] = _q[0]; E[1] = _q[1]; E[2] = _q[2]; E[3] = _q[3]; } while (0)
#define P10A_LOAD_ROWS(TG, E, R, HA) do { \
        asm volatile("" : PIN4(E[0]), PIN4(E[1]), PIN4(E[2]), PIN4(E[3])); \
        const int _e[16] = {E[0].x, E[0].y, E[0].z, E[0].w, E[1].x, E[1].y, E[1].z, E[1].w, E[2].x, E[2].y, E[2].z, E[2].w, E[3].x, E[3].y, E[3].z, E[3].w}; \
        _Pragma("unroll") for (int _i = 0; _i < 16; ++_i) R[_i] = *reinterpret_cast<const uint4*>(U8 + (size_t)_e[_i] * 128); \
        HA = *reinterpret_cast<const uint4*>(HNs + (size_t)((TG) * 8 + wave) * DM); } while (0)
#define P10A_COMPUTE(SLOT, R, HA) do { \
        asm volatile("" : PIN4(R[0]), PIN4(R[1]), PIN4(R[2]), PIN4(R[3]), PIN4(R[4]), PIN4(R[5])); \
        asm volatile("" : PIN4(R[6]), PIN4(R[7]), PIN4(R[8]), PIN4(R[9]), PIN4(R[10]), PIN4(R[11])); \
        asm volatile("" : PIN4(R[12]), PIN4(R[13]), PIN4(R[14]), PIN4(R[15]), PIN4(HA)); \
        int _v1 = 0, _v2 = 0; \
        _Pragma("unroll") for (int _i = 0; _i < 16; ++_i) { \
            int _a = __builtin_amdgcn_sdot4((int)R[_i].x, (int)HA.x, 0, false); \
            _a = __builtin_amdgcn_sdot4((int)R[_i].y, (int)HA.y, _a, false); \
            _a = __builtin_amdgcn_sdot4((int)R[_i].z, (int)HA.z, _a, false); \
            _a = __builtin_amdgcn_sdot4((int)R[_i].w, (int)HA.w, _a, false); \
            _a += __builtin_amdgcn_mov_dpp(_a, 0xB1, 0xf, 0xf, true); _a += __builtin_amdgcn_mov_dpp(_a, 0x4E, 0xf, 0xf, true); _a += __builtin_amdgcn_mov_dpp(_a, 0x141, 0xf, 0xf, true); \
            if (_i < 8) _v1 = (lg == _i) ? _a : _v1; else _v2 = (lg == _i - 8) ? _a : _v2; } \
        stg[(SLOT) * 128 + 16 * grp + lg] = (float)_v1; stg[(SLOT) * 128 + 16 * grp + 8 + lg] = (float)_v2; } while (0)
    int4 eA[4], eB[4], eC[4]; uint4 rA[16], rB[16]; uint4 hA0, hB0;
    if (rank >= NTG) return;
    const int ntok = (NTG - rank + nrank - 1) / nrank;
#define TGI(I) (rank + ((I) < ntok ? (I) : ntok - 1) * nrank)
    P10A_LOAD_EV(TGI(0), eA);
    SB; P10A_LOAD_EV(TGI(1), eB);
    SB; P10A_LOAD_ROWS(TGI(0), eA, rA, hA0);
    SB;
    for (int base = 0; base < ntok; base += 16) {
#pragma unroll 1
        for (int i = base; i < base + 16; i += 2) {
            SB; P10A_LOAD_EV(TGI(i + 2), eC);
            SB; P10A_LOAD_ROWS(TGI(i + 1), eB, rB, hB0);
            SB; P10A_COMPUTE(i - base, rA, hA0);
            SB; P10A_LOAD_EV(TGI(i + 3), eB);
            SB; P10A_LOAD_ROWS(TGI(i + 2), eC, rA, hA0);
            SB; P10A_COMPUTE(i + 1 - base, rB, hB0);
            SB;
        }
#pragma unroll 4
        for (int j = 0; j < 16; ++j) {
            const float2 v = *reinterpret_cast<const float2*>(stg + j * 128 + 2 * lane);
            *reinterpret_cast<float2*>(PD + (size_t)(TGI(base + j) * 8 + wave) * 128 + 2 * lane) = v;
        }
        __builtin_amdgcn_s_waitcnt(0x0F70);
    }
#undef TGI
#undef P10A_LOAD_EV
#undef P10A_LOAD_ROWS
#undef P10A_COMPUTE
}

DEVI void phase10w_block(const Params& p) {
    unsigned char* ws = p.ws;
    const int lane = threadIdx.x & 63, wave = threadIdx.x >> 6;
    const float* PD = reinterpret_cast<const float*>(ws + OFF_PD);
    const float* HS = reinterpret_cast<const float*>(ws + OFF_HS);
    for (int t = blockIdx.x * 8 + wave; t < M_TOK; t += gridDim.x * 8) {
        float d0 = 0.f, d1 = 0.f;
#pragma unroll
        for (int sl = 0; sl < 8; ++sl) { d0 += PD[((size_t)sl * M_TOK + t) * 128 + lane]; d1 += PD[((size_t)sl * M_TOK + t) * 128 + 64 + lane]; }
        const float hs = HS[t];
        const float u0 = reinterpret_cast<const float*>(ws + OFF_EU)[(size_t)t * 128 + lane], u1 = reinterpret_cast<const float*>(ws + OFF_EU)[(size_t)t * 128 + 64 + lane];
        const float g0 = reinterpret_cast<const float*>(ws + OFF_EW)[(size_t)t * 128 + lane], g1 = reinterpret_cast<const float*>(ws + OFF_EW)[(size_t)t * 128 + 64 + lane];
        d0 *= u0 * hs; d1 *= u1 * hs;
        _Float16* W = reinterpret_cast<_Float16*>(ws + OFF_W16) + (size_t)t * 128;
        W[lane] = (_Float16)(g0 * 0.5f * d0 * (1.f + erff(d0 * 0.70710678118654752f)));
        W[64 + lane] = (_Float16)(g1 * 0.5f * d1 * (1.f + erff(d1 * 0.70710678118654752f)));
    }
}

template <bool DRY>
DEVI void phase10b_block(const Params& p, char* smem) {
    unsigned char* ws = p.ws;
    const int s = blockIdx.x & 7, rank = blockIdx.x >> 3, nrank = ((int)gridDim.x - s + 7) >> 3;
    const int lane = threadIdx.x & 63, wave = threadIdx.x >> 6;
    const int lg = lane & 7, grp = lane >> 3;
    const unsigned char* V8 = ws + OFF_V8 + (size_t)s * (16384 * 128) + 16 * lg;
    float* stg = reinterpret_cast<float*>(smem) + wave * (16 * 128);
    constexpr int NTG = M_TOK / 8;
#define P10B_LOAD_EV(TG, E) do { const int4* _q = reinterpret_cast<const int4*>(reinterpret_cast<const int*>(ws + OFF_EIDX) + (size_t)((TG) * 8 + wave) * 128 + 16 * grp); \
        E[0] = _q[0]; E[1] = _q[1]; E[2] = _q[2]; E[3] = _q[3]; } while (0)
#define P10B_LOAD_ROWS(TG, E, R, WA, WB) do { \
        asm volatile("" : PIN4(E[0]), PIN4(E[1]), PIN4(E[2]), PIN4(E[3])); \
        const int _e[16] = {E[0].x, E[0].y, E[0].z, E[0].w, E[1].x, E[1].y, E[1].z, E[1].w, E[2].x, E[2].y, E[2].z, E[2].w, E[3].x, E[3].y, E[3].z, E[3].w}; \
        _Pragma("unroll") for (int _i = 0; _i < 16; ++_i) R[_i] = *reinterpret_cast<const uint4*>(V8 + (size_t)_e[_i] * 128); \
        const uint4* _w = reinterpret_cast<const uint4*>(reinterpret_cast<const _Float16*>(ws + OFF_W16) + (size_t)((TG) * 8 + wave) * 128 + 16 * grp); WA = _w[0]; WB = _w[1]; } while (0)
#define P10B_COMPUTE(SLOT, R, WA, WB) do { \
          \
        asm volatile("" : PIN4(R[0]), PIN4(R[1]), PIN4(R[2]), PIN4(R[3]), PIN4(R[4]), PIN4(R[5])); \
        asm volatile("" : PIN4(R[6]), PIN4(R[7]), PIN4(R[8]), PIN4(R[9]), PIN4(R[10]), PIN4(R[11])); \
        asm volatile("" : PIN4(R[12]), PIN4(R[13]), PIN4(R[14]), PIN4(R[15]), PIN4(WA), PIN4(WB)); \
        const unsigned _ww[8] = {WA.x, WA.y, WA.z, WA.w, WB.x, WB.y, WB.z, WB.w}; \
        h2_t _acc[8]; unsigned _zb; asm volatile("v_mov_b32 %0, 0" : "=v"(_zb)); \
        _Pragma("unroll") for (int _j = 0; _j < 8; ++_j) _acc[_j] = __builtin_bit_cast(h2_t, _zb); \
        _Pragma("unroll") for (int _i = 0; _i < 16; ++_i) { \
            const unsigned _pw = _ww[_i >> 1]; \
            const h2_t _wp = __builtin_bit_cast(h2_t, (_i & 1) ? ((_pw >> 16) | (_pw & 0xffff0000u)) : ((_pw << 16) | (_pw & 0xffffu))); \
            const unsigned _wd[4] = {R[_i].x, R[_i].y, R[_i].z, R[_i].w}; \
            _Pragma("unroll") for (int _j = 0; _j < 4; ++_j) { \
                _acc[2 * _j] += _wp * __builtin_amdgcn_cvt_scalef32_pk_f16_fp8((int)_wd[_j], 1.0f, false); \
                _acc[2 * _j + 1] += _wp * __builtin_amdgcn_cvt_scalef32_pk_f16_fp8((int)_wd[_j], 1.0f, true); } } \
        float _o[16]; \
        _Pragma("unroll") for (int _j = 0; _j < 8; ++_j) { \
            h2_t _x = _acc[_j]; \
            _x += __builtin_bit_cast(h2_t, __builtin_amdgcn_mov_dpp(__builtin_bit_cast(int, _x), 0x128, 0xf, 0xf, true));     \
            { auto _s = __builtin_amdgcn_permlane16_swap(__builtin_bit_cast(unsigned, _x), __builtin_bit_cast(unsigned, _x), false, false); _x = __builtin_bit_cast(h2_t, (unsigned)_s[0]) + __builtin_bit_cast(h2_t, (unsigned)_s[1]); } \
            { auto _s = __builtin_amdgcn_permlane32_swap(__builtin_bit_cast(unsigned, _x), __builtin_bit_cast(unsigned, _x), false, false); _x = __builtin_bit_cast(h2_t, (unsigned)_s[0]) + __builtin_bit_cast(h2_t, (unsigned)_s[1]); } \
            _o[2 * _j] = (float)_x[0]; _o[2 * _j + 1] = (float)_x[1]; } \
        if (grp == 0) { float* _orow = stg + (SLOT) * 128 + 16 * lg; \
            _Pragma("unroll") for (int _i = 0; _i < 4; ++_i) *reinterpret_cast<float4*>(_orow + 4 * _i) = make_float4(_o[4 * _i], _o[4 * _i + 1], _o[4 * _i + 2], _o[4 * _i + 3]); } } while (0)
    int4 eA[4], eB[4], eC[4]; uint4 rA[16], rB[16]; uint4 wA0, wA1, wB0, wB1;
    if (rank >= NTG) return;
    const int ntok = (NTG - rank + nrank - 1) / nrank;
#define TGI(I) (rank + ((I) < ntok ? (I) : ntok - 1) * nrank)
    P10B_LOAD_EV(TGI(0), eA);
    SB; P10B_LOAD_EV(TGI(1), eB);
    SB; P10B_LOAD_ROWS(TGI(0), eA, rA, wA0, wA1);
    SB;
    for (int base = 0; base < ntok; base += 16) {
        float2 hrow[16];
#pragma unroll
        for (int j = 0; j < 16; ++j) hrow[j] = *reinterpret_cast<const float2*>(p.out + (size_t)(TGI(base + j) * 8 + wave) * DM + 128 * s + 2 * lane);
#pragma unroll 1
        for (int i = base; i < base + 16; i += 2) {
            SB; P10B_LOAD_EV(TGI(i + 2), eC);
            SB; P10B_LOAD_ROWS(TGI(i + 1), eB, rB, wB0, wB1);
            SB; P10B_COMPUTE(i - base, rA, wA0, wA1);
            SB; P10B_LOAD_EV(TGI(i + 3), eB);
            SB; P10B_LOAD_ROWS(TGI(i + 2), eC, rA, wA0, wA1);
            SB; P10B_COMPUTE(i + 1 - base, rB, wB0, wB1);
            SB;
        }
        float ssv = 0.f;
#pragma unroll
        for (int j = 0; j < 16; ++j) {
            if (base + j < ntok) {
                const size_t ro = (size_t)(TGI(base + j) * 8 + wave) * DM + 128 * s + 2 * lane;
                const float2 v = *reinterpret_cast<const float2*>(stg + j * 128 + 2 * lane);
                const float2 hv = hrow[j];
                const float2 r = make_float2(hv.x + v.x, hv.y + v.y);
                *reinterpret_cast<float2*>(p.out + ro) = DRY ? hv : r;
                const float sq = sum64(r.x * r.x + r.y * r.y);
                ssv = (lane == j) ? sq : ssv;
            }
        }
        if (lane < 16 && base + lane < ntok) reinterpret_cast<float*>(ws + OFF_SSQ)[(DRY ? (size_t)M_TOK * 8 : 0) + (size_t)(TGI(base + lane) * 8 + wave) * 8 + s] = ssv;
        __builtin_amdgcn_s_waitcnt(0x0F70);
    }
#undef TGI
#undef P10B_LOAD_EV
#undef P10B_LOAD_ROWS
#undef P10B_COMPUTE
}

DEVI void phase10c_block(const Params& p) {
    unsigned char* ws = p.ws;
    const int lane = threadIdx.x & 63, wave = threadIdx.x >> 6;
    for (int t = blockIdx.x * 8 + wave; t < M_TOK; t += gridDim.x * 8) {
        const float* sq = reinterpret_cast<const float*>(ws + OFF_SSQ) + (size_t)t * 8;
        const float4 a = *reinterpret_cast<const float4*>(sq), b = *reinterpret_cast<const float4*>(sq + 4);
        const float r = rsqrtf((a.x + a.y + a.z + a.w + b.x + b.y + b.z + b.w) * (1.f / 1024.f) + 1e-6f);
        float4* orow = reinterpret_cast<float4*>(p.out + (size_t)t * DM);
        const float4* gf = reinterpret_cast<const float4*>(p.norm_f_g);
#pragma unroll
        for (int i = 0; i < 4; ++i) {
            const float4 v = orow[lane + 64 * i], g = gf[lane + 64 * i];
            orow[lane + 64 * i] = make_float4(v.x * r * g.x, v.y * r * g.y, v.z * r * g.z, v.w * r * g.w);
        }
    }
}

#define XB_TMO      128
#define XB_XCNT(j)  (256  + 64 * (j))
#define XB_XSUB(j)  (1280 + 64 * (j))
#define XB_XGEN(j)  (2304 + 64 * (j))
#define XB_TOP      3328
#define XB_TOPGEN   3392
#define XCD_BAR_WORDS 3456
#define XB_SPIN_CAP (1u << 22)
#define LAS __attribute__((address_space(3)))
DEVI unsigned xb_ld(unsigned* p)              { return __hip_atomic_load(p, __ATOMIC_RELAXED, __HIP_MEMORY_SCOPE_AGENT); }
DEVI unsigned xb_add(unsigned* p, unsigned v) { return __hip_atomic_fetch_add(p, v, __ATOMIC_RELAXED, __HIP_MEMORY_SCOPE_AGENT); }
DEVI unsigned xb_xcc_id() { return (unsigned)__builtin_amdgcn_s_getreg((3 << 11) | 20) & 0xFu; }
#define XB_SPIN(cond, bar) do { unsigned _sp = 0; while (cond) { __builtin_amdgcn_s_sleep(1); \
    if ((++_sp & 255u) == 0u) { if (xb_ld(&(bar)[XB_TMO])) break; if (_sp > XB_SPIN_CAP) { atomicAdd(&(bar)[XB_TMO], 1u); break; } } } } while (0)
struct XcdBarrier { unsigned* bar; unsigned x; volatile LAS unsigned* st; };
DEVI XcdBarrier xcd_barrier_post(unsigned* bar, volatile LAS unsigned* st) {
    XcdBarrier b; b.bar = bar; b.x = xb_xcc_id(); b.st = st;
    if (threadIdx.x == 0) (void)xb_add(&bar[XB_XCNT(b.x)], 1u);
    return b;
}
DEVI void xcd_barrier_complete(unsigned* bar, unsigned x, unsigned& nloc, unsigned& nx) {
    const unsigned G = gridDim.x * gridDim.y * gridDim.z;
    unsigned sum, cnt, mine, sp = 0u;
    for (;;) {
        sum = 0u; cnt = 0u; mine = 0u;
#pragma unroll
        for (unsigned j = 0; j < 16; ++j) { const unsigned c = xb_ld(&bar[XB_XCNT(j)]); sum += c; cnt += (c > 0u) ? 1u : 0u; mine = (j == x) ? c : mine; }
        if (sum == G) break;
        __builtin_amdgcn_s_sleep(1);
        if ((++sp & 255u) == 0u) { if (xb_ld(&bar[XB_TMO])) break; if (sp > XB_SPIN_CAP) { atomicAdd(&bar[XB_TMO], 1u); break; } }
    }
    nloc = mine > 0u ? mine : 1u; nx = cnt > 0u ? cnt : 1u;
}
DEVI void xcd_barrier(const XcdBarrier& b) {
    asm volatile("s_waitcnt vmcnt(0)" ::: "memory");
    __syncthreads();
    if (threadIdx.x == 0) {
        unsigned* bar = b.bar;
        __builtin_amdgcn_s_waitcnt(0);
        unsigned nloc = b.st[0], nx = b.st[1];
        if (nloc == 0u) { xcd_barrier_complete(bar, b.x, nloc, nx); b.st[0] = nloc; b.st[1] = nx; }
        const unsigned old = xb_add(&bar[XB_XSUB(b.x)], 1u);
        const unsigned gen = old / nloc;
        if (old + 1u == (gen + 1u) * nloc) {
            __builtin_amdgcn_fence(__ATOMIC_RELEASE, "agent");
            asm volatile("s_waitcnt vmcnt(0)" ::: "memory");
            const unsigned og = xb_add(&bar[XB_TOP], 1u);
            const unsigned tg = og / nx;
            if (og + 1u == (tg + 1u) * nx) xb_add(&bar[XB_TOPGEN], 1u);
            else XB_SPIN(xb_ld(&bar[XB_TOPGEN]) == tg, bar);
            __builtin_amdgcn_fence(__ATOMIC_ACQUIRE, "agent");
            xb_add(&bar[XB_XGEN(b.x)], 1u);
            asm volatile("s_waitcnt vmcnt(0)" ::: "memory");
        } else {
            XB_SPIN(xb_ld(&bar[XB_XGEN(b.x)]) == gen, bar);
            __builtin_amdgcn_fence(__ATOMIC_ACQUIRE, "agent");
            asm volatile("s_waitcnt vmcnt(0)" ::: "memory");
        }
    }
    __syncthreads();
}

constexpr int N_PHASES = 11;
constexpr int LDS_PHASE_BYTES = 131072;
constexpr int LDS_BYTES = LDS_PHASE_BYTES + 16;

__global__ void __launch_bounds__(512, 2) hymba_fwd(Params p) {
    extern __shared__ __attribute__((aligned(16))) char smem[];
    cg::grid_group grid = cg::this_grid();
    const int lo = p.ph_lo, hi = p.ph_hi;
    volatile LAS unsigned* bst = (volatile LAS unsigned*)(smem + LDS_PHASE_BYTES);
    if (threadIdx.x == 0) { bst[0] = 0u; bst[1] = 0u; bst[2] = 0u; bst[3] = 0u; }
    __syncthreads();
    XcdBarrier xb = xcd_barrier_post(reinterpret_cast<unsigned*>(p.ws + OFF_BAR), bst);
    const int hb = (int)(threadIdx.x >> 8);
    char* hsm = smem + hb * 65536;
#define SEAM(K) if ((K) > lo) { if ((K) == lo + 1) grid.sync(); else xcd_barrier(xb); }
#define RUN_PHASE(K, FN, N) if (lo <= (K) && (K) < hi) { SEAM(K) for (int rep = 0; rep < 1 + ((PROBE_DUP >> (K)) & 1); ++rep) { if (rep) xcd_barrier(xb); \
        for (int ub = blockIdx.x * 2; ub < (N); ub += gridDim.x * 2) { const int u = ub + hb; if (u < (N)) FN(p, u, hsm); } } }
#define RUN_GEMM(K, CALL) if (lo <= (K) && (K) < hi) { SEAM(K) CALL; }
    RUN_PHASE(0, phase0_unit, P0_UNITS)
    RUN_GEMM(1, run_gemm(reinterpret_cast<const bf16_t*>(p.ws + OFF_XN), reinterpret_cast<const bf16_t*>(p.ws + OFF_WIN), P1_N, EpiInProj{p.ws}, smem))
#if PROBE_P2G
    if (lo <= 2 && 2 < hi) { xcd_barrier(xb); for (int ub = blockIdx.x * 2; ub < P2_UNITS; ub += gridDim.x * 2) { const int u = ub + hb; if (u < P2_UNITS) phase2_dry_unit(p, u, hsm); } }
#endif
    RUN_PHASE(2, phase2_unit, P2_UNITS)
#if PROBE_P2T
    if (lo <= 2 && 2 < hi) { xcd_barrier(xb); for (int ub = blockIdx.x * 2; ub < P2_UNITS; ub += gridDim.x * 2) { const int u = ub + hb; if (u < P2_UNITS && (u % 7) >= 3) phase2_unit(p, u, hsm); } }
#endif
    RUN_PHASE(3, phase3_unit, P3_UNITS)
#if PROBE_P4
    if (lo <= 4 && 4 < hi) { xcd_barrier(xb); for (int ub = blockIdx.x * 2; ub < P4_UNITS; ub += gridDim.x * 2) { const int u = ub + hb; if (u < P4_UNITS) phase4_dry_unit(p, u, hsm); } }
#endif
    RUN_PHASE(4, phase4_unit, P4_UNITS)
    RUN_PHASE(5, phase5_unit, P5_UNITS)
    RUN_GEMM(6, run_gemm(reinterpret_cast<const bf16_t*>(p.ws + OFF_MIX), reinterpret_cast<const bf16_t*>(p.ws + OFF_WOUT), 1024, EpiOutProj{p.x, p.out}, smem))
    RUN_PHASE(7, phase7_unit, P7_UNITS)
    RUN_GEMM(8, run_gemm(reinterpret_cast<const bf16_t*>(p.ws + OFF_HN), reinterpret_cast<const bf16_t*>(p.ws + OFF_WQ), 2048, EpiQ{reinterpret_cast<bf16_t*>(p.ws + OFF_Q)}, smem))
    RUN_GEMM(9, phase9_block(p, smem))
    if (lo <= 10 && 10 < hi) {
        SEAM(10)
#if PROBE_P10X == 4
        phase10a_block(p, smem); xcd_barrier(xb);
#endif
        phase10a_block(p, smem);
#if PROBE_P10X == 1
        xcd_barrier(xb); phase10a_block(p, smem);
#endif

        xcd_barrier(xb); phase10w_block(p);
#if PROBE_P10X == 2
        xcd_barrier(xb); phase10b_block<true>(p, smem);
#endif
        xcd_barrier(xb); phase10b_block<false>(p, smem);
        xcd_barrier(xb); phase10c_block(p);
#if PROBE_P10X == 3
        xcd_barrier(xb); phase10c_block(p);
#endif
    }
#undef RUN_PHASE
#undef RUN_GEMM
#undef SEAM
}

extern "C" void kernel_launch(void* const* d_in, const int* in_sizes, int n_in, void* d_out, int out_size, void* d_ws, size_t ws_size, hipStream_t stream) {
    static int grid_blocks = 0;
    if (grid_blocks == 0) {
        if (n_in != 15 || in_sizes[0] != M_TOK * DM || out_size != M_TOK * DM || ws_size < WS_NEED) {
            fprintf(stderr, "kernel_launch: unexpected shapes (n_in %d, in0 %d, out %d, ws %zu)\n", n_in, n_in > 0 ? in_sizes[0] : -1, out_size, ws_size);
            grid_blocks = -1; return;
        }
        int dev = 0, cus = 0, per_cu = 0;
        (void)hipGetDevice(&dev);
        (void)hipDeviceGetAttribute(&cus, hipDeviceAttributeMultiprocessorCount, dev);
        (void)hipFuncSetAttribute((const void*)hymba_fwd, hipFuncAttributeMaxDynamicSharedMemorySize, LDS_BYTES);
        (void)hipOccupancyMaxActiveBlocksPerMultiprocessor(&per_cu, (const void*)hymba_fwd, 512, LDS_BYTES);
        if (per_cu < 1) per_cu = 1;
        if (per_cu > 1) per_cu = 1;
        grid_blocks = cus * per_cu;
    }
    if (grid_blocks < 0) return;
    Params p{};
    p.x = (const float*)d_in[0]; p.norm1_g = (const float*)d_in[1]; p.w_in = (const float*)d_in[2]; p.hg_lower = (const float*)d_in[3];
    p.hg_norm_g = (const float*)d_in[4]; p.gla_wg = (const float*)d_in[5]; p.gla_bg = (const float*)d_in[6]; p.gla_norm_g = (const float*)d_in[7];
    p.w_out = (const float*)d_in[8]; p.norm2_g = (const float*)d_in[9]; p.w_q = (const float*)d_in[10]; p.sub_keys = (const float*)d_in[11];
    p.peer_u = (const float*)d_in[12]; p.peer_v = (const float*)d_in[13]; p.norm_f_g = (const float*)d_in[14];
    p.out = (float*)d_out; p.ws = (unsigned char*)d_ws;
#if N_LAUNCH_MODE == 1
    (void)hipMemsetAsync((unsigned char*)d_ws + OFF_BAR, 0, XCD_BAR_WORDS * 4, stream);
    p.ph_lo = 0; p.ph_hi = N_PHASES;
    void* args[] = {&p};
    hipError_t e = hipLaunchCooperativeKernel((const void*)hymba_fwd, dim3(grid_blocks), dim3(512), args, LDS_BYTES, stream);
    if (e != hipSuccess) fprintf(stderr, "cooperative launch failed: %s (grid %d)\n", hipGetErrorString(e), grid_blocks);
#else
    for (int ph = 0; ph < N_PHASES; ++ph) {
        p.ph_lo = ph; p.ph_hi = ph + 1;
        hipLaunchKernelGGL(hymba_fwd, dim3(grid_blocks), dim3(512), LDS_BYTES, stream, p);
    }
#endif
}
```

```cpp
#include <hip/hip_runtime.h>
#include <hip/hip_cooperative_groups.h>
#include <cstdio>
#include <cstdint>
namespace cg = cooperative_groups;

#ifndef N_LAUNCH_MODE
#define N_LAUNCH_MODE 1
#endif

#ifndef PROBE_DUP
#define PROBE_DUP 0
#endif
#ifndef PROBE_P10_DUP
#define PROBE_P10_DUP 0
#endif
#ifndef P10_SLICED
#define P10_SLICED 0
#endif
#ifndef PROBE_P10A
#define PROBE_P10A 0
#endif
#ifndef PROBE_P10_MASK
#define PROBE_P10_MASK 0x7fffffff
#endif
#ifndef PROBE_P10X
#define PROBE_P10X 0
#endif
#ifndef PROBE_P2T
#define PROBE_P2T 0
#endif
#ifndef PROBE_P4
#define PROBE_P4 0
#endif
#ifndef PROBE_P2G
#define PROBE_P2G 0
#endif
#ifndef PROBE_GEMM_DUP
#define PROBE_GEMM_DUP 0
#endif
#define DEVI __device__ __forceinline__
#define LTID ((int)(threadIdx.x & 255u))
typedef unsigned short bf16_t;
using bf16x8 = __attribute__((ext_vector_type(8))) short;
using f32x4 = __attribute__((ext_vector_type(4))) float;

constexpr int M_TOK = 32768;
constexpr int DM = 1024;
constexpr int IN_WP = 3840;
constexpr size_t MiB = 1024ull * 1024ull;

constexpr size_t OFF_XN   = 0;
constexpr size_t OFF_WIN  = 64 * MiB;
constexpr size_t OFF_WOUT = 72 * MiB;
constexpr size_t OFF_WQ   = 74 * MiB;
constexpr size_t OFF_SK   = 78 * MiB;
constexpr size_t OFF_LB   = 79 * MiB;
constexpr size_t OFF_U8   = 80 * MiB;
constexpr size_t OFF_V8   = 96 * MiB;
constexpr size_t OFF_US   = 112 * MiB;
constexpr size_t OFF_VS   = 113 * MiB;
constexpr size_t OFF_R2   = 144 * MiB;
constexpr size_t OFF_HQ   = OFF_R2;
constexpr size_t OFF_HLF  = OFF_R2 + 32 * MiB;
constexpr size_t OFF_HV   = OFF_R2 + 64 * MiB;
constexpr size_t OFF_HG   = OFF_R2 + 96 * MiB;
constexpr size_t OFF_GQ   = OFF_R2 + 128 * MiB;
constexpr size_t OFF_GK   = OFF_R2 + 144 * MiB;
constexpr size_t OFF_GV   = OFF_R2 + 160 * MiB;
constexpr size_t OFF_GG   = OFF_R2 + 192 * MiB;
constexpr size_t OFF_GLOW = OFF_R2 + 224 * MiB;
constexpr size_t OFF_KTH  = 370 * MiB;
constexpr size_t OFF_KTG  = 402 * MiB;
constexpr size_t OFF_DECH = 418 * MiB;
constexpr size_t OFF_DECG = 419 * MiB;
constexpr size_t OFF_HVT  = 420 * MiB;
constexpr size_t OFF_GVT  = 452 * MiB;
constexpr size_t OFF_BAR  = 484 * MiB;
constexpr size_t WS_NEED  = 485 * MiB;
constexpr size_t OFF_MIX  = OFF_XN;
constexpr size_t OFF_HN   = OFF_R2;
constexpr size_t OFF_Q    = OFF_R2 + 64 * MiB;
constexpr size_t OFF_EIDX = OFF_KTH;
constexpr size_t OFF_EW   = OFF_KTH + 16 * MiB;
constexpr size_t OFF_EU   = OFF_KTG;
constexpr size_t OFF_HN8  = OFF_XN;
constexpr size_t OFF_HS   = OFF_XN + 32 * MiB;
constexpr size_t OFF_W16  = OFF_XN + 48 * MiB;
constexpr size_t OFF_SSQ  = OFF_XN + 33 * MiB;
constexpr size_t OFF_PD   = OFF_Q;
constexpr size_t OUT_STH = 0;
constexpr size_t OUT_STG = 64 * MiB;

struct Params {
    const float* x; const float* norm1_g; const float* w_in; const float* hg_lower; const float* hg_norm_g;
    const float* gla_wg; const float* gla_bg; const float* gla_norm_g; const float* w_out; const float* norm2_g;
    const float* w_q; const float* sub_keys; const float* peer_u; const float* peer_v; const float* norm_f_g;
    float* out; unsigned char* ws;
    int ph_lo, ph_hi;
};

DEVI unsigned short f2bf(float f) {
    unsigned u = __float_as_uint(f);
    u += 0x7fffu + ((u >> 16) & 1u);
    return (unsigned short)(u >> 16);
}
DEVI float bf2f(unsigned short b) { return __uint_as_float(((unsigned)b) << 16); }
DEVI unsigned pack2(float a, float b) { return (unsigned)f2bf(a) | ((unsigned)f2bf(b) << 16); }
DEVI float bflo(unsigned u) { return __uint_as_float(u << 16); }
DEVI float bfhi(unsigned u) { return __uint_as_float(u & 0xffff0000u); }
template <int CTRL> DEVI float dpp_f(float x) { return __builtin_bit_cast(float, __builtin_amdgcn_mov_dpp(__builtin_bit_cast(int, x), CTRL, 0xf, 0xf, true)); }
DEVI float wave_sum(float v) {
    v += dpp_f<0xB1>(v); v += dpp_f<0x4E>(v); v += dpp_f<0x141>(v); v += dpp_f<0x128>(v);
    { auto s = __builtin_amdgcn_permlane16_swap(__float_as_uint(v), __float_as_uint(v), false, false); v = __uint_as_float(s[0]) + __uint_as_float(s[1]); }
    { auto s = __builtin_amdgcn_permlane32_swap(__float_as_uint(v), __float_as_uint(v), false, false); v = __uint_as_float(s[0]) + __uint_as_float(s[1]); }
    return v;
}
DEVI float wave_max(float v) {
    v = fmaxf(v, dpp_f<0xB1>(v)); v = fmaxf(v, dpp_f<0x4E>(v)); v = fmaxf(v, dpp_f<0x141>(v)); v = fmaxf(v, dpp_f<0x128>(v));
    { auto s = __builtin_amdgcn_permlane16_swap(__float_as_uint(v), __float_as_uint(v), false, false); v = fmaxf(__uint_as_float(s[0]), __uint_as_float(s[1])); }
    { auto s = __builtin_amdgcn_permlane32_swap(__float_as_uint(v), __float_as_uint(v), false, false); v = fmaxf(__uint_as_float(s[0]), __uint_as_float(s[1])); }
    return v;
}
DEVI float silu_f(float x) { return x * __builtin_amdgcn_rcpf(1.f + __expf(-x)); }
DEVI f32x4 mfma16(bf16x8 a, bf16x8 b, f32x4 c) { return __builtin_amdgcn_mfma_f32_16x16x32_bf16(a, b, c, 0, 0, 0); }
DEVI bf16x8 ldg_frag(const bf16_t* p) { return *reinterpret_cast<const bf16x8*>(p); }

DEVI void rms_row_bf16(const float* __restrict__ xr, const float* __restrict__ g, bf16_t* __restrict__ dst, int lane) {
    float4 v[4]; float ss = 0.f;
#pragma unroll
    for (int i = 0; i < 4; ++i) { v[i] = reinterpret_cast<const float4*>(xr)[lane + 64 * i]; ss += v[i].x * v[i].x + v[i].y * v[i].y + v[i].z * v[i].z + v[i].w * v[i].w; }
    ss = wave_sum(ss);
    const float r = rsqrtf(ss * (1.f / 1024.f) + 1e-6f);
#pragma unroll
    for (int i = 0; i < 4; ++i) {
        const float4 gg = reinterpret_cast<const float4*>(g)[lane + 64 * i];
        uint2 o; o.x = pack2(v[i].x * r * gg.x, v[i].y * r * gg.y); o.y = pack2(v[i].z * r * gg.z, v[i].w * r * gg.w);
        reinterpret_cast<uint2*>(dst)[lane + 64 * i] = o;
    }
}

DEVI void transpose_tile(const float* __restrict__ src, int Nsrc, bf16_t* __restrict__ dst, int nt, int kt, int mode, float* lds) {
    const int tid = LTID, tx = tid & 63, ty = tid >> 6;
    const int np = nt * 64 + tx;
    int col = np; bool valid = true;
    if (mode == 1) {
        if (np < 3072) col = np; else if (np < 3584) col = np + 16; else if (np < 3600) col = np - 512; else { valid = false; col = 0; }
    }
#pragma unroll 4
    for (int kk = ty; kk < 64; kk += 4) {
        lds[kk * 65 + tx] = valid ? src[(size_t)(kt * 64 + kk) * Nsrc + col] : 0.f;
    }
    __syncthreads();
    const int nl = tid >> 2, kq = tid & 3;
    unsigned pk[8];
#pragma unroll
    for (int i = 0; i < 8; ++i) pk[i] = pack2(lds[(kq * 16 + 2 * i) * 65 + nl], lds[(kq * 16 + 2 * i + 1) * 65 + nl]);
    uint4* d = reinterpret_cast<uint4*>(dst + (size_t)(nt * 64 + nl) * 1024 + kt * 64 + kq * 16);
    d[0] = make_uint4(pk[0], pk[1], pk[2], pk[3]);
    d[1] = make_uint4(pk[4], pk[5], pk[6], pk[7]);
    __syncthreads();
}

DEVI void convert8(const float* __restrict__ src, bf16_t* __restrict__ dst, size_t idx8) {
    const float4 a = reinterpret_cast<const float4*>(src)[idx8 * 2], b = reinterpret_cast<const float4*>(src)[idx8 * 2 + 1];
    reinterpret_cast<uint4*>(dst)[idx8] = make_uint4(pack2(a.x, a.y), pack2(a.z, a.w), pack2(b.x, b.y), pack2(b.z, b.w));
}

DEVI int pack_i8x4(float a, float b, float c, float d) {
    const int ia = (int)rintf(a), ib = (int)rintf(b), ic = (int)rintf(c), id = (int)rintf(d);
    return (ia & 255) | ((ib & 255) << 8) | ((ic & 255) << 16) | (id << 24);
}
DEVI void quant_row_i8(const float* __restrict__ xr, unsigned char* __restrict__ dst_table, int row, float* __restrict__ descale, int lane) {
    float4 v[4]; float am = 0.f;
#pragma unroll
    for (int i = 0; i < 4; ++i) { v[i] = reinterpret_cast<const float4*>(xr)[lane + 64 * i]; am = fmaxf(am, fmaxf(fmaxf(fabsf(v[i].x), fabsf(v[i].y)), fmaxf(fabsf(v[i].z), fabsf(v[i].w)))); }
    am = wave_max(am);
    const float sc = am > 0.f ? 127.f / am : 1.f;
#pragma unroll
    for (int i = 0; i < 4; ++i) {
        const int w = lane + 64 * i;
        reinterpret_cast<int*>(dst_table)[(size_t)(w >> 5) * (16384 * 32) + (size_t)row * 32 + (w & 31)] = pack_i8x4(v[i].x * sc, v[i].y * sc, v[i].z * sc, v[i].w * sc);
    }
    if (lane == 0) *descale = am > 0.f ? am * (1.f / 127.f) : 1.f;
}
DEVI void quant_row_fp8(const float* __restrict__ xr, unsigned char* __restrict__ dst_table, int row, float* __restrict__ descale, int lane) {
    float4 v[4]; float am = 0.f;
#pragma unroll
    for (int i = 0; i < 4; ++i) { v[i] = reinterpret_cast<const float4*>(xr)[lane + 64 * i]; am = fmaxf(am, fmaxf(fmaxf(fabsf(v[i].x), fabsf(v[i].y)), fmaxf(fabsf(v[i].z), fabsf(v[i].w)))); }
    am = wave_max(am);
    const float sc = am > 0.f ? 448.f / am : 1.f;
#pragma unroll
    for (int i = 0; i < 4; ++i) {
        const float a = fminf(fmaxf(v[i].x * sc, -448.f), 448.f), b = fminf(fmaxf(v[i].y * sc, -448.f), 448.f);
        const float c = fminf(fmaxf(v[i].z * sc, -448.f), 448.f), d = fminf(fmaxf(v[i].w * sc, -448.f), 448.f);
        int pk = __builtin_amdgcn_cvt_pk_fp8_f32(a, b, 0, false);
        pk = __builtin_amdgcn_cvt_pk_fp8_f32(c, d, pk, true);
        const int w = lane + 64 * i;
        reinterpret_cast<int*>(dst_table)[(size_t)(w >> 5) * (16384 * 32) + (size_t)row * 32 + (w & 31)] = pk;
    }
    if (lane == 0) *descale = am > 0.f ? am * (1.f / 448.f) : 1.f;
}

constexpr int P0_XN = 8192, P0_WIN = 60 * 16, P0_WOUT = 16 * 16, P0_WQ = 32 * 16, P0_UV = 8192, P0_SK = 128, P0_LB = 1;
constexpr int P0_UNITS = P0_XN + P0_WIN + P0_WOUT + P0_WQ + P0_UV + P0_SK + P0_LB;

DEVI void phase0_unit(const Params& p, int u, char* smem) {
    const int tid = LTID, lane = tid & 63, w = tid >> 6;
    unsigned char* ws = p.ws;
    if (u < P0_XN) {
        const int row = u * 4 + w;
        rms_row_bf16(p.x + (size_t)row * DM, p.norm1_g, reinterpret_cast<bf16_t*>(ws + OFF_XN) + (size_t)row * DM, lane);
        return;
    }
    u -= P0_XN;
    if (u < P0_WIN) { transpose_tile(p.w_in, 3600, reinterpret_cast<bf16_t*>(ws + OFF_WIN), u / 16, u % 16, 1, reinterpret_cast<float*>(smem)); return; }
    u -= P0_WIN;
    if (u < P0_WOUT) { transpose_tile(p.w_out, 1024, reinterpret_cast<bf16_t*>(ws + OFF_WOUT), u / 16, u % 16, 0, reinterpret_cast<float*>(smem)); return; }
    u -= P0_WOUT;
    if (u < P0_WQ) { transpose_tile(p.w_q, 2048, reinterpret_cast<bf16_t*>(ws + OFF_WQ), u / 16, u % 16, 0, reinterpret_cast<float*>(smem)); return; }
    u -= P0_WQ;
    if (u < P0_UV) {
        const bool isv = u >= 4096; const int row = (isv ? u - 4096 : u) * 4 + w;
        if (isv) quant_row_fp8(p.peer_v + (size_t)row * DM, ws + OFF_V8, row, reinterpret_cast<float*>(ws + OFF_VS) + row, lane);
        else quant_row_i8(p.peer_u + (size_t)row * DM, ws + OFF_U8, row, reinterpret_cast<float*>(ws + OFF_US) + row, lane);
        return;
    }
    u -= P0_UV;
    if (u < P0_SK) { convert8(p.sub_keys, reinterpret_cast<bf16_t*>(ws + OFF_SK), (size_t)u * 256 + tid); return; }
    float* lb = reinterpret_cast<float*>(ws + OFF_LB);
    for (int n = tid; n < 512; n += 256) {
        const float l0 = p.hg_lower[n], l1 = p.hg_lower[512 + n];
        const float mx = fmaxf(l0, l1); const float e0 = __expf(l0 - mx), e1 = __expf(l1 - mx);
        lb[n] = e0 / (e0 + e1);
    }
}

namespace pg8 {
#define PG8_LAS __attribute__((address_space(3)))
typedef unsigned short bf16_t;
typedef short bf16x8 __attribute__((ext_vector_type(8)));
typedef float f32x4 __attribute__((ext_vector_type(4)));
typedef unsigned u32x4 __attribute__((ext_vector_type(4)));
constexpr int BM = 256, BK = 64, HALF = 128, HTB = HALF * BK * 2  , STAGE_BYTES = 8 * HTB, NXCD = 8, WGM = 8;

__host__ __device__ __forceinline__ int lds_byte(int r, int c) { const int st = (r >> 4) * 2 + (c >> 5), rr = r & 15, cc = c & 31, ob = rr * 64 + cc * 2; return st * 1024 + (ob ^ (((ob >> 9) & 1) << 5)); }
__host__ __device__ __forceinline__ void stage_rc(int b, int& R, int& C) { const int st = b / 1024, sb = b % 1024, swz = sb ^ (((sb >> 9) & 1) << 5); R = (st >> 1) * 16 + swz / 64; C = (st & 1) * 32 + (swz % 64) / 2; }
__host__ __device__ __forceinline__ int perm32(int rho) { const int n = rho >> 4, i = rho & 15; return 8 * (i >> 2) + 4 * n + (i & 3); }

struct Unit { int pm, pn; };
struct Gemm { const bf16_t* A; const bf16_t* Bt; int M, N, K; };

struct StaticOrder {
    int nM, nN, nwg, G, c;
    __host__ __device__ void init(int M, int N, int G_, int c_) { nM = M / BM; nN = N / BM; nwg = nM * nN; G = G_; c = c_; }
    __host__ __device__ bool next(int i, Unit& u) const {
        const long L = (long)i * G + c; if (L >= nwg) return false;
        int wgid = (int)L; { const int q = nwg / NXCD, r = nwg % NXCD, xcd = wgid % NXCD, off = wgid / NXCD; wgid = (xcd < r ? xcd * (q + 1) : r * (q + 1) + (xcd - r) * q) + off; }
        const int nig = WGM * nN, gid = wgid / nig, fm = gid * WGM, gsz = (nM - fm) < WGM ? (nM - fm) : WGM;
        u.pm = fm + ((wgid % nig) % gsz); u.pn = (wgid % nig) / gsz; return true;
    }
    __device__ __forceinline__ void a_ready(const Unit&) const {}
    __device__ __forceinline__ void done(const Unit&) const {}
};
__device__ __forceinline__ unsigned cvt_pk_bf16(float lo, float hi) { unsigned r; asm volatile("v_cvt_pk_bf16_f32 %0, %1, %2" : "=v"(r) : "v"(lo), "v"(hi)); return r; }
typedef float f32x2 __attribute__((ext_vector_type(2)));
template <class Epi, class Sched, bool STAMP = false>
__device__ __forceinline__ void gemm_phase(PG8_LAS unsigned char* lds, const Gemm g, const Sched& S, const Epi& E, unsigned long long* stamps) {
    const int tid = threadIdx.x, wid = __builtin_amdgcn_readfirstlane(tid >> 6), lane = tid & 63, wr = wid >> 2, wc = wid & 3, fr = lane & 15, fq = lane >> 4;
    const int K = g.K, nt = K / BK;
    int ts_lo = 0, ts_hi = 0, nts = 0; const unsigned long long rt_entry = STAMP ? (unsigned long long)wall_clock64() : 0ull;
#define PG8_STAMP() do { if (STAMP && wid == 0 && nts < 64) { const unsigned long long _c = (unsigned long long)clock64(); \
        ts_lo = (lane == nts) ? (int)(unsigned)_c : ts_lo; ts_hi = (lane == nts) ? (int)(unsigned)(_c >> 32) : ts_hi; ++nts; } } while (0)
    PG8_STAMP();
    unsigned voffA[2], voffB[2];
#pragma unroll
    for (int i = 0; i < 2; ++i) { int R, C; stage_rc(tid * 16 + i * 8192, R, C); const int Rb = Epi::PERM ? ((R & ~31) + perm32(R & 31)) : R;
        voffA[i] = (unsigned)(R * K + C) * 2u; voffB[i] = (unsigned)(Rb * K + C) * 2u; }
    const size_t kstep = (size_t)(BK * 2);
    const size_t hstep = (size_t)HALF * K * 2;
    const size_t tstep = 2 * hstep;
    const unsigned ldsw = (unsigned)wid * 1024u;
    const int aoff = lds_byte(wr * 64 + fr, fq * 8), boff = lds_byte(wc * 32 + fr, fq * 8);
#define PG8_SA(b, h) (((b) * 2 + (h)) * HTB)
#define PG8_SB(b, h) ((4 + (b) * 2 + (h)) * HTB)
#define PG8_STAGE(bufoff, gbase, voff) do { _Pragma("unroll") for (int _i = 0; _i < 2; ++_i) \
        __builtin_amdgcn_global_load_lds((const unsigned*)((const char*)(gbase) + (voff)[_i]), (PG8_LAS unsigned*)(lds + (bufoff) + ldsw + _i * 8192), 16, 0, 0); } while (0)
#define PG8_LDA(dst, b, h) do { _Pragma("unroll") for (int m = 0; m < 4; ++m) _Pragma("unroll") for (int k = 0; k < 2; ++k) dst[m][k] = *(const PG8_LAS bf16x8*)(lds + PG8_SA(b, h) + aoff + m * 2048 + k * 1024); } while (0)
#define PG8_LDB(dst, b, h) do { _Pragma("unroll") for (int n = 0; n < 2; ++n) _Pragma("unroll") for (int k = 0; k < 2; ++k) dst[n][k] = *(const PG8_LAS bf16x8*)(lds + PG8_SB(b, h) + boff + n * 2048 + k * 1024); } while (0)
#define PG8_MMA(ai, bj, At, Bt) do { __builtin_amdgcn_s_setprio(1); _Pragma("unroll") for (int m = 0; m < 4; ++m) _Pragma("unroll") for (int n = 0; n < 2; ++n) _Pragma("unroll") for (int k = 0; k < 2; ++k) \
        acc[ai][bj][m][n] = __builtin_amdgcn_mfma_f32_16x16x32_bf16(Bt[n][k], At[m][k], acc[ai][bj][m][n], 0, 0, 0); __builtin_amdgcn_s_setprio(0); } while (0)
#define PG8_WAIT_V(n) asm volatile("s_waitcnt vmcnt(" #n ")" ::: "memory")
#define PG8_WAIT_L(n) asm volatile("s_waitcnt lgkmcnt(" #n ")" ::: "memory")
#define PG8_BAR __builtin_amdgcn_s_barrier()
#define PG8_SCHED __builtin_amdgcn_sched_barrier(0)
    Unit cur, nxt; int ui = 0;
    if (!S.next(0, cur)) return;
    f32x4 acc[2][2][4][2];
#pragma unroll
    for (int a = 0; a < 2; ++a)
#pragma unroll
        for (int b = 0; b < 2; ++b)
#pragma unroll
            for (int m = 0; m < 4; ++m)
#pragma unroll
                for (int n = 0; n < 2; ++n) acc[a][b][m][n] = (f32x4){0.f, 0.f, 0.f, 0.f};
    bf16x8 At[4][2], B0[2][2], B1[2][2];
    const char* cA = (const char*)g.A + (size_t)cur.pm * tstep; const char* cB = (const char*)g.Bt + (size_t)cur.pn * tstep;
    S.a_ready(cur);
    PG8_STAGE(PG8_SB(0, 0), cB, voffB); PG8_STAGE(PG8_SA(0, 0), cA, voffA); PG8_STAGE(PG8_SB(0, 1), cB + hstep, voffB); PG8_STAGE(PG8_SA(0, 1), cA + hstep, voffA);
    if (wr == 1) PG8_BAR;
    PG8_WAIT_V(4); PG8_BAR;
    PG8_STAGE(PG8_SB(1, 0), cB + kstep, voffB); PG8_STAGE(PG8_SA(1, 0), cA + kstep, voffA); PG8_STAGE(PG8_SB(1, 1), cB + hstep + kstep, voffB);
    PG8_WAIT_V(6); PG8_BAR;
    PG8_STAMP();
    for (;;) {
        const bool has_next = S.next(ui + 1, nxt);
        const char* nA = has_next ? (const char*)g.A + (size_t)nxt.pm * tstep : cA; const char* nB = has_next ? (const char*)g.Bt + (size_t)nxt.pn * tstep : cB;
        for (int t = 0; t < nt; t += 2) {
            const bool last = (t == nt - 2);
            const char* a1 = cA + (size_t)(t + 1) * kstep;
            const char* a2 = last ? nA : cA + (size_t)(t + 2) * kstep; const char* b2 = last ? nB : cB + (size_t)(t + 2) * kstep;
            const char* a3 = a2 + kstep; const char* b3 = b2 + kstep;
            if (last && has_next) S.a_ready(nxt);
            PG8_LDB(B0, 0, 0); PG8_SCHED; PG8_LDA(At, 0, 0); PG8_STAGE(PG8_SA(1, 1), a1 + hstep, voffA);
            PG8_WAIT_L(8); PG8_BAR; PG8_WAIT_L(0); PG8_MMA(0, 0, At, B0); PG8_BAR; PG8_SCHED;
            PG8_LDB(B1, 0, 1); PG8_STAGE(PG8_SB(0, 0), b2, voffB);
            PG8_BAR; PG8_WAIT_L(0); PG8_MMA(0, 1, At, B1); PG8_BAR;
            PG8_LDA(At, 0, 1); PG8_STAGE(PG8_SA(0, 0), a2, voffA);
            PG8_BAR; PG8_WAIT_L(0); PG8_MMA(1, 0, At, B0); PG8_BAR; PG8_SCHED;
            PG8_STAGE(PG8_SB(0, 1), b2 + hstep, voffB);
            PG8_WAIT_V(6); PG8_BAR; PG8_MMA(1, 1, At, B1); PG8_BAR;
            PG8_LDB(B0, 1, 0); PG8_SCHED; PG8_LDA(At, 1, 0); PG8_STAGE(PG8_SA(0, 1), a2 + hstep, voffA);
            PG8_WAIT_L(8); PG8_BAR; PG8_WAIT_L(0); PG8_MMA(0, 0, At, B0); PG8_BAR; PG8_SCHED;
            PG8_LDB(B1, 1, 1); PG8_STAGE(PG8_SB(1, 0), b3, voffB);
            PG8_BAR; PG8_WAIT_L(0); PG8_MMA(0, 1, At, B1); PG8_BAR;
            PG8_LDA(At, 1, 1); PG8_STAGE(PG8_SA(1, 0), a3, voffA);
            PG8_BAR; PG8_WAIT_L(0); PG8_MMA(1, 0, At, B0); PG8_BAR; PG8_SCHED;
            PG8_STAGE(PG8_SB(1, 1), b3 + hstep, voffB);
            PG8_WAIT_V(6); PG8_BAR; PG8_MMA(1, 1, At, B1); PG8_BAR;
        }
        PG8_STAMP();
        if constexpr (!Epi::AFTER_DRAIN) { E(acc, cur, wr, wc, fr, fq); S.done(cur); }
        PG8_STAMP();
        if (!has_next) break;
#pragma unroll
        for (int a = 0; a < 2; ++a)
#pragma unroll
            for (int b = 0; b < 2; ++b)
#pragma unroll
                for (int m = 0; m < 4; ++m)
#pragma unroll
                    for (int n = 0; n < 2; ++n) acc[a][b][m][n] = (f32x4){0.f, 0.f, 0.f, 0.f};
        cur = nxt; cA = nA; cB = nB; ++ui;
    }
    PG8_WAIT_V(0);
    if (wr == 0) PG8_BAR;
    PG8_BAR;
    if constexpr (Epi::AFTER_DRAIN) { E.fused(acc, cur, wr, wc, fr, fq, lds, wid, lane); S.done(cur); }
    PG8_STAMP();
    if (STAMP && wid == 0) { stamps[lane] = lane < nts ? (((unsigned long long)(unsigned)ts_hi << 32) | (unsigned)ts_lo) : 0ull;
        if (lane == 62) stamps[62] = rt_entry; if (lane == 63) stamps[63] = (unsigned long long)wall_clock64(); }
#undef PG8_STAMP
#undef PG8_SA
#undef PG8_SB
#undef PG8_STAGE
#undef PG8_LDA
#undef PG8_LDB
#undef PG8_MMA
#undef PG8_WAIT_V
#undef PG8_WAIT_L
#undef PG8_BAR
#undef PG8_SCHED
}
}

DEVI uint4 pack8(const pg8::f32x4 a, const pg8::f32x4 b) { return make_uint4(pack2(a[0], a[1]), pack2(a[2], a[3]), pack2(b[0], b[1]), pack2(b[2], b[3])); }

constexpr int P1_N = IN_WP;
struct EpiInProj {
    static constexpr bool PERM = true, AFTER_DRAIN = false;
    unsigned char* ws;
    __device__ __forceinline__ void operator()(const pg8::f32x4 (&acc)[2][2][4][2], const pg8::Unit& u, int wr, int wc, int fr, int fq) const {
        const int row0 = u.pm * 256 + wr * 64 + fr;
        const int pn = u.pn;
        const int cl0 = wc * 32 + 8 * fq;
        bf16_t* dst; int ld, cbase, kind;
        if (pn < 2)       { dst = reinterpret_cast<bf16_t*>(ws + OFF_HQ);  ld = 512; cbase = pn * 256;        kind = 1; }
        else if (pn < 4)  { dst = reinterpret_cast<bf16_t*>(ws + OFF_HLF); ld = 512; cbase = (pn - 2) * 256;  kind = 2; }
        else if (pn < 6)  { dst = reinterpret_cast<bf16_t*>(ws + OFF_HV);  ld = 512; cbase = (pn - 4) * 256;  kind = 0; }
        else if (pn < 8)  { dst = reinterpret_cast<bf16_t*>(ws + OFF_HG);  ld = 512; cbase = (pn - 6) * 256;  kind = 1; }
        else if (pn == 8) { dst = reinterpret_cast<bf16_t*>(ws + OFF_GQ);  ld = 256; cbase = 0;               kind = 3; }
        else if (pn == 9) { dst = reinterpret_cast<bf16_t*>(ws + OFF_GK);  ld = 256; cbase = 0;               kind = 0; }
        else if (pn < 12) { dst = reinterpret_cast<bf16_t*>(ws + OFF_GV);  ld = 512; cbase = (pn - 10) * 256; kind = 0; }
        else if (pn < 14) { dst = reinterpret_cast<bf16_t*>(ws + OFF_GG);  ld = 512; cbase = (pn - 12) * 256; kind = 1; }
        else {
            if (wc == 0 && fq < 2) {
                float* gl = reinterpret_cast<float*>(ws + OFF_GLOW);
#pragma unroll
                for (int ai = 0; ai < 2; ++ai)
#pragma unroll
                    for (int m = 0; m < 4; ++m) {
                        float* rp = gl + (size_t)(row0 + ai * 128 + m * 16) * 16 + 8 * fq;
                        *reinterpret_cast<pg8::f32x4*>(rp) = acc[ai][0][m][0];
                        *reinterpret_cast<pg8::f32x4*>(rp + 4) = acc[ai][0][m][1];
                    }
            }
            return;
        }
        float lbv[2][8];
#pragma unroll
        for (int bj = 0; bj < 2; ++bj)
#pragma unroll
            for (int j = 0; j < 8; ++j) lbv[bj][j] = 0.f;
        if (kind == 2) {
            const float* lb = reinterpret_cast<const float*>(ws + OFF_LB);
#pragma unroll
            for (int bj = 0; bj < 2; ++bj)
#pragma unroll
                for (int j = 0; j < 8; ++j) lbv[bj][j] = lb[cbase + bj * 128 + cl0 + j];
        }
#pragma unroll
        for (int ai = 0; ai < 2; ++ai)
#pragma unroll
            for (int m = 0; m < 4; ++m) {
                bf16_t* rowp = dst + (size_t)(row0 + ai * 128 + m * 16) * ld + cbase + cl0;
#pragma unroll
                for (int bj = 0; bj < 2; ++bj) {
                    pg8::f32x4 v0 = acc[ai][bj][m][0], v1 = acc[ai][bj][m][1];
                    if (kind == 1) {
#pragma unroll
                        for (int j = 0; j < 4; ++j) { v0[j] = silu_f(v0[j]); v1[j] = silu_f(v1[j]); }
                    } else if (kind == 2) {
#pragma unroll
                        for (int j = 0; j < 4; ++j) {
                            const float l0 = lbv[bj][j], l1 = lbv[bj][4 + j];
                            v0[j] = __logf(l0 + (1.f - l0) * __builtin_amdgcn_rcpf(1.f + __expf(-v0[j])));
                            v1[j] = __logf(l1 + (1.f - l1) * __builtin_amdgcn_rcpf(1.f + __expf(-v1[j])));
                        }
                    } else if (kind == 3) {
#pragma unroll
                        for (int j = 0; j < 4; ++j) { v0[j] *= 0.125f; v1[j] *= 0.125f; }
                    }
                    *reinterpret_cast<uint4*>(rowp + bj * 128) = pack8(v0, v1);
                }
            }
    }
};
struct EpiOutProj {
    static constexpr bool PERM = false, AFTER_DRAIN = false;
    const float* x; float* out;
    __device__ __forceinline__ void operator()(const pg8::f32x4 (&acc)[2][2][4][2], const pg8::Unit& u, int wr, int wc, int fr, int fq) const {
        const int row0 = u.pm * 256 + wr * 64 + fr, col0 = u.pn * 256 + wc * 32 + 4 * fq;
#pragma unroll
        for (int ai = 0; ai < 2; ++ai)
#pragma unroll
            for (int m = 0; m < 4; ++m) {
                const size_t ro = (size_t)(row0 + ai * 128 + m * 16) * DM + col0;
#pragma unroll
                for (int bj = 0; bj < 2; ++bj)
#pragma unroll
                    for (int n = 0; n < 2; ++n) {
                        const pg8::f32x4 xv = *reinterpret_cast<const pg8::f32x4*>(x + ro + bj * 128 + n * 16);
                        *reinterpret_cast<pg8::f32x4*>(out + ro + bj * 128 + n * 16) = xv + acc[ai][bj][m][n];
                    }
            }
    }
};
struct EpiQ {
    static constexpr bool PERM = true, AFTER_DRAIN = false;
    bf16_t* Q;
    __device__ __forceinline__ void operator()(const pg8::f32x4 (&acc)[2][2][4][2], const pg8::Unit& u, int wr, int wc, int fr, int fq) const {
        const int row0 = u.pm * 256 + wr * 64 + fr, col0 = u.pn * 256 + wc * 32 + 8 * fq;
#pragma unroll
        for (int ai = 0; ai < 2; ++ai)
#pragma unroll
            for (int m = 0; m < 4; ++m) {
                bf16_t* rowp = Q + (size_t)(row0 + ai * 128 + m * 16) * 2048 + col0;
#pragma unroll
                for (int bj = 0; bj < 2; ++bj) *reinterpret_cast<uint4*>(rowp + bj * 128) = pack8(acc[ai][bj][m][0], acc[ai][bj][m][1]);
            }
    }
};
template <class Epi>
DEVI void run_gemm(const bf16_t* A, const bf16_t* Bt, int N, const Epi& E, char* smem) {
    pg8::Gemm g{A, Bt, M_TOK, N, 1024};
#if PROBE_GEMM_DUP
    struct DupOrder : pg8::StaticOrder { __host__ __device__ bool next(int i, pg8::Unit& u) const { return pg8::StaticOrder::next(i >> 1, u); } };
    DupOrder S; S.init(M_TOK, N, (int)gridDim.x, (int)blockIdx.x);
    pg8::gemm_phase<Epi, DupOrder, false>((PG8_LAS unsigned char*)smem, g, S, E, nullptr);
#else
    pg8::StaticOrder S; S.init(M_TOK, N, (int)gridDim.x, (int)blockIdx.x);
    pg8::gemm_phase<Epi, pg8::StaticOrder, false>((PG8_LAS unsigned char*)smem, g, S, E, nullptr);
#endif
    __builtin_amdgcn_s_waitcnt(0);
}

constexpr int P2_UNITS = 512 * 3;
DEVI float logsigmoid_f(float z) { return fminf(z, 0.f) - __logf(1.f + __expf(-fabsf(z))); }

template <bool DRY>
DEVI void phase2_unit_t(const Params& p, int u, char* smem) {
    unsigned char* ws = p.ws;
    const int tid = LTID;
    const int cidx = u / 3, part = u % 3;
    const size_t row0 = (size_t)cidx * 64;
    if (part >= 3) {
        const bool isg = part >= 5; const int n = ((part - 3) & 1) * 256 + tid;
        const bf16_t* V = reinterpret_cast<const bf16_t*>(ws + (isg ? OFF_GV : OFF_HV));
        bf16_t* VT = reinterpret_cast<bf16_t*>(ws + (isg ? OFF_GVT : OFF_HVT));
#pragma unroll 1
        for (int hf = 0; hf < 4; ++hf) {
            unsigned short vb[16];
#pragma unroll
            for (int r = 0; r < 16; ++r) vb[r] = V[(row0 + hf * 16 + r) * 512 + n];
#pragma unroll
            for (int r8 = 0; r8 < 2; ++r8) {
                unsigned pk[4];
#pragma unroll
                for (int rr = 0; rr < 8; ++rr) {
                    const unsigned short b = vb[r8 * 8 + rr];
                    if (rr & 1) pk[rr >> 1] |= ((unsigned)b << 16); else pk[rr >> 1] = b;
                }
                *reinterpret_cast<uint4*>(VT + ((size_t)cidx * 512 + n) * 64 + hf * 16 + r8 * 8) = make_uint4(pk[0], pk[1], pk[2], pk[3]);
            }
        }
        return;
    }
    if (part < 2) {
        const int n = part * 256 + tid;
        bf16_t* HQ = reinterpret_cast<bf16_t*>(ws + OFF_HQ);
        bf16_t* HLF = reinterpret_cast<bf16_t*>(ws + OFF_HLF);
        float Gl = 0.f;
#pragma unroll 16
        for (int r = 0; r < 64; ++r) Gl += bf2f(HLF[(row0 + r) * 512 + n]);
        float G = 0.f;
#pragma unroll 1
        for (int hf = 0; hf < 4; ++hf) {
            unsigned short lfb[16], qb[16];
#pragma unroll
            for (int r = 0; r < 16; ++r) { lfb[r] = HLF[(row0 + hf * 16 + r) * 512 + n]; qb[r] = HQ[(row0 + hf * 16 + r) * 512 + n]; }
#pragma unroll
            for (int r8 = 0; r8 < 2; ++r8) {
                unsigned pk[4];
#pragma unroll
                for (int rr = 0; rr < 8; ++rr) {
                    const int r = r8 * 8 + rr;
                    const size_t idx = (row0 + hf * 16 + r) * 512 + n;
                    const float lf = bf2f(lfb[r]);
                    G += lf;
                    const float key = 1.f - __expf(lf);
                    const unsigned short bq = f2bf(bf2f(qb[r]) * __expf(G));
                    const unsigned short bk = f2bf(key * __expf(-G));
                    if (DRY) { reinterpret_cast<bf16_t*>(ws + OFF_XN)[idx] = bq; reinterpret_cast<bf16_t*>(ws + OFF_XN + 32 * MiB)[idx] = bk; } else { HQ[idx] = bq; HLF[idx] = bk; }
                    if (rr & 1) pk[rr >> 1] |= ((unsigned)bk << 16); else pk[rr >> 1] = bk;
                }
            }
        }
        reinterpret_cast<float*>(DRY ? reinterpret_cast<unsigned char*>(p.out) + 64 * MiB : ws + OFF_DECH)[(size_t)cidx * 512 + n] = __expf(Gl);
    } else {
        const int n = tid;
        bf16_t* GQ = reinterpret_cast<bf16_t*>(ws + OFF_GQ);
        bf16_t* GK = reinterpret_cast<bf16_t*>(ws + OFF_GK);
        const float* GL = reinterpret_cast<const float*>(ws + OFF_GLOW);
        float wg[16];
#pragma unroll
        for (int j = 0; j < 16; ++j) wg[j] = p.gla_wg[j * 256 + n];
        const float bg = p.gla_bg[n];
        float Gl = 0.f, G = 0.f;
#pragma unroll 1
        for (int hf = 0; hf < 4; ++hf) {
            unsigned short qb[16], kb[16]; float lgv[16];
#pragma unroll
            for (int r = 0; r < 16; ++r) { qb[r] = GQ[(row0 + hf * 16 + r) * 256 + n]; kb[r] = GK[(row0 + hf * 16 + r) * 256 + n]; }
#pragma unroll
            for (int r = 0; r < 16; ++r) {
                const float4* g4 = reinterpret_cast<const float4*>(GL + (row0 + hf * 16 + r) * 16);
                float z = bg;
#pragma unroll
                for (int j = 0; j < 4; ++j) { const float4 t = g4[j]; z += t.x * wg[4 * j] + t.y * wg[4 * j + 1] + t.z * wg[4 * j + 2] + t.w * wg[4 * j + 3]; }
                lgv[r] = logsigmoid_f(z) * (1.f / 16.f);
            }
#pragma unroll
            for (int r8 = 0; r8 < 2; ++r8) {
                unsigned pk[4];
#pragma unroll
                for (int rr = 0; rr < 8; ++rr) {
                    const int r = r8 * 8 + rr;
                    G += lgv[r];
                    const size_t idx = (row0 + hf * 16 + r) * 256 + n;
                    const unsigned short bq = f2bf(bf2f(qb[r]) * __expf(G));
                    const unsigned short bk = f2bf(bf2f(kb[r]) * __expf(-G));
                    GQ[idx] = bq; GK[idx] = bk;
                    if (rr & 1) pk[rr >> 1] |= ((unsigned)bk << 16); else pk[rr >> 1] = bk;
                }
            }
        }
        Gl = G;
        reinterpret_cast<float*>(ws + OFF_DECG)[(size_t)cidx * 256 + n] = __expf(Gl);
    }
}

DEVI void phase2_unit(const Params& p, int u, char* smem) { phase2_unit_t<false>(p, u, smem); }
DEVI void phase2_dry_unit(const Params& p, int u, char* smem) { if ((u % 7) < 2) phase2_unit_t<true>(p, u, smem); }

DEVI unsigned off_b(unsigned row, unsigned ch) { return 256u * row + 16u * (ch ^ (((row & 3u) << 2) | ((row >> 2) & 3u))); }
DEVI unsigned tr_addr16(unsigned lane, unsigned c, unsigned ks, unsigned t) {
    const unsigned g = lane >> 4, q = (lane & 15u) >> 2, pp = lane & 3u;
    return off_b(32u * ks + 8u * g + 4u * t + q, 2u * c + (pp >> 1)) + 8u * (pp & 1u);
}
typedef unsigned short u16x4_t __attribute__((ext_vector_type(4)));
DEVI bf16x8 tr_frag(unsigned base, unsigned lane, unsigned c, unsigned ks) {
    u16x4_t a, b;
    asm volatile("ds_read_b64_tr_b16 %0, %2\n\tds_read_b64_tr_b16 %1, %3\n\ts_waitcnt lgkmcnt(0)" : "=&v"(a), "=&v"(b) : "v"(base + tr_addr16(lane, c, ks, 0)), "v"(base + tr_addr16(lane, c, ks, 1)) : "memory");
    bf16x8 r;
    r[0] = (short)a[0]; r[1] = (short)a[1]; r[2] = (short)a[2]; r[3] = (short)a[3]; r[4] = (short)b[0]; r[5] = (short)b[1]; r[6] = (short)b[2]; r[7] = (short)b[3];
    return r;
}
DEVI bf16x8 row_frag(const char* tile, unsigned lane, unsigned rb, unsigned s) { return *reinterpret_cast<const bf16x8*>(tile + off_b((lane & 15u) + 16u * rb, 4u * s + (lane >> 4))); }
DEVI void fill_tile64(char* tile, const bf16_t* __restrict__ g, int ldg) {
#pragma unroll
    for (int i = 0; i < 4; ++i) {
        const int n = LTID + 256 * i, row = n >> 4, ch = n & 15;
        *reinterpret_cast<uint4*>(tile + off_b(row, ch)) = *reinterpret_cast<const uint4*>(g + (size_t)row * ldg + ch * 8);
    }
}
DEVI void fill_tile64x64(char* tile, const bf16_t* __restrict__ g, int ldg) {
#pragma unroll
    for (int i = 0; i < 2; ++i) {
        const int n = LTID + 256 * i, row = n >> 3, ch = n & 7;
        *reinterpret_cast<uint4*>(tile + off_b(row, ch)) = *reinterpret_cast<const uint4*>(g + (size_t)row * ldg + ch * 8);
    }
}

constexpr int P3_UNITS = 4096;
template <int DK>
DEVI void kv_unit(const Params& p, int sidx, int c, char* smem) {
    unsigned char* ws = p.ws;
    const int lane = LTID & 63, w = LTID >> 6;
    const int b = sidx >> 2, h = sidx & 3;
    const int cidx = b * 128 + c;
    constexpr int NDB = DK / 16;
    const bf16_t* Kn = reinterpret_cast<const bf16_t*>(ws + (DK == 128 ? OFF_HLF : OFF_GK)) + (size_t)cidx * 64 * (4 * DK) + h * DK;
    const bf16_t* V = reinterpret_cast<const bf16_t*>(ws + (DK == 128 ? OFF_HV : OFF_GV)) + (size_t)cidx * 64 * 512 + h * 128;
    const float* DEC = reinterpret_cast<const float*>(ws + (DK == 128 ? OFF_DECH : OFF_DECG)) + (size_t)cidx * (4 * DK) + h * DK;
    bf16_t* ST = reinterpret_cast<bf16_t*>(reinterpret_cast<unsigned char*>(p.out) + (DK == 128 ? OUT_STH : OUT_STG)) + ((size_t)sidx * 128 + c) * (128 * DK);
    f32x4 acc[NDB][2];
#pragma unroll
    for (int i = 0; i < NDB; ++i) { acc[i][0] = f32x4{0, 0, 0, 0}; acc[i][1] = f32x4{0, 0, 0, 0}; }
    const int fo = (lane & 15) * 64 + 8 * (lane >> 4);
    fill_tile64(smem, V, 512);
    if (DK == 128) fill_tile64(smem + 16384, Kn, 512); else fill_tile64x64(smem + 16384, Kn, 256);
    __syncthreads();
    const unsigned tbase = (unsigned)(size_t)smem, kbase = tbase + 16384u;
#pragma unroll
    for (int ks = 0; ks < 2; ++ks) {
        bf16x8 bv[2];
#pragma unroll
        for (int nb = 0; nb < 2; ++nb) bv[nb] = tr_frag(tbase, (unsigned)lane, (unsigned)(2 * w + nb), (unsigned)ks);
#pragma unroll
        for (int db = 0; db < NDB; ++db) {
            const bf16x8 ak = tr_frag(kbase, (unsigned)lane, (unsigned)db, (unsigned)ks);
            acc[db][0] = mfma16(ak, bv[0], acc[db][0]);
            acc[db][1] = mfma16(ak, bv[1], acc[db][1]);
        }
    }
#pragma unroll
    for (int db = 0; db < NDB; ++db) {
        const int d = db * 16 + 4 * (lane >> 4);
        const float4 dc = *reinterpret_cast<const float4*>(DEC + d);
#pragma unroll
        for (int nb = 0; nb < 2; ++nb) {
            const int dv = 32 * w + nb * 16 + (lane & 15);
            uint2 o; o.x = pack2(acc[db][nb][0] * dc.x, acc[db][nb][1] * dc.y); o.y = pack2(acc[db][nb][2] * dc.z, acc[db][nb][3] * dc.w);
            *reinterpret_cast<uint2*>(ST + (size_t)dv * DK + d) = o;
        }
    }
    __syncthreads();
}
DEVI void phase3_unit(const Params& p, int u, char* smem) {
    if (u < 2048) kv_unit<128>(p, u >> 7, u & 127, smem); else { u -= 2048; kv_unit<64>(p, u >> 7, u & 127, smem); }
}

constexpr int P4_UNITS = 384;
template <bool DRY>
DEVI void phase4_unit_t(const Params& p, int u, char* smem) {
    unsigned char* ws = p.ws;
    int e = u * 256 + LTID;
    bf16_t* base; bf16_t* sbase; const float* dec; size_t cstride; int decstride;
    if (e < 65536) {
        const int sidx = e >> 12, rem = e & 4095, dv = rem >> 5, d4 = (rem & 31) * 4;
        const int b = sidx >> 2, h = sidx & 3;
        base = reinterpret_cast<bf16_t*>(reinterpret_cast<unsigned char*>(p.out) + OUT_STH) + ((size_t)sidx * 128) * 16384 + dv * 128 + d4;
        sbase = DRY ? reinterpret_cast<bf16_t*>(ws + OFF_XN) + ((size_t)sidx * 128) * 16384 + dv * 128 + d4 : base;
        cstride = 16384;
        dec = reinterpret_cast<const float*>(ws + OFF_DECH) + (size_t)(b * 128) * 512 + h * 128 + d4; decstride = 512;
    } else {
        e -= 65536;
        const int sidx = e >> 11, rem = e & 2047, dv = rem >> 4, d4 = (rem & 15) * 4;
        const int b = sidx >> 2, h = sidx & 3;
        base = reinterpret_cast<bf16_t*>(reinterpret_cast<unsigned char*>(p.out) + OUT_STG) + ((size_t)sidx * 128) * 8192 + dv * 64 + d4;
        sbase = DRY ? reinterpret_cast<bf16_t*>(ws + OFF_KTH) + ((size_t)sidx * 128) * 8192 + dv * 64 + d4 : base;
        cstride = 8192;
        dec = reinterpret_cast<const float*>(ws + OFF_DECG) + (size_t)(b * 128) * 256 + h * 64 + d4; decstride = 256;
    }
    float s0 = 0.f, s1 = 0.f, s2 = 0.f, s3 = 0.f;
    for (int c8 = 0; c8 < 128; c8 += 8) {
        uint2 kv[8]; float4 dc[8];
#pragma unroll
        for (int i = 0; i < 8; ++i) { kv[i] = *reinterpret_cast<const uint2*>(base + (size_t)(c8 + i) * cstride); dc[i] = *reinterpret_cast<const float4*>(dec + (size_t)(c8 + i) * decstride); }
#pragma unroll
        for (int i = 0; i < 8; ++i) {
            uint2 o; o.x = pack2(s0, s1); o.y = pack2(s2, s3);
            *reinterpret_cast<uint2*>(sbase + (size_t)(c8 + i) * cstride) = o;
            s0 = dc[i].x * s0 + bflo(kv[i].x); s1 = dc[i].y * s1 + bfhi(kv[i].x);
            s2 = dc[i].z * s2 + bflo(kv[i].y); s3 = dc[i].w * s3 + bfhi(kv[i].y);
        }
    }
}

DEVI void phase4_unit(const Params& p, int u, char* smem) { phase4_unit_t<false>(p, u, smem); }
DEVI void phase4_dry_unit(const Params& p, int u, char* smem) { phase4_unit_t<true>(p, u, smem); }

constexpr int P5_UNITS = 4096;
constexpr int PL_PITCH = 72;
template <int DK>
DEVI void out_unit(const Params& p, int sidx, int c, char* smem) {
    unsigned char* ws = p.ws;
    const int lane = LTID & 63, w = LTID >> 6;
    const int b = sidx >> 2, h = sidx & 3;
    const int cidx = b * 128 + c;
    const size_t row0 = (size_t)cidx * 64;
    constexpr int LDQ = 4 * DK;
    const bf16_t* Qn = reinterpret_cast<const bf16_t*>(ws + (DK == 128 ? OFF_HQ : OFF_GQ)) + row0 * LDQ + h * DK;
    const bf16_t* Kn = reinterpret_cast<const bf16_t*>(ws + (DK == 128 ? OFF_HLF : OFF_GK)) + row0 * LDQ + h * DK;
    const bf16_t* V = reinterpret_cast<const bf16_t*>(ws + (DK == 128 ? OFF_HV : OFF_GV)) + row0 * 512 + h * 128;
    const bf16_t* ST = reinterpret_cast<const bf16_t*>(reinterpret_cast<const unsigned char*>(p.out) + (DK == 128 ? OUT_STH : OUT_STG)) + ((size_t)sidx * 128 + c) * (128 * DK);
    const bf16_t* GATE = reinterpret_cast<const bf16_t*>(ws + (DK == 128 ? OFF_HG : OFF_GG)) + row0 * 512 + h * 128;
    const float* ng = (DK == 128) ? p.hg_norm_g : p.gla_norm_g;
    bf16_t* MIX = reinterpret_cast<bf16_t*>(ws + OFF_MIX) + row0 * 1024 + (DK == 128 ? 0 : 512) + h * 128;
    bf16_t* PL = reinterpret_cast<bf16_t*>(smem);
    float* RED = reinterpret_cast<float*>(smem + 64 * PL_PITCH * 2);

    const int l15 = lane & 15, lg = lane >> 4;
    bf16x8 ast[DK / 32][2];
    uint2 gtv[4][2]; float4 g4v[2];
    char* vtile = smem + 16384;
    char* qtile = smem + 32768;
    char* ktile = smem + 49152;
    fill_tile64(vtile, V, 512);
    if (DK == 128) { fill_tile64(qtile, Qn, LDQ); fill_tile64(ktile, Kn, LDQ); } else { fill_tile64x64(qtile, Qn, LDQ); fill_tile64x64(ktile, Kn, LDQ); }
#pragma unroll
    for (int ks = 0; ks < DK / 32; ++ks) {
#pragma unroll
        for (int x = 0; x < 2; ++x) ast[ks][x] = ldg_frag(ST + (size_t)((2 * w + x) * 16 + l15) * DK + ks * 32 + 8 * lg);
    }
#pragma unroll
    for (int x = 0; x < 2; ++x) {
        g4v[x] = *reinterpret_cast<const float4*>(ng + (2 * w + x) * 16 + 4 * lg);
#pragma unroll
        for (int y = 0; y < 4; ++y) gtv[y][x] = *reinterpret_cast<const uint2*>(GATE + (size_t)(y * 16 + l15) * 512 + (2 * w + x) * 16 + 4 * lg);
    }
    __syncthreads();
    {
        bf16x8 bq[DK / 32];
#pragma unroll
        for (int ks = 0; ks < DK / 32; ++ks) bq[ks] = row_frag(qtile, (unsigned)lane, (unsigned)w, (unsigned)ks);
#pragma unroll
        for (int jb = 0; jb < 4; ++jb) {
            f32x4 a = f32x4{0, 0, 0, 0};
            if (jb <= w) {
#pragma unroll
                for (int ks = 0; ks < DK / 32; ++ks) {
                    const bf16x8 ak = row_frag(ktile, (unsigned)lane, (unsigned)jb, (unsigned)ks);
                    a = mfma16(ak, bq[ks], a);
                }
            }
            const int i = w * 16 + l15, j0 = jb * 16 + 4 * lg;
            const float v0 = (j0 + 0 <= i) ? a[0] : 0.f, v1 = (j0 + 1 <= i) ? a[1] : 0.f, v2 = (j0 + 2 <= i) ? a[2] : 0.f, v3 = (j0 + 3 <= i) ? a[3] : 0.f;
            uint2 o; o.x = pack2(v0, v1); o.y = pack2(v2, v3);
            *reinterpret_cast<uint2*>(PL + i * PL_PITCH + j0) = o;
        }
    }
    __syncthreads();
    f32x4 acc[2][4];
#pragma unroll
    for (int x = 0; x < 2; ++x)
#pragma unroll
        for (int y = 0; y < 4; ++y) acc[x][y] = f32x4{0, 0, 0, 0};
#pragma unroll
    for (int ks = 0; ks < 2; ++ks) {
        bf16x8 bp[4], avx[2];
#pragma unroll
        for (int x = 0; x < 2; ++x) avx[x] = tr_frag((unsigned)(size_t)vtile, (unsigned)lane, (unsigned)(2 * w + x), (unsigned)ks);
#pragma unroll
        for (int y = 0; y < 4; ++y) bp[y] = *reinterpret_cast<const bf16x8*>(PL + (y * 16 + l15) * PL_PITCH + ks * 32 + 8 * lg);
#pragma unroll
        for (int x = 0; x < 2; ++x)
#pragma unroll
            for (int y = 0; y < 4; ++y) acc[x][y] = mfma16(avx[x], bp[y], acc[x][y]);
    }
#pragma unroll
    for (int ks = 0; ks < DK / 32; ++ks) {
#pragma unroll
        for (int x = 0; x < 2; ++x)
#pragma unroll
            for (int y = 0; y < 4; ++y) acc[x][y] = mfma16(ast[ks][x], row_frag(qtile, (unsigned)lane, (unsigned)y, (unsigned)ks), acc[x][y]);
    }
    float ssq[4];
#pragma unroll
    for (int y = 0; y < 4; ++y) {
        float s = 0.f;
#pragma unroll
        for (int x = 0; x < 2; ++x)
#pragma unroll
            for (int r = 0; r < 4; ++r) s += acc[x][y][r] * acc[x][y][r];
        s += __shfl_xor(s, 16); s += __shfl_xor(s, 32);
        ssq[y] = s;
    }
    if (lg == 0) {
#pragma unroll
        for (int y = 0; y < 4; ++y) RED[w * 64 + y * 16 + l15] = ssq[y];
    }
    __syncthreads();
#pragma unroll
    for (int y = 0; y < 4; ++y) {
        const int i = y * 16 + l15;
        const float tot = RED[i] + RED[64 + i] + RED[128 + i] + RED[192 + i];
        const float rstd = rsqrtf(tot * (1.f / 128.f) + 1e-6f);
#pragma unroll
        for (int x = 0; x < 2; ++x) {
            const int dv = (2 * w + x) * 16 + 4 * lg;
            const float4 g4 = g4v[x];
            const uint2 gt = gtv[y][x];
            uint2 o;
            o.x = pack2(acc[x][y][0] * rstd * g4.x * bflo(gt.x), acc[x][y][1] * rstd * g4.y * bfhi(gt.x));
            o.y = pack2(acc[x][y][2] * rstd * g4.z * bflo(gt.y), acc[x][y][3] * rstd * g4.w * bfhi(gt.y));
            *reinterpret_cast<uint2*>(MIX + (size_t)i * 1024 + dv) = o;
        }
    }
    __syncthreads();
}
DEVI void phase5_unit(const Params& p, int u, char* smem) {
    if (u < 2048) out_unit<128>(p, u >> 7, u & 127, smem); else { u -= 2048; out_unit<64>(p, u >> 7, u & 127, smem); }
}

DEVI void rms_row_bf16_i8(const float* __restrict__ xr, const float* __restrict__ g, bf16_t* __restrict__ dst, unsigned char* __restrict__ dst8, float* __restrict__ descale, int lane) {
    float4 v[4]; float ss = 0.f;
#pragma unroll
    for (int i = 0; i < 4; ++i) { v[i] = reinterpret_cast<const float4*>(xr)[lane + 64 * i]; ss += v[i].x * v[i].x + v[i].y * v[i].y + v[i].z * v[i].z + v[i].w * v[i].w; }
    ss = wave_sum(ss);
    const float r = rsqrtf(ss * (1.f / 1024.f) + 1e-6f);
    float am = 0.f;
#pragma unroll
    for (int i = 0; i < 4; ++i) {
        const float4 gg = reinterpret_cast<const float4*>(g)[lane + 64 * i];
        v[i].x *= r * gg.x; v[i].y *= r * gg.y; v[i].z *= r * gg.z; v[i].w *= r * gg.w;
        uint2 o; o.x = pack2(v[i].x, v[i].y); o.y = pack2(v[i].z, v[i].w);
        reinterpret_cast<uint2*>(dst)[lane + 64 * i] = o;
        am = fmaxf(am, fmaxf(fmaxf(fabsf(v[i].x), fabsf(v[i].y)), fmaxf(fabsf(v[i].z), fabsf(v[i].w))));
    }
    am = wave_max(am);
    const float sc = am > 0.f ? 127.f / am : 1.f;
#pragma unroll
    for (int i = 0; i < 4; ++i) reinterpret_cast<int*>(dst8)[lane + 64 * i] = pack_i8x4(v[i].x * sc, v[i].y * sc, v[i].z * sc, v[i].w * sc);
    if (lane == 0) *descale = am > 0.f ? am * (1.f / 127.f) : 1.f;
}
constexpr int P7_UNITS = 8192;
DEVI void phase7_unit(const Params& p, int u, char* smem) {
    const int lane = LTID & 63, w = LTID >> 6;
    const int row = u * 4 + w;
    rms_row_bf16_i8(p.out + (size_t)row * DM, p.norm2_g, reinterpret_cast<bf16_t*>(p.ws + OFF_HN) + (size_t)row * DM,
                    p.ws + OFF_HN8 + (size_t)row * DM, reinterpret_cast<float*>(p.ws + OFF_HS) + row, lane);
}

using f32x16 = __attribute__((ext_vector_type(16))) float;
DEVI f32x16 mfma32(bf16x8 a, bf16x8 b, f32x16 c) { return __builtin_amdgcn_mfma_f32_32x32x16_bf16(a, b, c, 0, 0, 0); }
DEVI unsigned umax(unsigned a, unsigned b) { return a > b ? a : b; }
DEVI unsigned umin(unsigned a, unsigned b) { return a > b ? b : a; }
DEVI unsigned f2ord(float f) { const unsigned u = __float_as_uint(f); return u ^ ((unsigned)((int)u >> 31) | 0x80000000u); }
DEVI float ord2f(unsigned k) { return __uint_as_float((k & 0x80000000u) ? (k ^ 0x80000000u) : ~k); }

template <int BASE>
DEVI void sort16_desc(unsigned (&x)[64]) {
#pragma unroll
    for (int k = 2; k <= 16; k <<= 1) {
#pragma unroll
        for (int j = k >> 1; j > 0; j >>= 1) {
#pragma unroll
            for (int i = 0; i < 16; ++i) {
                const int l = i ^ j;
                if (l > i) {
                    const bool desc = ((i & k) == 0);
                    const unsigned a = x[BASE + i], b = x[BASE + l];
                    const unsigned hi = umax(a, b), lo = umin(a, b);
                    x[BASE + i] = desc ? hi : lo; x[BASE + l] = desc ? lo : hi;
                }
            }
        }
    }
}
template <int BASE>
DEVI void bmerge16_desc(unsigned (&x)[64]) {
#pragma unroll
    for (int j = 8; j > 0; j >>= 1) {
#pragma unroll
        for (int i = 0; i < 16; ++i) {
            const int l = i ^ j;
            if (l > i) { const unsigned a = x[BASE + i], b = x[BASE + l]; x[BASE + i] = umax(a, b); x[BASE + l] = umin(a, b); }
        }
    }
}
DEVI void top16_of_64(unsigned (&x)[64]) {
    sort16_desc<0>(x); sort16_desc<16>(x); sort16_desc<32>(x); sort16_desc<48>(x);
#pragma unroll
    for (int i = 0; i < 16; ++i) x[i] = umax(x[i], x[31 - i]);
    bmerge16_desc<0>(x);
#pragma unroll
    for (int i = 0; i < 16; ++i) x[32 + i] = umax(x[32 + i], x[63 - i]);
    bmerge16_desc<32>(x);
#pragma unroll
    for (int i = 0; i < 16; ++i) x[i] = umax(x[i], x[47 - i]);
    bmerge16_desc<0>(x);
}

DEVI void scores_top16(const char* sktile, const bf16_t* __restrict__ Qp, int lane, unsigned (&out)[16]) {
    const int r31 = lane & 31, hh = lane >> 5;
    f32x16 acc[4];
#pragma unroll
    for (int nb = 0; nb < 4; ++nb)
#pragma unroll
        for (int r = 0; r < 16; ++r) acc[nb][r] = 0.f;
#pragma unroll
    for (int ks = 0; ks < 8; ++ks) {
        const bf16x8 bq = ldg_frag(Qp + (size_t)r31 * 2048 + ks * 16 + 8 * hh);
#pragma unroll
        for (int nb = 0; nb < 4; ++nb) {
            const bf16x8 ak = *reinterpret_cast<const bf16x8*>(sktile + off_b((unsigned)(nb * 32 + r31), (unsigned)(2 * ks + hh)));
            acc[nb] = mfma32(ak, bq, acc[nb]);
        }
    }
    unsigned x[64];
    const unsigned hx = (unsigned)hh * 4u;
#pragma unroll
    for (int nb = 0; nb < 4; ++nb)
#pragma unroll
        for (int r = 0; r < 16; ++r) {
            const int nbase = nb * 32 + (r & 3) + 8 * (r >> 2);
            x[nb * 16 + r] = ((f2ord(acc[nb][r]) & ~127u) | (unsigned)(127 - nbase)) ^ hx;
        }
    top16_of_64(x);
    unsigned lo[16], hi[16];
#pragma unroll
    for (int i = 0; i < 16; ++i) { auto rr = __builtin_amdgcn_permlane32_swap(x[i], x[i], false, false); lo[i] = rr[0]; hi[i] = rr[1]; }
#pragma unroll
    for (int i = 0; i < 16; ++i) x[i] = umax(lo[i], hi[15 - i]);
    bmerge16_desc<0>(x);
#pragma unroll
    for (int i = 0; i < 16; ++i) out[i] = x[i];
}

DEVI void phase9_block(const Params& p, char* smem) {
    unsigned char* ws = p.ws;
    const int tid = threadIdx.x, lane = tid & 63, w = tid >> 6;
    const int h = blockIdx.x & 7, rank = blockIdx.x >> 3, nrank = ((int)gridDim.x - h + 7) >> 3;
    const int hh = lane >> 5;
    {
        const bf16_t* SK = reinterpret_cast<const bf16_t*>(ws + OFF_SK) + (size_t)(h * 2) * 128 * 128;
#pragma unroll
        for (int i = 0; i < 8; ++i) {
            const int nn = tid + 512 * i, tl = nn >> 11, row = (nn >> 4) & 127, ch = nn & 15;
            *reinterpret_cast<uint4*>(smem + tl * 32768 + off_b((unsigned)row, (unsigned)ch)) = *reinterpret_cast<const uint4*>(SK + (size_t)tl * 16384 + row * 128 + ch * 8);
        }
    }
    __syncthreads();
    unsigned* KL = reinterpret_cast<unsigned*>(smem + 65536) + w * 2048;
    for (int it = rank; it < M_TOK / 256; it += nrank) {
    const int t0 = it * 256 + w * 32;
    const bf16_t* Q = reinterpret_cast<const bf16_t*>(ws + OFF_Q) + (size_t)t0 * 2048 + h * 256;
    unsigned k0[16], k1[16];
    scores_top16(smem, Q, lane, k0);
    scores_top16(smem + 32768, Q + 128, lane, k1);
#pragma unroll
    for (int i = 0; i < 16; ++i) { KL[i * 64 + lane] = k0[i]; KL[(16 + i) * 64 + lane] = k1[i]; }
    float s0[16], s1[16];
#pragma unroll
    for (int i = 0; i < 16; ++i) { s0[i] = ord2f(k0[i] & ~127u); s1[i] = ord2f(k1[i] & ~127u); }
    unsigned x[64];
    {
        int n = 0;
#pragma unroll
        for (int a = 0; a < 16; ++a)
#pragma unroll
            for (int b = 0; b < 16; ++b)
                if ((a + 1) * (b + 1) <= 16) { x[n] = (f2ord(s0[a] + s1[b]) & ~255u) | (unsigned)(255 - (a * 16 + b)); ++n; }
#pragma unroll
        for (int i = 50; i < 64; ++i) x[i] = 0u;
    }
    top16_of_64(x);
    float cv[16]; int ex[16];
#pragma unroll
    for (int i = 0; i < 16; ++i) {
        cv[i] = ord2f(x[i] & ~255u);
        const int cid = 255 - (int)(x[i] & 255u);
        const unsigned ka = KL[(cid >> 4) * 64 + lane], kb = KL[(16 + (cid & 15)) * 64 + lane];
        ex[i] = (127 - (int)(ka & 127u)) * 128 + (127 - (int)(kb & 127u));
    }
    float sum = 0.f;
    const float mx = cv[0];
#pragma unroll
    for (int i = 0; i < 16; ++i) cv[i] = __expf(cv[i] - mx);
#pragma unroll
    for (int i = 0; i < 16; ++i) sum += cv[i];
    const float inv = __builtin_amdgcn_rcpf(sum);
    const size_t orow = (size_t)(t0 + (lane & 31)) * 128 + h * 16;
    if (hh == 0) {
        int4* d = reinterpret_cast<int4*>(reinterpret_cast<int*>(ws + OFF_EIDX) + orow);
#pragma unroll
        for (int i = 0; i < 4; ++i) d[i] = make_int4(ex[4 * i], ex[4 * i + 1], ex[4 * i + 2], ex[4 * i + 3]);
        const float* US = reinterpret_cast<const float*>(ws + OFF_US);
        float4* du = reinterpret_cast<float4*>(reinterpret_cast<float*>(ws + OFF_EU) + orow);
#pragma unroll
        for (int i = 0; i < 4; ++i) du[i] = make_float4(US[ex[4 * i]], US[ex[4 * i + 1]], US[ex[4 * i + 2]], US[ex[4 * i + 3]]);
    } else {
        const float* VS = reinterpret_cast<const float*>(ws + OFF_VS);
        float4* d = reinterpret_cast<float4*>(reinterpret_cast<float*>(ws + OFF_EW) + orow);
#pragma unroll
        for (int i = 0; i < 4; ++i) d[i] = make_float4(cv[4 * i] * inv * VS[ex[4 * i]], cv[4 * i + 1] * inv * VS[ex[4 * i + 1]], cv[4 * i + 2] * inv * VS[ex[4 * i + 2]], cv[4 * i + 3] * inv * VS[ex[4 * i + 3]]);
        }
}
}

typedef _Float16 h2_t __attribute__((ext_vector_type(2)));
DEVI float sum8(float v) { v += dpp_f<0xB1>(v); v += dpp_f<0x4E>(v); v += dpp_f<0x141>(v); return v; }
DEVI float sum64(float v) {
    v = sum8(v); v += dpp_f<0x128>(v);
    { auto s = __builtin_amdgcn_permlane16_swap(__float_as_uint(v), __float_as_uint(v), false, false); v = __uint_as_float(s[0]) + __uint_as_float(s[1]); }
    { auto s = __builtin_amdgcn_permlane32_swap(__float_as_uint(v), __float_as_uint(v), false, false); v = __uint_as_float(s[0]) + __uint_as_float(s[1]); }
    return v;
}
DEVI long pack_i64(unsigned lo, unsigned hi) { return (long)(((unsigned long long)hi << 32) | (unsigned long long)lo); }

#define SB __builtin_amdgcn_sched_barrier(0)
#define SB __builtin_amdgcn_sched_barrier(0)
#define PIN4(Q) "+v"(Q.x), "+v"(Q.y), "+v"(Q.z), "+v"(Q.w)
DEVI void phase10a_block(const Params& p, char* smem) {
    unsigned char* ws = p.ws;
    const int s = blockIdx.x & 7, rank = blockIdx.x >> 3, nrank = ((int)gridDim.x - s + 7) >> 3;
    const int lane = threadIdx.x & 63, wave = threadIdx.x >> 6;
    const int lg = lane & 7, grp = lane >> 3;
    const unsigned char* U8 = ws + OFF_U8 + (size_t)s * (16384 * 128);
    const unsigned char* HNs = ws + OFF_HN8 + 128 * s + 16 * lg;
    float* PD = reinterpret_cast<float*>(ws + OFF_PD) + (size_t)s * M_TOK * 128;
    float* stg = reinterpret_cast<float*>(smem) + wave * (16 * 128);
    constexpr int NTG = M_TOK / 8;
#define P10A_LOAD_EV(TG, E) do { const int4* _q = reinterpret_cast<const int4*>(reinterpret_cast<const int*>(ws + OFF_EIDX) + (size_t)((TG) * 8 + wave) * 128 + 16 * grp); \
        E[0] = _q[0]; E[1] = _q[1]; E[2] = _q[2]; E[3] = _q[3]; } while (0)
#define P10A_LOAD_ROWS(TG, E, R, HA) do { \
        asm volatile("" : PIN4(E[0]), PIN4(E[1]), PIN4(E[2]), PIN4(E[3])); \
        const int _e[16] = {E[0].x, E[0].y, E[0].z, E[0].w, E[1].x, E[1].y, E[1].z, E[1].w, E[2].x, E[2].y, E[2].z, E[2].w, E[3].x, E[3].y, E[3].z, E[3].w}; \
        _Pragma("unroll") for (int _i = 0; _i < 16; ++_i) R[_i] = *reinterpret_cast<const uint4*>(U8 + ((unsigned)_e[_i] * 128u + 16u * (unsigned)lg)); \
        HA = *reinterpret_cast<const uint4*>(HNs + (size_t)((TG) * 8 + wave) * DM); } while (0)
#define P10A_COMPUTE(SLOT, R, HA) do { \
        asm volatile("" : PIN4(R[0]), PIN4(R[1]), PIN4(R[2]), PIN4(R[3]), PIN4(R[4]), PIN4(R[5])); \
        asm volatile("" : PIN4(R[6]), PIN4(R[7]), PIN4(R[8]), PIN4(R[9]), PIN4(R[10]), PIN4(R[11])); \
        asm volatile("" : PIN4(R[12]), PIN4(R[13]), PIN4(R[14]), PIN4(R[15]), PIN4(HA)); \
        int _v1 = 0, _v2 = 0; \
        _Pragma("unroll") for (int _i = 0; _i < 16; ++_i) { \
            int _a = __builtin_amdgcn_sdot4((int)R[_i].x, (int)HA.x, 0, false); \
            _a = __builtin_amdgcn_sdot4((int)R[_i].y, (int)HA.y, _a, false); \
            _a = __builtin_amdgcn_sdot4((int)R[_i].z, (int)HA.z, _a, false); \
            _a = __builtin_amdgcn_sdot4((int)R[_i].w, (int)HA.w, _a, false); \
            _a += __builtin_amdgcn_mov_dpp(_a, 0xB1, 0xf, 0xf, true); _a += __builtin_amdgcn_mov_dpp(_a, 0x4E, 0xf, 0xf, true); _a += __builtin_amdgcn_mov_dpp(_a, 0x141, 0xf, 0xf, true); \
            if (_i < 8) _v1 = (lg == _i) ? _a : _v1; else _v2 = (lg == _i - 8) ? _a : _v2; } \
        stg[(SLOT) * 128 + 16 * grp + lg] = (float)_v1; stg[(SLOT) * 128 + 16 * grp + 8 + lg] = (float)_v2; } while (0)
    int4 eA[4], eB[4], eC[4]; uint4 rA[16], rB[16]; uint4 hA0, hB0;
    if (rank >= NTG) return;
    const int ntok = (NTG - rank + nrank - 1) / nrank;
#define TGI(I) (rank + ((I) < ntok ? (I) : ntok - 1) * nrank)
    P10A_LOAD_EV(TGI(0), eA);
    SB; P10A_LOAD_EV(TGI(1), eB);
    SB; P10A_LOAD_ROWS(TGI(0), eA, rA, hA0);
    SB;
    for (int base = 0; base < ntok; base += 16) {
#pragma unroll 1
        for (int i = base; i < base + 16; i += 2) {
            SB; P10A_LOAD_EV(TGI(i + 2), eC);
            SB; P10A_LOAD_ROWS(TGI(i + 1), eB, rB, hB0);
            SB; P10A_COMPUTE(i - base, rA, hA0);
            SB; P10A_LOAD_EV(TGI(i + 3), eB);
            SB; P10A_LOAD_ROWS(TGI(i + 2), eC, rA, hA0);
            SB; P10A_COMPUTE(i + 1 - base, rB, hB0);
            SB;
        }
#pragma unroll 4
        for (int j = 0; j < 16; ++j) {
            const float2 v = *reinterpret_cast<const float2*>(stg + j * 128 + 2 * lane);
            *reinterpret_cast<float2*>(PD + (size_t)(TGI(base + j) * 8 + wave) * 128 + 2 * lane) = v;
        }
        __builtin_amdgcn_s_waitcnt(0x0F70);
    }
#undef TGI
#undef P10A_LOAD_EV
#undef P10A_LOAD_ROWS
#undef P10A_COMPUTE
}

DEVI void phase10w_block(const Params& p) {
    unsigned char* ws = p.ws;
    const int lane = threadIdx.x & 63, wave = threadIdx.x >> 6;
    const float* PD = reinterpret_cast<const float*>(ws + OFF_PD);
    const float* HS = reinterpret_cast<const float*>(ws + OFF_HS);
    for (int t = blockIdx.x * 8 + wave; t < M_TOK; t += gridDim.x * 8) {
        float d0 = 0.f, d1 = 0.f;
#pragma unroll
        for (int sl = 0; sl < 8; ++sl) { d0 += PD[((size_t)sl * M_TOK + t) * 128 + lane]; d1 += PD[((size_t)sl * M_TOK + t) * 128 + 64 + lane]; }
        const float hs = HS[t];
        const float u0 = reinterpret_cast<const float*>(ws + OFF_EU)[(size_t)t * 128 + lane], u1 = reinterpret_cast<const float*>(ws + OFF_EU)[(size_t)t * 128 + 64 + lane];
        const float g0 = reinterpret_cast<const float*>(ws + OFF_EW)[(size_t)t * 128 + lane], g1 = reinterpret_cast<const float*>(ws + OFF_EW)[(size_t)t * 128 + 64 + lane];
        d0 *= u0 * hs; d1 *= u1 * hs;
        h2_t* W = reinterpret_cast<h2_t*>(ws + OFF_W16) + (size_t)t * 128;
        const _Float16 w0 = (_Float16)(g0 * 0.5f * d0 * (1.f + erff(d0 * 0.70710678118654752f))), w1 = (_Float16)(g1 * 0.5f * d1 * (1.f + erff(d1 * 0.70710678118654752f)));
        W[lane] = h2_t{w0, w0};
        W[64 + lane] = h2_t{w1, w1};
    }
}

template <bool DRY>
DEVI void phase10b_block(const Params& p, char* smem) {
    unsigned char* ws = p.ws;
    const int s = blockIdx.x & 7, rank = blockIdx.x >> 3, nrank = ((int)gridDim.x - s + 7) >> 3;
    const int lane = threadIdx.x & 63, wave = threadIdx.x >> 6;
    const int lg = lane & 7, grp = lane >> 3;
    const unsigned char* V8 = ws + OFF_V8 + (size_t)s * (16384 * 128);
    float* stg = reinterpret_cast<float*>(smem) + wave * (16 * 128);
    constexpr int NTG = M_TOK / 8;
#define P10B_LOAD_EV(TG, E) do { const int4* _q = reinterpret_cast<const int4*>(reinterpret_cast<const int*>(ws + OFF_EIDX) + (size_t)((TG) * 8 + wave) * 128 + 16 * grp); \
        E[0] = _q[0]; E[1] = _q[1]; E[2] = _q[2]; E[3] = _q[3]; } while (0)
#define P10B_LOAD_ROWS(TG, E, R, WA, WB, WC, WD) do { \
        asm volatile("" : PIN4(E[0]), PIN4(E[1]), PIN4(E[2]), PIN4(E[3])); \
        const int _e[16] = {E[0].x, E[0].y, E[0].z, E[0].w, E[1].x, E[1].y, E[1].z, E[1].w, E[2].x, E[2].y, E[2].z, E[2].w, E[3].x, E[3].y, E[3].z, E[3].w}; \
        _Pragma("unroll") for (int _i = 0; _i < 16; ++_i) R[_i] = *reinterpret_cast<const uint4*>(V8 + ((unsigned)_e[_i] * 128u + 16u * (unsigned)lg)); \
        const uint4* _w = reinterpret_cast<const uint4*>(reinterpret_cast<const unsigned*>(ws + OFF_W16) + (size_t)((TG) * 8 + wave) * 128 + 16 * grp); WA = _w[0]; WB = _w[1]; WC = _w[2]; WD = _w[3]; } while (0)
#define P10B_COMPUTE(SLOT, R, WA, WB, WC, WD) do { \
          \
        asm volatile("" : PIN4(R[0]), PIN4(R[1]), PIN4(R[2]), PIN4(R[3]), PIN4(R[4]), PIN4(R[5])); \
        asm volatile("" : PIN4(R[6]), PIN4(R[7]), PIN4(R[8]), PIN4(R[9]), PIN4(R[10]), PIN4(R[11])); \
        asm volatile("" : PIN4(R[12]), PIN4(R[13]), PIN4(R[14]), PIN4(R[15]), PIN4(WA), PIN4(WB)); \
        asm volatile("" : PIN4(WC), PIN4(WD)); \
        const unsigned _ww[16] = {WA.x, WA.y, WA.z, WA.w, WB.x, WB.y, WB.z, WB.w, WC.x, WC.y, WC.z, WC.w, WD.x, WD.y, WD.z, WD.w}; \
        h2_t _acc[8]; unsigned _zb; asm volatile("v_mov_b32 %0, 0" : "=v"(_zb)); \
        _Pragma("unroll") for (int _j = 0; _j < 8; ++_j) _acc[_j] = __builtin_bit_cast(h2_t, _zb); \
        _Pragma("unroll") for (int _i = 0; _i < 16; ++_i) { \
            const h2_t _wp = __builtin_bit_cast(h2_t, _ww[_i]); \
            const unsigned _wd[4] = {R[_i].x, R[_i].y, R[_i].z, R[_i].w}; \
            _Pragma("unroll") for (int _j = 0; _j < 4; ++_j) { \
                _acc[2 * _j] += _wp * __builtin_amdgcn_cvt_scalef32_pk_f16_fp8((int)_wd[_j], 1.0f, false); \
                _acc[2 * _j + 1] += _wp * __builtin_amdgcn_cvt_scalef32_pk_f16_fp8((int)_wd[_j], 1.0f, true); } } \
        float _o[16]; \
        _Pragma("unroll") for (int _j = 0; _j < 8; ++_j) { \
            h2_t _x = _acc[_j]; \
            _x += __builtin_bit_cast(h2_t, __builtin_amdgcn_mov_dpp(__builtin_bit_cast(int, _x), 0x128, 0xf, 0xf, true));     \
            { auto _s = __builtin_amdgcn_permlane16_swap(__builtin_bit_cast(unsigned, _x), __builtin_bit_cast(unsigned, _x), false, false); _x = __builtin_bit_cast(h2_t, (unsigned)_s[0]) + __builtin_bit_cast(h2_t, (unsigned)_s[1]); } \
            { auto _s = __builtin_amdgcn_permlane32_swap(__builtin_bit_cast(unsigned, _x), __builtin_bit_cast(unsigned, _x), false, false); _x = __builtin_bit_cast(h2_t, (unsigned)_s[0]) + __builtin_bit_cast(h2_t, (unsigned)_s[1]); } \
            _o[2 * _j] = (float)_x[0]; _o[2 * _j + 1] = (float)_x[1]; } \
        if (grp == 0) { float* _orow = stg + (SLOT) * 128 + 16 * lg; \
            _Pragma("unroll") for (int _i = 0; _i < 4; ++_i) *reinterpret_cast<float4*>(_orow + 4 * _i) = make_float4(_o[4 * _i], _o[4 * _i + 1], _o[4 * _i + 2], _o[4 * _i + 3]); } } while (0)
    int4 eA[4], eB[4], eC[4]; uint4 rA[16], rB[16]; uint4 wA0, wA1, wA2, wA3, wB0, wB1, wB2, wB3;
    if (rank >= NTG) return;
    const int ntok = (NTG - rank + nrank - 1) / nrank;
#define TGI(I) (rank + ((I) < ntok ? (I) : ntok - 1) * nrank)
    P10B_LOAD_EV(TGI(0), eA);
    SB; P10B_LOAD_EV(TGI(1), eB);
    SB; P10B_LOAD_ROWS(TGI(0), eA, rA, wA0, wA1, wA2, wA3);
    SB;
    for (int base = 0; base < ntok; base += 16) {
        float2 hrow[16];
#pragma unroll
        for (int j = 0; j < 16; ++j) hrow[j] = *reinterpret_cast<const float2*>(p.out + (size_t)(TGI(base + j) * 8 + wave) * DM + 128 * s + 2 * lane);
#pragma unroll 1
        for (int i = base; i < base + 16; i += 2) {
            SB; P10B_LOAD_EV(TGI(i + 2), eC);
            SB; P10B_LOAD_ROWS(TGI(i + 1), eB, rB, wB0, wB1, wB2, wB3);
            SB; P10B_COMPUTE(i - base, rA, wA0, wA1, wA2, wA3);
            SB; P10B_LOAD_EV(TGI(i + 3), eB);
            SB; P10B_LOAD_ROWS(TGI(i + 2), eC, rA, wA0, wA1, wA2, wA3);
            SB; P10B_COMPUTE(i + 1 - base, rB, wB0, wB1, wB2, wB3);
            SB;
        }
        float ssv = 0.f;
#pragma unroll
        for (int j = 0; j < 16; ++j) {
            if (base + j < ntok) {
                const size_t ro = (size_t)(TGI(base + j) * 8 + wave) * DM + 128 * s + 2 * lane;
                const float2 v = *reinterpret_cast<const float2*>(stg + j * 128 + 2 * lane);
                const float2 hv = hrow[j];
                const float2 r = make_float2(hv.x + v.x, hv.y + v.y);
                *reinterpret_cast<float2*>(p.out + ro) = DRY ? hv : r;
                const float sq = sum64(r.x * r.x + r.y * r.y);
                ssv = (lane == j) ? sq : ssv;
            }
        }
        if (lane < 16 && base + lane < ntok) reinterpret_cast<float*>(ws + OFF_SSQ)[(DRY ? (size_t)M_TOK * 8 : 0) + (size_t)(TGI(base + lane) * 8 + wave) * 8 + s] = ssv;
        __builtin_amdgcn_s_waitcnt(0x0F70);
    }
#undef TGI
#undef P10B_LOAD_EV
#undef P10B_LOAD_ROWS
#undef P10B_COMPUTE
}

DEVI void phase10c_block(const Params& p) {
    unsigned char* ws = p.ws;
    const int lane = threadIdx.x & 63, wave = threadIdx.x >> 6;
    for (int t = blockIdx.x * 8 + wave; t < M_TOK; t += gridDim.x * 8) {
        const float* sq = reinterpret_cast<const float*>(ws + OFF_SSQ) + (size_t)t * 8;
        const float4 a = *reinterpret_cast<const float4*>(sq), b = *reinterpret_cast<const float4*>(sq + 4);
        const float r = rsqrtf((a.x + a.y + a.z + a.w + b.x + b.y + b.z + b.w) * (1.f / 1024.f) + 1e-6f);
        float4* orow = reinterpret_cast<float4*>(p.out + (size_t)t * DM);
        const float4* gf = reinterpret_cast<const float4*>(p.norm_f_g);
#pragma unroll
        for (int i = 0; i < 4; ++i) {
            const float4 v = orow[lane + 64 * i], g = gf[lane + 64 * i];
            orow[lane + 64 * i] = make_float4(v.x * r * g.x, v.y * r * g.y, v.z * r * g.z, v.w * r * g.w);
        }
    }
}

#define XB_TMO      128
#define XB_XCNT(j)  (256  + 64 * (j))
#define XB_XSUB(j)  (1280 + 64 * (j))
#define XB_XGEN(j)  (2304 + 64 * (j))
#define XB_TOP      3328
#define XB_TOPGEN   3392
#define XCD_BAR_WORDS 3456
#define XB_SPIN_CAP (1u << 22)
#define LAS __attribute__((address_space(3)))
DEVI unsigned xb_ld(unsigned* p)              { return __hip_atomic_load(p, __ATOMIC_RELAXED, __HIP_MEMORY_SCOPE_AGENT); }
DEVI unsigned xb_add(unsigned* p, unsigned v) { return __hip_atomic_fetch_add(p, v, __ATOMIC_RELAXED, __HIP_MEMORY_SCOPE_AGENT); }
DEVI unsigned xb_xcc_id() { return (unsigned)__builtin_amdgcn_s_getreg((3 << 11) | 20) & 0xFu; }
#define XB_SPIN(cond, bar) do { unsigned _sp = 0; while (cond) { __builtin_amdgcn_s_sleep(1); \
    if ((++_sp & 255u) == 0u) { if (xb_ld(&(bar)[XB_TMO])) break; if (_sp > XB_SPIN_CAP) { atomicAdd(&(bar)[XB_TMO], 1u); break; } } } } while (0)
struct XcdBarrier { unsigned* bar; unsigned x; volatile LAS unsigned* st; };
DEVI XcdBarrier xcd_barrier_post(unsigned* bar, volatile LAS unsigned* st) {
    XcdBarrier b; b.bar = bar; b.x = xb_xcc_id(); b.st = st;
    if (threadIdx.x == 0) (void)xb_add(&bar[XB_XCNT(b.x)], 1u);
    return b;
}
DEVI void xcd_barrier_complete(unsigned* bar, unsigned x, unsigned& nloc, unsigned& nx) {
    const unsigned G = gridDim.x * gridDim.y * gridDim.z;
    unsigned sum, cnt, mine, sp = 0u;
    for (;;) {
        sum = 0u; cnt = 0u; mine = 0u;
#pragma unroll
        for (unsigned j = 0; j < 16; ++j) { const unsigned c = xb_ld(&bar[XB_XCNT(j)]); sum += c; cnt += (c > 0u) ? 1u : 0u; mine = (j == x) ? c : mine; }
        if (sum == G) break;
        __builtin_amdgcn_s_sleep(1);
        if ((++sp & 255u) == 0u) { if (xb_ld(&bar[XB_TMO])) break; if (sp > XB_SPIN_CAP) { atomicAdd(&bar[XB_TMO], 1u); break; } }
    }
    nloc = mine > 0u ? mine : 1u; nx = cnt > 0u ? cnt : 1u;
}
DEVI void xcd_barrier(const XcdBarrier& b) {
    asm volatile("s_waitcnt vmcnt(0)" ::: "memory");
    __syncthreads();
    if (threadIdx.x == 0) {
        unsigned* bar = b.bar;
        __builtin_amdgcn_s_waitcnt(0);
        unsigned nloc = b.st[0], nx = b.st[1];
        if (nloc == 0u) { xcd_barrier_complete(bar, b.x, nloc, nx); b.st[0] = nloc; b.st[1] = nx; }
        const unsigned old = xb_add(&bar[XB_XSUB(b.x)], 1u);
        const unsigned gen = old / nloc;
        if (old + 1u == (gen + 1u) * nloc) {
            __builtin_amdgcn_fence(__ATOMIC_RELEASE, "agent");
            asm volatile("s_waitcnt vmcnt(0)" ::: "memory");
            const unsigned og = xb_add(&bar[XB_TOP], 1u);
            const unsigned tg = og / nx;
            if (og + 1u == (tg + 1u) * nx) xb_add(&bar[XB_TOPGEN], 1u);
            else XB_SPIN(xb_ld(&bar[XB_TOPGEN]) == tg, bar);
            __builtin_amdgcn_fence(__ATOMIC_ACQUIRE, "agent");
            xb_add(&bar[XB_XGEN(b.x)], 1u);
            asm volatile("s_waitcnt vmcnt(0)" ::: "memory");
        } else {
            XB_SPIN(xb_ld(&bar[XB_XGEN(b.x)]) == gen, bar);
            __builtin_amdgcn_fence(__ATOMIC_ACQUIRE, "agent");
            asm volatile("s_waitcnt vmcnt(0)" ::: "memory");
        }
    }
    __syncthreads();
}

constexpr int N_PHASES = 11;
constexpr int LDS_PHASE_BYTES = 131072;
constexpr int LDS_BYTES = LDS_PHASE_BYTES + 16;

__global__ void __launch_bounds__(512, 2) hymba_fwd(Params p) {
    extern __shared__ __attribute__((aligned(16))) char smem[];
    cg::grid_group grid = cg::this_grid();
    const int lo = p.ph_lo, hi = p.ph_hi;
    volatile LAS unsigned* bst = (volatile LAS unsigned*)(smem + LDS_PHASE_BYTES);
    if (threadIdx.x == 0) { bst[0] = 0u; bst[1] = 0u; bst[2] = 0u; bst[3] = 0u; }
    __syncthreads();
    XcdBarrier xb = xcd_barrier_post(reinterpret_cast<unsigned*>(p.ws + OFF_BAR), bst);
    const int hb = (int)(threadIdx.x >> 8);
    char* hsm = smem + hb * 65536;
#define SEAM(K) if ((K) > lo) { if ((K) == lo + 1) grid.sync(); else xcd_barrier(xb); }
#define RUN_PHASE(K, FN, N) if (lo <= (K) && (K) < hi) { SEAM(K) for (int rep = 0; rep < 1 + ((PROBE_DUP >> (K)) & 1); ++rep) { if (rep) xcd_barrier(xb); \
        for (int ub = blockIdx.x * 2; ub < (N); ub += gridDim.x * 2) { const int u = ub + hb; if (u < (N)) FN(p, u, hsm); } } }
#define RUN_GEMM(K, CALL) if (lo <= (K) && (K) < hi) { SEAM(K) CALL; }
    RUN_PHASE(0, phase0_unit, P0_UNITS)
    RUN_GEMM(1, run_gemm(reinterpret_cast<const bf16_t*>(p.ws + OFF_XN), reinterpret_cast<const bf16_t*>(p.ws + OFF_WIN), P1_N, EpiInProj{p.ws}, smem))
#if PROBE_P2G
    if (lo <= 2 && 2 < hi) { xcd_barrier(xb); for (int ub = blockIdx.x * 2; ub < P2_UNITS; ub += gridDim.x * 2) { const int u = ub + hb; if (u < P2_UNITS) phase2_dry_unit(p, u, hsm); } }
#endif
    RUN_PHASE(2, phase2_unit, P2_UNITS)
#if PROBE_P2T
    if (lo <= 2 && 2 < hi) { xcd_barrier(xb); for (int ub = blockIdx.x * 2; ub < P2_UNITS; ub += gridDim.x * 2) { const int u = ub + hb; if (u < P2_UNITS && (u % 7) >= 3) phase2_unit(p, u, hsm); } }
#endif
    RUN_PHASE(3, phase3_unit, P3_UNITS)
#if PROBE_P4
    if (lo <= 4 && 4 < hi) { xcd_barrier(xb); for (int ub = blockIdx.x * 2; ub < P4_UNITS; ub += gridDim.x * 2) { const int u = ub + hb; if (u < P4_UNITS) phase4_dry_unit(p, u, hsm); } }
#endif
    RUN_PHASE(4, phase4_unit, P4_UNITS)
    RUN_PHASE(5, phase5_unit, P5_UNITS)
    RUN_GEMM(6, run_gemm(reinterpret_cast<const bf16_t*>(p.ws + OFF_MIX), reinterpret_cast<const bf16_t*>(p.ws + OFF_WOUT), 1024, EpiOutProj{p.x, p.out}, smem))
    RUN_PHASE(7, phase7_unit, P7_UNITS)
    RUN_GEMM(8, run_gemm(reinterpret_cast<const bf16_t*>(p.ws + OFF_HN), reinterpret_cast<const bf16_t*>(p.ws + OFF_WQ), 2048, EpiQ{reinterpret_cast<bf16_t*>(p.ws + OFF_Q)}, smem))
    RUN_GEMM(9, phase9_block(p, smem))
    if (lo <= 10 && 10 < hi) {
        SEAM(10)
#if PROBE_P10X == 4
        phase10a_block(p, smem); xcd_barrier(xb);
#endif
        phase10a_block(p, smem);
#if PROBE_P10X == 1
        xcd_barrier(xb); phase10a_block(p, smem);
#endif

        xcd_barrier(xb); phase10w_block(p);
#if PROBE_P10X == 2
        xcd_barrier(xb); phase10b_block<true>(p, smem);
#endif
        xcd_barrier(xb); phase10b_block<false>(p, smem);
        xcd_barrier(xb); phase10c_block(p);
#if PROBE_P10X == 3
        xcd_barrier(xb); phase10c_block(p);
#endif
    }
#undef RUN_PHASE
#undef RUN_GEMM
#undef SEAM
}

extern "C" void kernel_launch(void* const* d_in, const int* in_sizes, int n_in, void* d_out, int out_size, void* d_ws, size_t ws_size, hipStream_t stream) {
    static int grid_blocks = 0;
    if (grid_blocks == 0) {
        if (n_in != 15 || in_sizes[0] != M_TOK * DM || out_size != M_TOK * DM || ws_size < WS_NEED) {
            fprintf(stderr, "kernel_launch: unexpected shapes (n_in %d, in0 %d, out %d, ws %zu)\n", n_in, n_in > 0 ? in_sizes[0] : -1, out_size, ws_size);
            grid_blocks = -1; return;
        }
        int dev = 0, cus = 0, per_cu = 0;
        (void)hipGetDevice(&dev);
        (void)hipDeviceGetAttribute(&cus, hipDeviceAttributeMultiprocessorCount, dev);
        (void)hipFuncSetAttribute((const void*)hymba_fwd, hipFuncAttributeMaxDynamicSharedMemorySize, LDS_BYTES);
        (void)hipOccupancyMaxActiveBlocksPerMultiprocessor(&per_cu, (const void*)hymba_fwd, 512, LDS_BYTES);
        if (per_cu < 1) per_cu = 1;
        if (per_cu > 1) per_cu = 1;
        grid_blocks = cus * per_cu;
    }
    if (grid_blocks < 0) return;
    Params p{};
    p.x = (const float*)d_in[0]; p.norm1_g = (const float*)d_in[1]; p.w_in = (const float*)d_in[2]; p.hg_lower = (const float*)d_in[3];
    p.hg_norm_g = (const float*)d_in[4]; p.gla_wg = (const float*)d_in[5]; p.gla_bg = (const float*)d_in[6]; p.gla_norm_g = (const float*)d_in[7];
    p.w_out = (const float*)d_in[8]; p.norm2_g = (const float*)d_in[9]; p.w_q = (const float*)d_in[10]; p.sub_keys = (const float*)d_in[11];
    p.peer_u = (const float*)d_in[12]; p.peer_v = (const float*)d_in[13]; p.norm_f_g = (const float*)d_in[14];
    p.out = (float*)d_out; p.ws = (unsigned char*)d_ws;
#if N_LAUNCH_MODE == 1
    (void)hipMemsetAsync((unsigned char*)d_ws + OFF_BAR, 0, XCD_BAR_WORDS * 4, stream);
    p.ph_lo = 0; p.ph_hi = N_PHASES;
    void* args[] = {&p};
    hipError_t e = hipLaunchCooperativeKernel((const void*)hymba_fwd, dim3(grid_blocks), dim3(512), args, LDS_BYTES, stream);
    if (e != hipSuccess) fprintf(stderr, "cooperative launch failed: %s (grid %d)\n", hipGetErrorString(e), grid_blocks);
#else
    for (int ph = 0; ph < N_PHASES; ++ph) {
        p.ph_lo = ph; p.ph_hi = ph + 1;
        hipLaunchKernelGGL(hymba_fwd, dim3(grid_blocks), dim3(512), LDS_BYTES, stream, p);
    }
#endif
}
```

```cpp
#include <hip/hip_runtime.h>
#include <hip/hip_cooperative_groups.h>
#include <cstdio>
#include <cstdint>
namespace cg = cooperative_groups;

#ifndef N_LAUNCH_MODE
#define N_LAUNCH_MODE 1
#endif

#ifndef PROBE_DUP
#define PROBE_DUP 0
#endif
#ifndef PROBE_P10_DUP
#define PROBE_P10_DUP 0
#endif
#ifndef P10_SLICED
#define P10_SLICED 0
#endif
#ifndef PROBE_P10A
#define PROBE_P10A 0
#endif
#ifndef PROBE_P10_MASK
#define PROBE_P10_MASK 0x7fffffff
#endif
#ifndef PROBE_P10X
#define PROBE_P10X 0
#endif
#ifndef PROBE_P2T
#define PROBE_P2T 0
#endif
#ifndef PROBE_P4
#define PROBE_P4 0
#endif
#ifndef PROBE_P2G
#define PROBE_P2G 0
#endif
#ifndef PROBE_GEMM_DUP
#define PROBE_GEMM_DUP 0
#endif
#define DEVI __device__ __forceinline__
#define LTID ((int)(threadIdx.x & 255u))
typedef unsigned short bf16_t;
using bf16x8 = __attribute__((ext_vector_type(8))) short;
using f32x4 = __attribute__((ext_vector_type(4))) float;

constexpr int M_TOK = 32768;
constexpr int DM = 1024;
constexpr int IN_WP = 3840;
constexpr size_t MiB = 1024ull * 1024ull;

constexpr size_t OFF_XN   = 0;
constexpr size_t OFF_WIN  = 64 * MiB;
constexpr size_t OFF_WOUT = 72 * MiB;
constexpr size_t OFF_WQ   = 74 * MiB;
constexpr size_t OFF_SK   = 78 * MiB;
constexpr size_t OFF_LB   = 79 * MiB;
constexpr size_t OFF_U8   = 80 * MiB;
constexpr size_t OFF_V8   = 96 * MiB;
constexpr size_t OFF_US   = 112 * MiB;
constexpr size_t OFF_VS   = 113 * MiB;
constexpr size_t OFF_R2   = 144 * MiB;
constexpr size_t OFF_HQ   = OFF_R2;
constexpr size_t OFF_HLF  = OFF_R2 + 32 * MiB;
constexpr size_t OFF_HV   = OFF_R2 + 64 * MiB;
constexpr size_t OFF_HG   = OFF_R2 + 96 * MiB;
constexpr size_t OFF_GQ   = OFF_R2 + 128 * MiB;
constexpr size_t OFF_GK   = OFF_R2 + 144 * MiB;
constexpr size_t OFF_GV   = OFF_R2 + 160 * MiB;
constexpr size_t OFF_GG   = OFF_R2 + 192 * MiB;
constexpr size_t OFF_GLOW = OFF_R2 + 224 * MiB;
constexpr size_t OFF_KTH  = 370 * MiB;
constexpr size_t OFF_KTG  = 402 * MiB;
constexpr size_t OFF_DECH = 418 * MiB;
constexpr size_t OFF_DECG = 419 * MiB;
constexpr size_t OFF_HVT  = 420 * MiB;
constexpr size_t OFF_GVT  = 452 * MiB;
constexpr size_t OFF_BAR  = 484 * MiB;
constexpr size_t WS_NEED  = 485 * MiB;
constexpr size_t OFF_MIX  = OFF_XN;
constexpr size_t OFF_HN   = OFF_R2;
constexpr size_t OFF_Q    = OFF_R2 + 64 * MiB;
constexpr size_t OFF_EIDX = OFF_KTH;
constexpr size_t OFF_EW   = OFF_KTH + 16 * MiB;
constexpr size_t OFF_EU   = OFF_KTG;
constexpr size_t OFF_HN8  = OFF_XN;
constexpr size_t OFF_HS   = OFF_XN + 32 * MiB;
constexpr size_t OFF_W16  = OFF_XN + 48 * MiB;
constexpr size_t OFF_SSQ  = OFF_XN + 33 * MiB;
constexpr size_t OFF_PD   = OFF_Q;
constexpr size_t OFF_PEER = OFF_Q + 64 * MiB;
constexpr size_t OUT_STH = 0;
constexpr size_t OUT_STG = 64 * MiB;

struct Params {
    const float* x; const float* norm1_g; const float* w_in; const float* hg_lower; const float* hg_norm_g;
    const float* gla_wg; const float* gla_bg; const float* gla_norm_g; const float* w_out; const float* norm2_g;
    const float* w_q; const float* sub_keys; const float* peer_u; const float* peer_v; const float* norm_f_g;
    float* out; unsigned char* ws;
    int ph_lo, ph_hi;
};

DEVI unsigned short f2bf(float f) {
    unsigned u = __float_as_uint(f);
    u += 0x7fffu + ((u >> 16) & 1u);
    return (unsigned short)(u >> 16);
}
DEVI float bf2f(unsigned short b) { return __uint_as_float(((unsigned)b) << 16); }
DEVI unsigned pack2(float a, float b) { return (unsigned)f2bf(a) | ((unsigned)f2bf(b) << 16); }
DEVI float bflo(unsigned u) { return __uint_as_float(u << 16); }
DEVI float bfhi(unsigned u) { return __uint_as_float(u & 0xffff0000u); }
template <int CTRL> DEVI float dpp_f(float x) { return __builtin_bit_cast(float, __builtin_amdgcn_mov_dpp(__builtin_bit_cast(int, x), CTRL, 0xf, 0xf, true)); }
DEVI float wave_sum(float v) {
    v += dpp_f<0xB1>(v); v += dpp_f<0x4E>(v); v += dpp_f<0x141>(v); v += dpp_f<0x128>(v);
    { auto s = __builtin_amdgcn_permlane16_swap(__float_as_uint(v), __float_as_uint(v), false, false); v = __uint_as_float(s[0]) + __uint_as_float(s[1]); }
    { auto s = __builtin_amdgcn_permlane32_swap(__float_as_uint(v), __float_as_uint(v), false, false); v = __uint_as_float(s[0]) + __uint_as_float(s[1]); }
    return v;
}
DEVI float wave_max(float v) {
    v = fmaxf(v, dpp_f<0xB1>(v)); v = fmaxf(v, dpp_f<0x4E>(v)); v = fmaxf(v, dpp_f<0x141>(v)); v = fmaxf(v, dpp_f<0x128>(v));
    { auto s = __builtin_amdgcn_permlane16_swap(__float_as_uint(v), __float_as_uint(v), false, false); v = fmaxf(__uint_as_float(s[0]), __uint_as_float(s[1])); }
    { auto s = __builtin_amdgcn_permlane32_swap(__float_as_uint(v), __float_as_uint(v), false, false); v = fmaxf(__uint_as_float(s[0]), __uint_as_float(s[1])); }
    return v;
}
DEVI float silu_f(float x) { return x * __builtin_amdgcn_rcpf(1.f + __expf(-x)); }
DEVI f32x4 mfma16(bf16x8 a, bf16x8 b, f32x4 c) { return __builtin_amdgcn_mfma_f32_16x16x32_bf16(a, b, c, 0, 0, 0); }
DEVI bf16x8 ldg_frag(const bf16_t* p) { return *reinterpret_cast<const bf16x8*>(p); }

DEVI void rms_row_bf16(const float* __restrict__ xr, const float* __restrict__ g, bf16_t* __restrict__ dst, int lane) {
    float4 v[4]; float ss = 0.f;
#pragma unroll
    for (int i = 0; i < 4; ++i) { v[i] = reinterpret_cast<const float4*>(xr)[lane + 64 * i]; ss += v[i].x * v[i].x + v[i].y * v[i].y + v[i].z * v[i].z + v[i].w * v[i].w; }
    ss = wave_sum(ss);
    const float r = rsqrtf(ss * (1.f / 1024.f) + 1e-6f);
#pragma unroll
    for (int i = 0; i < 4; ++i) {
        const float4 gg = reinterpret_cast<const float4*>(g)[lane + 64 * i];
        uint2 o; o.x = pack2(v[i].x * r * gg.x, v[i].y * r * gg.y); o.y = pack2(v[i].z * r * gg.z, v[i].w * r * gg.w);
        reinterpret_cast<uint2*>(dst)[lane + 64 * i] = o;
    }
}

DEVI void transpose_tile(const float* __restrict__ src, int Nsrc, bf16_t* __restrict__ dst, int nt, int kt, int mode, float* lds) {
    const int tid = LTID, tx = tid & 63, ty = tid >> 6;
    const int np = nt * 64 + tx;
    int col = np; bool valid = true;
    if (mode == 1) {
        if (np < 3072) col = np; else if (np < 3584) col = np + 16; else if (np < 3600) col = np - 512; else { valid = false; col = 0; }
    }
#pragma unroll 4
    for (int kk = ty; kk < 64; kk += 4) {
        lds[kk * 65 + tx] = valid ? src[(size_t)(kt * 64 + kk) * Nsrc + col] : 0.f;
    }
    __syncthreads();
    const int nl = tid >> 2, kq = tid & 3;
    unsigned pk[8];
#pragma unroll
    for (int i = 0; i < 8; ++i) pk[i] = pack2(lds[(kq * 16 + 2 * i) * 65 + nl], lds[(kq * 16 + 2 * i + 1) * 65 + nl]);
    uint4* d = reinterpret_cast<uint4*>(dst + (size_t)(nt * 64 + nl) * 1024 + kt * 64 + kq * 16);
    d[0] = make_uint4(pk[0], pk[1], pk[2], pk[3]);
    d[1] = make_uint4(pk[4], pk[5], pk[6], pk[7]);
    __syncthreads();
}

DEVI void convert8(const float* __restrict__ src, bf16_t* __restrict__ dst, size_t idx8) {
    const float4 a = reinterpret_cast<const float4*>(src)[idx8 * 2], b = reinterpret_cast<const float4*>(src)[idx8 * 2 + 1];
    reinterpret_cast<uint4*>(dst)[idx8] = make_uint4(pack2(a.x, a.y), pack2(a.z, a.w), pack2(b.x, b.y), pack2(b.z, b.w));
}

DEVI int pack_i8x4(float a, float b, float c, float d) {
    const int ia = (int)rintf(a), ib = (int)rintf(b), ic = (int)rintf(c), id = (int)rintf(d);
    return (ia & 255) | ((ib & 255) << 8) | ((ic & 255) << 16) | (id << 24);
}
DEVI void quant_row_i8(const float* __restrict__ xr, unsigned char* __restrict__ dst_table, int row, float* __restrict__ descale, int lane) {
    float4 v[4]; float am = 0.f;
#pragma unroll
    for (int i = 0; i < 4; ++i) { v[i] = reinterpret_cast<const float4*>(xr)[lane + 64 * i]; am = fmaxf(am, fmaxf(fmaxf(fabsf(v[i].x), fabsf(v[i].y)), fmaxf(fabsf(v[i].z), fabsf(v[i].w)))); }
    am = wave_max(am);
    const float sc = am > 0.f ? 127.f / am : 1.f;
#pragma unroll
    for (int i = 0; i < 4; ++i) {
        const int w = lane + 64 * i;
        reinterpret_cast<int*>(dst_table)[(size_t)(w >> 5) * (16384 * 32) + (size_t)row * 32 + (w & 31)] = pack_i8x4(v[i].x * sc, v[i].y * sc, v[i].z * sc, v[i].w * sc);
    }
    if (lane == 0) *descale = am > 0.f ? am * (1.f / 127.f) : 1.f;
}
DEVI void quant_row_fp8(const float* __restrict__ xr, unsigned char* __restrict__ dst_table, int row, float* __restrict__ descale, int lane) {
    float4 v[4]; float am = 0.f;
#pragma unroll
    for (int i = 0; i < 4; ++i) { v[i] = reinterpret_cast<const float4*>(xr)[lane + 64 * i]; am = fmaxf(am, fmaxf(fmaxf(fabsf(v[i].x), fabsf(v[i].y)), fmaxf(fabsf(v[i].z), fabsf(v[i].w)))); }
    am = wave_max(am);
    const float sc = am > 0.f ? 448.f / am : 1.f;
#pragma unroll
    for (int i = 0; i < 4; ++i) {
        const float a = fminf(fmaxf(v[i].x * sc, -448.f), 448.f), b = fminf(fmaxf(v[i].y * sc, -448.f), 448.f);
        const float c = fminf(fmaxf(v[i].z * sc, -448.f), 448.f), d = fminf(fmaxf(v[i].w * sc, -448.f), 448.f);
        int pk = __builtin_amdgcn_cvt_pk_fp8_f32(a, b, 0, false);
        pk = __builtin_amdgcn_cvt_pk_fp8_f32(c, d, pk, true);
        const int w = lane + 64 * i;
        reinterpret_cast<int*>(dst_table)[(size_t)(w >> 5) * (16384 * 32) + (size_t)row * 32 + (w & 31)] = pk;
    }
    if (lane == 0) *descale = am > 0.f ? am * (1.f / 448.f) : 1.f;
}

constexpr int P0_XN = 8192, P0_WIN = 60 * 16, P0_WOUT = 16 * 16, P0_WQ = 32 * 16, P0_UV = 8192, P0_SK = 128, P0_LB = 1;
constexpr int P0_UNITS = P0_XN + P0_WIN + P0_WOUT + P0_WQ + P0_UV + P0_SK + P0_LB;

DEVI void phase0_unit(const Params& p, int u, char* smem) {
    const int tid = LTID, lane = tid & 63, w = tid >> 6;
    unsigned char* ws = p.ws;
    if (u < P0_XN) {
        const int row = u * 4 + w;
        rms_row_bf16(p.x + (size_t)row * DM, p.norm1_g, reinterpret_cast<bf16_t*>(ws + OFF_XN) + (size_t)row * DM, lane);
        return;
    }
    u -= P0_XN;
    if (u < P0_WIN) { transpose_tile(p.w_in, 3600, reinterpret_cast<bf16_t*>(ws + OFF_WIN), u / 16, u % 16, 1, reinterpret_cast<float*>(smem)); return; }
    u -= P0_WIN;
    if (u < P0_WOUT) { transpose_tile(p.w_out, 1024, reinterpret_cast<bf16_t*>(ws + OFF_WOUT), u / 16, u % 16, 0, reinterpret_cast<float*>(smem)); return; }
    u -= P0_WOUT;
    if (u < P0_WQ) { transpose_tile(p.w_q, 2048, reinterpret_cast<bf16_t*>(ws + OFF_WQ), u / 16, u % 16, 0, reinterpret_cast<float*>(smem)); return; }
    u -= P0_WQ;
    if (u < P0_UV) {
        const bool isv = u >= 4096; const int row = (isv ? u - 4096 : u) * 4 + w;
        if (isv) quant_row_fp8(p.peer_v + (size_t)row * DM, ws + OFF_V8, row, reinterpret_cast<float*>(ws + OFF_VS) + row, lane);
        else quant_row_i8(p.peer_u + (size_t)row * DM, ws + OFF_U8, row, reinterpret_cast<float*>(ws + OFF_US) + row, lane);
        return;
    }
    u -= P0_UV;
    if (u < P0_SK) { convert8(p.sub_keys, reinterpret_cast<bf16_t*>(ws + OFF_SK), (size_t)u * 256 + tid); return; }
    float* lb = reinterpret_cast<float*>(ws + OFF_LB);
    for (int n = tid; n < 512; n += 256) {
        const float l0 = p.hg_lower[n], l1 = p.hg_lower[512 + n];
        const float mx = fmaxf(l0, l1); const float e0 = __expf(l0 - mx), e1 = __expf(l1 - mx);
        lb[n] = e0 / (e0 + e1);
    }
}

namespace pg8 {
#define PG8_LAS __attribute__((address_space(3)))
typedef unsigned short bf16_t;
typedef short bf16x8 __attribute__((ext_vector_type(8)));
typedef float f32x4 __attribute__((ext_vector_type(4)));
typedef unsigned u32x4 __attribute__((ext_vector_type(4)));
constexpr int BM = 256, BK = 64, HALF = 128, HTB = HALF * BK * 2  , STAGE_BYTES = 8 * HTB, NXCD = 8, WGM = 8;

__host__ __device__ __forceinline__ int lds_byte(int r, int c) { const int st = (r >> 4) * 2 + (c >> 5), rr = r & 15, cc = c & 31, ob = rr * 64 + cc * 2; return st * 1024 + (ob ^ (((ob >> 9) & 1) << 5)); }
__host__ __device__ __forceinline__ void stage_rc(int b, int& R, int& C) { const int st = b / 1024, sb = b % 1024, swz = sb ^ (((sb >> 9) & 1) << 5); R = (st >> 1) * 16 + swz / 64; C = (st & 1) * 32 + (swz % 64) / 2; }
__host__ __device__ __forceinline__ int perm32(int rho) { const int n = rho >> 4, i = rho & 15; return 8 * (i >> 2) + 4 * n + (i & 3); }

struct Unit { int pm, pn; };
struct Gemm { const bf16_t* A; const bf16_t* Bt; int M, N, K; };

struct StaticOrder {
    int nM, nN, nwg, G, c;
    __host__ __device__ void init(int M, int N, int G_, int c_) { nM = M / BM; nN = N / BM; nwg = nM * nN; G = G_; c = c_; }
    __host__ __device__ bool next(int i, Unit& u) const {
        const long L = (long)i * G + c; if (L >= nwg) return false;
        int wgid = (int)L; { const int q = nwg / NXCD, r = nwg % NXCD, xcd = wgid % NXCD, off = wgid / NXCD; wgid = (xcd < r ? xcd * (q + 1) : r * (q + 1) + (xcd - r) * q) + off; }
        const int nig = WGM * nN, gid = wgid / nig, fm = gid * WGM, gsz = (nM - fm) < WGM ? (nM - fm) : WGM;
        u.pm = fm + ((wgid % nig) % gsz); u.pn = (wgid % nig) / gsz; return true;
    }
    __device__ __forceinline__ void a_ready(const Unit&) const {}
    __device__ __forceinline__ void done(const Unit&) const {}
};
__device__ __forceinline__ unsigned cvt_pk_bf16(float lo, float hi) { unsigned r; asm volatile("v_cvt_pk_bf16_f32 %0, %1, %2" : "=v"(r) : "v"(lo), "v"(hi)); return r; }
typedef float f32x2 __attribute__((ext_vector_type(2)));
template <class Epi, class Sched, bool STAMP = false>
__device__ __forceinline__ void gemm_phase(PG8_LAS unsigned char* lds, const Gemm g, const Sched& S, const Epi& E, unsigned long long* stamps) {
    const int tid = threadIdx.x, wid = __builtin_amdgcn_readfirstlane(tid >> 6), lane = tid & 63, wr = wid >> 2, wc = wid & 3, fr = lane & 15, fq = lane >> 4;
    const int K = g.K, nt = K / BK;
    int ts_lo = 0, ts_hi = 0, nts = 0; const unsigned long long rt_entry = STAMP ? (unsigned long long)wall_clock64() : 0ull;
#define PG8_STAMP() do { if (STAMP && wid == 0 && nts < 64) { const unsigned long long _c = (unsigned long long)clock64(); \
        ts_lo = (lane == nts) ? (int)(unsigned)_c : ts_lo; ts_hi = (lane == nts) ? (int)(unsigned)(_c >> 32) : ts_hi; ++nts; } } while (0)
    PG8_STAMP();
    unsigned voffA[2], voffB[2];
#pragma unroll
    for (int i = 0; i < 2; ++i) { int R, C; stage_rc(tid * 16 + i * 8192, R, C); const int Rb = Epi::PERM ? ((R & ~31) + perm32(R & 31)) : R;
        voffA[i] = (unsigned)(R * K + C) * 2u; voffB[i] = (unsigned)(Rb * K + C) * 2u; }
    const size_t kstep = (size_t)(BK * 2);
    const size_t hstep = (size_t)HALF * K * 2;
    const size_t tstep = 2 * hstep;
    const unsigned ldsw = (unsigned)wid * 1024u;
    const int aoff = lds_byte(wr * 64 + fr, fq * 8), boff = lds_byte(wc * 32 + fr, fq * 8);
#define PG8_SA(b, h) (((b) * 2 + (h)) * HTB)
#define PG8_SB(b, h) ((4 + (b) * 2 + (h)) * HTB)
#define PG8_STAGE(bufoff, gbase, voff) do { _Pragma("unroll") for (int _i = 0; _i < 2; ++_i) \
        __builtin_amdgcn_global_load_lds((const unsigned*)((const char*)(gbase) + (voff)[_i]), (PG8_LAS unsigned*)(lds + (bufoff) + ldsw + _i * 8192), 16, 0, 0); } while (0)
#define PG8_LDA(dst, b, h) do { _Pragma("unroll") for (int m = 0; m < 4; ++m) _Pragma("unroll") for (int k = 0; k < 2; ++k) dst[m][k] = *(const PG8_LAS bf16x8*)(lds + PG8_SA(b, h) + aoff + m * 2048 + k * 1024); } while (0)
#define PG8_LDB(dst, b, h) do { _Pragma("unroll") for (int n = 0; n < 2; ++n) _Pragma("unroll") for (int k = 0; k < 2; ++k) dst[n][k] = *(const PG8_LAS bf16x8*)(lds + PG8_SB(b, h) + boff + n * 2048 + k * 1024); } while (0)
#define PG8_MMA(ai, bj, At, Bt) do { __builtin_amdgcn_s_setprio(1); _Pragma("unroll") for (int m = 0; m < 4; ++m) _Pragma("unroll") for (int n = 0; n < 2; ++n) _Pragma("unroll") for (int k = 0; k < 2; ++k) \
        acc[ai][bj][m][n] = __builtin_amdgcn_mfma_f32_16x16x32_bf16(Bt[n][k], At[m][k], acc[ai][bj][m][n], 0, 0, 0); __builtin_amdgcn_s_setprio(0); } while (0)
#define PG8_WAIT_V(n) asm volatile("s_waitcnt vmcnt(" #n ")" ::: "memory")
#define PG8_WAIT_L(n) asm volatile("s_waitcnt lgkmcnt(" #n ")" ::: "memory")
#define PG8_BAR __builtin_amdgcn_s_barrier()
#define PG8_SCHED __builtin_amdgcn_sched_barrier(0)
    Unit cur, nxt; int ui = 0;
    if (!S.next(0, cur)) return;
    f32x4 acc[2][2][4][2];
#pragma unroll
    for (int a = 0; a < 2; ++a)
#pragma unroll
        for (int b = 0; b < 2; ++b)
#pragma unroll
            for (int m = 0; m < 4; ++m)
#pragma unroll
                for (int n = 0; n < 2; ++n) acc[a][b][m][n] = (f32x4){0.f, 0.f, 0.f, 0.f};
    bf16x8 At[4][2], B0[2][2], B1[2][2];
    const char* cA = (const char*)g.A + (size_t)cur.pm * tstep; const char* cB = (const char*)g.Bt + (size_t)cur.pn * tstep;
    S.a_ready(cur);
    PG8_STAGE(PG8_SB(0, 0), cB, voffB); PG8_STAGE(PG8_SA(0, 0), cA, voffA); PG8_STAGE(PG8_SB(0, 1), cB + hstep, voffB); PG8_STAGE(PG8_SA(0, 1), cA + hstep, voffA);
    if (wr == 1) PG8_BAR;
    PG8_WAIT_V(4); PG8_BAR;
    PG8_STAGE(PG8_SB(1, 0), cB + kstep, voffB); PG8_STAGE(PG8_SA(1, 0), cA + kstep, voffA); PG8_STAGE(PG8_SB(1, 1), cB + hstep + kstep, voffB);
    PG8_WAIT_V(6); PG8_BAR;
    PG8_STAMP();
    for (;;) {
        const bool has_next = S.next(ui + 1, nxt);
        const char* nA = has_next ? (const char*)g.A + (size_t)nxt.pm * tstep : cA; const char* nB = has_next ? (const char*)g.Bt + (size_t)nxt.pn * tstep : cB;
        for (int t = 0; t < nt; t += 2) {
            const bool last = (t == nt - 2);
            const char* a1 = cA + (size_t)(t + 1) * kstep;
            const char* a2 = last ? nA : cA + (size_t)(t + 2) * kstep; const char* b2 = last ? nB : cB + (size_t)(t + 2) * kstep;
            const char* a3 = a2 + kstep; const char* b3 = b2 + kstep;
            if (last && has_next) S.a_ready(nxt);
            PG8_LDB(B0, 0, 0); PG8_SCHED; PG8_LDA(At, 0, 0); PG8_STAGE(PG8_SA(1, 1), a1 + hstep, voffA);
            PG8_WAIT_L(8); PG8_BAR; PG8_WAIT_L(0); PG8_MMA(0, 0, At, B0); PG8_BAR; PG8_SCHED;
            PG8_LDB(B1, 0, 1); PG8_STAGE(PG8_SB(0, 0), b2, voffB);
            PG8_BAR; PG8_WAIT_L(0); PG8_MMA(0, 1, At, B1); PG8_BAR;
            PG8_LDA(At, 0, 1); PG8_STAGE(PG8_SA(0, 0), a2, voffA);
            PG8_BAR; PG8_WAIT_L(0); PG8_MMA(1, 0, At, B0); PG8_BAR; PG8_SCHED;
            PG8_STAGE(PG8_SB(0, 1), b2 + hstep, voffB);
            PG8_WAIT_V(6); PG8_BAR; PG8_MMA(1, 1, At, B1); PG8_BAR;
            PG8_LDB(B0, 1, 0); PG8_SCHED; PG8_LDA(At, 1, 0); PG8_STAGE(PG8_SA(0, 1), a2 + hstep, voffA);
            PG8_WAIT_L(8); PG8_BAR; PG8_WAIT_L(0); PG8_MMA(0, 0, At, B0); PG8_BAR; PG8_SCHED;
            PG8_LDB(B1, 1, 1); PG8_STAGE(PG8_SB(1, 0), b3, voffB);
            PG8_BAR; PG8_WAIT_L(0); PG8_MMA(0, 1, At, B1); PG8_BAR;
            PG8_LDA(At, 1, 1); PG8_STAGE(PG8_SA(1, 0), a3, voffA);
            PG8_BAR; PG8_WAIT_L(0); PG8_MMA(1, 0, At, B0); PG8_BAR; PG8_SCHED;
            PG8_STAGE(PG8_SB(1, 1), b3 + hstep, voffB);
            PG8_WAIT_V(6); PG8_BAR; PG8_MMA(1, 1, At, B1); PG8_BAR;
        }
        PG8_STAMP();
        if constexpr (!Epi::AFTER_DRAIN) { E(acc, cur, wr, wc, fr, fq); S.done(cur); }
        PG8_STAMP();
        if (!has_next) break;
#pragma unroll
        for (int a = 0; a < 2; ++a)
#pragma unroll
            for (int b = 0; b < 2; ++b)
#pragma unroll
                for (int m = 0; m < 4; ++m)
#pragma unroll
                    for (int n = 0; n < 2; ++n) acc[a][b][m][n] = (f32x4){0.f, 0.f, 0.f, 0.f};
        cur = nxt; cA = nA; cB = nB; ++ui;
    }
    PG8_WAIT_V(0);
    if (wr == 0) PG8_BAR;
    PG8_BAR;
    if constexpr (Epi::AFTER_DRAIN) { E.fused(acc, cur, wr, wc, fr, fq, lds, wid, lane); S.done(cur); }
    PG8_STAMP();
    if (STAMP && wid == 0) { stamps[lane] = lane < nts ? (((unsigned long long)(unsigned)ts_hi << 32) | (unsigned)ts_lo) : 0ull;
        if (lane == 62) stamps[62] = rt_entry; if (lane == 63) stamps[63] = (unsigned long long)wall_clock64(); }
#undef PG8_STAMP
#undef PG8_SA
#undef PG8_SB
#undef PG8_STAGE
#undef PG8_LDA
#undef PG8_LDB
#undef PG8_MMA
#undef PG8_WAIT_V
#undef PG8_WAIT_L
#undef PG8_BAR
#undef PG8_SCHED
}
}

DEVI uint4 pack8(const pg8::f32x4 a, const pg8::f32x4 b) { return make_uint4(pack2(a[0], a[1]), pack2(a[2], a[3]), pack2(b[0], b[1]), pack2(b[2], b[3])); }

constexpr int P1_N = IN_WP;
struct EpiInProj {
    static constexpr bool PERM = true, AFTER_DRAIN = false;
    unsigned char* ws;
    __device__ __forceinline__ void operator()(const pg8::f32x4 (&acc)[2][2][4][2], const pg8::Unit& u, int wr, int wc, int fr, int fq) const {
        const int row0 = u.pm * 256 + wr * 64 + fr;
        const int pn = u.pn;
        const int cl0 = wc * 32 + 8 * fq;
        bf16_t* dst; int ld, cbase, kind;
        if (pn < 2)       { dst = reinterpret_cast<bf16_t*>(ws + OFF_HQ);  ld = 512; cbase = pn * 256;        kind = 1; }
        else if (pn < 4)  { dst = reinterpret_cast<bf16_t*>(ws + OFF_HLF); ld = 512; cbase = (pn - 2) * 256;  kind = 2; }
        else if (pn < 6)  { dst = reinterpret_cast<bf16_t*>(ws + OFF_HV);  ld = 512; cbase = (pn - 4) * 256;  kind = 0; }
        else if (pn < 8)  { dst = reinterpret_cast<bf16_t*>(ws + OFF_HG);  ld = 512; cbase = (pn - 6) * 256;  kind = 1; }
        else if (pn == 8) { dst = reinterpret_cast<bf16_t*>(ws + OFF_GQ);  ld = 256; cbase = 0;               kind = 3; }
        else if (pn == 9) { dst = reinterpret_cast<bf16_t*>(ws + OFF_GK);  ld = 256; cbase = 0;               kind = 0; }
        else if (pn < 12) { dst = reinterpret_cast<bf16_t*>(ws + OFF_GV);  ld = 512; cbase = (pn - 10) * 256; kind = 0; }
        else if (pn < 14) { dst = reinterpret_cast<bf16_t*>(ws + OFF_GG);  ld = 512; cbase = (pn - 12) * 256; kind = 1; }
        else {
            if (wc == 0 && fq < 2) {
                float* gl = reinterpret_cast<float*>(ws + OFF_GLOW);
#pragma unroll
                for (int ai = 0; ai < 2; ++ai)
#pragma unroll
                    for (int m = 0; m < 4; ++m) {
                        float* rp = gl + (size_t)(row0 + ai * 128 + m * 16) * 16 + 8 * fq;
                        *reinterpret_cast<pg8::f32x4*>(rp) = acc[ai][0][m][0];
                        *reinterpret_cast<pg8::f32x4*>(rp + 4) = acc[ai][0][m][1];
                    }
            }
            return;
        }
        float lbv[2][8];
#pragma unroll
        for (int bj = 0; bj < 2; ++bj)
#pragma unroll
            for (int j = 0; j < 8; ++j) lbv[bj][j] = 0.f;
        if (kind == 2) {
            const float* lb = reinterpret_cast<const float*>(ws + OFF_LB);
#pragma unroll
            for (int bj = 0; bj < 2; ++bj)
#pragma unroll
                for (int j = 0; j < 8; ++j) lbv[bj][j] = lb[cbase + bj * 128 + cl0 + j];
        }
#pragma unroll
        for (int ai = 0; ai < 2; ++ai)
#pragma unroll
            for (int m = 0; m < 4; ++m) {
                bf16_t* rowp = dst + (size_t)(row0 + ai * 128 + m * 16) * ld + cbase + cl0;
#pragma unroll
                for (int bj = 0; bj < 2; ++bj) {
                    pg8::f32x4 v0 = acc[ai][bj][m][0], v1 = acc[ai][bj][m][1];
                    if (kind == 1) {
#pragma unroll
                        for (int j = 0; j < 4; ++j) { v0[j] = silu_f(v0[j]); v1[j] = silu_f(v1[j]); }
                    } else if (kind == 2) {
#pragma unroll
                        for (int j = 0; j < 4; ++j) {
                            const float l0 = lbv[bj][j], l1 = lbv[bj][4 + j];
                            v0[j] = __logf(l0 + (1.f - l0) * __builtin_amdgcn_rcpf(1.f + __expf(-v0[j])));
                            v1[j] = __logf(l1 + (1.f - l1) * __builtin_amdgcn_rcpf(1.f + __expf(-v1[j])));
                        }
                    } else if (kind == 3) {
#pragma unroll
                        for (int j = 0; j < 4; ++j) { v0[j] *= 0.125f; v1[j] *= 0.125f; }
                    }
                    *reinterpret_cast<uint4*>(rowp + bj * 128) = pack8(v0, v1);
                }
            }
    }
};
struct EpiOutProj {
    static constexpr bool PERM = false, AFTER_DRAIN = false;
    const float* x; float* out;
    __device__ __forceinline__ void operator()(const pg8::f32x4 (&acc)[2][2][4][2], const pg8::Unit& u, int wr, int wc, int fr, int fq) const {
        const int row0 = u.pm * 256 + wr * 64 + fr, col0 = u.pn * 256 + wc * 32 + 4 * fq;
#pragma unroll
        for (int ai = 0; ai < 2; ++ai)
#pragma unroll
            for (int m = 0; m < 4; ++m) {
                const size_t ro = (size_t)(row0 + ai * 128 + m * 16) * DM + col0;
#pragma unroll
                for (int bj = 0; bj < 2; ++bj)
#pragma unroll
                    for (int n = 0; n < 2; ++n) {
                        const pg8::f32x4 xv = *reinterpret_cast<const pg8::f32x4*>(x + ro + bj * 128 + n * 16);
                        *reinterpret_cast<pg8::f32x4*>(out + ro + bj * 128 + n * 16) = xv + acc[ai][bj][m][n];
                    }
            }
    }
};
struct EpiQ {
    static constexpr bool PERM = true, AFTER_DRAIN = false;
    bf16_t* Q;
    __device__ __forceinline__ void operator()(const pg8::f32x4 (&acc)[2][2][4][2], const pg8::Unit& u, int wr, int wc, int fr, int fq) const {
        const int row0 = u.pm * 256 + wr * 64 + fr, col0 = u.pn * 256 + wc * 32 + 8 * fq;
#pragma unroll
        for (int ai = 0; ai < 2; ++ai)
#pragma unroll
            for (int m = 0; m < 4; ++m) {
                bf16_t* rowp = Q + (size_t)(row0 + ai * 128 + m * 16) * 2048 + col0;
#pragma unroll
                for (int bj = 0; bj < 2; ++bj) *reinterpret_cast<uint4*>(rowp + bj * 128) = pack8(acc[ai][bj][m][0], acc[ai][bj][m][1]);
            }
    }
};
template <class Epi>
DEVI void run_gemm(const bf16_t* A, const bf16_t* Bt, int N, const Epi& E, char* smem) {
    pg8::Gemm g{A, Bt, M_TOK, N, 1024};
#if PROBE_GEMM_DUP
    struct DupOrder : pg8::StaticOrder { __host__ __device__ bool next(int i, pg8::Unit& u) const { return pg8::StaticOrder::next(i >> 1, u); } };
    DupOrder S; S.init(M_TOK, N, (int)gridDim.x, (int)blockIdx.x);
    pg8::gemm_phase<Epi, DupOrder, false>((PG8_LAS unsigned char*)smem, g, S, E, nullptr);
#else
    pg8::StaticOrder S; S.init(M_TOK, N, (int)gridDim.x, (int)blockIdx.x);
    pg8::gemm_phase<Epi, pg8::StaticOrder, false>((PG8_LAS unsigned char*)smem, g, S, E, nullptr);
#endif
    __builtin_amdgcn_s_waitcnt(0);
}

constexpr int P2_UNITS = 512 * 3;
DEVI float logsigmoid_f(float z) { return fminf(z, 0.f) - __logf(1.f + __expf(-fabsf(z))); }

template <bool DRY>
DEVI void phase2_unit_t(const Params& p, int u, char* smem) {
    unsigned char* ws = p.ws;
    const int tid = LTID;
    const int cidx = u / 3, part = u % 3;
    const size_t row0 = (size_t)cidx * 64;
    if (part >= 3) {
        const bool isg = part >= 5; const int n = ((part - 3) & 1) * 256 + tid;
        const bf16_t* V = reinterpret_cast<const bf16_t*>(ws + (isg ? OFF_GV : OFF_HV));
        bf16_t* VT = reinterpret_cast<bf16_t*>(ws + (isg ? OFF_GVT : OFF_HVT));
#pragma unroll 1
        for (int hf = 0; hf < 4; ++hf) {
            unsigned short vb[16];
#pragma unroll
            for (int r = 0; r < 16; ++r) vb[r] = V[(row0 + hf * 16 + r) * 512 + n];
#pragma unroll
            for (int r8 = 0; r8 < 2; ++r8) {
                unsigned pk[4];
#pragma unroll
                for (int rr = 0; rr < 8; ++rr) {
                    const unsigned short b = vb[r8 * 8 + rr];
                    if (rr & 1) pk[rr >> 1] |= ((unsigned)b << 16); else pk[rr >> 1] = b;
                }
                *reinterpret_cast<uint4*>(VT + ((size_t)cidx * 512 + n) * 64 + hf * 16 + r8 * 8) = make_uint4(pk[0], pk[1], pk[2], pk[3]);
            }
        }
        return;
    }
    if (part < 2) {
        const int n = part * 256 + tid;
        bf16_t* HQ = reinterpret_cast<bf16_t*>(ws + OFF_HQ);
        bf16_t* HLF = reinterpret_cast<bf16_t*>(ws + OFF_HLF);
        float Gl = 0.f;
#pragma unroll 16
        for (int r = 0; r < 64; ++r) Gl += bf2f(HLF[(row0 + r) * 512 + n]);
        float G = 0.f;
#pragma unroll 1
        for (int hf = 0; hf < 4; ++hf) {
            unsigned short lfb[16], qb[16];
#pragma unroll
            for (int r = 0; r < 16; ++r) { lfb[r] = HLF[(row0 + hf * 16 + r) * 512 + n]; qb[r] = HQ[(row0 + hf * 16 + r) * 512 + n]; }
#pragma unroll
            for (int r8 = 0; r8 < 2; ++r8) {
                unsigned pk[4];
#pragma unroll
                for (int rr = 0; rr < 8; ++rr) {
                    const int r = r8 * 8 + rr;
                    const size_t idx = (row0 + hf * 16 + r) * 512 + n;
                    const float lf = bf2f(lfb[r]);
                    G += lf;
                    const float key = 1.f - __expf(lf);
                    const unsigned short bq = f2bf(bf2f(qb[r]) * __expf(G));
                    const unsigned short bk = f2bf(key * __expf(-G));
                    if (DRY) { reinterpret_cast<bf16_t*>(ws + OFF_XN)[idx] = bq; reinterpret_cast<bf16_t*>(ws + OFF_XN + 32 * MiB)[idx] = bk; } else { HQ[idx] = bq; HLF[idx] = bk; }
                    if (rr & 1) pk[rr >> 1] |= ((unsigned)bk << 16); else pk[rr >> 1] = bk;
                }
            }
        }
        reinterpret_cast<float*>(DRY ? reinterpret_cast<unsigned char*>(p.out) + 64 * MiB : ws + OFF_DECH)[(size_t)cidx * 512 + n] = __expf(Gl);
    } else {
        const int n = tid;
        bf16_t* GQ = reinterpret_cast<bf16_t*>(ws + OFF_GQ);
        bf16_t* GK = reinterpret_cast<bf16_t*>(ws + OFF_GK);
        const float* GL = reinterpret_cast<const float*>(ws + OFF_GLOW);
        float wg[16];
#pragma unroll
        for (int j = 0; j < 16; ++j) wg[j] = p.gla_wg[j * 256 + n];
        const float bg = p.gla_bg[n];
        float Gl = 0.f, G = 0.f;
#pragma unroll 1
        for (int hf = 0; hf < 4; ++hf) {
            unsigned short qb[16], kb[16]; float lgv[16];
#pragma unroll
            for (int r = 0; r < 16; ++r) { qb[r] = GQ[(row0 + hf * 16 + r) * 256 + n]; kb[r] = GK[(row0 + hf * 16 + r) * 256 + n]; }
#pragma unroll
            for (int r = 0; r < 16; ++r) {
                const float4* g4 = reinterpret_cast<const float4*>(GL + (row0 + hf * 16 + r) * 16);
                float z = bg;
#pragma unroll
                for (int j = 0; j < 4; ++j) { const float4 t = g4[j]; z += t.x * wg[4 * j] + t.y * wg[4 * j + 1] + t.z * wg[4 * j + 2] + t.w * wg[4 * j + 3]; }
                lgv[r] = logsigmoid_f(z) * (1.f / 16.f);
            }
#pragma unroll
            for (int r8 = 0; r8 < 2; ++r8) {
                unsigned pk[4];
#pragma unroll
                for (int rr = 0; rr < 8; ++rr) {
                    const int r = r8 * 8 + rr;
                    G += lgv[r];
                    const size_t idx = (row0 + hf * 16 + r) * 256 + n;
                    const unsigned short bq = f2bf(bf2f(qb[r]) * __expf(G));
                    const unsigned short bk = f2bf(bf2f(kb[r]) * __expf(-G));
                    GQ[idx] = bq; GK[idx] = bk;
                    if (rr & 1) pk[rr >> 1] |= ((unsigned)bk << 16); else pk[rr >> 1] = bk;
                }
            }
        }
        Gl = G;
        reinterpret_cast<float*>(ws + OFF_DECG)[(size_t)cidx * 256 + n] = __expf(Gl);
    }
}

DEVI void phase2_unit(const Params& p, int u, char* smem) { phase2_unit_t<false>(p, u, smem); }
DEVI void phase2_dry_unit(const Params& p, int u, char* smem) { if ((u % 7) < 2) phase2_unit_t<true>(p, u, smem); }

DEVI unsigned off_b(unsigned row, unsigned ch) { return 256u * row + 16u * (ch ^ (((row & 3u) << 2) | ((row >> 2) & 3u))); }
DEVI unsigned tr_addr16(unsigned lane, unsigned c, unsigned ks, unsigned t) {
    const unsigned g = lane >> 4, q = (lane & 15u) >> 2, pp = lane & 3u;
    return off_b(32u * ks + 8u * g + 4u * t + q, 2u * c + (pp >> 1)) + 8u * (pp & 1u);
}
typedef unsigned short u16x4_t __attribute__((ext_vector_type(4)));
DEVI bf16x8 tr_frag(unsigned base, unsigned lane, unsigned c, unsigned ks) {
    u16x4_t a, b;
    asm volatile("ds_read_b64_tr_b16 %0, %2\n\tds_read_b64_tr_b16 %1, %3\n\ts_waitcnt lgkmcnt(0)" : "=&v"(a), "=&v"(b) : "v"(base + tr_addr16(lane, c, ks, 0)), "v"(base + tr_addr16(lane, c, ks, 1)) : "memory");
    bf16x8 r;
    r[0] = (short)a[0]; r[1] = (short)a[1]; r[2] = (short)a[2]; r[3] = (short)a[3]; r[4] = (short)b[0]; r[5] = (short)b[1]; r[6] = (short)b[2]; r[7] = (short)b[3];
    return r;
}
DEVI bf16x8 row_frag(const char* tile, unsigned lane, unsigned rb, unsigned s) { return *reinterpret_cast<const bf16x8*>(tile + off_b((lane & 15u) + 16u * rb, 4u * s + (lane >> 4))); }
DEVI void fill_tile64(char* tile, const bf16_t* __restrict__ g, int ldg) {
#pragma unroll
    for (int i = 0; i < 4; ++i) {
        const int n = LTID + 256 * i, row = n >> 4, ch = n & 15;
        *reinterpret_cast<uint4*>(tile + off_b(row, ch)) = *reinterpret_cast<const uint4*>(g + (size_t)row * ldg + ch * 8);
    }
}
DEVI void fill_tile64x64(char* tile, const bf16_t* __restrict__ g, int ldg) {
#pragma unroll
    for (int i = 0; i < 2; ++i) {
        const int n = LTID + 256 * i, row = n >> 3, ch = n & 7;
        *reinterpret_cast<uint4*>(tile + off_b(row, ch)) = *reinterpret_cast<const uint4*>(g + (size_t)row * ldg + ch * 8);
    }
}

constexpr int P3_UNITS = 4096;
template <int DK>
DEVI void kv_unit(const Params& p, int sidx, int c, char* smem) {
    unsigned char* ws = p.ws;
    const int lane = LTID & 63, w = LTID >> 6;
    const int b = sidx >> 2, h = sidx & 3;
    const int cidx = b * 128 + c;
    constexpr int NDB = DK / 16;
    const bf16_t* Kn = reinterpret_cast<const bf16_t*>(ws + (DK == 128 ? OFF_HLF : OFF_GK)) + (size_t)cidx * 64 * (4 * DK) + h * DK;
    const bf16_t* V = reinterpret_cast<const bf16_t*>(ws + (DK == 128 ? OFF_HV : OFF_GV)) + (size_t)cidx * 64 * 512 + h * 128;
    const float* DEC = reinterpret_cast<const float*>(ws + (DK == 128 ? OFF_DECH : OFF_DECG)) + (size_t)cidx * (4 * DK) + h * DK;
    bf16_t* ST = reinterpret_cast<bf16_t*>(reinterpret_cast<unsigned char*>(p.out) + (DK == 128 ? OUT_STH : OUT_STG)) + ((size_t)sidx * 128 + c) * (128 * DK);
    f32x4 acc[NDB][2];
#pragma unroll
    for (int i = 0; i < NDB; ++i) { acc[i][0] = f32x4{0, 0, 0, 0}; acc[i][1] = f32x4{0, 0, 0, 0}; }
    const int fo = (lane & 15) * 64 + 8 * (lane >> 4);
    fill_tile64(smem, V, 512);
    if (DK == 128) fill_tile64(smem + 16384, Kn, 512); else fill_tile64x64(smem + 16384, Kn, 256);
    __syncthreads();
    const unsigned tbase = (unsigned)(size_t)smem, kbase = tbase + 16384u;
#pragma unroll
    for (int ks = 0; ks < 2; ++ks) {
        bf16x8 bv[2];
#pragma unroll
        for (int nb = 0; nb < 2; ++nb) bv[nb] = tr_frag(tbase, (unsigned)lane, (unsigned)(2 * w + nb), (unsigned)ks);
#pragma unroll
        for (int db = 0; db < NDB; ++db) {
            const bf16x8 ak = tr_frag(kbase, (unsigned)lane, (unsigned)db, (unsigned)ks);
            acc[db][0] = mfma16(ak, bv[0], acc[db][0]);
            acc[db][1] = mfma16(ak, bv[1], acc[db][1]);
        }
    }
#pragma unroll
    for (int db = 0; db < NDB; ++db) {
        const int d = db * 16 + 4 * (lane >> 4);
        const float4 dc = *reinterpret_cast<const float4*>(DEC + d);
#pragma unroll
        for (int nb = 0; nb < 2; ++nb) {
            const int dv = 32 * w + nb * 16 + (lane & 15);
            uint2 o; o.x = pack2(acc[db][nb][0] * dc.x, acc[db][nb][1] * dc.y); o.y = pack2(acc[db][nb][2] * dc.z, acc[db][nb][3] * dc.w);
            *reinterpret_cast<uint2*>(ST + (size_t)dv * DK + d) = o;
        }
    }
    __syncthreads();
}
DEVI void phase3_unit(const Params& p, int u, char* smem) {
    if (u < 2048) kv_unit<128>(p, u >> 7, u & 127, smem); else { u -= 2048; kv_unit<64>(p, u >> 7, u & 127, smem); }
}

constexpr int P4_UNITS = 384;
template <bool DRY>
DEVI void phase4_unit_t(const Params& p, int u, char* smem) {
    unsigned char* ws = p.ws;
    int e = u * 256 + LTID;
    bf16_t* base; bf16_t* sbase; const float* dec; size_t cstride; int decstride;
    if (e < 65536) {
        const int sidx = e >> 12, rem = e & 4095, dv = rem >> 5, d4 = (rem & 31) * 4;
        const int b = sidx >> 2, h = sidx & 3;
        base = reinterpret_cast<bf16_t*>(reinterpret_cast<unsigned char*>(p.out) + OUT_STH) + ((size_t)sidx * 128) * 16384 + dv * 128 + d4;
        sbase = DRY ? reinterpret_cast<bf16_t*>(ws + OFF_XN) + ((size_t)sidx * 128) * 16384 + dv * 128 + d4 : base;
        cstride = 16384;
        dec = reinterpret_cast<const float*>(ws + OFF_DECH) + (size_t)(b * 128) * 512 + h * 128 + d4; decstride = 512;
    } else {
        e -= 65536;
        const int sidx = e >> 11, rem = e & 2047, dv = rem >> 4, d4 = (rem & 15) * 4;
        const int b = sidx >> 2, h = sidx & 3;
        base = reinterpret_cast<bf16_t*>(reinterpret_cast<unsigned char*>(p.out) + OUT_STG) + ((size_t)sidx * 128) * 8192 + dv * 64 + d4;
        sbase = DRY ? reinterpret_cast<bf16_t*>(ws + OFF_KTH) + ((size_t)sidx * 128) * 8192 + dv * 64 + d4 : base;
        cstride = 8192;
        dec = reinterpret_cast<const float*>(ws + OFF_DECG) + (size_t)(b * 128) * 256 + h * 64 + d4; decstride = 256;
    }
    float s0 = 0.f, s1 = 0.f, s2 = 0.f, s3 = 0.f;
    for (int c8 = 0; c8 < 128; c8 += 8) {
        uint2 kv[8]; float4 dc[8];
#pragma unroll
        for (int i = 0; i < 8; ++i) { kv[i] = *reinterpret_cast<const uint2*>(base + (size_t)(c8 + i) * cstride); dc[i] = *reinterpret_cast<const float4*>(dec + (size_t)(c8 + i) * decstride); }
#pragma unroll
        for (int i = 0; i < 8; ++i) {
            uint2 o; o.x = pack2(s0, s1); o.y = pack2(s2, s3);
            *reinterpret_cast<uint2*>(sbase + (size_t)(c8 + i) * cstride) = o;
            s0 = dc[i].x * s0 + bflo(kv[i].x); s1 = dc[i].y * s1 + bfhi(kv[i].x);
            s2 = dc[i].z * s2 + bflo(kv[i].y); s3 = dc[i].w * s3 + bfhi(kv[i].y);
        }
    }
}

DEVI void phase4_unit(const Params& p, int u, char* smem) { phase4_unit_t<false>(p, u, smem); }
DEVI void phase4_dry_unit(const Params& p, int u, char* smem) { phase4_unit_t<true>(p, u, smem); }

constexpr int P5_UNITS = 4096;
constexpr int PL_PITCH = 72;
template <int DK>
DEVI void out_unit(const Params& p, int sidx, int c, char* smem) {
    unsigned char* ws = p.ws;
    const int lane = LTID & 63, w = LTID >> 6;
    const int b = sidx >> 2, h = sidx & 3;
    const int cidx = b * 128 + c;
    const size_t row0 = (size_t)cidx * 64;
    constexpr int LDQ = 4 * DK;
    const bf16_t* Qn = reinterpret_cast<const bf16_t*>(ws + (DK == 128 ? OFF_HQ : OFF_GQ)) + row0 * LDQ + h * DK;
    const bf16_t* Kn = reinterpret_cast<const bf16_t*>(ws + (DK == 128 ? OFF_HLF : OFF_GK)) + row0 * LDQ + h * DK;
    const bf16_t* V = reinterpret_cast<const bf16_t*>(ws + (DK == 128 ? OFF_HV : OFF_GV)) + row0 * 512 + h * 128;
    const bf16_t* ST = reinterpret_cast<const bf16_t*>(reinterpret_cast<const unsigned char*>(p.out) + (DK == 128 ? OUT_STH : OUT_STG)) + ((size_t)sidx * 128 + c) * (128 * DK);
    const bf16_t* GATE = reinterpret_cast<const bf16_t*>(ws + (DK == 128 ? OFF_HG : OFF_GG)) + row0 * 512 + h * 128;
    const float* ng = (DK == 128) ? p.hg_norm_g : p.gla_norm_g;
    bf16_t* MIX = reinterpret_cast<bf16_t*>(ws + OFF_MIX) + row0 * 1024 + (DK == 128 ? 0 : 512) + h * 128;
    bf16_t* PL = reinterpret_cast<bf16_t*>(smem);
    float* RED = reinterpret_cast<float*>(smem + 64 * PL_PITCH * 2);

    const int l15 = lane & 15, lg = lane >> 4;
    bf16x8 ast[DK / 32][2];
    uint2 gtv[4][2]; float4 g4v[2];
    char* vtile = smem + 16384;
    char* qtile = smem + 32768;
    char* ktile = smem + 49152;
    fill_tile64(vtile, V, 512);
    if (DK == 128) { fill_tile64(qtile, Qn, LDQ); fill_tile64(ktile, Kn, LDQ); } else { fill_tile64x64(qtile, Qn, LDQ); fill_tile64x64(ktile, Kn, LDQ); }
#pragma unroll
    for (int ks = 0; ks < DK / 32; ++ks) {
#pragma unroll
        for (int x = 0; x < 2; ++x) ast[ks][x] = ldg_frag(ST + (size_t)((2 * w + x) * 16 + l15) * DK + ks * 32 + 8 * lg);
    }
#pragma unroll
    for (int x = 0; x < 2; ++x) {
        g4v[x] = *reinterpret_cast<const float4*>(ng + (2 * w + x) * 16 + 4 * lg);
#pragma unroll
        for (int y = 0; y < 4; ++y) gtv[y][x] = *reinterpret_cast<const uint2*>(GATE + (size_t)(y * 16 + l15) * 512 + (2 * w + x) * 16 + 4 * lg);
    }
    __syncthreads();
    {
        bf16x8 bq[DK / 32];
#pragma unroll
        for (int ks = 0; ks < DK / 32; ++ks) bq[ks] = row_frag(qtile, (unsigned)lane, (unsigned)w, (unsigned)ks);
#pragma unroll
        for (int jb = 0; jb < 4; ++jb) {
            f32x4 a = f32x4{0, 0, 0, 0};
            if (jb <= w) {
#pragma unroll
                for (int ks = 0; ks < DK / 32; ++ks) {
                    const bf16x8 ak = row_frag(ktile, (unsigned)lane, (unsigned)jb, (unsigned)ks);
                    a = mfma16(ak, bq[ks], a);
                }
            }
            const int i = w * 16 + l15, j0 = jb * 16 + 4 * lg;
            const float v0 = (j0 + 0 <= i) ? a[0] : 0.f, v1 = (j0 + 1 <= i) ? a[1] : 0.f, v2 = (j0 + 2 <= i) ? a[2] : 0.f, v3 = (j0 + 3 <= i) ? a[3] : 0.f;
            uint2 o; o.x = pack2(v0, v1); o.y = pack2(v2, v3);
            *reinterpret_cast<uint2*>(PL + i * PL_PITCH + j0) = o;
        }
    }
    __syncthreads();
    f32x4 acc[2][4];
#pragma unroll
    for (int x = 0; x < 2; ++x)
#pragma unroll
        for (int y = 0; y < 4; ++y) acc[x][y] = f32x4{0, 0, 0, 0};
#pragma unroll
    for (int ks = 0; ks < 2; ++ks) {
        bf16x8 bp[4], avx[2];
#pragma unroll
        for (int x = 0; x < 2; ++x) avx[x] = tr_frag((unsigned)(size_t)vtile, (unsigned)lane, (unsigned)(2 * w + x), (unsigned)ks);
#pragma unroll
        for (int y = 0; y < 4; ++y) bp[y] = *reinterpret_cast<const bf16x8*>(PL + (y * 16 + l15) * PL_PITCH + ks * 32 + 8 * lg);
#pragma unroll
        for (int x = 0; x < 2; ++x)
#pragma unroll
            for (int y = 0; y < 4; ++y) acc[x][y] = mfma16(avx[x], bp[y], acc[x][y]);
    }
#pragma unroll
    for (int ks = 0; ks < DK / 32; ++ks) {
#pragma unroll
        for (int x = 0; x < 2; ++x)
#pragma unroll
            for (int y = 0; y < 4; ++y) acc[x][y] = mfma16(ast[ks][x], row_frag(qtile, (unsigned)lane, (unsigned)y, (unsigned)ks), acc[x][y]);
    }
    float ssq[4];
#pragma unroll
    for (int y = 0; y < 4; ++y) {
        float s = 0.f;
#pragma unroll
        for (int x = 0; x < 2; ++x)
#pragma unroll
            for (int r = 0; r < 4; ++r) s += acc[x][y][r] * acc[x][y][r];
        s += __shfl_xor(s, 16); s += __shfl_xor(s, 32);
        ssq[y] = s;
    }
    if (lg == 0) {
#pragma unroll
        for (int y = 0; y < 4; ++y) RED[w * 64 + y * 16 + l15] = ssq[y];
    }
    __syncthreads();
#pragma unroll
    for (int y = 0; y < 4; ++y) {
        const int i = y * 16 + l15;
        const float tot = RED[i] + RED[64 + i] + RED[128 + i] + RED[192 + i];
        const float rstd = rsqrtf(tot * (1.f / 128.f) + 1e-6f);
#pragma unroll
        for (int x = 0; x < 2; ++x) {
            const int dv = (2 * w + x) * 16 + 4 * lg;
            const float4 g4 = g4v[x];
            const uint2 gt = gtv[y][x];
            uint2 o;
            o.x = pack2(acc[x][y][0] * rstd * g4.x * bflo(gt.x), acc[x][y][1] * rstd * g4.y * bfhi(gt.x));
            o.y = pack2(acc[x][y][2] * rstd * g4.z * bflo(gt.y), acc[x][y][3] * rstd * g4.w * bfhi(gt.y));
            *reinterpret_cast<uint2*>(MIX + (size_t)i * 1024 + dv) = o;
        }
    }
    __syncthreads();
}
DEVI void phase5_unit(const Params& p, int u, char* smem) {
    if (u < 2048) out_unit<128>(p, u >> 7, u & 127, smem); else { u -= 2048; out_unit<64>(p, u >> 7, u & 127, smem); }
}

DEVI void rms_row_bf16_i8(const float* __restrict__ xr, const float* __restrict__ g, bf16_t* __restrict__ dst, unsigned char* __restrict__ dst8, float* __restrict__ descale, int lane) {
    float4 v[4]; float ss = 0.f;
#pragma unroll
    for (int i = 0; i < 4; ++i) { v[i] = reinterpret_cast<const float4*>(xr)[lane + 64 * i]; ss += v[i].x * v[i].x + v[i].y * v[i].y + v[i].z * v[i].z + v[i].w * v[i].w; }
    ss = wave_sum(ss);
    const float r = rsqrtf(ss * (1.f / 1024.f) + 1e-6f);
    float am = 0.f;
#pragma unroll
    for (int i = 0; i < 4; ++i) {
        const float4 gg = reinterpret_cast<const float4*>(g)[lane + 64 * i];
        v[i].x *= r * gg.x; v[i].y *= r * gg.y; v[i].z *= r * gg.z; v[i].w *= r * gg.w;
        uint2 o; o.x = pack2(v[i].x, v[i].y); o.y = pack2(v[i].z, v[i].w);
        reinterpret_cast<uint2*>(dst)[lane + 64 * i] = o;
        am = fmaxf(am, fmaxf(fmaxf(fabsf(v[i].x), fabsf(v[i].y)), fmaxf(fabsf(v[i].z), fabsf(v[i].w))));
    }
    am = wave_max(am);
    const float sc = am > 0.f ? 127.f / am : 1.f;
#pragma unroll
    for (int i = 0; i < 4; ++i) reinterpret_cast<int*>(dst8)[lane + 64 * i] = pack_i8x4(v[i].x * sc, v[i].y * sc, v[i].z * sc, v[i].w * sc);
    if (lane == 0) *descale = am > 0.f ? am * (1.f / 127.f) : 1.f;
}
constexpr int P7_UNITS = 8192;
DEVI void phase7_unit(const Params& p, int u, char* smem) {
    const int lane = LTID & 63, w = LTID >> 6;
    const int row = u * 4 + w;
    rms_row_bf16_i8(p.out + (size_t)row * DM, p.norm2_g, reinterpret_cast<bf16_t*>(p.ws + OFF_HN) + (size_t)row * DM,
                    p.ws + OFF_HN8 + (size_t)row * DM, reinterpret_cast<float*>(p.ws + OFF_HS) + row, lane);
}

using f32x16 = __attribute__((ext_vector_type(16))) float;
DEVI f32x16 mfma32(bf16x8 a, bf16x8 b, f32x16 c) { return __builtin_amdgcn_mfma_f32_32x32x16_bf16(a, b, c, 0, 0, 0); }
DEVI unsigned umax(unsigned a, unsigned b) { return a > b ? a : b; }
DEVI unsigned umin(unsigned a, unsigned b) { return a > b ? b : a; }
DEVI unsigned f2ord(float f) { const unsigned u = __float_as_uint(f); return u ^ ((unsigned)((int)u >> 31) | 0x80000000u); }
DEVI float ord2f(unsigned k) { return __uint_as_float((k & 0x80000000u) ? (k ^ 0x80000000u) : ~k); }

template <int BASE>
DEVI void sort16_desc(unsigned (&x)[64]) {
#pragma unroll
    for (int k = 2; k <= 16; k <<= 1) {
#pragma unroll
        for (int j = k >> 1; j > 0; j >>= 1) {
#pragma unroll
            for (int i = 0; i < 16; ++i) {
                const int l = i ^ j;
                if (l > i) {
                    const bool desc = ((i & k) == 0);
                    const unsigned a = x[BASE + i], b = x[BASE + l];
                    const unsigned hi = umax(a, b), lo = umin(a, b);
                    x[BASE + i] = desc ? hi : lo; x[BASE + l] = desc ? lo : hi;
                }
            }
        }
    }
}
template <int BASE>
DEVI void bmerge16_desc(unsigned (&x)[64]) {
#pragma unroll
    for (int j = 8; j > 0; j >>= 1) {
#pragma unroll
        for (int i = 0; i < 16; ++i) {
            const int l = i ^ j;
            if (l > i) { const unsigned a = x[BASE + i], b = x[BASE + l]; x[BASE + i] = umax(a, b); x[BASE + l] = umin(a, b); }
        }
    }
}
DEVI void top16_of_64(unsigned (&x)[64]) {
    sort16_desc<0>(x); sort16_desc<16>(x); sort16_desc<32>(x); sort16_desc<48>(x);
#pragma unroll
    for (int i = 0; i < 16; ++i) x[i] = umax(x[i], x[31 - i]);
    bmerge16_desc<0>(x);
#pragma unroll
    for (int i = 0; i < 16; ++i) x[32 + i] = umax(x[32 + i], x[63 - i]);
    bmerge16_desc<32>(x);
#pragma unroll
    for (int i = 0; i < 16; ++i) x[i] = umax(x[i], x[47 - i]);
    bmerge16_desc<0>(x);
}

DEVI void scores_top16(const char* sktile, const bf16_t* __restrict__ Qp, int lane, unsigned (&out)[16]) {
    const int r31 = lane & 31, hh = lane >> 5;
    f32x16 acc[4];
#pragma unroll
    for (int nb = 0; nb < 4; ++nb)
#pragma unroll
        for (int r = 0; r < 16; ++r) acc[nb][r] = 0.f;
#pragma unroll
    for (int ks = 0; ks < 8; ++ks) {
        const bf16x8 bq = ldg_frag(Qp + (size_t)r31 * 2048 + ks * 16 + 8 * hh);
#pragma unroll
        for (int nb = 0; nb < 4; ++nb) {
            const bf16x8 ak = *reinterpret_cast<const bf16x8*>(sktile + off_b((unsigned)(nb * 32 + r31), (unsigned)(2 * ks + hh)));
            acc[nb] = mfma32(ak, bq, acc[nb]);
        }
    }
    unsigned x[64];
    const unsigned hx = (unsigned)hh * 4u;
#pragma unroll
    for (int nb = 0; nb < 4; ++nb)
#pragma unroll
        for (int r = 0; r < 16; ++r) {
            const int nbase = nb * 32 + (r & 3) + 8 * (r >> 2);
            x[nb * 16 + r] = ((f2ord(acc[nb][r]) & ~127u) | (unsigned)(127 - nbase)) ^ hx;
        }
    top16_of_64(x);
    unsigned lo[16], hi[16];
#pragma unroll
    for (int i = 0; i < 16; ++i) { auto rr = __builtin_amdgcn_permlane32_swap(x[i], x[i], false, false); lo[i] = rr[0]; hi[i] = rr[1]; }
#pragma unroll
    for (int i = 0; i < 16; ++i) x[i] = umax(lo[i], hi[15 - i]);
    bmerge16_desc<0>(x);
#pragma unroll
    for (int i = 0; i < 16; ++i) out[i] = x[i];
}

DEVI void phase9_block(const Params& p, char* smem) {
    unsigned char* ws = p.ws;
    const int tid = threadIdx.x, lane = tid & 63, w = tid >> 6;
    const int h = blockIdx.x & 7, rank = blockIdx.x >> 3, nrank = ((int)gridDim.x - h + 7) >> 3;
    const int hh = lane >> 5;
    {
        const bf16_t* SK = reinterpret_cast<const bf16_t*>(ws + OFF_SK) + (size_t)(h * 2) * 128 * 128;
#pragma unroll
        for (int i = 0; i < 8; ++i) {
            const int nn = tid + 512 * i, tl = nn >> 11, row = (nn >> 4) & 127, ch = nn & 15;
            *reinterpret_cast<uint4*>(smem + tl * 32768 + off_b((unsigned)row, (unsigned)ch)) = *reinterpret_cast<const uint4*>(SK + (size_t)tl * 16384 + row * 128 + ch * 8);
        }
    }
    __syncthreads();
    unsigned* KL = reinterpret_cast<unsigned*>(smem + 65536) + w * 2048;
    for (int it = rank; it < M_TOK / 256; it += nrank) {
    const int t0 = it * 256 + w * 32;
    const bf16_t* Q = reinterpret_cast<const bf16_t*>(ws + OFF_Q) + (size_t)t0 * 2048 + h * 256;
    unsigned k0[16], k1[16];
    scores_top16(smem, Q, lane, k0);
    scores_top16(smem + 32768, Q + 128, lane, k1);
#pragma unroll
    for (int i = 0; i < 16; ++i) { KL[i * 64 + lane] = k0[i]; KL[(16 + i) * 64 + lane] = k1[i]; }
    float s0[16], s1[16];
#pragma unroll
    for (int i = 0; i < 16; ++i) { s0[i] = ord2f(k0[i] & ~127u); s1[i] = ord2f(k1[i] & ~127u); }
    unsigned x[64];
    {
        int n = 0;
#pragma unroll
        for (int a = 0; a < 16; ++a)
#pragma unroll
            for (int b = 0; b < 16; ++b)
                if ((a + 1) * (b + 1) <= 16) { x[n] = (f2ord(s0[a] + s1[b]) & ~255u) | (unsigned)(255 - (a * 16 + b)); ++n; }
#pragma unroll
        for (int i = 50; i < 64; ++i) x[i] = 0u;
    }
    top16_of_64(x);
    float cv[16]; int ex[16];
#pragma unroll
    for (int i = 0; i < 16; ++i) {
        cv[i] = ord2f(x[i] & ~255u);
        const int cid = 255 - (int)(x[i] & 255u);
        const unsigned ka = KL[(cid >> 4) * 64 + lane], kb = KL[(16 + (cid & 15)) * 64 + lane];
        ex[i] = (127 - (int)(ka & 127u)) * 128 + (127 - (int)(kb & 127u));
    }
    float sum = 0.f;
    const float mx = cv[0];
#pragma unroll
    for (int i = 0; i < 16; ++i) cv[i] = __expf(cv[i] - mx);
#pragma unroll
    for (int i = 0; i < 16; ++i) sum += cv[i];
    const float inv = __builtin_amdgcn_rcpf(sum);
    const size_t orow = (size_t)(t0 + (lane & 31)) * 128 + h * 16;
    if (hh == 0) {
        int4* d = reinterpret_cast<int4*>(reinterpret_cast<int*>(ws + OFF_EIDX) + orow);
#pragma unroll
        for (int i = 0; i < 4; ++i) d[i] = make_int4(ex[4 * i], ex[4 * i + 1], ex[4 * i + 2], ex[4 * i + 3]);
        const float* US = reinterpret_cast<const float*>(ws + OFF_US);
        float4* du = reinterpret_cast<float4*>(reinterpret_cast<float*>(ws + OFF_EU) + orow);
#pragma unroll
        for (int i = 0; i < 4; ++i) du[i] = make_float4(US[ex[4 * i]], US[ex[4 * i + 1]], US[ex[4 * i + 2]], US[ex[4 * i + 3]]);
    } else {
        const float* VS = reinterpret_cast<const float*>(ws + OFF_VS);
        float4* d = reinterpret_cast<float4*>(reinterpret_cast<float*>(ws + OFF_EW) + orow);
#pragma unroll
        for (int i = 0; i < 4; ++i) d[i] = make_float4(cv[4 * i] * inv * VS[ex[4 * i]], cv[4 * i + 1] * inv * VS[ex[4 * i + 1]], cv[4 * i + 2] * inv * VS[ex[4 * i + 2]], cv[4 * i + 3] * inv * VS[ex[4 * i + 3]]);
        }
}
}

typedef _Float16 h2_t __attribute__((ext_vector_type(2)));
DEVI float sum8(float v) { v += dpp_f<0xB1>(v); v += dpp_f<0x4E>(v); v += dpp_f<0x141>(v); return v; }
DEVI float sum64(float v) {
    v = sum8(v); v += dpp_f<0x128>(v);
    { auto s = __builtin_amdgcn_permlane16_swap(__float_as_uint(v), __float_as_uint(v), false, false); v = __uint_as_float(s[0]) + __uint_as_float(s[1]); }
    { auto s = __builtin_amdgcn_permlane32_swap(__float_as_uint(v), __float_as_uint(v), false, false); v = __uint_as_float(s[0]) + __uint_as_float(s[1]); }
    return v;
}
DEVI long pack_i64(unsigned lo, unsigned hi) { return (long)(((unsigned long long)hi << 32) | (unsigned long long)lo); }

#define SB __builtin_amdgcn_sched_barrier(0)
#define SB __builtin_amdgcn_sched_barrier(0)
#define PIN4(Q) "+v"(Q.x), "+v"(Q.y), "+v"(Q.z), "+v"(Q.w)
DEVI void phase10a_block(const Params& p, char* smem) {
    unsigned char* ws = p.ws;
    const int s = blockIdx.x & 7, rank = blockIdx.x >> 3, nrank = ((int)gridDim.x - s + 7) >> 3;
    const int lane = threadIdx.x & 63, wave = threadIdx.x >> 6;
    const int lg = lane & 7, grp = lane >> 3;
    const unsigned char* U8 = ws + OFF_U8 + (size_t)s * (16384 * 128);
    const unsigned char* HNs = ws + OFF_HN8 + 128 * s + 16 * lg;
    unsigned* PD = reinterpret_cast<unsigned*>(ws + OFF_PD) + (size_t)s * M_TOK * 64;
    float* stg = reinterpret_cast<float*>(smem) + wave * (16 * 128);
    constexpr int NTG = M_TOK / 8;
#define P10A_LOAD_EV(TG, E) do { const int4* _q = reinterpret_cast<const int4*>(reinterpret_cast<const int*>(ws + OFF_EIDX) + (size_t)((TG) * 8 + wave) * 128 + 16 * grp); \
        E[0] = _q[0]; E[1] = _q[1]; E[2] = _q[2]; E[3] = _q[3]; } while (0)
#define P10A_LOAD_ROWS(TG, E, R, HA) do { \
        asm volatile("" : PIN4(E[0]), PIN4(E[1]), PIN4(E[2]), PIN4(E[3])); \
        const int _e[16] = {E[0].x, E[0].y, E[0].z, E[0].w, E[1].x, E[1].y, E[1].z, E[1].w, E[2].x, E[2].y, E[2].z, E[2].w, E[3].x, E[3].y, E[3].z, E[3].w}; \
        _Pragma("unroll") for (int _i = 0; _i < 16; ++_i) R[_i] = *reinterpret_cast<const uint4*>(U8 + ((unsigned)_e[_i] * 128u + 16u * (unsigned)lg)); \
        HA = *reinterpret_cast<const uint4*>(HNs + (size_t)((TG) * 8 + wave) * DM); } while (0)
#define P10A_COMPUTE(SLOT, R, HA) do { \
        asm volatile("" : PIN4(R[0]), PIN4(R[1]), PIN4(R[2]), PIN4(R[3]), PIN4(R[4]), PIN4(R[5])); \
        asm volatile("" : PIN4(R[6]), PIN4(R[7]), PIN4(R[8]), PIN4(R[9]), PIN4(R[10]), PIN4(R[11])); \
        asm volatile("" : PIN4(R[12]), PIN4(R[13]), PIN4(R[14]), PIN4(R[15]), PIN4(HA)); \
        int _v1 = 0, _v2 = 0; \
        _Pragma("unroll") for (int _i = 0; _i < 16; ++_i) { \
            int _a = __builtin_amdgcn_sdot4((int)R[_i].x, (int)HA.x, 0, false); \
            _a = __builtin_amdgcn_sdot4((int)R[_i].y, (int)HA.y, _a, false); \
            _a = __builtin_amdgcn_sdot4((int)R[_i].z, (int)HA.z, _a, false); \
            _a = __builtin_amdgcn_sdot4((int)R[_i].w, (int)HA.w, _a, false); \
            _a += __builtin_amdgcn_mov_dpp(_a, 0xB1, 0xf, 0xf, true); _a += __builtin_amdgcn_mov_dpp(_a, 0x4E, 0xf, 0xf, true); _a += __builtin_amdgcn_mov_dpp(_a, 0x141, 0xf, 0xf, true); \
            if (_i < 8) _v1 = (lg == _i) ? _a : _v1; else _v2 = (lg == _i - 8) ? _a : _v2; } \
        stg[(SLOT) * 128 + 16 * grp + lg] = (float)_v1; stg[(SLOT) * 128 + 16 * grp + 8 + lg] = (float)_v2; } while (0)
    int4 eA[4], eB[4], eC[4]; uint4 rA[16], rB[16]; uint4 hA0, hB0;
    if (rank >= NTG) return;
    const int ntok = (NTG - rank + nrank - 1) / nrank;
#define TGI(I) (rank + ((I) < ntok ? (I) : ntok - 1) * nrank)
    P10A_LOAD_EV(TGI(0), eA);
    SB; P10A_LOAD_EV(TGI(1), eB);
    SB; P10A_LOAD_ROWS(TGI(0), eA, rA, hA0);
    SB;
    for (int base = 0; base < ntok; base += 16) {
#pragma unroll 1
        for (int i = base; i < base + 16; i += 2) {
            SB; P10A_LOAD_EV(TGI(i + 2), eC);
            SB; P10A_LOAD_ROWS(TGI(i + 1), eB, rB, hB0);
            SB; P10A_COMPUTE(i - base, rA, hA0);
            SB; P10A_LOAD_EV(TGI(i + 3), eB);
            SB; P10A_LOAD_ROWS(TGI(i + 2), eC, rA, hA0);
            SB; P10A_COMPUTE(i + 1 - base, rB, hB0);
            SB;
        }
#pragma unroll 4
        for (int j = 0; j < 16; ++j) {
            const float2 v = *reinterpret_cast<const float2*>(stg + j * 128 + 2 * lane);
            PD[(size_t)(TGI(base + j) * 8 + wave) * 64 + lane] = pack2(v.x, v.y);
        }
        __builtin_amdgcn_s_waitcnt(0x0F70);
    }
#undef TGI
#undef P10A_LOAD_EV
#undef P10A_LOAD_ROWS
#undef P10A_COMPUTE
}

DEVI void phase10w_block(const Params& p) {
    unsigned char* ws = p.ws;
    const int lane = threadIdx.x & 63, wave = threadIdx.x >> 6;
    const unsigned* PD = reinterpret_cast<const unsigned*>(ws + OFF_PD);
    const float* HS = reinterpret_cast<const float*>(ws + OFF_HS);
    for (int t = blockIdx.x * 8 + wave; t < M_TOK; t += gridDim.x * 8) {
        unsigned pd[8];
#pragma unroll
        for (int sl = 0; sl < 8; ++sl) pd[sl] = PD[((size_t)sl * M_TOK + t) * 64 + lane];
        const float2 uu = reinterpret_cast<const float2*>(ws + OFF_EU)[(size_t)t * 64 + lane];
        const float2 gg = reinterpret_cast<const float2*>(ws + OFF_EW)[(size_t)t * 64 + lane];
        const float hs = HS[t];
        float d0 = 0.f, d1 = 0.f;
#pragma unroll
        for (int sl = 0; sl < 8; ++sl) { d0 += bflo(pd[sl]); d1 += bfhi(pd[sl]); }
        d0 *= uu.x * hs; d1 *= uu.y * hs;
        const _Float16 w0 = (_Float16)(gg.x * 0.5f * d0 * (1.f + erff(d0 * 0.70710678118654752f))), w1 = (_Float16)(gg.y * 0.5f * d1 * (1.f + erff(d1 * 0.70710678118654752f)));
        const h2_t p0 = h2_t{w0, w0}, p1 = h2_t{w1, w1};
        reinterpret_cast<uint2*>(ws + OFF_W16)[(size_t)t * 64 + lane] = make_uint2(__builtin_bit_cast(unsigned, p0), __builtin_bit_cast(unsigned, p1));
    }
}

template <bool DRY>
DEVI void phase10b_block(const Params& p, char* smem) {
    unsigned char* ws = p.ws;
    const int s = blockIdx.x & 7, rank = blockIdx.x >> 3, nrank = ((int)gridDim.x - s + 7) >> 3;
    const int lane = threadIdx.x & 63, wave = threadIdx.x >> 6;
    const int lg = lane & 7, grp = lane >> 3;
    const unsigned char* V8 = ws + OFF_V8 + (size_t)s * (16384 * 128);
    float* stg = reinterpret_cast<float*>(smem) + wave * (16 * 128);
    constexpr int NTG = M_TOK / 8;
#define P10B_LOAD_EV(TG, E) do { const int4* _q = reinterpret_cast<const int4*>(reinterpret_cast<const int*>(ws + OFF_EIDX) + (size_t)((TG) * 8 + wave) * 128 + 16 * grp); \
        E[0] = _q[0]; E[1] = _q[1]; E[2] = _q[2]; E[3] = _q[3]; } while (0)
#define P10B_LOAD_ROWS(TG, E, R, WA, WB, WC, WD) do { \
        asm volatile("" : PIN4(E[0]), PIN4(E[1]), PIN4(E[2]), PIN4(E[3])); \
        const int _e[16] = {E[0].x, E[0].y, E[0].z, E[0].w, E[1].x, E[1].y, E[1].z, E[1].w, E[2].x, E[2].y, E[2].z, E[2].w, E[3].x, E[3].y, E[3].z, E[3].w}; \
        _Pragma("unroll") for (int _i = 0; _i < 16; ++_i) R[_i] = *reinterpret_cast<const uint4*>(V8 + ((unsigned)_e[_i] * 128u + 16u * (unsigned)lg)); \
        const uint4* _w = reinterpret_cast<const uint4*>(reinterpret_cast<const unsigned*>(ws + OFF_W16) + (size_t)((TG) * 8 + wave) * 128 + 16 * grp); WA = _w[0]; WB = _w[1]; WC = _w[2]; WD = _w[3]; } while (0)
#define P10B_COMPUTE(SLOT, R, WA, WB, WC, WD) do { \
          \
        asm volatile("" : PIN4(R[0]), PIN4(R[1]), PIN4(R[2]), PIN4(R[3]), PIN4(R[4]), PIN4(R[5])); \
        asm volatile("" : PIN4(R[6]), PIN4(R[7]), PIN4(R[8]), PIN4(R[9]), PIN4(R[10]), PIN4(R[11])); \
        asm volatile("" : PIN4(R[12]), PIN4(R[13]), PIN4(R[14]), PIN4(R[15]), PIN4(WA), PIN4(WB)); \
        asm volatile("" : PIN4(WC), PIN4(WD)); \
        const unsigned _ww[16] = {WA.x, WA.y, WA.z, WA.w, WB.x, WB.y, WB.z, WB.w, WC.x, WC.y, WC.z, WC.w, WD.x, WD.y, WD.z, WD.w}; \
        h2_t _acc[8]; unsigned _zb; asm volatile("v_mov_b32 %0, 0" : "=v"(_zb)); \
        _Pragma("unroll") for (int _j = 0; _j < 8; ++_j) _acc[_j] = __builtin_bit_cast(h2_t, _zb); \
        _Pragma("unroll") for (int _i = 0; _i < 16; ++_i) { \
            const h2_t _wp = __builtin_bit_cast(h2_t, _ww[_i]); \
            const unsigned _wd[4] = {R[_i].x, R[_i].y, R[_i].z, R[_i].w}; \
            _Pragma("unroll") for (int _j = 0; _j < 4; ++_j) { \
                _acc[2 * _j] += _wp * __builtin_amdgcn_cvt_scalef32_pk_f16_fp8((int)_wd[_j], 1.0f, false); \
                _acc[2 * _j + 1] += _wp * __builtin_amdgcn_cvt_scalef32_pk_f16_fp8((int)_wd[_j], 1.0f, true); } } \
        float _o[16]; \
        _Pragma("unroll") for (int _j = 0; _j < 8; ++_j) { \
            h2_t _x = _acc[_j]; \
            _x += __builtin_bit_cast(h2_t, __builtin_amdgcn_mov_dpp(__builtin_bit_cast(int, _x), 0x128, 0xf, 0xf, true));     \
            { auto _s = __builtin_amdgcn_permlane16_swap(__builtin_bit_cast(unsigned, _x), __builtin_bit_cast(unsigned, _x), false, false); _x = __builtin_bit_cast(h2_t, (unsigned)_s[0]) + __builtin_bit_cast(h2_t, (unsigned)_s[1]); } \
            { auto _s = __builtin_amdgcn_permlane32_swap(__builtin_bit_cast(unsigned, _x), __builtin_bit_cast(unsigned, _x), false, false); _x = __builtin_bit_cast(h2_t, (unsigned)_s[0]) + __builtin_bit_cast(h2_t, (unsigned)_s[1]); } \
            _o[2 * _j] = (float)_x[0]; _o[2 * _j + 1] = (float)_x[1]; } \
        if (grp == 0) { float* _orow = stg + (SLOT) * 128 + 16 * lg; \
            _Pragma("unroll") for (int _i = 0; _i < 4; ++_i) *reinterpret_cast<float4*>(_orow + 4 * _i) = make_float4(_o[4 * _i], _o[4 * _i + 1], _o[4 * _i + 2], _o[4 * _i + 3]); } } while (0)
    int4 eA[4], eB[4], eC[4]; uint4 rA[16], rB[16]; uint4 wA0, wA1, wA2, wA3, wB0, wB1, wB2, wB3;
    if (rank >= NTG) return;
    const int ntok = (NTG - rank + nrank - 1) / nrank;
#define TGI(I) (rank + ((I) < ntok ? (I) : ntok - 1) * nrank)
    P10B_LOAD_EV(TGI(0), eA);
    SB; P10B_LOAD_EV(TGI(1), eB);
    SB; P10B_LOAD_ROWS(TGI(0), eA, rA, wA0, wA1, wA2, wA3);
    SB;
    for (int base = 0; base < ntok; base += 16) {
#pragma unroll 1
        for (int i = base; i < base + 16; i += 2) {
            SB; P10B_LOAD_EV(TGI(i + 2), eC);
            SB; P10B_LOAD_ROWS(TGI(i + 1), eB, rB, wB0, wB1, wB2, wB3);
            SB; P10B_COMPUTE(i - base, rA, wA0, wA1, wA2, wA3);
            SB; P10B_LOAD_EV(TGI(i + 3), eB);
            SB; P10B_LOAD_ROWS(TGI(i + 2), eC, rA, wA0, wA1, wA2, wA3);
            SB; P10B_COMPUTE(i + 1 - base, rB, wB0, wB1, wB2, wB3);
            SB;
        }
#pragma unroll 4
        for (int j = 0; j < 16; ++j) {
            const float2 v = *reinterpret_cast<const float2*>(stg + j * 128 + 2 * lane);
            reinterpret_cast<unsigned*>(ws + OFF_PEER)[(DRY ? (size_t)M_TOK * 512 : 0) + (size_t)(TGI(base + j) * 8 + wave) * 512 + 64 * s + lane] = pack2(v.x, v.y);
        }
        __builtin_amdgcn_s_waitcnt(0x0F70);
    }
#undef TGI
#undef P10B_LOAD_EV
#undef P10B_LOAD_ROWS
#undef P10B_COMPUTE
}

DEVI void phase10c_block(const Params& p) {
    unsigned char* ws = p.ws;
    const int lane = threadIdx.x & 63, wave = threadIdx.x >> 6;
    const float4* gf = reinterpret_cast<const float4*>(p.norm_f_g);
    for (int t = blockIdx.x * 8 + wave; t < M_TOK; t += gridDim.x * 8) {
        float4* orow = reinterpret_cast<float4*>(p.out + (size_t)t * DM);
        const uint2* prow = reinterpret_cast<const uint2*>(ws + OFF_PEER) + (size_t)t * 256;
        float4 v[4]; uint2 q[4];
#pragma unroll
        for (int i = 0; i < 4; ++i) { v[i] = orow[lane + 64 * i]; q[i] = prow[lane + 64 * i]; }
        float ss = 0.f;
#pragma unroll
        for (int i = 0; i < 4; ++i) {
            v[i].x += bflo(q[i].x); v[i].y += bfhi(q[i].x); v[i].z += bflo(q[i].y); v[i].w += bfhi(q[i].y);
            ss += v[i].x * v[i].x + v[i].y * v[i].y + v[i].z * v[i].z + v[i].w * v[i].w;
        }
        const float r = rsqrtf(wave_sum(ss) * (1.f / 1024.f) + 1e-6f);
#pragma unroll
        for (int i = 0; i < 4; ++i) {
            const float4 g = gf[lane + 64 * i];
            orow[lane + 64 * i] = make_float4(v[i].x * r * g.x, v[i].y * r * g.y, v[i].z * r * g.z, v[i].w * r * g.w);
        }
    }
}

#define XB_TMO      128
#define XB_XCNT(j)  (256  + 64 * (j))
#define XB_XSUB(j)  (1280 + 64 * (j))
#define XB_XGEN(j)  (2304 + 64 * (j))
#define XB_TOP      3328
#define XB_TOPGEN   3392
#define XCD_BAR_WORDS 3456
#define XB_SPIN_CAP (1u << 22)
#define LAS __attribute__((address_space(3)))
DEVI unsigned xb_ld(unsigned* p)              { return __hip_atomic_load(p, __ATOMIC_RELAXED, __HIP_MEMORY_SCOPE_AGENT); }
DEVI unsigned xb_add(unsigned* p, unsigned v) { return __hip_atomic_fetch_add(p, v, __ATOMIC_RELAXED, __HIP_MEMORY_SCOPE_AGENT); }
DEVI unsigned xb_xcc_id() { return (unsigned)__builtin_amdgcn_s_getreg((3 << 11) | 20) & 0xFu; }
#define XB_SPIN(cond, bar) do { unsigned _sp = 0; while (cond) { __builtin_amdgcn_s_sleep(1); \
    if ((++_sp & 255u) == 0u) { if (xb_ld(&(bar)[XB_TMO])) break; if (_sp > XB_SPIN_CAP) { atomicAdd(&(bar)[XB_TMO], 1u); break; } } } } while (0)
struct XcdBarrier { unsigned* bar; unsigned x; volatile LAS unsigned* st; };
DEVI XcdBarrier xcd_barrier_post(unsigned* bar, volatile LAS unsigned* st) {
    XcdBarrier b; b.bar = bar; b.x = xb_xcc_id(); b.st = st;
    if (threadIdx.x == 0) (void)xb_add(&bar[XB_XCNT(b.x)], 1u);
    return b;
}
DEVI void xcd_barrier_complete(unsigned* bar, unsigned x, unsigned& nloc, unsigned& nx) {
    const unsigned G = gridDim.x * gridDim.y * gridDim.z;
    unsigned sum, cnt, mine, sp = 0u;
    for (;;) {
        sum = 0u; cnt = 0u; mine = 0u;
#pragma unroll
        for (unsigned j = 0; j < 16; ++j) { const unsigned c = xb_ld(&bar[XB_XCNT(j)]); sum += c; cnt += (c > 0u) ? 1u : 0u; mine = (j == x) ? c : mine; }
        if (sum == G) break;
        __builtin_amdgcn_s_sleep(1);
        if ((++sp & 255u) == 0u) { if (xb_ld(&bar[XB_TMO])) break; if (sp > XB_SPIN_CAP) { atomicAdd(&bar[XB_TMO], 1u); break; } }
    }
    nloc = mine > 0u ? mine : 1u; nx = cnt > 0u ? cnt : 1u;
}
DEVI void xcd_barrier(const XcdBarrier& b) {
    asm volatile("s_waitcnt vmcnt(0)" ::: "memory");
    __syncthreads();
    if (threadIdx.x == 0) {
        unsigned* bar = b.bar;
        __builtin_amdgcn_s_waitcnt(0);
        unsigned nloc = b.st[0], nx = b.st[1];
        if (nloc == 0u) { xcd_barrier_complete(bar, b.x, nloc, nx); b.st[0] = nloc; b.st[1] = nx; }
        const unsigned old = xb_add(&bar[XB_XSUB(b.x)], 1u);
        const unsigned gen = old / nloc;
        if (old + 1u == (gen + 1u) * nloc) {
            __builtin_amdgcn_fence(__ATOMIC_RELEASE, "agent");
            asm volatile("s_waitcnt vmcnt(0)" ::: "memory");
            const unsigned og = xb_add(&bar[XB_TOP], 1u);
            const unsigned tg = og / nx;
            if (og + 1u == (tg + 1u) * nx) xb_add(&bar[XB_TOPGEN], 1u);
            else XB_SPIN(xb_ld(&bar[XB_TOPGEN]) == tg, bar);
            __builtin_amdgcn_fence(__ATOMIC_ACQUIRE, "agent");
            xb_add(&bar[XB_XGEN(b.x)], 1u);
            asm volatile("s_waitcnt vmcnt(0)" ::: "memory");
        } else {
            XB_SPIN(xb_ld(&bar[XB_XGEN(b.x)]) == gen, bar);
            __builtin_amdgcn_fence(__ATOMIC_ACQUIRE, "agent");
            asm volatile("s_waitcnt vmcnt(0)" ::: "memory");
        }
    }
    __syncthreads();
}

constexpr int N_PHASES = 11;
constexpr int LDS_PHASE_BYTES = 131072;
constexpr int LDS_BYTES = LDS_PHASE_BYTES + 16;

__global__ void __launch_bounds__(512, 2) hymba_fwd(Params p) {
    extern __shared__ __attribute__((aligned(16))) char smem[];
    cg::grid_group grid = cg::this_grid();
    const int lo = p.ph_lo, hi = p.ph_hi;
    volatile LAS unsigned* bst = (volatile LAS unsigned*)(smem + LDS_PHASE_BYTES);
    if (threadIdx.x == 0) { bst[0] = 0u; bst[1] = 0u; bst[2] = 0u; bst[3] = 0u; }
    __syncthreads();
    XcdBarrier xb = xcd_barrier_post(reinterpret_cast<unsigned*>(p.ws + OFF_BAR), bst);
    const int hb = (int)(threadIdx.x >> 8);
    char* hsm = smem + hb * 65536;
#define SEAM(K) if ((K) > lo) { if ((K) == lo + 1) grid.sync(); else xcd_barrier(xb); }
#define RUN_PHASE(K, FN, N) if (lo <= (K) && (K) < hi) { SEAM(K) for (int rep = 0; rep < 1 + ((PROBE_DUP >> (K)) & 1); ++rep) { if (rep) xcd_barrier(xb); \
        for (int ub = blockIdx.x * 2; ub < (N); ub += gridDim.x * 2) { const int u = ub + hb; if (u < (N)) FN(p, u, hsm); } } }
#define RUN_GEMM(K, CALL) if (lo <= (K) && (K) < hi) { SEAM(K) CALL; }
    RUN_PHASE(0, phase0_unit, P0_UNITS)
    RUN_GEMM(1, run_gemm(reinterpret_cast<const bf16_t*>(p.ws + OFF_XN), reinterpret_cast<const bf16_t*>(p.ws + OFF_WIN), P1_N, EpiInProj{p.ws}, smem))
#if PROBE_P2G
    if (lo <= 2 && 2 < hi) { xcd_barrier(xb); for (int ub = blockIdx.x * 2; ub < P2_UNITS; ub += gridDim.x * 2) { const int u = ub + hb; if (u < P2_UNITS) phase2_dry_unit(p, u, hsm); } }
#endif
    RUN_PHASE(2, phase2_unit, P2_UNITS)
#if PROBE_P2T
    if (lo <= 2 && 2 < hi) { xcd_barrier(xb); for (int ub = blockIdx.x * 2; ub < P2_UNITS; ub += gridDim.x * 2) { const int u = ub + hb; if (u < P2_UNITS && (u % 7) >= 3) phase2_unit(p, u, hsm); } }
#endif
    RUN_PHASE(3, phase3_unit, P3_UNITS)
#if PROBE_P4
    if (lo <= 4 && 4 < hi) { xcd_barrier(xb); for (int ub = blockIdx.x * 2; ub < P4_UNITS; ub += gridDim.x * 2) { const int u = ub + hb; if (u < P4_UNITS) phase4_dry_unit(p, u, hsm); } }
#endif
    RUN_PHASE(4, phase4_unit, P4_UNITS)
    RUN_PHASE(5, phase5_unit, P5_UNITS)
    RUN_GEMM(6, run_gemm(reinterpret_cast<const bf16_t*>(p.ws + OFF_MIX), reinterpret_cast<const bf16_t*>(p.ws + OFF_WOUT), 1024, EpiOutProj{p.x, p.out}, smem))
    RUN_PHASE(7, phase7_unit, P7_UNITS)
    RUN_GEMM(8, run_gemm(reinterpret_cast<const bf16_t*>(p.ws + OFF_HN), reinterpret_cast<const bf16_t*>(p.ws + OFF_WQ), 2048, EpiQ{reinterpret_cast<bf16_t*>(p.ws + OFF_Q)}, smem))
    RUN_GEMM(9, phase9_block(p, smem))
    if (lo <= 10 && 10 < hi) {
        SEAM(10)
#if PROBE_P10X == 4
        phase10a_block(p, smem); xcd_barrier(xb);
#endif
        phase10a_block(p, smem);
#if PROBE_P10X == 1
        xcd_barrier(xb); phase10a_block(p, smem);
#endif

        xcd_barrier(xb); phase10w_block(p);
#if PROBE_P10X == 2
        xcd_barrier(xb); phase10b_block<true>(p, smem);
#endif
        xcd_barrier(xb); phase10b_block<false>(p, smem);
        xcd_barrier(xb); phase10c_block(p);
#if PROBE_P10X == 3
        xcd_barrier(xb); phase10c_block(p);
#endif
    }
#undef RUN_PHASE
#undef RUN_GEMM
#undef SEAM
}

extern "C" void kernel_launch(void* const* d_in, const int* in_sizes, int n_in, void* d_out, int out_size, void* d_ws, size_t ws_size, hipStream_t stream) {
    static int grid_blocks = 0;
    if (grid_blocks == 0) {
        if (n_in != 15 || in_sizes[0] != M_TOK * DM || out_size != M_TOK * DM || ws_size < WS_NEED) {
            fprintf(stderr, "kernel_launch: unexpected shapes (n_in %d, in0 %d, out %d, ws %zu)\n", n_in, n_in > 0 ? in_sizes[0] : -1, out_size, ws_size);
            grid_blocks = -1; return;
        }
        int dev = 0, cus = 0, per_cu = 0;
        (void)hipGetDevice(&dev);
        (void)hipDeviceGetAttribute(&cus, hipDeviceAttributeMultiprocessorCount, dev);
        (void)hipFuncSetAttribute((const void*)hymba_fwd, hipFuncAttributeMaxDynamicSharedMemorySize, LDS_BYTES);
        (void)hipOccupancyMaxActiveBlocksPerMultiprocessor(&per_cu, (const void*)hymba_fwd, 512, LDS_BYTES);
        if (per_cu < 1) per_cu = 1;
        if (per_cu > 1) per_cu = 1;
        grid_blocks = cus * per_cu;
    }
    if (grid_blocks < 0) return;
    Params p{};
    p.x = (const float*)d_in[0]; p.norm1_g = (const float*)d_in[1]; p.w_in = (const float*)d_in[2]; p.hg_lower = (const float*)d_in[3];
    p.hg_norm_g = (const float*)d_in[4]; p.gla_wg = (const float*)d_in[5]; p.gla_bg = (const float*)d_in[6]; p.gla_norm_g = (const float*)d_in[7];
    p.w_out = (const float*)d_in[8]; p.norm2_g = (const float*)d_in[9]; p.w_q = (const float*)d_in[10]; p.sub_keys = (const float*)d_in[11];
    p.peer_u = (const float*)d_in[12]; p.peer_v = (const float*)d_in[13]; p.norm_f_g = (const float*)d_in[14];
    p.out = (float*)d_out; p.ws = (unsigned char*)d_ws;
#if N_LAUNCH_MODE == 1
    (void)hipMemsetAsync((unsigned char*)d_ws + OFF_BAR, 0, XCD_BAR_WORDS * 4, stream);
    p.ph_lo = 0; p.ph_hi = N_PHASES;
    void* args[] = {&p};
    hipError_t e = hipLaunchCooperativeKernel((const void*)hymba_fwd, dim3(grid_blocks), dim3(512), args, LDS_BYTES, stream);
    if (e != hipSuccess) fprintf(stderr, "cooperative launch failed: %s (grid %d)\n", hipGetErrorString(e), grid_blocks);
#else
    for (int ph = 0; ph < N_PHASES; ++ph) {
        p.ph_lo = ph; p.ph_hi = ph + 1;
        hipLaunchKernelGGL(hymba_fwd, dim3(grid_blocks), dim3(512), LDS_BYTES, stream, p);
    }
#endif
}
```

```cpp
#include <hip/hip_runtime.h>
#include <hip/hip_cooperative_groups.h>
#include <cstdio>
#include <cstdint>
namespace cg = cooperative_groups;

#ifndef N_LAUNCH_MODE
#define N_LAUNCH_MODE 1
#endif

#ifndef PROBE_DUP
#define PROBE_DUP 0
#endif
#ifndef PROBE_P10_DUP
#define PROBE_P10_DUP 0
#endif
#ifndef P10_SLICED
#define P10_SLICED 0
#endif
#ifndef PROBE_P10A
#define PROBE_P10A 0
#endif
#ifndef PROBE_P10_MASK
#define PROBE_P10_MASK 0x7fffffff
#endif
#ifndef PROBE_P10X
#define PROBE_P10X 0
#endif
#ifndef PROBE_P2T
#define PROBE_P2T 0
#endif
#ifndef PROBE_P4
#define PROBE_P4 0
#endif
#ifndef PROBE_P2G
#define PROBE_P2G 0
#endif
#ifndef PROBE_GEMM_DUP
#define PROBE_GEMM_DUP 0
#endif
#define DEVI __device__ __forceinline__
#define LTID ((int)(threadIdx.x & 255u))
typedef unsigned short bf16_t;
using bf16x8 = __attribute__((ext_vector_type(8))) short;
using f32x4 = __attribute__((ext_vector_type(4))) float;

constexpr int M_TOK = 32768;
constexpr int DM = 1024;
constexpr int IN_WP = 3840;
constexpr size_t MiB = 1024ull * 1024ull;

constexpr size_t OFF_XN   = 0;
constexpr size_t OFF_WIN  = 64 * MiB;
constexpr size_t OFF_WOUT = 72 * MiB;
constexpr size_t OFF_WQ   = 74 * MiB;
constexpr size_t OFF_SK   = 78 * MiB;
constexpr size_t OFF_LB   = 79 * MiB;
constexpr size_t OFF_U8   = 80 * MiB;
constexpr size_t OFF_V8   = 96 * MiB;
constexpr size_t OFF_US   = 112 * MiB;
constexpr size_t OFF_VS   = 113 * MiB;
constexpr size_t OFF_R2   = 144 * MiB;
constexpr size_t OFF_HQ   = OFF_R2;
constexpr size_t OFF_HLF  = OFF_R2 + 32 * MiB;
constexpr size_t OFF_HV   = OFF_R2 + 64 * MiB;
constexpr size_t OFF_HG   = OFF_R2 + 96 * MiB;
constexpr size_t OFF_GQ   = OFF_R2 + 128 * MiB;
constexpr size_t OFF_GK   = OFF_R2 + 144 * MiB;
constexpr size_t OFF_GV   = OFF_R2 + 160 * MiB;
constexpr size_t OFF_GG   = OFF_R2 + 192 * MiB;
constexpr size_t OFF_GLOW = OFF_R2 + 224 * MiB;
constexpr size_t OFF_KTH  = 370 * MiB;
constexpr size_t OFF_KTG  = 402 * MiB;
constexpr size_t OFF_DECH = 418 * MiB;
constexpr size_t OFF_DECG = 419 * MiB;
constexpr size_t OFF_HVT  = 420 * MiB;
constexpr size_t OFF_GVT  = 452 * MiB;
constexpr size_t OFF_H16  = OFF_HVT;
constexpr size_t OFF_DUMMY = 336 * MiB;
constexpr size_t OFF_BAR  = 484 * MiB;
constexpr size_t WS_NEED  = 485 * MiB;
constexpr size_t OFF_MIX  = OFF_XN;
constexpr size_t OFF_HN   = OFF_R2;
constexpr size_t OFF_Q    = OFF_R2 + 64 * MiB;
constexpr size_t OFF_EIDX = OFF_KTH;
constexpr size_t OFF_EW   = OFF_KTH + 16 * MiB;
constexpr size_t OFF_EU   = OFF_KTG;
constexpr size_t OFF_HN8  = OFF_XN;
constexpr size_t OFF_HS   = OFF_XN + 32 * MiB;
constexpr size_t OFF_W16  = OFF_XN + 48 * MiB;
constexpr size_t OFF_SSQ  = OFF_XN + 33 * MiB;
constexpr size_t OFF_PD   = OFF_Q;
constexpr size_t OFF_PEER = OFF_Q + 64 * MiB;
constexpr size_t OUT_STH = 0;
constexpr size_t OUT_STG = 64 * MiB;

struct Params {
    const float* x; const float* norm1_g; const float* w_in; const float* hg_lower; const float* hg_norm_g;
    const float* gla_wg; const float* gla_bg; const float* gla_norm_g; const float* w_out; const float* norm2_g;
    const float* w_q; const float* sub_keys; const float* peer_u; const float* peer_v; const float* norm_f_g;
    float* out; unsigned char* ws;
    int ph_lo, ph_hi;
};

DEVI unsigned short f2bf(float f) {
    unsigned u = __float_as_uint(f);
    u += 0x7fffu + ((u >> 16) & 1u);
    return (unsigned short)(u >> 16);
}
DEVI float bf2f(unsigned short b) { return __uint_as_float(((unsigned)b) << 16); }
DEVI unsigned pack2(float a, float b) { return (unsigned)f2bf(a) | ((unsigned)f2bf(b) << 16); }
DEVI float bflo(unsigned u) { return __uint_as_float(u << 16); }
DEVI float bfhi(unsigned u) { return __uint_as_float(u & 0xffff0000u); }
template <int CTRL> DEVI float dpp_f(float x) { return __builtin_bit_cast(float, __builtin_amdgcn_mov_dpp(__builtin_bit_cast(int, x), CTRL, 0xf, 0xf, true)); }
DEVI float wave_sum(float v) {
    v += dpp_f<0xB1>(v); v += dpp_f<0x4E>(v); v += dpp_f<0x141>(v); v += dpp_f<0x128>(v);
    { auto s = __builtin_amdgcn_permlane16_swap(__float_as_uint(v), __float_as_uint(v), false, false); v = __uint_as_float(s[0]) + __uint_as_float(s[1]); }
    { auto s = __builtin_amdgcn_permlane32_swap(__float_as_uint(v), __float_as_uint(v), false, false); v = __uint_as_float(s[0]) + __uint_as_float(s[1]); }
    return v;
}
DEVI float wave_max(float v) {
    v = fmaxf(v, dpp_f<0xB1>(v)); v = fmaxf(v, dpp_f<0x4E>(v)); v = fmaxf(v, dpp_f<0x141>(v)); v = fmaxf(v, dpp_f<0x128>(v));
    { auto s = __builtin_amdgcn_permlane16_swap(__float_as_uint(v), __float_as_uint(v), false, false); v = fmaxf(__uint_as_float(s[0]), __uint_as_float(s[1])); }
    { auto s = __builtin_amdgcn_permlane32_swap(__float_as_uint(v), __float_as_uint(v), false, false); v = fmaxf(__uint_as_float(s[0]), __uint_as_float(s[1])); }
    return v;
}
DEVI float silu_f(float x) { return x * __builtin_amdgcn_rcpf(1.f + __expf(-x)); }
DEVI f32x4 mfma16(bf16x8 a, bf16x8 b, f32x4 c) { return __builtin_amdgcn_mfma_f32_16x16x32_bf16(a, b, c, 0, 0, 0); }
DEVI bf16x8 ldg_frag(const bf16_t* p) { return *reinterpret_cast<const bf16x8*>(p); }

DEVI void rms_row_bf16(const float* __restrict__ xr, const float* __restrict__ g, bf16_t* __restrict__ dst, int lane) {
    float4 v[4]; float ss = 0.f;
#pragma unroll
    for (int i = 0; i < 4; ++i) { v[i] = reinterpret_cast<const float4*>(xr)[lane + 64 * i]; ss += v[i].x * v[i].x + v[i].y * v[i].y + v[i].z * v[i].z + v[i].w * v[i].w; }
    ss = wave_sum(ss);
    const float r = rsqrtf(ss * (1.f / 1024.f) + 1e-6f);
#pragma unroll
    for (int i = 0; i < 4; ++i) {
        const float4 gg = reinterpret_cast<const float4*>(g)[lane + 64 * i];
        uint2 o; o.x = pack2(v[i].x * r * gg.x, v[i].y * r * gg.y); o.y = pack2(v[i].z * r * gg.z, v[i].w * r * gg.w);
        reinterpret_cast<uint2*>(dst)[lane + 64 * i] = o;
    }
}

DEVI void transpose_tile(const float* __restrict__ src, int Nsrc, bf16_t* __restrict__ dst, int nt, int kt, int mode, float* lds) {
    const int tid = LTID, tx = tid & 63, ty = tid >> 6;
    const int np = nt * 64 + tx;
    int col = np; bool valid = true;
    if (mode == 1) {
        if (np < 3072) col = np; else if (np < 3584) col = np + 16; else if (np < 3600) col = np - 512; else { valid = false; col = 0; }
    }
#pragma unroll 4
    for (int kk = ty; kk < 64; kk += 4) {
        lds[kk * 65 + tx] = valid ? src[(size_t)(kt * 64 + kk) * Nsrc + col] : 0.f;
    }
    __syncthreads();
    const int nl = tid >> 2, kq = tid & 3;
    unsigned pk[8];
#pragma unroll
    for (int i = 0; i < 8; ++i) pk[i] = pack2(lds[(kq * 16 + 2 * i) * 65 + nl], lds[(kq * 16 + 2 * i + 1) * 65 + nl]);
    uint4* d = reinterpret_cast<uint4*>(dst + (size_t)(nt * 64 + nl) * 1024 + kt * 64 + kq * 16);
    d[0] = make_uint4(pk[0], pk[1], pk[2], pk[3]);
    d[1] = make_uint4(pk[4], pk[5], pk[6], pk[7]);
    __syncthreads();
}

DEVI void convert8(const float* __restrict__ src, bf16_t* __restrict__ dst, size_t idx8) {
    const float4 a = reinterpret_cast<const float4*>(src)[idx8 * 2], b = reinterpret_cast<const float4*>(src)[idx8 * 2 + 1];
    reinterpret_cast<uint4*>(dst)[idx8] = make_uint4(pack2(a.x, a.y), pack2(a.z, a.w), pack2(b.x, b.y), pack2(b.z, b.w));
}

DEVI int pack_i8x4(float a, float b, float c, float d) {
    const int ia = (int)rintf(a), ib = (int)rintf(b), ic = (int)rintf(c), id = (int)rintf(d);
    return (ia & 255) | ((ib & 255) << 8) | ((ic & 255) << 16) | (id << 24);
}
DEVI void quant_row_i8(const float* __restrict__ xr, unsigned char* __restrict__ dst_table, int row, float* __restrict__ descale, int lane) {
    float4 v[4]; float am = 0.f;
#pragma unroll
    for (int i = 0; i < 4; ++i) { v[i] = reinterpret_cast<const float4*>(xr)[lane + 64 * i]; am = fmaxf(am, fmaxf(fmaxf(fabsf(v[i].x), fabsf(v[i].y)), fmaxf(fabsf(v[i].z), fabsf(v[i].w)))); }
    am = wave_max(am);
    const float sc = am > 0.f ? 127.f / am : 1.f;
#pragma unroll
    for (int i = 0; i < 4; ++i) {
        const int w = lane + 64 * i;
        reinterpret_cast<int*>(dst_table)[(size_t)(w >> 5) * (16384 * 32) + (size_t)row * 32 + (w & 31)] = pack_i8x4(v[i].x * sc, v[i].y * sc, v[i].z * sc, v[i].w * sc);
    }
    if (lane == 0) *descale = am > 0.f ? am * (1.f / 127.f) : 1.f;
}
DEVI void quant_row_fp8(const float* __restrict__ xr, unsigned char* __restrict__ dst_table, int row, float* __restrict__ descale, int lane) {
    float4 v[4]; float am = 0.f;
#pragma unroll
    for (int i = 0; i < 4; ++i) { v[i] = reinterpret_cast<const float4*>(xr)[lane + 64 * i]; am = fmaxf(am, fmaxf(fmaxf(fabsf(v[i].x), fabsf(v[i].y)), fmaxf(fabsf(v[i].z), fabsf(v[i].w)))); }
    am = wave_max(am);
    const float sc = am > 0.f ? 448.f / am : 1.f;
#pragma unroll
    for (int i = 0; i < 4; ++i) {
        const float a = fminf(fmaxf(v[i].x * sc, -448.f), 448.f), b = fminf(fmaxf(v[i].y * sc, -448.f), 448.f);
        const float c = fminf(fmaxf(v[i].z * sc, -448.f), 448.f), d = fminf(fmaxf(v[i].w * sc, -448.f), 448.f);
        int pk = __builtin_amdgcn_cvt_pk_fp8_f32(a, b, 0, false);
        pk = __builtin_amdgcn_cvt_pk_fp8_f32(c, d, pk, true);
        const int w = lane + 64 * i;
        reinterpret_cast<int*>(dst_table)[(size_t)(w >> 5) * (16384 * 32) + (size_t)row * 32 + (w & 31)] = pk;
    }
    if (lane == 0) *descale = am > 0.f ? am * (1.f / 448.f) : 1.f;
}

constexpr int P0_XN = 8192, P0_WIN = 60 * 16, P0_WOUT = 16 * 16, P0_WQ = 32 * 16, P0_UV = 8192, P0_SK = 128, P0_LB = 1;
constexpr int P0_UNITS = P0_XN + P0_WIN + P0_WOUT + P0_WQ + P0_UV + P0_SK + P0_LB;

DEVI void phase0_unit(const Params& p, int u, char* smem) {
    const int tid = LTID, lane = tid & 63, w = tid >> 6;
    unsigned char* ws = p.ws;
    if (u < P0_XN) {
        const int row = u * 4 + w;
        rms_row_bf16(p.x + (size_t)row * DM, p.norm1_g, reinterpret_cast<bf16_t*>(ws + OFF_XN) + (size_t)row * DM, lane);
        return;
    }
    u -= P0_XN;
    if (u < P0_WIN) { transpose_tile(p.w_in, 3600, reinterpret_cast<bf16_t*>(ws + OFF_WIN), u / 16, u % 16, 1, reinterpret_cast<float*>(smem)); return; }
    u -= P0_WIN;
    if (u < P0_WOUT) { transpose_tile(p.w_out, 1024, reinterpret_cast<bf16_t*>(ws + OFF_WOUT), u / 16, u % 16, 0, reinterpret_cast<float*>(smem)); return; }
    u -= P0_WOUT;
    if (u < P0_WQ) { transpose_tile(p.w_q, 2048, reinterpret_cast<bf16_t*>(ws + OFF_WQ), u / 16, u % 16, 0, reinterpret_cast<float*>(smem)); return; }
    u -= P0_WQ;
    if (u < P0_UV) {
        const bool isv = u >= 4096; const int row = (isv ? u - 4096 : u) * 4 + w;
        if (isv) quant_row_fp8(p.peer_v + (size_t)row * DM, ws + OFF_V8, row, reinterpret_cast<float*>(ws + OFF_VS) + row, lane);
        else quant_row_i8(p.peer_u + (size_t)row * DM, ws + OFF_U8, row, reinterpret_cast<float*>(ws + OFF_US) + row, lane);
        return;
    }
    u -= P0_UV;
    if (u < P0_SK) { convert8(p.sub_keys, reinterpret_cast<bf16_t*>(ws + OFF_SK), (size_t)u * 256 + tid); return; }
    float* lb = reinterpret_cast<float*>(ws + OFF_LB);
    for (int n = tid; n < 512; n += 256) {
        const float l0 = p.hg_lower[n], l1 = p.hg_lower[512 + n];
        const float mx = fmaxf(l0, l1); const float e0 = __expf(l0 - mx), e1 = __expf(l1 - mx);
        lb[n] = e0 / (e0 + e1);
    }
}

namespace pg8 {
#define PG8_LAS __attribute__((address_space(3)))
typedef unsigned short bf16_t;
typedef short bf16x8 __attribute__((ext_vector_type(8)));
typedef float f32x4 __attribute__((ext_vector_type(4)));
typedef unsigned u32x4 __attribute__((ext_vector_type(4)));
constexpr int BM = 256, BK = 64, HALF = 128, HTB = HALF * BK * 2  , STAGE_BYTES = 8 * HTB, NXCD = 8, WGM = 8;

__host__ __device__ __forceinline__ int lds_byte(int r, int c) { const int st = (r >> 4) * 2 + (c >> 5), rr = r & 15, cc = c & 31, ob = rr * 64 + cc * 2; return st * 1024 + (ob ^ (((ob >> 9) & 1) << 5)); }
__host__ __device__ __forceinline__ void stage_rc(int b, int& R, int& C) { const int st = b / 1024, sb = b % 1024, swz = sb ^ (((sb >> 9) & 1) << 5); R = (st >> 1) * 16 + swz / 64; C = (st & 1) * 32 + (swz % 64) / 2; }
__host__ __device__ __forceinline__ int perm32(int rho) { const int n = rho >> 4, i = rho & 15; return 8 * (i >> 2) + 4 * n + (i & 3); }

struct Unit { int pm, pn; };
struct Gemm { const bf16_t* A; const bf16_t* Bt; int M, N, K; };

struct StaticOrder {
    int nM, nN, nwg, G, c;
    __host__ __device__ void init(int M, int N, int G_, int c_) { nM = M / BM; nN = N / BM; nwg = nM * nN; G = G_; c = c_; }
    __host__ __device__ bool next(int i, Unit& u) const {
        const long L = (long)i * G + c; if (L >= nwg) return false;
        int wgid = (int)L; { const int q = nwg / NXCD, r = nwg % NXCD, xcd = wgid % NXCD, off = wgid / NXCD; wgid = (xcd < r ? xcd * (q + 1) : r * (q + 1) + (xcd - r) * q) + off; }
        const int nig = WGM * nN, gid = wgid / nig, fm = gid * WGM, gsz = (nM - fm) < WGM ? (nM - fm) : WGM;
        u.pm = fm + ((wgid % nig) % gsz); u.pn = (wgid % nig) / gsz; return true;
    }
    __device__ __forceinline__ void a_ready(const Unit&) const {}
    __device__ __forceinline__ void done(const Unit&) const {}
};
__device__ __forceinline__ unsigned cvt_pk_bf16(float lo, float hi) { unsigned r; asm volatile("v_cvt_pk_bf16_f32 %0, %1, %2" : "=v"(r) : "v"(lo), "v"(hi)); return r; }
typedef float f32x2 __attribute__((ext_vector_type(2)));
template <class Epi, class Sched, bool STAMP = false>
__device__ __forceinline__ void gemm_phase(PG8_LAS unsigned char* lds, const Gemm g, const Sched& S, const Epi& E, unsigned long long* stamps) {
    const int tid = threadIdx.x, wid = __builtin_amdgcn_readfirstlane(tid >> 6), lane = tid & 63, wr = wid >> 2, wc = wid & 3, fr = lane & 15, fq = lane >> 4;
    const int K = g.K, nt = K / BK;
    int ts_lo = 0, ts_hi = 0, nts = 0; const unsigned long long rt_entry = STAMP ? (unsigned long long)wall_clock64() : 0ull;
#define PG8_STAMP() do { if (STAMP && wid == 0 && nts < 64) { const unsigned long long _c = (unsigned long long)clock64(); \
        ts_lo = (lane == nts) ? (int)(unsigned)_c : ts_lo; ts_hi = (lane == nts) ? (int)(unsigned)(_c >> 32) : ts_hi; ++nts; } } while (0)
    PG8_STAMP();
    unsigned voffA[2], voffB[2];
#pragma unroll
    for (int i = 0; i < 2; ++i) { int R, C; stage_rc(tid * 16 + i * 8192, R, C); const int Rb = Epi::PERM ? ((R & ~31) + perm32(R & 31)) : R;
        voffA[i] = (unsigned)(R * K + C) * 2u; voffB[i] = (unsigned)(Rb * K + C) * 2u; }
    const size_t kstep = (size_t)(BK * 2);
    const size_t hstep = (size_t)HALF * K * 2;
    const size_t tstep = 2 * hstep;
    const unsigned ldsw = (unsigned)wid * 1024u;
    const int aoff = lds_byte(wr * 64 + fr, fq * 8), boff = lds_byte(wc * 32 + fr, fq * 8);
#define PG8_SA(b, h) (((b) * 2 + (h)) * HTB)
#define PG8_SB(b, h) ((4 + (b) * 2 + (h)) * HTB)
#define PG8_STAGE(bufoff, gbase, voff) do { _Pragma("unroll") for (int _i = 0; _i < 2; ++_i) \
        __builtin_amdgcn_global_load_lds((const unsigned*)((const char*)(gbase) + (voff)[_i]), (PG8_LAS unsigned*)(lds + (bufoff) + ldsw + _i * 8192), 16, 0, 0); } while (0)
#define PG8_LDA(dst, b, h) do { _Pragma("unroll") for (int m = 0; m < 4; ++m) _Pragma("unroll") for (int k = 0; k < 2; ++k) dst[m][k] = *(const PG8_LAS bf16x8*)(lds + PG8_SA(b, h) + aoff + m * 2048 + k * 1024); } while (0)
#define PG8_LDB(dst, b, h) do { _Pragma("unroll") for (int n = 0; n < 2; ++n) _Pragma("unroll") for (int k = 0; k < 2; ++k) dst[n][k] = *(const PG8_LAS bf16x8*)(lds + PG8_SB(b, h) + boff + n * 2048 + k * 1024); } while (0)
#define PG8_MMA(ai, bj, At, Bt) do { __builtin_amdgcn_s_setprio(1); _Pragma("unroll") for (int m = 0; m < 4; ++m) _Pragma("unroll") for (int n = 0; n < 2; ++n) _Pragma("unroll") for (int k = 0; k < 2; ++k) \
        acc[ai][bj][m][n] = __builtin_amdgcn_mfma_f32_16x16x32_bf16(Bt[n][k], At[m][k], acc[ai][bj][m][n], 0, 0, 0); __builtin_amdgcn_s_setprio(0); } while (0)
#define PG8_WAIT_V(n) asm volatile("s_waitcnt vmcnt(" #n ")" ::: "memory")
#define PG8_WAIT_L(n) asm volatile("s_waitcnt lgkmcnt(" #n ")" ::: "memory")
#define PG8_BAR __builtin_amdgcn_s_barrier()
#define PG8_SCHED __builtin_amdgcn_sched_barrier(0)
    Unit cur, nxt; int ui = 0;
    if (!S.next(0, cur)) return;
    f32x4 acc[2][2][4][2];
#pragma unroll
    for (int a = 0; a < 2; ++a)
#pragma unroll
        for (int b = 0; b < 2; ++b)
#pragma unroll
            for (int m = 0; m < 4; ++m)
#pragma unroll
                for (int n = 0; n < 2; ++n) acc[a][b][m][n] = (f32x4){0.f, 0.f, 0.f, 0.f};
    bf16x8 At[4][2], B0[2][2], B1[2][2];
    const char* cA = (const char*)g.A + (size_t)cur.pm * tstep; const char* cB = (const char*)g.Bt + (size_t)cur.pn * tstep;
    S.a_ready(cur);
    PG8_STAGE(PG8_SB(0, 0), cB, voffB); PG8_STAGE(PG8_SA(0, 0), cA, voffA); PG8_STAGE(PG8_SB(0, 1), cB + hstep, voffB); PG8_STAGE(PG8_SA(0, 1), cA + hstep, voffA);
    if (wr == 1) PG8_BAR;
    PG8_WAIT_V(4); PG8_BAR;
    PG8_STAGE(PG8_SB(1, 0), cB + kstep, voffB); PG8_STAGE(PG8_SA(1, 0), cA + kstep, voffA); PG8_STAGE(PG8_SB(1, 1), cB + hstep + kstep, voffB);
    PG8_WAIT_V(6); PG8_BAR;
    PG8_STAMP();
    for (;;) {
        const bool has_next = S.next(ui + 1, nxt);
        const char* nA = has_next ? (const char*)g.A + (size_t)nxt.pm * tstep : cA; const char* nB = has_next ? (const char*)g.Bt + (size_t)nxt.pn * tstep : cB;
        for (int t = 0; t < nt; t += 2) {
            const bool last = (t == nt - 2);
            const char* a1 = cA + (size_t)(t + 1) * kstep;
            const char* a2 = last ? nA : cA + (size_t)(t + 2) * kstep; const char* b2 = last ? nB : cB + (size_t)(t + 2) * kstep;
            const char* a3 = a2 + kstep; const char* b3 = b2 + kstep;
            if (last && has_next) S.a_ready(nxt);
            PG8_LDB(B0, 0, 0); PG8_SCHED; PG8_LDA(At, 0, 0); PG8_STAGE(PG8_SA(1, 1), a1 + hstep, voffA);
            PG8_WAIT_L(8); PG8_BAR; PG8_WAIT_L(0); PG8_MMA(0, 0, At, B0); PG8_BAR; PG8_SCHED;
            PG8_LDB(B1, 0, 1); PG8_STAGE(PG8_SB(0, 0), b2, voffB);
            PG8_BAR; PG8_WAIT_L(0); PG8_MMA(0, 1, At, B1); PG8_BAR;
            PG8_LDA(At, 0, 1); PG8_STAGE(PG8_SA(0, 0), a2, voffA);
            PG8_BAR; PG8_WAIT_L(0); PG8_MMA(1, 0, At, B0); PG8_BAR; PG8_SCHED;
            PG8_STAGE(PG8_SB(0, 1), b2 + hstep, voffB);
            PG8_WAIT_V(6); PG8_BAR; PG8_MMA(1, 1, At, B1); PG8_BAR;
            PG8_LDB(B0, 1, 0); PG8_SCHED; PG8_LDA(At, 1, 0); PG8_STAGE(PG8_SA(0, 1), a2 + hstep, voffA);
            PG8_WAIT_L(8); PG8_BAR; PG8_WAIT_L(0); PG8_MMA(0, 0, At, B0); PG8_BAR; PG8_SCHED;
            PG8_LDB(B1, 1, 1); PG8_STAGE(PG8_SB(1, 0), b3, voffB);
            PG8_BAR; PG8_WAIT_L(0); PG8_MMA(0, 1, At, B1); PG8_BAR;
            PG8_LDA(At, 1, 1); PG8_STAGE(PG8_SA(1, 0), a3, voffA);
            PG8_BAR; PG8_WAIT_L(0); PG8_MMA(1, 0, At, B0); PG8_BAR; PG8_SCHED;
            PG8_STAGE(PG8_SB(1, 1), b3 + hstep, voffB);
            PG8_WAIT_V(6); PG8_BAR; PG8_MMA(1, 1, At, B1); PG8_BAR;
        }
        PG8_STAMP();
        if constexpr (!Epi::AFTER_DRAIN) { E(acc, cur, wr, wc, fr, fq); S.done(cur); }
        PG8_STAMP();
        if (!has_next) break;
#pragma unroll
        for (int a = 0; a < 2; ++a)
#pragma unroll
            for (int b = 0; b < 2; ++b)
#pragma unroll
                for (int m = 0; m < 4; ++m)
#pragma unroll
                    for (int n = 0; n < 2; ++n) acc[a][b][m][n] = (f32x4){0.f, 0.f, 0.f, 0.f};
        cur = nxt; cA = nA; cB = nB; ++ui;
    }
    PG8_WAIT_V(0);
    if (wr == 0) PG8_BAR;
    PG8_BAR;
    if constexpr (Epi::AFTER_DRAIN) { E.fused(acc, cur, wr, wc, fr, fq, lds, wid, lane); S.done(cur); }
    PG8_STAMP();
    if (STAMP && wid == 0) { stamps[lane] = lane < nts ? (((unsigned long long)(unsigned)ts_hi << 32) | (unsigned)ts_lo) : 0ull;
        if (lane == 62) stamps[62] = rt_entry; if (lane == 63) stamps[63] = (unsigned long long)wall_clock64(); }
#undef PG8_STAMP
#undef PG8_SA
#undef PG8_SB
#undef PG8_STAGE
#undef PG8_LDA
#undef PG8_LDB
#undef PG8_MMA
#undef PG8_WAIT_V
#undef PG8_WAIT_L
#undef PG8_BAR
#undef PG8_SCHED
}
}

DEVI uint4 pack8(const pg8::f32x4 a, const pg8::f32x4 b) { return make_uint4(pack2(a[0], a[1]), pack2(a[2], a[3]), pack2(b[0], b[1]), pack2(b[2], b[3])); }

constexpr int P1_N = IN_WP;
struct EpiInProj {
    static constexpr bool PERM = true, AFTER_DRAIN = false;
    unsigned char* ws;
    __device__ __forceinline__ void operator()(const pg8::f32x4 (&acc)[2][2][4][2], const pg8::Unit& u, int wr, int wc, int fr, int fq) const {
        const int row0 = u.pm * 256 + wr * 64 + fr;
        const int pn = u.pn;
        const int cl0 = wc * 32 + 8 * fq;
        bf16_t* dst; int ld, cbase, kind;
        if (pn < 2)       { dst = reinterpret_cast<bf16_t*>(ws + OFF_HQ);  ld = 512; cbase = pn * 256;        kind = 1; }
        else if (pn < 4)  { dst = reinterpret_cast<bf16_t*>(ws + OFF_HLF); ld = 512; cbase = (pn - 2) * 256;  kind = 2; }
        else if (pn < 6)  { dst = reinterpret_cast<bf16_t*>(ws + OFF_HV);  ld = 512; cbase = (pn - 4) * 256;  kind = 0; }
        else if (pn < 8)  { dst = reinterpret_cast<bf16_t*>(ws + OFF_HG);  ld = 512; cbase = (pn - 6) * 256;  kind = 1; }
        else if (pn == 8) { dst = reinterpret_cast<bf16_t*>(ws + OFF_GQ);  ld = 256; cbase = 0;               kind = 3; }
        else if (pn == 9) { dst = reinterpret_cast<bf16_t*>(ws + OFF_GK);  ld = 256; cbase = 0;               kind = 0; }
        else if (pn < 12) { dst = reinterpret_cast<bf16_t*>(ws + OFF_GV);  ld = 512; cbase = (pn - 10) * 256; kind = 0; }
        else if (pn < 14) { dst = reinterpret_cast<bf16_t*>(ws + OFF_GG);  ld = 512; cbase = (pn - 12) * 256; kind = 1; }
        else {
            if (wc == 0 && fq < 2) {
                float* gl = reinterpret_cast<float*>(ws + OFF_GLOW);
#pragma unroll
                for (int ai = 0; ai < 2; ++ai)
#pragma unroll
                    for (int m = 0; m < 4; ++m) {
                        float* rp = gl + (size_t)(row0 + ai * 128 + m * 16) * 16 + 8 * fq;
                        *reinterpret_cast<pg8::f32x4*>(rp) = acc[ai][0][m][0];
                        *reinterpret_cast<pg8::f32x4*>(rp + 4) = acc[ai][0][m][1];
                    }
            }
            return;
        }
        float lbv[2][8];
#pragma unroll
        for (int bj = 0; bj < 2; ++bj)
#pragma unroll
            for (int j = 0; j < 8; ++j) lbv[bj][j] = 0.f;
        if (kind == 2) {
            const float* lb = reinterpret_cast<const float*>(ws + OFF_LB);
#pragma unroll
            for (int bj = 0; bj < 2; ++bj)
#pragma unroll
                for (int j = 0; j < 8; ++j) lbv[bj][j] = lb[cbase + bj * 128 + cl0 + j];
        }
#pragma unroll
        for (int ai = 0; ai < 2; ++ai)
#pragma unroll
            for (int m = 0; m < 4; ++m) {
                bf16_t* rowp = dst + (size_t)(row0 + ai * 128 + m * 16) * ld + cbase + cl0;
#pragma unroll
                for (int bj = 0; bj < 2; ++bj) {
                    pg8::f32x4 v0 = acc[ai][bj][m][0], v1 = acc[ai][bj][m][1];
                    if (kind == 1) {
#pragma unroll
                        for (int j = 0; j < 4; ++j) { v0[j] = silu_f(v0[j]); v1[j] = silu_f(v1[j]); }
                    } else if (kind == 2) {
#pragma unroll
                        for (int j = 0; j < 4; ++j) {
                            const float l0 = lbv[bj][j], l1 = lbv[bj][4 + j];
                            v0[j] = __logf(l0 + (1.f - l0) * __builtin_amdgcn_rcpf(1.f + __expf(-v0[j])));
                            v1[j] = __logf(l1 + (1.f - l1) * __builtin_amdgcn_rcpf(1.f + __expf(-v1[j])));
                        }
                    } else if (kind == 3) {
#pragma unroll
                        for (int j = 0; j < 4; ++j) { v0[j] *= 0.125f; v1[j] *= 0.125f; }
                    }
                    *reinterpret_cast<uint4*>(rowp + bj * 128) = pack8(v0, v1);
                }
            }
    }
};
struct EpiOutProj {
    static constexpr bool PERM = true, AFTER_DRAIN = false;
    const float* x; bf16_t* h16;
    __device__ __forceinline__ void operator()(const pg8::f32x4 (&acc)[2][2][4][2], const pg8::Unit& u, int wr, int wc, int fr, int fq) const {
        const int row0 = u.pm * 256 + wr * 64 + fr, col0 = u.pn * 256 + wc * 32 + 8 * fq;
#pragma unroll
        for (int ai = 0; ai < 2; ++ai)
#pragma unroll
            for (int m = 0; m < 4; ++m) {
                const size_t ro = (size_t)(row0 + ai * 128 + m * 16) * DM + col0;
#pragma unroll
                for (int bj = 0; bj < 2; ++bj) {
                    const pg8::f32x4 x0 = *reinterpret_cast<const pg8::f32x4*>(x + ro + bj * 128), x1 = *reinterpret_cast<const pg8::f32x4*>(x + ro + bj * 128 + 4);
                    *reinterpret_cast<uint4*>(h16 + ro + bj * 128) = pack8(x0 + acc[ai][bj][m][0], x1 + acc[ai][bj][m][1]);
                }
            }
    }
};
struct EpiQ {
    static constexpr bool PERM = true, AFTER_DRAIN = false;
    bf16_t* Q;
    __device__ __forceinline__ void operator()(const pg8::f32x4 (&acc)[2][2][4][2], const pg8::Unit& u, int wr, int wc, int fr, int fq) const {
        const int row0 = u.pm * 256 + wr * 64 + fr, col0 = u.pn * 256 + wc * 32 + 8 * fq;
#pragma unroll
        for (int ai = 0; ai < 2; ++ai)
#pragma unroll
            for (int m = 0; m < 4; ++m) {
                bf16_t* rowp = Q + (size_t)(row0 + ai * 128 + m * 16) * 2048 + col0;
#pragma unroll
                for (int bj = 0; bj < 2; ++bj) *reinterpret_cast<uint4*>(rowp + bj * 128) = pack8(acc[ai][bj][m][0], acc[ai][bj][m][1]);
            }
    }
};
template <class Epi>
DEVI void run_gemm(const bf16_t* A, const bf16_t* Bt, int N, const Epi& E, char* smem) {
    pg8::Gemm g{A, Bt, M_TOK, N, 1024};
#if PROBE_GEMM_DUP
    struct DupOrder : pg8::StaticOrder { __host__ __device__ bool next(int i, pg8::Unit& u) const { return pg8::StaticOrder::next(i >> 1, u); } };
    DupOrder S; S.init(M_TOK, N, (int)gridDim.x, (int)blockIdx.x);
    pg8::gemm_phase<Epi, DupOrder, false>((PG8_LAS unsigned char*)smem, g, S, E, nullptr);
#else
    pg8::StaticOrder S; S.init(M_TOK, N, (int)gridDim.x, (int)blockIdx.x);
    pg8::gemm_phase<Epi, pg8::StaticOrder, false>((PG8_LAS unsigned char*)smem, g, S, E, nullptr);
#endif
    __builtin_amdgcn_s_waitcnt(0);
}

DEVI float logsigmoid_f(float z) { return fminf(z, 0.f) - __logf(1.f + __expf(-fabsf(z))); }

DEVI unsigned off_b(unsigned row, unsigned ch) { return 256u * row + 16u * (ch ^ (((row & 3u) << 2) | ((row >> 2) & 3u))); }
DEVI unsigned tr_addr16(unsigned lane, unsigned c, unsigned ks, unsigned t) {
    const unsigned g = lane >> 4, q = (lane & 15u) >> 2, pp = lane & 3u;
    return off_b(32u * ks + 8u * g + 4u * t + q, 2u * c + (pp >> 1)) + 8u * (pp & 1u);
}
typedef unsigned short u16x4_t __attribute__((ext_vector_type(4)));
DEVI bf16x8 tr_frag(unsigned base, unsigned lane, unsigned c, unsigned ks) {
    u16x4_t a, b;
    asm volatile("ds_read_b64_tr_b16 %0, %2\n\tds_read_b64_tr_b16 %1, %3\n\ts_waitcnt lgkmcnt(0)" : "=&v"(a), "=&v"(b) : "v"(base + tr_addr16(lane, c, ks, 0)), "v"(base + tr_addr16(lane, c, ks, 1)) : "memory");
    bf16x8 r;
    r[0] = (short)a[0]; r[1] = (short)a[1]; r[2] = (short)a[2]; r[3] = (short)a[3]; r[4] = (short)b[0]; r[5] = (short)b[1]; r[6] = (short)b[2]; r[7] = (short)b[3];
    return r;
}
DEVI bf16x8 row_frag(const char* tile, unsigned lane, unsigned rb, unsigned s) { return *reinterpret_cast<const bf16x8*>(tile + off_b((lane & 15u) + 16u * rb, 4u * s + (lane >> 4))); }
DEVI void fill_tile64(char* tile, const bf16_t* __restrict__ g, int ldg) {
#pragma unroll
    for (int i = 0; i < 4; ++i) {
        const int n = LTID + 256 * i, row = n >> 4, ch = n & 15;
        *reinterpret_cast<uint4*>(tile + off_b(row, ch)) = *reinterpret_cast<const uint4*>(g + (size_t)row * ldg + ch * 8);
    }
}
DEVI void fill_tile64x64(char* tile, const bf16_t* __restrict__ g, int ldg) {
#pragma unroll
    for (int i = 0; i < 2; ++i) {
        const int n = LTID + 256 * i, row = n >> 3, ch = n & 7;
        *reinterpret_cast<uint4*>(tile + off_b(row, ch)) = *reinterpret_cast<const uint4*>(g + (size_t)row * ldg + ch * 8);
    }
}

typedef unsigned gu32x4 __attribute__((ext_vector_type(4)));
typedef float gf32x4 __attribute__((ext_vector_type(4)));
template <int DK, bool KV> struct GPre;
template <bool KV> struct GPre<128, KV> { unsigned a[16], b[KV ? 1 : 16]; gu32x4 v[4]; };
template <bool KV> struct GPre<64, KV>  { unsigned a[8], b[KV ? 1 : 8]; gu32x4 v[4]; gf32x4 gl; float2 wg[16]; float2 bg; };

template <int N>
DEVI void dummy_stores(unsigned char* ws) {
    uint2* d = reinterpret_cast<uint2*>(ws + OFF_DUMMY) + (size_t)threadIdx.x * (2 * N);
#pragma unroll
    for (int i = 0; i < N; ++i) d[2 * i] = make_uint2(0u, 0u);
}

template <int DK, bool KV>
DEVI void gate_prefetch(const Params& p, int sidx, int c, GPre<DK, KV>& r) {
    unsigned char* ws = p.ws;
    int tid = LTID; asm volatile("" : "+v"(tid));
    const int b = sidx >> 2, h = sidx & 3;
    const size_t row0 = (size_t)(b * 128 + c) * 64;
    const bf16_t* A = reinterpret_cast<const bf16_t*>(ws + (DK == 128 ? OFF_HLF : OFF_GK)) + row0 * (4 * DK) + h * DK;
    const bf16_t* Q = reinterpret_cast<const bf16_t*>(ws + (DK == 128 ? OFF_HQ : OFF_GQ)) + row0 * (4 * DK) + h * DK;
    const bf16_t* V = reinterpret_cast<const bf16_t*>(ws + (DK == 128 ? OFF_HV : OFF_GV)) + row0 * 512 + h * 128;
    constexpr int NR = (DK == 128) ? 16 : 8;
    const int cp = (DK == 128) ? (tid & 63) : (tid & 31), rq = (DK == 128) ? (tid >> 6) : (tid >> 5);
#pragma unroll
    for (int i = 0; i < 4; ++i) { const int n = tid + 256 * i; r.v[i] = *reinterpret_cast<const gu32x4*>(V + (size_t)(n >> 4) * 512 + (n & 15) * 8); }
#pragma unroll
    for (int i = 0; i < NR; ++i) {
        r.a[i] = *reinterpret_cast<const unsigned*>(A + (size_t)(NR * rq + i) * (4 * DK) + 2 * cp);
        if (!KV) r.b[i] = *reinterpret_cast<const unsigned*>(Q + (size_t)(NR * rq + i) * (4 * DK) + 2 * cp);
    }
    if constexpr (DK == 64) {
        r.gl = reinterpret_cast<const gf32x4*>(ws + OFF_GLOW)[row0 * 4 + tid];
        const int col = h * 64 + 2 * cp;
#pragma unroll
        for (int j = 0; j < 16; ++j) r.wg[j] = *reinterpret_cast<const float2*>(p.gla_wg + j * 256 + col);
        r.bg = *reinterpret_cast<const float2*>(p.gla_bg + col);
    }
}

template <int DK, bool KV>
DEVI void gate_apply(GPre<DK, KV>& r, char* vtile, char* qtile, char* ktile, float* tot, float4* glt, float* __restrict__ decout) {
    int tid = LTID; asm volatile("" : "+v"(tid));
    constexpr int NR = (DK == 128) ? 16 : 8, NG = 64 / NR;
    const int cp = (DK == 128) ? (tid & 63) : (tid & 31), rq = (DK == 128) ? (tid >> 6) : (tid >> 5);
#pragma unroll
    for (int i = 0; i < 4; ++i) { const int n = tid + 256 * i; *reinterpret_cast<gu32x4*>(vtile + off_b((unsigned)(n >> 4), (unsigned)(n & 15))) = r.v[i]; }
    float l0[NR], l1[NR];
    if constexpr (DK == 128) {
#pragma unroll
        for (int i = 0; i < NR; ++i) { l0[i] = bflo(r.a[i]); l1[i] = bfhi(r.a[i]); }
    } else {
        reinterpret_cast<gf32x4*>(glt)[tid] = r.gl;
        __syncthreads();
#pragma unroll
        for (int i = 0; i < NR; ++i) {
            float z0 = r.bg.x, z1 = r.bg.y;
#pragma unroll
            for (int j = 0; j < 4; ++j) {
                const float4 t = glt[(NR * rq + i) * 4 + j];
                z0 += t.x * r.wg[4 * j].x + t.y * r.wg[4 * j + 1].x + t.z * r.wg[4 * j + 2].x + t.w * r.wg[4 * j + 3].x;
                z1 += t.x * r.wg[4 * j].y + t.y * r.wg[4 * j + 1].y + t.z * r.wg[4 * j + 2].y + t.w * r.wg[4 * j + 3].y;
            }
            l0[i] = logsigmoid_f(z0) * (1.f / 16.f); l1[i] = logsigmoid_f(z1) * (1.f / 16.f);
        }
    }
    float s0 = 0.f, s1 = 0.f;
#pragma unroll
    for (int i = 0; i < NR; ++i) { s0 += l0[i]; s1 += l1[i]; }
    *reinterpret_cast<float2*>(tot + rq * DK + 2 * cp) = make_float2(s0, s1);
    __syncthreads();
    float G0 = 0.f, G1 = 0.f, T0 = 0.f, T1 = 0.f;
#pragma unroll
    for (int k = 0; k < NG; ++k) {
        const float2 t = *reinterpret_cast<const float2*>(tot + k * DK + 2 * cp);
        T0 += t.x; T1 += t.y;
        if (k < rq) { G0 += t.x; G1 += t.y; }
    }
    if (KV && rq == 0) *reinterpret_cast<float2*>(decout + 2 * cp) = make_float2(__expf(T0), __expf(T1));
#pragma unroll
    for (int i = 0; i < NR; ++i) {
        G0 += l0[i]; G1 += l1[i];
        float k0, k1;
        if constexpr (DK == 128) { k0 = 1.f - __expf(l0[i]); k1 = 1.f - __expf(l1[i]); } else { k0 = bflo(r.a[i]); k1 = bfhi(r.a[i]); }
        const unsigned o = off_b((unsigned)(NR * rq + i), (unsigned)(cp >> 2)) + 4u * (unsigned)(cp & 3);
        if constexpr (KV) {
            *reinterpret_cast<unsigned*>(ktile + o) = pack2(k0 * __expf(T0 - G0), k1 * __expf(T1 - G1));
        } else {
            *reinterpret_cast<unsigned*>(qtile + o) = pack2(bflo(r.b[i]) * __expf(G0), bfhi(r.b[i]) * __expf(G1));
            *reinterpret_cast<unsigned*>(ktile + o) = pack2(k0 * __expf(-G0), k1 * __expf(-G1));
        }
    }
}

constexpr int P3_UNITS = 4096;
template <int DK>
DEVI void kv_unit(const Params& p, int sidx, int c, int nsidx, int nc, char* smem, GPre<DK, true>& pre) {
    unsigned char* ws = p.ws;
    const int lane = LTID & 63, w = LTID >> 6;
    const int b = sidx >> 2, h = sidx & 3;
    const int cidx = b * 128 + c;
    constexpr int NDB = DK / 16;
    float* DEC = reinterpret_cast<float*>(ws + (DK == 128 ? OFF_DECH : OFF_DECG)) + (size_t)cidx * (4 * DK) + h * DK;
    bf16_t* ST = reinterpret_cast<bf16_t*>(reinterpret_cast<unsigned char*>(p.out) + (DK == 128 ? OUT_STH : OUT_STG)) + ((size_t)sidx * 128 + c) * (128 * DK);
    f32x4 acc[NDB][2];
#pragma unroll
    for (int i = 0; i < NDB; ++i) { acc[i][0] = f32x4{0, 0, 0, 0}; acc[i][1] = f32x4{0, 0, 0, 0}; }
    const int fo = (lane & 15) * 64 + 8 * (lane >> 4);
    gate_apply<DK, true>(pre, smem, nullptr, smem + 16384, reinterpret_cast<float*>(smem + 32768), reinterpret_cast<float4*>(smem + 36864), DEC);
    gate_prefetch<DK, true>(p, nsidx, nc, pre);
    __syncthreads();
    const unsigned tbase = (unsigned)(size_t)smem, kbase = tbase + 16384u;
#pragma unroll
    for (int ks = 0; ks < 2; ++ks) {
        bf16x8 bv[2];
#pragma unroll
        for (int nb = 0; nb < 2; ++nb) bv[nb] = tr_frag(tbase, (unsigned)lane, (unsigned)(2 * w + nb), (unsigned)ks);
#pragma unroll
        for (int db = 0; db < NDB; ++db) {
            const bf16x8 ak = tr_frag(kbase, (unsigned)lane, (unsigned)db, (unsigned)ks);
            acc[db][0] = mfma16(ak, bv[0], acc[db][0]);
            acc[db][1] = mfma16(ak, bv[1], acc[db][1]);
        }
    }
#pragma unroll
    for (int db = 0; db < NDB; ++db) {
        const int d = db * 16 + 4 * (lane >> 4);
#pragma unroll
        for (int nb = 0; nb < 2; ++nb) {
            const int dv = 32 * w + nb * 16 + (lane & 15);
            uint2 o; o.x = pack2(acc[db][nb][0], acc[db][nb][1]); o.y = pack2(acc[db][nb][2], acc[db][nb][3]);
            *reinterpret_cast<uint2*>(ST + (size_t)dv * DK + d) = o;
        }
    }
    __syncthreads();
}
template <int DK>
DEVI void phase3_loop(const Params& p, int hb, char* hsm) {
    GPre<DK, true> pre;
    const int stride = (int)gridDim.x * 2;
    int v = (int)blockIdx.x * 2 + hb;
    if (v < 2048) { gate_prefetch<DK, true>(p, v >> 7, v & 127, pre); dummy_stores<DK / 8>(p.ws); }
    for (; v < 2048; v += stride) {
        const int nv = (v + stride < 2048) ? v + stride : v;
        kv_unit<DK>(p, v >> 7, v & 127, nv >> 7, nv & 127, hsm, pre);
    }
}

constexpr int P4_UNITS = 384;
template <bool DRY>
DEVI void phase4_unit_t(const Params& p, int u, char* smem) {
    unsigned char* ws = p.ws;
    int e = u * 256 + LTID;
    bf16_t* base; bf16_t* sbase; const float* dec; size_t cstride; int decstride;
    if (e < 65536) {
        const int sidx = e >> 12, rem = e & 4095, dv = rem >> 5, d4 = (rem & 31) * 4;
        const int b = sidx >> 2, h = sidx & 3;
        base = reinterpret_cast<bf16_t*>(reinterpret_cast<unsigned char*>(p.out) + OUT_STH) + ((size_t)sidx * 128) * 16384 + dv * 128 + d4;
        sbase = DRY ? reinterpret_cast<bf16_t*>(ws + OFF_XN) + ((size_t)sidx * 128) * 16384 + dv * 128 + d4 : base;
        cstride = 16384;
        dec = reinterpret_cast<const float*>(ws + OFF_DECH) + (size_t)(b * 128) * 512 + h * 128 + d4; decstride = 512;
    } else {
        e -= 65536;
        const int sidx = e >> 11, rem = e & 2047, dv = rem >> 4, d4 = (rem & 15) * 4;
        const int b = sidx >> 2, h = sidx & 3;
        base = reinterpret_cast<bf16_t*>(reinterpret_cast<unsigned char*>(p.out) + OUT_STG) + ((size_t)sidx * 128) * 8192 + dv * 64 + d4;
        sbase = DRY ? reinterpret_cast<bf16_t*>(ws + OFF_KTH) + ((size_t)sidx * 128) * 8192 + dv * 64 + d4 : base;
        cstride = 8192;
        dec = reinterpret_cast<const float*>(ws + OFF_DECG) + (size_t)(b * 128) * 256 + h * 64 + d4; decstride = 256;
    }
    float s0 = 0.f, s1 = 0.f, s2 = 0.f, s3 = 0.f;
    for (int c8 = 0; c8 < 128; c8 += 8) {
        uint2 kv[8]; float4 dc[8];
#pragma unroll
        for (int i = 0; i < 8; ++i) { kv[i] = *reinterpret_cast<const uint2*>(base + (size_t)(c8 + i) * cstride); dc[i] = *reinterpret_cast<const float4*>(dec + (size_t)(c8 + i) * decstride); }
#pragma unroll
        for (int i = 0; i < 8; ++i) {
            uint2 o; o.x = pack2(s0, s1); o.y = pack2(s2, s3);
            *reinterpret_cast<uint2*>(sbase + (size_t)(c8 + i) * cstride) = o;
            s0 = dc[i].x * s0 + bflo(kv[i].x); s1 = dc[i].y * s1 + bfhi(kv[i].x);
            s2 = dc[i].z * s2 + bflo(kv[i].y); s3 = dc[i].w * s3 + bfhi(kv[i].y);
        }
    }
}

DEVI void phase4_unit(const Params& p, int u, char* smem) { phase4_unit_t<false>(p, u, smem); }
DEVI void phase4_dry_unit(const Params& p, int u, char* smem) { phase4_unit_t<true>(p, u, smem); }

constexpr int P5_UNITS = 4096;
constexpr int PL_PITCH = 72;
typedef unsigned gu32x2 __attribute__((ext_vector_type(2)));
template <int DK> struct OutRegs { GPre<DK, false> pre; bf16x8 ast[DK / 32][2]; gu32x2 gtv[4][2]; };
template <int DK>
DEVI void out_load_ast(const Params& p, int sidx, int c, OutRegs<DK>& R) {
    int tid = LTID; asm volatile("" : "+v"(tid));
    const int lane = tid & 63, w = tid >> 6, l15 = lane & 15, lg = lane >> 4;
    const bf16_t* ST = reinterpret_cast<const bf16_t*>(reinterpret_cast<const unsigned char*>(p.out) + (DK == 128 ? OUT_STH : OUT_STG)) + ((size_t)sidx * 128 + c) * (128 * DK);
#pragma unroll
    for (int ks = 0; ks < DK / 32; ++ks) {
#pragma unroll
        for (int x = 0; x < 2; ++x) R.ast[ks][x] = ldg_frag(ST + (size_t)((2 * w + x) * 16 + l15) * DK + ks * 32 + 8 * lg);
    }
}
template <int DK>
DEVI void out_load_gates(const Params& p, int sidx, int c, OutRegs<DK>& R) {
    int tid = LTID; asm volatile("" : "+v"(tid));
    const int lane = tid & 63, w = tid >> 6, l15 = lane & 15, lg = lane >> 4;
    const size_t row0 = (size_t)((sidx >> 2) * 128 + c) * 64;
    const bf16_t* GATE = reinterpret_cast<const bf16_t*>(p.ws + (DK == 128 ? OFF_HG : OFF_GG)) + row0 * 512 + (sidx & 3) * 128;
#pragma unroll
    for (int x = 0; x < 2; ++x) {
#pragma unroll
        for (int y = 0; y < 4; ++y) R.gtv[y][x] = *reinterpret_cast<const gu32x2*>(GATE + (size_t)(y * 16 + l15) * 512 + (2 * w + x) * 16 + 4 * lg);
    }
}
template <int DK>
DEVI void out_unit(const Params& p, int sidx, int c, int nsidx, int nc, char* smem, OutRegs<DK>& R, const float4 (&g4v)[2]) {
    unsigned char* ws = p.ws;
    const int lane = LTID & 63, w = LTID >> 6;
    const int b = sidx >> 2, h = sidx & 3;
    const int cidx = b * 128 + c;
    const size_t row0 = (size_t)cidx * 64;
    constexpr int LDQ = 4 * DK;
    bf16_t* MIX = reinterpret_cast<bf16_t*>(ws + OFF_MIX) + row0 * 1024 + (DK == 128 ? 0 : 512) + h * 128;
    bf16_t* PL = reinterpret_cast<bf16_t*>(smem);
    float* RED = reinterpret_cast<float*>(smem + 64 * PL_PITCH * 2);

    const int l15 = lane & 15, lg = lane >> 4;
    char* vtile = smem + 16384;
    char* qtile = smem + 32768;
    char* ktile = smem + 49152;
    gate_apply<DK, false>(R.pre, vtile, qtile, ktile, reinterpret_cast<float*>(smem + 10240), reinterpret_cast<float4*>(smem + 12288), nullptr);
    gate_prefetch<DK, false>(p, nsidx, nc, R.pre);
    __syncthreads();
    {
        bf16x8 bq[DK / 32];
#pragma unroll
        for (int ks = 0; ks < DK / 32; ++ks) bq[ks] = row_frag(qtile, (unsigned)lane, (unsigned)w, (unsigned)ks);
#pragma unroll
        for (int jb = 0; jb < 4; ++jb) {
            f32x4 a = f32x4{0, 0, 0, 0};
            if (jb <= w) {
#pragma unroll
                for (int ks = 0; ks < DK / 32; ++ks) {
                    const bf16x8 ak = row_frag(ktile, (unsigned)lane, (unsigned)jb, (unsigned)ks);
                    a = mfma16(ak, bq[ks], a);
                }
            }
            const int i = w * 16 + l15, j0 = jb * 16 + 4 * lg;
            const float v0 = (j0 + 0 <= i) ? a[0] : 0.f, v1 = (j0 + 1 <= i) ? a[1] : 0.f, v2 = (j0 + 2 <= i) ? a[2] : 0.f, v3 = (j0 + 3 <= i) ? a[3] : 0.f;
            uint2 o; o.x = pack2(v0, v1); o.y = pack2(v2, v3);
            *reinterpret_cast<uint2*>(PL + i * PL_PITCH + j0) = o;
        }
    }
    __syncthreads();
    f32x4 acc[2][4];
#pragma unroll
    for (int x = 0; x < 2; ++x)
#pragma unroll
        for (int y = 0; y < 4; ++y) acc[x][y] = f32x4{0, 0, 0, 0};
#pragma unroll
    for (int ks = 0; ks < 2; ++ks) {
        bf16x8 bp[4], avx[2];
#pragma unroll
        for (int x = 0; x < 2; ++x) avx[x] = tr_frag((unsigned)(size_t)vtile, (unsigned)lane, (unsigned)(2 * w + x), (unsigned)ks);
#pragma unroll
        for (int y = 0; y < 4; ++y) bp[y] = *reinterpret_cast<const bf16x8*>(PL + (y * 16 + l15) * PL_PITCH + ks * 32 + 8 * lg);
#pragma unroll
        for (int x = 0; x < 2; ++x)
#pragma unroll
            for (int y = 0; y < 4; ++y) acc[x][y] = mfma16(avx[x], bp[y], acc[x][y]);
    }
#pragma unroll
    for (int ks = 0; ks < DK / 32; ++ks) {
#pragma unroll
        for (int x = 0; x < 2; ++x)
#pragma unroll
            for (int y = 0; y < 4; ++y) acc[x][y] = mfma16(R.ast[ks][x], row_frag(qtile, (unsigned)lane, (unsigned)y, (unsigned)ks), acc[x][y]);
    }
    out_load_ast<DK>(p, nsidx, nc, R);
    float ssq[4];
#pragma unroll
    for (int y = 0; y < 4; ++y) {
        float s = 0.f;
#pragma unroll
        for (int x = 0; x < 2; ++x)
#pragma unroll
            for (int r = 0; r < 4; ++r) s += acc[x][y][r] * acc[x][y][r];
        s += __shfl_xor(s, 16); s += __shfl_xor(s, 32);
        ssq[y] = s;
    }
    if (lg == 0) {
#pragma unroll
        for (int y = 0; y < 4; ++y) RED[w * 64 + y * 16 + l15] = ssq[y];
    }
    __syncthreads();
#pragma unroll
    for (int y = 0; y < 4; ++y) {
        const int i = y * 16 + l15;
        const float tot = RED[i] + RED[64 + i] + RED[128 + i] + RED[192 + i];
        const float rstd = rsqrtf(tot * (1.f / 128.f) + 1e-6f);
#pragma unroll
        for (int x = 0; x < 2; ++x) {
            const int dv = (2 * w + x) * 16 + 4 * lg;
            const float4 g4 = g4v[x];
            const gu32x2 gt = R.gtv[y][x];
            uint2 o;
            o.x = pack2(acc[x][y][0] * rstd * g4.x * bflo(gt.x), acc[x][y][1] * rstd * g4.y * bfhi(gt.x));
            o.y = pack2(acc[x][y][2] * rstd * g4.z * bflo(gt.y), acc[x][y][3] * rstd * g4.w * bfhi(gt.y));
            *reinterpret_cast<uint2*>(MIX + (size_t)i * 1024 + dv) = o;
        }
    }
    out_load_gates<DK>(p, nsidx, nc, R);
    __syncthreads();
}
template <int DK>
DEVI void phase5_loop(const Params& p, int hb, char* hsm) {
    OutRegs<DK> R;
    const int stride = (int)gridDim.x * 2;
    int v = (int)blockIdx.x * 2 + hb;
    const int lane = LTID & 63, w = LTID >> 6;
    const float* ng = (DK == 128) ? p.hg_norm_g : p.gla_norm_g;
    const float4 g4v[2] = {*reinterpret_cast<const float4*>(ng + (2 * w) * 16 + 4 * (lane >> 4)), *reinterpret_cast<const float4*>(ng + (2 * w + 1) * 16 + 4 * (lane >> 4))};
    if (v < 2048) {
        gate_prefetch<DK, false>(p, v >> 7, v & 127, R.pre); out_load_ast<DK>(p, v >> 7, v & 127, R); dummy_stores<8>(p.ws); out_load_gates<DK>(p, v >> 7, v & 127, R);
    }
    for (; v < 2048; v += stride) {
        const int nv = (v + stride < 2048) ? v + stride : v;
        out_unit<DK>(p, v >> 7, v & 127, nv >> 7, nv & 127, hsm, R, g4v);
    }
}

DEVI void rms_row16_bf16_i8(const bf16_t* __restrict__ xr, const float* __restrict__ g, bf16_t* __restrict__ dst, unsigned char* __restrict__ dst8, float* __restrict__ descale, int lane) {
    float v[2][8]; float ss = 0.f;
#pragma unroll
    for (int i = 0; i < 2; ++i) {
        const uint4 q = reinterpret_cast<const uint4*>(xr)[lane + 64 * i];
        v[i][0] = bflo(q.x); v[i][1] = bfhi(q.x); v[i][2] = bflo(q.y); v[i][3] = bfhi(q.y); v[i][4] = bflo(q.z); v[i][5] = bfhi(q.z); v[i][6] = bflo(q.w); v[i][7] = bfhi(q.w);
#pragma unroll
        for (int j = 0; j < 8; ++j) ss += v[i][j] * v[i][j];
    }
    ss = wave_sum(ss);
    const float r = rsqrtf(ss * (1.f / 1024.f) + 1e-6f);
    float am = 0.f;
#pragma unroll
    for (int i = 0; i < 2; ++i) {
        const float4 g0 = reinterpret_cast<const float4*>(g)[2 * (lane + 64 * i)], g1 = reinterpret_cast<const float4*>(g)[2 * (lane + 64 * i) + 1];
        v[i][0] *= r * g0.x; v[i][1] *= r * g0.y; v[i][2] *= r * g0.z; v[i][3] *= r * g0.w; v[i][4] *= r * g1.x; v[i][5] *= r * g1.y; v[i][6] *= r * g1.z; v[i][7] *= r * g1.w;
        reinterpret_cast<uint4*>(dst)[lane + 64 * i] = make_uint4(pack2(v[i][0], v[i][1]), pack2(v[i][2], v[i][3]), pack2(v[i][4], v[i][5]), pack2(v[i][6], v[i][7]));
#pragma unroll
        for (int j = 0; j < 8; ++j) am = fmaxf(am, fabsf(v[i][j]));
    }
    am = wave_max(am);
    const float sc = am > 0.f ? 127.f / am : 1.f;
#pragma unroll
    for (int i = 0; i < 2; ++i)
        reinterpret_cast<int2*>(dst8)[lane + 64 * i] = make_int2(pack_i8x4(v[i][0] * sc, v[i][1] * sc, v[i][2] * sc, v[i][3] * sc), pack_i8x4(v[i][4] * sc, v[i][5] * sc, v[i][6] * sc, v[i][7] * sc));
    if (lane == 0) *descale = am > 0.f ? am * (1.f / 127.f) : 1.f;
}
constexpr int P7_UNITS = 8192;
DEVI void phase7_unit(const Params& p, int u, char* smem) {
    const int lane = LTID & 63, w = LTID >> 6;
    const int row = u * 4 + w;
    rms_row16_bf16_i8(reinterpret_cast<const bf16_t*>(p.ws + OFF_H16) + (size_t)row * DM, p.norm2_g, reinterpret_cast<bf16_t*>(p.ws + OFF_HN) + (size_t)row * DM,
                      p.ws + OFF_HN8 + (size_t)row * DM, reinterpret_cast<float*>(p.ws + OFF_HS) + row, lane);
}

using f32x16 = __attribute__((ext_vector_type(16))) float;
DEVI f32x16 mfma32(bf16x8 a, bf16x8 b, f32x16 c) { return __builtin_amdgcn_mfma_f32_32x32x16_bf16(a, b, c, 0, 0, 0); }
DEVI unsigned umax(unsigned a, unsigned b) { return a > b ? a : b; }
DEVI unsigned umin(unsigned a, unsigned b) { return a > b ? b : a; }
DEVI unsigned f2ord(float f) { const unsigned u = __float_as_uint(f); return u ^ ((unsigned)((int)u >> 31) | 0x80000000u); }
DEVI float ord2f(unsigned k) { return __uint_as_float((k & 0x80000000u) ? (k ^ 0x80000000u) : ~k); }

template <int BASE>
DEVI void sort16_desc(unsigned (&x)[64]) {
#pragma unroll
    for (int k = 2; k <= 16; k <<= 1) {
#pragma unroll
        for (int j = k >> 1; j > 0; j >>= 1) {
#pragma unroll
            for (int i = 0; i < 16; ++i) {
                const int l = i ^ j;
                if (l > i) {
                    const bool desc = ((i & k) == 0);
                    const unsigned a = x[BASE + i], b = x[BASE + l];
                    const unsigned hi = umax(a, b), lo = umin(a, b);
                    x[BASE + i] = desc ? hi : lo; x[BASE + l] = desc ? lo : hi;
                }
            }
        }
    }
}
template <int BASE>
DEVI void bmerge16_desc(unsigned (&x)[64]) {
#pragma unroll
    for (int j = 8; j > 0; j >>= 1) {
#pragma unroll
        for (int i = 0; i < 16; ++i) {
            const int l = i ^ j;
            if (l > i) { const unsigned a = x[BASE + i], b = x[BASE + l]; x[BASE + i] = umax(a, b); x[BASE + l] = umin(a, b); }
        }
    }
}
DEVI void top16_of_64(unsigned (&x)[64]) {
    sort16_desc<0>(x); sort16_desc<16>(x); sort16_desc<32>(x); sort16_desc<48>(x);
#pragma unroll
    for (int i = 0; i < 16; ++i) x[i] = umax(x[i], x[31 - i]);
    bmerge16_desc<0>(x);
#pragma unroll
    for (int i = 0; i < 16; ++i) x[32 + i] = umax(x[32 + i], x[63 - i]);
    bmerge16_desc<32>(x);
#pragma unroll
    for (int i = 0; i < 16; ++i) x[i] = umax(x[i], x[47 - i]);
    bmerge16_desc<0>(x);
}

DEVI void scores_top16(const char* sktile, const bf16_t* __restrict__ Qp, int lane, unsigned (&out)[16]) {
    const int r31 = lane & 31, hh = lane >> 5;
    f32x16 acc[4];
#pragma unroll
    for (int nb = 0; nb < 4; ++nb)
#pragma unroll
        for (int r = 0; r < 16; ++r) acc[nb][r] = 0.f;
#pragma unroll
    for (int ks = 0; ks < 8; ++ks) {
        const bf16x8 bq = ldg_frag(Qp + (size_t)r31 * 2048 + ks * 16 + 8 * hh);
#pragma unroll
        for (int nb = 0; nb < 4; ++nb) {
            const bf16x8 ak = *reinterpret_cast<const bf16x8*>(sktile + off_b((unsigned)(nb * 32 + r31), (unsigned)(2 * ks + hh)));
            acc[nb] = mfma32(ak, bq, acc[nb]);
        }
    }
    unsigned x[64];
    const unsigned hx = (unsigned)hh * 4u;
#pragma unroll
    for (int nb = 0; nb < 4; ++nb)
#pragma unroll
        for (int r = 0; r < 16; ++r) {
            const int nbase = nb * 32 + (r & 3) + 8 * (r >> 2);
            x[nb * 16 + r] = ((f2ord(acc[nb][r]) & ~127u) | (unsigned)(127 - nbase)) ^ hx;
        }
    top16_of_64(x);
    unsigned lo[16], hi[16];
#pragma unroll
    for (int i = 0; i < 16; ++i) { auto rr = __builtin_amdgcn_permlane32_swap(x[i], x[i], false, false); lo[i] = rr[0]; hi[i] = rr[1]; }
#pragma unroll
    for (int i = 0; i < 16; ++i) x[i] = umax(lo[i], hi[15 - i]);
    bmerge16_desc<0>(x);
#pragma unroll
    for (int i = 0; i < 16; ++i) out[i] = x[i];
}

DEVI void phase9_block(const Params& p, char* smem) {
    unsigned char* ws = p.ws;
    const int tid = threadIdx.x, lane = tid & 63, w = tid >> 6;
    const int h = blockIdx.x & 7, rank = blockIdx.x >> 3, nrank = ((int)gridDim.x - h + 7) >> 3;
    const int hh = lane >> 5;
    {
        const bf16_t* SK = reinterpret_cast<const bf16_t*>(ws + OFF_SK) + (size_t)(h * 2) * 128 * 128;
#pragma unroll
        for (int i = 0; i < 8; ++i) {
            const int nn = tid + 512 * i, tl = nn >> 11, row = (nn >> 4) & 127, ch = nn & 15;
            *reinterpret_cast<uint4*>(smem + tl * 32768 + off_b((unsigned)row, (unsigned)ch)) = *reinterpret_cast<const uint4*>(SK + (size_t)tl * 16384 + row * 128 + ch * 8);
        }
    }
    __syncthreads();
    unsigned* KL = reinterpret_cast<unsigned*>(smem + 65536) + w * 2048;
    for (int it = rank; it < M_TOK / 256; it += nrank) {
    const int t0 = it * 256 + w * 32;
    const bf16_t* Q = reinterpret_cast<const bf16_t*>(ws + OFF_Q) + (size_t)t0 * 2048 + h * 256;
    unsigned k0[16], k1[16];
    scores_top16(smem, Q, lane, k0);
    scores_top16(smem + 32768, Q + 128, lane, k1);
#pragma unroll
    for (int i = 0; i < 16; ++i) { KL[i * 64 + lane] = k0[i]; KL[(16 + i) * 64 + lane] = k1[i]; }
    float s0[16], s1[16];
#pragma unroll
    for (int i = 0; i < 16; ++i) { s0[i] = ord2f(k0[i] & ~127u); s1[i] = ord2f(k1[i] & ~127u); }
    unsigned x[64];
    {
        int n = 0;
#pragma unroll
        for (int a = 0; a < 16; ++a)
#pragma unroll
            for (int b = 0; b < 16; ++b)
                if ((a + 1) * (b + 1) <= 16) { x[n] = (f2ord(s0[a] + s1[b]) & ~255u) | (unsigned)(255 - (a * 16 + b)); ++n; }
#pragma unroll
        for (int i = 50; i < 64; ++i) x[i] = 0u;
    }
    top16_of_64(x);
    float cv[16]; int ex[16];
#pragma unroll
    for (int i = 0; i < 16; ++i) {
        cv[i] = ord2f(x[i] & ~255u);
        const int cid = 255 - (int)(x[i] & 255u);
        const unsigned ka = KL[(cid >> 4) * 64 + lane], kb = KL[(16 + (cid & 15)) * 64 + lane];
        ex[i] = (127 - (int)(ka & 127u)) * 128 + (127 - (int)(kb & 127u));
    }
    float sum = 0.f;
    const float mx = cv[0];
#pragma unroll
    for (int i = 0; i < 16; ++i) cv[i] = __expf(cv[i] - mx);
#pragma unroll
    for (int i = 0; i < 16; ++i) sum += cv[i];
    const float inv = __builtin_amdgcn_rcpf(sum);
    const size_t orow = (size_t)(t0 + (lane & 31)) * 128 + h * 16;
    if (hh == 0) {
        int4* d = reinterpret_cast<int4*>(reinterpret_cast<int*>(ws + OFF_EIDX) + orow);
#pragma unroll
        for (int i = 0; i < 4; ++i) d[i] = make_int4(ex[4 * i], ex[4 * i + 1], ex[4 * i + 2], ex[4 * i + 3]);
        const float* US = reinterpret_cast<const float*>(ws + OFF_US);
        float4* du = reinterpret_cast<float4*>(reinterpret_cast<float*>(ws + OFF_EU) + orow);
#pragma unroll
        for (int i = 0; i < 4; ++i) du[i] = make_float4(US[ex[4 * i]], US[ex[4 * i + 1]], US[ex[4 * i + 2]], US[ex[4 * i + 3]]);
    } else {
        const float* VS = reinterpret_cast<const float*>(ws + OFF_VS);
        float4* d = reinterpret_cast<float4*>(reinterpret_cast<float*>(ws + OFF_EW) + orow);
#pragma unroll
        for (int i = 0; i < 4; ++i) d[i] = make_float4(cv[4 * i] * inv * VS[ex[4 * i]], cv[4 * i + 1] * inv * VS[ex[4 * i + 1]], cv[4 * i + 2] * inv * VS[ex[4 * i + 2]], cv[4 * i + 3] * inv * VS[ex[4 * i + 3]]);
        }
}
}

typedef _Float16 h2_t __attribute__((ext_vector_type(2)));
DEVI float sum8(float v) { v += dpp_f<0xB1>(v); v += dpp_f<0x4E>(v); v += dpp_f<0x141>(v); return v; }
DEVI float sum64(float v) {
    v = sum8(v); v += dpp_f<0x128>(v);
    { auto s = __builtin_amdgcn_permlane16_swap(__float_as_uint(v), __float_as_uint(v), false, false); v = __uint_as_float(s[0]) + __uint_as_float(s[1]); }
    { auto s = __builtin_amdgcn_permlane32_swap(__float_as_uint(v), __float_as_uint(v), false, false); v = __uint_as_float(s[0]) + __uint_as_float(s[1]); }
    return v;
}
DEVI long pack_i64(unsigned lo, unsigned hi) { return (long)(((unsigned long long)hi << 32) | (unsigned long long)lo); }

#define SB __builtin_amdgcn_sched_barrier(0)
#define SB __builtin_amdgcn_sched_barrier(0)
#define PIN4(Q) "+v"(Q.x), "+v"(Q.y), "+v"(Q.z), "+v"(Q.w)
DEVI void phase10a_block(const Params& p, char* smem) {
    unsigned char* ws = p.ws;
    const int s = blockIdx.x & 7, rank = blockIdx.x >> 3, nrank = ((int)gridDim.x - s + 7) >> 3;
    const int lane = threadIdx.x & 63, wave = threadIdx.x >> 6;
    const int lg = lane & 7, grp = lane >> 3;
    const unsigned char* U8 = ws + OFF_U8 + (size_t)s * (16384 * 128);
    const unsigned char* HNs = ws + OFF_HN8 + 128 * s + 16 * lg;
    unsigned* PD = reinterpret_cast<unsigned*>(ws + OFF_PD) + (size_t)s * M_TOK * 64;
    float* stg = reinterpret_cast<float*>(smem) + wave * (16 * 128);
    constexpr int NTG = M_TOK / 8;
#define P10A_LOAD_EV(TG, E) do { const int4* _q = reinterpret_cast<const int4*>(reinterpret_cast<const int*>(ws + OFF_EIDX) + (size_t)((TG) * 8 + wave) * 128 + 16 * grp); \
        E[0] = _q[0]; E[1] = _q[1]; E[2] = _q[2]; E[3] = _q[3]; } while (0)
#define P10A_LOAD_ROWS(TG, E, R, HA) do { \
        asm volatile("" : PIN4(E[0]), PIN4(E[1]), PIN4(E[2]), PIN4(E[3])); \
        const int _e[16] = {E[0].x, E[0].y, E[0].z, E[0].w, E[1].x, E[1].y, E[1].z, E[1].w, E[2].x, E[2].y, E[2].z, E[2].w, E[3].x, E[3].y, E[3].z, E[3].w}; \
        _Pragma("unroll") for (int _i = 0; _i < 16; ++_i) R[_i] = *reinterpret_cast<const uint4*>(U8 + ((unsigned)_e[_i] * 128u + 16u * (unsigned)lg)); \
        HA = *reinterpret_cast<const uint4*>(HNs + (size_t)((TG) * 8 + wave) * DM); } while (0)
#define P10A_COMPUTE(SLOT, R, HA) do { \
        asm volatile("" : PIN4(R[0]), PIN4(R[1]), PIN4(R[2]), PIN4(R[3]), PIN4(R[4]), PIN4(R[5])); \
        asm volatile("" : PIN4(R[6]), PIN4(R[7]), PIN4(R[8]), PIN4(R[9]), PIN4(R[10]), PIN4(R[11])); \
        asm volatile("" : PIN4(R[12]), PIN4(R[13]), PIN4(R[14]), PIN4(R[15]), PIN4(HA)); \
        int _v1 = 0, _v2 = 0; \
        _Pragma("unroll") for (int _i = 0; _i < 16; ++_i) { \
            int _a = __builtin_amdgcn_sdot4((int)R[_i].x, (int)HA.x, 0, false); \
            _a = __builtin_amdgcn_sdot4((int)R[_i].y, (int)HA.y, _a, false); \
            _a = __builtin_amdgcn_sdot4((int)R[_i].z, (int)HA.z, _a, false); \
            _a = __builtin_amdgcn_sdot4((int)R[_i].w, (int)HA.w, _a, false); \
            _a += __builtin_amdgcn_mov_dpp(_a, 0xB1, 0xf, 0xf, true); _a += __builtin_amdgcn_mov_dpp(_a, 0x4E, 0xf, 0xf, true); _a += __builtin_amdgcn_mov_dpp(_a, 0x141, 0xf, 0xf, true); \
            if (_i < 8) _v1 = (lg == _i) ? _a : _v1; else _v2 = (lg == _i - 8) ? _a : _v2; } \
        stg[(SLOT) * 128 + 16 * grp + lg] = (float)_v1; stg[(SLOT) * 128 + 16 * grp + 8 + lg] = (float)_v2; } while (0)
    int4 eA[4], eB[4], eC[4]; uint4 rA[16], rB[16]; uint4 hA0, hB0;
    if (rank >= NTG) return;
    const int ntok = (NTG - rank + nrank - 1) / nrank;
#define TGI(I) (rank + ((I) < ntok ? (I) : ntok - 1) * nrank)
    P10A_LOAD_EV(TGI(0), eA);
    SB; P10A_LOAD_EV(TGI(1), eB);
    SB; P10A_LOAD_ROWS(TGI(0), eA, rA, hA0);
    SB;
    for (int base = 0; base < ntok; base += 16) {
#pragma unroll 1
        for (int i = base; i < base + 16; i += 2) {
            SB; P10A_LOAD_EV(TGI(i + 2), eC);
            SB; P10A_LOAD_ROWS(TGI(i + 1), eB, rB, hB0);
            SB; P10A_COMPUTE(i - base, rA, hA0);
            SB; P10A_LOAD_EV(TGI(i + 3), eB);
            SB; P10A_LOAD_ROWS(TGI(i + 2), eC, rA, hA0);
            SB; P10A_COMPUTE(i + 1 - base, rB, hB0);
            SB;
        }
#pragma unroll 4
        for (int j = 0; j < 16; ++j) {
            const float2 v = *reinterpret_cast<const float2*>(stg + j * 128 + 2 * lane);
            PD[(size_t)(TGI(base + j) * 8 + wave) * 64 + lane] = pack2(v.x, v.y);
        }
        __builtin_amdgcn_s_waitcnt(0x0F70);
    }
#undef TGI
#undef P10A_LOAD_EV
#undef P10A_LOAD_ROWS
#undef P10A_COMPUTE
}

DEVI void phase10w_block(const Params& p) {
    unsigned char* ws = p.ws;
    const int lane = threadIdx.x & 63, wave = threadIdx.x >> 6;
    const unsigned* PD = reinterpret_cast<const unsigned*>(ws + OFF_PD);
    const float* HS = reinterpret_cast<const float*>(ws + OFF_HS);
    for (int t = blockIdx.x * 8 + wave; t < M_TOK; t += gridDim.x * 8) {
        unsigned pd[8];
#pragma unroll
        for (int sl = 0; sl < 8; ++sl) pd[sl] = PD[((size_t)sl * M_TOK + t) * 64 + lane];
        const float2 uu = reinterpret_cast<const float2*>(ws + OFF_EU)[(size_t)t * 64 + lane];
        const float2 gg = reinterpret_cast<const float2*>(ws + OFF_EW)[(size_t)t * 64 + lane];
        const float hs = HS[t];
        float d0 = 0.f, d1 = 0.f;
#pragma unroll
        for (int sl = 0; sl < 8; ++sl) { d0 += bflo(pd[sl]); d1 += bfhi(pd[sl]); }
        d0 *= uu.x * hs; d1 *= uu.y * hs;
        const _Float16 w0 = (_Float16)(gg.x * 0.5f * d0 * (1.f + erff(d0 * 0.70710678118654752f))), w1 = (_Float16)(gg.y * 0.5f * d1 * (1.f + erff(d1 * 0.70710678118654752f)));
        const h2_t p0 = h2_t{w0, w0}, p1 = h2_t{w1, w1};
        reinterpret_cast<uint2*>(ws + OFF_W16)[(size_t)t * 64 + lane] = make_uint2(__builtin_bit_cast(unsigned, p0), __builtin_bit_cast(unsigned, p1));
    }
}

template <bool DRY>
DEVI void phase10b_block(const Params& p, char* smem) {
    unsigned char* ws = p.ws;
    const int s = blockIdx.x & 7, rank = blockIdx.x >> 3, nrank = ((int)gridDim.x - s + 7) >> 3;
    const int lane = threadIdx.x & 63, wave = threadIdx.x >> 6;
    const int lg = lane & 7, grp = lane >> 3;
    const unsigned char* V8 = ws + OFF_V8 + (size_t)s * (16384 * 128);
    float* stg = reinterpret_cast<float*>(smem) + wave * (16 * 128);
    constexpr int NTG = M_TOK / 8;
#define P10B_LOAD_EV(TG, E) do { const int4* _q = reinterpret_cast<const int4*>(reinterpret_cast<const int*>(ws + OFF_EIDX) + (size_t)((TG) * 8 + wave) * 128 + 16 * grp); \
        E[0] = _q[0]; E[1] = _q[1]; E[2] = _q[2]; E[3] = _q[3]; } while (0)
#define P10B_LOAD_ROWS(TG, E, R, WA, WB, WC, WD) do { \
        asm volatile("" : PIN4(E[0]), PIN4(E[1]), PIN4(E[2]), PIN4(E[3])); \
        const int _e[16] = {E[0].x, E[0].y, E[0].z, E[0].w, E[1].x, E[1].y, E[1].z, E[1].w, E[2].x, E[2].y, E[2].z, E[2].w, E[3].x, E[3].y, E[3].z, E[3].w}; \
        _Pragma("unroll") for (int _i = 0; _i < 16; ++_i) R[_i] = *reinterpret_cast<const uint4*>(V8 + ((unsigned)_e[_i] * 128u + 16u * (unsigned)lg)); \
        const uint4* _w = reinterpret_cast<const uint4*>(reinterpret_cast<const unsigned*>(ws + OFF_W16) + (size_t)((TG) * 8 + wave) * 128 + 16 * grp); WA = _w[0]; WB = _w[1]; WC = _w[2]; WD = _w[3]; } while (0)
#define P10B_COMPUTE(SLOT, R, WA, WB, WC, WD) do { \
          \
        asm volatile("" : PIN4(R[0]), PIN4(R[1]), PIN4(R[2]), PIN4(R[3]), PIN4(R[4]), PIN4(R[5])); \
        asm volatile("" : PIN4(R[6]), PIN4(R[7]), PIN4(R[8]), PIN4(R[9]), PIN4(R[10]), PIN4(R[11])); \
        asm volatile("" : PIN4(R[12]), PIN4(R[13]), PIN4(R[14]), PIN4(R[15]), PIN4(WA), PIN4(WB)); \
        asm volatile("" : PIN4(WC), PIN4(WD)); \
        const unsigned _ww[16] = {WA.x, WA.y, WA.z, WA.w, WB.x, WB.y, WB.z, WB.w, WC.x, WC.y, WC.z, WC.w, WD.x, WD.y, WD.z, WD.w}; \
        h2_t _acc[8]; unsigned _zb; asm volatile("v_mov_b32 %0, 0" : "=v"(_zb)); \
        _Pragma("unroll") for (int _j = 0; _j < 8; ++_j) _acc[_j] = __builtin_bit_cast(h2_t, _zb); \
        _Pragma("unroll") for (int _i = 0; _i < 16; ++_i) { \
            const h2_t _wp = __builtin_bit_cast(h2_t, _ww[_i]); \
            const unsigned _wd[4] = {R[_i].x, R[_i].y, R[_i].z, R[_i].w}; \
            _Pragma("unroll") for (int _j = 0; _j < 4; ++_j) { \
                _acc[2 * _j] += _wp * __builtin_amdgcn_cvt_scalef32_pk_f16_fp8((int)_wd[_j], 1.0f, false); \
                _acc[2 * _j + 1] += _wp * __builtin_amdgcn_cvt_scalef32_pk_f16_fp8((int)_wd[_j], 1.0f, true); } } \
        float _o[16]; \
        _Pragma("unroll") for (int _j = 0; _j < 8; ++_j) { \
            h2_t _x = _acc[_j]; \
            _x += __builtin_bit_cast(h2_t, __builtin_amdgcn_mov_dpp(__builtin_bit_cast(int, _x), 0x128, 0xf, 0xf, true));     \
            { auto _s = __builtin_amdgcn_permlane16_swap(__builtin_bit_cast(unsigned, _x), __builtin_bit_cast(unsigned, _x), false, false); _x = __builtin_bit_cast(h2_t, (unsigned)_s[0]) + __builtin_bit_cast(h2_t, (unsigned)_s[1]); } \
            { auto _s = __builtin_amdgcn_permlane32_swap(__builtin_bit_cast(unsigned, _x), __builtin_bit_cast(unsigned, _x), false, false); _x = __builtin_bit_cast(h2_t, (unsigned)_s[0]) + __builtin_bit_cast(h2_t, (unsigned)_s[1]); } \
            _o[2 * _j] = (float)_x[0]; _o[2 * _j + 1] = (float)_x[1]; } \
        if (grp == 0) { float* _orow = stg + (SLOT) * 128 + 16 * lg; \
            _Pragma("unroll") for (int _i = 0; _i < 4; ++_i) *reinterpret_cast<float4*>(_orow + 4 * _i) = make_float4(_o[4 * _i], _o[4 * _i + 1], _o[4 * _i + 2], _o[4 * _i + 3]); } } while (0)
    int4 eA[4], eB[4], eC[4]; uint4 rA[16], rB[16]; uint4 wA0, wA1, wA2, wA3, wB0, wB1, wB2, wB3;
    if (rank >= NTG) return;
    const int ntok = (NTG - rank + nrank - 1) / nrank;
#define TGI(I) (rank + ((I) < ntok ? (I) : ntok - 1) * nrank)
    P10B_LOAD_EV(TGI(0), eA);
    SB; P10B_LOAD_EV(TGI(1), eB);
    SB; P10B_LOAD_ROWS(TGI(0), eA, rA, wA0, wA1, wA2, wA3);
    SB;
    for (int base = 0; base < ntok; base += 16) {
#pragma unroll 1
        for (int i = base; i < base + 16; i += 2) {
            SB; P10B_LOAD_EV(TGI(i + 2), eC);
            SB; P10B_LOAD_ROWS(TGI(i + 1), eB, rB, wB0, wB1, wB2, wB3);
            SB; P10B_COMPUTE(i - base, rA, wA0, wA1, wA2, wA3);
            SB; P10B_LOAD_EV(TGI(i + 3), eB);
            SB; P10B_LOAD_ROWS(TGI(i + 2), eC, rA, wA0, wA1, wA2, wA3);
            SB; P10B_COMPUTE(i + 1 - base, rB, wB0, wB1, wB2, wB3);
            SB;
        }
#pragma unroll 4
        for (int j = 0; j < 16; ++j) {
            const float2 v = *reinterpret_cast<const float2*>(stg + j * 128 + 2 * lane);
            reinterpret_cast<unsigned*>(ws + OFF_PEER)[(DRY ? (size_t)M_TOK * 512 : 0) + (size_t)(TGI(base + j) * 8 + wave) * 512 + 64 * s + lane] = pack2(v.x, v.y);
        }
        __builtin_amdgcn_s_waitcnt(0x0F70);
    }
#undef TGI
#undef P10B_LOAD_EV
#undef P10B_LOAD_ROWS
#undef P10B_COMPUTE
}

DEVI void phase10c_block(const Params& p) {
    unsigned char* ws = p.ws;
    const int lane = threadIdx.x & 63, wave = threadIdx.x >> 6;
    const float4* gf = reinterpret_cast<const float4*>(p.norm_f_g);
    for (int t = blockIdx.x * 8 + wave; t < M_TOK; t += gridDim.x * 8) {
        const uint4* hrow = reinterpret_cast<const uint4*>(ws + OFF_H16) + (size_t)t * 128;
        const uint4* prow = reinterpret_cast<const uint4*>(ws + OFF_PEER) + (size_t)t * 128;
        float4* orow = reinterpret_cast<float4*>(p.out + (size_t)t * DM);
        uint4 hq[2], pq[2];
#pragma unroll
        for (int i = 0; i < 2; ++i) { hq[i] = hrow[lane + 64 * i]; pq[i] = prow[lane + 64 * i]; }
        float v[2][8]; float ss = 0.f;
#pragma unroll
        for (int i = 0; i < 2; ++i) {
            v[i][0] = bflo(hq[i].x) + bflo(pq[i].x); v[i][1] = bfhi(hq[i].x) + bfhi(pq[i].x); v[i][2] = bflo(hq[i].y) + bflo(pq[i].y); v[i][3] = bfhi(hq[i].y) + bfhi(pq[i].y);
            v[i][4] = bflo(hq[i].z) + bflo(pq[i].z); v[i][5] = bfhi(hq[i].z) + bfhi(pq[i].z); v[i][6] = bflo(hq[i].w) + bflo(pq[i].w); v[i][7] = bfhi(hq[i].w) + bfhi(pq[i].w);
#pragma unroll
            for (int j = 0; j < 8; ++j) ss += v[i][j] * v[i][j];
        }
        const float r = rsqrtf(wave_sum(ss) * (1.f / 1024.f) + 1e-6f);
#pragma unroll
        for (int i = 0; i < 2; ++i) {
            const float4 g0 = gf[2 * (lane + 64 * i)], g1 = gf[2 * (lane + 64 * i) + 1];
            orow[2 * (lane + 64 * i)] = make_float4(v[i][0] * r * g0.x, v[i][1] * r * g0.y, v[i][2] * r * g0.z, v[i][3] * r * g0.w);
            orow[2 * (lane + 64 * i) + 1] = make_float4(v[i][4] * r * g1.x, v[i][5] * r * g1.y, v[i][6] * r * g1.z, v[i][7] * r * g1.w);
        }
    }
}

#define XB_TMO      128
#define XB_XCNT(j)  (256  + 64 * (j))
#define XB_XSUB(j)  (1280 + 64 * (j))
#define XB_XGEN(j)  (2304 + 64 * (j))
#define XB_TOP      3328
#define XB_TOPGEN   3392
#define XCD_BAR_WORDS 3456
#define XB_SPIN_CAP (1u << 22)
#define LAS __attribute__((address_space(3)))
DEVI unsigned xb_ld(unsigned* p)              { return __hip_atomic_load(p, __ATOMIC_RELAXED, __HIP_MEMORY_SCOPE_AGENT); }
DEVI unsigned xb_add(unsigned* p, unsigned v) { return __hip_atomic_fetch_add(p, v, __ATOMIC_RELAXED, __HIP_MEMORY_SCOPE_AGENT); }
DEVI unsigned xb_xcc_id() { return (unsigned)__builtin_amdgcn_s_getreg((3 << 11) | 20) & 0xFu; }
#define XB_SPIN(cond, bar) do { unsigned _sp = 0; while (cond) { __builtin_amdgcn_s_sleep(1); \
    if ((++_sp & 255u) == 0u) { if (xb_ld(&(bar)[XB_TMO])) break; if (_sp > XB_SPIN_CAP) { atomicAdd(&(bar)[XB_TMO], 1u); break; } } } } while (0)
struct XcdBarrier { unsigned* bar; unsigned x; volatile LAS unsigned* st; };
DEVI XcdBarrier xcd_barrier_post(unsigned* bar, volatile LAS unsigned* st) {
    XcdBarrier b; b.bar = bar; b.x = xb_xcc_id(); b.st = st;
    if (threadIdx.x == 0) (void)xb_add(&bar[XB_XCNT(b.x)], 1u);
    return b;
}
DEVI void xcd_barrier_complete(unsigned* bar, unsigned x, unsigned& nloc, unsigned& nx) {
    const unsigned G = gridDim.x * gridDim.y * gridDim.z;
    unsigned sum, cnt, mine, sp = 0u;
    for (;;) {
        sum = 0u; cnt = 0u; mine = 0u;
#pragma unroll
        for (unsigned j = 0; j < 16; ++j) { const unsigned c = xb_ld(&bar[XB_XCNT(j)]); sum += c; cnt += (c > 0u) ? 1u : 0u; mine = (j == x) ? c : mine; }
        if (sum == G) break;
        __builtin_amdgcn_s_sleep(1);
        if ((++sp & 255u) == 0u) { if (xb_ld(&bar[XB_TMO])) break; if (sp > XB_SPIN_CAP) { atomicAdd(&bar[XB_TMO], 1u); break; } }
    }
    nloc = mine > 0u ? mine : 1u; nx = cnt > 0u ? cnt : 1u;
}
DEVI void xcd_barrier(const XcdBarrier& b) {
    asm volatile("s_waitcnt vmcnt(0)" ::: "memory");
    __syncthreads();
    if (threadIdx.x == 0) {
        unsigned* bar = b.bar;
        __builtin_amdgcn_s_waitcnt(0);
        unsigned nloc = b.st[0], nx = b.st[1];
        if (nloc == 0u) { xcd_barrier_complete(bar, b.x, nloc, nx); b.st[0] = nloc; b.st[1] = nx; }
        const unsigned old = xb_add(&bar[XB_XSUB(b.x)], 1u);
        const unsigned gen = old / nloc;
        if (old + 1u == (gen + 1u) * nloc) {
            __builtin_amdgcn_fence(__ATOMIC_RELEASE, "agent");
            asm volatile("s_waitcnt vmcnt(0)" ::: "memory");
            const unsigned og = xb_add(&bar[XB_TOP], 1u);
            const unsigned tg = og / nx;
            if (og + 1u == (tg + 1u) * nx) xb_add(&bar[XB_TOPGEN], 1u);
            else XB_SPIN(xb_ld(&bar[XB_TOPGEN]) == tg, bar);
            __builtin_amdgcn_fence(__ATOMIC_ACQUIRE, "agent");
            xb_add(&bar[XB_XGEN(b.x)], 1u);
            asm volatile("s_waitcnt vmcnt(0)" ::: "memory");
        } else {
            XB_SPIN(xb_ld(&bar[XB_XGEN(b.x)]) == gen, bar);
            __builtin_amdgcn_fence(__ATOMIC_ACQUIRE, "agent");
            asm volatile("s_waitcnt vmcnt(0)" ::: "memory");
        }
    }
    __syncthreads();
}

constexpr int N_PHASES = 11;
constexpr int LDS_PHASE_BYTES = 131072;
constexpr int LDS_BYTES = LDS_PHASE_BYTES + 16;

__global__ void __launch_bounds__(512, 2) hymba_fwd(Params p) {
    extern __shared__ __attribute__((aligned(16))) char smem[];
    cg::grid_group grid = cg::this_grid();
    const int lo = p.ph_lo, hi = p.ph_hi;
    volatile LAS unsigned* bst = (volatile LAS unsigned*)(smem + LDS_PHASE_BYTES);
    if (threadIdx.x == 0) { bst[0] = 0u; bst[1] = 0u; bst[2] = 0u; bst[3] = 0u; }
    __syncthreads();
    XcdBarrier xb = xcd_barrier_post(reinterpret_cast<unsigned*>(p.ws + OFF_BAR), bst);
    const int hb = (int)(threadIdx.x >> 8);
    char* hsm = smem + hb * 65536;
#define SEAM(K) if ((K) > lo) { if ((K) == lo + 1) grid.sync(); else xcd_barrier(xb); }
#define RUN_PHASE(K, FN, N) if (lo <= (K) && (K) < hi) { SEAM(K) for (int rep = 0; rep < 1 + ((PROBE_DUP >> (K)) & 1); ++rep) { if (rep) xcd_barrier(xb); \
        for (int ub = blockIdx.x * 2; ub < (N); ub += gridDim.x * 2) { const int u = ub + hb; if (u < (N)) FN(p, u, hsm); } } }
#define RUN_GEMM(K, CALL) if (lo <= (K) && (K) < hi) { SEAM(K) CALL; }
    RUN_PHASE(0, phase0_unit, P0_UNITS)
    RUN_GEMM(1, run_gemm(reinterpret_cast<const bf16_t*>(p.ws + OFF_XN), reinterpret_cast<const bf16_t*>(p.ws + OFF_WIN), P1_N, EpiInProj{p.ws}, smem))
    if (lo <= 3 && 3 < hi) { SEAM(3) phase3_loop<128>(p, hb, hsm); phase3_loop<64>(p, hb, hsm); }
#if PROBE_P4
    if (lo <= 4 && 4 < hi) { xcd_barrier(xb); for (int ub = blockIdx.x * 2; ub < P4_UNITS; ub += gridDim.x * 2) { const int u = ub + hb; if (u < P4_UNITS) phase4_dry_unit(p, u, hsm); } }
#endif
    RUN_PHASE(4, phase4_unit, P4_UNITS)
    if (lo <= 5 && 5 < hi) { SEAM(5) phase5_loop<128>(p, hb, hsm); phase5_loop<64>(p, hb, hsm); }
    RUN_GEMM(6, run_gemm(reinterpret_cast<const bf16_t*>(p.ws + OFF_MIX), reinterpret_cast<const bf16_t*>(p.ws + OFF_WOUT), 1024, EpiOutProj{p.x, reinterpret_cast<bf16_t*>(p.ws + OFF_H16)}, smem))
    RUN_PHASE(7, phase7_unit, P7_UNITS)
    RUN_GEMM(8, run_gemm(reinterpret_cast<const bf16_t*>(p.ws + OFF_HN), reinterpret_cast<const bf16_t*>(p.ws + OFF_WQ), 2048, EpiQ{reinterpret_cast<bf16_t*>(p.ws + OFF_Q)}, smem))
    RUN_GEMM(9, phase9_block(p, smem))
    if (lo <= 10 && 10 < hi) {
        SEAM(10)
#if PROBE_P10X == 4
        phase10a_block(p, smem); xcd_barrier(xb);
#endif
        phase10a_block(p, smem);
#if PROBE_P10X == 1
        xcd_barrier(xb); phase10a_block(p, smem);
#endif

        xcd_barrier(xb); phase10w_block(p);
#if PROBE_P10X == 2
        xcd_barrier(xb); phase10b_block<true>(p, smem);
#endif
        xcd_barrier(xb); phase10b_block<false>(p, smem);
        xcd_barrier(xb); phase10c_block(p);
#if PROBE_P10X == 3
        xcd_barrier(xb); phase10c_block(p);
#endif
    }
#undef RUN_PHASE
#undef RUN_GEMM
#undef SEAM
}

extern "C" void kernel_launch(void* const* d_in, const int* in_sizes, int n_in, void* d_out, int out_size, void* d_ws, size_t ws_size, hipStream_t stream) {
    static int grid_blocks = 0;
    if (grid_blocks == 0) {
        if (n_in != 15 || in_sizes[0] != M_TOK * DM || out_size != M_TOK * DM || ws_size < WS_NEED) {
            fprintf(stderr, "kernel_launch: unexpected shapes (n_in %d, in0 %d, out %d, ws %zu)\n", n_in, n_in > 0 ? in_sizes[0] : -1, out_size, ws_size);
            grid_blocks = -1; return;
        }
        int dev = 0, cus = 0, per_cu = 0;
        (void)hipGetDevice(&dev);
        (void)hipDeviceGetAttribute(&cus, hipDeviceAttributeMultiprocessorCount, dev);
        (void)hipFuncSetAttribute((const void*)hymba_fwd, hipFuncAttributeMaxDynamicSharedMemorySize, LDS_BYTES);
        (void)hipOccupancyMaxActiveBlocksPerMultiprocessor(&per_cu, (const void*)hymba_fwd, 512, LDS_BYTES);
        if (per_cu < 1) per_cu = 1;
        if (per_cu > 1) per_cu = 1;
        grid_blocks = cus * per_cu;
    }
    if (grid_blocks < 0) return;
    Params p{};
    p.x = (const float*)d_in[0]; p.norm1_g = (const float*)d_in[1]; p.w_in = (const float*)d_in[2]; p.hg_lower = (const float*)d_in[3];
    p.hg_norm_g = (const float*)d_in[4]; p.gla_wg = (const float*)d_in[5]; p.gla_bg = (const float*)d_in[6]; p.gla_norm_g = (const float*)d_in[7];
    p.w_out = (const float*)d_in[8]; p.norm2_g = (const float*)d_in[9]; p.w_q = (const float*)d_in[10]; p.sub_keys = (const float*)d_in[11];
    p.peer_u = (const float*)d_in[12]; p.peer_v = (const float*)d_in[13]; p.norm_f_g = (const float*)d_in[14];
    p.out = (float*)d_out; p.ws = (unsigned char*)d_ws;
#if N_LAUNCH_MODE == 1
    (void)hipMemsetAsync((unsigned char*)d_ws + OFF_BAR, 0, XCD_BAR_WORDS * 4, stream);
    p.ph_lo = 0; p.ph_hi = N_PHASES;
    void* args[] = {&p};
    hipError_t e = hipLaunchCooperativeKernel((const void*)hymba_fwd, dim3(grid_blocks), dim3(512), args, LDS_BYTES, stream);
    if (e != hipSuccess) fprintf(stderr, "cooperative launch failed: %s (grid %d)\n", hipGetErrorString(e), grid_blocks);
#else
    for (int ph = 0; ph < N_PHASES; ++ph) {
        p.ph_lo = ph; p.ph_hi = ph + 1;
        hipLaunchKernelGGL(hymba_fwd, dim3(grid_blocks), dim3(512), LDS_BYTES, stream, p);
    }
#endif
}
```

```cpp
#include <hip/hip_runtime.h>
#include <hip/hip_cooperative_groups.h>
#include <cstdio>
#include <cstdint>
namespace cg = cooperative_groups;

#ifndef N_LAUNCH_MODE
#define N_LAUNCH_MODE 1
#endif

#ifndef PROBE_DUP
#define PROBE_DUP 0
#endif
#ifndef PROBE_P10_DUP
#define PROBE_P10_DUP 0
#endif
#ifndef P10_SLICED
#define P10_SLICED 0
#endif
#ifndef PROBE_P10A
#define PROBE_P10A 0
#endif
#ifndef PROBE_P10_MASK
#define PROBE_P10_MASK 0x7fffffff
#endif
#ifndef PROBE_P10X
#define PROBE_P10X 0
#endif
#ifndef PROBE_P2T
#define PROBE_P2T 0
#endif
#ifndef PROBE_P4
#define PROBE_P4 0
#endif
#ifndef PROBE_P2G
#define PROBE_P2G 0
#endif
#ifndef PROBE_GEMM_DUP
#define PROBE_GEMM_DUP 0
#endif
#define DEVI __device__ __forceinline__
#define LTID ((int)(threadIdx.x & 255u))
typedef unsigned short bf16_t;
using bf16x8 = __attribute__((ext_vector_type(8))) short;
using f32x4 = __attribute__((ext_vector_type(4))) float;

constexpr int M_TOK = 32768;
constexpr int DM = 1024;
constexpr int IN_WP = 3840;
constexpr size_t MiB = 1024ull * 1024ull;

constexpr size_t OFF_XN   = 0;
constexpr size_t OFF_WIN  = 64 * MiB;
constexpr size_t OFF_WOUT = 72 * MiB;
constexpr size_t OFF_WQ   = 74 * MiB;
constexpr size_t OFF_SK   = 78 * MiB;
constexpr size_t OFF_LB   = 79 * MiB;
constexpr size_t OFF_U8   = 80 * MiB;
constexpr size_t OFF_V8   = 96 * MiB;
constexpr size_t OFF_US   = 112 * MiB;
constexpr size_t OFF_VS   = 113 * MiB;
constexpr size_t OFF_R2   = 144 * MiB;
constexpr size_t OFF_HQ   = OFF_R2;
constexpr size_t OFF_HLF  = OFF_R2 + 32 * MiB;
constexpr size_t OFF_HV   = OFF_R2 + 64 * MiB;
constexpr size_t OFF_HG   = OFF_R2 + 96 * MiB;
constexpr size_t OFF_GQ   = OFF_R2 + 128 * MiB;
constexpr size_t OFF_GK   = OFF_R2 + 144 * MiB;
constexpr size_t OFF_GV   = OFF_R2 + 160 * MiB;
constexpr size_t OFF_GG   = OFF_R2 + 192 * MiB;
constexpr size_t OFF_GLOW = OFF_R2 + 224 * MiB;
constexpr size_t OFF_KTH  = 370 * MiB;
constexpr size_t OFF_KTG  = 402 * MiB;
constexpr size_t OFF_DECH = 418 * MiB;
constexpr size_t OFF_DECG = 419 * MiB;
constexpr size_t OFF_HVT  = 420 * MiB;
constexpr size_t OFF_GVT  = 452 * MiB;
constexpr size_t OFF_H16  = OFF_HVT;
constexpr size_t OFF_DUMMY = 336 * MiB;
constexpr size_t OFF_BAR  = 484 * MiB;
constexpr size_t WS_NEED  = 485 * MiB;
constexpr size_t OFF_MIX  = OFF_XN;
constexpr size_t OFF_HN   = OFF_R2;
constexpr size_t OFF_Q    = OFF_R2 + 64 * MiB;
constexpr size_t OFF_EIDX = OFF_KTH;
constexpr size_t OFF_EW   = OFF_KTH + 16 * MiB;
constexpr size_t OFF_EU   = OFF_KTG;
constexpr size_t OFF_HN8  = OFF_XN;
constexpr size_t OFF_HS   = OFF_XN + 32 * MiB;
constexpr size_t OFF_W16  = OFF_XN + 48 * MiB;
constexpr size_t OFF_SSQ  = OFF_XN + 33 * MiB;
constexpr size_t OFF_PD   = OFF_Q;
constexpr size_t OFF_PEER = OFF_Q + 64 * MiB;
constexpr size_t OUT_STH = 0;
constexpr size_t OUT_STG = 64 * MiB;

struct Params {
    const float* x; const float* norm1_g; const float* w_in; const float* hg_lower; const float* hg_norm_g;
    const float* gla_wg; const float* gla_bg; const float* gla_norm_g; const float* w_out; const float* norm2_g;
    const float* w_q; const float* sub_keys; const float* peer_u; const float* peer_v; const float* norm_f_g;
    float* out; unsigned char* ws;
    int ph_lo, ph_hi;
};

DEVI unsigned short f2bf(float f) {
    unsigned u = __float_as_uint(f);
    u += 0x7fffu + ((u >> 16) & 1u);
    return (unsigned short)(u >> 16);
}
DEVI float bf2f(unsigned short b) { return __uint_as_float(((unsigned)b) << 16); }
DEVI unsigned pack2(float a, float b) { return (unsigned)f2bf(a) | ((unsigned)f2bf(b) << 16); }
DEVI float bflo(unsigned u) { return __uint_as_float(u << 16); }
DEVI float bfhi(unsigned u) { return __uint_as_float(u & 0xffff0000u); }
template <int CTRL> DEVI float dpp_f(float x) { return __builtin_bit_cast(float, __builtin_amdgcn_mov_dpp(__builtin_bit_cast(int, x), CTRL, 0xf, 0xf, true)); }
DEVI float wave_sum(float v) {
    v += dpp_f<0xB1>(v); v += dpp_f<0x4E>(v); v += dpp_f<0x141>(v); v += dpp_f<0x128>(v);
    { auto s = __builtin_amdgcn_permlane16_swap(__float_as_uint(v), __float_as_uint(v), false, false); v = __uint_as_float(s[0]) + __uint_as_float(s[1]); }
    { auto s = __builtin_amdgcn_permlane32_swap(__float_as_uint(v), __float_as_uint(v), false, false); v = __uint_as_float(s[0]) + __uint_as_float(s[1]); }
    return v;
}
DEVI float wave_max(float v) {
    v = fmaxf(v, dpp_f<0xB1>(v)); v = fmaxf(v, dpp_f<0x4E>(v)); v = fmaxf(v, dpp_f<0x141>(v)); v = fmaxf(v, dpp_f<0x128>(v));
    { auto s = __builtin_amdgcn_permlane16_swap(__float_as_uint(v), __float_as_uint(v), false, false); v = fmaxf(__uint_as_float(s[0]), __uint_as_float(s[1])); }
    { auto s = __builtin_amdgcn_permlane32_swap(__float_as_uint(v), __float_as_uint(v), false, false); v = fmaxf(__uint_as_float(s[0]), __uint_as_float(s[1])); }
    return v;
}
DEVI float silu_f(float x) { return x * __builtin_amdgcn_rcpf(1.f + __expf(-x)); }
DEVI f32x4 mfma16(bf16x8 a, bf16x8 b, f32x4 c) { return __builtin_amdgcn_mfma_f32_16x16x32_bf16(a, b, c, 0, 0, 0); }
DEVI bf16x8 ldg_frag(const bf16_t* p) { return *reinterpret_cast<const bf16x8*>(p); }

DEVI void rms_row_bf16(const float* __restrict__ xr, const float* __restrict__ g, bf16_t* __restrict__ dst, int lane) {
    float4 v[4]; float ss = 0.f;
#pragma unroll
    for (int i = 0; i < 4; ++i) { v[i] = reinterpret_cast<const float4*>(xr)[lane + 64 * i]; ss += v[i].x * v[i].x + v[i].y * v[i].y + v[i].z * v[i].z + v[i].w * v[i].w; }
    ss = wave_sum(ss);
    const float r = rsqrtf(ss * (1.f / 1024.f) + 1e-6f);
#pragma unroll
    for (int i = 0; i < 4; ++i) {
        const float4 gg = reinterpret_cast<const float4*>(g)[lane + 64 * i];
        uint2 o; o.x = pack2(v[i].x * r * gg.x, v[i].y * r * gg.y); o.y = pack2(v[i].z * r * gg.z, v[i].w * r * gg.w);
        reinterpret_cast<uint2*>(dst)[lane + 64 * i] = o;
    }
}

DEVI void transpose_tile(const float* __restrict__ src, int Nsrc, bf16_t* __restrict__ dst, int nt, int kt, int mode, float* lds) {
    const int tid = LTID, tx = tid & 63, ty = tid >> 6;
    const int np = nt * 64 + tx;
    int col = np; bool valid = true;
    if (mode == 1) {
        if (np < 3072) col = np; else if (np < 3584) col = np + 16; else if (np < 3600) col = np - 512; else { valid = false; col = 0; }
    }
#pragma unroll 4
    for (int kk = ty; kk < 64; kk += 4) {
        lds[kk * 65 + tx] = valid ? src[(size_t)(kt * 64 + kk) * Nsrc + col] : 0.f;
    }
    __syncthreads();
    const int nl = tid >> 2, kq = tid & 3;
    unsigned pk[8];
#pragma unroll
    for (int i = 0; i < 8; ++i) pk[i] = pack2(lds[(kq * 16 + 2 * i) * 65 + nl], lds[(kq * 16 + 2 * i + 1) * 65 + nl]);
    uint4* d = reinterpret_cast<uint4*>(dst + (size_t)(nt * 64 + nl) * 1024 + kt * 64 + kq * 16);
    d[0] = make_uint4(pk[0], pk[1], pk[2], pk[3]);
    d[1] = make_uint4(pk[4], pk[5], pk[6], pk[7]);
    __syncthreads();
}

DEVI void convert8(const float* __restrict__ src, bf16_t* __restrict__ dst, size_t idx8) {
    const float4 a = reinterpret_cast<const float4*>(src)[idx8 * 2], b = reinterpret_cast<const float4*>(src)[idx8 * 2 + 1];
    reinterpret_cast<uint4*>(dst)[idx8] = make_uint4(pack2(a.x, a.y), pack2(a.z, a.w), pack2(b.x, b.y), pack2(b.z, b.w));
}

DEVI int pack_i8x4(float a, float b, float c, float d) {
    const int ia = (int)rintf(a), ib = (int)rintf(b), ic = (int)rintf(c), id = (int)rintf(d);
    return (ia & 255) | ((ib & 255) << 8) | ((ic & 255) << 16) | (id << 24);
}
DEVI void quant_row_i8(const float* __restrict__ xr, unsigned char* __restrict__ dst_table, int row, float* __restrict__ descale, int lane) {
    float4 v[4]; float am = 0.f;
#pragma unroll
    for (int i = 0; i < 4; ++i) { v[i] = reinterpret_cast<const float4*>(xr)[lane + 64 * i]; am = fmaxf(am, fmaxf(fmaxf(fabsf(v[i].x), fabsf(v[i].y)), fmaxf(fabsf(v[i].z), fabsf(v[i].w)))); }
    am = wave_max(am);
    const float sc = am > 0.f ? 127.f / am : 1.f;
#pragma unroll
    for (int i = 0; i < 4; ++i) {
        const int w = lane + 64 * i;
        reinterpret_cast<int*>(dst_table)[(size_t)(w >> 5) * (16384 * 32) + (size_t)row * 32 + (w & 31)] = pack_i8x4(v[i].x * sc, v[i].y * sc, v[i].z * sc, v[i].w * sc);
    }
    if (lane == 0) *descale = am > 0.f ? am * (1.f / 127.f) : 1.f;
}
DEVI void quant_row_fp8(const float* __restrict__ xr, unsigned char* __restrict__ dst_table, int row, float* __restrict__ descale, int lane) {
    float4 v[4]; float am = 0.f;
#pragma unroll
    for (int i = 0; i < 4; ++i) { v[i] = reinterpret_cast<const float4*>(xr)[lane + 64 * i]; am = fmaxf(am, fmaxf(fmaxf(fabsf(v[i].x), fabsf(v[i].y)), fmaxf(fabsf(v[i].z), fabsf(v[i].w)))); }
    am = wave_max(am);
    const float sc = am > 0.f ? 448.f / am : 1.f;
#pragma unroll
    for (int i = 0; i < 4; ++i) {
        const float a = fminf(fmaxf(v[i].x * sc, -448.f), 448.f), b = fminf(fmaxf(v[i].y * sc, -448.f), 448.f);
        const float c = fminf(fmaxf(v[i].z * sc, -448.f), 448.f), d = fminf(fmaxf(v[i].w * sc, -448.f), 448.f);
        int pk = __builtin_amdgcn_cvt_pk_fp8_f32(a, b, 0, false);
        pk = __builtin_amdgcn_cvt_pk_fp8_f32(c, d, pk, true);
        const int w = lane + 64 * i;
        reinterpret_cast<int*>(dst_table)[(size_t)(w >> 5) * (16384 * 32) + (size_t)row * 32 + (w & 31)] = pk;
    }
    if (lane == 0) *descale = am > 0.f ? am * (1.f / 448.f) : 1.f;
}

constexpr int P0_XN = 8192, P0_WIN = 60 * 16, P0_WOUT = 16 * 16, P0_WQ = 32 * 16, P0_UV = 8192, P0_SK = 128, P0_LB = 1;
constexpr int P0_UNITS = P0_XN + P0_WIN + P0_WOUT + P0_WQ + P0_UV + P0_SK + P0_LB;

DEVI void phase0_unit(const Params& p, int u, char* smem) {
    const int tid = LTID, lane = tid & 63, w = tid >> 6;
    unsigned char* ws = p.ws;
    if (u < P0_XN) {
        const int row = u * 4 + w;
        rms_row_bf16(p.x + (size_t)row * DM, p.norm1_g, reinterpret_cast<bf16_t*>(ws + OFF_XN) + (size_t)row * DM, lane);
        return;
    }
    u -= P0_XN;
    if (u < P0_WIN) { transpose_tile(p.w_in, 3600, reinterpret_cast<bf16_t*>(ws + OFF_WIN), u / 16, u % 16, 1, reinterpret_cast<float*>(smem)); return; }
    u -= P0_WIN;
    if (u < P0_WOUT) { transpose_tile(p.w_out, 1024, reinterpret_cast<bf16_t*>(ws + OFF_WOUT), u / 16, u % 16, 0, reinterpret_cast<float*>(smem)); return; }
    u -= P0_WOUT;
    if (u < P0_WQ) { transpose_tile(p.w_q, 2048, reinterpret_cast<bf16_t*>(ws + OFF_WQ), u / 16, u % 16, 0, reinterpret_cast<float*>(smem)); return; }
    u -= P0_WQ;
    if (u < P0_UV) {
        const bool isv = u >= 4096; const int row = (isv ? u - 4096 : u) * 4 + w;
        if (isv) quant_row_fp8(p.peer_v + (size_t)row * DM, ws + OFF_V8, row, reinterpret_cast<float*>(ws + OFF_VS) + row, lane);
        else quant_row_i8(p.peer_u + (size_t)row * DM, ws + OFF_U8, row, reinterpret_cast<float*>(ws + OFF_US) + row, lane);
        return;
    }
    u -= P0_UV;
    if (u < P0_SK) { convert8(p.sub_keys, reinterpret_cast<bf16_t*>(ws + OFF_SK), (size_t)u * 256 + tid); return; }
    float* lb = reinterpret_cast<float*>(ws + OFF_LB);
    for (int n = tid; n < 512; n += 256) {
        const float l0 = p.hg_lower[n], l1 = p.hg_lower[512 + n];
        const float mx = fmaxf(l0, l1); const float e0 = __expf(l0 - mx), e1 = __expf(l1 - mx);
        lb[n] = e0 / (e0 + e1);
    }
}

namespace pg8 {
#define PG8_LAS __attribute__((address_space(3)))
typedef unsigned short bf16_t;
typedef short bf16x8 __attribute__((ext_vector_type(8)));
typedef float f32x4 __attribute__((ext_vector_type(4)));
typedef unsigned u32x4 __attribute__((ext_vector_type(4)));
constexpr int BM = 256, BK = 64, HALF = 128, HTB = HALF * BK * 2  , STAGE_BYTES = 8 * HTB, NXCD = 8, WGM = 8;

__host__ __device__ __forceinline__ int lds_byte(int r, int c) { const int st = (r >> 4) * 2 + (c >> 5), rr = r & 15, cc = c & 31, ob = rr * 64 + cc * 2; return st * 1024 + (ob ^ (((ob >> 9) & 1) << 5)); }
__host__ __device__ __forceinline__ void stage_rc(int b, int& R, int& C) { const int st = b / 1024, sb = b % 1024, swz = sb ^ (((sb >> 9) & 1) << 5); R = (st >> 1) * 16 + swz / 64; C = (st & 1) * 32 + (swz % 64) / 2; }
__host__ __device__ __forceinline__ int perm32(int rho) { const int n = rho >> 4, i = rho & 15; return 8 * (i >> 2) + 4 * n + (i & 3); }

struct Unit { int pm, pn; };
struct Gemm { const bf16_t* A; const bf16_t* Bt; int M, N, K; };

struct StaticOrder {
    int nM, nN, nwg, G, c;
    __host__ __device__ void init(int M, int N, int G_, int c_) { nM = M / BM; nN = N / BM; nwg = nM * nN; G = G_; c = c_; }
    __host__ __device__ bool next(int i, Unit& u) const {
        const long L = (long)i * G + c; if (L >= nwg) return false;
        int wgid = (int)L; { const int q = nwg / NXCD, r = nwg % NXCD, xcd = wgid % NXCD, off = wgid / NXCD; wgid = (xcd < r ? xcd * (q + 1) : r * (q + 1) + (xcd - r) * q) + off; }
        const int nig = WGM * nN, gid = wgid / nig, fm = gid * WGM, gsz = (nM - fm) < WGM ? (nM - fm) : WGM;
        u.pm = fm + ((wgid % nig) % gsz); u.pn = (wgid % nig) / gsz; return true;
    }
    __device__ __forceinline__ void a_ready(const Unit&) const {}
    __device__ __forceinline__ void done(const Unit&) const {}
};
__device__ __forceinline__ unsigned cvt_pk_bf16(float lo, float hi) { unsigned r; asm volatile("v_cvt_pk_bf16_f32 %0, %1, %2" : "=v"(r) : "v"(lo), "v"(hi)); return r; }
typedef float f32x2 __attribute__((ext_vector_type(2)));
template <class Epi, class Sched, bool STAMP = false>
__device__ __forceinline__ void gemm_phase(PG8_LAS unsigned char* lds, const Gemm g, const Sched& S, const Epi& E, unsigned long long* stamps) {
    const int tid = threadIdx.x, wid = __builtin_amdgcn_readfirstlane(tid >> 6), lane = tid & 63, wr = wid >> 2, wc = wid & 3, fr = lane & 15, fq = lane >> 4;
    const int K = g.K, nt = K / BK;
    int ts_lo = 0, ts_hi = 0, nts = 0; const unsigned long long rt_entry = STAMP ? (unsigned long long)wall_clock64() : 0ull;
#define PG8_STAMP() do { if (STAMP && wid == 0 && nts < 64) { const unsigned long long _c = (unsigned long long)clock64(); \
        ts_lo = (lane == nts) ? (int)(unsigned)_c : ts_lo; ts_hi = (lane == nts) ? (int)(unsigned)(_c >> 32) : ts_hi; ++nts; } } while (0)
    PG8_STAMP();
    unsigned voffA[2], voffB[2];
#pragma unroll
    for (int i = 0; i < 2; ++i) { int R, C; stage_rc(tid * 16 + i * 8192, R, C); const int Rb = Epi::PERM ? ((R & ~31) + perm32(R & 31)) : R;
        voffA[i] = (unsigned)(R * K + C) * 2u; voffB[i] = (unsigned)(Rb * K + C) * 2u; }
    const size_t kstep = (size_t)(BK * 2);
    const size_t hstep = (size_t)HALF * K * 2;
    const size_t tstep = 2 * hstep;
    const unsigned ldsw = (unsigned)wid * 1024u;
    const int aoff = lds_byte(wr * 64 + fr, fq * 8), boff = lds_byte(wc * 32 + fr, fq * 8);
#define PG8_SA(b, h) (((b) * 2 + (h)) * HTB)
#define PG8_SB(b, h) ((4 + (b) * 2 + (h)) * HTB)
#define PG8_STAGE(bufoff, gbase, voff) do { _Pragma("unroll") for (int _i = 0; _i < 2; ++_i) \
        __builtin_amdgcn_global_load_lds((const unsigned*)((const char*)(gbase) + (voff)[_i]), (PG8_LAS unsigned*)(lds + (bufoff) + ldsw + _i * 8192), 16, 0, 0); } while (0)
#define PG8_LDA(dst, b, h) do { _Pragma("unroll") for (int m = 0; m < 4; ++m) _Pragma("unroll") for (int k = 0; k < 2; ++k) dst[m][k] = *(const PG8_LAS bf16x8*)(lds + PG8_SA(b, h) + aoff + m * 2048 + k * 1024); } while (0)
#define PG8_LDB(dst, b, h) do { _Pragma("unroll") for (int n = 0; n < 2; ++n) _Pragma("unroll") for (int k = 0; k < 2; ++k) dst[n][k] = *(const PG8_LAS bf16x8*)(lds + PG8_SB(b, h) + boff + n * 2048 + k * 1024); } while (0)
#define PG8_MMA(ai, bj, At, Bt) do { __builtin_amdgcn_s_setprio(1); _Pragma("unroll") for (int m = 0; m < 4; ++m) _Pragma("unroll") for (int n = 0; n < 2; ++n) _Pragma("unroll") for (int k = 0; k < 2; ++k) \
        acc[ai][bj][m][n] = __builtin_amdgcn_mfma_f32_16x16x32_bf16(Bt[n][k], At[m][k], acc[ai][bj][m][n], 0, 0, 0); __builtin_amdgcn_s_setprio(0); } while (0)
#define PG8_WAIT_V(n) asm volatile("s_waitcnt vmcnt(" #n ")" ::: "memory")
#define PG8_WAIT_L(n) asm volatile("s_waitcnt lgkmcnt(" #n ")" ::: "memory")
#define PG8_BAR __builtin_amdgcn_s_barrier()
#define PG8_SCHED __builtin_amdgcn_sched_barrier(0)
    Unit cur, nxt; int ui = 0;
    if (!S.next(0, cur)) return;
    f32x4 acc[2][2][4][2];
#pragma unroll
    for (int a = 0; a < 2; ++a)
#pragma unroll
        for (int b = 0; b < 2; ++b)
#pragma unroll
            for (int m = 0; m < 4; ++m)
#pragma unroll
                for (int n = 0; n < 2; ++n) acc[a][b][m][n] = (f32x4){0.f, 0.f, 0.f, 0.f};
    bf16x8 At[4][2], B0[2][2], B1[2][2];
    const char* cA = (const char*)g.A + (size_t)cur.pm * tstep; const char* cB = (const char*)g.Bt + (size_t)cur.pn * tstep;
    S.a_ready(cur);
    PG8_STAGE(PG8_SB(0, 0), cB, voffB); PG8_STAGE(PG8_SA(0, 0), cA, voffA); PG8_STAGE(PG8_SB(0, 1), cB + hstep, voffB); PG8_STAGE(PG8_SA(0, 1), cA + hstep, voffA);
    if (wr == 1) PG8_BAR;
    PG8_WAIT_V(4); PG8_BAR;
    PG8_STAGE(PG8_SB(1, 0), cB + kstep, voffB); PG8_STAGE(PG8_SA(1, 0), cA + kstep, voffA); PG8_STAGE(PG8_SB(1, 1), cB + hstep + kstep, voffB);
    PG8_WAIT_V(6); PG8_BAR;
    PG8_STAMP();
    for (;;) {
        const bool has_next = S.next(ui + 1, nxt);
        const char* nA = has_next ? (const char*)g.A + (size_t)nxt.pm * tstep : cA; const char* nB = has_next ? (const char*)g.Bt + (size_t)nxt.pn * tstep : cB;
        for (int t = 0; t < nt; t += 2) {
            const bool last = (t == nt - 2);
            const char* a1 = cA + (size_t)(t + 1) * kstep;
            const char* a2 = last ? nA : cA + (size_t)(t + 2) * kstep; const char* b2 = last ? nB : cB + (size_t)(t + 2) * kstep;
            const char* a3 = a2 + kstep; const char* b3 = b2 + kstep;
            if (last && has_next) S.a_ready(nxt);
            PG8_LDB(B0, 0, 0); PG8_SCHED; PG8_LDA(At, 0, 0); PG8_STAGE(PG8_SA(1, 1), a1 + hstep, voffA);
            PG8_WAIT_L(8); PG8_BAR; PG8_WAIT_L(0); PG8_MMA(0, 0, At, B0); PG8_BAR; PG8_SCHED;
            PG8_LDB(B1, 0, 1); PG8_STAGE(PG8_SB(0, 0), b2, voffB);
            PG8_BAR; PG8_WAIT_L(0); PG8_MMA(0, 1, At, B1); PG8_BAR;
            PG8_LDA(At, 0, 1); PG8_STAGE(PG8_SA(0, 0), a2, voffA);
            PG8_BAR; PG8_WAIT_L(0); PG8_MMA(1, 0, At, B0); PG8_BAR; PG8_SCHED;
            PG8_STAGE(PG8_SB(0, 1), b2 + hstep, voffB);
            PG8_WAIT_V(6); PG8_BAR; PG8_MMA(1, 1, At, B1); PG8_BAR;
            PG8_LDB(B0, 1, 0); PG8_SCHED; PG8_LDA(At, 1, 0); PG8_STAGE(PG8_SA(0, 1), a2 + hstep, voffA);
            PG8_WAIT_L(8); PG8_BAR; PG8_WAIT_L(0); PG8_MMA(0, 0, At, B0); PG8_BAR; PG8_SCHED;
            PG8_LDB(B1, 1, 1); PG8_STAGE(PG8_SB(1, 0), b3, voffB);
            PG8_BAR; PG8_WAIT_L(0); PG8_MMA(0, 1, At, B1); PG8_BAR;
            PG8_LDA(At, 1, 1); PG8_STAGE(PG8_SA(1, 0), a3, voffA);
            PG8_BAR; PG8_WAIT_L(0); PG8_MMA(1, 0, At, B0); PG8_BAR; PG8_SCHED;
            PG8_STAGE(PG8_SB(1, 1), b3 + hstep, voffB);
            PG8_WAIT_V(6); PG8_BAR; PG8_MMA(1, 1, At, B1); PG8_BAR;
        }
        PG8_STAMP();
        if constexpr (!Epi::AFTER_DRAIN) { E(acc, cur, wr, wc, fr, fq); S.done(cur); }
        PG8_STAMP();
        if (!has_next) break;
#pragma unroll
        for (int a = 0; a < 2; ++a)
#pragma unroll
            for (int b = 0; b < 2; ++b)
#pragma unroll
                for (int m = 0; m < 4; ++m)
#pragma unroll
                    for (int n = 0; n < 2; ++n) acc[a][b][m][n] = (f32x4){0.f, 0.f, 0.f, 0.f};
        cur = nxt; cA = nA; cB = nB; ++ui;
    }
    PG8_WAIT_V(0);
    if (wr == 0) PG8_BAR;
    PG8_BAR;
    if constexpr (Epi::AFTER_DRAIN) { E.fused(acc, cur, wr, wc, fr, fq, lds, wid, lane); S.done(cur); }
    PG8_STAMP();
    if (STAMP && wid == 0) { stamps[lane] = lane < nts ? (((unsigned long long)(unsigned)ts_hi << 32) | (unsigned)ts_lo) : 0ull;
        if (lane == 62) stamps[62] = rt_entry; if (lane == 63) stamps[63] = (unsigned long long)wall_clock64(); }
#undef PG8_STAMP
#undef PG8_SA
#undef PG8_SB
#undef PG8_STAGE
#undef PG8_LDA
#undef PG8_LDB
#undef PG8_MMA
#undef PG8_WAIT_V
#undef PG8_WAIT_L
#undef PG8_BAR
#undef PG8_SCHED
}
}

DEVI uint4 pack8(const pg8::f32x4 a, const pg8::f32x4 b) { return make_uint4(pack2(a[0], a[1]), pack2(a[2], a[3]), pack2(b[0], b[1]), pack2(b[2], b[3])); }

constexpr int P1_N = IN_WP;
struct EpiInProj {
    static constexpr bool PERM = true, AFTER_DRAIN = false;
    unsigned char* ws;
    __device__ __forceinline__ void operator()(const pg8::f32x4 (&acc)[2][2][4][2], const pg8::Unit& u, int wr, int wc, int fr, int fq) const {
        const int row0 = u.pm * 256 + wr * 64 + fr;
        const int pn = u.pn;
        const int cl0 = wc * 32 + 8 * fq;
        bf16_t* dst; int ld, cbase, kind;
        if (pn < 2)       { dst = reinterpret_cast<bf16_t*>(ws + OFF_HQ);  ld = 512; cbase = pn * 256;        kind = 1; }
        else if (pn < 4)  { dst = reinterpret_cast<bf16_t*>(ws + OFF_HLF); ld = 512; cbase = (pn - 2) * 256;  kind = 2; }
        else if (pn < 6)  { dst = reinterpret_cast<bf16_t*>(ws + OFF_HV);  ld = 512; cbase = (pn - 4) * 256;  kind = 0; }
        else if (pn < 8)  { dst = reinterpret_cast<bf16_t*>(ws + OFF_HG);  ld = 512; cbase = (pn - 6) * 256;  kind = 1; }
        else if (pn == 8) { dst = reinterpret_cast<bf16_t*>(ws + OFF_GQ);  ld = 256; cbase = 0;               kind = 3; }
        else if (pn == 9) { dst = reinterpret_cast<bf16_t*>(ws + OFF_GK);  ld = 256; cbase = 0;               kind = 0; }
        else if (pn < 12) { dst = reinterpret_cast<bf16_t*>(ws + OFF_GV);  ld = 512; cbase = (pn - 10) * 256; kind = 0; }
        else if (pn < 14) { dst = reinterpret_cast<bf16_t*>(ws + OFF_GG);  ld = 512; cbase = (pn - 12) * 256; kind = 1; }
        else {
            if (wc == 0 && fq < 2) {
                float* gl = reinterpret_cast<float*>(ws + OFF_GLOW);
#pragma unroll
                for (int ai = 0; ai < 2; ++ai)
#pragma unroll
                    for (int m = 0; m < 4; ++m) {
                        float* rp = gl + (size_t)(row0 + ai * 128 + m * 16) * 16 + 8 * fq;
                        *reinterpret_cast<pg8::f32x4*>(rp) = acc[ai][0][m][0];
                        *reinterpret_cast<pg8::f32x4*>(rp + 4) = acc[ai][0][m][1];
                    }
            }
            return;
        }
        float lbv[2][8];
#pragma unroll
        for (int bj = 0; bj < 2; ++bj)
#pragma unroll
            for (int j = 0; j < 8; ++j) lbv[bj][j] = 0.f;
        if (kind == 2) {
            const float* lb = reinterpret_cast<const float*>(ws + OFF_LB);
#pragma unroll
            for (int bj = 0; bj < 2; ++bj)
#pragma unroll
                for (int j = 0; j < 8; ++j) lbv[bj][j] = lb[cbase + bj * 128 + cl0 + j];
        }
#pragma unroll
        for (int ai = 0; ai < 2; ++ai)
#pragma unroll
            for (int m = 0; m < 4; ++m) {
                bf16_t* rowp = dst + (size_t)(row0 + ai * 128 + m * 16) * ld + cbase + cl0;
#pragma unroll
                for (int bj = 0; bj < 2; ++bj) {
                    pg8::f32x4 v0 = acc[ai][bj][m][0], v1 = acc[ai][bj][m][1];
                    if (kind == 1) {
#pragma unroll
                        for (int j = 0; j < 4; ++j) { v0[j] = silu_f(v0[j]); v1[j] = silu_f(v1[j]); }
                    } else if (kind == 2) {
#pragma unroll
                        for (int j = 0; j < 4; ++j) {
                            const float l0 = lbv[bj][j], l1 = lbv[bj][4 + j];
                            v0[j] = __logf(l0 + (1.f - l0) * __builtin_amdgcn_rcpf(1.f + __expf(-v0[j])));
                            v1[j] = __logf(l1 + (1.f - l1) * __builtin_amdgcn_rcpf(1.f + __expf(-v1[j])));
                        }
                    } else if (kind == 3) {
#pragma unroll
                        for (int j = 0; j < 4; ++j) { v0[j] *= 0.125f; v1[j] *= 0.125f; }
                    }
                    *reinterpret_cast<uint4*>(rowp + bj * 128) = pack8(v0, v1);
                }
            }
    }
};
struct EpiOutProj {
    static constexpr bool PERM = true, AFTER_DRAIN = false;
    const float* x; bf16_t* h16;
    __device__ __forceinline__ void operator()(const pg8::f32x4 (&acc)[2][2][4][2], const pg8::Unit& u, int wr, int wc, int fr, int fq) const {
        const int row0 = u.pm * 256 + wr * 64 + fr, col0 = u.pn * 256 + wc * 32 + 8 * fq;
#pragma unroll
        for (int ai = 0; ai < 2; ++ai)
#pragma unroll
            for (int m = 0; m < 4; ++m) {
                const size_t ro = (size_t)(row0 + ai * 128 + m * 16) * DM + col0;
#pragma unroll
                for (int bj = 0; bj < 2; ++bj) {
                    const pg8::f32x4 x0 = *reinterpret_cast<const pg8::f32x4*>(x + ro + bj * 128), x1 = *reinterpret_cast<const pg8::f32x4*>(x + ro + bj * 128 + 4);
                    *reinterpret_cast<uint4*>(h16 + ro + bj * 128) = pack8(x0 + acc[ai][bj][m][0], x1 + acc[ai][bj][m][1]);
                }
            }
    }
};
struct EpiQ {
    static constexpr bool PERM = true, AFTER_DRAIN = false;
    bf16_t* Q;
    __device__ __forceinline__ void operator()(const pg8::f32x4 (&acc)[2][2][4][2], const pg8::Unit& u, int wr, int wc, int fr, int fq) const {
        const int row0 = u.pm * 256 + wr * 64 + fr, col0 = u.pn * 256 + wc * 32 + 8 * fq;
#pragma unroll
        for (int ai = 0; ai < 2; ++ai)
#pragma unroll
            for (int m = 0; m < 4; ++m) {
                bf16_t* rowp = Q + (size_t)(row0 + ai * 128 + m * 16) * 2048 + col0;
#pragma unroll
                for (int bj = 0; bj < 2; ++bj) *reinterpret_cast<uint4*>(rowp + bj * 128) = pack8(acc[ai][bj][m][0], acc[ai][bj][m][1]);
            }
    }
};
template <class Epi>
DEVI void run_gemm(const bf16_t* A, const bf16_t* Bt, int N, const Epi& E, char* smem) {
    pg8::Gemm g{A, Bt, M_TOK, N, 1024};
#if PROBE_GEMM_DUP
    struct DupOrder : pg8::StaticOrder { __host__ __device__ bool next(int i, pg8::Unit& u) const { return pg8::StaticOrder::next(i >> 1, u); } };
    DupOrder S; S.init(M_TOK, N, (int)gridDim.x, (int)blockIdx.x);
    pg8::gemm_phase<Epi, DupOrder, false>((PG8_LAS unsigned char*)smem, g, S, E, nullptr);
#else
    pg8::StaticOrder S; S.init(M_TOK, N, (int)gridDim.x, (int)blockIdx.x);
    pg8::gemm_phase<Epi, pg8::StaticOrder, false>((PG8_LAS unsigned char*)smem, g, S, E, nullptr);
#endif
    __builtin_amdgcn_s_waitcnt(0);
}

DEVI float logsigmoid_f(float z) { return fminf(z, 0.f) - __logf(1.f + __expf(-fabsf(z))); }

DEVI unsigned off_b(unsigned row, unsigned ch) { return 256u * row + 16u * (ch ^ (((row & 3u) << 2) | ((row >> 2) & 3u))); }
DEVI unsigned tr_addr16(unsigned lane, unsigned c, unsigned ks, unsigned t) {
    const unsigned g = lane >> 4, q = (lane & 15u) >> 2, pp = lane & 3u;
    return off_b(32u * ks + 8u * g + 4u * t + q, 2u * c + (pp >> 1)) + 8u * (pp & 1u);
}
typedef unsigned short u16x4_t __attribute__((ext_vector_type(4)));
DEVI bf16x8 tr_frag(unsigned base, unsigned lane, unsigned c, unsigned ks) {
    u16x4_t a, b;
    asm volatile("ds_read_b64_tr_b16 %0, %2\n\tds_read_b64_tr_b16 %1, %3\n\ts_waitcnt lgkmcnt(0)" : "=&v"(a), "=&v"(b) : "v"(base + tr_addr16(lane, c, ks, 0)), "v"(base + tr_addr16(lane, c, ks, 1)) : "memory");
    bf16x8 r;
    r[0] = (short)a[0]; r[1] = (short)a[1]; r[2] = (short)a[2]; r[3] = (short)a[3]; r[4] = (short)b[0]; r[5] = (short)b[1]; r[6] = (short)b[2]; r[7] = (short)b[3];
    return r;
}
DEVI bf16x8 row_frag(const char* tile, unsigned lane, unsigned rb, unsigned s) { return *reinterpret_cast<const bf16x8*>(tile + off_b((lane & 15u) + 16u * rb, 4u * s + (lane >> 4))); }
DEVI void fill_tile64(char* tile, const bf16_t* __restrict__ g, int ldg) {
#pragma unroll
    for (int i = 0; i < 4; ++i) {
        const int n = LTID + 256 * i, row = n >> 4, ch = n & 15;
        *reinterpret_cast<uint4*>(tile + off_b(row, ch)) = *reinterpret_cast<const uint4*>(g + (size_t)row * ldg + ch * 8);
    }
}
DEVI void fill_tile64x64(char* tile, const bf16_t* __restrict__ g, int ldg) {
#pragma unroll
    for (int i = 0; i < 2; ++i) {
        const int n = LTID + 256 * i, row = n >> 3, ch = n & 7;
        *reinterpret_cast<uint4*>(tile + off_b(row, ch)) = *reinterpret_cast<const uint4*>(g + (size_t)row * ldg + ch * 8);
    }
}

typedef unsigned gu32x4 __attribute__((ext_vector_type(4)));
typedef float gf32x4 __attribute__((ext_vector_type(4)));
template <int DK, bool KV> struct GPre;
template <bool KV> struct GPre<128, KV> { unsigned a[16], b[KV ? 1 : 16]; gu32x4 v[4]; };
template <bool KV> struct GPre<64, KV>  { unsigned a[8], b[KV ? 1 : 8]; gu32x4 v[4]; gf32x4 gl; float2 wg[16]; float2 bg; };

template <int N>
DEVI void dummy_stores(unsigned char* ws) {
    uint2* d = reinterpret_cast<uint2*>(ws + OFF_DUMMY) + (size_t)threadIdx.x * (2 * N);
#pragma unroll
    for (int i = 0; i < N; ++i) d[2 * i] = make_uint2(0u, 0u);
}

template <int DK, bool KV>
DEVI void gate_prefetch(const Params& p, int sidx, int c, GPre<DK, KV>& r) {
    unsigned char* ws = p.ws;
    int tid = LTID; asm volatile("" : "+v"(tid));
    const int b = sidx >> 2, h = sidx & 3;
    const size_t row0 = (size_t)(b * 128 + c) * 64;
    const bf16_t* A = reinterpret_cast<const bf16_t*>(ws + (DK == 128 ? OFF_HLF : OFF_GK)) + row0 * (4 * DK) + h * DK;
    const bf16_t* Q = reinterpret_cast<const bf16_t*>(ws + (DK == 128 ? OFF_HQ : OFF_GQ)) + row0 * (4 * DK) + h * DK;
    const bf16_t* V = reinterpret_cast<const bf16_t*>(ws + (DK == 128 ? OFF_HV : OFF_GV)) + row0 * 512 + h * 128;
    constexpr int NR = (DK == 128) ? 16 : 8;
    const int cp = (DK == 128) ? (tid & 63) : (tid & 31), rq = (DK == 128) ? (tid >> 6) : (tid >> 5);
#pragma unroll
    for (int i = 0; i < 4; ++i) { const int n = tid + 256 * i; r.v[i] = *reinterpret_cast<const gu32x4*>(V + (size_t)(n >> 4) * 512 + (n & 15) * 8); }
#pragma unroll
    for (int i = 0; i < NR; ++i) {
        r.a[i] = *reinterpret_cast<const unsigned*>(A + (size_t)(NR * rq + i) * (4 * DK) + 2 * cp);
        if (!KV) r.b[i] = *reinterpret_cast<const unsigned*>(Q + (size_t)(NR * rq + i) * (4 * DK) + 2 * cp);
    }
    if constexpr (DK == 64) {
        r.gl = reinterpret_cast<const gf32x4*>(ws + OFF_GLOW)[row0 * 4 + tid];
        const int col = h * 64 + 2 * cp;
#pragma unroll
        for (int j = 0; j < 16; ++j) r.wg[j] = *reinterpret_cast<const float2*>(p.gla_wg + j * 256 + col);
        r.bg = *reinterpret_cast<const float2*>(p.gla_bg + col);
    }
}

template <int DK, bool KV>
DEVI void gate_apply(GPre<DK, KV>& r, char* vtile, char* qtile, char* ktile, float* tot, float4* glt, float* __restrict__ decout) {
    int tid = LTID; asm volatile("" : "+v"(tid));
    constexpr int NR = (DK == 128) ? 16 : 8, NG = 64 / NR;
    const int cp = (DK == 128) ? (tid & 63) : (tid & 31), rq = (DK == 128) ? (tid >> 6) : (tid >> 5);
#pragma unroll
    for (int i = 0; i < 4; ++i) { const int n = tid + 256 * i; *reinterpret_cast<gu32x4*>(vtile + off_b((unsigned)(n >> 4), (unsigned)(n & 15))) = r.v[i]; }
    float l0[NR], l1[NR];
    if constexpr (DK == 128) {
#pragma unroll
        for (int i = 0; i < NR; ++i) { l0[i] = bflo(r.a[i]); l1[i] = bfhi(r.a[i]); }
    } else {
        reinterpret_cast<gf32x4*>(glt)[tid] = r.gl;
        __syncthreads();
#pragma unroll
        for (int i = 0; i < NR; ++i) {
            float z0 = r.bg.x, z1 = r.bg.y;
#pragma unroll
            for (int j = 0; j < 4; ++j) {
                const float4 t = glt[(NR * rq + i) * 4 + j];
                z0 += t.x * r.wg[4 * j].x + t.y * r.wg[4 * j + 1].x + t.z * r.wg[4 * j + 2].x + t.w * r.wg[4 * j + 3].x;
                z1 += t.x * r.wg[4 * j].y + t.y * r.wg[4 * j + 1].y + t.z * r.wg[4 * j + 2].y + t.w * r.wg[4 * j + 3].y;
            }
            l0[i] = logsigmoid_f(z0) * (1.f / 16.f); l1[i] = logsigmoid_f(z1) * (1.f / 16.f);
        }
    }
    float s0 = 0.f, s1 = 0.f;
#pragma unroll
    for (int i = 0; i < NR; ++i) { s0 += l0[i]; s1 += l1[i]; }
    *reinterpret_cast<float2*>(tot + rq * DK + 2 * cp) = make_float2(s0, s1);
    __syncthreads();
    float G0 = 0.f, G1 = 0.f, T0 = 0.f, T1 = 0.f;
#pragma unroll
    for (int k = 0; k < NG; ++k) {
        const float2 t = *reinterpret_cast<const float2*>(tot + k * DK + 2 * cp);
        T0 += t.x; T1 += t.y;
        if (k < rq) { G0 += t.x; G1 += t.y; }
    }
    if (KV && rq == 0) *reinterpret_cast<float2*>(decout + 2 * cp) = make_float2(__expf(T0), __expf(T1));
#pragma unroll
    for (int i = 0; i < NR; ++i) {
        G0 += l0[i]; G1 += l1[i];
        float k0, k1;
        if constexpr (DK == 128) { k0 = 1.f - __expf(l0[i]); k1 = 1.f - __expf(l1[i]); } else { k0 = bflo(r.a[i]); k1 = bfhi(r.a[i]); }
        const unsigned o = off_b((unsigned)(NR * rq + i), (unsigned)(cp >> 2)) + 4u * (unsigned)(cp & 3);
        if constexpr (KV) {
            *reinterpret_cast<unsigned*>(ktile + o) = pack2(k0 * __expf(T0 - G0), k1 * __expf(T1 - G1));
        } else {
            *reinterpret_cast<unsigned*>(qtile + o) = pack2(bflo(r.b[i]) * __expf(G0), bfhi(r.b[i]) * __expf(G1));
            *reinterpret_cast<unsigned*>(ktile + o) = pack2(k0 * __expf(-G0), k1 * __expf(-G1));
        }
    }
}

constexpr int P3_UNITS = 4096;
template <int DK>
DEVI void kv_unit(const Params& p, int sidx, int c, int nsidx, int nc, char* smem, GPre<DK, true>& pre) {
    unsigned char* ws = p.ws;
    const int lane = LTID & 63, w = LTID >> 6;
    const int b = sidx >> 2, h = sidx & 3;
    const int cidx = b * 128 + c;
    constexpr int NDB = DK / 16;
    float* DEC = reinterpret_cast<float*>(ws + (DK == 128 ? OFF_DECH : OFF_DECG)) + (size_t)cidx * (4 * DK) + h * DK;
    bf16_t* ST = reinterpret_cast<bf16_t*>(reinterpret_cast<unsigned char*>(p.out) + (DK == 128 ? OUT_STH : OUT_STG)) + ((size_t)sidx * 128 + c) * (128 * DK);
    f32x4 acc[NDB][2];
#pragma unroll
    for (int i = 0; i < NDB; ++i) { acc[i][0] = f32x4{0, 0, 0, 0}; acc[i][1] = f32x4{0, 0, 0, 0}; }
    const int fo = (lane & 15) * 64 + 8 * (lane >> 4);
    gate_apply<DK, true>(pre, smem, nullptr, smem + 16384, reinterpret_cast<float*>(smem + 32768), reinterpret_cast<float4*>(smem + 36864), DEC);
    gate_prefetch<DK, true>(p, nsidx, nc, pre);
    __syncthreads();
    const unsigned tbase = (unsigned)(size_t)smem, kbase = tbase + 16384u;
#pragma unroll
    for (int ks = 0; ks < 2; ++ks) {
        bf16x8 bv[2];
#pragma unroll
        for (int nb = 0; nb < 2; ++nb) bv[nb] = tr_frag(tbase, (unsigned)lane, (unsigned)(2 * w + nb), (unsigned)ks);
#pragma unroll
        for (int db = 0; db < NDB; ++db) {
            const bf16x8 ak = tr_frag(kbase, (unsigned)lane, (unsigned)db, (unsigned)ks);
            acc[db][0] = mfma16(ak, bv[0], acc[db][0]);
            acc[db][1] = mfma16(ak, bv[1], acc[db][1]);
        }
    }
#pragma unroll
    for (int db = 0; db < NDB; ++db) {
        const int d = db * 16 + 4 * (lane >> 4);
#pragma unroll
        for (int nb = 0; nb < 2; ++nb) {
            const int dv = 32 * w + nb * 16 + (lane & 15);
            uint2 o; o.x = pack2(acc[db][nb][0], acc[db][nb][1]); o.y = pack2(acc[db][nb][2], acc[db][nb][3]);
            *reinterpret_cast<uint2*>(ST + (size_t)dv * DK + d) = o;
        }
    }
    __syncthreads();
}
template <int DK>
DEVI void phase3_loop(const Params& p, int hb, char* hsm) {
    GPre<DK, true> pre;
    const int stride = (int)gridDim.x * 2;
    int v = (int)blockIdx.x * 2 + hb;
    if (v < 2048) { gate_prefetch<DK, true>(p, v >> 7, v & 127, pre); dummy_stores<DK / 8>(p.ws); }
    for (; v < 2048; v += stride) {
        const int nv = (v + stride < 2048) ? v + stride : v;
        kv_unit<DK>(p, v >> 7, v & 127, nv >> 7, nv & 127, hsm, pre);
    }
}

constexpr int P4_UNITS = 384;
template <bool DRY>
DEVI void phase4_unit_t(const Params& p, int u, char* smem) {
    unsigned char* ws = p.ws;
    int e = u * 256 + LTID;
    bf16_t* base; bf16_t* sbase; const float* dec; size_t cstride; int decstride;
    if (e < 65536) {
        const int sidx = e >> 12, rem = e & 4095, dv = rem >> 5, d4 = (rem & 31) * 4;
        const int b = sidx >> 2, h = sidx & 3;
        base = reinterpret_cast<bf16_t*>(reinterpret_cast<unsigned char*>(p.out) + OUT_STH) + ((size_t)sidx * 128) * 16384 + dv * 128 + d4;
        sbase = DRY ? reinterpret_cast<bf16_t*>(ws + OFF_XN) + ((size_t)sidx * 128) * 16384 + dv * 128 + d4 : base;
        cstride = 16384;
        dec = reinterpret_cast<const float*>(ws + OFF_DECH) + (size_t)(b * 128) * 512 + h * 128 + d4; decstride = 512;
    } else {
        e -= 65536;
        const int sidx = e >> 11, rem = e & 2047, dv = rem >> 4, d4 = (rem & 15) * 4;
        const int b = sidx >> 2, h = sidx & 3;
        base = reinterpret_cast<bf16_t*>(reinterpret_cast<unsigned char*>(p.out) + OUT_STG) + ((size_t)sidx * 128) * 8192 + dv * 64 + d4;
        sbase = DRY ? reinterpret_cast<bf16_t*>(ws + OFF_KTH) + ((size_t)sidx * 128) * 8192 + dv * 64 + d4 : base;
        cstride = 8192;
        dec = reinterpret_cast<const float*>(ws + OFF_DECG) + (size_t)(b * 128) * 256 + h * 64 + d4; decstride = 256;
    }
    float s0 = 0.f, s1 = 0.f, s2 = 0.f, s3 = 0.f;
    for (int c8 = 0; c8 < 128; c8 += 8) {
        uint2 kv[8]; float4 dc[8];
#pragma unroll
        for (int i = 0; i < 8; ++i) { kv[i] = *reinterpret_cast<const uint2*>(base + (size_t)(c8 + i) * cstride); dc[i] = *reinterpret_cast<const float4*>(dec + (size_t)(c8 + i) * decstride); }
#pragma unroll
        for (int i = 0; i < 8; ++i) {
            uint2 o; o.x = pack2(s0, s1); o.y = pack2(s2, s3);
            *reinterpret_cast<uint2*>(sbase + (size_t)(c8 + i) * cstride) = o;
            s0 = dc[i].x * s0 + bflo(kv[i].x); s1 = dc[i].y * s1 + bfhi(kv[i].x);
            s2 = dc[i].z * s2 + bflo(kv[i].y); s3 = dc[i].w * s3 + bfhi(kv[i].y);
        }
    }
}

DEVI void phase4_unit(const Params& p, int u, char* smem) { phase4_unit_t<false>(p, u, smem); }
DEVI void phase4_dry_unit(const Params& p, int u, char* smem) { phase4_unit_t<true>(p, u, smem); }

constexpr int P5_UNITS = 4096;
constexpr int PL_PITCH = 72;
typedef unsigned gu32x2 __attribute__((ext_vector_type(2)));
template <int DK> struct OutRegs { GPre<DK, false> pre; bf16x8 ast[DK / 32][2]; gu32x2 gtv[4][2]; };
template <int DK>
DEVI void out_load_ast(const Params& p, int sidx, int c, OutRegs<DK>& R) {
    int tid = LTID; asm volatile("" : "+v"(tid));
    const int lane = tid & 63, w = tid >> 6, l15 = lane & 15, lg = lane >> 4;
    const bf16_t* ST = reinterpret_cast<const bf16_t*>(reinterpret_cast<const unsigned char*>(p.out) + (DK == 128 ? OUT_STH : OUT_STG)) + ((size_t)sidx * 128 + c) * (128 * DK);
#pragma unroll
    for (int ks = 0; ks < DK / 32; ++ks) {
#pragma unroll
        for (int x = 0; x < 2; ++x) R.ast[ks][x] = ldg_frag(ST + (size_t)((2 * w + x) * 16 + l15) * DK + ks * 32 + 8 * lg);
    }
}
template <int DK>
DEVI void out_load_gates(const Params& p, int sidx, int c, OutRegs<DK>& R) {
    int tid = LTID; asm volatile("" : "+v"(tid));
    const int lane = tid & 63, w = tid >> 6, l15 = lane & 15, lg = lane >> 4;
    const size_t row0 = (size_t)((sidx >> 2) * 128 + c) * 64;
    const bf16_t* GATE = reinterpret_cast<const bf16_t*>(p.ws + (DK == 128 ? OFF_HG : OFF_GG)) + row0 * 512 + (sidx & 3) * 128;
#pragma unroll
    for (int x = 0; x < 2; ++x) {
#pragma unroll
        for (int y = 0; y < 4; ++y) R.gtv[y][x] = *reinterpret_cast<const gu32x2*>(GATE + (size_t)(y * 16 + l15) * 512 + (2 * w + x) * 16 + 4 * lg);
    }
}
template <int DK>
DEVI void out_unit(const Params& p, int sidx, int c, int nsidx, int nc, char* smem, OutRegs<DK>& R, const float4 (&g4v)[2]) {
    unsigned char* ws = p.ws;
    const int lane = LTID & 63, w = LTID >> 6;
    const int b = sidx >> 2, h = sidx & 3;
    const int cidx = b * 128 + c;
    const size_t row0 = (size_t)cidx * 64;
    constexpr int LDQ = 4 * DK;
    bf16_t* MIX = reinterpret_cast<bf16_t*>(ws + OFF_MIX) + row0 * 1024 + (DK == 128 ? 0 : 512) + h * 128;
    bf16_t* PL = reinterpret_cast<bf16_t*>(smem);
    float* RED = reinterpret_cast<float*>(smem + 64 * PL_PITCH * 2);

    const int l15 = lane & 15, lg = lane >> 4;
    char* vtile = smem + 16384;
    char* qtile = smem + 32768;
    char* ktile = smem + 49152;
    gate_apply<DK, false>(R.pre, vtile, qtile, ktile, reinterpret_cast<float*>(smem + 10240), reinterpret_cast<float4*>(smem + 12288), nullptr);
    gate_prefetch<DK, false>(p, nsidx, nc, R.pre);
    __syncthreads();
    {
        bf16x8 bq[DK / 32];
#pragma unroll
        for (int ks = 0; ks < DK / 32; ++ks) bq[ks] = row_frag(qtile, (unsigned)lane, (unsigned)w, (unsigned)ks);
#pragma unroll
        for (int jb = 0; jb < 4; ++jb) {
            f32x4 a = f32x4{0, 0, 0, 0};
            if (jb <= w) {
#pragma unroll
                for (int ks = 0; ks < DK / 32; ++ks) {
                    const bf16x8 ak = row_frag(ktile, (unsigned)lane, (unsigned)jb, (unsigned)ks);
                    a = mfma16(ak, bq[ks], a);
                }
            }
            const int i = w * 16 + l15, j0 = jb * 16 + 4 * lg;
            const float v0 = (j0 + 0 <= i) ? a[0] : 0.f, v1 = (j0 + 1 <= i) ? a[1] : 0.f, v2 = (j0 + 2 <= i) ? a[2] : 0.f, v3 = (j0 + 3 <= i) ? a[3] : 0.f;
            uint2 o; o.x = pack2(v0, v1); o.y = pack2(v2, v3);
            *reinterpret_cast<uint2*>(PL + i * PL_PITCH + j0) = o;
        }
    }
    __syncthreads();
    f32x4 acc[2][4];
#pragma unroll
    for (int x = 0; x < 2; ++x)
#pragma unroll
        for (int y = 0; y < 4; ++y) acc[x][y] = f32x4{0, 0, 0, 0};
#pragma unroll
    for (int ks = 0; ks < 2; ++ks) {
        bf16x8 bp[4], avx[2];
#pragma unroll
        for (int x = 0; x < 2; ++x) avx[x] = tr_frag((unsigned)(size_t)vtile, (unsigned)lane, (unsigned)(2 * w + x), (unsigned)ks);
#pragma unroll
        for (int y = 0; y < 4; ++y) bp[y] = *reinterpret_cast<const bf16x8*>(PL + (y * 16 + l15) * PL_PITCH + ks * 32 + 8 * lg);
#pragma unroll
        for (int x = 0; x < 2; ++x)
#pragma unroll
            for (int y = 0; y < 4; ++y) acc[x][y] = mfma16(avx[x], bp[y], acc[x][y]);
    }
#pragma unroll
    for (int ks = 0; ks < DK / 32; ++ks) {
#pragma unroll
        for (int x = 0; x < 2; ++x)
#pragma unroll
            for (int y = 0; y < 4; ++y) acc[x][y] = mfma16(R.ast[ks][x], row_frag(qtile, (unsigned)lane, (unsigned)y, (unsigned)ks), acc[x][y]);
    }
    out_load_ast<DK>(p, nsidx, nc, R);
    float ssq[4];
#pragma unroll
    for (int y = 0; y < 4; ++y) {
        float s = 0.f;
#pragma unroll
        for (int x = 0; x < 2; ++x)
#pragma unroll
            for (int r = 0; r < 4; ++r) s += acc[x][y][r] * acc[x][y][r];
        s += __shfl_xor(s, 16); s += __shfl_xor(s, 32);
        ssq[y] = s;
    }
    if (lg == 0) {
#pragma unroll
        for (int y = 0; y < 4; ++y) RED[w * 64 + y * 16 + l15] = ssq[y];
    }
    __syncthreads();
#pragma unroll
    for (int y = 0; y < 4; ++y) {
        const int i = y * 16 + l15;
        const float tot = RED[i] + RED[64 + i] + RED[128 + i] + RED[192 + i];
        const float rstd = rsqrtf(tot * (1.f / 128.f) + 1e-6f);
#pragma unroll
        for (int x = 0; x < 2; ++x) {
            const int dv = (2 * w + x) * 16 + 4 * lg;
            const float4 g4 = g4v[x];
            const gu32x2 gt = R.gtv[y][x];
            uint2 o;
            o.x = pack2(acc[x][y][0] * rstd * g4.x * bflo(gt.x), acc[x][y][1] * rstd * g4.y * bfhi(gt.x));
            o.y = pack2(acc[x][y][2] * rstd * g4.z * bflo(gt.y), acc[x][y][3] * rstd * g4.w * bfhi(gt.y));
            *reinterpret_cast<uint2*>(MIX + (size_t)i * 1024 + dv) = o;
        }
    }
    out_load_gates<DK>(p, nsidx, nc, R);
    __syncthreads();
}
template <int DK>
DEVI void phase5_loop(const Params& p, int hb, char* hsm) {
    OutRegs<DK> R;
    const int stride = (int)gridDim.x * 2;
    int v = (int)blockIdx.x * 2 + hb;
    const int lane = LTID & 63, w = LTID >> 6;
    const float* ng = (DK == 128) ? p.hg_norm_g : p.gla_norm_g;
    const float4 g4v[2] = {*reinterpret_cast<const float4*>(ng + (2 * w) * 16 + 4 * (lane >> 4)), *reinterpret_cast<const float4*>(ng + (2 * w + 1) * 16 + 4 * (lane >> 4))};
    if (v < 2048) {
        gate_prefetch<DK, false>(p, v >> 7, v & 127, R.pre); out_load_ast<DK>(p, v >> 7, v & 127, R); dummy_stores<8>(p.ws); out_load_gates<DK>(p, v >> 7, v & 127, R);
    }
    for (; v < 2048; v += stride) {
        const int nv = (v + stride < 2048) ? v + stride : v;
        out_unit<DK>(p, v >> 7, v & 127, nv >> 7, nv & 127, hsm, R, g4v);
    }
}

DEVI void rms_row16_bf16_i8(const bf16_t* __restrict__ xr, const float* __restrict__ g, bf16_t* __restrict__ dst, unsigned char* __restrict__ dst8, float* __restrict__ descale, int lane) {
    float v[2][8]; float ss = 0.f;
#pragma unroll
    for (int i = 0; i < 2; ++i) {
        const uint4 q = reinterpret_cast<const uint4*>(xr)[lane + 64 * i];
        v[i][0] = bflo(q.x); v[i][1] = bfhi(q.x); v[i][2] = bflo(q.y); v[i][3] = bfhi(q.y); v[i][4] = bflo(q.z); v[i][5] = bfhi(q.z); v[i][6] = bflo(q.w); v[i][7] = bfhi(q.w);
#pragma unroll
        for (int j = 0; j < 8; ++j) ss += v[i][j] * v[i][j];
    }
    ss = wave_sum(ss);
    const float r = rsqrtf(ss * (1.f / 1024.f) + 1e-6f);
    float am = 0.f;
#pragma unroll
    for (int i = 0; i < 2; ++i) {
        const float4 g0 = reinterpret_cast<const float4*>(g)[2 * (lane + 64 * i)], g1 = reinterpret_cast<const float4*>(g)[2 * (lane + 64 * i) + 1];
        v[i][0] *= r * g0.x; v[i][1] *= r * g0.y; v[i][2] *= r * g0.z; v[i][3] *= r * g0.w; v[i][4] *= r * g1.x; v[i][5] *= r * g1.y; v[i][6] *= r * g1.z; v[i][7] *= r * g1.w;
        reinterpret_cast<uint4*>(dst)[lane + 64 * i] = make_uint4(pack2(v[i][0], v[i][1]), pack2(v[i][2], v[i][3]), pack2(v[i][4], v[i][5]), pack2(v[i][6], v[i][7]));
#pragma unroll
        for (int j = 0; j < 8; ++j) am = fmaxf(am, fabsf(v[i][j]));
    }
    am = wave_max(am);
    const float sc = am > 0.f ? 127.f / am : 1.f;
#pragma unroll
    for (int i = 0; i < 2; ++i)
        reinterpret_cast<int2*>(dst8)[lane + 64 * i] = make_int2(pack_i8x4(v[i][0] * sc, v[i][1] * sc, v[i][2] * sc, v[i][3] * sc), pack_i8x4(v[i][4] * sc, v[i][5] * sc, v[i][6] * sc, v[i][7] * sc));
    if (lane == 0) *descale = am > 0.f ? am * (1.f / 127.f) : 1.f;
}
constexpr int P7_UNITS = 8192;
DEVI void phase7_unit(const Params& p, int u, char* smem) {
    const int lane = LTID & 63, w = LTID >> 6;
    const int row = u * 4 + w;
    rms_row16_bf16_i8(reinterpret_cast<const bf16_t*>(p.ws + OFF_H16) + (size_t)row * DM, p.norm2_g, reinterpret_cast<bf16_t*>(p.ws + OFF_HN) + (size_t)row * DM,
                      p.ws + OFF_HN8 + (size_t)row * DM, reinterpret_cast<float*>(p.ws + OFF_HS) + row, lane);
}

using f32x16 = __attribute__((ext_vector_type(16))) float;
DEVI f32x16 mfma32(bf16x8 a, bf16x8 b, f32x16 c) { return __builtin_amdgcn_mfma_f32_32x32x16_bf16(a, b, c, 0, 0, 0); }
DEVI unsigned umax(unsigned a, unsigned b) { return a > b ? a : b; }
DEVI unsigned umin(unsigned a, unsigned b) { return a > b ? b : a; }
DEVI unsigned f2ord(float f) { const unsigned u = __float_as_uint(f); return u ^ ((unsigned)((int)u >> 31) | 0x80000000u); }
DEVI float ord2f(unsigned k) { return __uint_as_float((k & 0x80000000u) ? (k ^ 0x80000000u) : ~k); }

template <int BASE>
DEVI void sort16_desc(unsigned (&x)[64]) {
#pragma unroll
    for (int k = 2; k <= 16; k <<= 1) {
#pragma unroll
        for (int j = k >> 1; j > 0; j >>= 1) {
#pragma unroll
            for (int i = 0; i < 16; ++i) {
                const int l = i ^ j;
                if (l > i) {
                    const bool desc = ((i & k) == 0);
                    const unsigned a = x[BASE + i], b = x[BASE + l];
                    const unsigned hi = umax(a, b), lo = umin(a, b);
                    x[BASE + i] = desc ? hi : lo; x[BASE + l] = desc ? lo : hi;
                }
            }
        }
    }
}
template <int BASE>
DEVI void bmerge16_desc(unsigned (&x)[64]) {
#pragma unroll
    for (int j = 8; j > 0; j >>= 1) {
#pragma unroll
        for (int i = 0; i < 16; ++i) {
            const int l = i ^ j;
            if (l > i) { const unsigned a = x[BASE + i], b = x[BASE + l]; x[BASE + i] = umax(a, b); x[BASE + l] = umin(a, b); }
        }
    }
}
DEVI void top16_of_64(unsigned (&x)[64]) {
    sort16_desc<0>(x); sort16_desc<16>(x); sort16_desc<32>(x); sort16_desc<48>(x);
#pragma unroll
    for (int i = 0; i < 16; ++i) x[i] = umax(x[i], x[31 - i]);
    bmerge16_desc<0>(x);
#pragma unroll
    for (int i = 0; i < 16; ++i) x[32 + i] = umax(x[32 + i], x[63 - i]);
    bmerge16_desc<32>(x);
#pragma unroll
    for (int i = 0; i < 16; ++i) x[i] = umax(x[i], x[47 - i]);
    bmerge16_desc<0>(x);
}

DEVI void scores_top16(const char* sktile, const bf16_t* __restrict__ Qp, int lane, unsigned (&out)[16]) {
    const int r31 = lane & 31, hh = lane >> 5;
    f32x16 acc[4];
#pragma unroll
    for (int nb = 0; nb < 4; ++nb)
#pragma unroll
        for (int r = 0; r < 16; ++r) acc[nb][r] = 0.f;
#pragma unroll
    for (int ks = 0; ks < 8; ++ks) {
        const bf16x8 bq = ldg_frag(Qp + (size_t)r31 * 2048 + ks * 16 + 8 * hh);
#pragma unroll
        for (int nb = 0; nb < 4; ++nb) {
            const bf16x8 ak = *reinterpret_cast<const bf16x8*>(sktile + off_b((unsigned)(nb * 32 + r31), (unsigned)(2 * ks + hh)));
            acc[nb] = mfma32(ak, bq, acc[nb]);
        }
    }
    unsigned x[64];
    const unsigned hx = (unsigned)hh * 4u;
#pragma unroll
    for (int nb = 0; nb < 4; ++nb)
#pragma unroll
        for (int r = 0; r < 16; ++r) {
            const int nbase = nb * 32 + (r & 3) + 8 * (r >> 2);
            x[nb * 16 + r] = ((f2ord(acc[nb][r]) & ~127u) | (unsigned)(127 - nbase)) ^ hx;
        }
    top16_of_64(x);
    unsigned lo[16], hi[16];
#pragma unroll
    for (int i = 0; i < 16; ++i) { auto rr = __builtin_amdgcn_permlane32_swap(x[i], x[i], false, false); lo[i] = rr[0]; hi[i] = rr[1]; }
#pragma unroll
    for (int i = 0; i < 16; ++i) x[i] = umax(lo[i], hi[15 - i]);
    bmerge16_desc<0>(x);
#pragma unroll
    for (int i = 0; i < 16; ++i) out[i] = x[i];
}

DEVI void phase9_block(const Params& p, char* smem) {
    unsigned char* ws = p.ws;
    const int tid = threadIdx.x, lane = tid & 63, w = tid >> 6;
    const int h = blockIdx.x & 7, rank = blockIdx.x >> 3, nrank = ((int)gridDim.x - h + 7) >> 3;
    const int hh = lane >> 5;
    {
        const bf16_t* SK = reinterpret_cast<const bf16_t*>(ws + OFF_SK) + (size_t)(h * 2) * 128 * 128;
#pragma unroll
        for (int i = 0; i < 8; ++i) {
            const int nn = tid + 512 * i, tl = nn >> 11, row = (nn >> 4) & 127, ch = nn & 15;
            *reinterpret_cast<uint4*>(smem + tl * 32768 + off_b((unsigned)row, (unsigned)ch)) = *reinterpret_cast<const uint4*>(SK + (size_t)tl * 16384 + row * 128 + ch * 8);
        }
    }
    __syncthreads();
    unsigned* KL = reinterpret_cast<unsigned*>(smem + 65536) + w * 2048;
    for (int it = rank; it < M_TOK / 256; it += nrank) {
    const int t0 = it * 256 + w * 32;
    const bf16_t* Q = reinterpret_cast<const bf16_t*>(ws + OFF_Q) + (size_t)t0 * 2048 + h * 256;
    unsigned k0[16], k1[16];
    scores_top16(smem, Q, lane, k0);
    scores_top16(smem + 32768, Q + 128, lane, k1);
#pragma unroll
    for (int i = 0; i < 16; ++i) { KL[i * 64 + lane] = k0[i]; KL[(16 + i) * 64 + lane] = k1[i]; }
    float s0[16], s1[16];
#pragma unroll
    for (int i = 0; i < 16; ++i) { s0[i] = ord2f(k0[i] & ~127u); s1[i] = ord2f(k1[i] & ~127u); }
    unsigned x[64];
    {
        int n = 0;
#pragma unroll
        for (int a = 0; a < 16; ++a)
#pragma unroll
            for (int b = 0; b < 16; ++b)
                if ((a + 1) * (b + 1) <= 16) { x[n] = (f2ord(s0[a] + s1[b]) & ~255u) | (unsigned)(255 - (a * 16 + b)); ++n; }
#pragma unroll
        for (int i = 50; i < 64; ++i) x[i] = 0u;
    }
    top16_of_64(x);
    float cv[16]; int ex[16];
#pragma unroll
    for (int i = 0; i < 16; ++i) {
        cv[i] = ord2f(x[i] & ~255u);
        const int cid = 255 - (int)(x[i] & 255u);
        const unsigned ka = KL[(cid >> 4) * 64 + lane], kb = KL[(16 + (cid & 15)) * 64 + lane];
        ex[i] = (127 - (int)(ka & 127u)) * 128 + (127 - (int)(kb & 127u));
    }
    float sum = 0.f;
    const float mx = cv[0];
#pragma unroll
    for (int i = 0; i < 16; ++i) cv[i] = __expf(cv[i] - mx);
#pragma unroll
    for (int i = 0; i < 16; ++i) sum += cv[i];
    const float inv = __builtin_amdgcn_rcpf(sum);
    const size_t orow = (size_t)(t0 + (lane & 31)) * 128 + h * 16;
    if (hh == 0) {
        int4* d = reinterpret_cast<int4*>(reinterpret_cast<int*>(ws + OFF_EIDX) + orow);
#pragma unroll
        for (int i = 0; i < 4; ++i) d[i] = make_int4(ex[4 * i], ex[4 * i + 1], ex[4 * i + 2], ex[4 * i + 3]);
        const float* US = reinterpret_cast<const float*>(ws + OFF_US);
        float4* du = reinterpret_cast<float4*>(reinterpret_cast<float*>(ws + OFF_EU) + orow);
#pragma unroll
        for (int i = 0; i < 4; ++i) du[i] = make_float4(US[ex[4 * i]], US[ex[4 * i + 1]], US[ex[4 * i + 2]], US[ex[4 * i + 3]]);
    } else {
        const float* VS = reinterpret_cast<const float*>(ws + OFF_VS);
        float4* d = reinterpret_cast<float4*>(reinterpret_cast<float*>(ws + OFF_EW) + orow);
#pragma unroll
        for (int i = 0; i < 4; ++i) d[i] = make_float4(cv[4 * i] * inv * VS[ex[4 * i]], cv[4 * i + 1] * inv * VS[ex[4 * i + 1]], cv[4 * i + 2] * inv * VS[ex[4 * i + 2]], cv[4 * i + 3] * inv * VS[ex[4 * i + 3]]);
        }
}
}

typedef _Float16 h2_t __attribute__((ext_vector_type(2)));
DEVI float sum8(float v) { v += dpp_f<0xB1>(v); v += dpp_f<0x4E>(v); v += dpp_f<0x141>(v); return v; }
DEVI float sum64(float v) {
    v = sum8(v); v += dpp_f<0x128>(v);
    { auto s = __builtin_amdgcn_permlane16_swap(__float_as_uint(v), __float_as_uint(v), false, false); v = __uint_as_float(s[0]) + __uint_as_float(s[1]); }
    { auto s = __builtin_amdgcn_permlane32_swap(__float_as_uint(v), __float_as_uint(v), false, false); v = __uint_as_float(s[0]) + __uint_as_float(s[1]); }
    return v;
}
DEVI long pack_i64(unsigned lo, unsigned hi) { return (long)(((unsigned long long)hi << 32) | (unsigned long long)lo); }

#define SB __builtin_amdgcn_sched_barrier(0)
#define SB __builtin_amdgcn_sched_barrier(0)
#define PIN4(Q) "+v"(Q.x), "+v"(Q.y), "+v"(Q.z), "+v"(Q.w)
DEVI void phase10a_block(const Params& p, char* smem) {
    unsigned char* ws = p.ws;
    const int s = blockIdx.x & 7, rank = blockIdx.x >> 3, nrank = ((int)gridDim.x - s + 7) >> 3;
    const int lane = threadIdx.x & 63, wave = threadIdx.x >> 6;
    const int lg = lane & 7, grp = lane >> 3;
    const unsigned char* U8 = ws + OFF_U8 + (size_t)s * (16384 * 128);
    const unsigned char* HNs = ws + OFF_HN8 + 128 * s + 16 * lg;
    unsigned* PD = reinterpret_cast<unsigned*>(ws + OFF_PD) + (size_t)s * M_TOK * 64;
    float* stg = reinterpret_cast<float*>(smem) + wave * (16 * 128);
    constexpr int NTG = M_TOK / 8;
#define P10A_LOAD_EV(TG, E) do { const int4* _q = reinterpret_cast<const int4*>(reinterpret_cast<const int*>(ws + OFF_EIDX) + (size_t)((TG) * 8 + wave) * 128 + 16 * grp); \
        E[0] = _q[0]; E[1] = _q[1]; E[2] = _q[2]; E[3] = _q[3]; } while (0)
#define P10A_LOAD_ROWS(TG, E, R, HA) do { \
        asm volatile("" : PIN4(E[0]), PIN4(E[1]), PIN4(E[2]), PIN4(E[3])); \
        const int _e[16] = {E[0].x, E[0].y, E[0].z, E[0].w, E[1].x, E[1].y, E[1].z, E[1].w, E[2].x, E[2].y, E[2].z, E[2].w, E[3].x, E[3].y, E[3].z, E[3].w}; \
        _Pragma("unroll") for (int _i = 0; _i < 16; ++_i) R[_i] = *reinterpret_cast<const uint4*>(U8 + ((unsigned)_e[_i] * 128u + 16u * (unsigned)lg)); \
        HA = *reinterpret_cast<const uint4*>(HNs + (size_t)((TG) * 8 + wave) * DM); } while (0)
#define P10A_COMPUTE(SLOT, R, HA) do { \
        asm volatile("" : PIN4(R[0]), PIN4(R[1]), PIN4(R[2]), PIN4(R[3]), PIN4(R[4]), PIN4(R[5])); \
        asm volatile("" : PIN4(R[6]), PIN4(R[7]), PIN4(R[8]), PIN4(R[9]), PIN4(R[10]), PIN4(R[11])); \
        asm volatile("" : PIN4(R[12]), PIN4(R[13]), PIN4(R[14]), PIN4(R[15]), PIN4(HA)); \
        int _v1 = 0, _v2 = 0; \
        _Pragma("unroll") for (int _i = 0; _i < 16; ++_i) { \
            int _a = __builtin_amdgcn_sdot4((int)R[_i].x, (int)HA.x, 0, false); \
            _a = __builtin_amdgcn_sdot4((int)R[_i].y, (int)HA.y, _a, false); \
            _a = __builtin_amdgcn_sdot4((int)R[_i].z, (int)HA.z, _a, false); \
            _a = __builtin_amdgcn_sdot4((int)R[_i].w, (int)HA.w, _a, false); \
            _a += __builtin_amdgcn_mov_dpp(_a, 0xB1, 0xf, 0xf, true); _a += __builtin_amdgcn_mov_dpp(_a, 0x4E, 0xf, 0xf, true); _a += __builtin_amdgcn_mov_dpp(_a, 0x141, 0xf, 0xf, true); \
            if (_i < 8) _v1 = (lg == _i) ? _a : _v1; else _v2 = (lg == _i - 8) ? _a : _v2; } \
        stg[(SLOT) * 128 + 16 * grp + lg] = (float)_v1; stg[(SLOT) * 128 + 16 * grp + 8 + lg] = (float)_v2; } while (0)
    int4 eA[4], eB[4], eC[4]; uint4 rA[16], rB[16]; uint4 hA0, hB0;
    if (rank >= NTG) return;
    const int ntok = (NTG - rank + nrank - 1) / nrank;
#define TGI(I) (rank + ((I) < ntok ? (I) : ntok - 1) * nrank)
    P10A_LOAD_EV(TGI(0), eA);
    SB; P10A_LOAD_EV(TGI(1), eB);
    SB; P10A_LOAD_ROWS(TGI(0), eA, rA, hA0);
    SB;
    for (int base = 0; base < ntok; base += 16) {
#pragma unroll 1
        for (int i = base; i < base + 16; i += 2) {
            SB; P10A_LOAD_EV(TGI(i + 2), eC);
            SB; P10A_LOAD_ROWS(TGI(i + 1), eB, rB, hB0);
            SB; P10A_COMPUTE(i - base, rA, hA0);
            SB; P10A_LOAD_EV(TGI(i + 3), eB);
            SB; P10A_LOAD_ROWS(TGI(i + 2), eC, rA, hA0);
            SB; P10A_COMPUTE(i + 1 - base, rB, hB0);
            SB;
        }
#pragma unroll 4
        for (int j = 0; j < 16; ++j) {
            const float2 v = *reinterpret_cast<const float2*>(stg + j * 128 + 2 * lane);
            PD[(size_t)(TGI(base + j) * 8 + wave) * 64 + lane] = pack2(v.x, v.y);
        }
        __builtin_amdgcn_s_waitcnt(0x0F70);
    }
#undef TGI
#undef P10A_LOAD_EV
#undef P10A_LOAD_ROWS
#undef P10A_COMPUTE
}

DEVI void phase10w_block(const Params& p) {
    unsigned char* ws = p.ws;
    const int lane = threadIdx.x & 63, wave = threadIdx.x >> 6;
    const unsigned* PD = reinterpret_cast<const unsigned*>(ws + OFF_PD);
    const float* HS = reinterpret_cast<const float*>(ws + OFF_HS);
    for (int t = blockIdx.x * 8 + wave; t < M_TOK; t += gridDim.x * 8) {
        unsigned pd[8];
#pragma unroll
        for (int sl = 0; sl < 8; ++sl) pd[sl] = PD[((size_t)sl * M_TOK + t) * 64 + lane];
        const float2 uu = reinterpret_cast<const float2*>(ws + OFF_EU)[(size_t)t * 64 + lane];
        const float2 gg = reinterpret_cast<const float2*>(ws + OFF_EW)[(size_t)t * 64 + lane];
        const float hs = HS[t];
        float d0 = 0.f, d1 = 0.f;
#pragma unroll
        for (int sl = 0; sl < 8; ++sl) { d0 += bflo(pd[sl]); d1 += bfhi(pd[sl]); }
        d0 *= uu.x * hs; d1 *= uu.y * hs;
        const _Float16 w0 = (_Float16)(gg.x * 0.5f * d0 * (1.f + erff(d0 * 0.70710678118654752f))), w1 = (_Float16)(gg.y * 0.5f * d1 * (1.f + erff(d1 * 0.70710678118654752f)));
        const h2_t p0 = h2_t{w0, w0}, p1 = h2_t{w1, w1};
        reinterpret_cast<uint2*>(ws + OFF_W16)[(size_t)t * 64 + lane] = make_uint2(__builtin_bit_cast(unsigned, p0), __builtin_bit_cast(unsigned, p1));
    }
}

template <bool DRY>
DEVI void phase10b_block(const Params& p, char* smem) {
    unsigned char* ws = p.ws;
    const int s = blockIdx.x & 7, rank = blockIdx.x >> 3, nrank = ((int)gridDim.x - s + 7) >> 3;
    const int lane = threadIdx.x & 63, wave = threadIdx.x >> 6;
    const int lg = lane & 7, grp = lane >> 3;
    const unsigned char* V8 = ws + OFF_V8 + (size_t)s * (16384 * 128);
    float* stg = reinterpret_cast<float*>(smem) + wave * (16 * 128);
    constexpr int NTG = M_TOK / 8;
#define P10B_LOAD_EV(TG, E) do { const int4* _q = reinterpret_cast<const int4*>(reinterpret_cast<const int*>(ws + OFF_EIDX) + (size_t)((TG) * 8 + wave) * 128 + 16 * grp); \
        E[0] = _q[0]; E[1] = _q[1]; E[2] = _q[2]; E[3] = _q[3]; } while (0)
#define P10B_LOAD_ROWS(TG, E, R, WA, WB, WC, WD) do { \
        asm volatile("" : PIN4(E[0]), PIN4(E[1]), PIN4(E[2]), PIN4(E[3])); \
        const int _e[16] = {E[0].x, E[0].y, E[0].z, E[0].w, E[1].x, E[1].y, E[1].z, E[1].w, E[2].x, E[2].y, E[2].z, E[2].w, E[3].x, E[3].y, E[3].z, E[3].w}; \
        _Pragma("unroll") for (int _i = 0; _i < 16; ++_i) R[_i] = *reinterpret_cast<const uint4*>(V8 + ((unsigned)_e[_i] * 128u + 16u * (unsigned)lg)); \
        const uint4* _w = reinterpret_cast<const uint4*>(reinterpret_cast<const unsigned*>(ws + OFF_W16) + (size_t)((TG) * 8 + wave) * 128 + 16 * grp); WA = _w[0]; WB = _w[1]; WC = _w[2]; WD = _w[3]; } while (0)
#define P10B_COMPUTE(SLOT, R, WA, WB, WC, WD) do { \
          \
        asm volatile("" : PIN4(R[0]), PIN4(R[1]), PIN4(R[2]), PIN4(R[3]), PIN4(R[4]), PIN4(R[5])); \
        asm volatile("" : PIN4(R[6]), PIN4(R[7]), PIN4(R[8]), PIN4(R[9]), PIN4(R[10]), PIN4(R[11])); \
        asm volatile("" : PIN4(R[12]), PIN4(R[13]), PIN4(R[14]), PIN4(R[15]), PIN4(WA), PIN4(WB)); \
        asm volatile("" : PIN4(WC), PIN4(WD)); \
        const unsigned _ww[16] = {WA.x, WA.y, WA.z, WA.w, WB.x, WB.y, WB.z, WB.w, WC.x, WC.y, WC.z, WC.w, WD.x, WD.y, WD.z, WD.w}; \
        h2_t _acc[8]; unsigned _zb; asm volatile("v_mov_b32 %0, 0" : "=v"(_zb)); \
        _Pragma("unroll") for (int _j = 0; _j < 8; ++_j) _acc[_j] = __builtin_bit_cast(h2_t, _zb); \
        _Pragma("unroll") for (int _i = 0; _i < 16; ++_i) { \
            const h2_t _wp = __builtin_bit_cast(h2_t, _ww[_i]); \
            const unsigned _wd[4] = {R[_i].x, R[_i].y, R[_i].z, R[_i].w}; \
            _Pragma("unroll") for (int _j = 0; _j < 4; ++_j) { \
                _acc[2 * _j] += _wp * __builtin_amdgcn_cvt_scalef32_pk_f16_fp8((int)_wd[_j], 1.0f, false); \
                _acc[2 * _j + 1] += _wp * __builtin_amdgcn_cvt_scalef32_pk_f16_fp8((int)_wd[_j], 1.0f, true); } } \
          \
          \
        h2_t _r5[4], _r4[2]; \
        _Pragma("unroll") for (int _j = 0; _j < 4; ++_j) { auto _s = __builtin_amdgcn_permlane32_swap(__builtin_bit_cast(unsigned, _acc[_j]), __builtin_bit_cast(unsigned, _acc[_j + 4]), false, false); \
            _r5[_j] = __builtin_bit_cast(h2_t, (unsigned)_s[0]) + __builtin_bit_cast(h2_t, (unsigned)_s[1]); } \
        _Pragma("unroll") for (int _j = 0; _j < 2; ++_j) { auto _s = __builtin_amdgcn_permlane16_swap(__builtin_bit_cast(unsigned, _r5[_j]), __builtin_bit_cast(unsigned, _r5[_j + 2]), false, false); \
            _r4[_j] = __builtin_bit_cast(h2_t, (unsigned)_s[0]) + __builtin_bit_cast(h2_t, (unsigned)_s[1]); } \
        { const bool _b3 = (lane & 8) != 0; \
          const unsigned _send = _b3 ? __builtin_bit_cast(unsigned, _r4[0]) : __builtin_bit_cast(unsigned, _r4[1]); \
          const h2_t _keep = _b3 ? _r4[1] : _r4[0]; \
          const h2_t _res = _keep + __builtin_bit_cast(h2_t, __builtin_amdgcn_mov_dpp((int)_send, 0x128, 0xf, 0xf, true));     \
          *reinterpret_cast<float2*>(stg + (SLOT) * 128 + 16 * lg + 2 * grp) = make_float2((float)_res[0], (float)_res[1]); } } while (0)
    int4 eA[4], eB[4], eC[4]; uint4 rA[16], rB[16]; uint4 wA0, wA1, wA2, wA3, wB0, wB1, wB2, wB3;
    if (rank >= NTG) return;
    const int ntok = (NTG - rank + nrank - 1) / nrank;
#define TGI(I) (rank + ((I) < ntok ? (I) : ntok - 1) * nrank)
    P10B_LOAD_EV(TGI(0), eA);
    SB; P10B_LOAD_EV(TGI(1), eB);
    SB; P10B_LOAD_ROWS(TGI(0), eA, rA, wA0, wA1, wA2, wA3);
    SB;
    for (int base = 0; base < ntok; base += 16) {
#pragma unroll 1
        for (int i = base; i < base + 16; i += 2) {
            SB; P10B_LOAD_EV(TGI(i + 2), eC);
            SB; P10B_LOAD_ROWS(TGI(i + 1), eB, rB, wB0, wB1, wB2, wB3);
            SB; P10B_COMPUTE(i - base, rA, wA0, wA1, wA2, wA3);
            SB; P10B_LOAD_EV(TGI(i + 3), eB);
            SB; P10B_LOAD_ROWS(TGI(i + 2), eC, rA, wA0, wA1, wA2, wA3);
            SB; P10B_COMPUTE(i + 1 - base, rB, wB0, wB1, wB2, wB3);
            SB;
        }
#pragma unroll 4
        for (int j = 0; j < 16; ++j) {
            const float2 v = *reinterpret_cast<const float2*>(stg + j * 128 + 2 * lane);
            reinterpret_cast<unsigned*>(ws + OFF_PEER)[(DRY ? (size_t)M_TOK * 512 : 0) + (size_t)(TGI(base + j) * 8 + wave) * 512 + 64 * s + lane] = pack2(v.x, v.y);
        }
        __builtin_amdgcn_s_waitcnt(0x0F70);
    }
#undef TGI
#undef P10B_LOAD_EV
#undef P10B_LOAD_ROWS
#undef P10B_COMPUTE
}

DEVI void phase10c_block(const Params& p) {
    unsigned char* ws = p.ws;
    const int lane = threadIdx.x & 63, wave = threadIdx.x >> 6;
    const float4* gf = reinterpret_cast<const float4*>(p.norm_f_g);
    for (int t = blockIdx.x * 8 + wave; t < M_TOK; t += gridDim.x * 8) {
        const uint4* hrow = reinterpret_cast<const uint4*>(ws + OFF_H16) + (size_t)t * 128;
        const uint4* prow = reinterpret_cast<const uint4*>(ws + OFF_PEER) + (size_t)t * 128;
        float4* orow = reinterpret_cast<float4*>(p.out + (size_t)t * DM);
        uint4 hq[2], pq[2];
#pragma unroll
        for (int i = 0; i < 2; ++i) { hq[i] = hrow[lane + 64 * i]; pq[i] = prow[lane + 64 * i]; }
        float v[2][8]; float ss = 0.f;
#pragma unroll
        for (int i = 0; i < 2; ++i) {
            v[i][0] = bflo(hq[i].x) + bflo(pq[i].x); v[i][1] = bfhi(hq[i].x) + bfhi(pq[i].x); v[i][2] = bflo(hq[i].y) + bflo(pq[i].y); v[i][3] = bfhi(hq[i].y) + bfhi(pq[i].y);
            v[i][4] = bflo(hq[i].z) + bflo(pq[i].z); v[i][5] = bfhi(hq[i].z) + bfhi(pq[i].z); v[i][6] = bflo(hq[i].w) + bflo(pq[i].w); v[i][7] = bfhi(hq[i].w) + bfhi(pq[i].w);
#pragma unroll
            for (int j = 0; j < 8; ++j) ss += v[i][j] * v[i][j];
        }
        const float r = rsqrtf(wave_sum(ss) * (1.f / 1024.f) + 1e-6f);
#pragma unroll
        for (int i = 0; i < 2; ++i) {
            const float4 g0 = gf[2 * (lane + 64 * i)], g1 = gf[2 * (lane + 64 * i) + 1];
            orow[2 * (lane + 64 * i)] = make_float4(v[i][0] * r * g0.x, v[i][1] * r * g0.y, v[i][2] * r * g0.z, v[i][3] * r * g0.w);
            orow[2 * (lane + 64 * i) + 1] = make_float4(v[i][4] * r * g1.x, v[i][5] * r * g1.y, v[i][6] * r * g1.z, v[i][7] * r * g1.w);
        }
    }
}

#define XB_TMO      128
#define XB_XCNT(j)  (256  + 64 * (j))
#define XB_XSUB(j)  (1280 + 64 * (j))
#define XB_XGEN(j)  (2304 + 64 * (j))
#define XB_TOP      3328
#define XB_TOPGEN   3392
#define XCD_BAR_WORDS 3456
#define XB_SPIN_CAP (1u << 22)
#define LAS __attribute__((address_space(3)))
DEVI unsigned xb_ld(unsigned* p)              { return __hip_atomic_load(p, __ATOMIC_RELAXED, __HIP_MEMORY_SCOPE_AGENT); }
DEVI unsigned xb_add(unsigned* p, unsigned v) { return __hip_atomic_fetch_add(p, v, __ATOMIC_RELAXED, __HIP_MEMORY_SCOPE_AGENT); }
DEVI unsigned xb_xcc_id() { return (unsigned)__builtin_amdgcn_s_getreg((3 << 11) | 20) & 0xFu; }
#define XB_SPIN(cond, bar) do { unsigned _sp = 0; while (cond) { __builtin_amdgcn_s_sleep(1); \
    if ((++_sp & 255u) == 0u) { if (xb_ld(&(bar)[XB_TMO])) break; if (_sp > XB_SPIN_CAP) { atomicAdd(&(bar)[XB_TMO], 1u); break; } } } } while (0)
struct XcdBarrier { unsigned* bar; unsigned x; volatile LAS unsigned* st; };
DEVI XcdBarrier xcd_barrier_post(unsigned* bar, volatile LAS unsigned* st) {
    XcdBarrier b; b.bar = bar; b.x = xb_xcc_id(); b.st = st;
    if (threadIdx.x == 0) (void)xb_add(&bar[XB_XCNT(b.x)], 1u);
    return b;
}
DEVI void xcd_barrier_complete(unsigned* bar, unsigned x, unsigned& nloc, unsigned& nx) {
    const unsigned G = gridDim.x * gridDim.y * gridDim.z;
    unsigned sum, cnt, mine, sp = 0u;
    for (;;) {
        sum = 0u; cnt = 0u; mine = 0u;
#pragma unroll
        for (unsigned j = 0; j < 16; ++j) { const unsigned c = xb_ld(&bar[XB_XCNT(j)]); sum += c; cnt += (c > 0u) ? 1u : 0u; mine = (j == x) ? c : mine; }
        if (sum == G) break;
        __builtin_amdgcn_s_sleep(1);
        if ((++sp & 255u) == 0u) { if (xb_ld(&bar[XB_TMO])) break; if (sp > XB_SPIN_CAP) { atomicAdd(&bar[XB_TMO], 1u); break; } }
    }
    nloc = mine > 0u ? mine : 1u; nx = cnt > 0u ? cnt : 1u;
}
DEVI void xcd_barrier(const XcdBarrier& b) {
    asm volatile("s_waitcnt vmcnt(0)" ::: "memory");
    __syncthreads();
    if (threadIdx.x == 0) {
        unsigned* bar = b.bar;
        __builtin_amdgcn_s_waitcnt(0);
        unsigned nloc = b.st[0], nx = b.st[1];
        if (nloc == 0u) { xcd_barrier_complete(bar, b.x, nloc, nx); b.st[0] = nloc; b.st[1] = nx; }
        const unsigned old = xb_add(&bar[XB_XSUB(b.x)], 1u);
        const unsigned gen = old / nloc;
        if (old + 1u == (gen + 1u) * nloc) {
            __builtin_amdgcn_fence(__ATOMIC_RELEASE, "agent");
            asm volatile("s_waitcnt vmcnt(0)" ::: "memory");
            const unsigned og = xb_add(&bar[XB_TOP], 1u);
            const unsigned tg = og / nx;
            if (og + 1u == (tg + 1u) * nx) xb_add(&bar[XB_TOPGEN], 1u);
            else XB_SPIN(xb_ld(&bar[XB_TOPGEN]) == tg, bar);
            __builtin_amdgcn_fence(__ATOMIC_ACQUIRE, "agent");
            xb_add(&bar[XB_XGEN(b.x)], 1u);
            asm volatile("s_waitcnt vmcnt(0)" ::: "memory");
        } else {
            XB_SPIN(xb_ld(&bar[XB_XGEN(b.x)]) == gen, bar);
            __builtin_amdgcn_fence(__ATOMIC_ACQUIRE, "agent");
            asm volatile("s_waitcnt vmcnt(0)" ::: "memory");
        }
    }
    __syncthreads();
}

constexpr int N_PHASES = 11;
constexpr int LDS_PHASE_BYTES = 131072;
constexpr int LDS_BYTES = LDS_PHASE_BYTES + 16;

__global__ void __launch_bounds__(512, 2) hymba_fwd(Params p) {
    extern __shared__ __attribute__((aligned(16))) char smem[];
    cg::grid_group grid = cg::this_grid();
    const int lo = p.ph_lo, hi = p.ph_hi;
    volatile LAS unsigned* bst = (volatile LAS unsigned*)(smem + LDS_PHASE_BYTES);
    if (threadIdx.x == 0) { bst[0] = 0u; bst[1] = 0u; bst[2] = 0u; bst[3] = 0u; }
    __syncthreads();
    XcdBarrier xb = xcd_barrier_post(reinterpret_cast<unsigned*>(p.ws + OFF_BAR), bst);
    const int hb = (int)(threadIdx.x >> 8);
    char* hsm = smem + hb * 65536;
#define SEAM(K) if ((K) > lo) { if ((K) == lo + 1) grid.sync(); else xcd_barrier(xb); }
#define RUN_PHASE(K, FN, N) if (lo <= (K) && (K) < hi) { SEAM(K) for (int rep = 0; rep < 1 + ((PROBE_DUP >> (K)) & 1); ++rep) { if (rep) xcd_barrier(xb); \
        for (int ub = blockIdx.x * 2; ub < (N); ub += gridDim.x * 2) { const int u = ub + hb; if (u < (N)) FN(p, u, hsm); } } }
#define RUN_GEMM(K, CALL) if (lo <= (K) && (K) < hi) { SEAM(K) CALL; }
    RUN_PHASE(0, phase0_unit, P0_UNITS)
    RUN_GEMM(1, run_gemm(reinterpret_cast<const bf16_t*>(p.ws + OFF_XN), reinterpret_cast<const bf16_t*>(p.ws + OFF_WIN), P1_N, EpiInProj{p.ws}, smem))
    if (lo <= 3 && 3 < hi) { SEAM(3) phase3_loop<128>(p, hb, hsm); phase3_loop<64>(p, hb, hsm); }
#if PROBE_P4
    if (lo <= 4 && 4 < hi) { xcd_barrier(xb); for (int ub = blockIdx.x * 2; ub < P4_UNITS; ub += gridDim.x * 2) { const int u = ub + hb; if (u < P4_UNITS) phase4_dry_unit(p, u, hsm); } }
#endif
    RUN_PHASE(4, phase4_unit, P4_UNITS)
    if (lo <= 5 && 5 < hi) { SEAM(5) phase5_loop<128>(p, hb, hsm); phase5_loop<64>(p, hb, hsm); }
    RUN_GEMM(6, run_gemm(reinterpret_cast<const bf16_t*>(p.ws + OFF_MIX), reinterpret_cast<const bf16_t*>(p.ws + OFF_WOUT), 1024, EpiOutProj{p.x, reinterpret_cast<bf16_t*>(p.ws + OFF_H16)}, smem))
    RUN_PHASE(7, phase7_unit, P7_UNITS)
    RUN_GEMM(8, run_gemm(reinterpret_cast<const bf16_t*>(p.ws + OFF_HN), reinterpret_cast<const bf16_t*>(p.ws + OFF_WQ), 2048, EpiQ{reinterpret_cast<bf16_t*>(p.ws + OFF_Q)}, smem))
    RUN_GEMM(9, phase9_block(p, smem))
    if (lo <= 10 && 10 < hi) {
        SEAM(10)
#if PROBE_P10X == 4
        phase10a_block(p, smem); xcd_barrier(xb);
#endif
        phase10a_block(p, smem);
#if PROBE_P10X == 1
        xcd_barrier(xb); phase10a_block(p, smem);
#endif

        xcd_barrier(xb); phase10w_block(p);
#if PROBE_P10X == 2
        xcd_barrier(xb); phase10b_block<true>(p, smem);
#endif
        xcd_barrier(xb); phase10b_block<false>(p, smem);
        xcd_barrier(xb); phase10c_block(p);
#if PROBE_P10X == 3
        xcd_barrier(xb); phase10c_block(p);
#endif
    }
#undef RUN_PHASE
#undef RUN_GEMM
#undef SEAM
}

extern "C" void kernel_launch(void* const* d_in, const int* in_sizes, int n_in, void* d_out, int out_size, void* d_ws, size_t ws_size, hipStream_t stream) {
    static int grid_blocks = 0;
    if (grid_blocks == 0) {
        if (n_in != 15 || in_sizes[0] != M_TOK * DM || out_size != M_TOK * DM || ws_size < WS_NEED) {
            fprintf(stderr, "kernel_launch: unexpected shapes (n_in %d, in0 %d, out %d, ws %zu)\n", n_in, n_in > 0 ? in_sizes[0] : -1, out_size, ws_size);
            grid_blocks = -1; return;
        }
        int dev = 0, cus = 0, per_cu = 0;
        (void)hipGetDevice(&dev);
        (void)hipDeviceGetAttribute(&cus, hipDeviceAttributeMultiprocessorCount, dev);
        (void)hipFuncSetAttribute((const void*)hymba_fwd, hipFuncAttributeMaxDynamicSharedMemorySize, LDS_BYTES);
        (void)hipOccupancyMaxActiveBlocksPerMultiprocessor(&per_cu, (const void*)hymba_fwd, 512, LDS_BYTES);
        if (per_cu < 1) per_cu = 1;
        if (per_cu > 1) per_cu = 1;
        grid_blocks = cus * per_cu;
    }
    if (grid_blocks < 0) return;
    Params p{};
    p.x = (const float*)d_in[0]; p.norm1_g = (const float*)d_in[1]; p.w_in = (const float*)d_in[2]; p.hg_lower = (const float*)d_in[3];
    p.hg_norm_g = (const float*)d_in[4]; p.gla_wg = (const float*)d_in[5]; p.gla_bg = (const float*)d_in[6]; p.gla_norm_g = (const float*)d_in[7];
    p.w_out = (const float*)d_in[8]; p.norm2_g = (const float*)d_in[9]; p.w_q = (const float*)d_in[10]; p.sub_keys = (const float*)d_in[11];
    p.peer_u = (const float*)d_in[12]; p.peer_v = (const float*)d_in[13]; p.norm_f_g = (const float*)d_in[14];
    p.out = (float*)d_out; p.ws = (unsigned char*)d_ws;
#if N_LAUNCH_MODE == 1
    (void)hipMemsetAsync((unsigned char*)d_ws + OFF_BAR, 0, XCD_BAR_WORDS * 4, stream);
    p.ph_lo = 0; p.ph_hi = N_PHASES;
    void* args[] = {&p};
    hipError_t e = hipLaunchCooperativeKernel((const void*)hymba_fwd, dim3(grid_blocks), dim3(512), args, LDS_BYTES, stream);
    if (e != hipSuccess) fprintf(stderr, "cooperative launch failed: %s (grid %d)\n", hipGetErrorString(e), grid_blocks);
#else
    for (int ph = 0; ph < N_PHASES; ++ph) {
        p.ph_lo = ph; p.ph_hi = ph + 1;
        hipLaunchKernelGGL(hymba_fwd, dim3(grid_blocks), dim3(512), LDS_BYTES, stream, p);
    }
#endif
}
```

```cpp
#include <hip/hip_runtime.h>
#include <hip/hip_cooperative_groups.h>
#include <cstdio>
#include <cstdint>
namespace cg = cooperative_groups;

#ifndef N_LAUNCH_MODE
#define N_LAUNCH_MODE 1
#endif

#ifndef PROBE_DUP
#define PROBE_DUP 0
#endif
#ifndef PROBE_P10_DUP
#define PROBE_P10_DUP 0
#endif
#ifndef P10_SLICED
#define P10_SLICED 0
#endif
#ifndef PROBE_P10A
#define PROBE_P10A 0
#endif
#ifndef PROBE_P10_MASK
#define PROBE_P10_MASK 0x7fffffff
#endif
#ifndef PROBE_P10X
#define PROBE_P10X 0
#endif
#ifndef PROBE_P2T
#define PROBE_P2T 0
#endif
#ifndef PROBE_P4
#define PROBE_P4 0
#endif
#ifndef PROBE_P2G
#define PROBE_P2G 0
#endif
#ifndef PROBE_GEMM_DUP
#define PROBE_GEMM_DUP 0
#endif
#define DEVI __device__ __forceinline__
#define LTID ((int)(threadIdx.x & 255u))
typedef unsigned short bf16_t;
using bf16x8 = __attribute__((ext_vector_type(8))) short;
using f32x4 = __attribute__((ext_vector_type(4))) float;

constexpr int M_TOK = 32768;
constexpr int DM = 1024;
constexpr int IN_WP = 3840;
constexpr size_t MiB = 1024ull * 1024ull;

constexpr size_t OFF_XN   = 0;
constexpr size_t OFF_WIN  = 64 * MiB;
constexpr size_t OFF_WOUT = 72 * MiB;
constexpr size_t OFF_WQ   = 74 * MiB;
constexpr size_t OFF_SK   = 78 * MiB;
constexpr size_t OFF_LB   = 79 * MiB;
constexpr size_t OFF_U8   = 80 * MiB;
constexpr size_t OFF_V8   = 96 * MiB;
constexpr size_t OFF_US   = 112 * MiB;
constexpr size_t OFF_VS   = 113 * MiB;
constexpr size_t OFF_R2   = 144 * MiB;
constexpr size_t OFF_HQ   = OFF_R2;
constexpr size_t OFF_HLF  = OFF_R2 + 32 * MiB;
constexpr size_t OFF_HV   = OFF_R2 + 64 * MiB;
constexpr size_t OFF_HG   = OFF_R2 + 96 * MiB;
constexpr size_t OFF_GQ   = OFF_R2 + 128 * MiB;
constexpr size_t OFF_GK   = OFF_R2 + 144 * MiB;
constexpr size_t OFF_GV   = OFF_R2 + 160 * MiB;
constexpr size_t OFF_GG   = OFF_R2 + 192 * MiB;
constexpr size_t OFF_GLOW = OFF_R2 + 224 * MiB;
constexpr size_t OFF_KTH  = 370 * MiB;
constexpr size_t OFF_KTG  = 402 * MiB;
constexpr size_t OFF_DECH = 418 * MiB;
constexpr size_t OFF_DECG = 419 * MiB;
constexpr size_t OFF_HVT  = 420 * MiB;
constexpr size_t OFF_GVT  = 452 * MiB;
constexpr size_t OFF_H16  = OFF_HVT;
constexpr size_t OFF_DUMMY = 336 * MiB;
constexpr size_t OFF_BAR  = 484 * MiB;
constexpr size_t WS_NEED  = 485 * MiB;
constexpr size_t OFF_MIX  = OFF_XN;
constexpr size_t OFF_HN   = OFF_R2;
constexpr size_t OFF_Q    = OFF_R2 + 64 * MiB;
constexpr size_t OFF_EIDX = OFF_KTH;
constexpr size_t OFF_EW   = OFF_KTH + 16 * MiB;
constexpr size_t OFF_EU   = OFF_KTG;
constexpr size_t OFF_HN8  = OFF_XN;
constexpr size_t OFF_HS   = OFF_XN + 32 * MiB;
constexpr size_t OFF_W16  = OFF_XN + 48 * MiB;
constexpr size_t OFF_SSQ  = OFF_XN + 33 * MiB;
constexpr size_t OFF_PD   = OFF_Q;
constexpr size_t OFF_PEER = OFF_Q + 64 * MiB;
constexpr size_t OUT_STH = 0;
constexpr size_t OUT_STG = 64 * MiB;

struct Params {
    const float* x; const float* norm1_g; const float* w_in; const float* hg_lower; const float* hg_norm_g;
    const float* gla_wg; const float* gla_bg; const float* gla_norm_g; const float* w_out; const float* norm2_g;
    const float* w_q; const float* sub_keys; const float* peer_u; const float* peer_v; const float* norm_f_g;
    float* out; unsigned char* ws;
    int ph_lo, ph_hi;
};

DEVI unsigned short f2bf(float f) {
    unsigned u = __float_as_uint(f);
    u += 0x7fffu + ((u >> 16) & 1u);
    return (unsigned short)(u >> 16);
}
DEVI float bf2f(unsigned short b) { return __uint_as_float(((unsigned)b) << 16); }
DEVI unsigned pack2(float a, float b) { return (unsigned)f2bf(a) | ((unsigned)f2bf(b) << 16); }
DEVI float bflo(unsigned u) { return __uint_as_float(u << 16); }
DEVI float bfhi(unsigned u) { return __uint_as_float(u & 0xffff0000u); }
template <int CTRL> DEVI float dpp_f(float x) { return __builtin_bit_cast(float, __builtin_amdgcn_mov_dpp(__builtin_bit_cast(int, x), CTRL, 0xf, 0xf, true)); }
DEVI float wave_sum(float v) {
    v += dpp_f<0xB1>(v); v += dpp_f<0x4E>(v); v += dpp_f<0x141>(v); v += dpp_f<0x128>(v);
    { auto s = __builtin_amdgcn_permlane16_swap(__float_as_uint(v), __float_as_uint(v), false, false); v = __uint_as_float(s[0]) + __uint_as_float(s[1]); }
    { auto s = __builtin_amdgcn_permlane32_swap(__float_as_uint(v), __float_as_uint(v), false, false); v = __uint_as_float(s[0]) + __uint_as_float(s[1]); }
    return v;
}
DEVI float wave_max(float v) {
    v = fmaxf(v, dpp_f<0xB1>(v)); v = fmaxf(v, dpp_f<0x4E>(v)); v = fmaxf(v, dpp_f<0x141>(v)); v = fmaxf(v, dpp_f<0x128>(v));
    { auto s = __builtin_amdgcn_permlane16_swap(__float_as_uint(v), __float_as_uint(v), false, false); v = fmaxf(__uint_as_float(s[0]), __uint_as_float(s[1])); }
    { auto s = __builtin_amdgcn_permlane32_swap(__float_as_uint(v), __float_as_uint(v), false, false); v = fmaxf(__uint_as_float(s[0]), __uint_as_float(s[1])); }
    return v;
}
DEVI float silu_f(float x) { return x * __builtin_amdgcn_rcpf(1.f + __expf(-x)); }
DEVI f32x4 mfma16(bf16x8 a, bf16x8 b, f32x4 c) { return __builtin_amdgcn_mfma_f32_16x16x32_bf16(a, b, c, 0, 0, 0); }
DEVI bf16x8 ldg_frag(const bf16_t* p) { return *reinterpret_cast<const bf16x8*>(p); }

DEVI void rms_row_bf16(const float* __restrict__ xr, const float* __restrict__ g, bf16_t* __restrict__ dst, int lane) {
    float4 v[4]; float ss = 0.f;
#pragma unroll
    for (int i = 0; i < 4; ++i) { v[i] = reinterpret_cast<const float4*>(xr)[lane + 64 * i]; ss += v[i].x * v[i].x + v[i].y * v[i].y + v[i].z * v[i].z + v[i].w * v[i].w; }
    ss = wave_sum(ss);
    const float r = rsqrtf(ss * (1.f / 1024.f) + 1e-6f);
#pragma unroll
    for (int i = 0; i < 4; ++i) {
        const float4 gg = reinterpret_cast<const float4*>(g)[lane + 64 * i];
        uint2 o; o.x = pack2(v[i].x * r * gg.x, v[i].y * r * gg.y); o.y = pack2(v[i].z * r * gg.z, v[i].w * r * gg.w);
        reinterpret_cast<uint2*>(dst)[lane + 64 * i] = o;
    }
}

DEVI void transpose_tile(const float* __restrict__ src, int Nsrc, bf16_t* __restrict__ dst, int nt, int kt, int mode, float* lds) {
    const int tid = LTID, tx = tid & 63, ty = tid >> 6;
    const int np = nt * 64 + tx;
    int col = np; bool valid = true;
    if (mode == 1) {
        if (np < 3072) col = np; else if (np < 3584) col = np + 16; else if (np < 3600) col = np - 512; else { valid = false; col = 0; }
    }
#pragma unroll 4
    for (int kk = ty; kk < 64; kk += 4) {
        lds[kk * 65 + tx] = valid ? src[(size_t)(kt * 64 + kk) * Nsrc + col] : 0.f;
    }
    __syncthreads();
    const int nl = tid >> 2, kq = tid & 3;
    unsigned pk[8];
#pragma unroll
    for (int i = 0; i < 8; ++i) pk[i] = pack2(lds[(kq * 16 + 2 * i) * 65 + nl], lds[(kq * 16 + 2 * i + 1) * 65 + nl]);
    uint4* d = reinterpret_cast<uint4*>(dst + (size_t)(nt * 64 + nl) * 1024 + kt * 64 + kq * 16);
    d[0] = make_uint4(pk[0], pk[1], pk[2], pk[3]);
    d[1] = make_uint4(pk[4], pk[5], pk[6], pk[7]);
    __syncthreads();
}

DEVI void convert8(const float* __restrict__ src, bf16_t* __restrict__ dst, size_t idx8) {
    const float4 a = reinterpret_cast<const float4*>(src)[idx8 * 2], b = reinterpret_cast<const float4*>(src)[idx8 * 2 + 1];
    reinterpret_cast<uint4*>(dst)[idx8] = make_uint4(pack2(a.x, a.y), pack2(a.z, a.w), pack2(b.x, b.y), pack2(b.z, b.w));
}

DEVI int pack_i8x4(float a, float b, float c, float d) {
    const int ia = (int)rintf(a), ib = (int)rintf(b), ic = (int)rintf(c), id = (int)rintf(d);
    return (ia & 255) | ((ib & 255) << 8) | ((ic & 255) << 16) | (id << 24);
}
DEVI void quant_row_i8(const float* __restrict__ xr, unsigned char* __restrict__ dst_table, int row, float* __restrict__ descale, int lane) {
    float4 v[4]; float am = 0.f;
#pragma unroll
    for (int i = 0; i < 4; ++i) { v[i] = reinterpret_cast<const float4*>(xr)[lane + 64 * i]; am = fmaxf(am, fmaxf(fmaxf(fabsf(v[i].x), fabsf(v[i].y)), fmaxf(fabsf(v[i].z), fabsf(v[i].w)))); }
    am = wave_max(am);
    const float sc = am > 0.f ? 127.f / am : 1.f;
#pragma unroll
    for (int i = 0; i < 4; ++i) {
        const int w = lane + 64 * i;
        reinterpret_cast<int*>(dst_table)[(size_t)(w >> 5) * (16384 * 32) + (size_t)row * 32 + (w & 31)] = pack_i8x4(v[i].x * sc, v[i].y * sc, v[i].z * sc, v[i].w * sc);
    }
    if (lane == 0) *descale = am > 0.f ? am * (1.f / 127.f) : 1.f;
}
DEVI void quant_row_fp8(const float* __restrict__ xr, unsigned char* __restrict__ dst_table, int row, float* __restrict__ descale, int lane) {
    float4 v[4]; float am = 0.f;
#pragma unroll
    for (int i = 0; i < 4; ++i) { v[i] = reinterpret_cast<const float4*>(xr)[lane + 64 * i]; am = fmaxf(am, fmaxf(fmaxf(fabsf(v[i].x), fabsf(v[i].y)), fmaxf(fabsf(v[i].z), fabsf(v[i].w)))); }
    am = wave_max(am);
    const float sc = am > 0.f ? 448.f / am : 1.f;
#pragma unroll
    for (int i = 0; i < 4; ++i) {
        const float a = fminf(fmaxf(v[i].x * sc, -448.f), 448.f), b = fminf(fmaxf(v[i].y * sc, -448.f), 448.f);
        const float c = fminf(fmaxf(v[i].z * sc, -448.f), 448.f), d = fminf(fmaxf(v[i].w * sc, -448.f), 448.f);
        int pk = __builtin_amdgcn_cvt_pk_fp8_f32(a, b, 0, false);
        pk = __builtin_amdgcn_cvt_pk_fp8_f32(c, d, pk, true);
        const int w = lane + 64 * i;
        reinterpret_cast<int*>(dst_table)[(size_t)(w >> 5) * (16384 * 32) + (size_t)row * 32 + (w & 31)] = pk;
    }
    if (lane == 0) *descale = am > 0.f ? am * (1.f / 448.f) : 1.f;
}

constexpr int P0_XN = 8192, P0_WIN = 60 * 16, P0_WOUT = 16 * 16, P0_WQ = 32 * 16, P0_UV = 8192, P0_SK = 128, P0_LB = 1;
constexpr int P0_UNITS = P0_XN + P0_WIN + P0_WOUT + P0_WQ + P0_UV + P0_SK + P0_LB;

DEVI void phase0_unit(const Params& p, int u, char* smem) {
    const int tid = LTID, lane = tid & 63, w = tid >> 6;
    unsigned char* ws = p.ws;
    if (u < P0_XN) {
        const int row = u * 4 + w;
        rms_row_bf16(p.x + (size_t)row * DM, p.norm1_g, reinterpret_cast<bf16_t*>(ws + OFF_XN) + (size_t)row * DM, lane);
        return;
    }
    u -= P0_XN;
    if (u < P0_WIN) { transpose_tile(p.w_in, 3600, reinterpret_cast<bf16_t*>(ws + OFF_WIN), u / 16, u % 16, 1, reinterpret_cast<float*>(smem)); return; }
    u -= P0_WIN;
    if (u < P0_WOUT) { transpose_tile(p.w_out, 1024, reinterpret_cast<bf16_t*>(ws + OFF_WOUT), u / 16, u % 16, 0, reinterpret_cast<float*>(smem)); return; }
    u -= P0_WOUT;
    if (u < P0_WQ) { transpose_tile(p.w_q, 2048, reinterpret_cast<bf16_t*>(ws + OFF_WQ), u / 16, u % 16, 0, reinterpret_cast<float*>(smem)); return; }
    u -= P0_WQ;
    if (u < P0_UV) {
        const bool isv = u >= 4096; const int row = (isv ? u - 4096 : u) * 4 + w;
        if (isv) quant_row_fp8(p.peer_v + (size_t)row * DM, ws + OFF_V8, row, reinterpret_cast<float*>(ws + OFF_VS) + row, lane);
        else quant_row_i8(p.peer_u + (size_t)row * DM, ws + OFF_U8, row, reinterpret_cast<float*>(ws + OFF_US) + row, lane);
        return;
    }
    u -= P0_UV;
    if (u < P0_SK) { convert8(p.sub_keys, reinterpret_cast<bf16_t*>(ws + OFF_SK), (size_t)u * 256 + tid); return; }
    float* lb = reinterpret_cast<float*>(ws + OFF_LB);
    for (int n = tid; n < 512; n += 256) {
        const float l0 = p.hg_lower[n], l1 = p.hg_lower[512 + n];
        const float mx = fmaxf(l0, l1); const float e0 = __expf(l0 - mx), e1 = __expf(l1 - mx);
        lb[n] = e0 / (e0 + e1);
    }
}

namespace pg8 {
#define PG8_LAS __attribute__((address_space(3)))
typedef unsigned short bf16_t;
typedef short bf16x8 __attribute__((ext_vector_type(8)));
typedef float f32x4 __attribute__((ext_vector_type(4)));
typedef unsigned u32x4 __attribute__((ext_vector_type(4)));
constexpr int BM = 256, BK = 64, HALF = 128, HTB = HALF * BK * 2  , STAGE_BYTES = 8 * HTB, NXCD = 8, WGM = 8;

__host__ __device__ __forceinline__ int lds_byte(int r, int c) { const int st = (r >> 4) * 2 + (c >> 5), rr = r & 15, cc = c & 31, ob = rr * 64 + cc * 2; return st * 1024 + (ob ^ (((ob >> 9) & 1) << 5)); }
__host__ __device__ __forceinline__ void stage_rc(int b, int& R, int& C) { const int st = b / 1024, sb = b % 1024, swz = sb ^ (((sb >> 9) & 1) << 5); R = (st >> 1) * 16 + swz / 64; C = (st & 1) * 32 + (swz % 64) / 2; }
__host__ __device__ __forceinline__ int perm32(int rho) { const int n = rho >> 4, i = rho & 15; return 8 * (i >> 2) + 4 * n + (i & 3); }

struct Unit { int pm, pn; };
struct Gemm { const bf16_t* A; const bf16_t* Bt; int M, N, K; };

struct StaticOrder {
    int nM, nN, nwg, G, c;
    __host__ __device__ void init(int M, int N, int G_, int c_) { nM = M / BM; nN = N / BM; nwg = nM * nN; G = G_; c = c_; }
    __host__ __device__ bool next(int i, Unit& u) const {
        const long L = (long)i * G + c; if (L >= nwg) return false;
        int wgid = (int)L; { const int q = nwg / NXCD, r = nwg % NXCD, xcd = wgid % NXCD, off = wgid / NXCD; wgid = (xcd < r ? xcd * (q + 1) : r * (q + 1) + (xcd - r) * q) + off; }
        const int nig = WGM * nN, gid = wgid / nig, fm = gid * WGM, gsz = (nM - fm) < WGM ? (nM - fm) : WGM;
        u.pm = fm + ((wgid % nig) % gsz); u.pn = (wgid % nig) / gsz; return true;
    }
    __device__ __forceinline__ void a_ready(const Unit&) const {}
    __device__ __forceinline__ void done(const Unit&) const {}
};
__device__ __forceinline__ unsigned cvt_pk_bf16(float lo, float hi) { unsigned r; asm volatile("v_cvt_pk_bf16_f32 %0, %1, %2" : "=v"(r) : "v"(lo), "v"(hi)); return r; }
typedef float f32x2 __attribute__((ext_vector_type(2)));
template <class Epi, class Sched, bool STAMP = false>
__device__ __forceinline__ void gemm_phase(PG8_LAS unsigned char* lds, const Gemm g, const Sched& S, const Epi& E, unsigned long long* stamps) {
    const int tid = threadIdx.x, wid = __builtin_amdgcn_readfirstlane(tid >> 6), lane = tid & 63, wr = wid >> 2, wc = wid & 3, fr = lane & 15, fq = lane >> 4;
    const int K = g.K, nt = K / BK;
    int ts_lo = 0, ts_hi = 0, nts = 0; const unsigned long long rt_entry = STAMP ? (unsigned long long)wall_clock64() : 0ull;
#define PG8_STAMP() do { if (STAMP && wid == 0 && nts < 64) { const unsigned long long _c = (unsigned long long)clock64(); \
        ts_lo = (lane == nts) ? (int)(unsigned)_c : ts_lo; ts_hi = (lane == nts) ? (int)(unsigned)(_c >> 32) : ts_hi; ++nts; } } while (0)
    PG8_STAMP();
    unsigned voffA[2], voffB[2];
#pragma unroll
    for (int i = 0; i < 2; ++i) { int R, C; stage_rc(tid * 16 + i * 8192, R, C); const int Rb = Epi::PERM ? ((R & ~31) + perm32(R & 31)) : R;
        voffA[i] = (unsigned)(R * K + C) * 2u; voffB[i] = (unsigned)(Rb * K + C) * 2u; }
    const size_t kstep = (size_t)(BK * 2);
    const size_t hstep = (size_t)HALF * K * 2;
    const size_t tstep = 2 * hstep;
    const unsigned ldsw = (unsigned)wid * 1024u;
    const int aoff = lds_byte(wr * 64 + fr, fq * 8), boff = lds_byte(wc * 32 + fr, fq * 8);
#define PG8_SA(b, h) (((b) * 2 + (h)) * HTB)
#define PG8_SB(b, h) ((4 + (b) * 2 + (h)) * HTB)
#define PG8_STAGE(bufoff, gbase, voff) do { _Pragma("unroll") for (int _i = 0; _i < 2; ++_i) \
        __builtin_amdgcn_global_load_lds((const unsigned*)((const char*)(gbase) + (voff)[_i]), (PG8_LAS unsigned*)(lds + (bufoff) + ldsw + _i * 8192), 16, 0, 0); } while (0)
#define PG8_LDA(dst, b, h) do { _Pragma("unroll") for (int m = 0; m < 4; ++m) _Pragma("unroll") for (int k = 0; k < 2; ++k) dst[m][k] = *(const PG8_LAS bf16x8*)(lds + PG8_SA(b, h) + aoff + m * 2048 + k * 1024); } while (0)
#define PG8_LDB(dst, b, h) do { _Pragma("unroll") for (int n = 0; n < 2; ++n) _Pragma("unroll") for (int k = 0; k < 2; ++k) dst[n][k] = *(const PG8_LAS bf16x8*)(lds + PG8_SB(b, h) + boff + n * 2048 + k * 1024); } while (0)
#define PG8_MMA(ai, bj, At, Bt) do { __builtin_amdgcn_s_setprio(1); _Pragma("unroll") for (int m = 0; m < 4; ++m) _Pragma("unroll") for (int n = 0; n < 2; ++n) _Pragma("unroll") for (int k = 0; k < 2; ++k) \
        acc[ai][bj][m][n] = __builtin_amdgcn_mfma_f32_16x16x32_bf16(Bt[n][k], At[m][k], acc[ai][bj][m][n], 0, 0, 0); __builtin_amdgcn_s_setprio(0); } while (0)
#define PG8_WAIT_V(n) asm volatile("s_waitcnt vmcnt(" #n ")" ::: "memory")
#define PG8_WAIT_L(n) asm volatile("s_waitcnt lgkmcnt(" #n ")" ::: "memory")
#define PG8_BAR __builtin_amdgcn_s_barrier()
#define PG8_SCHED __builtin_amdgcn_sched_barrier(0)
    Unit cur, nxt; int ui = 0;
    if (!S.next(0, cur)) return;
    f32x4 acc[2][2][4][2];
#pragma unroll
    for (int a = 0; a < 2; ++a)
#pragma unroll
        for (int b = 0; b < 2; ++b)
#pragma unroll
            for (int m = 0; m < 4; ++m)
#pragma unroll
                for (int n = 0; n < 2; ++n) acc[a][b][m][n] = (f32x4){0.f, 0.f, 0.f, 0.f};
    bf16x8 At[4][2], B0[2][2], B1[2][2];
    const char* cA = (const char*)g.A + (size_t)cur.pm * tstep; const char* cB = (const char*)g.Bt + (size_t)cur.pn * tstep;
    S.a_ready(cur);
    PG8_STAGE(PG8_SB(0, 0), cB, voffB); PG8_STAGE(PG8_SA(0, 0), cA, voffA); PG8_STAGE(PG8_SB(0, 1), cB + hstep, voffB); PG8_STAGE(PG8_SA(0, 1), cA + hstep, voffA);
    if (wr == 1) PG8_BAR;
    PG8_WAIT_V(4); PG8_BAR;
    PG8_STAGE(PG8_SB(1, 0), cB + kstep, voffB); PG8_STAGE(PG8_SA(1, 0), cA + kstep, voffA); PG8_STAGE(PG8_SB(1, 1), cB + hstep + kstep, voffB);
    PG8_WAIT_V(6); PG8_BAR;
    PG8_STAMP();
    for (;;) {
        const bool has_next = S.next(ui + 1, nxt);
        const char* nA = has_next ? (const char*)g.A + (size_t)nxt.pm * tstep : cA; const char* nB = has_next ? (const char*)g.Bt + (size_t)nxt.pn * tstep : cB;
        for (int t = 0; t < nt; t += 2) {
            const bool last = (t == nt - 2);
            const char* a1 = cA + (size_t)(t + 1) * kstep;
            const char* a2 = last ? nA : cA + (size_t)(t + 2) * kstep; const char* b2 = last ? nB : cB + (size_t)(t + 2) * kstep;
            const char* a3 = a2 + kstep; const char* b3 = b2 + kstep;
            if (last && has_next) S.a_ready(nxt);
            PG8_LDB(B0, 0, 0); PG8_SCHED; PG8_LDA(At, 0, 0); PG8_STAGE(PG8_SA(1, 1), a1 + hstep, voffA);
            PG8_WAIT_L(8); PG8_BAR; PG8_WAIT_L(0); PG8_MMA(0, 0, At, B0); PG8_BAR; PG8_SCHED;
            PG8_LDB(B1, 0, 1); PG8_STAGE(PG8_SB(0, 0), b2, voffB);
            PG8_BAR; PG8_WAIT_L(0); PG8_MMA(0, 1, At, B1); PG8_BAR;
            PG8_LDA(At, 0, 1); PG8_STAGE(PG8_SA(0, 0), a2, voffA);
            PG8_BAR; PG8_WAIT_L(0); PG8_MMA(1, 0, At, B0); PG8_BAR; PG8_SCHED;
            PG8_STAGE(PG8_SB(0, 1), b2 + hstep, voffB);
            PG8_WAIT_V(6); PG8_BAR; PG8_MMA(1, 1, At, B1); PG8_BAR;
            PG8_LDB(B0, 1, 0); PG8_SCHED; PG8_LDA(At, 1, 0); PG8_STAGE(PG8_SA(0, 1), a2 + hstep, voffA);
            PG8_WAIT_L(8); PG8_BAR; PG8_WAIT_L(0); PG8_MMA(0, 0, At, B0); PG8_BAR; PG8_SCHED;
            PG8_LDB(B1, 1, 1); PG8_STAGE(PG8_SB(1, 0), b3, voffB);
            PG8_BAR; PG8_WAIT_L(0); PG8_MMA(0, 1, At, B1); PG8_BAR;
            PG8_LDA(At, 1, 1); PG8_STAGE(PG8_SA(1, 0), a3, voffA);
            PG8_BAR; PG8_WAIT_L(0); PG8_MMA(1, 0, At, B0); PG8_BAR; PG8_SCHED;
            PG8_STAGE(PG8_SB(1, 1), b3 + hstep, voffB);
            PG8_WAIT_V(6); PG8_BAR; PG8_MMA(1, 1, At, B1); PG8_BAR;
        }
        PG8_STAMP();
        if constexpr (!Epi::AFTER_DRAIN) { E(acc, cur, wr, wc, fr, fq); S.done(cur); }
        PG8_STAMP();
        if (!has_next) break;
#pragma unroll
        for (int a = 0; a < 2; ++a)
#pragma unroll
            for (int b = 0; b < 2; ++b)
#pragma unroll
                for (int m = 0; m < 4; ++m)
#pragma unroll
                    for (int n = 0; n < 2; ++n) acc[a][b][m][n] = (f32x4){0.f, 0.f, 0.f, 0.f};
        cur = nxt; cA = nA; cB = nB; ++ui;
    }
    PG8_WAIT_V(0);
    if (wr == 0) PG8_BAR;
    PG8_BAR;
    if constexpr (Epi::AFTER_DRAIN) { E.fused(acc, cur, wr, wc, fr, fq, lds, wid, lane); S.done(cur); }
    PG8_STAMP();
    if (STAMP && wid == 0) { stamps[lane] = lane < nts ? (((unsigned long long)(unsigned)ts_hi << 32) | (unsigned)ts_lo) : 0ull;
        if (lane == 62) stamps[62] = rt_entry; if (lane == 63) stamps[63] = (unsigned long long)wall_clock64(); }
#undef PG8_STAMP
#undef PG8_SA
#undef PG8_SB
#undef PG8_STAGE
#undef PG8_LDA
#undef PG8_LDB
#undef PG8_MMA
#undef PG8_WAIT_V
#undef PG8_WAIT_L
#undef PG8_BAR
#undef PG8_SCHED
}
}

DEVI uint4 pack8(const pg8::f32x4 a, const pg8::f32x4 b) { return make_uint4(pack2(a[0], a[1]), pack2(a[2], a[3]), pack2(b[0], b[1]), pack2(b[2], b[3])); }

constexpr int P1_N = IN_WP;
struct EpiInProj {
    static constexpr bool PERM = true, AFTER_DRAIN = false;
    unsigned char* ws;
    __device__ __forceinline__ void operator()(const pg8::f32x4 (&acc)[2][2][4][2], const pg8::Unit& u, int wr, int wc, int fr, int fq) const {
        const int row0 = u.pm * 256 + wr * 64 + fr;
        const int pn = u.pn;
        const int cl0 = wc * 32 + 8 * fq;
        bf16_t* dst; int ld, cbase, kind;
        if (pn < 2)       { dst = reinterpret_cast<bf16_t*>(ws + OFF_HQ);  ld = 512; cbase = pn * 256;        kind = 1; }
        else if (pn < 4)  { dst = reinterpret_cast<bf16_t*>(ws + OFF_HLF); ld = 512; cbase = (pn - 2) * 256;  kind = 2; }
        else if (pn < 6)  { dst = reinterpret_cast<bf16_t*>(ws + OFF_HV);  ld = 512; cbase = (pn - 4) * 256;  kind = 0; }
        else if (pn < 8)  { dst = reinterpret_cast<bf16_t*>(ws + OFF_HG);  ld = 512; cbase = (pn - 6) * 256;  kind = 1; }
        else if (pn == 8) { dst = reinterpret_cast<bf16_t*>(ws + OFF_GQ);  ld = 256; cbase = 0;               kind = 3; }
        else if (pn == 9) { dst = reinterpret_cast<bf16_t*>(ws + OFF_GK);  ld = 256; cbase = 0;               kind = 0; }
        else if (pn < 12) { dst = reinterpret_cast<bf16_t*>(ws + OFF_GV);  ld = 512; cbase = (pn - 10) * 256; kind = 0; }
        else if (pn < 14) { dst = reinterpret_cast<bf16_t*>(ws + OFF_GG);  ld = 512; cbase = (pn - 12) * 256; kind = 1; }
        else {
            if (wc == 0 && fq < 2) {
                float* gl = reinterpret_cast<float*>(ws + OFF_GLOW);
#pragma unroll
                for (int ai = 0; ai < 2; ++ai)
#pragma unroll
                    for (int m = 0; m < 4; ++m) {
                        float* rp = gl + (size_t)(row0 + ai * 128 + m * 16) * 16 + 8 * fq;
                        *reinterpret_cast<pg8::f32x4*>(rp) = acc[ai][0][m][0];
                        *reinterpret_cast<pg8::f32x4*>(rp + 4) = acc[ai][0][m][1];
                    }
            }
            return;
        }
        float lbv[2][8];
#pragma unroll
        for (int bj = 0; bj < 2; ++bj)
#pragma unroll
            for (int j = 0; j < 8; ++j) lbv[bj][j] = 0.f;
        if (kind == 2) {
            const float* lb = reinterpret_cast<const float*>(ws + OFF_LB);
#pragma unroll
            for (int bj = 0; bj < 2; ++bj)
#pragma unroll
                for (int j = 0; j < 8; ++j) lbv[bj][j] = lb[cbase + bj * 128 + cl0 + j];
        }
#pragma unroll
        for (int ai = 0; ai < 2; ++ai)
#pragma unroll
            for (int m = 0; m < 4; ++m) {
                bf16_t* rowp = dst + (size_t)(row0 + ai * 128 + m * 16) * ld + cbase + cl0;
#pragma unroll
                for (int bj = 0; bj < 2; ++bj) {
                    pg8::f32x4 v0 = acc[ai][bj][m][0], v1 = acc[ai][bj][m][1];
                    if (kind == 1) {
#pragma unroll
                        for (int j = 0; j < 4; ++j) { v0[j] = silu_f(v0[j]); v1[j] = silu_f(v1[j]); }
                    } else if (kind == 2) {
#pragma unroll
                        for (int j = 0; j < 4; ++j) {
                            const float l0 = lbv[bj][j], l1 = lbv[bj][4 + j];
                            v0[j] = __logf(l0 + (1.f - l0) * __builtin_amdgcn_rcpf(1.f + __expf(-v0[j])));
                            v1[j] = __logf(l1 + (1.f - l1) * __builtin_amdgcn_rcpf(1.f + __expf(-v1[j])));
                        }
                    } else if (kind == 3) {
#pragma unroll
                        for (int j = 0; j < 4; ++j) { v0[j] *= 0.125f; v1[j] *= 0.125f; }
                    }
                    *reinterpret_cast<uint4*>(rowp + bj * 128) = pack8(v0, v1);
                }
            }
    }
};
struct EpiOutProj {
    static constexpr bool PERM = true, AFTER_DRAIN = false;
    const float* x; bf16_t* h16;
    __device__ __forceinline__ void operator()(const pg8::f32x4 (&acc)[2][2][4][2], const pg8::Unit& u, int wr, int wc, int fr, int fq) const {
        const int row0 = u.pm * 256 + wr * 64 + fr, col0 = u.pn * 256 + wc * 32 + 8 * fq;
#pragma unroll
        for (int ai = 0; ai < 2; ++ai)
#pragma unroll
            for (int m = 0; m < 4; ++m) {
                const size_t ro = (size_t)(row0 + ai * 128 + m * 16) * DM + col0;
#pragma unroll
                for (int bj = 0; bj < 2; ++bj) {
                    const pg8::f32x4 x0 = *reinterpret_cast<const pg8::f32x4*>(x + ro + bj * 128), x1 = *reinterpret_cast<const pg8::f32x4*>(x + ro + bj * 128 + 4);
                    *reinterpret_cast<uint4*>(h16 + ro + bj * 128) = pack8(x0 + acc[ai][bj][m][0], x1 + acc[ai][bj][m][1]);
                }
            }
    }
};
struct EpiQ {
    static constexpr bool PERM = true, AFTER_DRAIN = false;
    bf16_t* Q;
    __device__ __forceinline__ void operator()(const pg8::f32x4 (&acc)[2][2][4][2], const pg8::Unit& u, int wr, int wc, int fr, int fq) const {
        const int row0 = u.pm * 256 + wr * 64 + fr, col0 = u.pn * 256 + wc * 32 + 8 * fq;
#pragma unroll
        for (int ai = 0; ai < 2; ++ai)
#pragma unroll
            for (int m = 0; m < 4; ++m) {
                bf16_t* rowp = Q + (size_t)(row0 + ai * 128 + m * 16) * 2048 + col0;
#pragma unroll
                for (int bj = 0; bj < 2; ++bj) *reinterpret_cast<uint4*>(rowp + bj * 128) = pack8(acc[ai][bj][m][0], acc[ai][bj][m][1]);
            }
    }
};
template <class Epi>
DEVI void run_gemm(const bf16_t* A, const bf16_t* Bt, int N, const Epi& E, char* smem) {
    pg8::Gemm g{A, Bt, M_TOK, N, 1024};
#if PROBE_GEMM_DUP
    struct DupOrder : pg8::StaticOrder { __host__ __device__ bool next(int i, pg8::Unit& u) const { return pg8::StaticOrder::next(i >> 1, u); } };
    DupOrder S; S.init(M_TOK, N, (int)gridDim.x, (int)blockIdx.x);
    pg8::gemm_phase<Epi, DupOrder, false>((PG8_LAS unsigned char*)smem, g, S, E, nullptr);
#else
    pg8::StaticOrder S; S.init(M_TOK, N, (int)gridDim.x, (int)blockIdx.x);
    pg8::gemm_phase<Epi, pg8::StaticOrder, false>((PG8_LAS unsigned char*)smem, g, S, E, nullptr);
#endif
    __builtin_amdgcn_s_waitcnt(0);
}

DEVI float logsigmoid_f(float z) { return fminf(z, 0.f) - __logf(1.f + __expf(-fabsf(z))); }

DEVI unsigned off_b(unsigned row, unsigned ch) { return 256u * row + 16u * (ch ^ (((row & 3u) << 2) | ((row >> 2) & 3u))); }
DEVI unsigned tr_addr16(unsigned lane, unsigned c, unsigned ks, unsigned t) {
    const unsigned g = lane >> 4, q = (lane & 15u) >> 2, pp = lane & 3u;
    return off_b(32u * ks + 8u * g + 4u * t + q, 2u * c + (pp >> 1)) + 8u * (pp & 1u);
}
typedef unsigned short u16x4_t __attribute__((ext_vector_type(4)));
DEVI bf16x8 tr_frag(unsigned base, unsigned lane, unsigned c, unsigned ks) {
    u16x4_t a, b;
    asm volatile("ds_read_b64_tr_b16 %0, %2\n\tds_read_b64_tr_b16 %1, %3\n\ts_waitcnt lgkmcnt(0)" : "=&v"(a), "=&v"(b) : "v"(base + tr_addr16(lane, c, ks, 0)), "v"(base + tr_addr16(lane, c, ks, 1)) : "memory");
    bf16x8 r;
    r[0] = (short)a[0]; r[1] = (short)a[1]; r[2] = (short)a[2]; r[3] = (short)a[3]; r[4] = (short)b[0]; r[5] = (short)b[1]; r[6] = (short)b[2]; r[7] = (short)b[3];
    return r;
}
DEVI bf16x8 row_frag(const char* tile, unsigned lane, unsigned rb, unsigned s) { return *reinterpret_cast<const bf16x8*>(tile + off_b((lane & 15u) + 16u * rb, 4u * s + (lane >> 4))); }
DEVI void fill_tile64(char* tile, const bf16_t* __restrict__ g, int ldg) {
#pragma unroll
    for (int i = 0; i < 4; ++i) {
        const int n = LTID + 256 * i, row = n >> 4, ch = n & 15;
        *reinterpret_cast<uint4*>(tile + off_b(row, ch)) = *reinterpret_cast<const uint4*>(g + (size_t)row * ldg + ch * 8);
    }
}
DEVI void fill_tile64x64(char* tile, const bf16_t* __restrict__ g, int ldg) {
#pragma unroll
    for (int i = 0; i < 2; ++i) {
        const int n = LTID + 256 * i, row = n >> 3, ch = n & 7;
        *reinterpret_cast<uint4*>(tile + off_b(row, ch)) = *reinterpret_cast<const uint4*>(g + (size_t)row * ldg + ch * 8);
    }
}

typedef unsigned gu32x4 __attribute__((ext_vector_type(4)));
typedef float gf32x4 __attribute__((ext_vector_type(4)));
template <int DK, bool KV> struct GPre;
template <bool KV> struct GPre<128, KV> { unsigned a[16], b[KV ? 1 : 16]; gu32x4 v[4]; };
template <bool KV> struct GPre<64, KV>  { unsigned a[8], b[KV ? 1 : 8]; gu32x4 v[4]; gf32x4 gl; float2 wg[16]; float2 bg; };

template <int N>
DEVI void dummy_stores(unsigned char* ws) {
    uint2* d = reinterpret_cast<uint2*>(ws + OFF_DUMMY) + (size_t)threadIdx.x * (2 * N);
#pragma unroll
    for (int i = 0; i < N; ++i) d[2 * i] = make_uint2(0u, 0u);
}

template <int DK, bool KV>
DEVI void gate_prefetch(const Params& p, int sidx, int c, GPre<DK, KV>& r) {
    unsigned char* ws = p.ws;
    int tid = LTID; asm volatile("" : "+v"(tid));
    const int b = sidx >> 2, h = sidx & 3;
    const size_t row0 = (size_t)(b * 128 + c) * 64;
    const bf16_t* A = reinterpret_cast<const bf16_t*>(ws + (DK == 128 ? OFF_HLF : OFF_GK)) + row0 * (4 * DK) + h * DK;
    const bf16_t* Q = reinterpret_cast<const bf16_t*>(ws + (DK == 128 ? OFF_HQ : OFF_GQ)) + row0 * (4 * DK) + h * DK;
    const bf16_t* V = reinterpret_cast<const bf16_t*>(ws + (DK == 128 ? OFF_HV : OFF_GV)) + row0 * 512 + h * 128;
    constexpr int NR = (DK == 128) ? 16 : 8;
    const int cp = (DK == 128) ? (tid & 63) : (tid & 31), rq = (DK == 128) ? (tid >> 6) : (tid >> 5);
#pragma unroll
    for (int i = 0; i < 4; ++i) { const int n = tid + 256 * i; r.v[i] = *reinterpret_cast<const gu32x4*>(V + (size_t)(n >> 4) * 512 + (n & 15) * 8); }
#pragma unroll
    for (int i = 0; i < NR; ++i) {
        r.a[i] = *reinterpret_cast<const unsigned*>(A + (size_t)(NR * rq + i) * (4 * DK) + 2 * cp);
        if (!KV) r.b[i] = *reinterpret_cast<const unsigned*>(Q + (size_t)(NR * rq + i) * (4 * DK) + 2 * cp);
    }
    if constexpr (DK == 64) {
        r.gl = reinterpret_cast<const gf32x4*>(ws + OFF_GLOW)[row0 * 4 + tid];
        const int col = h * 64 + 2 * cp;
#pragma unroll
        for (int j = 0; j < 16; ++j) r.wg[j] = *reinterpret_cast<const float2*>(p.gla_wg + j * 256 + col);
        r.bg = *reinterpret_cast<const float2*>(p.gla_bg + col);
    }
}

template <int DK, bool KV>
DEVI void gate_apply(GPre<DK, KV>& r, char* vtile, char* qtile, char* ktile, float* tot, float4* glt, float* __restrict__ decout) {
    int tid = LTID; asm volatile("" : "+v"(tid));
    constexpr int NR = (DK == 128) ? 16 : 8, NG = 64 / NR;
    const int cp = (DK == 128) ? (tid & 63) : (tid & 31), rq = (DK == 128) ? (tid >> 6) : (tid >> 5);
#pragma unroll
    for (int i = 0; i < 4; ++i) { const int n = tid + 256 * i; *reinterpret_cast<gu32x4*>(vtile + off_b((unsigned)(n >> 4), (unsigned)(n & 15))) = r.v[i]; }
    float l0[NR], l1[NR];
    if constexpr (DK == 128) {
#pragma unroll
        for (int i = 0; i < NR; ++i) { l0[i] = bflo(r.a[i]); l1[i] = bfhi(r.a[i]); }
    } else {
        reinterpret_cast<gf32x4*>(glt)[tid] = r.gl;
        __syncthreads();
#pragma unroll
        for (int i = 0; i < NR; ++i) {
            float z0 = r.bg.x, z1 = r.bg.y;
#pragma unroll
            for (int j = 0; j < 4; ++j) {
                const float4 t = glt[(NR * rq + i) * 4 + j];
                z0 += t.x * r.wg[4 * j].x + t.y * r.wg[4 * j + 1].x + t.z * r.wg[4 * j + 2].x + t.w * r.wg[4 * j + 3].x;
                z1 += t.x * r.wg[4 * j].y + t.y * r.wg[4 * j + 1].y + t.z * r.wg[4 * j + 2].y + t.w * r.wg[4 * j + 3].y;
            }
            l0[i] = logsigmoid_f(z0) * (1.f / 16.f); l1[i] = logsigmoid_f(z1) * (1.f / 16.f);
        }
    }
    float s0 = 0.f, s1 = 0.f;
#pragma unroll
    for (int i = 0; i < NR; ++i) { s0 += l0[i]; s1 += l1[i]; }
    *reinterpret_cast<float2*>(tot + rq * DK + 2 * cp) = make_float2(s0, s1);
    __syncthreads();
    float G0 = 0.f, G1 = 0.f, T0 = 0.f, T1 = 0.f;
#pragma unroll
    for (int k = 0; k < NG; ++k) {
        const float2 t = *reinterpret_cast<const float2*>(tot + k * DK + 2 * cp);
        T0 += t.x; T1 += t.y;
        if (k < rq) { G0 += t.x; G1 += t.y; }
    }
    if (KV && rq == 0) *reinterpret_cast<float2*>(decout + 2 * cp) = make_float2(__expf(T0), __expf(T1));
#pragma unroll
    for (int i = 0; i < NR; ++i) {
        G0 += l0[i]; G1 += l1[i];
        float k0, k1;
        if constexpr (DK == 128) { k0 = 1.f - __expf(l0[i]); k1 = 1.f - __expf(l1[i]); } else { k0 = bflo(r.a[i]); k1 = bfhi(r.a[i]); }
        const unsigned o = off_b((unsigned)(NR * rq + i), (unsigned)(cp >> 2)) + 4u * (unsigned)(cp & 3);
        if constexpr (KV) {
            *reinterpret_cast<unsigned*>(ktile + o) = pack2(k0 * __expf(T0 - G0), k1 * __expf(T1 - G1));
        } else {
            *reinterpret_cast<unsigned*>(qtile + o) = pack2(bflo(r.b[i]) * __expf(G0), bfhi(r.b[i]) * __expf(G1));
            *reinterpret_cast<unsigned*>(ktile + o) = pack2(k0 * __expf(-G0), k1 * __expf(-G1));
        }
    }
}

constexpr int P3_UNITS = 4096;
template <int DK>
DEVI void kv_unit(const Params& p, int sidx, int c, int nsidx, int nc, char* smem, GPre<DK, true>& pre) {
    unsigned char* ws = p.ws;
    const int lane = LTID & 63, w = LTID >> 6;
    const int b = sidx >> 2, h = sidx & 3;
    const int cidx = b * 128 + c;
    constexpr int NDB = DK / 16;
    float* DEC = reinterpret_cast<float*>(ws + (DK == 128 ? OFF_DECH : OFF_DECG)) + (size_t)cidx * (4 * DK) + h * DK;
    bf16_t* ST = reinterpret_cast<bf16_t*>(reinterpret_cast<unsigned char*>(p.out) + (DK == 128 ? OUT_STH : OUT_STG)) + ((size_t)sidx * 128 + c) * (128 * DK);
    f32x4 acc[NDB][2];
#pragma unroll
    for (int i = 0; i < NDB; ++i) { acc[i][0] = f32x4{0, 0, 0, 0}; acc[i][1] = f32x4{0, 0, 0, 0}; }
    const int fo = (lane & 15) * 64 + 8 * (lane >> 4);
    gate_apply<DK, true>(pre, smem, nullptr, smem + 16384, reinterpret_cast<float*>(smem + 32768), reinterpret_cast<float4*>(smem + 36864), DEC);
    gate_prefetch<DK, true>(p, nsidx, nc, pre);
    __syncthreads();
    const unsigned tbase = (unsigned)(size_t)smem, kbase = tbase + 16384u;
#pragma unroll
    for (int ks = 0; ks < 2; ++ks) {
        bf16x8 bv[2];
#pragma unroll
        for (int nb = 0; nb < 2; ++nb) bv[nb] = tr_frag(tbase, (unsigned)lane, (unsigned)(2 * w + nb), (unsigned)ks);
#pragma unroll
        for (int db = 0; db < NDB; ++db) {
            const bf16x8 ak = tr_frag(kbase, (unsigned)lane, (unsigned)db, (unsigned)ks);
            acc[db][0] = mfma16(ak, bv[0], acc[db][0]);
            acc[db][1] = mfma16(ak, bv[1], acc[db][1]);
        }
    }
#pragma unroll
    for (int db = 0; db < NDB; ++db) {
        const int d = db * 16 + 4 * (lane >> 4);
#pragma unroll
        for (int nb = 0; nb < 2; ++nb) {
            const int dv = 32 * w + nb * 16 + (lane & 15);
            uint2 o; o.x = pack2(acc[db][nb][0], acc[db][nb][1]); o.y = pack2(acc[db][nb][2], acc[db][nb][3]);
            *reinterpret_cast<uint2*>(ST + (size_t)dv * DK + d) = o;
        }
    }
    __syncthreads();
}
template <int DK>
DEVI void phase3_loop(const Params& p, int hb, char* hsm) {
    GPre<DK, true> pre;
    const int stride = (int)gridDim.x * 2;
    int v = (int)blockIdx.x * 2 + hb;
    if (v < 2048) { gate_prefetch<DK, true>(p, v >> 7, v & 127, pre); dummy_stores<DK / 8>(p.ws); }
    for (; v < 2048; v += stride) {
        const int nv = (v + stride < 2048) ? v + stride : v;
        kv_unit<DK>(p, v >> 7, v & 127, nv >> 7, nv & 127, hsm, pre);
    }
}

constexpr int P4_UNITS = 384;
template <bool DRY>
DEVI void phase4_unit_t(const Params& p, int u, char* smem) {
    unsigned char* ws = p.ws;
    int e = u * 256 + LTID;
    bf16_t* base; bf16_t* sbase; const float* dec; size_t cstride; int decstride;
    if (e < 65536) {
        const int sidx = e >> 12, rem = e & 4095, dv = rem >> 5, d4 = (rem & 31) * 4;
        const int b = sidx >> 2, h = sidx & 3;
        base = reinterpret_cast<bf16_t*>(reinterpret_cast<unsigned char*>(p.out) + OUT_STH) + ((size_t)sidx * 128) * 16384 + dv * 128 + d4;
        sbase = DRY ? reinterpret_cast<bf16_t*>(ws + OFF_XN) + ((size_t)sidx * 128) * 16384 + dv * 128 + d4 : base;
        cstride = 16384;
        dec = reinterpret_cast<const float*>(ws + OFF_DECH) + (size_t)(b * 128) * 512 + h * 128 + d4; decstride = 512;
    } else {
        e -= 65536;
        const int sidx = e >> 11, rem = e & 2047, dv = rem >> 4, d4 = (rem & 15) * 4;
        const int b = sidx >> 2, h = sidx & 3;
        base = reinterpret_cast<bf16_t*>(reinterpret_cast<unsigned char*>(p.out) + OUT_STG) + ((size_t)sidx * 128) * 8192 + dv * 64 + d4;
        sbase = DRY ? reinterpret_cast<bf16_t*>(ws + OFF_KTH) + ((size_t)sidx * 128) * 8192 + dv * 64 + d4 : base;
        cstride = 8192;
        dec = reinterpret_cast<const float*>(ws + OFF_DECG) + (size_t)(b * 128) * 256 + h * 64 + d4; decstride = 256;
    }
    float s0 = 0.f, s1 = 0.f, s2 = 0.f, s3 = 0.f;
    for (int c8 = 0; c8 < 128; c8 += 8) {
        uint2 kv[8]; float4 dc[8];
#pragma unroll
        for (int i = 0; i < 8; ++i) { kv[i] = *reinterpret_cast<const uint2*>(base + (size_t)(c8 + i) * cstride); dc[i] = *reinterpret_cast<const float4*>(dec + (size_t)(c8 + i) * decstride); }
#pragma unroll
        for (int i = 0; i < 8; ++i) {
            uint2 o; o.x = pack2(s0, s1); o.y = pack2(s2, s3);
            *reinterpret_cast<uint2*>(sbase + (size_t)(c8 + i) * cstride) = o;
            s0 = dc[i].x * s0 + bflo(kv[i].x); s1 = dc[i].y * s1 + bfhi(kv[i].x);
            s2 = dc[i].z * s2 + bflo(kv[i].y); s3 = dc[i].w * s3 + bfhi(kv[i].y);
        }
    }
}

DEVI void phase4_unit(const Params& p, int u, char* smem) { phase4_unit_t<false>(p, u, smem); }
DEVI void phase4_dry_unit(const Params& p, int u, char* smem) { phase4_unit_t<true>(p, u, smem); }

constexpr int P5_UNITS = 4096;
constexpr int PL_PITCH = 72;
typedef unsigned gu32x2 __attribute__((ext_vector_type(2)));
template <int DK> struct OutRegs { GPre<DK, false> pre; bf16x8 ast[DK / 32][2]; gu32x2 gtv[4][2]; };
template <int DK>
DEVI void out_load_ast(const Params& p, int sidx, int c, OutRegs<DK>& R) {
    int tid = LTID; asm volatile("" : "+v"(tid));
    const int lane = tid & 63, w = tid >> 6, l15 = lane & 15, lg = lane >> 4;
    const bf16_t* ST = reinterpret_cast<const bf16_t*>(reinterpret_cast<const unsigned char*>(p.out) + (DK == 128 ? OUT_STH : OUT_STG)) + ((size_t)sidx * 128 + c) * (128 * DK);
#pragma unroll
    for (int ks = 0; ks < DK / 32; ++ks) {
#pragma unroll
        for (int x = 0; x < 2; ++x) R.ast[ks][x] = ldg_frag(ST + (size_t)((2 * w + x) * 16 + l15) * DK + ks * 32 + 8 * lg);
    }
}
template <int DK>
DEVI void out_load_gates(const Params& p, int sidx, int c, OutRegs<DK>& R) {
    int tid = LTID; asm volatile("" : "+v"(tid));
    const int lane = tid & 63, w = tid >> 6, l15 = lane & 15, lg = lane >> 4;
    const size_t row0 = (size_t)((sidx >> 2) * 128 + c) * 64;
    const bf16_t* GATE = reinterpret_cast<const bf16_t*>(p.ws + (DK == 128 ? OFF_HG : OFF_GG)) + row0 * 512 + (sidx & 3) * 128;
#pragma unroll
    for (int x = 0; x < 2; ++x) {
#pragma unroll
        for (int y = 0; y < 4; ++y) R.gtv[y][x] = *reinterpret_cast<const gu32x2*>(GATE + (size_t)(y * 16 + l15) * 512 + (2 * w + x) * 16 + 4 * lg);
    }
}
template <int DK>
DEVI void out_unit(const Params& p, int sidx, int c, int nsidx, int nc, char* smem, OutRegs<DK>& R, const float4 (&g4v)[2]) {
    unsigned char* ws = p.ws;
    const int lane = LTID & 63, w = LTID >> 6;
    const int b = sidx >> 2, h = sidx & 3;
    const int cidx = b * 128 + c;
    const size_t row0 = (size_t)cidx * 64;
    constexpr int LDQ = 4 * DK;
    bf16_t* MIX = reinterpret_cast<bf16_t*>(ws + OFF_MIX) + row0 * 1024 + (DK == 128 ? 0 : 512) + h * 128;
    bf16_t* PL = reinterpret_cast<bf16_t*>(smem);
    float* RED = reinterpret_cast<float*>(smem + 64 * PL_PITCH * 2);

    const int l15 = lane & 15, lg = lane >> 4;
    char* vtile = smem + 16384;
    char* qtile = smem + 32768;
    char* ktile = smem + 49152;
    gate_apply<DK, false>(R.pre, vtile, qtile, ktile, reinterpret_cast<float*>(smem + 10240), reinterpret_cast<float4*>(smem + 12288), nullptr);
    gate_prefetch<DK, false>(p, nsidx, nc, R.pre);
    __syncthreads();
    {
        bf16x8 bq[DK / 32];
#pragma unroll
        for (int ks = 0; ks < DK / 32; ++ks) bq[ks] = row_frag(qtile, (unsigned)lane, (unsigned)w, (unsigned)ks);
#pragma unroll
        for (int jb = 0; jb < 4; ++jb) {
            f32x4 a = f32x4{0, 0, 0, 0};
            if (jb <= w) {
#pragma unroll
                for (int ks = 0; ks < DK / 32; ++ks) {
                    const bf16x8 ak = row_frag(ktile, (unsigned)lane, (unsigned)jb, (unsigned)ks);
                    a = mfma16(ak, bq[ks], a);
                }
            }
            const int i = w * 16 + l15, j0 = jb * 16 + 4 * lg;
            const float v0 = (j0 + 0 <= i) ? a[0] : 0.f, v1 = (j0 + 1 <= i) ? a[1] : 0.f, v2 = (j0 + 2 <= i) ? a[2] : 0.f, v3 = (j0 + 3 <= i) ? a[3] : 0.f;
            uint2 o; o.x = pack2(v0, v1); o.y = pack2(v2, v3);
            *reinterpret_cast<uint2*>(PL + i * PL_PITCH + j0) = o;
        }
    }
    __syncthreads();
    f32x4 acc[2][4];
#pragma unroll
    for (int x = 0; x < 2; ++x)
#pragma unroll
        for (int y = 0; y < 4; ++y) acc[x][y] = f32x4{0, 0, 0, 0};
#pragma unroll
    for (int ks = 0; ks < 2; ++ks) {
        bf16x8 bp[4], avx[2];
#pragma unroll
        for (int x = 0; x < 2; ++x) avx[x] = tr_frag((unsigned)(size_t)vtile, (unsigned)lane, (unsigned)(2 * w + x), (unsigned)ks);
#pragma unroll
        for (int y = 0; y < 4; ++y) bp[y] = *reinterpret_cast<const bf16x8*>(PL + (y * 16 + l15) * PL_PITCH + ks * 32 + 8 * lg);
#pragma unroll
        for (int x = 0; x < 2; ++x)
#pragma unroll
            for (int y = 0; y < 4; ++y) acc[x][y] = mfma16(avx[x], bp[y], acc[x][y]);
    }
#pragma unroll
    for (int ks = 0; ks < DK / 32; ++ks) {
#pragma unroll
        for (int x = 0; x < 2; ++x)
#pragma unroll
            for (int y = 0; y < 4; ++y) acc[x][y] = mfma16(R.ast[ks][x], row_frag(qtile, (unsigned)lane, (unsigned)y, (unsigned)ks), acc[x][y]);
    }
    out_load_ast<DK>(p, nsidx, nc, R);
    float ssq[4];
#pragma unroll
    for (int y = 0; y < 4; ++y) {
        float s = 0.f;
#pragma unroll
        for (int x = 0; x < 2; ++x)
#pragma unroll
            for (int r = 0; r < 4; ++r) s += acc[x][y][r] * acc[x][y][r];
        s += __shfl_xor(s, 16); s += __shfl_xor(s, 32);
        ssq[y] = s;
    }
    if (lg == 0) {
#pragma unroll
        for (int y = 0; y < 4; ++y) RED[w * 64 + y * 16 + l15] = ssq[y];
    }
    __syncthreads();
#pragma unroll
    for (int y = 0; y < 4; ++y) {
        const int i = y * 16 + l15;
        const float tot = RED[i] + RED[64 + i] + RED[128 + i] + RED[192 + i];
        const float rstd = rsqrtf(tot * (1.f / 128.f) + 1e-6f);
#pragma unroll
        for (int x = 0; x < 2; ++x) {
            const int dv = (2 * w + x) * 16 + 4 * lg;
            const float4 g4 = g4v[x];
            const gu32x2 gt = R.gtv[y][x];
            uint2 o;
            o.x = pack2(acc[x][y][0] * rstd * g4.x * bflo(gt.x), acc[x][y][1] * rstd * g4.y * bfhi(gt.x));
            o.y = pack2(acc[x][y][2] * rstd * g4.z * bflo(gt.y), acc[x][y][3] * rstd * g4.w * bfhi(gt.y));
            *reinterpret_cast<uint2*>(MIX + (size_t)i * 1024 + dv) = o;
        }
    }
    out_load_gates<DK>(p, nsidx, nc, R);
    __syncthreads();
}
template <int DK>
DEVI void phase5_loop(const Params& p, int hb, char* hsm) {
    OutRegs<DK> R;
    const int stride = (int)gridDim.x * 2;
    int v = (int)blockIdx.x * 2 + hb;
    const int lane = LTID & 63, w = LTID >> 6;
    const float* ng = (DK == 128) ? p.hg_norm_g : p.gla_norm_g;
    const float4 g4v[2] = {*reinterpret_cast<const float4*>(ng + (2 * w) * 16 + 4 * (lane >> 4)), *reinterpret_cast<const float4*>(ng + (2 * w + 1) * 16 + 4 * (lane >> 4))};
    if (v < 2048) {
        gate_prefetch<DK, false>(p, v >> 7, v & 127, R.pre); out_load_ast<DK>(p, v >> 7, v & 127, R); dummy_stores<8>(p.ws); out_load_gates<DK>(p, v >> 7, v & 127, R);
    }
    for (; v < 2048; v += stride) {
        const int nv = (v + stride < 2048) ? v + stride : v;
        out_unit<DK>(p, v >> 7, v & 127, nv >> 7, nv & 127, hsm, R, g4v);
    }
}

DEVI void rms_row16_bf16_i8(const bf16_t* __restrict__ xr, const float* __restrict__ g, bf16_t* __restrict__ dst, unsigned char* __restrict__ dst8, float* __restrict__ descale, int lane) {
    float v[2][8]; float ss = 0.f;
#pragma unroll
    for (int i = 0; i < 2; ++i) {
        const uint4 q = reinterpret_cast<const uint4*>(xr)[lane + 64 * i];
        v[i][0] = bflo(q.x); v[i][1] = bfhi(q.x); v[i][2] = bflo(q.y); v[i][3] = bfhi(q.y); v[i][4] = bflo(q.z); v[i][5] = bfhi(q.z); v[i][6] = bflo(q.w); v[i][7] = bfhi(q.w);
#pragma unroll
        for (int j = 0; j < 8; ++j) ss += v[i][j] * v[i][j];
    }
    ss = wave_sum(ss);
    const float r = rsqrtf(ss * (1.f / 1024.f) + 1e-6f);
    float am = 0.f;
#pragma unroll
    for (int i = 0; i < 2; ++i) {
        const float4 g0 = reinterpret_cast<const float4*>(g)[2 * (lane + 64 * i)], g1 = reinterpret_cast<const float4*>(g)[2 * (lane + 64 * i) + 1];
        v[i][0] *= r * g0.x; v[i][1] *= r * g0.y; v[i][2] *= r * g0.z; v[i][3] *= r * g0.w; v[i][4] *= r * g1.x; v[i][5] *= r * g1.y; v[i][6] *= r * g1.z; v[i][7] *= r * g1.w;
        reinterpret_cast<uint4*>(dst)[lane + 64 * i] = make_uint4(pack2(v[i][0], v[i][1]), pack2(v[i][2], v[i][3]), pack2(v[i][4], v[i][5]), pack2(v[i][6], v[i][7]));
#pragma unroll
        for (int j = 0; j < 8; ++j) am = fmaxf(am, fabsf(v[i][j]));
    }
    am = wave_max(am);
    const float sc = am > 0.f ? 127.f / am : 1.f;
#pragma unroll
    for (int i = 0; i < 2; ++i)
        reinterpret_cast<int2*>(dst8)[lane + 64 * i] = make_int2(pack_i8x4(v[i][0] * sc, v[i][1] * sc, v[i][2] * sc, v[i][3] * sc), pack_i8x4(v[i][4] * sc, v[i][5] * sc, v[i][6] * sc, v[i][7] * sc));
    if (lane == 0) *descale = am > 0.f ? am * (1.f / 127.f) : 1.f;
}
constexpr int P7_UNITS = 8192;
DEVI void phase7_unit(const Params& p, int u, char* smem) {
    const int lane = LTID & 63, w = LTID >> 6;
    const int row = u * 4 + w;
    rms_row16_bf16_i8(reinterpret_cast<const bf16_t*>(p.ws + OFF_H16) + (size_t)row * DM, p.norm2_g, reinterpret_cast<bf16_t*>(p.ws + OFF_HN) + (size_t)row * DM,
                      p.ws + OFF_HN8 + (size_t)row * DM, reinterpret_cast<float*>(p.ws + OFF_HS) + row, lane);
}

using f32x16 = __attribute__((ext_vector_type(16))) float;
DEVI f32x16 mfma32(bf16x8 a, bf16x8 b, f32x16 c) { return __builtin_amdgcn_mfma_f32_32x32x16_bf16(a, b, c, 0, 0, 0); }
DEVI unsigned umax(unsigned a, unsigned b) { return a > b ? a : b; }
DEVI unsigned umin(unsigned a, unsigned b) { return a > b ? b : a; }
DEVI unsigned f2ord(float f) { const unsigned u = __float_as_uint(f); return u ^ ((unsigned)((int)u >> 31) | 0x80000000u); }
DEVI float ord2f(unsigned k) { return __uint_as_float((k & 0x80000000u) ? (k ^ 0x80000000u) : ~k); }

template <int BASE>
DEVI void sort16_desc(unsigned (&x)[64]) {
#pragma unroll
    for (int k = 2; k <= 16; k <<= 1) {
#pragma unroll
        for (int j = k >> 1; j > 0; j >>= 1) {
#pragma unroll
            for (int i = 0; i < 16; ++i) {
                const int l = i ^ j;
                if (l > i) {
                    const bool desc = ((i & k) == 0);
                    const unsigned a = x[BASE + i], b = x[BASE + l];
                    const unsigned hi = umax(a, b), lo = umin(a, b);
                    x[BASE + i] = desc ? hi : lo; x[BASE + l] = desc ? lo : hi;
                }
            }
        }
    }
}
template <int BASE>
DEVI void bmerge16_desc(unsigned (&x)[64]) {
#pragma unroll
    for (int j = 8; j > 0; j >>= 1) {
#pragma unroll
        for (int i = 0; i < 16; ++i) {
            const int l = i ^ j;
            if (l > i) { const unsigned a = x[BASE + i], b = x[BASE + l]; x[BASE + i] = umax(a, b); x[BASE + l] = umin(a, b); }
        }
    }
}
DEVI void top16_of_64(unsigned (&x)[64]) {
    sort16_desc<0>(x); sort16_desc<16>(x); sort16_desc<32>(x); sort16_desc<48>(x);
#pragma unroll
    for (int i = 0; i < 16; ++i) x[i] = umax(x[i], x[31 - i]);
    bmerge16_desc<0>(x);
#pragma unroll
    for (int i = 0; i < 16; ++i) x[32 + i] = umax(x[32 + i], x[63 - i]);
    bmerge16_desc<32>(x);
#pragma unroll
    for (int i = 0; i < 16; ++i) x[i] = umax(x[i], x[47 - i]);
    bmerge16_desc<0>(x);
}

DEVI void scores_top16(const char* sktile, const bf16_t* __restrict__ Qp, int lane, unsigned (&out)[16]) {
    const int r31 = lane & 31, hh = lane >> 5;
    f32x16 acc[4];
#pragma unroll
    for (int nb = 0; nb < 4; ++nb)
#pragma unroll
        for (int r = 0; r < 16; ++r) acc[nb][r] = 0.f;
#pragma unroll
    for (int ks = 0; ks < 8; ++ks) {
        const bf16x8 bq = ldg_frag(Qp + (size_t)r31 * 2048 + ks * 16 + 8 * hh);
#pragma unroll
        for (int nb = 0; nb < 4; ++nb) {
            const bf16x8 ak = *reinterpret_cast<const bf16x8*>(sktile + off_b((unsigned)(nb * 32 + r31), (unsigned)(2 * ks + hh)));
            acc[nb] = mfma32(ak, bq, acc[nb]);
        }
    }
    unsigned x[64];
    const unsigned hx = (unsigned)hh * 4u;
#pragma unroll
    for (int nb = 0; nb < 4; ++nb)
#pragma unroll
        for (int r = 0; r < 16; ++r) {
            const int nbase = nb * 32 + (r & 3) + 8 * (r >> 2);
            x[nb * 16 + r] = ((f2ord(acc[nb][r]) & ~127u) | (unsigned)(127 - nbase)) ^ hx;
        }
    top16_of_64(x);
    unsigned lo[16], hi[16];
#pragma unroll
    for (int i = 0; i < 16; ++i) { auto rr = __builtin_amdgcn_permlane32_swap(x[i], x[i], false, false); lo[i] = rr[0]; hi[i] = rr[1]; }
#pragma unroll
    for (int i = 0; i < 16; ++i) x[i] = umax(lo[i], hi[15 - i]);
    bmerge16_desc<0>(x);
#pragma unroll
    for (int i = 0; i < 16; ++i) out[i] = x[i];
}

DEVI void phase9_block(const Params& p, char* smem) {
    unsigned char* ws = p.ws;
    const int tid = threadIdx.x, lane = tid & 63, w = tid >> 6;
    const int h = blockIdx.x & 7, rank = blockIdx.x >> 3, nrank = ((int)gridDim.x - h + 7) >> 3;
    const int hh = lane >> 5;
    {
        const bf16_t* SK = reinterpret_cast<const bf16_t*>(ws + OFF_SK) + (size_t)(h * 2) * 128 * 128;
#pragma unroll
        for (int i = 0; i < 8; ++i) {
            const int nn = tid + 512 * i, tl = nn >> 11, row = (nn >> 4) & 127, ch = nn & 15;
            *reinterpret_cast<uint4*>(smem + tl * 32768 + off_b((unsigned)row, (unsigned)ch)) = *reinterpret_cast<const uint4*>(SK + (size_t)tl * 16384 + row * 128 + ch * 8);
        }
    }
    __syncthreads();
    unsigned* KL = reinterpret_cast<unsigned*>(smem + 65536) + w * 2048;
    for (int it = rank; it < M_TOK / 256; it += nrank) {
    const int t0 = it * 256 + w * 32;
    const bf16_t* Q = reinterpret_cast<const bf16_t*>(ws + OFF_Q) + (size_t)t0 * 2048 + h * 256;
    unsigned k0[16], k1[16];
    scores_top16(smem, Q, lane, k0);
    scores_top16(smem + 32768, Q + 128, lane, k1);
#pragma unroll
    for (int i = 0; i < 16; ++i) { KL[i * 64 + lane] = k0[i]; KL[(16 + i) * 64 + lane] = k1[i]; }
    float s0[16], s1[16];
#pragma unroll
    for (int i = 0; i < 16; ++i) { s0[i] = ord2f(k0[i] & ~127u); s1[i] = ord2f(k1[i] & ~127u); }
    unsigned x[64];
    {
        int n = 0;
#pragma unroll
        for (int a = 0; a < 16; ++a)
#pragma unroll
            for (int b = 0; b < 16; ++b)
                if ((a + 1) * (b + 1) <= 16) { x[n] = (f2ord(s0[a] + s1[b]) & ~255u) | (unsigned)(255 - (a * 16 + b)); ++n; }
#pragma unroll
        for (int i = 50; i < 64; ++i) x[i] = 0u;
    }
    top16_of_64(x);
    float cv[16]; int ex[16];
#pragma unroll
    for (int i = 0; i < 16; ++i) {
        cv[i] = ord2f(x[i] & ~255u);
        const int cid = 255 - (int)(x[i] & 255u);
        const unsigned ka = KL[(cid >> 4) * 64 + lane], kb = KL[(16 + (cid & 15)) * 64 + lane];
        ex[i] = (127 - (int)(ka & 127u)) * 128 + (127 - (int)(kb & 127u));
    }
    float sum = 0.f;
    const float mx = cv[0];
#pragma unroll
    for (int i = 0; i < 16; ++i) cv[i] = __expf(cv[i] - mx);
#pragma unroll
    for (int i = 0; i < 16; ++i) sum += cv[i];
    const float inv = __builtin_amdgcn_rcpf(sum);
    const size_t orow = (size_t)(t0 + (lane & 31)) * 128 + h * 16;
    if (hh == 0) {
        int4* d = reinterpret_cast<int4*>(reinterpret_cast<int*>(ws + OFF_EIDX) + orow);
#pragma unroll
        for (int i = 0; i < 4; ++i) d[i] = make_int4(ex[4 * i], ex[4 * i + 1], ex[4 * i + 2], ex[4 * i + 3]);
        const float* US = reinterpret_cast<const float*>(ws + OFF_US);
        float4* du = reinterpret_cast<float4*>(reinterpret_cast<float*>(ws + OFF_EU) + orow);
#pragma unroll
        for (int i = 0; i < 4; ++i) du[i] = make_float4(US[ex[4 * i]], US[ex[4 * i + 1]], US[ex[4 * i + 2]], US[ex[4 * i + 3]]);
    } else {
        const float* VS = reinterpret_cast<const float*>(ws + OFF_VS);
        float4* d = reinterpret_cast<float4*>(reinterpret_cast<float*>(ws + OFF_EW) + orow);
#pragma unroll
        for (int i = 0; i < 4; ++i) d[i] = make_float4(cv[4 * i] * inv * VS[ex[4 * i]], cv[4 * i + 1] * inv * VS[ex[4 * i + 1]], cv[4 * i + 2] * inv * VS[ex[4 * i + 2]], cv[4 * i + 3] * inv * VS[ex[4 * i + 3]]);
        }
}
}

typedef _Float16 h2_t __attribute__((ext_vector_type(2)));
DEVI float sum8(float v) { v += dpp_f<0xB1>(v); v += dpp_f<0x4E>(v); v += dpp_f<0x141>(v); return v; }
DEVI float sum64(float v) {
    v = sum8(v); v += dpp_f<0x128>(v);
    { auto s = __builtin_amdgcn_permlane16_swap(__float_as_uint(v), __float_as_uint(v), false, false); v = __uint_as_float(s[0]) + __uint_as_float(s[1]); }
    { auto s = __builtin_amdgcn_permlane32_swap(__float_as_uint(v), __float_as_uint(v), false, false); v = __uint_as_float(s[0]) + __uint_as_float(s[1]); }
    return v;
}
DEVI long pack_i64(unsigned lo, unsigned hi) { return (long)(((unsigned long long)hi << 32) | (unsigned long long)lo); }

#define SB __builtin_amdgcn_sched_barrier(0)
#define SB __builtin_amdgcn_sched_barrier(0)
#define PIN4(Q) "+v"(Q.x), "+v"(Q.y), "+v"(Q.z), "+v"(Q.w)
DEVI void phase10a_block(const Params& p, char* smem) {
    unsigned char* ws = p.ws;
    const int s = blockIdx.x & 7, rank = blockIdx.x >> 3, nrank = ((int)gridDim.x - s + 7) >> 3;
    const int lane = threadIdx.x & 63, wave = threadIdx.x >> 6;
    const int lg = lane & 7, grp = lane >> 3;
    const unsigned char* U8 = ws + OFF_U8 + (size_t)s * (16384 * 128);
    const unsigned char* HNs = ws + OFF_HN8 + 128 * s + 16 * lg;
    unsigned* PD = reinterpret_cast<unsigned*>(ws + OFF_PD) + (size_t)s * M_TOK * 64;
    float* stg = reinterpret_cast<float*>(smem) + wave * (16 * 128);
    constexpr int NTG = M_TOK / 8;
#define P10A_LOAD_EV(TG, E) do { const int4* _q = reinterpret_cast<const int4*>(reinterpret_cast<const int*>(ws + OFF_EIDX) + (size_t)((TG) * 8 + wave) * 128 + 16 * grp); \
        E[0] = _q[0]; E[1] = _q[1]; E[2] = _q[2]; E[3] = _q[3]; } while (0)
#define P10A_LOAD_ROWS(TG, E, R, HA) do { \
        asm volatile("" : PIN4(E[0]), PIN4(E[1]), PIN4(E[2]), PIN4(E[3])); \
        const int _e[16] = {E[0].x, E[0].y, E[0].z, E[0].w, E[1].x, E[1].y, E[1].z, E[1].w, E[2].x, E[2].y, E[2].z, E[2].w, E[3].x, E[3].y, E[3].z, E[3].w}; \
        _Pragma("unroll") for (int _i = 0; _i < 16; ++_i) R[_i] = *reinterpret_cast<const uint4*>(U8 + ((unsigned)_e[_i] * 128u + 16u * (unsigned)lg)); \
        HA = *reinterpret_cast<const uint4*>(HNs + (size_t)((TG) * 8 + wave) * DM); } while (0)
#define P10A_COMPUTE(SLOT, R, HA) do { \
        asm volatile("" : PIN4(R[0]), PIN4(R[1]), PIN4(R[2]), PIN4(R[3]), PIN4(R[4]), PIN4(R[5])); \
        asm volatile("" : PIN4(R[6]), PIN4(R[7]), PIN4(R[8]), PIN4(R[9]), PIN4(R[10]), PIN4(R[11])); \
        asm volatile("" : PIN4(R[12]), PIN4(R[13]), PIN4(R[14]), PIN4(R[15]), PIN4(HA)); \
        int _v1 = 0, _v2 = 0; \
        _Pragma("unroll") for (int _i = 0; _i < 16; ++_i) { \
            int _a = __builtin_amdgcn_sdot4((int)R[_i].x, (int)HA.x, 0, false); \
            _a = __builtin_amdgcn_sdot4((int)R[_i].y, (int)HA.y, _a, false); \
            _a = __builtin_amdgcn_sdot4((int)R[_i].z, (int)HA.z, _a, false); \
            _a = __builtin_amdgcn_sdot4((int)R[_i].w, (int)HA.w, _a, false); \
            _a += __builtin_amdgcn_mov_dpp(_a, 0xB1, 0xf, 0xf, true); _a += __builtin_amdgcn_mov_dpp(_a, 0x4E, 0xf, 0xf, true); _a += __builtin_amdgcn_mov_dpp(_a, 0x141, 0xf, 0xf, true); \
            if (_i < 8) _v1 = (lg == _i) ? _a : _v1; else _v2 = (lg == _i - 8) ? _a : _v2; } \
        stg[(SLOT) * 128 + 16 * grp + lg] = (float)_v1; stg[(SLOT) * 128 + 16 * grp + 8 + lg] = (float)_v2; } while (0)
    int4 eA[4], eB[4], eC[4]; uint4 rA[16], rB[16]; uint4 hA0, hB0;
    if (rank >= NTG) return;
    const int ntok = (NTG - rank + nrank - 1) / nrank;
#define TGI(I) (rank + ((I) < ntok ? (I) : ntok - 1) * nrank)
    P10A_LOAD_EV(TGI(0), eA);
    SB; P10A_LOAD_EV(TGI(1), eB);
    SB; P10A_LOAD_ROWS(TGI(0), eA, rA, hA0);
    SB;
    for (int base = 0; base < ntok; base += 16) {
#pragma unroll 1
        for (int i = base; i < base + 16; i += 2) {
            SB; P10A_LOAD_EV(TGI(i + 2), eC);
            SB; P10A_LOAD_ROWS(TGI(i + 1), eB, rB, hB0);
            SB; P10A_COMPUTE(i - base, rA, hA0);
            SB; P10A_LOAD_EV(TGI(i + 3), eB);
            SB; P10A_LOAD_ROWS(TGI(i + 2), eC, rA, hA0);
            SB; P10A_COMPUTE(i + 1 - base, rB, hB0);
            SB;
        }
#pragma unroll 4
        for (int j = 0; j < 16; ++j) {
            const float2 v = *reinterpret_cast<const float2*>(stg + j * 128 + 2 * lane);
            PD[(size_t)(TGI(base + j) * 8 + wave) * 64 + lane] = pack2(v.x, v.y);
        }
        __builtin_amdgcn_s_waitcnt(0x0F70);
    }
#undef TGI
#undef P10A_LOAD_EV
#undef P10A_LOAD_ROWS
#undef P10A_COMPUTE
}

DEVI void phase10w_block(const Params& p) {
    unsigned char* ws = p.ws;
    const int lane = threadIdx.x & 63, wave = threadIdx.x >> 6;
    const unsigned* PD = reinterpret_cast<const unsigned*>(ws + OFF_PD);
    const float* HS = reinterpret_cast<const float*>(ws + OFF_HS);
    for (int t = blockIdx.x * 8 + wave; t < M_TOK; t += gridDim.x * 8) {
        unsigned pd[8];
#pragma unroll
        for (int sl = 0; sl < 8; ++sl) pd[sl] = PD[((size_t)sl * M_TOK + t) * 64 + lane];
        const float2 uu = reinterpret_cast<const float2*>(ws + OFF_EU)[(size_t)t * 64 + lane];
        const float2 gg = reinterpret_cast<const float2*>(ws + OFF_EW)[(size_t)t * 64 + lane];
        const float hs = HS[t];
        float d0 = 0.f, d1 = 0.f;
#pragma unroll
        for (int sl = 0; sl < 8; ++sl) { d0 += bflo(pd[sl]); d1 += bfhi(pd[sl]); }
        d0 *= uu.x * hs; d1 *= uu.y * hs;
        const _Float16 w0 = (_Float16)(gg.x * 0.5f * d0 * (1.f + erff(d0 * 0.70710678118654752f))), w1 = (_Float16)(gg.y * 0.5f * d1 * (1.f + erff(d1 * 0.70710678118654752f)));
        const h2_t p0 = h2_t{w0, w0}, p1 = h2_t{w1, w1};
        reinterpret_cast<uint2*>(ws + OFF_W16)[(size_t)t * 64 + lane] = make_uint2(__builtin_bit_cast(unsigned, p0), __builtin_bit_cast(unsigned, p1));
    }
}

template <bool DRY>
DEVI void phase10b_block(const Params& p, char* smem) {
    unsigned char* ws = p.ws;
    const int s = blockIdx.x & 7, rank = blockIdx.x >> 3, nrank = ((int)gridDim.x - s + 7) >> 3;
    const int lane = threadIdx.x & 63, wave = threadIdx.x >> 6;
    const int lg = lane & 7, grp = lane >> 3;
    const unsigned char* V8 = ws + OFF_V8 + (size_t)s * (16384 * 128);
    float* stg = reinterpret_cast<float*>(smem) + wave * (16 * 128);
    constexpr int NTG = M_TOK / 8;
#define P10B_LOAD_EV(TG, E) do { const int4* _q = reinterpret_cast<const int4*>(reinterpret_cast<const int*>(ws + OFF_EIDX) + (size_t)((TG) * 8 + wave) * 128 + 16 * grp); \
        E[0] = _q[0]; E[1] = _q[1]; E[2] = _q[2]; E[3] = _q[3]; } while (0)
#define P10B_LOAD_ROWS(TG, E, R, WA, WB, WC, WD) do { \
        asm volatile("" : PIN4(E[0]), PIN4(E[1]), PIN4(E[2]), PIN4(E[3])); \
        const int _e[16] = {E[0].x, E[0].y, E[0].z, E[0].w, E[1].x, E[1].y, E[1].z, E[1].w, E[2].x, E[2].y, E[2].z, E[2].w, E[3].x, E[3].y, E[3].z, E[3].w}; \
        _Pragma("unroll") for (int _i = 0; _i < 16; ++_i) R[_i] = *reinterpret_cast<const uint4*>(V8 + ((unsigned)_e[_i] * 128u + 16u * (unsigned)lg)); \
        const uint4* _w = reinterpret_cast<const uint4*>(reinterpret_cast<const unsigned*>(ws + OFF_W16) + (size_t)((TG) * 8 + wave) * 128 + 16 * grp); WA = _w[0]; WB = _w[1]; WC = _w[2]; WD = _w[3]; } while (0)
#define P10B_COMPUTE(SLOT, R, WA, WB, WC, WD) do { \
          \
        asm volatile("" : PIN4(R[0]), PIN4(R[1]), PIN4(R[2]), PIN4(R[3]), PIN4(R[4]), PIN4(R[5])); \
        asm volatile("" : PIN4(R[6]), PIN4(R[7]), PIN4(R[8]), PIN4(R[9]), PIN4(R[10]), PIN4(R[11])); \
        asm volatile("" : PIN4(R[12]), PIN4(R[13]), PIN4(R[14]), PIN4(R[15]), PIN4(WA), PIN4(WB)); \
        asm volatile("" : PIN4(WC), PIN4(WD)); \
        const unsigned _ww[16] = {WA.x, WA.y, WA.z, WA.w, WB.x, WB.y, WB.z, WB.w, WC.x, WC.y, WC.z, WC.w, WD.x, WD.y, WD.z, WD.w}; \
        h2_t _acc[8]; unsigned _zb; asm volatile("v_mov_b32 %0, 0" : "=v"(_zb)); \
        _Pragma("unroll") for (int _j = 0; _j < 8; ++_j) _acc[_j] = __builtin_bit_cast(h2_t, _zb); \
        _Pragma("unroll") for (int _i = 0; _i < 16; ++_i) { \
            const h2_t _wp = __builtin_bit_cast(h2_t, _ww[_i]); \
            const unsigned _wd[4] = {R[_i].x, R[_i].y, R[_i].z, R[_i].w}; \
            _Pragma("unroll") for (int _j = 0; _j < 4; ++_j) { \
                _acc[2 * _j] += _wp * __builtin_amdgcn_cvt_scalef32_pk_f16_fp8((int)_wd[_j], 1.0f, false); \
                _acc[2 * _j + 1] += _wp * __builtin_amdgcn_cvt_scalef32_pk_f16_fp8((int)_wd[_j], 1.0f, true); } } \
          \
          \
        h2_t _r5[4], _r4[2]; \
        _Pragma("unroll") for (int _j = 0; _j < 4; ++_j) { auto _s = __builtin_amdgcn_permlane32_swap(__builtin_bit_cast(unsigned, _acc[_j]), __builtin_bit_cast(unsigned, _acc[_j + 4]), false, false); \
            _r5[_j] = __builtin_bit_cast(h2_t, (unsigned)_s[0]) + __builtin_bit_cast(h2_t, (unsigned)_s[1]); } \
        _Pragma("unroll") for (int _j = 0; _j < 2; ++_j) { auto _s = __builtin_amdgcn_permlane16_swap(__builtin_bit_cast(unsigned, _r5[_j]), __builtin_bit_cast(unsigned, _r5[_j + 2]), false, false); \
            _r4[_j] = __builtin_bit_cast(h2_t, (unsigned)_s[0]) + __builtin_bit_cast(h2_t, (unsigned)_s[1]); } \
        { const bool _b3 = (lane & 8) != 0; \
          const unsigned _send = _b3 ? __builtin_bit_cast(unsigned, _r4[0]) : __builtin_bit_cast(unsigned, _r4[1]); \
          const h2_t _keep = _b3 ? _r4[1] : _r4[0]; \
          const h2_t _res = _keep + __builtin_bit_cast(h2_t, __builtin_amdgcn_mov_dpp((int)_send, 0x128, 0xf, 0xf, true));     \
          *reinterpret_cast<float2*>(stg + (SLOT) * 128 + 16 * lg + 2 * grp) = make_float2((float)_res[0], (float)_res[1]); } } while (0)
    int4 eA[4], eB[4], eC[4]; uint4 rA[16], rB[16]; uint4 wA0, wA1, wA2, wA3, wB0, wB1, wB2, wB3;
    if (rank >= NTG) return;
    const int ntok = (NTG - rank + nrank - 1) / nrank;
#define TGI(I) (rank + ((I) < ntok ? (I) : ntok - 1) * nrank)
    P10B_LOAD_EV(TGI(0), eA);
    SB; P10B_LOAD_EV(TGI(1), eB);
    SB; P10B_LOAD_ROWS(TGI(0), eA, rA, wA0, wA1, wA2, wA3);
    SB;
    for (int base = 0; base < ntok; base += 16) {
#pragma unroll 1
        for (int i = base; i < base + 16; i += 2) {
            SB; P10B_LOAD_EV(TGI(i + 2), eC);
            SB; P10B_LOAD_ROWS(TGI(i + 1), eB, rB, wB0, wB1, wB2, wB3);
            SB; P10B_COMPUTE(i - base, rA, wA0, wA1, wA2, wA3);
            SB; P10B_LOAD_EV(TGI(i + 3), eB);
            SB; P10B_LOAD_ROWS(TGI(i + 2), eC, rA, wA0, wA1, wA2, wA3);
            SB; P10B_COMPUTE(i + 1 - base, rB, wB0, wB1, wB2, wB3);
            SB;
        }
#pragma unroll 4
        for (int j = 0; j < 16; ++j) {
            const float2 v = *reinterpret_cast<const float2*>(stg + j * 128 + 2 * lane);
            reinterpret_cast<unsigned*>(ws + OFF_PEER)[(DRY ? (size_t)M_TOK * 512 : 0) + (size_t)(TGI(base + j) * 8 + wave) * 512 + 64 * s + lane] = pack2(v.x, v.y);
        }
        __builtin_amdgcn_s_waitcnt(0x0F70);
    }
#undef TGI
#undef P10B_LOAD_EV
#undef P10B_LOAD_ROWS
#undef P10B_COMPUTE
}

DEVI void phase10c_block(const Params& p) {
    unsigned char* ws = p.ws;
    const int lane = threadIdx.x & 63, wave = threadIdx.x >> 6;
    const float4* gf = reinterpret_cast<const float4*>(p.norm_f_g);
    for (int t = blockIdx.x * 8 + wave; t < M_TOK; t += gridDim.x * 8) {
        const uint4* hrow = reinterpret_cast<const uint4*>(ws + OFF_H16) + (size_t)t * 128;
        const uint4* prow = reinterpret_cast<const uint4*>(ws + OFF_PEER) + (size_t)t * 128;
        float4* orow = reinterpret_cast<float4*>(p.out + (size_t)t * DM);
        uint4 hq[2], pq[2];
#pragma unroll
        for (int i = 0; i < 2; ++i) { hq[i] = hrow[lane + 64 * i]; pq[i] = prow[lane + 64 * i]; }
        float v[2][8]; float ss = 0.f;
#pragma unroll
        for (int i = 0; i < 2; ++i) {
            v[i][0] = bflo(hq[i].x) + bflo(pq[i].x); v[i][1] = bfhi(hq[i].x) + bfhi(pq[i].x); v[i][2] = bflo(hq[i].y) + bflo(pq[i].y); v[i][3] = bfhi(hq[i].y) + bfhi(pq[i].y);
            v[i][4] = bflo(hq[i].z) + bflo(pq[i].z); v[i][5] = bfhi(hq[i].z) + bfhi(pq[i].z); v[i][6] = bflo(hq[i].w) + bflo(pq[i].w); v[i][7] = bfhi(hq[i].w) + bfhi(pq[i].w);
#pragma unroll
            for (int j = 0; j < 8; ++j) ss += v[i][j] * v[i][j];
        }
        const float r = rsqrtf(wave_sum(ss) * (1.f / 1024.f) + 1e-6f);
#pragma unroll
        for (int i = 0; i < 2; ++i) {
            const float4 g0 = gf[2 * (lane + 64 * i)], g1 = gf[2 * (lane + 64 * i) + 1];
            orow[2 * (lane + 64 * i)] = make_float4(v[i][0] * r * g0.x, v[i][1] * r * g0.y, v[i][2] * r * g0.z, v[i][3] * r * g0.w);
            orow[2 * (lane + 64 * i) + 1] = make_float4(v[i][4] * r * g1.x, v[i][5] * r * g1.y, v[i][6] * r * g1.z, v[i][7] * r * g1.w);
        }
    }
}

#define XB_TMO      128
#define XB_XCNT(j)  (256  + 64 * (j))
#define XB_XSUB(j)  (1280 + 64 * (j))
#define XB_XGEN(j)  (2304 + 64 * (j))
#define XB_TOP      3328
#define XB_TOPGEN   3392
#define XCD_BAR_WORDS 3456
#define XB_SPIN_CAP (1u << 22)
#define LAS __attribute__((address_space(3)))
DEVI unsigned xb_ld(unsigned* p)              { return __hip_atomic_load(p, __ATOMIC_RELAXED, __HIP_MEMORY_SCOPE_AGENT); }
DEVI unsigned xb_add(unsigned* p, unsigned v) { return __hip_atomic_fetch_add(p, v, __ATOMIC_RELAXED, __HIP_MEMORY_SCOPE_AGENT); }
DEVI unsigned xb_xcc_id() { return (unsigned)__builtin_amdgcn_s_getreg((3 << 11) | 20) & 0xFu; }
#define XB_SPIN(cond, bar) do { unsigned _sp = 0; while (cond) { __builtin_amdgcn_s_sleep(1); \
    if ((++_sp & 255u) == 0u) { if (xb_ld(&(bar)[XB_TMO])) break; if (_sp > XB_SPIN_CAP) { atomicAdd(&(bar)[XB_TMO], 1u); break; } } } } while (0)
struct XcdBarrier { unsigned* bar; unsigned x; volatile LAS unsigned* st; };
DEVI XcdBarrier xcd_barrier_post(unsigned* bar, volatile LAS unsigned* st) {
    XcdBarrier b; b.bar = bar; b.x = xb_xcc_id(); b.st = st;
    if (threadIdx.x == 0) (void)xb_add(&bar[XB_XCNT(b.x)], 1u);
    return b;
}
DEVI void xcd_barrier_complete(unsigned* bar, unsigned x, unsigned& nloc, unsigned& nx) {
    const unsigned G = gridDim.x * gridDim.y * gridDim.z;
    unsigned sum, cnt, mine, sp = 0u;
    for (;;) {
        sum = 0u; cnt = 0u; mine = 0u;
#pragma unroll
        for (unsigned j = 0; j < 16; ++j) { const unsigned c = xb_ld(&bar[XB_XCNT(j)]); sum += c; cnt += (c > 0u) ? 1u : 0u; mine = (j == x) ? c : mine; }
        if (sum == G) break;
        __builtin_amdgcn_s_sleep(1);
        if ((++sp & 255u) == 0u) { if (xb_ld(&bar[XB_TMO])) break; if (sp > XB_SPIN_CAP) { atomicAdd(&bar[XB_TMO], 1u); break; } }
    }
    nloc = mine > 0u ? mine : 1u; nx = cnt > 0u ? cnt : 1u;
}
DEVI void xcd_barrier(const XcdBarrier& b) {
    asm volatile("s_waitcnt vmcnt(0)" ::: "memory");
    __syncthreads();
    if (threadIdx.x == 0) {
        unsigned* bar = b.bar;
        __builtin_amdgcn_s_waitcnt(0);
        unsigned nloc = b.st[0], nx = b.st[1];
        if (nloc == 0u) { xcd_barrier_complete(bar, b.x, nloc, nx); b.st[0] = nloc; b.st[1] = nx; }
        const unsigned old = xb_add(&bar[XB_XSUB(b.x)], 1u);
        const unsigned gen = old / nloc;
        if (old + 1u == (gen + 1u) * nloc) {
            __builtin_amdgcn_fence(__ATOMIC_RELEASE, "agent");
            asm volatile("s_waitcnt vmcnt(0)" ::: "memory");
            const unsigned og = xb_add(&bar[XB_TOP], 1u);
            const unsigned tg = og / nx;
            if (og + 1u == (tg + 1u) * nx) xb_add(&bar[XB_TOPGEN], 1u);
            else XB_SPIN(xb_ld(&bar[XB_TOPGEN]) == tg, bar);
            __builtin_amdgcn_fence(__ATOMIC_ACQUIRE, "agent");
            xb_add(&bar[XB_XGEN(b.x)], 1u);
            asm volatile("s_waitcnt vmcnt(0)" ::: "memory");
        } else {
            XB_SPIN(xb_ld(&bar[XB_XGEN(b.x)]) == gen, bar);
            __builtin_amdgcn_fence(__ATOMIC_ACQUIRE, "agent");
            asm volatile("s_waitcnt vmcnt(0)" ::: "memory");
        }
    }
    __syncthreads();
}

constexpr int N_PHASES = 11;
constexpr int LDS_PHASE_BYTES = 131072;
constexpr int LDS_BYTES = LDS_PHASE_BYTES + 16;

__global__ void __launch_bounds__(512, 2) hymba_fwd(Params p) {
    extern __shared__ __attribute__((aligned(16))) char smem[];
    cg::grid_group grid = cg::this_grid();
    const int lo = p.ph_lo, hi = p.ph_hi;
    volatile LAS unsigned* bst = (volatile LAS unsigned*)(smem + LDS_PHASE_BYTES);
    if (threadIdx.x == 0) { bst[0] = 0u; bst[1] = 0u; bst[2] = 0u; bst[3] = 0u; }
    __syncthreads();
    XcdBarrier xb = xcd_barrier_post(reinterpret_cast<unsigned*>(p.ws + OFF_BAR), bst);
    const int hb = (int)(threadIdx.x >> 8);
    char* hsm = smem + hb * 65536;
#define SEAM(K) if ((K) > lo) { if (hi < 0) grid.sync(); else xcd_barrier(xb); }
#define RUN_PHASE(K, FN, N) if (lo <= (K) && (K) < hi) { SEAM(K) for (int rep = 0; rep < 1 + ((PROBE_DUP >> (K)) & 1); ++rep) { if (rep) xcd_barrier(xb); \
        for (int ub = blockIdx.x * 2; ub < (N); ub += gridDim.x * 2) { const int u = ub + hb; if (u < (N)) FN(p, u, hsm); } } }
#define RUN_GEMM(K, CALL) if (lo <= (K) && (K) < hi) { SEAM(K) CALL; }
    RUN_PHASE(0, phase0_unit, P0_UNITS)
    RUN_GEMM(1, run_gemm(reinterpret_cast<const bf16_t*>(p.ws + OFF_XN), reinterpret_cast<const bf16_t*>(p.ws + OFF_WIN), P1_N, EpiInProj{p.ws}, smem))
    if (lo <= 3 && 3 < hi) { SEAM(3) phase3_loop<128>(p, hb, hsm); phase3_loop<64>(p, hb, hsm); }
#if PROBE_P4
    if (lo <= 4 && 4 < hi) { xcd_barrier(xb); for (int ub = blockIdx.x * 2; ub < P4_UNITS; ub += gridDim.x * 2) { const int u = ub + hb; if (u < P4_UNITS) phase4_dry_unit(p, u, hsm); } }
#endif
    RUN_PHASE(4, phase4_unit, P4_UNITS)
    if (lo <= 5 && 5 < hi) { SEAM(5) phase5_loop<128>(p, hb, hsm); phase5_loop<64>(p, hb, hsm); }
    RUN_GEMM(6, run_gemm(reinterpret_cast<const bf16_t*>(p.ws + OFF_MIX), reinterpret_cast<const bf16_t*>(p.ws + OFF_WOUT), 1024, EpiOutProj{p.x, reinterpret_cast<bf16_t*>(p.ws + OFF_H16)}, smem))
    RUN_PHASE(7, phase7_unit, P7_UNITS)
    RUN_GEMM(8, run_gemm(reinterpret_cast<const bf16_t*>(p.ws + OFF_HN), reinterpret_cast<const bf16_t*>(p.ws + OFF_WQ), 2048, EpiQ{reinterpret_cast<bf16_t*>(p.ws + OFF_Q)}, smem))
    RUN_GEMM(9, phase9_block(p, smem))
    if (lo <= 10 && 10 < hi) {
        SEAM(10)
#if PROBE_P10X == 4
        phase10a_block(p, smem); xcd_barrier(xb);
#endif
        phase10a_block(p, smem);
#if PROBE_P10X == 1
        xcd_barrier(xb); phase10a_block(p, smem);
#endif

        xcd_barrier(xb); phase10w_block(p);
#if PROBE_P10X == 2
        xcd_barrier(xb); phase10b_block<true>(p, smem);
#endif
        xcd_barrier(xb); phase10b_block<false>(p, smem);
        xcd_barrier(xb); phase10c_block(p);
#if PROBE_P10X == 3
        xcd_barrier(xb); phase10c_block(p);
#endif
    }
#undef RUN_PHASE
#undef RUN_GEMM
#undef SEAM
}

extern "C" void kernel_launch(void* const* d_in, const int* in_sizes, int n_in, void* d_out, int out_size, void* d_ws, size_t ws_size, hipStream_t stream) {
    static int grid_blocks = 0;
    if (grid_blocks == 0) {
        if (n_in != 15 || in_sizes[0] != M_TOK * DM || out_size != M_TOK * DM || ws_size < WS_NEED) {
            fprintf(stderr, "kernel_launch: unexpected shapes (n_in %d, in0 %d, out %d, ws %zu)\n", n_in, n_in > 0 ? in_sizes[0] : -1, out_size, ws_size);
            grid_blocks = -1; return;
        }
        int dev = 0, cus = 0, per_cu = 0;
        (void)hipGetDevice(&dev);
        (void)hipDeviceGetAttribute(&cus, hipDeviceAttributeMultiprocessorCount, dev);
        (void)hipFuncSetAttribute((const void*)hymba_fwd, hipFuncAttributeMaxDynamicSharedMemorySize, LDS_BYTES);
        (void)hipOccupancyMaxActiveBlocksPerMultiprocessor(&per_cu, (const void*)hymba_fwd, 512, LDS_BYTES);
        if (per_cu < 1) per_cu = 1;
        if (per_cu > 1) per_cu = 1;
        grid_blocks = cus * per_cu;
    }
    if (grid_blocks < 0) return;
    Params p{};
    p.x = (const float*)d_in[0]; p.norm1_g = (const float*)d_in[1]; p.w_in = (const float*)d_in[2]; p.hg_lower = (const float*)d_in[3];
    p.hg_norm_g = (const float*)d_in[4]; p.gla_wg = (const float*)d_in[5]; p.gla_bg = (const float*)d_in[6]; p.gla_norm_g = (const float*)d_in[7];
    p.w_out = (const float*)d_in[8]; p.norm2_g = (const float*)d_in[9]; p.w_q = (const float*)d_in[10]; p.sub_keys = (const float*)d_in[11];
    p.peer_u = (const float*)d_in[12]; p.peer_v = (const float*)d_in[13]; p.norm_f_g = (const float*)d_in[14];
    p.out = (float*)d_out; p.ws = (unsigned char*)d_ws;
#if N_LAUNCH_MODE == 1
    (void)hipMemsetAsync((unsigned char*)d_ws + OFF_BAR, 0, XCD_BAR_WORDS * 4, stream);
    p.ph_lo = 0; p.ph_hi = N_PHASES;
    void* args[] = {&p};
    hipError_t e = hipLaunchCooperativeKernel((const void*)hymba_fwd, dim3(grid_blocks), dim3(512), args, LDS_BYTES, stream);
    if (e != hipSuccess) fprintf(stderr, "cooperative launch failed: %s (grid %d)\n", hipGetErrorString(e), grid_blocks);
#else
    for (int ph = 0; ph < N_PHASES; ++ph) {
        p.ph_lo = ph; p.ph_hi = ph + 1;
        hipLaunchKernelGGL(hymba_fwd, dim3(grid_blocks), dim3(512), LDS_BYTES, stream, p);
    }
#endif
}
```

```cpp
#include <hip/hip_runtime.h>
#include <hip/hip_cooperative_groups.h>
#include <cstdio>
#include <cstdint>
namespace cg = cooperative_groups;

#ifndef N_LAUNCH_MODE
#define N_LAUNCH_MODE 1
#endif

#ifndef PROBE_DUP
#define PROBE_DUP 0
#endif
#ifndef PROBE_P10_DUP
#define PROBE_P10_DUP 0
#endif
#ifndef P10_SLICED
#define P10_SLICED 0
#endif
#ifndef PROBE_P10A
#define PROBE_P10A 0
#endif
#ifndef PROBE_P10_MASK
#define PROBE_P10_MASK 0x7fffffff
#endif
#ifndef PROBE_P10X
#define PROBE_P10X 0
#endif
#ifndef PROBE_P2T
#define PROBE_P2T 0
#endif
#ifndef PROBE_P4
#define PROBE_P4 0
#endif
#ifndef PROBE_P2G
#define PROBE_P2G 0
#endif
#ifndef PROBE_GEMM_DUP
#define PROBE_GEMM_DUP 0
#endif
#define DEVI __device__ __forceinline__
#define LTID ((int)(threadIdx.x & 255u))
typedef unsigned short bf16_t;
using bf16x8 = __attribute__((ext_vector_type(8))) short;
using f32x4 = __attribute__((ext_vector_type(4))) float;

constexpr int M_TOK = 32768;
constexpr int DM = 1024;
constexpr int IN_WP = 3840;
constexpr size_t MiB = 1024ull * 1024ull;

constexpr size_t OFF_XN   = 0;
constexpr size_t OFF_WIN  = 64 * MiB;
constexpr size_t OFF_WOUT = 72 * MiB;
constexpr size_t OFF_WQ   = 74 * MiB;
constexpr size_t OFF_SK   = 78 * MiB;
constexpr size_t OFF_LB   = 79 * MiB;
constexpr size_t OFF_U8   = 80 * MiB;
constexpr size_t OFF_V8   = 96 * MiB;
constexpr size_t OFF_US   = 112 * MiB;
constexpr size_t OFF_VS   = 113 * MiB;
constexpr size_t OFF_R2   = 144 * MiB;
constexpr size_t OFF_HQ   = OFF_R2;
constexpr size_t OFF_HLF  = OFF_R2 + 32 * MiB;
constexpr size_t OFF_HV   = OFF_R2 + 64 * MiB;
constexpr size_t OFF_HG   = OFF_R2 + 96 * MiB;
constexpr size_t OFF_GQ   = OFF_R2 + 128 * MiB;
constexpr size_t OFF_GK   = OFF_R2 + 144 * MiB;
constexpr size_t OFF_GV   = OFF_R2 + 160 * MiB;
constexpr size_t OFF_GG   = OFF_R2 + 192 * MiB;
constexpr size_t OFF_GLOW = OFF_R2 + 224 * MiB;
constexpr size_t OFF_KTH  = 370 * MiB;
constexpr size_t OFF_KTG  = 402 * MiB;
constexpr size_t OFF_DECH = 418 * MiB;
constexpr size_t OFF_DECG = 419 * MiB;
constexpr size_t OFF_HVT  = 420 * MiB;
constexpr size_t OFF_GVT  = 452 * MiB;
constexpr size_t OFF_H16  = OFF_HVT;
constexpr size_t OFF_DUMMY = 336 * MiB;
constexpr size_t OFF_BAR  = 484 * MiB;
constexpr size_t WS_NEED  = 485 * MiB;
constexpr size_t OFF_MIX  = OFF_XN;
constexpr size_t OFF_HN   = OFF_R2;
constexpr size_t OFF_Q    = OFF_R2 + 64 * MiB;
constexpr size_t OFF_EIDX = OFF_KTH;
constexpr size_t OFF_EW   = OFF_KTH + 16 * MiB;
constexpr size_t OFF_EU   = OFF_KTG;
constexpr size_t OFF_HN8  = OFF_XN;
constexpr size_t OFF_HS   = OFF_XN + 32 * MiB;
constexpr size_t OFF_W16  = OFF_XN + 48 * MiB;
constexpr size_t OFF_SSQ  = OFF_XN + 33 * MiB;
constexpr size_t OFF_PD   = OFF_Q;
constexpr size_t OFF_PEER = OFF_Q + 64 * MiB;
constexpr size_t OUT_STH = 0;
constexpr size_t OUT_STG = 64 * MiB;

struct Params {
    const float* x; const float* norm1_g; const float* w_in; const float* hg_lower; const float* hg_norm_g;
    const float* gla_wg; const float* gla_bg; const float* gla_norm_g; const float* w_out; const float* norm2_g;
    const float* w_q; const float* sub_keys; const float* peer_u; const float* peer_v; const float* norm_f_g;
    float* out; unsigned char* ws;
    int ph_lo, ph_hi;
};

DEVI unsigned short f2bf(float f) {
    unsigned u = __float_as_uint(f);
    u += 0x7fffu + ((u >> 16) & 1u);
    return (unsigned short)(u >> 16);
}
DEVI float bf2f(unsigned short b) { return __uint_as_float(((unsigned)b) << 16); }
DEVI unsigned pack2(float a, float b) { return (unsigned)f2bf(a) | ((unsigned)f2bf(b) << 16); }
DEVI float bflo(unsigned u) { return __uint_as_float(u << 16); }
DEVI float bfhi(unsigned u) { return __uint_as_float(u & 0xffff0000u); }
template <int CTRL> DEVI float dpp_f(float x) { return __builtin_bit_cast(float, __builtin_amdgcn_mov_dpp(__builtin_bit_cast(int, x), CTRL, 0xf, 0xf, true)); }
DEVI float wave_sum(float v) {
    v += dpp_f<0xB1>(v); v += dpp_f<0x4E>(v); v += dpp_f<0x141>(v); v += dpp_f<0x128>(v);
    { auto s = __builtin_amdgcn_permlane16_swap(__float_as_uint(v), __float_as_uint(v), false, false); v = __uint_as_float(s[0]) + __uint_as_float(s[1]); }
    { auto s = __builtin_amdgcn_permlane32_swap(__float_as_uint(v), __float_as_uint(v), false, false); v = __uint_as_float(s[0]) + __uint_as_float(s[1]); }
    return v;
}
DEVI float wave_max(float v) {
    v = fmaxf(v, dpp_f<0xB1>(v)); v = fmaxf(v, dpp_f<0x4E>(v)); v = fmaxf(v, dpp_f<0x141>(v)); v = fmaxf(v, dpp_f<0x128>(v));
    { auto s = __builtin_amdgcn_permlane16_swap(__float_as_uint(v), __float_as_uint(v), false, false); v = fmaxf(__uint_as_float(s[0]), __uint_as_float(s[1])); }
    { auto s = __builtin_amdgcn_permlane32_swap(__float_as_uint(v), __float_as_uint(v), false, false); v = fmaxf(__uint_as_float(s[0]), __uint_as_float(s[1])); }
    return v;
}
DEVI float silu_f(float x) { return x * __builtin_amdgcn_rcpf(1.f + __expf(-x)); }
DEVI f32x4 mfma16(bf16x8 a, bf16x8 b, f32x4 c) { return __builtin_amdgcn_mfma_f32_16x16x32_bf16(a, b, c, 0, 0, 0); }
DEVI bf16x8 ldg_frag(const bf16_t* p) { return *reinterpret_cast<const bf16x8*>(p); }

DEVI void rms_row_bf16(const float* __restrict__ xr, const float* __restrict__ g, bf16_t* __restrict__ dst, int lane) {
    float4 v[4]; float ss = 0.f;
#pragma unroll
    for (int i = 0; i < 4; ++i) { v[i] = reinterpret_cast<const float4*>(xr)[lane + 64 * i]; ss += v[i].x * v[i].x + v[i].y * v[i].y + v[i].z * v[i].z + v[i].w * v[i].w; }
    ss = wave_sum(ss);
    const float r = rsqrtf(ss * (1.f / 1024.f) + 1e-6f);
#pragma unroll
    for (int i = 0; i < 4; ++i) {
        const float4 gg = reinterpret_cast<const float4*>(g)[lane + 64 * i];
        uint2 o; o.x = pack2(v[i].x * r * gg.x, v[i].y * r * gg.y); o.y = pack2(v[i].z * r * gg.z, v[i].w * r * gg.w);
        reinterpret_cast<uint2*>(dst)[lane + 64 * i] = o;
    }
}

DEVI void transpose_tile(const float* __restrict__ src, int Nsrc, bf16_t* __restrict__ dst, int nt, int kt, int mode, float* lds) {
    const int tid = LTID, tx = tid & 63, ty = tid >> 6;
    const int np = nt * 64 + tx;
    int col = np; bool valid = true;
    if (mode == 1) {
        if (np < 3072) col = np; else if (np < 3584) col = np + 16; else if (np < 3600) col = np - 512; else { valid = false; col = 0; }
    }
#pragma unroll 4
    for (int kk = ty; kk < 64; kk += 4) {
        lds[kk * 65 + tx] = valid ? src[(size_t)(kt * 64 + kk) * Nsrc + col] : 0.f;
    }
    __syncthreads();
    const int nl = tid >> 2, kq = tid & 3;
    unsigned pk[8];
#pragma unroll
    for (int i = 0; i < 8; ++i) pk[i] = pack2(lds[(kq * 16 + 2 * i) * 65 + nl], lds[(kq * 16 + 2 * i + 1) * 65 + nl]);
    uint4* d = reinterpret_cast<uint4*>(dst + (size_t)(nt * 64 + nl) * 1024 + kt * 64 + kq * 16);
    d[0] = make_uint4(pk[0], pk[1], pk[2], pk[3]);
    d[1] = make_uint4(pk[4], pk[5], pk[6], pk[7]);
    __syncthreads();
}

DEVI void convert8(const float* __restrict__ src, bf16_t* __restrict__ dst, size_t idx8) {
    const float4 a = reinterpret_cast<const float4*>(src)[idx8 * 2], b = reinterpret_cast<const float4*>(src)[idx8 * 2 + 1];
    reinterpret_cast<uint4*>(dst)[idx8] = make_uint4(pack2(a.x, a.y), pack2(a.z, a.w), pack2(b.x, b.y), pack2(b.z, b.w));
}

DEVI int pack_i8x4(float a, float b, float c, float d) {
    const int ia = (int)rintf(a), ib = (int)rintf(b), ic = (int)rintf(c), id = (int)rintf(d);
    return (ia & 255) | ((ib & 255) << 8) | ((ic & 255) << 16) | (id << 24);
}
DEVI void quant_row_i8(const float* __restrict__ xr, unsigned char* __restrict__ dst_table, int row, float* __restrict__ descale, int lane) {
    float4 v[4]; float am = 0.f;
#pragma unroll
    for (int i = 0; i < 4; ++i) { v[i] = reinterpret_cast<const float4*>(xr)[lane + 64 * i]; am = fmaxf(am, fmaxf(fmaxf(fabsf(v[i].x), fabsf(v[i].y)), fmaxf(fabsf(v[i].z), fabsf(v[i].w)))); }
    am = wave_max(am);
    const float sc = am > 0.f ? 127.f / am : 1.f;
#pragma unroll
    for (int i = 0; i < 4; ++i) {
        const int w = lane + 64 * i;
        reinterpret_cast<int*>(dst_table)[(size_t)(w >> 5) * (16384 * 32) + (size_t)row * 32 + (w & 31)] = pack_i8x4(v[i].x * sc, v[i].y * sc, v[i].z * sc, v[i].w * sc);
    }
    if (lane == 0) *descale = am > 0.f ? am * (1.f / 127.f) : 1.f;
}
DEVI void quant_row_fp8(const float* __restrict__ xr, unsigned char* __restrict__ dst_table, int row, float* __restrict__ descale, int lane) {
    float4 v[4]; float am = 0.f;
#pragma unroll
    for (int i = 0; i < 4; ++i) { v[i] = reinterpret_cast<const float4*>(xr)[lane + 64 * i]; am = fmaxf(am, fmaxf(fmaxf(fabsf(v[i].x), fabsf(v[i].y)), fmaxf(fabsf(v[i].z), fabsf(v[i].w)))); }
    am = wave_max(am);
    const float sc = am > 0.f ? 448.f / am : 1.f;
#pragma unroll
    for (int i = 0; i < 4; ++i) {
        const float a = fminf(fmaxf(v[i].x * sc, -448.f), 448.f), b = fminf(fmaxf(v[i].y * sc, -448.f), 448.f);
        const float c = fminf(fmaxf(v[i].z * sc, -448.f), 448.f), d = fminf(fmaxf(v[i].w * sc, -448.f), 448.f);
        int pk = __builtin_amdgcn_cvt_pk_fp8_f32(a, b, 0, false);
        pk = __builtin_amdgcn_cvt_pk_fp8_f32(c, d, pk, true);
        const int w = lane + 64 * i;
        reinterpret_cast<int*>(dst_table)[(size_t)(w >> 5) * (16384 * 32) + (size_t)row * 32 + (w & 31)] = pk;
    }
    if (lane == 0) *descale = am > 0.f ? am * (1.f / 448.f) : 1.f;
}

constexpr int P0_XN = 8192, P0_WIN = 60 * 16, P0_WOUT = 16 * 16, P0_WQ = 32 * 16, P0_UV = 0  , P0_SK = 128, P0_LB = 1;
constexpr int P0_UNITS = P0_XN + P0_WIN + P0_WOUT + P0_WQ + P0_UV + P0_SK + P0_LB;

DEVI void phase0_unit(const Params& p, int u, char* smem) {
    const int tid = LTID, lane = tid & 63, w = tid >> 6;
    unsigned char* ws = p.ws;
    if (u < P0_XN) {
        const int row = u * 4 + w;
        rms_row_bf16(p.x + (size_t)row * DM, p.norm1_g, reinterpret_cast<bf16_t*>(ws + OFF_XN) + (size_t)row * DM, lane);
        return;
    }
    u -= P0_XN;
    if (u < P0_WIN) { transpose_tile(p.w_in, 3600, reinterpret_cast<bf16_t*>(ws + OFF_WIN), u / 16, u % 16, 1, reinterpret_cast<float*>(smem)); return; }
    u -= P0_WIN;
    if (u < P0_WOUT) { transpose_tile(p.w_out, 1024, reinterpret_cast<bf16_t*>(ws + OFF_WOUT), u / 16, u % 16, 0, reinterpret_cast<float*>(smem)); return; }
    u -= P0_WOUT;
    if (u < P0_WQ) { transpose_tile(p.w_q, 2048, reinterpret_cast<bf16_t*>(ws + OFF_WQ), u / 16, u % 16, 0, reinterpret_cast<float*>(smem)); return; }
    u -= P0_WQ;
    if (u < P0_UV) {
        const bool isv = u >= 4096; const int row = (isv ? u - 4096 : u) * 4 + w;
        if (isv) quant_row_fp8(p.peer_v + (size_t)row * DM, ws + OFF_V8, row, reinterpret_cast<float*>(ws + OFF_VS) + row, lane);
        else quant_row_i8(p.peer_u + (size_t)row * DM, ws + OFF_U8, row, reinterpret_cast<float*>(ws + OFF_US) + row, lane);
        return;
    }
    u -= P0_UV;
    if (u < P0_SK) { convert8(p.sub_keys, reinterpret_cast<bf16_t*>(ws + OFF_SK), (size_t)u * 256 + tid); return; }
    float* lb = reinterpret_cast<float*>(ws + OFF_LB);
    for (int n = tid; n < 512; n += 256) {
        const float l0 = p.hg_lower[n], l1 = p.hg_lower[512 + n];
        const float mx = fmaxf(l0, l1); const float e0 = __expf(l0 - mx), e1 = __expf(l1 - mx);
        lb[n] = e0 / (e0 + e1);
    }
}

namespace pg8 {
#define PG8_LAS __attribute__((address_space(3)))
typedef unsigned short bf16_t;
typedef short bf16x8 __attribute__((ext_vector_type(8)));
typedef float f32x4 __attribute__((ext_vector_type(4)));
typedef unsigned u32x4 __attribute__((ext_vector_type(4)));
constexpr int BM = 256, BK = 64, HALF = 128, HTB = HALF * BK * 2  , STAGE_BYTES = 8 * HTB, NXCD = 8, WGM = 8;

__host__ __device__ __forceinline__ int lds_byte(int r, int c) { const int st = (r >> 4) * 2 + (c >> 5), rr = r & 15, cc = c & 31, ob = rr * 64 + cc * 2; return st * 1024 + (ob ^ (((ob >> 9) & 1) << 5)); }
__host__ __device__ __forceinline__ void stage_rc(int b, int& R, int& C) { const int st = b / 1024, sb = b % 1024, swz = sb ^ (((sb >> 9) & 1) << 5); R = (st >> 1) * 16 + swz / 64; C = (st & 1) * 32 + (swz % 64) / 2; }
__host__ __device__ __forceinline__ int perm32(int rho) { const int n = rho >> 4, i = rho & 15; return 8 * (i >> 2) + 4 * n + (i & 3); }

struct Unit { int pm, pn; };
struct Gemm { const bf16_t* A; const bf16_t* Bt; int M, N, K; };

struct StaticOrder {
    int nM, nN, nwg, G, c;
    __host__ __device__ void init(int M, int N, int G_, int c_) { nM = M / BM; nN = N / BM; nwg = nM * nN; G = G_; c = c_; }
    __host__ __device__ bool next(int i, Unit& u) const {
        const long L = (long)i * G + c; if (L >= nwg) return false;
        int wgid = (int)L; { const int q = nwg / NXCD, r = nwg % NXCD, xcd = wgid % NXCD, off = wgid / NXCD; wgid = (xcd < r ? xcd * (q + 1) : r * (q + 1) + (xcd - r) * q) + off; }
        const int nig = WGM * nN, gid = wgid / nig, fm = gid * WGM, gsz = (nM - fm) < WGM ? (nM - fm) : WGM;
        u.pm = fm + ((wgid % nig) % gsz); u.pn = (wgid % nig) / gsz; return true;
    }
    __device__ __forceinline__ void a_ready(const Unit&) const {}
    __device__ __forceinline__ void done(const Unit&) const {}
};
__device__ __forceinline__ unsigned cvt_pk_bf16(float lo, float hi) { unsigned r; asm volatile("v_cvt_pk_bf16_f32 %0, %1, %2" : "=v"(r) : "v"(lo), "v"(hi)); return r; }
typedef float f32x2 __attribute__((ext_vector_type(2)));
template <class Epi, class Sched, bool STAMP = false>
__device__ __forceinline__ void gemm_phase(PG8_LAS unsigned char* lds, const Gemm g, const Sched& S, const Epi& E, unsigned long long* stamps) {
    const int tid = threadIdx.x, wid = __builtin_amdgcn_readfirstlane(tid >> 6), lane = tid & 63, wr = wid >> 2, wc = wid & 3, fr = lane & 15, fq = lane >> 4;
    const int K = g.K, nt = K / BK;
    int ts_lo = 0, ts_hi = 0, nts = 0; const unsigned long long rt_entry = STAMP ? (unsigned long long)wall_clock64() : 0ull;
#define PG8_STAMP() do { if (STAMP && wid == 0 && nts < 64) { const unsigned long long _c = (unsigned long long)clock64(); \
        ts_lo = (lane == nts) ? (int)(unsigned)_c : ts_lo; ts_hi = (lane == nts) ? (int)(unsigned)(_c >> 32) : ts_hi; ++nts; } } while (0)
    PG8_STAMP();
    unsigned voffA[2], voffB[2];
#pragma unroll
    for (int i = 0; i < 2; ++i) { int R, C; stage_rc(tid * 16 + i * 8192, R, C); const int Rb = Epi::PERM ? ((R & ~31) + perm32(R & 31)) : R;
        voffA[i] = (unsigned)(R * K + C) * 2u; voffB[i] = (unsigned)(Rb * K + C) * 2u; }
    const size_t kstep = (size_t)(BK * 2);
    const size_t hstep = (size_t)HALF * K * 2;
    const size_t tstep = 2 * hstep;
    const unsigned ldsw = (unsigned)wid * 1024u;
    const int aoff = lds_byte(wr * 64 + fr, fq * 8), boff = lds_byte(wc * 32 + fr, fq * 8);
#define PG8_SA(b, h) (((b) * 2 + (h)) * HTB)
#define PG8_SB(b, h) ((4 + (b) * 2 + (h)) * HTB)
#define PG8_STAGE(bufoff, gbase, voff) do { _Pragma("unroll") for (int _i = 0; _i < 2; ++_i) \
        __builtin_amdgcn_global_load_lds((const unsigned*)((const char*)(gbase) + (voff)[_i]), (PG8_LAS unsigned*)(lds + (bufoff) + ldsw + _i * 8192), 16, 0, 0); } while (0)
#define PG8_LDA(dst, b, h) do { _Pragma("unroll") for (int m = 0; m < 4; ++m) _Pragma("unroll") for (int k = 0; k < 2; ++k) dst[m][k] = *(const PG8_LAS bf16x8*)(lds + PG8_SA(b, h) + aoff + m * 2048 + k * 1024); } while (0)
#define PG8_LDB(dst, b, h) do { _Pragma("unroll") for (int n = 0; n < 2; ++n) _Pragma("unroll") for (int k = 0; k < 2; ++k) dst[n][k] = *(const PG8_LAS bf16x8*)(lds + PG8_SB(b, h) + boff + n * 2048 + k * 1024); } while (0)
#define PG8_MMA(ai, bj, At, Bt) do { __builtin_amdgcn_s_setprio(1); _Pragma("unroll") for (int m = 0; m < 4; ++m) _Pragma("unroll") for (int n = 0; n < 2; ++n) _Pragma("unroll") for (int k = 0; k < 2; ++k) \
        acc[ai][bj][m][n] = __builtin_amdgcn_mfma_f32_16x16x32_bf16(Bt[n][k], At[m][k], acc[ai][bj][m][n], 0, 0, 0); __builtin_amdgcn_s_setprio(0); } while (0)
#define PG8_WAIT_V(n) asm volatile("s_waitcnt vmcnt(" #n ")" ::: "memory")
#define PG8_WAIT_L(n) asm volatile("s_waitcnt lgkmcnt(" #n ")" ::: "memory")
#define PG8_BAR __builtin_amdgcn_s_barrier()
#define PG8_SCHED __builtin_amdgcn_sched_barrier(0)
    Unit cur, nxt; int ui = 0;
    if (!S.next(0, cur)) return;
    f32x4 acc[2][2][4][2];
#pragma unroll
    for (int a = 0; a < 2; ++a)
#pragma unroll
        for (int b = 0; b < 2; ++b)
#pragma unroll
            for (int m = 0; m < 4; ++m)
#pragma unroll
                for (int n = 0; n < 2; ++n) acc[a][b][m][n] = (f32x4){0.f, 0.f, 0.f, 0.f};
    bf16x8 At[4][2], B0[2][2], B1[2][2];
    const char* cA = (const char*)g.A + (size_t)cur.pm * tstep; const char* cB = (const char*)g.Bt + (size_t)cur.pn * tstep;
    S.a_ready(cur);
    PG8_STAGE(PG8_SB(0, 0), cB, voffB); PG8_STAGE(PG8_SA(0, 0), cA, voffA); PG8_STAGE(PG8_SB(0, 1), cB + hstep, voffB); PG8_STAGE(PG8_SA(0, 1), cA + hstep, voffA);
    if (wr == 1) PG8_BAR;
    PG8_WAIT_V(4); PG8_BAR;
    PG8_STAGE(PG8_SB(1, 0), cB + kstep, voffB); PG8_STAGE(PG8_SA(1, 0), cA + kstep, voffA); PG8_STAGE(PG8_SB(1, 1), cB + hstep + kstep, voffB);
    PG8_WAIT_V(6); PG8_BAR;
    PG8_STAMP();
    for (;;) {
        const bool has_next = S.next(ui + 1, nxt);
        const char* nA = has_next ? (const char*)g.A + (size_t)nxt.pm * tstep : cA; const char* nB = has_next ? (const char*)g.Bt + (size_t)nxt.pn * tstep : cB;
        for (int t = 0; t < nt; t += 2) {
            const bool last = (t == nt - 2);
            const char* a1 = cA + (size_t)(t + 1) * kstep;
            const char* a2 = last ? nA : cA + (size_t)(t + 2) * kstep; const char* b2 = last ? nB : cB + (size_t)(t + 2) * kstep;
            const char* a3 = a2 + kstep; const char* b3 = b2 + kstep;
            if (last && has_next) S.a_ready(nxt);
            PG8_LDB(B0, 0, 0); PG8_SCHED; PG8_LDA(At, 0, 0); PG8_STAGE(PG8_SA(1, 1), a1 + hstep, voffA);
            PG8_WAIT_L(8); PG8_BAR; PG8_WAIT_L(0); PG8_MMA(0, 0, At, B0); PG8_BAR; PG8_SCHED;
            PG8_LDB(B1, 0, 1); PG8_STAGE(PG8_SB(0, 0), b2, voffB);
            PG8_BAR; PG8_WAIT_L(0); PG8_MMA(0, 1, At, B1); PG8_BAR;
            PG8_LDA(At, 0, 1); PG8_STAGE(PG8_SA(0, 0), a2, voffA);
            PG8_BAR; PG8_WAIT_L(0); PG8_MMA(1, 0, At, B0); PG8_BAR; PG8_SCHED;
            PG8_STAGE(PG8_SB(0, 1), b2 + hstep, voffB);
            PG8_WAIT_V(6); PG8_BAR; PG8_MMA(1, 1, At, B1); PG8_BAR;
            PG8_LDB(B0, 1, 0); PG8_SCHED; PG8_LDA(At, 1, 0); PG8_STAGE(PG8_SA(0, 1), a2 + hstep, voffA);
            PG8_WAIT_L(8); PG8_BAR; PG8_WAIT_L(0); PG8_MMA(0, 0, At, B0); PG8_BAR; PG8_SCHED;
            PG8_LDB(B1, 1, 1); PG8_STAGE(PG8_SB(1, 0), b3, voffB);
            PG8_BAR; PG8_WAIT_L(0); PG8_MMA(0, 1, At, B1); PG8_BAR;
            PG8_LDA(At, 1, 1); PG8_STAGE(PG8_SA(1, 0), a3, voffA);
            PG8_BAR; PG8_WAIT_L(0); PG8_MMA(1, 0, At, B0); PG8_BAR; PG8_SCHED;
            PG8_STAGE(PG8_SB(1, 1), b3 + hstep, voffB);
            PG8_WAIT_V(6); PG8_BAR; PG8_MMA(1, 1, At, B1); PG8_BAR;
        }
        PG8_STAMP();
        if constexpr (!Epi::AFTER_DRAIN) { E(acc, cur, wr, wc, fr, fq); S.done(cur); }
        PG8_STAMP();
        if (!has_next) break;
#pragma unroll
        for (int a = 0; a < 2; ++a)
#pragma unroll
            for (int b = 0; b < 2; ++b)
#pragma unroll
                for (int m = 0; m < 4; ++m)
#pragma unroll
                    for (int n = 0; n < 2; ++n) acc[a][b][m][n] = (f32x4){0.f, 0.f, 0.f, 0.f};
        cur = nxt; cA = nA; cB = nB; ++ui;
    }
    PG8_WAIT_V(0);
    if (wr == 0) PG8_BAR;
    PG8_BAR;
    if constexpr (Epi::AFTER_DRAIN) { E.fused(acc, cur, wr, wc, fr, fq, lds, wid, lane); S.done(cur); }
    PG8_STAMP();
    if (STAMP && wid == 0) { stamps[lane] = lane < nts ? (((unsigned long long)(unsigned)ts_hi << 32) | (unsigned)ts_lo) : 0ull;
        if (lane == 62) stamps[62] = rt_entry; if (lane == 63) stamps[63] = (unsigned long long)wall_clock64(); }
#undef PG8_STAMP
#undef PG8_SA
#undef PG8_SB
#undef PG8_STAGE
#undef PG8_LDA
#undef PG8_LDB
#undef PG8_MMA
#undef PG8_WAIT_V
#undef PG8_WAIT_L
#undef PG8_BAR
#undef PG8_SCHED
}
}

DEVI uint4 pack8(const pg8::f32x4 a, const pg8::f32x4 b) { return make_uint4(pack2(a[0], a[1]), pack2(a[2], a[3]), pack2(b[0], b[1]), pack2(b[2], b[3])); }

constexpr int P1_N = IN_WP;
struct EpiInProj {
    static constexpr bool PERM = true, AFTER_DRAIN = false;
    unsigned char* ws;
    __device__ __forceinline__ void operator()(const pg8::f32x4 (&acc)[2][2][4][2], const pg8::Unit& u, int wr, int wc, int fr, int fq) const {
        const int row0 = u.pm * 256 + wr * 64 + fr;
        const int pn = u.pn;
        const int cl0 = wc * 32 + 8 * fq;
        bf16_t* dst; int ld, cbase, kind;
        if (pn < 2)       { dst = reinterpret_cast<bf16_t*>(ws + OFF_HQ);  ld = 512; cbase = pn * 256;        kind = 1; }
        else if (pn < 4)  { dst = reinterpret_cast<bf16_t*>(ws + OFF_HLF); ld = 512; cbase = (pn - 2) * 256;  kind = 2; }
        else if (pn < 6)  { dst = reinterpret_cast<bf16_t*>(ws + OFF_HV);  ld = 512; cbase = (pn - 4) * 256;  kind = 0; }
        else if (pn < 8)  { dst = reinterpret_cast<bf16_t*>(ws + OFF_HG);  ld = 512; cbase = (pn - 6) * 256;  kind = 1; }
        else if (pn == 8) { dst = reinterpret_cast<bf16_t*>(ws + OFF_GQ);  ld = 256; cbase = 0;               kind = 3; }
        else if (pn == 9) { dst = reinterpret_cast<bf16_t*>(ws + OFF_GK);  ld = 256; cbase = 0;               kind = 0; }
        else if (pn < 12) { dst = reinterpret_cast<bf16_t*>(ws + OFF_GV);  ld = 512; cbase = (pn - 10) * 256; kind = 0; }
        else if (pn < 14) { dst = reinterpret_cast<bf16_t*>(ws + OFF_GG);  ld = 512; cbase = (pn - 12) * 256; kind = 1; }
        else {
            if (wc == 0 && fq < 2) {
                float* gl = reinterpret_cast<float*>(ws + OFF_GLOW);
#pragma unroll
                for (int ai = 0; ai < 2; ++ai)
#pragma unroll
                    for (int m = 0; m < 4; ++m) {
                        float* rp = gl + (size_t)(row0 + ai * 128 + m * 16) * 16 + 8 * fq;
                        *reinterpret_cast<pg8::f32x4*>(rp) = acc[ai][0][m][0];
                        *reinterpret_cast<pg8::f32x4*>(rp + 4) = acc[ai][0][m][1];
                    }
            }
            return;
        }
        float lbv[2][8];
#pragma unroll
        for (int bj = 0; bj < 2; ++bj)
#pragma unroll
            for (int j = 0; j < 8; ++j) lbv[bj][j] = 0.f;
        if (kind == 2) {
            const float* lb = reinterpret_cast<const float*>(ws + OFF_LB);
#pragma unroll
            for (int bj = 0; bj < 2; ++bj)
#pragma unroll
                for (int j = 0; j < 8; ++j) lbv[bj][j] = lb[cbase + bj * 128 + cl0 + j];
        }
#pragma unroll
        for (int ai = 0; ai < 2; ++ai)
#pragma unroll
            for (int m = 0; m < 4; ++m) {
                bf16_t* rowp = dst + (size_t)(row0 + ai * 128 + m * 16) * ld + cbase + cl0;
#pragma unroll
                for (int bj = 0; bj < 2; ++bj) {
                    pg8::f32x4 v0 = acc[ai][bj][m][0], v1 = acc[ai][bj][m][1];
                    if (kind == 1) {
#pragma unroll
                        for (int j = 0; j < 4; ++j) { v0[j] = silu_f(v0[j]); v1[j] = silu_f(v1[j]); }
                    } else if (kind == 2) {
#pragma unroll
                        for (int j = 0; j < 4; ++j) {
                            const float l0 = lbv[bj][j], l1 = lbv[bj][4 + j];
                            v0[j] = __logf(l0 + (1.f - l0) * __builtin_amdgcn_rcpf(1.f + __expf(-v0[j])));
                            v1[j] = __logf(l1 + (1.f - l1) * __builtin_amdgcn_rcpf(1.f + __expf(-v1[j])));
                        }
                    } else if (kind == 3) {
#pragma unroll
                        for (int j = 0; j < 4; ++j) { v0[j] *= 0.125f; v1[j] *= 0.125f; }
                    }
                    *reinterpret_cast<uint4*>(rowp + bj * 128) = pack8(v0, v1);
                }
            }
    }
};
struct EpiOutProj {
    static constexpr bool PERM = true, AFTER_DRAIN = false;
    const float* __restrict__ x; bf16_t* __restrict__ h16;
    __device__ __forceinline__ void operator()(const pg8::f32x4 (&acc)[2][2][4][2], const pg8::Unit& u, int wr, int wc, int fr, int fq) const {
        const int row0 = u.pm * 256 + wr * 64 + fr, col0 = u.pn * 256 + wc * 32 + 8 * fq;
#pragma unroll
        for (int ai = 0; ai < 2; ++ai) {
            pg8::f32x4 xv[4][2][2];
#pragma unroll
            for (int m = 0; m < 4; ++m)
#pragma unroll
                for (int bj = 0; bj < 2; ++bj) {
                    const size_t ro = (size_t)(row0 + ai * 128 + m * 16) * DM + col0 + bj * 128;
                    xv[m][bj][0] = *reinterpret_cast<const pg8::f32x4*>(x + ro); xv[m][bj][1] = *reinterpret_cast<const pg8::f32x4*>(x + ro + 4);
                }
#pragma unroll
            for (int m = 0; m < 4; ++m)
#pragma unroll
                for (int bj = 0; bj < 2; ++bj) {
                    const size_t ro = (size_t)(row0 + ai * 128 + m * 16) * DM + col0 + bj * 128;
                    *reinterpret_cast<uint4*>(h16 + ro) = pack8(xv[m][bj][0] + acc[ai][bj][m][0], xv[m][bj][1] + acc[ai][bj][m][1]);
                }
        }
    }
};
struct EpiQ {
    static constexpr bool PERM = true, AFTER_DRAIN = false;
    bf16_t* Q;
    __device__ __forceinline__ void operator()(const pg8::f32x4 (&acc)[2][2][4][2], const pg8::Unit& u, int wr, int wc, int fr, int fq) const {
        const int row0 = u.pm * 256 + wr * 64 + fr, col0 = u.pn * 256 + wc * 32 + 8 * fq;
#pragma unroll
        for (int ai = 0; ai < 2; ++ai)
#pragma unroll
            for (int m = 0; m < 4; ++m) {
                bf16_t* rowp = Q + (size_t)(row0 + ai * 128 + m * 16) * 2048 + col0;
#pragma unroll
                for (int bj = 0; bj < 2; ++bj) *reinterpret_cast<uint4*>(rowp + bj * 128) = pack8(acc[ai][bj][m][0], acc[ai][bj][m][1]);
            }
    }
};
template <class Epi>
DEVI void run_gemm(const bf16_t* A, const bf16_t* Bt, int N, const Epi& E, char* smem) {
    pg8::Gemm g{A, Bt, M_TOK, N, 1024};
#if PROBE_GEMM_DUP
    struct DupOrder : pg8::StaticOrder { __host__ __device__ bool next(int i, pg8::Unit& u) const { return pg8::StaticOrder::next(i >> 1, u); } };
    DupOrder S; S.init(M_TOK, N, (int)gridDim.x, (int)blockIdx.x);
    pg8::gemm_phase<Epi, DupOrder, false>((PG8_LAS unsigned char*)smem, g, S, E, nullptr);
#else
    pg8::StaticOrder S; S.init(M_TOK, N, (int)gridDim.x, (int)blockIdx.x);
    pg8::gemm_phase<Epi, pg8::StaticOrder, false>((PG8_LAS unsigned char*)smem, g, S, E, nullptr);
#endif
    __builtin_amdgcn_s_waitcnt(0);
}

DEVI float logsigmoid_f(float z) { return fminf(z, 0.f) - __logf(1.f + __expf(-fabsf(z))); }

DEVI unsigned off_b(unsigned row, unsigned ch) { return 256u * row + 16u * (ch ^ (((row & 3u) << 2) | ((row >> 2) & 3u))); }
DEVI unsigned tr_addr16(unsigned lane, unsigned c, unsigned ks, unsigned t) {
    const unsigned g = lane >> 4, q = (lane & 15u) >> 2, pp = lane & 3u;
    return off_b(32u * ks + 8u * g + 4u * t + q, 2u * c + (pp >> 1)) + 8u * (pp & 1u);
}
typedef unsigned short u16x4_t __attribute__((ext_vector_type(4)));
DEVI bf16x8 tr_frag(unsigned base, unsigned lane, unsigned c, unsigned ks) {
    u16x4_t a, b;
    asm volatile("ds_read_b64_tr_b16 %0, %2\n\tds_read_b64_tr_b16 %1, %3\n\ts_waitcnt lgkmcnt(0)" : "=&v"(a), "=&v"(b) : "v"(base + tr_addr16(lane, c, ks, 0)), "v"(base + tr_addr16(lane, c, ks, 1)) : "memory");
    bf16x8 r;
    r[0] = (short)a[0]; r[1] = (short)a[1]; r[2] = (short)a[2]; r[3] = (short)a[3]; r[4] = (short)b[0]; r[5] = (short)b[1]; r[6] = (short)b[2]; r[7] = (short)b[3];
    return r;
}
DEVI bf16x8 row_frag(const char* tile, unsigned lane, unsigned rb, unsigned s) { return *reinterpret_cast<const bf16x8*>(tile + off_b((lane & 15u) + 16u * rb, 4u * s + (lane >> 4))); }
DEVI void fill_tile64(char* tile, const bf16_t* __restrict__ g, int ldg) {
#pragma unroll
    for (int i = 0; i < 4; ++i) {
        const int n = LTID + 256 * i, row = n >> 4, ch = n & 15;
        *reinterpret_cast<uint4*>(tile + off_b(row, ch)) = *reinterpret_cast<const uint4*>(g + (size_t)row * ldg + ch * 8);
    }
}
DEVI void fill_tile64x64(char* tile, const bf16_t* __restrict__ g, int ldg) {
#pragma unroll
    for (int i = 0; i < 2; ++i) {
        const int n = LTID + 256 * i, row = n >> 3, ch = n & 7;
        *reinterpret_cast<uint4*>(tile + off_b(row, ch)) = *reinterpret_cast<const uint4*>(g + (size_t)row * ldg + ch * 8);
    }
}

typedef unsigned gu32x4 __attribute__((ext_vector_type(4)));
typedef unsigned gu32x2 __attribute__((ext_vector_type(2)));
typedef float gf32x4 __attribute__((ext_vector_type(4)));
template <int DK, bool KV> struct GPre;
template <bool KV> struct GPre<128, KV> { unsigned a[16], b[KV ? 1 : 16]; gu32x4 v[4]; };
template <bool KV> struct GPre<64, KV>  { unsigned a[8], b[KV ? 1 : 8]; gu32x4 v[4]; gf32x4 gl; float2 wg[16]; float2 bg; };

template <int N>
DEVI void dummy_stores(unsigned char* ws) {
    uint2* d = reinterpret_cast<uint2*>(ws + OFF_DUMMY) + (size_t)threadIdx.x * (2 * N);
#pragma unroll
    for (int i = 0; i < N; ++i) d[2 * i] = make_uint2(0u, 0u);
}

template <int DK, bool KV>
DEVI void gate_prefetch(const Params& p, int sidx, int c, GPre<DK, KV>& r) {
    unsigned char* ws = p.ws;
    int tid = LTID; asm volatile("" : "+v"(tid));
    const int b = sidx >> 2, h = sidx & 3;
    const size_t row0 = (size_t)(b * 128 + c) * 64;
    const bf16_t* A = reinterpret_cast<const bf16_t*>(ws + (DK == 128 ? OFF_HLF : OFF_GK)) + row0 * (4 * DK) + h * DK;
    const bf16_t* Q = reinterpret_cast<const bf16_t*>(ws + (DK == 128 ? OFF_HQ : OFF_GQ)) + row0 * (4 * DK) + h * DK;
    const bf16_t* V = reinterpret_cast<const bf16_t*>(ws + (DK == 128 ? OFF_HV : OFF_GV)) + row0 * 512 + h * 128;
    constexpr int NR = (DK == 128) ? 16 : 8;
    const int cp = (DK == 128) ? (tid & 63) : (tid & 31), rq = (DK == 128) ? (tid >> 6) : (tid >> 5);
#pragma unroll
    for (int i = 0; i < 4; ++i) { const int n = tid + 256 * i; r.v[i] = *reinterpret_cast<const gu32x4*>(V + (size_t)(n >> 4) * 512 + (n & 15) * 8); }
#pragma unroll
    for (int i = 0; i < NR; ++i) {
        r.a[i] = *reinterpret_cast<const unsigned*>(A + (size_t)(NR * rq + i) * (4 * DK) + 2 * cp);
        if (!KV) r.b[i] = *reinterpret_cast<const unsigned*>(Q + (size_t)(NR * rq + i) * (4 * DK) + 2 * cp);
    }
    if constexpr (DK == 64) {
        r.gl = reinterpret_cast<const gf32x4*>(ws + OFF_GLOW)[row0 * 4 + tid];
        const int col = h * 64 + 2 * cp;
#pragma unroll
        for (int j = 0; j < 16; ++j) r.wg[j] = *reinterpret_cast<const float2*>(p.gla_wg + j * 256 + col);
        r.bg = *reinterpret_cast<const float2*>(p.gla_bg + col);
    }
}

template <int DK, bool KV>
DEVI void gate_apply(GPre<DK, KV>& r, char* vtile, char* qtile, char* ktile, float* tot, float4* glt, float* __restrict__ decout) {
    int tid = LTID; asm volatile("" : "+v"(tid));
    constexpr int NR = (DK == 128) ? 16 : 8, NG = 64 / NR;
    const int cp = (DK == 128) ? (tid & 63) : (tid & 31), rq = (DK == 128) ? (tid >> 6) : (tid >> 5);
#pragma unroll
    for (int i = 0; i < 4; ++i) { const int n = tid + 256 * i; *reinterpret_cast<gu32x4*>(vtile + off_b((unsigned)(n >> 4), (unsigned)(n & 15))) = r.v[i]; }
    float l0[NR], l1[NR];
    if constexpr (DK == 128) {
#pragma unroll
        for (int i = 0; i < NR; ++i) { l0[i] = bflo(r.a[i]); l1[i] = bfhi(r.a[i]); }
    } else {
        reinterpret_cast<gf32x4*>(glt)[tid] = r.gl;
        __syncthreads();
#pragma unroll
        for (int i = 0; i < NR; ++i) {
            float z0 = r.bg.x, z1 = r.bg.y;
#pragma unroll
            for (int j = 0; j < 4; ++j) {
                const float4 t = glt[(NR * rq + i) * 4 + j];
                z0 += t.x * r.wg[4 * j].x + t.y * r.wg[4 * j + 1].x + t.z * r.wg[4 * j + 2].x + t.w * r.wg[4 * j + 3].x;
                z1 += t.x * r.wg[4 * j].y + t.y * r.wg[4 * j + 1].y + t.z * r.wg[4 * j + 2].y + t.w * r.wg[4 * j + 3].y;
            }
            l0[i] = logsigmoid_f(z0) * (1.f / 16.f); l1[i] = logsigmoid_f(z1) * (1.f / 16.f);
        }
    }
    float s0 = 0.f, s1 = 0.f;
#pragma unroll
    for (int i = 0; i < NR; ++i) { s0 += l0[i]; s1 += l1[i]; }
    *reinterpret_cast<float2*>(tot + rq * DK + 2 * cp) = make_float2(s0, s1);
    __syncthreads();
    float G0 = 0.f, G1 = 0.f, T0 = 0.f, T1 = 0.f;
#pragma unroll
    for (int k = 0; k < NG; ++k) {
        const float2 t = *reinterpret_cast<const float2*>(tot + k * DK + 2 * cp);
        T0 += t.x; T1 += t.y;
        if (k < rq) { G0 += t.x; G1 += t.y; }
    }
    if (KV && rq == 0) *reinterpret_cast<float2*>(decout + 2 * cp) = make_float2(__expf(T0), __expf(T1));
#pragma unroll
    for (int i = 0; i < NR; ++i) {
        G0 += l0[i]; G1 += l1[i];
        float k0, k1;
        if constexpr (DK == 128) { k0 = 1.f - __expf(l0[i]); k1 = 1.f - __expf(l1[i]); } else { k0 = bflo(r.a[i]); k1 = bfhi(r.a[i]); }
        const unsigned o = off_b((unsigned)(NR * rq + i), (unsigned)(cp >> 2)) + 4u * (unsigned)(cp & 3);
        if constexpr (KV) {
            *reinterpret_cast<unsigned*>(ktile + o) = pack2(k0 * __expf(T0 - G0), k1 * __expf(T1 - G1));
        } else {
            *reinterpret_cast<unsigned*>(qtile + o) = pack2(bflo(r.b[i]) * __expf(G0), bfhi(r.b[i]) * __expf(G1));
            *reinterpret_cast<unsigned*>(ktile + o) = pack2(k0 * __expf(-G0), k1 * __expf(-G1));
        }
    }
}

constexpr int P3_UNITS = 4096;
template <int DK>
DEVI void kv_unit(const Params& p, int sidx, int c, int nsidx, int nc, char* smem, GPre<DK, true>& pre) {
    unsigned char* ws = p.ws;
    const int lane = LTID & 63, w = LTID >> 6;
    const int b = sidx >> 2, h = sidx & 3;
    const int cidx = b * 128 + c;
    constexpr int NDB = DK / 16;
    float* DEC = reinterpret_cast<float*>(ws + (DK == 128 ? OFF_DECH : OFF_DECG)) + (size_t)cidx * (4 * DK) + h * DK;
    bf16_t* ST = reinterpret_cast<bf16_t*>(reinterpret_cast<unsigned char*>(p.out) + (DK == 128 ? OUT_STH : OUT_STG)) + ((size_t)sidx * 128 + c) * (128 * DK);
    f32x4 acc[NDB][2];
#pragma unroll
    for (int i = 0; i < NDB; ++i) { acc[i][0] = f32x4{0, 0, 0, 0}; acc[i][1] = f32x4{0, 0, 0, 0}; }
    const int fo = (lane & 15) * 64 + 8 * (lane >> 4);
    gate_apply<DK, true>(pre, smem, nullptr, smem + 16384, reinterpret_cast<float*>(smem + 32768), reinterpret_cast<float4*>(smem + 36864), DEC);
    gate_prefetch<DK, true>(p, nsidx, nc, pre);
    __syncthreads();
    const unsigned tbase = (unsigned)(size_t)smem, kbase = tbase + 16384u;
#pragma unroll
    for (int ks = 0; ks < 2; ++ks) {
        bf16x8 bv[2];
#pragma unroll
        for (int nb = 0; nb < 2; ++nb) bv[nb] = tr_frag(tbase, (unsigned)lane, (unsigned)(2 * w + nb), (unsigned)ks);
#pragma unroll
        for (int db = 0; db < NDB; ++db) {
            const bf16x8 ak = tr_frag(kbase, (unsigned)lane, (unsigned)db, (unsigned)ks);
            acc[db][0] = mfma16(ak, bv[0], acc[db][0]);
            acc[db][1] = mfma16(ak, bv[1], acc[db][1]);
        }
    }
#pragma unroll
    for (int db = 0; db < NDB; ++db) {
        const int d = db * 16 + 4 * (lane >> 4);
#pragma unroll
        for (int nb = 0; nb < 2; ++nb) {
            const int dv = 32 * w + nb * 16 + (lane & 15);
            uint2 o; o.x = pack2(acc[db][nb][0], acc[db][nb][1]); o.y = pack2(acc[db][nb][2], acc[db][nb][3]);
            *reinterpret_cast<uint2*>(ST + (size_t)dv * DK + d) = o;
        }
    }
    __syncthreads();
}
template <int DK>
DEVI void phase3_loop(const Params& p, int hb, char* hsm) {
    GPre<DK, true> pre;
    const int stride = (int)gridDim.x * 2;
    int v = (int)blockIdx.x * 2 + hb;
    if (v < 2048) { gate_prefetch<DK, true>(p, v >> 7, v & 127, pre); dummy_stores<DK / 8>(p.ws); }
    for (; v < 2048; v += stride) {
        const int nv = (v + stride < 2048) ? v + stride : v;
        kv_unit<DK>(p, v >> 7, v & 127, nv >> 7, nv & 127, hsm, pre);
    }
}

constexpr int P4_UNITS = 384;
template <int DK>
DEVI void phase4_scan(const Params& p, int e) {
    unsigned char* ws = p.ws;
    constexpr int CS = 128 * DK;
    const int sidx = e / (CS / 4), rem = e % (CS / 4), dv = rem / (DK / 4), d4 = (rem % (DK / 4)) * 4;
    const int b = sidx >> 2, h = sidx & 3;
    unsigned char* stb = reinterpret_cast<unsigned char*>(p.out) + (DK == 128 ? OUT_STH : OUT_STG);
    const unsigned char* decb = ws + (DK == 128 ? OFF_DECH : OFF_DECG);
    const unsigned toff = (unsigned)(((size_t)sidx * 128 * CS + dv * DK + d4) * 2);
    const unsigned doff = (unsigned)(((size_t)(b * 128) * (4 * DK) + h * DK + d4) * 4);
    float s0 = 0.f, s1 = 0.f, s2 = 0.f, s3 = 0.f;
    gu32x2 kvA[8], kvB[8]; gf32x4 dcA[8], dcB[8];
#define P4_LOAD(KV, DC, BT) do { const int _c8 = ((BT) < 16 ? (BT) : 15) * 8; _Pragma("unroll") for (int i = 0; i < 8; ++i) { \
        KV[i] = *reinterpret_cast<const gu32x2*>(stb + (size_t)(_c8 + i) * (CS * 2) + toff); DC[i] = *reinterpret_cast<const gf32x4*>(decb + (size_t)(_c8 + i) * (4 * DK * 4) + doff); } } while (0)
#define P4_STEP(KV, DC, BT) do { const int _c8 = (BT) * 8; _Pragma("unroll") for (int i = 0; i < 8; ++i) { \
        gu32x2 o; o.x = pack2(s0, s1); o.y = pack2(s2, s3); \
        *reinterpret_cast<gu32x2*>(stb + (size_t)(_c8 + i) * (CS * 2) + toff) = o; \
        s0 = DC[i].x * s0 + bflo(KV[i].x); s1 = DC[i].y * s1 + bfhi(KV[i].x); \
        s2 = DC[i].z * s2 + bflo(KV[i].y); s3 = DC[i].w * s3 + bfhi(KV[i].y); } } while (0)
    P4_LOAD(kvA, dcA, 0); dummy_stores<8>(ws);
#pragma unroll 1
    for (int bt = 0; bt < 16; bt += 2) {
        P4_LOAD(kvB, dcB, bt + 1); P4_STEP(kvA, dcA, bt);
        P4_LOAD(kvA, dcA, bt + 2); P4_STEP(kvB, dcB, bt + 1);
    }
#undef P4_LOAD
#undef P4_STEP
}
DEVI void phase4_unit(const Params& p, int u, char* smem) {
    if (u < 256) phase4_scan<128>(p, u * 256 + LTID); else phase4_scan<64>(p, (u - 256) * 256 + LTID);
}

constexpr int P5_UNITS = 4096;
constexpr int PL_PITCH = 72;
template <int DK> struct OutRegs { GPre<DK, false> pre; bf16x8 ast[DK / 32][2]; gu32x2 gtv[4][2]; };
template <int DK>
DEVI void out_load_ast(const Params& p, int sidx, int c, OutRegs<DK>& R) {
    int tid = LTID; asm volatile("" : "+v"(tid));
    const int lane = tid & 63, w = tid >> 6, l15 = lane & 15, lg = lane >> 4;
    const bf16_t* ST = reinterpret_cast<const bf16_t*>(reinterpret_cast<const unsigned char*>(p.out) + (DK == 128 ? OUT_STH : OUT_STG)) + ((size_t)sidx * 128 + c) * (128 * DK);
#pragma unroll
    for (int ks = 0; ks < DK / 32; ++ks) {
#pragma unroll
        for (int x = 0; x < 2; ++x) R.ast[ks][x] = ldg_frag(ST + (size_t)((2 * w + x) * 16 + l15) * DK + ks * 32 + 8 * lg);
    }
}
template <int DK>
DEVI void out_load_gates(const Params& p, int sidx, int c, OutRegs<DK>& R) {
    int tid = LTID; asm volatile("" : "+v"(tid));
    const int lane = tid & 63, w = tid >> 6, l15 = lane & 15, lg = lane >> 4;
    const size_t row0 = (size_t)((sidx >> 2) * 128 + c) * 64;
    const bf16_t* GATE = reinterpret_cast<const bf16_t*>(p.ws + (DK == 128 ? OFF_HG : OFF_GG)) + row0 * 512 + (sidx & 3) * 128;
#pragma unroll
    for (int x = 0; x < 2; ++x) {
#pragma unroll
        for (int y = 0; y < 4; ++y) R.gtv[y][x] = *reinterpret_cast<const gu32x2*>(GATE + (size_t)(y * 16 + l15) * 512 + (2 * w + x) * 16 + 4 * lg);
    }
}
template <int DK>
DEVI void out_unit(const Params& p, int sidx, int c, int nsidx, int nc, char* smem, OutRegs<DK>& R, const float4 (&g4v)[2]) {
    unsigned char* ws = p.ws;
    const int lane = LTID & 63, w = LTID >> 6;
    const int b = sidx >> 2, h = sidx & 3;
    const int cidx = b * 128 + c;
    const size_t row0 = (size_t)cidx * 64;
    constexpr int LDQ = 4 * DK;
    bf16_t* MIX = reinterpret_cast<bf16_t*>(ws + OFF_MIX) + row0 * 1024 + (DK == 128 ? 0 : 512) + h * 128;
    bf16_t* PL = reinterpret_cast<bf16_t*>(smem);
    float* RED = reinterpret_cast<float*>(smem + 64 * PL_PITCH * 2);

    const int l15 = lane & 15, lg = lane >> 4;
    char* vtile = smem + 16384;
    char* qtile = smem + 32768;
    char* ktile = smem + 49152;
    gate_apply<DK, false>(R.pre, vtile, qtile, ktile, reinterpret_cast<float*>(smem + 10240), reinterpret_cast<float4*>(smem + 12288), nullptr);
    gate_prefetch<DK, false>(p, nsidx, nc, R.pre);
    __syncthreads();
    {
        bf16x8 bq[DK / 32];
#pragma unroll
        for (int ks = 0; ks < DK / 32; ++ks) bq[ks] = row_frag(qtile, (unsigned)lane, (unsigned)w, (unsigned)ks);
#pragma unroll
        for (int jb = 0; jb < 4; ++jb) {
            f32x4 a = f32x4{0, 0, 0, 0};
            if (jb <= w) {
#pragma unroll
                for (int ks = 0; ks < DK / 32; ++ks) {
                    const bf16x8 ak = row_frag(ktile, (unsigned)lane, (unsigned)jb, (unsigned)ks);
                    a = mfma16(ak, bq[ks], a);
                }
            }
            const int i = w * 16 + l15, j0 = jb * 16 + 4 * lg;
            const float v0 = (j0 + 0 <= i) ? a[0] : 0.f, v1 = (j0 + 1 <= i) ? a[1] : 0.f, v2 = (j0 + 2 <= i) ? a[2] : 0.f, v3 = (j0 + 3 <= i) ? a[3] : 0.f;
            uint2 o; o.x = pack2(v0, v1); o.y = pack2(v2, v3);
            *reinterpret_cast<uint2*>(PL + i * PL_PITCH + j0) = o;
        }
    }
    __syncthreads();
    f32x4 acc[2][4];
#pragma unroll
    for (int x = 0; x < 2; ++x)
#pragma unroll
        for (int y = 0; y < 4; ++y) acc[x][y] = f32x4{0, 0, 0, 0};
#pragma unroll
    for (int ks = 0; ks < 2; ++ks) {
        bf16x8 bp[4], avx[2];
#pragma unroll
        for (int x = 0; x < 2; ++x) avx[x] = tr_frag((unsigned)(size_t)vtile, (unsigned)lane, (unsigned)(2 * w + x), (unsigned)ks);
#pragma unroll
        for (int y = 0; y < 4; ++y) bp[y] = *reinterpret_cast<const bf16x8*>(PL + (y * 16 + l15) * PL_PITCH + ks * 32 + 8 * lg);
#pragma unroll
        for (int x = 0; x < 2; ++x)
#pragma unroll
            for (int y = 0; y < 4; ++y) acc[x][y] = mfma16(avx[x], bp[y], acc[x][y]);
    }
#pragma unroll
    for (int ks = 0; ks < DK / 32; ++ks) {
#pragma unroll
        for (int x = 0; x < 2; ++x)
#pragma unroll
            for (int y = 0; y < 4; ++y) acc[x][y] = mfma16(R.ast[ks][x], row_frag(qtile, (unsigned)lane, (unsigned)y, (unsigned)ks), acc[x][y]);
    }
    out_load_ast<DK>(p, nsidx, nc, R);
    float ssq[4];
#pragma unroll
    for (int y = 0; y < 4; ++y) {
        float s = 0.f;
#pragma unroll
        for (int x = 0; x < 2; ++x)
#pragma unroll
            for (int r = 0; r < 4; ++r) s += acc[x][y][r] * acc[x][y][r];
        s += __shfl_xor(s, 16); s += __shfl_xor(s, 32);
        ssq[y] = s;
    }
    if (lg == 0) {
#pragma unroll
        for (int y = 0; y < 4; ++y) RED[w * 64 + y * 16 + l15] = ssq[y];
    }
    __syncthreads();
#pragma unroll
    for (int y = 0; y < 4; ++y) {
        const int i = y * 16 + l15;
        const float tot = RED[i] + RED[64 + i] + RED[128 + i] + RED[192 + i];
        const float rstd = rsqrtf(tot * (1.f / 128.f) + 1e-6f);
#pragma unroll
        for (int x = 0; x < 2; ++x) {
            const int dv = (2 * w + x) * 16 + 4 * lg;
            const float4 g4 = g4v[x];
            const gu32x2 gt = R.gtv[y][x];
            uint2 o;
            o.x = pack2(acc[x][y][0] * rstd * g4.x * bflo(gt.x), acc[x][y][1] * rstd * g4.y * bfhi(gt.x));
            o.y = pack2(acc[x][y][2] * rstd * g4.z * bflo(gt.y), acc[x][y][3] * rstd * g4.w * bfhi(gt.y));
            *reinterpret_cast<uint2*>(MIX + (size_t)i * 1024 + dv) = o;
        }
    }
    out_load_gates<DK>(p, nsidx, nc, R);
    __syncthreads();
}
template <int DK>
DEVI void phase5_loop(const Params& p, int hb, char* hsm) {
    OutRegs<DK> R;
    const int stride = (int)gridDim.x * 2;
    int v = (int)blockIdx.x * 2 + hb;
    const int lane = LTID & 63, w = LTID >> 6;
    const float* ng = (DK == 128) ? p.hg_norm_g : p.gla_norm_g;
    const float4 g4v[2] = {*reinterpret_cast<const float4*>(ng + (2 * w) * 16 + 4 * (lane >> 4)), *reinterpret_cast<const float4*>(ng + (2 * w + 1) * 16 + 4 * (lane >> 4))};
    if (v < 2048) {
        gate_prefetch<DK, false>(p, v >> 7, v & 127, R.pre); out_load_ast<DK>(p, v >> 7, v & 127, R); dummy_stores<8>(p.ws); out_load_gates<DK>(p, v >> 7, v & 127, R);
    }
    for (; v < 2048; v += stride) {
        const int nv = (v + stride < 2048) ? v + stride : v;
        out_unit<DK>(p, v >> 7, v & 127, nv >> 7, nv & 127, hsm, R, g4v);
    }
}

DEVI void rms_row16_bf16_i8(const bf16_t* __restrict__ xr, const float* __restrict__ g, bf16_t* __restrict__ dst, unsigned char* __restrict__ dst8, float* __restrict__ descale, int lane) {
    float v[2][8]; float ss = 0.f;
#pragma unroll
    for (int i = 0; i < 2; ++i) {
        const uint4 q = reinterpret_cast<const uint4*>(xr)[lane + 64 * i];
        v[i][0] = bflo(q.x); v[i][1] = bfhi(q.x); v[i][2] = bflo(q.y); v[i][3] = bfhi(q.y); v[i][4] = bflo(q.z); v[i][5] = bfhi(q.z); v[i][6] = bflo(q.w); v[i][7] = bfhi(q.w);
#pragma unroll
        for (int j = 0; j < 8; ++j) ss += v[i][j] * v[i][j];
    }
    ss = wave_sum(ss);
    const float r = rsqrtf(ss * (1.f / 1024.f) + 1e-6f);
    float am = 0.f;
#pragma unroll
    for (int i = 0; i < 2; ++i) {
        const float4 g0 = reinterpret_cast<const float4*>(g)[2 * (lane + 64 * i)], g1 = reinterpret_cast<const float4*>(g)[2 * (lane + 64 * i) + 1];
        v[i][0] *= r * g0.x; v[i][1] *= r * g0.y; v[i][2] *= r * g0.z; v[i][3] *= r * g0.w; v[i][4] *= r * g1.x; v[i][5] *= r * g1.y; v[i][6] *= r * g1.z; v[i][7] *= r * g1.w;
        reinterpret_cast<uint4*>(dst)[lane + 64 * i] = make_uint4(pack2(v[i][0], v[i][1]), pack2(v[i][2], v[i][3]), pack2(v[i][4], v[i][5]), pack2(v[i][6], v[i][7]));
#pragma unroll
        for (int j = 0; j < 8; ++j) am = fmaxf(am, fabsf(v[i][j]));
    }
    am = wave_max(am);
    const float sc = am > 0.f ? 127.f / am : 1.f;
#pragma unroll
    for (int i = 0; i < 2; ++i)
        reinterpret_cast<int2*>(dst8)[lane + 64 * i] = make_int2(pack_i8x4(v[i][0] * sc, v[i][1] * sc, v[i][2] * sc, v[i][3] * sc), pack_i8x4(v[i][4] * sc, v[i][5] * sc, v[i][6] * sc, v[i][7] * sc));
    if (lane == 0) *descale = am > 0.f ? am * (1.f / 127.f) : 1.f;
}
constexpr int P7_UNITS = 8192;
DEVI void phase7_unit(const Params& p, int u, char* smem) {
    const int lane = LTID & 63, w = LTID >> 6;
    const int row = u * 4 + w;
    rms_row16_bf16_i8(reinterpret_cast<const bf16_t*>(p.ws + OFF_H16) + (size_t)row * DM, p.norm2_g, reinterpret_cast<bf16_t*>(p.ws + OFF_HN) + (size_t)row * DM,
                      p.ws + OFF_HN8 + (size_t)row * DM, reinterpret_cast<float*>(p.ws + OFF_HS) + row, lane);
}

using f32x16 = __attribute__((ext_vector_type(16))) float;
DEVI f32x16 mfma32(bf16x8 a, bf16x8 b, f32x16 c) { return __builtin_amdgcn_mfma_f32_32x32x16_bf16(a, b, c, 0, 0, 0); }
DEVI unsigned umax(unsigned a, unsigned b) { return a > b ? a : b; }
DEVI unsigned umin(unsigned a, unsigned b) { return a > b ? b : a; }
DEVI unsigned f2ord(float f) { const unsigned u = __float_as_uint(f); return u ^ ((unsigned)((int)u >> 31) | 0x80000000u); }
DEVI float ord2f(unsigned k) { return __uint_as_float((k & 0x80000000u) ? (k ^ 0x80000000u) : ~k); }

template <int BASE>
DEVI void sort16_desc(unsigned (&x)[64]) {
#pragma unroll
    for (int k = 2; k <= 16; k <<= 1) {
#pragma unroll
        for (int j = k >> 1; j > 0; j >>= 1) {
#pragma unroll
            for (int i = 0; i < 16; ++i) {
                const int l = i ^ j;
                if (l > i) {
                    const bool desc = ((i & k) == 0);
                    const unsigned a = x[BASE + i], b = x[BASE + l];
                    const unsigned hi = umax(a, b), lo = umin(a, b);
                    x[BASE + i] = desc ? hi : lo; x[BASE + l] = desc ? lo : hi;
                }
            }
        }
    }
}
template <int BASE>
DEVI void bmerge16_desc(unsigned (&x)[64]) {
#pragma unroll
    for (int j = 8; j > 0; j >>= 1) {
#pragma unroll
        for (int i = 0; i < 16; ++i) {
            const int l = i ^ j;
            if (l > i) { const unsigned a = x[BASE + i], b = x[BASE + l]; x[BASE + i] = umax(a, b); x[BASE + l] = umin(a, b); }
        }
    }
}
DEVI void top16_of_64(unsigned (&x)[64]) {
    sort16_desc<0>(x); sort16_desc<16>(x); sort16_desc<32>(x); sort16_desc<48>(x);
#pragma unroll
    for (int i = 0; i < 16; ++i) x[i] = umax(x[i], x[31 - i]);
    bmerge16_desc<0>(x);
#pragma unroll
    for (int i = 0; i < 16; ++i) x[32 + i] = umax(x[32 + i], x[63 - i]);
    bmerge16_desc<32>(x);
#pragma unroll
    for (int i = 0; i < 16; ++i) x[i] = umax(x[i], x[47 - i]);
    bmerge16_desc<0>(x);
}

DEVI void scores_top16(const char* sktile, const bf16_t* __restrict__ Qp, int lane, unsigned (&out)[16]) {
    const int r31 = lane & 31, hh = lane >> 5;
    f32x16 acc[4];
#pragma unroll
    for (int nb = 0; nb < 4; ++nb)
#pragma unroll
        for (int r = 0; r < 16; ++r) acc[nb][r] = 0.f;
#pragma unroll
    for (int ks = 0; ks < 8; ++ks) {
        const bf16x8 bq = ldg_frag(Qp + (size_t)r31 * 2048 + ks * 16 + 8 * hh);
#pragma unroll
        for (int nb = 0; nb < 4; ++nb) {
            const bf16x8 ak = *reinterpret_cast<const bf16x8*>(sktile + off_b((unsigned)(nb * 32 + r31), (unsigned)(2 * ks + hh)));
            acc[nb] = mfma32(ak, bq, acc[nb]);
        }
    }
    unsigned x[64];
    const unsigned hx = (unsigned)hh * 4u;
#pragma unroll
    for (int nb = 0; nb < 4; ++nb)
#pragma unroll
        for (int r = 0; r < 16; ++r) {
            const int nbase = nb * 32 + (r & 3) + 8 * (r >> 2);
            x[nb * 16 + r] = ((f2ord(acc[nb][r]) & ~127u) | (unsigned)(127 - nbase)) ^ hx;
        }
    top16_of_64(x);
    unsigned lo[16], hi[16];
#pragma unroll
    for (int i = 0; i < 16; ++i) { auto rr = __builtin_amdgcn_permlane32_swap(x[i], x[i], false, false); lo[i] = rr[0]; hi[i] = rr[1]; }
#pragma unroll
    for (int i = 0; i < 16; ++i) x[i] = umax(lo[i], hi[15 - i]);
    bmerge16_desc<0>(x);
#pragma unroll
    for (int i = 0; i < 16; ++i) out[i] = x[i];
}

DEVI void phase9_block(const Params& p, char* smem) {
    unsigned char* ws = p.ws;
    const int tid = threadIdx.x, lane = tid & 63, w = tid >> 6;
    const int h = blockIdx.x & 7, rank = blockIdx.x >> 3, nrank = ((int)gridDim.x - h + 7) >> 3;
    const int hh = lane >> 5;
    {
        const bf16_t* SK = reinterpret_cast<const bf16_t*>(ws + OFF_SK) + (size_t)(h * 2) * 128 * 128;
#pragma unroll
        for (int i = 0; i < 8; ++i) {
            const int nn = tid + 512 * i, tl = nn >> 11, row = (nn >> 4) & 127, ch = nn & 15;
            *reinterpret_cast<uint4*>(smem + tl * 32768 + off_b((unsigned)row, (unsigned)ch)) = *reinterpret_cast<const uint4*>(SK + (size_t)tl * 16384 + row * 128 + ch * 8);
        }
    }
    __syncthreads();
    unsigned* KL = reinterpret_cast<unsigned*>(smem + 65536) + w * 2048;
    const int gw = (int)blockIdx.x * 8 + w, ngw = (int)gridDim.x * 8;
#define P9_SIDE_ROWS() do { for (int row = gw; row < 2 * 16384; row += ngw) { \
        if (row < 16384) quant_row_i8(p.peer_u + (size_t)row * DM, ws + OFF_U8, row, reinterpret_cast<float*>(ws + OFF_US) + row, lane); \
        else quant_row_fp8(p.peer_v + (size_t)(row - 16384) * DM, ws + OFF_V8, row - 16384, reinterpret_cast<float*>(ws + OFF_VS) + row - 16384, lane); } } while (0)
    if (w < 4) P9_SIDE_ROWS();
    for (int it = rank; it < M_TOK / 256; it += nrank) {
    const int t0 = it * 256 + w * 32;
    const bf16_t* Q = reinterpret_cast<const bf16_t*>(ws + OFF_Q) + (size_t)t0 * 2048 + h * 256;
    unsigned k0[16], k1[16];
    scores_top16(smem, Q, lane, k0);
    scores_top16(smem + 32768, Q + 128, lane, k1);
#pragma unroll
    for (int i = 0; i < 16; ++i) { KL[i * 64 + lane] = k0[i]; KL[(16 + i) * 64 + lane] = k1[i]; }
    float s0[16], s1[16];
#pragma unroll
    for (int i = 0; i < 16; ++i) { s0[i] = ord2f(k0[i] & ~127u); s1[i] = ord2f(k1[i] & ~127u); }
    unsigned x[64];
    {
        int n = 0;
#pragma unroll
        for (int a = 0; a < 16; ++a)
#pragma unroll
            for (int b = 0; b < 16; ++b)
                if ((a + 1) * (b + 1) <= 16) { x[n] = (f2ord(s0[a] + s1[b]) & ~255u) | (unsigned)(255 - (a * 16 + b)); ++n; }
#pragma unroll
        for (int i = 50; i < 64; ++i) x[i] = 0u;
    }
    top16_of_64(x);
    float cv[16]; int ex[16];
#pragma unroll
    for (int i = 0; i < 16; ++i) {
        cv[i] = ord2f(x[i] & ~255u);
        const int cid = 255 - (int)(x[i] & 255u);
        const unsigned ka = KL[(cid >> 4) * 64 + lane], kb = KL[(16 + (cid & 15)) * 64 + lane];
        ex[i] = (127 - (int)(ka & 127u)) * 128 + (127 - (int)(kb & 127u));
    }
    float sum = 0.f;
    const float mx = cv[0];
#pragma unroll
    for (int i = 0; i < 16; ++i) cv[i] = __expf(cv[i] - mx);
#pragma unroll
    for (int i = 0; i < 16; ++i) sum += cv[i];
    const float inv = __builtin_amdgcn_rcpf(sum);
    const size_t orow = (size_t)(t0 + (lane & 31)) * 128 + h * 16;
    if (hh == 0) {
        int4* d = reinterpret_cast<int4*>(reinterpret_cast<int*>(ws + OFF_EIDX) + orow);
#pragma unroll
        for (int i = 0; i < 4; ++i) d[i] = make_int4(ex[4 * i], ex[4 * i + 1], ex[4 * i + 2], ex[4 * i + 3]);
    } else {
        float4* d = reinterpret_cast<float4*>(reinterpret_cast<float*>(ws + OFF_EW) + orow);
#pragma unroll
        for (int i = 0; i < 4; ++i) d[i] = make_float4(cv[4 * i] * inv, cv[4 * i + 1] * inv, cv[4 * i + 2] * inv, cv[4 * i + 3] * inv);
        }
}
    if (w >= 4) P9_SIDE_ROWS();
#undef P9_SIDE_ROWS
}

typedef _Float16 h2_t __attribute__((ext_vector_type(2)));
DEVI float sum8(float v) { v += dpp_f<0xB1>(v); v += dpp_f<0x4E>(v); v += dpp_f<0x141>(v); return v; }
DEVI float sum64(float v) {
    v = sum8(v); v += dpp_f<0x128>(v);
    { auto s = __builtin_amdgcn_permlane16_swap(__float_as_uint(v), __float_as_uint(v), false, false); v = __uint_as_float(s[0]) + __uint_as_float(s[1]); }
    { auto s = __builtin_amdgcn_permlane32_swap(__float_as_uint(v), __float_as_uint(v), false, false); v = __uint_as_float(s[0]) + __uint_as_float(s[1]); }
    return v;
}
DEVI long pack_i64(unsigned lo, unsigned hi) { return (long)(((unsigned long long)hi << 32) | (unsigned long long)lo); }

#define SB __builtin_amdgcn_sched_barrier(0)
#define SB __builtin_amdgcn_sched_barrier(0)
#define PIN4(Q) "+v"(Q.x), "+v"(Q.y), "+v"(Q.z), "+v"(Q.w)
DEVI void phase10a_block(const Params& p, char* smem) {
    unsigned char* ws = p.ws;
    const int s = blockIdx.x & 7, rank = blockIdx.x >> 3, nrank = ((int)gridDim.x - s + 7) >> 3;
    const int lane = threadIdx.x & 63, wave = threadIdx.x >> 6;
    const int lg = lane & 7, grp = lane >> 3;
    const unsigned char* U8 = ws + OFF_U8 + (size_t)s * (16384 * 128);
    const unsigned char* HNs = ws + OFF_HN8 + 128 * s + 16 * lg;
    unsigned* PD = reinterpret_cast<unsigned*>(ws + OFF_PD) + (size_t)s * M_TOK * 64;
    float* stg = reinterpret_cast<float*>(smem) + wave * (16 * 128);
    constexpr int NTG = M_TOK / 8;
#define P10A_LOAD_EV(TG, E) do { const int4* _q = reinterpret_cast<const int4*>(reinterpret_cast<const int*>(ws + OFF_EIDX) + (size_t)((TG) * 8 + wave) * 128 + 16 * grp); \
        E[0] = _q[0]; E[1] = _q[1]; E[2] = _q[2]; E[3] = _q[3]; } while (0)
#define P10A_LOAD_ROWS(TG, E, R, HA) do { \
        asm volatile("" : PIN4(E[0]), PIN4(E[1]), PIN4(E[2]), PIN4(E[3])); \
        const int _e[16] = {E[0].x, E[0].y, E[0].z, E[0].w, E[1].x, E[1].y, E[1].z, E[1].w, E[2].x, E[2].y, E[2].z, E[2].w, E[3].x, E[3].y, E[3].z, E[3].w}; \
        _Pragma("unroll") for (int _i = 0; _i < 16; ++_i) R[_i] = *reinterpret_cast<const uint4*>(U8 + ((unsigned)_e[_i] * 128u + 16u * (unsigned)lg)); \
        HA = *reinterpret_cast<const uint4*>(HNs + (size_t)((TG) * 8 + wave) * DM); } while (0)
#define P10A_COMPUTE(SLOT, R, HA) do { \
        asm volatile("" : PIN4(R[0]), PIN4(R[1]), PIN4(R[2]), PIN4(R[3]), PIN4(R[4]), PIN4(R[5])); \
        asm volatile("" : PIN4(R[6]), PIN4(R[7]), PIN4(R[8]), PIN4(R[9]), PIN4(R[10]), PIN4(R[11])); \
        asm volatile("" : PIN4(R[12]), PIN4(R[13]), PIN4(R[14]), PIN4(R[15]), PIN4(HA)); \
        int _v1 = 0, _v2 = 0; \
        _Pragma("unroll") for (int _i = 0; _i < 16; ++_i) { \
            int _a = __builtin_amdgcn_sdot4((int)R[_i].x, (int)HA.x, 0, false); \
            _a = __builtin_amdgcn_sdot4((int)R[_i].y, (int)HA.y, _a, false); \
            _a = __builtin_amdgcn_sdot4((int)R[_i].z, (int)HA.z, _a, false); \
            _a = __builtin_amdgcn_sdot4((int)R[_i].w, (int)HA.w, _a, false); \
            _a += __builtin_amdgcn_mov_dpp(_a, 0xB1, 0xf, 0xf, true); _a += __builtin_amdgcn_mov_dpp(_a, 0x4E, 0xf, 0xf, true); _a += __builtin_amdgcn_mov_dpp(_a, 0x141, 0xf, 0xf, true); \
            if (_i < 8) _v1 = (lg == _i) ? _a : _v1; else _v2 = (lg == _i - 8) ? _a : _v2; } \
        stg[(SLOT) * 128 + 16 * grp + lg] = (float)_v1; stg[(SLOT) * 128 + 16 * grp + 8 + lg] = (float)_v2; } while (0)
    int4 eA[4], eB[4], eC[4]; uint4 rA[16], rB[16]; uint4 hA0, hB0;
    if (rank >= NTG) return;
    const int ntok = (NTG - rank + nrank - 1) / nrank;
#define TGI(I) (rank + ((I) < ntok ? (I) : ntok - 1) * nrank)
    P10A_LOAD_EV(TGI(0), eA);
    SB; P10A_LOAD_EV(TGI(1), eB);
    SB; P10A_LOAD_ROWS(TGI(0), eA, rA, hA0);
    SB;
    for (int base = 0; base < ntok; base += 16) {
#pragma unroll 1
        for (int i = base; i < base + 16; i += 2) {
            SB; P10A_LOAD_EV(TGI(i + 2), eC);
            SB; P10A_LOAD_ROWS(TGI(i + 1), eB, rB, hB0);
            SB; P10A_COMPUTE(i - base, rA, hA0);
            SB; P10A_LOAD_EV(TGI(i + 3), eB);
            SB; P10A_LOAD_ROWS(TGI(i + 2), eC, rA, hA0);
            SB; P10A_COMPUTE(i + 1 - base, rB, hB0);
            SB;
        }
#pragma unroll 4
        for (int j = 0; j < 16; ++j) {
            const float2 v = *reinterpret_cast<const float2*>(stg + j * 128 + 2 * lane);
            PD[(size_t)(TGI(base + j) * 8 + wave) * 64 + lane] = pack2(v.x, v.y);
        }
        __builtin_amdgcn_s_waitcnt(0x0F70);
    }
#undef TGI
#undef P10A_LOAD_EV
#undef P10A_LOAD_ROWS
#undef P10A_COMPUTE
}

DEVI void phase10w_block(const Params& p) {
    unsigned char* ws = p.ws;
    const int lane = threadIdx.x & 63, wave = threadIdx.x >> 6;
    const unsigned* PD = reinterpret_cast<const unsigned*>(ws + OFF_PD);
    const float* HS = reinterpret_cast<const float*>(ws + OFF_HS);
    const float* US = reinterpret_cast<const float*>(ws + OFF_US);
    const float* VS = reinterpret_cast<const float*>(ws + OFF_VS);
    const int2* EI = reinterpret_cast<const int2*>(ws + OFF_EIDX);
    const int nstep = (int)gridDim.x * 8;
    int t = blockIdx.x * 8 + wave;
    if (t >= M_TOK) return;
    int2 ei = EI[(size_t)t * 64 + lane];
    for (; t < M_TOK; t += nstep) {
        const int tn = (t + nstep < M_TOK) ? t + nstep : t;
        unsigned pd[8];
#pragma unroll
        for (int sl = 0; sl < 8; ++sl) pd[sl] = PD[((size_t)sl * M_TOK + t) * 64 + lane];
        const float2 sm = reinterpret_cast<const float2*>(ws + OFF_EW)[(size_t)t * 64 + lane];
        const float hs = HS[t];
        const float u0 = US[ei.x], u1 = US[ei.y], v0 = VS[ei.x], v1 = VS[ei.y];
        ei = EI[(size_t)tn * 64 + lane];
        float d0 = 0.f, d1 = 0.f;
#pragma unroll
        for (int sl = 0; sl < 8; ++sl) { d0 += bflo(pd[sl]); d1 += bfhi(pd[sl]); }
        d0 *= u0 * hs; d1 *= u1 * hs;
        const _Float16 w0 = (_Float16)(sm.x * v0 * 0.5f * d0 * (1.f + erff(d0 * 0.70710678118654752f))), w1 = (_Float16)(sm.y * v1 * 0.5f * d1 * (1.f + erff(d1 * 0.70710678118654752f)));
        const h2_t p0 = h2_t{w0, w0}, p1 = h2_t{w1, w1};
        reinterpret_cast<uint2*>(ws + OFF_W16)[(size_t)t * 64 + lane] = make_uint2(__builtin_bit_cast(unsigned, p0), __builtin_bit_cast(unsigned, p1));
    }
}

template <bool DRY>
DEVI void phase10b_block(const Params& p, char* smem) {
    unsigned char* ws = p.ws;
    const int s = blockIdx.x & 7, rank = blockIdx.x >> 3, nrank = ((int)gridDim.x - s + 7) >> 3;
    const int lane = threadIdx.x & 63, wave = threadIdx.x >> 6;
    const int lg = lane & 7, grp = lane >> 3;
    const unsigned char* V8 = ws + OFF_V8 + (size_t)s * (16384 * 128);
    float* stg = reinterpret_cast<float*>(smem) + wave * (16 * 128);
    constexpr int NTG = M_TOK / 8;
#define P10B_LOAD_EV(TG, E) do { const int4* _q = reinterpret_cast<const int4*>(reinterpret_cast<const int*>(ws + OFF_EIDX) + (size_t)((TG) * 8 + wave) * 128 + 16 * grp); \
        E[0] = _q[0]; E[1] = _q[1]; E[2] = _q[2]; E[3] = _q[3]; } while (0)
#define P10B_LOAD_ROWS(TG, E, R, WA, WB, WC, WD) do { \
        asm volatile("" : PIN4(E[0]), PIN4(E[1]), PIN4(E[2]), PIN4(E[3])); \
        const int _e[16] = {E[0].x, E[0].y, E[0].z, E[0].w, E[1].x, E[1].y, E[1].z, E[1].w, E[2].x, E[2].y, E[2].z, E[2].w, E[3].x, E[3].y, E[3].z, E[3].w}; \
        _Pragma("unroll") for (int _i = 0; _i < 16; ++_i) R[_i] = *reinterpret_cast<const uint4*>(V8 + ((unsigned)_e[_i] * 128u + 16u * (unsigned)lg)); \
        const uint4* _w = reinterpret_cast<const uint4*>(reinterpret_cast<const unsigned*>(ws + OFF_W16) + (size_t)((TG) * 8 + wave) * 128 + 16 * grp); WA = _w[0]; WB = _w[1]; WC = _w[2]; WD = _w[3]; } while (0)
#define P10B_COMPUTE(SLOT, R, WA, WB, WC, WD) do { \
          \
        asm volatile("" : PIN4(R[0]), PIN4(R[1]), PIN4(R[2]), PIN4(R[3]), PIN4(R[4]), PIN4(R[5])); \
        asm volatile("" : PIN4(R[6]), PIN4(R[7]), PIN4(R[8]), PIN4(R[9]), PIN4(R[10]), PIN4(R[11])); \
        asm volatile("" : PIN4(R[12]), PIN4(R[13]), PIN4(R[14]), PIN4(R[15]), PIN4(WA), PIN4(WB)); \
        asm volatile("" : PIN4(WC), PIN4(WD)); \
        const unsigned _ww[16] = {WA.x, WA.y, WA.z, WA.w, WB.x, WB.y, WB.z, WB.w, WC.x, WC.y, WC.z, WC.w, WD.x, WD.y, WD.z, WD.w}; \
        h2_t _acc[8]; unsigned _zb; asm volatile("v_mov_b32 %0, 0" : "=v"(_zb)); \
        _Pragma("unroll") for (int _j = 0; _j < 8; ++_j) _acc[_j] = __builtin_bit_cast(h2_t, _zb); \
        _Pragma("unroll") for (int _i = 0; _i < 16; ++_i) { \
            const h2_t _wp = __builtin_bit_cast(h2_t, _ww[_i]); \
            const unsigned _wd[4] = {R[_i].x, R[_i].y, R[_i].z, R[_i].w}; \
            _Pragma("unroll") for (int _j = 0; _j < 4; ++_j) { \
                _acc[2 * _j] += _wp * __builtin_amdgcn_cvt_scalef32_pk_f16_fp8((int)_wd[_j], 1.0f, false); \
                _acc[2 * _j + 1] += _wp * __builtin_amdgcn_cvt_scalef32_pk_f16_fp8((int)_wd[_j], 1.0f, true); } } \
          \
          \
        h2_t _r5[4], _r4[2]; \
        _Pragma("unroll") for (int _j = 0; _j < 4; ++_j) { auto _s = __builtin_amdgcn_permlane32_swap(__builtin_bit_cast(unsigned, _acc[_j]), __builtin_bit_cast(unsigned, _acc[_j + 4]), false, false); \
            _r5[_j] = __builtin_bit_cast(h2_t, (unsigned)_s[0]) + __builtin_bit_cast(h2_t, (unsigned)_s[1]); } \
        _Pragma("unroll") for (int _j = 0; _j < 2; ++_j) { auto _s = __builtin_amdgcn_permlane16_swap(__builtin_bit_cast(unsigned, _r5[_j]), __builtin_bit_cast(unsigned, _r5[_j + 2]), false, false); \
            _r4[_j] = __builtin_bit_cast(h2_t, (unsigned)_s[0]) + __builtin_bit_cast(h2_t, (unsigned)_s[1]); } \
        { const bool _b3 = (lane & 8) != 0; \
          const unsigned _send = _b3 ? __builtin_bit_cast(unsigned, _r4[0]) : __builtin_bit_cast(unsigned, _r4[1]); \
          const h2_t _keep = _b3 ? _r4[1] : _r4[0]; \
          const h2_t _res = _keep + __builtin_bit_cast(h2_t, __builtin_amdgcn_mov_dpp((int)_send, 0x128, 0xf, 0xf, true));     \
          *reinterpret_cast<float2*>(stg + (SLOT) * 128 + 16 * lg + 2 * grp) = make_float2((float)_res[0], (float)_res[1]); } } while (0)
    int4 eA[4], eB[4], eC[4]; uint4 rA[16], rB[16]; uint4 wA0, wA1, wA2, wA3, wB0, wB1, wB2, wB3;
    if (rank >= NTG) return;
    const int ntok = (NTG - rank + nrank - 1) / nrank;
#define TGI(I) (rank + ((I) < ntok ? (I) : ntok - 1) * nrank)
    P10B_LOAD_EV(TGI(0), eA);
    SB; P10B_LOAD_EV(TGI(1), eB);
    SB; P10B_LOAD_ROWS(TGI(0), eA, rA, wA0, wA1, wA2, wA3);
    SB;
    for (int base = 0; base < ntok; base += 16) {
#pragma unroll 1
        for (int i = base; i < base + 16; i += 2) {
            SB; P10B_LOAD_EV(TGI(i + 2), eC);
            SB; P10B_LOAD_ROWS(TGI(i + 1), eB, rB, wB0, wB1, wB2, wB3);
            SB; P10B_COMPUTE(i - base, rA, wA0, wA1, wA2, wA3);
            SB; P10B_LOAD_EV(TGI(i + 3), eB);
            SB; P10B_LOAD_ROWS(TGI(i + 2), eC, rA, wA0, wA1, wA2, wA3);
            SB; P10B_COMPUTE(i + 1 - base, rB, wB0, wB1, wB2, wB3);
            SB;
        }
#pragma unroll 4
        for (int j = 0; j < 16; ++j) {
            const float2 v = *reinterpret_cast<const float2*>(stg + j * 128 + 2 * lane);
            reinterpret_cast<unsigned*>(ws + OFF_PEER)[(DRY ? (size_t)M_TOK * 512 : 0) + (size_t)(TGI(base + j) * 8 + wave) * 512 + 64 * s + lane] = pack2(v.x, v.y);
        }
        __builtin_amdgcn_s_waitcnt(0x0F70);
    }
#undef TGI
#undef P10B_LOAD_EV
#undef P10B_LOAD_ROWS
#undef P10B_COMPUTE
}

DEVI void phase10c_block(const Params& p) {
    unsigned char* ws = p.ws;
    const int lane = threadIdx.x & 63, wave = threadIdx.x >> 6;
    const float4* gf = reinterpret_cast<const float4*>(p.norm_f_g);
    for (int t = blockIdx.x * 8 + wave; t < M_TOK; t += gridDim.x * 8) {
        const uint4* hrow = reinterpret_cast<const uint4*>(ws + OFF_H16) + (size_t)t * 128;
        const uint4* prow = reinterpret_cast<const uint4*>(ws + OFF_PEER) + (size_t)t * 128;
        float4* orow = reinterpret_cast<float4*>(p.out + (size_t)t * DM);
        uint4 hq[2], pq[2];
#pragma unroll
        for (int i = 0; i < 2; ++i) { hq[i] = hrow[lane + 64 * i]; pq[i] = prow[lane + 64 * i]; }
        float v[2][8]; float ss = 0.f;
#pragma unroll
        for (int i = 0; i < 2; ++i) {
            v[i][0] = bflo(hq[i].x) + bflo(pq[i].x); v[i][1] = bfhi(hq[i].x) + bfhi(pq[i].x); v[i][2] = bflo(hq[i].y) + bflo(pq[i].y); v[i][3] = bfhi(hq[i].y) + bfhi(pq[i].y);
            v[i][4] = bflo(hq[i].z) + bflo(pq[i].z); v[i][5] = bfhi(hq[i].z) + bfhi(pq[i].z); v[i][6] = bflo(hq[i].w) + bflo(pq[i].w); v[i][7] = bfhi(hq[i].w) + bfhi(pq[i].w);
#pragma unroll
            for (int j = 0; j < 8; ++j) ss += v[i][j] * v[i][j];
        }
        const float r = rsqrtf(wave_sum(ss) * (1.f / 1024.f) + 1e-6f);
#pragma unroll
        for (int i = 0; i < 2; ++i) {
            const float4 g0 = gf[2 * (lane + 64 * i)], g1 = gf[2 * (lane + 64 * i) + 1];
            orow[2 * (lane + 64 * i)] = make_float4(v[i][0] * r * g0.x, v[i][1] * r * g0.y, v[i][2] * r * g0.z, v[i][3] * r * g0.w);
            orow[2 * (lane + 64 * i) + 1] = make_float4(v[i][4] * r * g1.x, v[i][5] * r * g1.y, v[i][6] * r * g1.z, v[i][7] * r * g1.w);
        }
    }
}

#define XB_TMO      128
#define XB_XCNT(j)  (256  + 64 * (j))
#define XB_XSUB(j)  (1280 + 64 * (j))
#define XB_XGEN(j)  (2304 + 64 * (j))
#define XB_TOP      3328
#define XB_TOPGEN   3392
#define XCD_BAR_WORDS 3456
#define XB_SPIN_CAP (1u << 22)
#define LAS __attribute__((address_space(3)))
DEVI unsigned xb_ld(unsigned* p)              { return __hip_atomic_load(p, __ATOMIC_RELAXED, __HIP_MEMORY_SCOPE_AGENT); }
DEVI unsigned xb_add(unsigned* p, unsigned v) { return __hip_atomic_fetch_add(p, v, __ATOMIC_RELAXED, __HIP_MEMORY_SCOPE_AGENT); }
DEVI unsigned xb_xcc_id() { return (unsigned)__builtin_amdgcn_s_getreg((3 << 11) | 20) & 0xFu; }
#define XB_SPIN(cond, bar) do { unsigned _sp = 0; while (cond) { __builtin_amdgcn_s_sleep(1); \
    if ((++_sp & 255u) == 0u) { if (xb_ld(&(bar)[XB_TMO])) break; if (_sp > XB_SPIN_CAP) { atomicAdd(&(bar)[XB_TMO], 1u); break; } } } } while (0)
struct XcdBarrier { unsigned* bar; unsigned x; volatile LAS unsigned* st; };
DEVI XcdBarrier xcd_barrier_post(unsigned* bar, volatile LAS unsigned* st) {
    XcdBarrier b; b.bar = bar; b.x = xb_xcc_id(); b.st = st;
    if (threadIdx.x == 0) (void)xb_add(&bar[XB_XCNT(b.x)], 1u);
    return b;
}
DEVI void xcd_barrier_complete(unsigned* bar, unsigned x, unsigned& nloc, unsigned& nx) {
    const unsigned G = gridDim.x * gridDim.y * gridDim.z;
    unsigned sum, cnt, mine, sp = 0u;
    for (;;) {
        sum = 0u; cnt = 0u; mine = 0u;
#pragma unroll
        for (unsigned j = 0; j < 16; ++j) { const unsigned c = xb_ld(&bar[XB_XCNT(j)]); sum += c; cnt += (c > 0u) ? 1u : 0u; mine = (j == x) ? c : mine; }
        if (sum == G) break;
        __builtin_amdgcn_s_sleep(1);
        if ((++sp & 255u) == 0u) { if (xb_ld(&bar[XB_TMO])) break; if (sp > XB_SPIN_CAP) { atomicAdd(&bar[XB_TMO], 1u); break; } }
    }
    nloc = mine > 0u ? mine : 1u; nx = cnt > 0u ? cnt : 1u;
}
DEVI void xcd_barrier(const XcdBarrier& b) {
    asm volatile("s_waitcnt vmcnt(0)" ::: "memory");
    __syncthreads();
    if (threadIdx.x == 0) {
        unsigned* bar = b.bar;
        __builtin_amdgcn_s_waitcnt(0);
        unsigned nloc = b.st[0], nx = b.st[1];
        if (nloc == 0u) { xcd_barrier_complete(bar, b.x, nloc, nx); b.st[0] = nloc; b.st[1] = nx; }
        const unsigned old = xb_add(&bar[XB_XSUB(b.x)], 1u);
        const unsigned gen = old / nloc;
        if (old + 1u == (gen + 1u) * nloc) {
            __builtin_amdgcn_fence(__ATOMIC_RELEASE, "agent");
            asm volatile("s_waitcnt vmcnt(0)" ::: "memory");
            const unsigned og = xb_add(&bar[XB_TOP], 1u);
            const unsigned tg = og / nx;
            if (og + 1u == (tg + 1u) * nx) xb_add(&bar[XB_TOPGEN], 1u);
            else XB_SPIN(xb_ld(&bar[XB_TOPGEN]) == tg, bar);
            __builtin_amdgcn_fence(__ATOMIC_ACQUIRE, "agent");
            xb_add(&bar[XB_XGEN(b.x)], 1u);
            asm volatile("s_waitcnt vmcnt(0)" ::: "memory");
        } else {
            XB_SPIN(xb_ld(&bar[XB_XGEN(b.x)]) == gen, bar);
            __builtin_amdgcn_fence(__ATOMIC_ACQUIRE, "agent");
            asm volatile("s_waitcnt vmcnt(0)" ::: "memory");
        }
    }
    __syncthreads();
}

constexpr int N_PHASES = 11;
constexpr int LDS_PHASE_BYTES = 131072;
constexpr int LDS_BYTES = LDS_PHASE_BYTES + 16;

__global__ void __launch_bounds__(512, 2) hymba_fwd(Params p) {
    extern __shared__ __attribute__((aligned(16))) char smem[];
    cg::grid_group grid = cg::this_grid();
    const int lo = p.ph_lo, hi = p.ph_hi;
    volatile LAS unsigned* bst = (volatile LAS unsigned*)(smem + LDS_PHASE_BYTES);
    if (threadIdx.x == 0) { bst[0] = 0u; bst[1] = 0u; bst[2] = 0u; bst[3] = 0u; }
    __syncthreads();
    XcdBarrier xb = xcd_barrier_post(reinterpret_cast<unsigned*>(p.ws + OFF_BAR), bst);
    const int hb = (int)(threadIdx.x >> 8);
    char* hsm = smem + hb * 65536;
#define SEAM(K) if ((K) > lo) { if (hi < 0) grid.sync(); else xcd_barrier(xb); }
#define RUN_PHASE(K, FN, N) if (lo <= (K) && (K) < hi) { SEAM(K) for (int rep = 0; rep < 1 + ((PROBE_DUP >> (K)) & 1); ++rep) { if (rep) xcd_barrier(xb); \
        for (int ub = blockIdx.x * 2; ub < (N); ub += gridDim.x * 2) { const int u = ub + hb; if (u < (N)) FN(p, u, hsm); } } }
#define RUN_GEMM(K, CALL) if (lo <= (K) && (K) < hi) { SEAM(K) CALL; }
    RUN_PHASE(0, phase0_unit, P0_UNITS)
    RUN_GEMM(1, run_gemm(reinterpret_cast<const bf16_t*>(p.ws + OFF_XN), reinterpret_cast<const bf16_t*>(p.ws + OFF_WIN), P1_N, EpiInProj{p.ws}, smem))
    if (lo <= 3 && 3 < hi) { SEAM(3) phase3_loop<128>(p, hb, hsm); phase3_loop<64>(p, hb, hsm); }
    RUN_PHASE(4, phase4_unit, P4_UNITS)
    if (lo <= 5 && 5 < hi) { SEAM(5) phase5_loop<128>(p, hb, hsm); phase5_loop<64>(p, hb, hsm); }
    RUN_GEMM(6, run_gemm(reinterpret_cast<const bf16_t*>(p.ws + OFF_MIX), reinterpret_cast<const bf16_t*>(p.ws + OFF_WOUT), 1024, EpiOutProj{p.x, reinterpret_cast<bf16_t*>(p.ws + OFF_H16)}, smem))
    RUN_PHASE(7, phase7_unit, P7_UNITS)
    RUN_GEMM(8, run_gemm(reinterpret_cast<const bf16_t*>(p.ws + OFF_HN), reinterpret_cast<const bf16_t*>(p.ws + OFF_WQ), 2048, EpiQ{reinterpret_cast<bf16_t*>(p.ws + OFF_Q)}, smem))
    RUN_GEMM(9, phase9_block(p, smem))
    if (lo <= 10 && 10 < hi) {
        SEAM(10)
#if PROBE_P10X == 4
        phase10a_block(p, smem); xcd_barrier(xb);
#endif
        phase10a_block(p, smem);
#if PROBE_P10X == 1
        xcd_barrier(xb); phase10a_block(p, smem);
#endif

        xcd_barrier(xb); phase10w_block(p);
#if PROBE_P10X == 2
        xcd_barrier(xb); phase10b_block<true>(p, smem);
#endif
        xcd_barrier(xb); phase10b_block<false>(p, smem);
        xcd_barrier(xb); phase10c_block(p);
#if PROBE_P10X == 3
        xcd_barrier(xb); phase10c_block(p);
#endif
    }
#undef RUN_PHASE
#undef RUN_GEMM
#undef SEAM
}

extern "C" void kernel_launch(void* const* d_in, const int* in_sizes, int n_in, void* d_out, int out_size, void* d_ws, size_t ws_size, hipStream_t stream) {
    static int grid_blocks = 0;
    if (grid_blocks == 0) {
        if (n_in != 15 || in_sizes[0] != M_TOK * DM || out_size != M_TOK * DM || ws_size < WS_NEED) {
            fprintf(stderr, "kernel_launch: unexpected shapes (n_in %d, in0 %d, out %d, ws %zu)\n", n_in, n_in > 0 ? in_sizes[0] : -1, out_size, ws_size);
            grid_blocks = -1; return;
        }
        int dev = 0, cus = 0, per_cu = 0;
        (void)hipGetDevice(&dev);
        (void)hipDeviceGetAttribute(&cus, hipDeviceAttributeMultiprocessorCount, dev);
        (void)hipFuncSetAttribute((const void*)hymba_fwd, hipFuncAttributeMaxDynamicSharedMemorySize, LDS_BYTES);
        (void)hipOccupancyMaxActiveBlocksPerMultiprocessor(&per_cu, (const void*)hymba_fwd, 512, LDS_BYTES);
        if (per_cu < 1) per_cu = 1;
        if (per_cu > 1) per_cu = 1;
        grid_blocks = cus * per_cu;
    }
    if (grid_blocks < 0) return;
    Params p{};
    p.x = (const float*)d_in[0]; p.norm1_g = (const float*)d_in[1]; p.w_in = (const float*)d_in[2]; p.hg_lower = (const float*)d_in[3];
    p.hg_norm_g = (const float*)d_in[4]; p.gla_wg = (const float*)d_in[5]; p.gla_bg = (const float*)d_in[6]; p.gla_norm_g = (const float*)d_in[7];
    p.w_out = (const float*)d_in[8]; p.norm2_g = (const float*)d_in[9]; p.w_q = (const float*)d_in[10]; p.sub_keys = (const float*)d_in[11];
    p.peer_u = (const float*)d_in[12]; p.peer_v = (const float*)d_in[13]; p.norm_f_g = (const float*)d_in[14];
    p.out = (float*)d_out; p.ws = (unsigned char*)d_ws;
#if N_LAUNCH_MODE == 1
    (void)hipMemsetAsync((unsigned char*)d_ws + OFF_BAR, 0, XCD_BAR_WORDS * 4, stream);
    p.ph_lo = 0; p.ph_hi = N_PHASES;
    void* args[] = {&p};
    hipError_t e = hipLaunchCooperativeKernel((const void*)hymba_fwd, dim3(grid_blocks), dim3(512), args, LDS_BYTES, stream);
    if (e != hipSuccess) fprintf(stderr, "cooperative launch failed: %s (grid %d)\n", hipGetErrorString(e), grid_blocks);
#else
    for (int ph = 0; ph < N_PHASES; ++ph) {
        p.ph_lo = ph; p.ph_hi = ph + 1;
        hipLaunchKernelGGL(hymba_fwd, dim3(grid_blocks), dim3(512), LDS_BYTES, stream, p);
    }
#endif
}
```
